# Optimizing an MI355X kernel written in HIP

```python
import jax
import jax.numpy as jnp
from jax import lax
import numpy as np

D_MODEL = 1024
BATCH = 4
SEQ = 4096
DEPTH = 2

GRID_W = 64
CTX_LEN = 256
HEAD_DIM = 64
NORM_EPS = 1e-6
ROPE_THETA = 10000.0
SW_HEADS = D_MODEL // (2 * HEAD_DIM)
SW_KV_HEADS = SW_HEADS // 4
SW_GROUP = SW_HEADS // SW_KV_HEADS
SW_WINDOW = 128
SW_BLOCK = 128
SC_DIM = D_MODEL // 2
SC_WIDTH = 3
NA_HEADS = D_MODEL // (2 * HEAD_DIM)
NA_WIN_ROWS = 8
NA_WIN_COLS = 16
FOURIER_DIM = D_MODEL // 2
FOURIER_GROUPS = 4
SW_Q_DIM = SW_HEADS * HEAD_DIM
SW_KV_DIM = SW_KV_HEADS * HEAD_DIM
EVEN_IN = SW_Q_DIM + 2 * SW_KV_DIM + 3 * SC_DIM
EVEN_OUT = SW_Q_DIM + SC_DIM
NA_DIM = NA_HEADS * HEAD_DIM
ODD_IN = 3 * NA_DIM + FOURIER_DIM
ODD_OUT = NA_DIM + FOURIER_DIM
N_EXPERTS = 32
TOP_K = 4
D_FF = D_MODEL
SWIGLU_LIMIT = 7.0
SWIGLU_ALPHA = 1.702
MOE_BLOCK = 128

kernel_name = 'hybrid_conv_swa_natten_fnet_moe_dit'


def rms_norm(x, g):
    x32 = x.astype(jnp.float32)
    y = x32 * lax.rsqrt(jnp.mean(x32 * x32, axis=-1, keepdims=True) + NORM_EPS)
    return (y * g.astype(jnp.float32)).astype(x.dtype)


def axial_rope(n_tok):
    t = jnp.arange(n_tok, dtype=jnp.int32)
    row = (t // GRID_W).astype(jnp.float32)
    col = (t % GRID_W).astype(jnp.float32)
    n_freq = HEAD_DIM // 4
    inv_freq = jnp.power(ROPE_THETA, -jnp.arange(n_freq, dtype=jnp.float32) / n_freq)
    ang = jnp.concatenate([row[:, None] * inv_freq, col[:, None] * inv_freq], axis=-1)
    return jnp.cos(ang), jnp.sin(ang)


def apply_rope(x, cos, sin):
    shape = (x.shape[1],) + (1,) * (x.ndim - 3) + (x.shape[-1] // 2,)
    cos = cos.reshape(shape).astype(x.dtype)
    sin = sin.reshape(shape).astype(x.dtype)
    x1, x2 = jnp.split(x, 2, axis=-1)
    return jnp.concatenate([x1 * cos - x2 * sin, x2 * cos + x1 * sin], axis=-1)


def context_attention(q, k, v, sink):
    b, n_ctx, hk, g, _ = q.shape
    s = jnp.einsum('bqhgd,bkhd->bhgqk', q, k).astype(jnp.float32) * (HEAD_DIM ** -0.5)
    if sink is not None:
        s_sink = jnp.broadcast_to(sink.astype(jnp.float32).reshape(1, hk, g, 1, 1), s.shape[:-1] + (1,))
        s = jnp.concatenate([s, s_sink], axis=-1)
    p = jax.nn.softmax(s, axis=-1).astype(v.dtype)
    o = jnp.einsum('bhgqk,bkhd->bqhgd', p[..., :n_ctx], v)
    return o.reshape(b, n_ctx, hk * g * HEAD_DIM)


def window_attention(q, k, v, k_ctx, v_ctx, sink):
    b, s = q.shape[0], q.shape[1]
    nb = s // SW_BLOCK
    nk = 3 * SW_BLOCK
    scale = HEAD_DIM ** -0.5
    qb = q.reshape(b, nb, SW_BLOCK, SW_KV_HEADS, SW_GROUP, HEAD_DIM)
    pad = ((0, 0), (SW_BLOCK, SW_BLOCK), (0, 0), (0, 0))

    def band(t):
        tp = jnp.pad(t, pad).reshape(b, nb + 2, SW_BLOCK, SW_KV_HEADS, HEAD_DIM)
        return jnp.concatenate([tp[:, :-2], tp[:, 1:-1], tp[:, 2:]], axis=2)

    kb, vb = band(k), band(v)
    q_pos = jnp.arange(nb)[:, None] * SW_BLOCK + jnp.arange(SW_BLOCK)[None, :]
    k_pos = jnp.arange(nb)[:, None] * SW_BLOCK - SW_BLOCK + jnp.arange(nk)[None, :]
    valid = ((jnp.abs(q_pos[:, :, None] - k_pos[:, None, :]) <= SW_WINDOW)
             & (k_pos >= 0)[:, None, :] & (k_pos < s)[:, None, :])
    s_loc = jnp.einsum('bnqhgd,bnkhd->bnhgqk', qb, kb).astype(jnp.float32) * scale
    s_loc = jnp.where(valid[None, :, None, None], s_loc, -jnp.inf)
    s_ctx = jnp.einsum('bnqhgd,bkhd->bnhgqk', qb, k_ctx).astype(jnp.float32) * scale
    s_sink = jnp.broadcast_to(sink.astype(jnp.float32).reshape(1, 1, SW_KV_HEADS, SW_GROUP, 1, 1),
                              s_loc.shape[:-1] + (1,))
    p = jax.nn.softmax(jnp.concatenate([s_loc, s_ctx, s_sink], axis=-1), axis=-1).astype(v.dtype)
    o = (jnp.einsum('bnhgqk,bnkhd->bnqhgd', p[..., :nk], vb)
         + jnp.einsum('bnhgqk,bkhd->bnqhgd', p[..., nk:nk + k_ctx.shape[1]], v_ctx))
    return o.reshape(b, s, SW_Q_DIM)


def short_gated_conv(p, conv_w):
    gate_b, gate_c, u = jnp.split(p, 3, axis=-1)
    z = gate_c * u
    n = z.shape[1]
    half = SC_WIDTH // 2
    zp = jnp.pad(z, ((0, 0), (half, half), (0, 0)))
    y = zp[:, 0:n] * conv_w[0]
    for j in range(1, SC_WIDTH):
        y = y + zp[:, j:j + n] * conv_w[j]
    return gate_b * y


def neighborhood_attention(q, k, v, k_ctx, v_ctx, rpb):
    b, s = q.shape[0], q.shape[1]
    rows = s // GRID_W
    win_r = min(NA_WIN_ROWS, rows)
    scale = HEAD_DIM ** -0.5
    grid = (b, rows, GRID_W, NA_HEADS, HEAD_DIM)
    qg, kg, vg = q.reshape(grid), k.reshape(grid), v.reshape(grid)
    r = jnp.arange(rows)
    r0 = jnp.clip(r - win_r // 2, 0, rows - win_r)
    row_idx = r0[:, None] + jnp.arange(win_r)[None, :]
    k_rows = kg[:, row_idx]
    v_rows = vg[:, row_idx]
    col = jnp.arange(GRID_W)
    c0 = jnp.clip(col - NA_WIN_COLS // 2, 0, GRID_W - NA_WIN_COLS)
    col_ok = (col[None, :] >= c0[:, None]) & (col[None, :] < c0[:, None] + NA_WIN_COLS)
    dr = row_idx - r[:, None] + NA_WIN_ROWS - 1
    dc = jnp.clip(col[None, :] - col[:, None] + NA_WIN_COLS - 1, 0, 2 * NA_WIN_COLS - 2)
    bias = rpb[:, dr[:, None, :, None], dc[None, :, None, :]]
    bias = jnp.where(col_ok[None, None, :, None, :], bias.astype(jnp.float32), -jnp.inf)
    s_loc = (jnp.einsum('brqhd,brwkhd->brhqwk', qg, k_rows).astype(jnp.float32) * scale
             + jnp.transpose(bias, (1, 0, 2, 3, 4))[None])
    n_loc = win_r * GRID_W
    s_loc = s_loc.reshape(b, rows, NA_HEADS, GRID_W, n_loc)
    s_ctx = jnp.einsum('brqhd,bkhd->brhqk', qg, k_ctx).astype(jnp.float32) * scale
    p = jax.nn.softmax(jnp.concatenate([s_loc, s_ctx], axis=-1), axis=-1).astype(v.dtype)
    p_loc = p[..., :n_loc].reshape(b, rows, NA_HEADS, GRID_W, win_r, GRID_W)
    o = (jnp.einsum('brhqwk,brwkhd->brqhd', p_loc, v_rows)
         + jnp.einsum('brhqk,bkhd->brqhd', p[..., n_loc:], v_ctx))
    return o.reshape(b, s, NA_DIM)


def fourier_mix(f):
    b, n, _ = f.shape
    fg = f.reshape(b, n, FOURIER_GROUPS, FOURIER_DIM // FOURIER_GROUPS).astype(jnp.float32)
    y = jnp.fft.fft2(fg, axes=(1, 3), norm='ortho').real
    return y.reshape(b, n, FOURIER_DIM).astype(f.dtype)


def even_mixer(h, h_ctx, w_in, w_out, conv_w, sink, cos, sin, need_ctx):
    b, s, _ = h.shape
    n_ctx = h_ctx.shape[1]
    cuts = [SW_Q_DIM, SW_Q_DIM + SW_KV_DIM, SW_Q_DIM + 2 * SW_KV_DIM]
    q, k, v, sc = jnp.split(h @ w_in, cuts, axis=-1)
    q = apply_rope(q.reshape(b, s, SW_KV_HEADS, SW_GROUP, HEAD_DIM), cos, sin)
    k = apply_rope(k.reshape(b, s, SW_KV_HEADS, HEAD_DIM), cos, sin)
    v = v.reshape(b, s, SW_KV_HEADS, HEAD_DIM)
    if need_ctx:
        q_c, k_c, v_c, sc_c = jnp.split(h_ctx @ w_in, cuts, axis=-1)
    else:
        k_c, v_c = jnp.split(h_ctx @ w_in[:, cuts[0]:cuts[2]], 2, axis=-1)
    k_c = k_c.reshape(b, n_ctx, SW_KV_HEADS, HEAD_DIM)
    v_c = v_c.reshape(b, n_ctx, SW_KV_HEADS, HEAD_DIM)
    attn = window_attention(q, k, v, k_c, v_c, sink)
    conv = short_gated_conv(sc, conv_w)
    y = jnp.concatenate([attn, conv], axis=-1) @ w_out
    y_ctx = None
    if need_ctx:
        q_c = q_c.reshape(b, n_ctx, SW_KV_HEADS, SW_GROUP, HEAD_DIM)
        attn_c = context_attention(q_c, k_c, v_c, sink)
        conv_c = short_gated_conv(sc_c, conv_w)
        y_ctx = jnp.concatenate([attn_c, conv_c], axis=-1) @ w_out
    return y, y_ctx


def odd_mixer(h, h_ctx, w_in, w_out, rpb, need_ctx):
    b, s, _ = h.shape
    n_ctx = h_ctx.shape[1]
    cuts = [NA_DIM, 2 * NA_DIM, 3 * NA_DIM]
    q, k, v, f = jnp.split(h @ w_in, cuts, axis=-1)
    heads = (b, s, NA_HEADS, HEAD_DIM)
    q, k, v = q.reshape(heads), k.reshape(heads), v.reshape(heads)
    if need_ctx:
        q_c, k_c, v_c, f_c = jnp.split(h_ctx @ w_in, cuts, axis=-1)
    else:
        k_c, v_c = jnp.split(h_ctx @ w_in[:, cuts[0]:cuts[2]], 2, axis=-1)
    k_c = k_c.reshape(b, n_ctx, NA_HEADS, HEAD_DIM)
    v_c = v_c.reshape(b, n_ctx, NA_HEADS, HEAD_DIM)
    attn = neighborhood_attention(q, k, v, k_c, v_c, rpb)
    four = fourier_mix(f)
    y = jnp.concatenate([attn, four], axis=-1) @ w_out
    y_ctx = None
    if need_ctx:
        q_c = q_c.reshape(b, n_ctx, NA_HEADS, 1, HEAD_DIM)
        attn_c = context_attention(q_c, k_c, v_c, None)
        y_ctx = jnp.concatenate([attn_c, fourier_mix(f_c)], axis=-1) @ w_out
    return y, y_ctx


def moe_ffn(h, router_w, router_b, w_gu, b_gu, w_dn, b_dn):
    n_tok = h.shape[0]
    logits = (h @ router_w + router_b).astype(jnp.float32)
    top_logit, top_e = lax.top_k(logits, TOP_K)
    top_w = jax.nn.softmax(top_logit, axis=-1)
    n_assign = n_tok * TOP_K
    flat_e = top_e.reshape(-1)
    flat_tok = jnp.repeat(jnp.arange(n_tok, dtype=jnp.int32), TOP_K)
    flat_w = top_w.reshape(-1)
    order = jnp.argsort(flat_e)
    sorted_e = flat_e[order]
    counts = jnp.bincount(flat_e, length=N_EXPERTS)
    padded = (counts + MOE_BLOCK - 1) // MOE_BLOCK * MOE_BLOCK
    pad_end = jnp.cumsum(padded)
    pad_start = pad_end - padded
    start = jnp.cumsum(counts) - counts
    dest = pad_start[sorted_e] + jnp.arange(n_assign, dtype=jnp.int32) - start[sorted_e]
    n_blocks = -(-n_assign // MOE_BLOCK) + N_EXPERTS
    cap = n_blocks * MOE_BLOCK
    tok_buf = jnp.zeros((cap,), jnp.int32).at[dest].set(flat_tok[order])
    w_buf = jnp.zeros((cap,), h.dtype).at[dest].set(flat_w[order].astype(h.dtype))
    block_e = jnp.minimum(
        jnp.searchsorted(pad_end, jnp.arange(n_blocks, dtype=jnp.int32) * MOE_BLOCK, side='right'),
        N_EXPERTS - 1)

    def run_block(args):
        tok, e, w = args
        xb = h[tok]
        gu = xb @ w_gu[e] + b_gu[e]
        g, u = jnp.split(gu, 2, axis=-1)
        g = jnp.minimum(g, SWIGLU_LIMIT)
        u = jnp.clip(u, -SWIGLU_LIMIT, SWIGLU_LIMIT)
        act = (u + 1) * (g * jax.nn.sigmoid(SWIGLU_ALPHA * g))
        return (act @ w_dn[e] + b_dn[e]) * w[:, None]

    ys = lax.map(run_block, (tok_buf.reshape(n_blocks, MOE_BLOCK), block_e,
                             w_buf.reshape(n_blocks, MOE_BLOCK)))
    return jnp.zeros_like(h).at[tok_buf].add(ys.reshape(cap, -1))


def setup_inputs(seed: int = 0) -> dict:
    key = jax.random.key(seed)
    ks = jax.random.split(key, 22)
    n_even = (DEPTH + 1) // 2
    n_odd = DEPTH // 2
    D = D_MODEL

    def nrm(k, shape, scale):
        return jax.random.normal(k, shape, jnp.float32) * scale

    return {
        'x': nrm(ks[0], (BATCH, SEQ, D), 1.0),
        'c': nrm(ks[1], (BATCH, D), 1.0),
        'ctx': nrm(ks[2], (BATCH, CTX_LEN, D), 1.0),
        'c_ctx': nrm(ks[3], (D,), 1.0),
        'ada_w': nrm(ks[4], (DEPTH, D, 6 * D), D ** -0.5),
        'ada_b': nrm(ks[5], (DEPTH, 6 * D), 0.02),
        'norm_mix': 1.0 + nrm(ks[6], (DEPTH, D), 0.02),
        'norm_ffn': 1.0 + nrm(ks[7], (DEPTH, D), 0.02),
        'even_w_in': nrm(ks[8], (n_even, D, EVEN_IN), D ** -0.5),
        'even_w_out': nrm(ks[9], (n_even, EVEN_OUT, D), EVEN_OUT ** -0.5),
        'even_conv_w': nrm(ks[10], (n_even, SC_WIDTH, SC_DIM), SC_WIDTH ** -0.5),
        'even_sink': nrm(ks[11], (n_even, SW_HEADS), 0.5),
        'odd_w_in': nrm(ks[12], (n_odd, D, ODD_IN), D ** -0.5),
        'odd_w_out': nrm(ks[13], (n_odd, ODD_OUT, D), ODD_OUT ** -0.5),
        'odd_rpb': nrm(ks[14], (n_odd, NA_HEADS, 2 * NA_WIN_ROWS - 1, 2 * NA_WIN_COLS - 1), 0.1),
        'router_w': nrm(ks[15], (DEPTH, D, N_EXPERTS), D ** -0.5),
        'router_b': nrm(ks[16], (DEPTH, N_EXPERTS), 0.01),
        'moe_w_gu': nrm(ks[17], (DEPTH, N_EXPERTS, D, 2 * D_FF), D ** -0.5),
        'moe_b_gu': nrm(ks[18], (DEPTH, N_EXPERTS, 2 * D_FF), 0.01),
        'moe_w_dn': nrm(ks[19], (DEPTH, N_EXPERTS, D_FF, D), D_FF ** -0.5),
        'moe_b_dn': nrm(ks[20], (DEPTH, N_EXPERTS, D), 0.01),
        'final_norm': 1.0 + nrm(ks[21], (D,), 0.02),
    }


def reference(x, c, ctx, c_ctx, ada_w, ada_b, norm_mix, norm_ffn, even_w_in, even_w_out,
              even_conv_w, even_sink, odd_w_in, odd_w_out, odd_rpb, router_w, router_b,
              moe_w_gu, moe_b_gu, moe_w_dn, moe_b_dn, final_norm):
    b, s, d = x.shape
    cos, sin = axial_rope(s)
    x_ctx = ctx
    for l in range(DEPTH):
        need_ctx = l < DEPTH - 1
        mod = jax.nn.silu(c) @ ada_w[l] + ada_b[l]
        mod_c = jax.nn.silu(c_ctx) @ ada_w[l] + ada_b[l]
        sh1, sc1, g1, sh2, sc2, g2 = jnp.split(mod[:, None, :], 6, axis=-1)
        sh1c, sc1c, g1c, sh2c, sc2c, g2c = jnp.split(mod_c, 6, axis=-1)
        h = rms_norm(x, norm_mix[l]) * (1 + sc1) + sh1
        h_c = rms_norm(x_ctx, norm_mix[l]) * (1 + sc1c) + sh1c
        if l % 2 == 0:
            i = l // 2
            y, y_c = even_mixer(h, h_c, even_w_in[i], even_w_out[i], even_conv_w[i], even_sink[i],
                                cos, sin, need_ctx)
        else:
            i = l // 2
            y, y_c = odd_mixer(h, h_c, odd_w_in[i], odd_w_out[i], odd_rpb[i], need_ctx)
        x = x + g1 * y
        h2 = (rms_norm(x, norm_ffn[l]) * (1 + sc2) + sh2).reshape(b * s, d)
        if need_ctx:
            x_ctx = x_ctx + g1c * y_c
            h2_c = (rms_norm(x_ctx, norm_ffn[l]) * (1 + sc2c) + sh2c).reshape(-1, d)
            out = moe_ffn(jnp.concatenate([h2, h2_c], axis=0), router_w[l], router_b[l],
                          moe_w_gu[l], moe_b_gu[l], moe_w_dn[l], moe_b_dn[l])
            x = x + g2 * out[:b * s].reshape(b, s, d)
            x_ctx = x_ctx + g2c * out[b * s:].reshape(x_ctx.shape)
        else:
            out = moe_ffn(h2, router_w[l], router_b[l], moe_w_gu[l], moe_b_gu[l],
                          moe_w_dn[l], moe_b_dn[l])
            x = x + g2 * out.reshape(b, s, d)
    return rms_norm(x, final_norm)
```

```cpp
#include <hip/hip_runtime.h>
#include <cstdio>
#include <cstdint>

#ifndef N_LAUNCH_MODE
#define N_LAUNCH_MODE 1
#endif

#ifndef PHASE_MASK
#define PHASE_MASK 0x1FFFF
#endif
#define PH_ON(ph) ((PHASE_MASK >> (ph)) & 1)
#define LAS __attribute__((address_space(3)))
#define GAS __attribute__((address_space(1)))
typedef unsigned short bf16_t;
typedef short bf16x8 __attribute__((ext_vector_type(8)));
typedef short s16x4 __attribute__((ext_vector_type(4)));
typedef float f32x4 __attribute__((ext_vector_type(4)));
typedef float f32x2 __attribute__((ext_vector_type(2)));
typedef int i32x4 __attribute__((ext_vector_type(4)));
typedef unsigned u32x2 __attribute__((ext_vector_type(2)));
typedef unsigned u32x4 __attribute__((ext_vector_type(4)));

constexpr int D = 1024, NB = 4, SEQ = 4096, CTXL = 256;
constexpr int NMAIN = NB * SEQ, NCTX = NB * CTXL, NTOK = NMAIN + NCTX;
constexpr int EVEN_IN = 2304, NEXP = 32, DFF = 1024;
constexpr int QKV_LD = 1536;
constexpr float NORM_EPS = 1e-6f;
constexpr float LOG2E = 1.4426950408889634f;

constexpr size_t MiB = 1ull << 20;
constexpr size_t WS_CTL = 0, CTL_BYTES = 1 * MiB;
constexpr size_t WS_MOD = 1 * MiB;
constexpr size_t WS_M1 = 2 * MiB;
constexpr size_t WS_M2 = WS_M1 + 65536;
constexpr size_t WS_ROPE = WS_M2 + 65536;
constexpr size_t WS_TW = WS_ROPE + 8192;
constexpr size_t WS_WF = 4 * MiB;
constexpr size_t WS_TOPW = 8 * MiB;
constexpr size_t WS_POS = 9 * MiB;
constexpr size_t WS_LIST = 12 * MiB;
constexpr size_t WS_H = 16 * MiB;
constexpr size_t WS_MIX = 52 * MiB;
constexpr size_t WS_XS = 88 * MiB;
constexpr size_t WS_PROJ = 160 * MiB;
constexpr size_t WS_Z = 240 * MiB;
constexpr size_t WS_A1 = 304 * MiB;
constexpr size_t WS_ACT = 368 * MiB;
constexpr size_t WS_Y = 512 * MiB;
constexpr size_t WS_END = 656 * MiB;
constexpr int CW_BAR = 4096;
constexpr int CW_CNT = 8192;

constexpr int LDS_BYTES = 147456;
constexpr int PARAM_OFF = LDS_BYTES - 512;
constexpr int MISC_OFF = LDS_BYTES - 256;
constexpr int A_TILE_B = 32768, B_ROWB = 544, B_TILE_B = 64 * B_ROWB, STAGE_B = A_TILE_B + B_TILE_B;
static_assert(2 * STAGE_B + 1024 <= PARAM_OFF, "LDS");

enum { PH_PREP = 0, PH_NORM1_0, PH_INPROJ_0, PH_ATTN_0, PH_OUTPROJ_0, PH_ROUTE_0, PH_MOE1_0, PH_MOE2_0, PH_COMB_0,
       PH_INPROJ_1, PH_ATTN_1, PH_FST2_1, PH_OUTPROJ_1, PH_ROUTE_1, PH_MOE1_1, PH_MOE2_1, PH_FINAL, NPHASE };

struct Params {
    const float *x, *c, *ctx, *c_ctx, *ada_w, *ada_b, *norm_mix, *norm_ffn, *even_w_in, *even_w_out, *even_conv_w, *even_sink,
                *odd_w_in, *odd_w_out, *odd_rpb, *router_w, *router_b, *moe_w_gu, *moe_b_gu, *moe_w_dn, *moe_b_dn, *final_norm;
    float* out; unsigned char* ws; int ph_lo, ph_hi;
};

__device__ __forceinline__ unsigned pk2(float lo, float hi) { unsigned r; asm("v_cvt_pk_bf16_f32 %0, %1, %2" : "=v"(r) : "v"(lo), "v"(hi)); return r; }
__device__ __forceinline__ float bflo(unsigned u) { return __builtin_bit_cast(float, u << 16); }
__device__ __forceinline__ float bfhi(unsigned u) { return __builtin_bit_cast(float, u & 0xffff0000u); }
__device__ __forceinline__ float wave_sum(float v) {
#pragma unroll
    for (int o = 1; o < 64; o <<= 1) v += __shfl_xor(v, o);
    return v;
}
__device__ __forceinline__ float fexp2(float x) { return __builtin_amdgcn_exp2f(x); }

#define XB_TMO      128
#define XB_XCNT(j)  (256  + 64 * (j))
#define XB_XSUB(j)  (1280 + 64 * (j))
#define XB_XGEN(j)  (2304 + 64 * (j))
#define XB_TOP      3328
#define XB_TOPGEN   3392
#define XB_SPIN_CAP (1u << 22)
__device__ __forceinline__ unsigned xb_ld(unsigned* p)              { return __hip_atomic_load(p, __ATOMIC_RELAXED, __HIP_MEMORY_SCOPE_AGENT); }
__device__ __forceinline__ unsigned xb_add(unsigned* p, unsigned v) { return __hip_atomic_fetch_add(p, v, __ATOMIC_RELAXED, __HIP_MEMORY_SCOPE_AGENT); }
__device__ __forceinline__ unsigned xb_xcc_id() { return (unsigned)__builtin_amdgcn_s_getreg((3 << 11) | 20) & 0xFu; }
#define XB_SPIN(cond, bar) do { unsigned _sp = 0; while (cond) { __builtin_amdgcn_s_sleep(1); \
    if ((++_sp & 255u) == 0u) { if (xb_ld(&(bar)[XB_TMO])) break; if (_sp > XB_SPIN_CAP) { atomicAdd(&(bar)[XB_TMO], 1u); break; } } } } while (0)
struct XcdBarrier { unsigned* bar; unsigned x; volatile LAS unsigned* st; };
__device__ __forceinline__ XcdBarrier xcd_barrier_post(unsigned* bar, volatile LAS unsigned* st) {
    XcdBarrier b; b.bar = bar; b.x = xb_xcc_id(); b.st = st;
    if (threadIdx.x == 0) (void)xb_add(&bar[XB_XCNT(b.x)], 1u);
    return b;
}
__device__ __forceinline__ void xcd_barrier_complete(unsigned* bar, unsigned x, unsigned& nloc, unsigned& nx) {
    const unsigned G = gridDim.x * gridDim.y * gridDim.z;
    unsigned sum, cnt, mine, sp = 0u;
    for (;;) {
        sum = 0u; cnt = 0u; mine = 0u;
#pragma unroll
        for (unsigned j = 0; j < 16; ++j) { const unsigned c = xb_ld(&bar[XB_XCNT(j)]); sum += c; cnt += (c > 0u) ? 1u : 0u; mine = (j == x) ? c : mine; }
        if (sum == G) break;
        __builtin_amdgcn_s_sleep(1);
        if ((++sp & 255u) == 0u) { if (xb_ld(&bar[XB_TMO])) break; if (sp > XB_SPIN_CAP) { atomicAdd(&bar[XB_TMO], 1u); break; } }
    }
    nloc = mine > 0u ? mine : 1u; nx = cnt > 0u ? cnt : 1u;
}
__device__ __forceinline__ void xcd_barrier(const XcdBarrier& b) {
    asm volatile("s_waitcnt vmcnt(0)" ::: "memory");
    __syncthreads();
    if (threadIdx.x == 0) {
        unsigned* bar = b.bar;
        __builtin_amdgcn_s_waitcnt(0);
        unsigned nloc = b.st[0], nx = b.st[1];
        if (nloc == 0u) { xcd_barrier_complete(bar, b.x, nloc, nx); b.st[0] = nloc; b.st[1] = nx; }
        const unsigned old = xb_add(&bar[XB_XSUB(b.x)], 1u);
        const unsigned gen = old / nloc;
        if (old + 1u == (gen + 1u) * nloc) {
            __builtin_amdgcn_fence(__ATOMIC_RELEASE, "agent");
            asm volatile("s_waitcnt vmcnt(0)" ::: "memory");
            const unsigned og = xb_add(&bar[XB_TOP], 1u);
            const unsigned tg = og / nx;
            if (og + 1u == (tg + 1u) * nx) xb_add(&bar[XB_TOPGEN], 1u);
            else XB_SPIN(xb_ld(&bar[XB_TOPGEN]) == tg, bar);
            __builtin_amdgcn_fence(__ATOMIC_ACQUIRE, "agent");
            xb_add(&bar[XB_XGEN(b.x)], 1u);
            asm volatile("s_waitcnt vmcnt(0)" ::: "memory");
        } else {
            XB_SPIN(xb_ld(&bar[XB_XGEN(b.x)]) == gen, bar);
            __builtin_amdgcn_fence(__ATOMIC_ACQUIRE, "agent");
            asm volatile("s_waitcnt vmcnt(0)" ::: "memory");
        }
    }
    __syncthreads();
}

struct GA { const bf16_t* base; unsigned off[4]; };
struct GB { const float* ptr; unsigned ldb; unsigned lcol; unsigned woff; };
__device__ __forceinline__ int a_piece_row(int wid, int lane, int i) { const int sb = lane * 16, swz = sb ^ (((sb >> 9) & 1) << 5); return ((wid >> 1) + 4 * i) * 16 + (swz >> 6); }
__device__ __forceinline__ int a_piece_col(int wid, int lane) { const int sb = lane * 16, swz = sb ^ (((sb >> 9) & 1) << 5); return (wid & 1) * 32 + ((swz & 63) >> 1); }

__device__ __forceinline__ void gemm_tile(LAS unsigned char* lds, const GA& ga, const GB& gb, const int nt_, f32x4 (&acc)[8][4], const int wid, const int lane) {
    int nt = nt_; asm volatile("" : "+s"(nt));
    const int wr = wid >> 2, wc = wid & 3, fr = lane & 15, fq = lane >> 4;
    const unsigned a_w = (unsigned)(wid * 1024 + lane * 16);
    const unsigned b_w = (unsigned)(A_TILE_B + ((wid >> 2) * 32 + 4 * (wid & 3)) * B_ROWB) + gb.woff;
    const unsigned a_r = (unsigned)(wr * 16384 + ((fr * 64 + fq * 16) ^ ((fr >> 3) << 5)));
    const unsigned b_r = (unsigned)(A_TILE_B + (4 * fq + (fr >> 2)) * B_ROWB + (wc * 64 + (fr & 3) * 4) * 2);
    f32x4 sb[8];
    const unsigned ldb4 = gb.ldb * 4u; const unsigned lcolb = gb.lcol * 4u; unsigned aoff[4];
    const __amdgpu_buffer_rsrc_t ra = __builtin_amdgcn_make_buffer_rsrc((void*)ga.base, 0, 0x7fffffff, 0x00020000);
    const __amdgpu_buffer_rsrc_t rb = __builtin_amdgcn_make_buffer_rsrc((void*)gb.ptr, 0, 0x7fffffff, 0x00020000);
#pragma unroll
    for (int i = 0; i < 4; ++i) aoff[i] = ga.off[i] * 2u;
#pragma unroll
    for (int m = 0; m < 8; ++m)
#pragma unroll
        for (int n = 0; n < 4; ++n) acc[m][n] = (f32x4){0.f, 0.f, 0.f, 0.f};
#define G_GLDS_A(buf, kt) do { _Pragma("unroll") for (int i = 0; i < 4; ++i) \
        __builtin_amdgcn_raw_ptr_buffer_load_lds(ra, (LAS void*)(lds + (buf) + wid * 1024 + i * 8192), 16, (int)aoff[i], (kt) * 128, 0, 0); } while (0)
#define G_ISSUE_B(kt) do { \
        _Pragma("unroll") for (int i = 0; i < 8; ++i) sb[i] = __builtin_bit_cast(f32x4, __builtin_amdgcn_raw_buffer_load_b128(rb, (int)lcolb, (int)(((unsigned)(kt) * 64u + i) * ldb4), 0)); \
        __builtin_amdgcn_sched_barrier(0); } while (0)
#define G_WRITE_B(buf) do { \
        _Pragma("unroll") for (int i = 0; i < 8; ++i) { u32x2 w; w.x = pk2(sb[i][0], sb[i][1]); w.y = pk2(sb[i][2], sb[i][3]); \
            *(LAS u32x2*)(lds + (buf) + b_w + (16 * (i >> 2) + (i & 3)) * B_ROWB) = w; } __builtin_amdgcn_sched_barrier(0); } while (0)
#define G_KSTEP(buf, ks) do { bf16x8 Bf[4]; \
        _Pragma("unroll") for (int n = 0; n < 4; ++n) { \
            const s16x4 lo = __builtin_amdgcn_ds_read_tr16_b64_v4i16((LAS s16x4*)(lds + (buf) + b_r + (ks) * 32 * B_ROWB + n * 32)); \
            const s16x4 hi = __builtin_amdgcn_ds_read_tr16_b64_v4i16((LAS s16x4*)(lds + (buf) + b_r + (ks) * 32 * B_ROWB + 16 * B_ROWB + n * 32)); \
            Bf[n] = (bf16x8){lo[0], lo[1], lo[2], lo[3], hi[0], hi[1], hi[2], hi[3]}; } \
        _Pragma("unroll") for (int mh = 0; mh < 2; ++mh) { bf16x8 At[4]; \
            _Pragma("unroll") for (int m = 0; m < 4; ++m) At[m] = *(const LAS bf16x8*)(lds + (buf) + a_r + (mh * 4 + m) * 2048 + (ks) * 1024); \
            _Pragma("unroll") for (int m = 0; m < 4; ++m) _Pragma("unroll") for (int n = 0; n < 4; ++n) \
                acc[mh * 4 + m][n] = __builtin_amdgcn_mfma_f32_16x16x32_bf16(Bf[n], At[m], acc[mh * 4 + m][n], 0, 0, 0); } \
        __builtin_amdgcn_sched_barrier(0); } while (0)
    { unsigned b0 = 0; asm volatile("" : "+s"(b0));
      G_GLDS_A(b0, 0); G_ISSUE_B(0); G_WRITE_B(b0); if (nt > 1) G_ISSUE_B(1); }
    asm volatile("s_waitcnt vmcnt(8)" ::: "memory");
    __syncthreads();
    for (int t = 0; t < nt; ++t) {
        unsigned bc = (unsigned)(t & 1) * STAGE_B, bn = (unsigned)((t & 1) ^ 1) * STAGE_B; asm volatile("" : "+s"(bc), "+s"(bn));
        if (t + 1 < nt) { G_WRITE_B(bn); G_GLDS_A(bn, t + 1); }
        if (t + 2 < nt) G_ISSUE_B(t + 2);
        G_KSTEP(bc, 0); G_KSTEP(bc, 1);
        asm volatile("s_waitcnt vmcnt(0)" ::: "memory");
        __syncthreads();
    }
#undef G_GLDS_A
#undef G_ISSUE_B
#undef G_WRITE_B
#undef G_KSTEP
}

struct Frame { LAS unsigned char* lds; int tid, lane, wid, bid, G; unsigned char* ws; };
__device__ __forceinline__ const void* ldp(const Frame& F, int off) {
    const u32x2 v = *(const volatile LAS u32x2*)(F.lds + PARAM_OFF + off);
    const unsigned lo = __builtin_amdgcn_readfirstlane(v.x), hi = __builtin_amdgcn_readfirstlane(v.y);
    return (const void*)(((unsigned long long)hi << 32) | lo);
}
#define PP(f) ((const float*)ldp(F, (int)__builtin_offsetof(Params, f)))
#define F_mod ((float*)(F.ws + WS_MOD))
#define F_M1 ((bf16_t*)(F.ws + WS_M1))
#define F_M2 ((bf16_t*)(F.ws + WS_M2))
#define F_ROPE ((f32x2*)(F.ws + WS_ROPE))
#define F_TW ((f32x2*)(F.ws + WS_TW))
#define F_WF ((float*)(F.ws + WS_WF))
#define F_TOPW ((float*)(F.ws + WS_TOPW))
#define F_POS ((int*)(F.ws + WS_POS))
#define F_LIST ((int*)(F.ws + WS_LIST))
#define F_H ((bf16_t*)(F.ws + WS_H))
#define F_MIX ((bf16_t*)(F.ws + WS_MIX))
#define F_XS ((float*)(F.ws + WS_XS))
#define F_PROJ ((bf16_t*)(F.ws + WS_PROJ))
#define F_Z ((float*)(F.ws + WS_Z))
#define F_A1 ((float*)(F.ws + WS_A1))
#define F_ACT ((bf16_t*)(F.ws + WS_ACT))
#define F_Y ((bf16_t*)(F.ws + WS_Y))
#define F_cnt ((unsigned*)(F.ws + WS_CTL) + CW_CNT)

__device__ __forceinline__ const float* modp(const Frame& F, int l, int r, int which) { return F_mod + ((size_t)(l * 5 + r)) * 6144 + which * 1024; }
__device__ __forceinline__ int mod_row(int row) { return row < NMAIN ? (row >> 12) : 4; }

__device__ __forceinline__ float row_rstd(const f32x4 (&v)[4]) {
    float s = 0.f;
#pragma unroll
    for (int j = 0; j < 4; ++j) s += (v[j][0] * v[j][0] + v[j][1] * v[j][1]) + (v[j][2] * v[j][2] + v[j][3] * v[j][3]);
    return __builtin_amdgcn_rsqf(wave_sum(s) * (1.f / D) + NORM_EPS);
}
__device__ __forceinline__ void norm_mod_store(const f32x4 (&v)[4], float rstd, const float* gam, const float* sc, const float* sh, bf16_t* dst, int lane, f32x4 (*keep)[4] = nullptr) {
#pragma unroll
    for (int j = 0; j < 4; ++j) {
        const int c = 4 * lane + 256 * j;
        const f32x4 g = *(const f32x4*)(gam + c), s1 = *(const f32x4*)(sc + c), s0 = *(const f32x4*)(sh + c);
        f32x4 h;
#pragma unroll
        for (int i = 0; i < 4; ++i) h[i] = v[j][i] * rstd * g[i] * (1.f + s1[i]) + s0[i];
        u32x2 w; w.x = pk2(h[0], h[1]); w.y = pk2(h[2], h[3]);
        *(u32x2*)(dst + c) = w;
        if (keep) (*keep)[j] = h;
    }
}

__device__ __forceinline__ void phase_prep(Frame& F) {
    LAS float* sil = (LAS float*)F.lds;
    LAS float* red = (LAS float*)(F.lds + 20480);
    LAS float* ct = (LAS float*)(F.lds + 32768);
    for (int idx = F.tid; idx < 5120; idx += 512) { const int r = idx >> 10, k = idx & 1023; const float v = r < 4 ? PP(c)[r * 1024 + k] : PP(c_ctx)[k]; sil[idx] = v / (1.f + __expf(-v)); }
    if (F.tid < 128) ct[F.tid] = cospif((float)F.tid / 64.f);
    __syncthreads();
    constexpr int N_ADA = 192, N_CONST = 8, N_FOLD = 256;
    for (int it = F.bid; it < N_ADA + N_CONST + N_FOLD; it += F.G) {
        if (it < N_ADA) {
            const int l = it / 96, j0 = (it % 96) * 64, col = j0 + F.lane;
            const float* w = PP(ada_w) + ((size_t)l * 1024 + F.wid * 128) * 6144 + col;
            float a[5] = {0.f, 0.f, 0.f, 0.f, 0.f};
#pragma unroll 8
            for (int k = 0; k < 128; ++k) { const float wv = w[(size_t)k * 6144];
#pragma unroll
                for (int r = 0; r < 5; ++r) a[r] += sil[r * 1024 + F.wid * 128 + k] * wv; }
#pragma unroll
            for (int r = 0; r < 5; ++r) red[(F.wid * 5 + r) * 64 + F.lane] = a[r];
            __syncthreads();
            if (F.tid < 320) { const int r = F.tid >> 6, ln = F.tid & 63; float s = 0.f;
#pragma unroll
                for (int w8 = 0; w8 < 8; ++w8) s += red[(w8 * 5 + r) * 64 + ln];
                F_mod[(size_t)(l * 5 + r) * 6144 + j0 + ln] = s + PP(ada_b)[l * 6144 + j0 + ln]; }
            __syncthreads();
        } else if (it < N_ADA + N_CONST) {
            const int gt = (it - N_ADA) * 512 + F.tid;
            for (int e = gt; e < 32768; e += 4096) {
                const int row = e >> 7, kk = e & 127;
                float v1 = 0.f, v2 = 0.f;
                if (row < 128) { const int ro = row >> 6, k1 = row & 63, n1 = kk >> 1, ri = kk & 1; const float ph = (float)((n1 * k1) & 63) / 32.f; const float cs = cospif(ph), sn = sinpif(ph);
                    v1 = (ro == ri) ? cs : (ro == 0 ? sn : -sn); }
                if (row < 64) { const int ro = kk >> 6, n2 = kk & 63; const float ph = (float)((row * n2) & 63) / 32.f; v2 = ro == 0 ? cospif(ph) : sinpif(ph); }
                F_M1[e] = (bf16_t)(pk2(v1, 0.f) & 0xffffu); F_M2[e] = (bf16_t)(pk2(v2, 0.f) & 0xffffu);
            }
            if (gt < 1024) { const int pos = gt >> 4, f = gt & 15; const double ang = (double)pos * pow(10000.0, -(double)f / 16.0); F_ROPE[gt] = (f32x2){(float)cos(ang), (float)sin(ang)}; }
            { const float ph = (float)gt / 2048.f; F_TW[gt] = (f32x2){cospif(ph), sinpif(ph)}; }
        } else {
            const int fi = it - N_ADA - N_CONST, rc = fi >> 2, g = fi & 3, half = F.tid >> 8, j = F.tid & 255, jj = j & 127;
            for (int i2 = 0; i2 < 8; ++i2) {
                const int row = rc * 16 + i2 * 2 + half;
                const float* wr_ = PP(odd_w_in) + (size_t)row * 2048 + 1536 + g * 128;
                float s = 0.f;
                if (j < 128) { for (int cc = 0; cc < 128; ++cc) s += wr_[cc] * ct[(cc * jj) & 127]; }
                else { for (int cc = 0; cc < 128; ++cc) s -= wr_[cc] * ct[((cc * jj) - 32) & 127]; }
                F_WF[(size_t)row * 1024 + g * 256 + j] = s;
            }
        }
    }
}

__device__ __forceinline__ void phase_norm1_l0(Frame& F) {
    const int gw = F.bid * 8 + F.wid, NGW = F.G * 8;
    for (int row = gw; row < NTOK; row += NGW) {
        const float* src = row < NMAIN ? PP(x) + (size_t)row * D : PP(ctx) + (size_t)(row - NMAIN) * D;
        f32x4 v[4];
#pragma unroll
        for (int j = 0; j < 4; ++j) v[j] = *(const f32x4*)(src + 4 * F.lane + 256 * j);
        const float rstd = row_rstd(v); const int r = mod_row(row);
        norm_mod_store(v, rstd, PP(norm_mix), modp(F, 0, r, 1), modp(F, 0, r, 0), F_H + (size_t)row * D, F.lane);
    }
}

#define EPI_ROW(pm, m) ((pm) * 256 + wr * 128 + (m) * 16 + fr)
__device__ __forceinline__ void phase_inproj_l0(Frame& F) {
    const int wid = F.wid, lane = F.lane, wr = wid >> 2, wc = wid & 3, fr = lane & 15, fq = lane >> 4;
    constexpr int nM = NTOK / 256, nN = EVEN_IN / 256;
    f32x4 acc[8][4];
    for (int t = F.bid; t < nM * nN; t += F.G) {
        const int pm = t / nN, pn = t % nN;
        GA ga; ga.base = F_H; { const int C = a_piece_col(wid, lane);
#pragma unroll
            for (int i = 0; i < 4; ++i) ga.off[i] = (unsigned)((pm * 256 + a_piece_row(wid, lane, i)) * D + C); }
        GB gb; gb.ptr = PP(even_w_in) + (size_t)(wid * 8) * EVEN_IN + pn * 256; gb.lcol = 4 * lane; gb.ldb = EVEN_IN; gb.woff = 8 * lane;
        gemm_tile(F.lds, ga, gb, D / 64, acc, wid, lane);
        const int colb = pn * 256 + wc * 64;
        const bool rope = (colb < 640) && (pm < NMAIN / 256);
#pragma unroll
        for (int m = 0; m < 8; ++m) {
            const int row = EPI_ROW(pm, m);
            if (rope) {
                const int tt = row & (SEQ - 1), gr = tt >> 6, gc = tt & 63;
#pragma unroll
                for (int n = 0; n < 2; ++n) {
                    const int pos = n == 0 ? gr : gc;
#pragma unroll
                    for (int j = 0; j < 4; ++j) { const f32x2 cs = F_ROPE[pos * 16 + 4 * fq + j]; const float x1 = acc[m][n][j], x2 = acc[m][n + 2][j];
                        acc[m][n][j] = x1 * cs.x - x2 * cs.y; acc[m][n + 2][j] = x2 * cs.x + x1 * cs.y; }
                }
            }
#pragma unroll
            for (int n = 0; n < 4; ++n) { u32x2 w; w.x = pk2(acc[m][n][0], acc[m][n][1]); w.y = pk2(acc[m][n][2], acc[m][n][3]);
                *(u32x2*)(F_PROJ + (size_t)row * EVEN_IN + colb + n * 16 + 4 * fq) = w; }
        }
    }
}

__device__ __forceinline__ void phase_outproj(Frame& F, const int layer) {
    const int wid = F.wid, lane = F.lane, wr = wid >> 2, wc = wid & 3, fr = lane & 15, fq = lane >> 4;
    const int nM = (layer == 0 ? NTOK : NMAIN) / 256, nN = 4;
    const float* W = layer == 0 ? PP(even_w_out) : PP(odd_w_out);
    f32x4 acc[8][4];
    for (int t = F.bid; t < nM * nN; t += F.G) {
        const int pm = t / nN, pn = t % nN;
        GA ga; ga.base = F_MIX; { const int C = a_piece_col(wid, lane);
#pragma unroll
            for (int i = 0; i < 4; ++i) ga.off[i] = (unsigned)((pm * 256 + a_piece_row(wid, lane, i)) * D + C); }
        GB gb; gb.ptr = W + (size_t)(wid * 8) * D + pn * 256; gb.lcol = 4 * lane; gb.ldb = D; gb.woff = 8 * lane;
        gemm_tile(F.lds, ga, gb, D / 64, acc, wid, lane);
        const int colb = pn * 256 + wc * 64;
#pragma unroll
        for (int m = 0; m < 8; ++m) {
            const int row = EPI_ROW(pm, m); const int r = mod_row(row);
            const float* xin = layer == 0 ? (row < NMAIN ? PP(x) + (size_t)row * D : PP(ctx) + (size_t)(row - NMAIN) * D) : F_XS + (size_t)row * D;
            const float* g1 = modp(F, layer, r, 2);
#pragma unroll
            for (int n = 0; n < 4; ++n) { const int c = colb + n * 16 + 4 * fq; const f32x4 xv = *(const f32x4*)(xin + c), gv = *(const f32x4*)(g1 + c);
                f32x4 o;
#pragma unroll
                for (int j = 0; j < 4; ++j) o[j] = xv[j] + gv[j] * acc[m][n][j];
                *(f32x4*)(F_XS + (size_t)row * D + c) = o; }
        }
    }
}

constexpr int QT = 2;
struct AttnSt { f32x4 o[4][QT]; float m[QT], l[QT]; };
#define V_ROWB 160
__device__ __forceinline__ void v_stage(LAS unsigned char* vl, const bf16_t* vsrc, int ld, int lane) {
    i32x4 t[4];
#pragma unroll
    for (int i = 0; i < 4; ++i) t[i] = *(const i32x4*)(vsrc + (size_t)((lane >> 3) + 8 * i) * ld + (lane & 7) * 8);
#pragma unroll
    for (int i = 0; i < 4; ++i) *(LAS i32x4*)(vl + ((lane >> 3) + 8 * i) * V_ROWB + (lane & 7) * 16) = t[i];
}
#define ATTN_STEP(ksrc, kld, vsrc, vld, SCALE, BIAS) do { \
    bf16x8 kf[2][2]; \
    _Pragma("unroll") for (int kt = 0; kt < 2; ++kt) _Pragma("unroll") for (int ks = 0; ks < 2; ++ks) \
        kf[kt][ks] = *(const bf16x8*)((ksrc) + (size_t)(kt * 16 + fr) * (kld) + ks * 32 + 8 * fq); \
    v_stage(vl, (vsrc), (vld), lane); \
    bf16x8 vf[4]; \
    _Pragma("unroll") for (int dt = 0; dt < 4; ++dt) { \
        const s16x4 lo = __builtin_amdgcn_ds_read_tr16_b64_v4i16((LAS s16x4*)(vl + (4 * fq + (fr >> 2)) * V_ROWB + (dt * 16 + (fr & 3) * 4) * 2)); \
        const s16x4 hi = __builtin_amdgcn_ds_read_tr16_b64_v4i16((LAS s16x4*)(vl + (16 + 4 * fq + (fr >> 2)) * V_ROWB + (dt * 16 + (fr & 3) * 4) * 2)); \
        vf[dt] = (bf16x8){lo[0], lo[1], lo[2], lo[3], hi[0], hi[1], hi[2], hi[3]}; } \
    _Pragma("unroll") for (int qt = 0; qt < QT; ++qt) { \
        f32x4 s[2]; \
        _Pragma("unroll") for (int kt = 0; kt < 2; ++kt) { s[kt] = (f32x4){0.f, 0.f, 0.f, 0.f}; \
            _Pragma("unroll") for (int ks = 0; ks < 2; ++ks) s[kt] = __builtin_amdgcn_mfma_f32_16x16x32_bf16(kf[kt][ks], qf[qt][ks], s[kt], 0, 0, 0); } \
        float mx = -INFINITY; \
        _Pragma("unroll") for (int kt = 0; kt < 2; ++kt) _Pragma("unroll") for (int j = 0; j < 4; ++j) { const float tv = s[kt][j] * (SCALE) + BIAS(qt, kt, j); s[kt][j] = tv; mx = fmaxf(mx, tv); } \
        mx = fmaxf(mx, __shfl_xor(mx, 16)); mx = fmaxf(mx, __shfl_xor(mx, 32)); \
        const float mn = fmaxf(st.m[qt], mx), al = fexp2(st.m[qt] - mn); st.m[qt] = mn; \
        float ps = 0.f; \
        _Pragma("unroll") for (int kt = 0; kt < 2; ++kt) _Pragma("unroll") for (int j = 0; j < 4; ++j) { const float pv = fexp2(s[kt][j] - mn); s[kt][j] = pv; ps += pv; } \
        st.l[qt] = st.l[qt] * al + ps; \
        const unsigned w0 = pk2(s[0][0], s[0][1]), w1 = pk2(s[0][2], s[0][3]), w2 = pk2(s[1][0], s[1][1]), w3 = pk2(s[1][2], s[1][3]); \
        const bf16x8 pf = __builtin_bit_cast(bf16x8, ((u32x4){w0, w1, w2, w3})); \
        _Pragma("unroll") for (int dt = 0; dt < 4; ++dt) st.o[dt][qt] = __builtin_amdgcn_mfma_f32_16x16x32_bf16(vf[dt], pf, st.o[dt][qt] * al, 0, 0, 0); } \
    } while (0)

__device__ __forceinline__ void attn_store(AttnSt& st, bf16_t* dst  , int dld, int fr, int fq) {
#pragma unroll
    for (int qt = 0; qt < QT; ++qt) {
        float l = st.l[qt]; l += __shfl_xor(l, 16); l += __shfl_xor(l, 32);
        const float inv = 1.f / l;
#pragma unroll
        for (int dt = 0; dt < 4; ++dt) { const f32x4 o = st.o[dt][qt] * inv; u32x2 w; w.x = pk2(o[0], o[1]); w.y = pk2(o[2], o[3]);
            *(u32x2*)(dst + (size_t)(qt * 16 + fr) * dld + dt * 16 + 4 * fq) = w; }
    }
}

__device__ __forceinline__ void phase_attn_l0(Frame& F) {
    const int wid = F.wid, lane = F.lane, fr = lane & 15, fq = lane >> 4;
    LAS unsigned char* vl = F.lds + wid * 8192;
    constexpr int N_WIN = 256, N_CTXA = 16, N_CONV = NTOK / 64;
    const float SC = 0.125f * LOG2E;
    for (int it = F.bid; it < N_WIN + N_CTXA + N_CONV; it += F.G) {
        if (it < N_WIN + N_CTXA) {
            const bool isctx = it >= N_WIN;
            int b, kvh, qb;
            if (!isctx) { b = it >> 6; kvh = (it >> 5) & 1; qb = it & 31; } else { const int c = it - N_WIN; b = c >> 2; kvh = (c >> 1) & 1; qb = c & 1; }
            const int g = wid >> 1, h = kvh * 4 + g;
            for (int qh = 0; qh < 4 / QT; ++qh) {
            const int qq0 = (wid & 1) * 64 + qh * (16 * QT);
            const int qrow0 = (isctx ? NMAIN + b * CTXL : b * SEQ) + qb * 128 + qq0;
            bf16x8 qf[QT][2];
#pragma unroll
            for (int qt = 0; qt < QT; ++qt)
#pragma unroll
                for (int ks = 0; ks < 2; ++ks) qf[qt][ks] = *(const bf16x8*)(F_PROJ + (size_t)(qrow0 + qt * 16 + fr) * EVEN_IN + h * 64 + ks * 32 + 8 * fq);
            AttnSt st;
            const float sink = PP(even_sink)[h] * LOG2E;
#pragma unroll
            for (int qt = 0; qt < QT; ++qt) { st.m[qt] = sink; st.l[qt] = (fq == 0) ? 1.f : 0.f;
#pragma unroll
                for (int dt = 0; dt < 4; ++dt) st.o[dt][qt] = (f32x4){0.f, 0.f, 0.f, 0.f}; }
            const int kcol = 512 + kvh * 64, vcol = 640 + kvh * 64;
            for (int ch = isctx ? 3 : 0; ch < 5; ++ch) {
                int krow0;
                if (ch < 3) { const int kb = qb - 1 + ch; if (kb < 0 || kb >= SEQ / 128) continue; krow0 = b * SEQ + kb * 128; } else krow0 = NMAIN + b * CTXL + (ch - 3) * 128;
                for (int s32 = 0; s32 < 4; ++s32) {
                    const bf16_t* kp = F_PROJ + (size_t)(krow0 + s32 * 32) * EVEN_IN + kcol;
                    const bf16_t* vp = F_PROJ + (size_t)(krow0 + s32 * 32) * EVEN_IN + vcol;
                    if (ch == 0) {
#define BIAS_PREV(qt, kt, j) ((s32 * 32 + kt * 16 + 4 * fq + j) >= (qq0 + qt * 16 + fr) ? 0.f : -INFINITY)
                        ATTN_STEP(kp, EVEN_IN, vp, EVEN_IN, SC, BIAS_PREV);
                    } else if (ch == 2) {
#define BIAS_NEXT(qt, kt, j) ((s32 * 32 + kt * 16 + 4 * fq + j) <= (qq0 + qt * 16 + fr) ? 0.f : -INFINITY)
                        ATTN_STEP(kp, EVEN_IN, vp, EVEN_IN, SC, BIAS_NEXT);
                    } else {
#define BIAS_NONE(qt, kt, j) 0.f
                        ATTN_STEP(kp, EVEN_IN, vp, EVEN_IN, SC, BIAS_NONE);
                    }
                }
            }
            attn_store(st, F_MIX + (size_t)qrow0 * D + h * 64, D, fr, fq);
            }
        } else {
            const int ci = it - N_WIN - N_CTXA, c4 = (F.tid & 127) * 4, r0 = ci * 64 + (F.tid >> 7) * 16;
            const f32x4 w0 = *(const f32x4*)(PP(even_conv_w) + c4), w1 = *(const f32x4*)(PP(even_conv_w) + 512 + c4), w2 = *(const f32x4*)(PP(even_conv_w) + 1024 + c4);
#define LOADZ(dst, row_) do { const u32x2 gc_ = *(const u32x2*)(F_PROJ + (size_t)(row_) * EVEN_IN + 1280 + c4), uu_ = *(const u32x2*)(F_PROJ + (size_t)(row_) * EVEN_IN + 1792 + c4); \
                dst = (f32x4){bflo(gc_.x) * bflo(uu_.x), bfhi(gc_.x) * bfhi(uu_.x), bflo(gc_.y) * bflo(uu_.y), bfhi(gc_.y) * bfhi(uu_.y)}; } while (0)
            const int seqmask = r0 < NMAIN ? (SEQ - 1) : (CTXL - 1);
            f32x4 zp = (f32x4){0.f, 0.f, 0.f, 0.f}, zc, zn;
            if ((r0 & seqmask) != 0) LOADZ(zp, r0 - 1);
            LOADZ(zc, r0);
            for (int i = 0; i < 16; ++i) {
                const int row = r0 + i;
                zn = (f32x4){0.f, 0.f, 0.f, 0.f}; if ((row & seqmask) != seqmask) LOADZ(zn, row + 1);
                const u32x2 gb = *(const u32x2*)(F_PROJ + (size_t)row * EVEN_IN + 768 + c4);
                const f32x4 y = zp * w0 + zc * w1 + zn * w2;
                u32x2 w; w.x = pk2(bflo(gb.x) * y[0], bfhi(gb.x) * y[1]); w.y = pk2(bflo(gb.y) * y[2], bfhi(gb.y) * y[3]);
                *(u32x2*)(F_MIX + (size_t)row * D + 512 + c4) = w;
                zp = zc; zc = zn;
            }
        }
    }
}

constexpr int RW_LD = 1028;
__device__ __forceinline__ void phase_route(Frame& F, const int layer) {
    const int nrows = layer == 0 ? NTOK : NMAIN;
    LAS float* rwT = (LAS float*)F.lds;
    LAS int* cntL = (LAS int*)(F.lds + 32 * RW_LD * 4);
    LAS int* baseL = cntL + 32;
    LAS int* selE = baseL + 32;
    LAS int* selR = selE + 288;
    const float* rw = PP(router_w) + (size_t)layer * D * NEXP;
    for (int idx = F.tid; idx < D * NEXP; idx += 512) rwT[(idx & 31) * RW_LD + (idx >> 5)] = rw[idx];
    if (F.tid < 32) cntL[F.tid] = 0;
    __syncthreads();
    const int lane = F.lane, gw = F.bid * 8 + F.wid, NGW = F.G * 8;
    const float* gam = PP(norm_ffn) + layer * D;
    int slot = F.wid;
    for (int row = gw; row < nrows; row += NGW, slot += 8) {
        f32x4 v[4], h[4];
#pragma unroll
        for (int j = 0; j < 4; ++j) v[j] = *(const f32x4*)(F_XS + (size_t)row * D + 4 * lane + 256 * j);
        const float rstd = row_rstd(v); const int r = mod_row(row);
        norm_mod_store(v, rstd, gam, modp(F, layer, r, 4), modp(F, layer, r, 3), F_H + (size_t)row * D, lane, &h);
        float pe[32];
#pragma unroll
        for (int e = 0; e < 32; ++e) { float s = 0.f;
#pragma unroll
            for (int j = 0; j < 4; ++j) { const f32x4 w = *(const LAS f32x4*)(rwT + e * RW_LD + 4 * lane + 256 * j); s += (h[j][0] * w[0] + h[j][1] * w[1]) + (h[j][2] * w[2] + h[j][3] * w[3]); }
            pe[e] = s; }
        float q16[16], q8[8], q4[4], q2[2], q1;
        { const bool hi = lane & 32;
#pragma unroll
          for (int i = 0; i < 16; ++i) { const float snd = hi ? pe[i] : pe[16 + i], mine = hi ? pe[16 + i] : pe[i]; q16[i] = mine + __shfl_xor(snd, 32); } }
        { const bool hi = lane & 16;
#pragma unroll
          for (int i = 0; i < 8; ++i) { const float snd = hi ? q16[i] : q16[8 + i], mine = hi ? q16[8 + i] : q16[i]; q8[i] = mine + __shfl_xor(snd, 16); } }
        { const bool hi = lane & 8;
#pragma unroll
          for (int i = 0; i < 4; ++i) { const float snd = hi ? q8[i] : q8[4 + i], mine = hi ? q8[4 + i] : q8[i]; q4[i] = mine + __shfl_xor(snd, 8); } }
        { const bool hi = lane & 4;
#pragma unroll
          for (int i = 0; i < 2; ++i) { const float snd = hi ? q4[i] : q4[2 + i], mine = hi ? q4[2 + i] : q4[i]; q2[i] = mine + __shfl_xor(snd, 4); } }
        { const bool hi = lane & 2; const float snd = hi ? q2[0] : q2[1], mine = hi ? q2[1] : q2[0]; q1 = mine + __shfl_xor(snd, 2); }
        q1 += __shfl_xor(q1, 1);
        const int myE = (lane >> 1) & 31;
        float val = q1 + PP(router_b)[layer * NEXP + myE];
        float tv[4]; int te[4];
#pragma unroll
        for (int k = 0; k < 4; ++k) {
            float bv = val; int be = myE;
#pragma unroll
            for (int o = 1; o < 64; o <<= 1) { const float ov = __shfl_xor(bv, o); const int oe = __shfl_xor(be, o); if (ov > bv || (ov == bv && oe < be)) { bv = ov; be = oe; } }
            tv[k] = bv; te[k] = be; if (myE == be) val = -INFINITY;
        }
        const float e1 = __expf(tv[1] - tv[0]), e2 = __expf(tv[2] - tv[0]), e3 = __expf(tv[3] - tv[0]), inv = 1.f / (1.f + e1 + e2 + e3);
        if (lane == 0) {
            *(f32x4*)(F_TOPW + (size_t)row * 4) = (f32x4){inv, e1 * inv, e2 * inv, e3 * inv};
#pragma unroll
            for (int k = 0; k < 4; ++k) { selE[slot * 4 + k] = te[k]; selR[slot * 4 + k] = atomicAdd((int*)(cntL + te[k]), 1); }
        }
    }
    __syncthreads();
    if (F.tid < 32) { const int c = cntL[F.tid]; baseL[F.tid] = c ? (int)atomicAdd(F_cnt + layer * 32 + F.tid, (unsigned)c) : 0; }
    __syncthreads();
    if (F.tid < 288) { const int s = F.tid >> 2, k = F.tid & 3; const int row = F.bid * 8 + (s & 7) + (s >> 3) * NGW;
        if (row < nrows) { const int e = selE[F.tid], pos = baseL[e] + selR[F.tid]; F_POS[(size_t)row * 4 + k] = e | (pos << 8); F_LIST[(size_t)e * NTOK + pos] = row; } }
    __syncthreads();
}

__device__ __forceinline__ void moe_prefix(Frame& F, const int layer, LAS int* mtp, LAS int* roff) {
    if (F.tid == 0) { int a = 0, b = 0; for (int e = 0; e < 32; ++e) { const int c = (int)__hip_atomic_load(F_cnt + layer * 32 + e, __ATOMIC_RELAXED, __HIP_MEMORY_SCOPE_AGENT); mtp[e] = a; roff[e] = b; a += (c + 255) >> 8; b += c; } mtp[32] = a; roff[32] = b; }
    __syncthreads();
}
__device__ __forceinline__ void phase_moe1(Frame& F, const int layer) {
    const int wid = F.wid, lane = F.lane, wr = wid >> 2, wc = wid & 3, fr = lane & 15, fq = lane >> 4;
    LAS int* mtp = (LAS int*)(F.lds + 2 * STAGE_B); LAS int* roff = mtp + 40;
    moe_prefix(F, layer, mtp, roff);
    const int RT = mtp[32];
    f32x4 acc[8][4];
    for (int id = F.bid; id < RT * 8; id += F.G) {
        const int ct = id & 7, rt = id >> 3;
        int e = 0; while (mtp[e + 1] <= rt) ++e;
        const int rbase = (rt - mtp[e]) * 256, cnt = roff[e + 1] - roff[e], ro = roff[e];
        const int* list = F_LIST + (size_t)e * NTOK;
        GA ga; ga.base = F_H; { const int C = a_piece_col(wid, lane);
#pragma unroll
            for (int i = 0; i < 4; ++i) { int rr = rbase + a_piece_row(wid, lane, i); rr = rr < cnt ? rr : cnt - 1; ga.off[i] = (unsigned)(list[rr] * D + C); } }
        const float* W = PP(moe_w_gu) + ((size_t)(layer * NEXP + e) * D) * (2 * DFF);
        const int l2 = lane & 31, gcol = (lane >> 5) * DFF + ct * 128 + 4 * l2, tcol = ((4 * l2) >> 5) * 64 + (lane >> 5) * 32 + ((4 * l2) & 31);
        GB gb; gb.ptr = W + (size_t)(wid * 8) * (2 * DFF); gb.lcol = gcol; gb.ldb = 2 * DFF; gb.woff = 2 * tcol;
        gemm_tile(F.lds, ga, gb, D / 64, acc, wid, lane);
        const float* bias = PP(moe_b_gu) + (size_t)(layer * NEXP + e) * (2 * DFF);
#pragma unroll
        for (int n = 0; n < 2; ++n) {
            const int gc = ct * 128 + wc * 32 + n * 16 + 4 * fq;
            const f32x4 bg = *(const f32x4*)(bias + gc), bu = *(const f32x4*)(bias + DFF + gc);
#pragma unroll
            for (int m = 0; m < 8; ++m) {
                const int r = rbase + wr * 128 + m * 16 + fr;
                float a[4];
#pragma unroll
                for (int j = 0; j < 4; ++j) { const float gg = fminf(acc[m][n][j] + bg[j], 7.f), uu = fminf(fmaxf(acc[m][n + 2][j] + bu[j], -7.f), 7.f);
                    a[j] = (uu + 1.f) * gg / (1.f + __expf(-1.702f * gg)); }
                if (r < cnt) { u32x2 w; w.x = pk2(a[0], a[1]); w.y = pk2(a[2], a[3]); *(u32x2*)(F_ACT + (size_t)(ro + r) * DFF + gc) = w; }
            }
        }
    }
}
__device__ __forceinline__ void phase_moe2(Frame& F, const int layer) {
    const int wid = F.wid, lane = F.lane, wr = wid >> 2, wc = wid & 3, fr = lane & 15, fq = lane >> 4;
    LAS int* mtp = (LAS int*)(F.lds + 2 * STAGE_B); LAS int* roff = mtp + 40;
    moe_prefix(F, layer, mtp, roff);
    const int RT = mtp[32];
    f32x4 acc[8][4];
    for (int id = F.bid; id < RT * 4; id += F.G) {
        const int ct = id & 3, rt = id >> 2;
        int e = 0; while (mtp[e + 1] <= rt) ++e;
        const int rbase = (rt - mtp[e]) * 256, cnt = roff[e + 1] - roff[e], ro = roff[e];
        GA ga; ga.base = F_ACT; { const int C = a_piece_col(wid, lane);
#pragma unroll
            for (int i = 0; i < 4; ++i) { int rr = rbase + a_piece_row(wid, lane, i); rr = rr < cnt ? rr : cnt - 1; ga.off[i] = (unsigned)((ro + rr) * DFF + C); } }
        const float* W = PP(moe_w_dn) + ((size_t)(layer * NEXP + e) * DFF) * D;
        GB gb; gb.ptr = W + (size_t)(wid * 8) * D + ct * 256; gb.lcol = 4 * lane; gb.ldb = D; gb.woff = 8 * lane;
        gemm_tile(F.lds, ga, gb, DFF / 64, acc, wid, lane);
        const float* bias = PP(moe_b_dn) + (size_t)(layer * NEXP + e) * D;
#pragma unroll
        for (int n = 0; n < 4; ++n) {
            const int c = ct * 256 + wc * 64 + n * 16 + 4 * fq;
            const f32x4 bv = *(const f32x4*)(bias + c);
#pragma unroll
            for (int m = 0; m < 8; ++m) {
                const int r = rbase + wr * 128 + m * 16 + fr;
                if (r < cnt) { u32x2 w; w.x = pk2(acc[m][n][0] + bv[0], acc[m][n][1] + bv[1]); w.y = pk2(acc[m][n][2] + bv[2], acc[m][n][3] + bv[3]); *(u32x2*)(F_Y + (size_t)(ro + r) * D + c) = w; }
            }
        }
    }
}

__device__ __forceinline__ void phase_combine(Frame& F, const int layer) {
    LAS int* mtp = (LAS int*)(F.lds + 2 * STAGE_B); LAS int* roff = mtp + 40;
    moe_prefix(F, layer, mtp, roff);
    const int nrows = layer == 0 ? NTOK : NMAIN, lane = F.lane;
    const int gw = F.bid * 8 + F.wid, NGW = F.G * 8;
    for (int row = gw; row < nrows; row += NGW) {
        const i32x4 ps = *(const i32x4*)(F_POS + (size_t)row * 4); const f32x4 tw = *(const f32x4*)(F_TOPW + (size_t)row * 4);
        const int r = mod_row(row); const float* g2 = modp(F, layer, r, 5);
        f32x4 v[4];
#pragma unroll
        for (int j = 0; j < 4; ++j) v[j] = (f32x4){0.f, 0.f, 0.f, 0.f};
#pragma unroll
        for (int k = 0; k < 4; ++k) { const int e = ps[k] & 255, pos = ps[k] >> 8; const bf16_t* y = F_Y + (size_t)(roff[e] + pos) * D; const float w = tw[k];
#pragma unroll
            for (int j = 0; j < 4; ++j) { const u32x2 u = *(const u32x2*)(y + 4 * lane + 256 * j); v[j][0] += w * bflo(u.x); v[j][1] += w * bfhi(u.x); v[j][2] += w * bflo(u.y); v[j][3] += w * bfhi(u.y); } }
#pragma unroll
        for (int j = 0; j < 4; ++j) { const int c = 4 * lane + 256 * j; const f32x4 xs = *(const f32x4*)(F_XS + (size_t)row * D + c), gv = *(const f32x4*)(g2 + c); v[j] = xs + gv * v[j]; }
        const float rstd = row_rstd(v);
        if (layer == 0) {
#pragma unroll
            for (int j = 0; j < 4; ++j) *(f32x4*)(F_XS + (size_t)row * D + 4 * lane + 256 * j) = v[j];
            norm_mod_store(v, rstd, PP(norm_mix) + D, modp(F, 1, r, 1), modp(F, 1, r, 0), F_H + (size_t)row * D, lane);
        } else {
#pragma unroll
            for (int j = 0; j < 4; ++j) { const int c = 4 * lane + 256 * j; const f32x4 g = *(const f32x4*)(PP(final_norm) + c); *(f32x4*)(((float*)ldp(F, (int)__builtin_offsetof(Params, out))) + (size_t)row * D + c) = v[j] * rstd * g; }
        }
    }
}

__device__ __forceinline__ void phase_inproj_l1(Frame& F) {
    const int wid = F.wid, lane = F.lane, wr = wid >> 2, wc = wid & 3, fr = lane & 15, fq = lane >> 4;
    constexpr int N_MAIN_T = (NMAIN / 256) * 10, N_CTX_T = (NCTX / 256) * 4;
    f32x4 acc[8][4];
    for (int t = F.bid; t < N_MAIN_T + N_CTX_T; t += F.G) {
        int pm, pn;
        if (t < N_MAIN_T) { pm = t / 10; pn = t % 10; } else { const int c = t - N_MAIN_T; pm = NMAIN / 256 + (c >> 2); pn = 2 + (c & 3); }
        GA ga; ga.base = F_H; { const int C = a_piece_col(wid, lane);
#pragma unroll
            for (int i = 0; i < 4; ++i) ga.off[i] = (unsigned)((pm * 256 + a_piece_row(wid, lane, i)) * D + C); }
        GB gb;
        if (pn < 6) { gb.ptr = PP(odd_w_in) + (size_t)(wid * 8) * 2048 + pn * 256; gb.ldb = 2048; }
        else { gb.ptr = F_WF + (size_t)(wid * 8) * 1024 + (pn - 6) * 256; gb.ldb = 1024; }
        gb.lcol = 4 * lane; gb.woff = 8 * lane;
        gemm_tile(F.lds, ga, gb, D / 64, acc, wid, lane);
        if (pn < 6) {
#pragma unroll
            for (int m = 0; m < 8; ++m) { const int row = EPI_ROW(pm, m);
#pragma unroll
                for (int n = 0; n < 4; ++n) { u32x2 w; w.x = pk2(acc[m][n][0], acc[m][n][1]); w.y = pk2(acc[m][n][2], acc[m][n][3]);
                    *(u32x2*)(F_PROJ + (size_t)row * QKV_LD + pn * 256 + wc * 64 + n * 16 + 4 * fq) = w; } }
        } else {
            const int g = pn - 6, ri = wc >> 1;
#pragma unroll
            for (int m = 0; m < 8; ++m) { const int row = EPI_ROW(pm, m), b = row >> 12, n1 = (row >> 6) & 63, n2 = row & 63;
                float* zb = F_Z + ((((size_t)(b * 64 + n1) * 2 + ri) * 64 + n2) * 512) + g * 128 + (wc & 1) * 64;
#pragma unroll
                for (int n = 0; n < 4; ++n) *(f32x4*)(zb + n * 16 + 4 * fq) = acc[m][n]; }
        }
    }
}

__device__ __forceinline__ void phase_attn_l1(Frame& F) {
    const int wid = F.wid, lane = F.lane, wr = wid >> 2, wc = wid & 3, fr = lane & 15, fq = lane >> 4;
    constexpr int N_NA = NB * 64, N_F1 = NB * 128;
    const float SC = 0.125f * LOG2E;
    f32x4 acc[8][4];
    for (int it = F.bid; it < N_NA + N_F1; it += F.G) {
        if (it < N_NA) {
            LAS unsigned char* vl = F.lds + wid * 8192;
            LAS float* rp = (LAS float*)(vl + 5120);
            const int b = it >> 6, r = it & 63, h = wid;
            for (int i = lane; i < 465; i += 64) rp[i] = PP(odd_rpb)[h * 465 + i] * LOG2E;
            for (int qh = 0; qh < 4 / QT; ++qh) {
            const int qc0 = qh * (16 * QT), qrow0 = b * SEQ + r * 64 + qc0;
            bf16x8 qf[QT][2];
#pragma unroll
            for (int qt = 0; qt < QT; ++qt)
#pragma unroll
                for (int ks = 0; ks < 2; ++ks) qf[qt][ks] = *(const bf16x8*)(F_PROJ + (size_t)(qrow0 + qt * 16 + fr) * QKV_LD + h * 64 + ks * 32 + 8 * fq);
            AttnSt st;
#pragma unroll
            for (int qt = 0; qt < QT; ++qt) { st.m[qt] = -1e30f; st.l[qt] = 0.f;
#pragma unroll
                for (int dt = 0; dt < 4; ++dt) st.o[dt][qt] = (f32x4){0.f, 0.f, 0.f, 0.f}; }
            const int r0 = min(max(r - 4, 0), 56);
            int c0q[QT];
#pragma unroll
            for (int qt = 0; qt < QT; ++qt) c0q[qt] = min(max(qc0 + qt * 16 + fr - 8, 0), 48);
            for (int s = 0; s < 16; ++s) {
                const int kr = r0 + (s >> 1), half = s & 1;
                const bf16_t* kp = F_PROJ + (size_t)(b * SEQ + kr * 64 + half * 32) * QKV_LD + 512 + h * 64;
                const bf16_t* vp = kp + 512;
                const LAS float* rpr = rp + (kr - r + 7) * 31 + 15;
#define BIAS_NA(qt, kt, j) ({ const int kc = half * 32 + kt * 16 + 4 * fq + j; const int dc = kc - (qc0 + qt * 16 + fr); (kc >= c0q[qt] && kc < c0q[qt] + 16) ? rpr[dc] : -INFINITY; })
                ATTN_STEP(kp, QKV_LD, vp, QKV_LD, SC, BIAS_NA);
            }
            for (int s = 0; s < 8; ++s) {
                const bf16_t* kp = F_PROJ + (size_t)(NMAIN + b * CTXL + s * 32) * QKV_LD + 512 + h * 64;
                const bf16_t* vp = kp + 512;
                ATTN_STEP(kp, QKV_LD, vp, QKV_LD, SC, BIAS_NONE);
            }
            attn_store(st, F_MIX + (size_t)qrow0 * D + h * 64, D, fr, fq);
            }
            __syncthreads();
        } else {
            const int fi = it - N_NA, b = fi >> 7, ct = fi & 127;
            GA ga; ga.base = F_M1; { const int C = a_piece_col(wid, lane);
#pragma unroll
                for (int i = 0; i < 4; ++i) ga.off[i] = (unsigned)(a_piece_row(wid, lane, i) * 128 + C); }
            GB gb; gb.ptr = F_Z + (size_t)b * 128 * 32768 + (size_t)(wid * 8) * 32768 + ct * 256; gb.lcol = 4 * lane; gb.ldb = 32768; gb.woff = 8 * lane;
            gemm_tile(F.lds, ga, gb, 2, acc, wid, lane);
            if (wr == 0) {
#pragma unroll
                for (int m = 0; m < 4; ++m) { const int k1 = m * 16 + fr;
#pragma unroll
                    for (int n = 0; n < 4; ++n) { const int col = ct * 256 + wc * 64 + n * 16 + 4 * fq, n2 = col >> 9, c = col & 511;
                        const f32x2 tw = F_TW[n2 * k1];
                        const f32x4 re = acc[m][n], im = acc[m + 4][n];
                        const f32x4 ore = re * tw.x + im * tw.y, oim = im * tw.x - re * tw.y;
                        *(f32x4*)(F_A1 + ((((size_t)(b * 2 + 0) * 64 + n2) * 64 + k1) * 512) + c) = ore;
                        *(f32x4*)(F_A1 + ((((size_t)(b * 2 + 1) * 64 + n2) * 64 + k1) * 512) + c) = oim; } }
            }
        }
    }
}

__device__ __forceinline__ void phase_fst2(Frame& F) {
    const int wid = F.wid, lane = F.lane, wr = wid >> 2, wc = wid & 3, fr = lane & 15, fq = lane >> 4;
    const float scl = 1.f / 724.0773439350247f;
    f32x4 acc[8][4];
    for (int it = F.bid; it < NB * 128; it += F.G) {
        const int b = it >> 7, ct = it & 127;
        GA ga; ga.base = F_M2; { const int C = a_piece_col(wid, lane);
#pragma unroll
            for (int i = 0; i < 4; ++i) ga.off[i] = (unsigned)(a_piece_row(wid, lane, i) * 128 + C); }
        GB gb; gb.ptr = F_A1 + (size_t)b * 128 * 32768 + (size_t)(wid * 8) * 32768 + ct * 256; gb.lcol = 4 * lane; gb.ldb = 32768; gb.woff = 8 * lane;
        gemm_tile(F.lds, ga, gb, 2, acc, wid, lane);
        if (wr == 0) {
#pragma unroll
            for (int m = 0; m < 4; ++m) { const int k2 = m * 16 + fr;
#pragma unroll
                for (int n = 0; n < 4; ++n) { const int col = ct * 256 + wc * 64 + n * 16 + 4 * fq, k1 = col >> 9, c = col & 511;
                    const f32x4 o = acc[m][n] * scl; u32x2 w; w.x = pk2(o[0], o[1]); w.y = pk2(o[2], o[3]);
                    *(u32x2*)(F_MIX + (size_t)(b * SEQ + k1 + 64 * k2) * D + 512 + c) = w; } }
        }
    }
}

__global__ void __launch_bounds__(512, 2) fwd_kernel(Params p) {
    extern __shared__ __attribute__((aligned(16))) unsigned char lds_raw[];
    Frame F;
    F.lds = (LAS unsigned char*)lds_raw;
    F.tid = threadIdx.x; F.lane = F.tid & 63; F.wid = __builtin_amdgcn_readfirstlane(F.tid >> 6); F.bid = blockIdx.x; F.G = gridDim.x;
    unsigned char* ws = p.ws; F.ws = ws;
    volatile LAS unsigned* MISC = (volatile LAS unsigned*)(F.lds + MISC_OFF);
    if (F.tid < 64) MISC[F.tid] = 0u;
    if (F.tid == 64) { LAS unsigned long long* LP = (LAS unsigned long long*)(F.lds + PARAM_OFF);
        LP[0] = (unsigned long long)p.x; LP[1] = (unsigned long long)p.c; LP[2] = (unsigned long long)p.ctx; LP[3] = (unsigned long long)p.c_ctx; LP[4] = (unsigned long long)p.ada_w; LP[5] = (unsigned long long)p.ada_b;
        LP[6] = (unsigned long long)p.norm_mix; LP[7] = (unsigned long long)p.norm_ffn; LP[8] = (unsigned long long)p.even_w_in; LP[9] = (unsigned long long)p.even_w_out; LP[10] = (unsigned long long)p.even_conv_w;
        LP[11] = (unsigned long long)p.even_sink; LP[12] = (unsigned long long)p.odd_w_in; LP[13] = (unsigned long long)p.odd_w_out; LP[14] = (unsigned long long)p.odd_rpb; LP[15] = (unsigned long long)p.router_w;
        LP[16] = (unsigned long long)p.router_b; LP[17] = (unsigned long long)p.moe_w_gu; LP[18] = (unsigned long long)p.moe_b_gu; LP[19] = (unsigned long long)p.moe_w_dn; LP[20] = (unsigned long long)p.moe_b_dn;
        LP[21] = (unsigned long long)p.final_norm; LP[22] = (unsigned long long)p.out; }
    __syncthreads();
    const int lo = p.ph_lo, hi = p.ph_hi;
    XcdBarrier bar; bar.bar = (unsigned*)(ws + WS_CTL) + CW_BAR; bar.x = 0; bar.st = MISC + 8;
    if (hi - lo > 1) bar = xcd_barrier_post((unsigned*)(ws + WS_CTL) + CW_BAR, MISC + 8);
#define RUN_PHASE(ph, call) do { if (PH_ON(ph) && lo <= (ph) && (ph) < hi) { call; } if (lo <= (ph) && (ph) + 1 < hi) xcd_barrier(bar); } while (0)
    RUN_PHASE(PH_PREP, phase_prep(F));
    RUN_PHASE(PH_NORM1_0, phase_norm1_l0(F));
    RUN_PHASE(PH_INPROJ_0, phase_inproj_l0(F));
    RUN_PHASE(PH_ATTN_0, phase_attn_l0(F));
    RUN_PHASE(PH_OUTPROJ_0, phase_outproj(F, 0));
    RUN_PHASE(PH_ROUTE_0, phase_route(F, 0));
    RUN_PHASE(PH_MOE1_0, phase_moe1(F, 0));
    RUN_PHASE(PH_MOE2_0, phase_moe2(F, 0));
    RUN_PHASE(PH_COMB_0, phase_combine(F, 0));
    RUN_PHASE(PH_INPROJ_1, phase_inproj_l1(F));
    RUN_PHASE(PH_ATTN_1, phase_attn_l1(F));
    RUN_PHASE(PH_FST2_1, phase_fst2(F));
    RUN_PHASE(PH_OUTPROJ_1, phase_outproj(F, 1));
    RUN_PHASE(PH_ROUTE_1, phase_route(F, 1));
    RUN_PHASE(PH_MOE1_1, phase_moe1(F, 1));
    RUN_PHASE(PH_MOE2_1, phase_moe2(F, 1));
    RUN_PHASE(PH_FINAL, phase_combine(F, 1));
}

extern "C" void kernel_launch(void* const* d_in, const int* in_sizes, int n_in, void* d_out, int out_size, void* d_ws, size_t ws_size, hipStream_t stream) {
    static int grid = 0;
    if (grid == 0) {
        if (n_in != 22 || ws_size < WS_END) { fprintf(stderr, "kernel_launch: unexpected inputs (n_in %d, ws %zu)\n", n_in, ws_size); grid = -1; return; }
        int dev = 0, cus = 0, per_cu = 0;
        hipGetDevice(&dev);
        hipDeviceGetAttribute(&cus, hipDeviceAttributeMultiprocessorCount, dev);
        hipFuncSetAttribute((const void*)fwd_kernel, hipFuncAttributeMaxDynamicSharedMemorySize, LDS_BYTES);
        hipOccupancyMaxActiveBlocksPerMultiprocessor(&per_cu, (const void*)fwd_kernel, 512, LDS_BYTES);
        if (per_cu < 1) { fprintf(stderr, "kernel_launch: occupancy query says %d blocks/CU\n", per_cu); per_cu = 1; }
        (void)hipGetLastError();
        grid = cus;
    }
    if (grid < 0) return;
    hipMemsetAsync((char*)d_ws + WS_CTL, 0, CTL_BYTES, stream);
    Params p{};
    const float** pp = (const float**)&p;
    for (int i = 0; i < 22; ++i) pp[i] = (const float*)d_in[i];
    p.out = (float*)d_out; p.ws = (unsigned char*)d_ws;
#if N_LAUNCH_MODE == 1
    for (int ph = 0; ph < NPHASE; ++ph) { p.ph_lo = ph; p.ph_hi = ph + 1; hipLaunchKernelGGL(fwd_kernel, dim3(grid), dim3(512), LDS_BYTES, stream, p); }
#else
    p.ph_lo = 0; p.ph_hi = NPHASE;
    void* args[] = {&p};
    hipError_t e = hipLaunchCooperativeKernel((const void*)fwd_kernel, dim3(grid), dim3(512), args, LDS_BYTES, stream);
    if (e != hipSuccess) fprintf(stderr, "kernel_launch: cooperative launch failed: %s (grid %d)\n", hipGetErrorString(e), grid);
#endif
}
```

```cpp
#include <hip/hip_runtime.h>
#include <cstdio>
#include <cstdint>

#ifndef N_LAUNCH_MODE
#define N_LAUNCH_MODE 0
#endif

#ifndef PHASE_MASK
#define PHASE_MASK 0x1FFFF
#endif
#define PH_ON(ph) ((PHASE_MASK >> (ph)) & 1)
#define LAS __attribute__((address_space(3)))
#define GAS __attribute__((address_space(1)))
typedef unsigned short bf16_t;
typedef short bf16x8 __attribute__((ext_vector_type(8)));
typedef short s16x4 __attribute__((ext_vector_type(4)));
typedef float f32x4 __attribute__((ext_vector_type(4)));
typedef float f32x2 __attribute__((ext_vector_type(2)));
typedef int i32x4 __attribute__((ext_vector_type(4)));
typedef unsigned u32x2 __attribute__((ext_vector_type(2)));
typedef unsigned u32x4 __attribute__((ext_vector_type(4)));

constexpr int D = 1024, NB = 4, SEQ = 4096, CTXL = 256;
constexpr int NMAIN = NB * SEQ, NCTX = NB * CTXL, NTOK = NMAIN + NCTX;
constexpr int EVEN_IN = 2304, NEXP = 32, DFF = 1024;
constexpr int QKV_LD = 1536;
constexpr float NORM_EPS = 1e-6f;
constexpr float LOG2E = 1.4426950408889634f;

constexpr size_t MiB = 1ull << 20;
constexpr size_t WS_CTL = 0, CTL_BYTES = 1 * MiB;
constexpr size_t WS_MOD = 1 * MiB;
constexpr size_t WS_M1 = 2 * MiB;
constexpr size_t WS_M2 = WS_M1 + 65536;
constexpr size_t WS_ROPE = WS_M2 + 65536;
constexpr size_t WS_TW = WS_ROPE + 8192;
constexpr size_t WS_WF = 4 * MiB;
constexpr size_t WS_TOPW = 8 * MiB;
constexpr size_t WS_POS = 9 * MiB;
constexpr size_t WS_LIST = 12 * MiB;
constexpr size_t WS_H = 16 * MiB;
constexpr size_t WS_MIX = 52 * MiB;
constexpr size_t WS_XS = 88 * MiB;
constexpr size_t WS_PROJ = 160 * MiB;
constexpr size_t WS_Z = 240 * MiB;
constexpr size_t WS_A1 = 304 * MiB;
constexpr size_t WS_ACT = 368 * MiB;
constexpr size_t WS_Y = 512 * MiB;
constexpr size_t WS_END = 656 * MiB;
constexpr int CW_BAR = 4096;
constexpr int CW_CNT = 8192;

constexpr int LDS_BYTES = 147456;
constexpr int PARAM_OFF = LDS_BYTES - 512;
constexpr int MISC_OFF = LDS_BYTES - 256;
constexpr int A_TILE_B = 32768, B_ROWB = 544, B_TILE_B = 64 * B_ROWB, STAGE_B = A_TILE_B + B_TILE_B;
static_assert(2 * STAGE_B + 1024 <= PARAM_OFF, "LDS");

enum { PH_PREP = 0, PH_NORM1_0, PH_INPROJ_0, PH_ATTN_0, PH_OUTPROJ_0, PH_ROUTE_0, PH_MOE1_0, PH_MOE2_0, PH_COMB_0,
       PH_INPROJ_1, PH_ATTN_1, PH_FST2_1, PH_OUTPROJ_1, PH_ROUTE_1, PH_MOE1_1, PH_MOE2_1, PH_FINAL, NPHASE };

struct Params {
    const float *x, *c, *ctx, *c_ctx, *ada_w, *ada_b, *norm_mix, *norm_ffn, *even_w_in, *even_w_out, *even_conv_w, *even_sink,
                *odd_w_in, *odd_w_out, *odd_rpb, *router_w, *router_b, *moe_w_gu, *moe_b_gu, *moe_w_dn, *moe_b_dn, *final_norm;
    float* out; unsigned char* ws; int ph_lo, ph_hi;
};

__device__ __forceinline__ unsigned pk2(float lo, float hi) { unsigned r; asm("v_cvt_pk_bf16_f32 %0, %1, %2" : "=v"(r) : "v"(lo), "v"(hi)); return r; }
__device__ __forceinline__ float bflo(unsigned u) { return __builtin_bit_cast(float, u << 16); }
__device__ __forceinline__ float bfhi(unsigned u) { return __builtin_bit_cast(float, u & 0xffff0000u); }
__device__ __forceinline__ float wave_sum(float v) {
#pragma unroll
    for (int o = 1; o < 64; o <<= 1) v += __shfl_xor(v, o);
    return v;
}
__device__ __forceinline__ float fexp2(float x) { return __builtin_amdgcn_exp2f(x); }

#define XB_TMO      128
#define XB_XCNT(j)  (256  + 64 * (j))
#define XB_XSUB(j)  (1280 + 64 * (j))
#define XB_XGEN(j)  (2304 + 64 * (j))
#define XB_TOP      3328
#define XB_TOPGEN   3392
#define XB_SPIN_CAP (1u << 22)
__device__ __forceinline__ unsigned xb_ld(unsigned* p)              { return __hip_atomic_load(p, __ATOMIC_RELAXED, __HIP_MEMORY_SCOPE_AGENT); }
__device__ __forceinline__ unsigned xb_add(unsigned* p, unsigned v) { return __hip_atomic_fetch_add(p, v, __ATOMIC_RELAXED, __HIP_MEMORY_SCOPE_AGENT); }
__device__ __forceinline__ unsigned xb_xcc_id() { return (unsigned)__builtin_amdgcn_s_getreg((3 << 11) | 20) & 0xFu; }
#define XB_SPIN(cond, bar) do { unsigned _sp = 0; while (cond) { __builtin_amdgcn_s_sleep(1); \
    if ((++_sp & 255u) == 0u) { if (xb_ld(&(bar)[XB_TMO])) break; if (_sp > XB_SPIN_CAP) { atomicAdd(&(bar)[XB_TMO], 1u); break; } } } } while (0)
struct XcdBarrier { unsigned* bar; unsigned x; volatile LAS unsigned* st; };
__device__ __forceinline__ XcdBarrier xcd_barrier_post(unsigned* bar, volatile LAS unsigned* st) {
    XcdBarrier b; b.bar = bar; b.x = xb_xcc_id(); b.st = st;
    if (threadIdx.x == 0) (void)xb_add(&bar[XB_XCNT(b.x)], 1u);
    return b;
}
__device__ __forceinline__ void xcd_barrier_complete(unsigned* bar, unsigned x, unsigned& nloc, unsigned& nx) {
    const unsigned G = gridDim.x * gridDim.y * gridDim.z;
    unsigned sum, cnt, mine, sp = 0u;
    for (;;) {
        sum = 0u; cnt = 0u; mine = 0u;
#pragma unroll
        for (unsigned j = 0; j < 16; ++j) { const unsigned c = xb_ld(&bar[XB_XCNT(j)]); sum += c; cnt += (c > 0u) ? 1u : 0u; mine = (j == x) ? c : mine; }
        if (sum == G) break;
        __builtin_amdgcn_s_sleep(1);
        if ((++sp & 255u) == 0u) { if (xb_ld(&bar[XB_TMO])) break; if (sp > XB_SPIN_CAP) { atomicAdd(&bar[XB_TMO], 1u); break; } }
    }
    nloc = mine > 0u ? mine : 1u; nx = cnt > 0u ? cnt : 1u;
}
__device__ __forceinline__ void xcd_barrier(const XcdBarrier& b) {
    asm volatile("s_waitcnt vmcnt(0)" ::: "memory");
    __syncthreads();
    if (threadIdx.x == 0) {
        unsigned* bar = b.bar;
        __builtin_amdgcn_s_waitcnt(0);
        unsigned nloc = b.st[0], nx = b.st[1];
        if (nloc == 0u) { xcd_barrier_complete(bar, b.x, nloc, nx); b.st[0] = nloc; b.st[1] = nx; }
        const unsigned old = xb_add(&bar[XB_XSUB(b.x)], 1u);
        const unsigned gen = old / nloc;
        if (old + 1u == (gen + 1u) * nloc) {
            __builtin_amdgcn_fence(__ATOMIC_RELEASE, "agent");
            asm volatile("s_waitcnt vmcnt(0)" ::: "memory");
            const unsigned og = xb_add(&bar[XB_TOP], 1u);
            const unsigned tg = og / nx;
            if (og + 1u == (tg + 1u) * nx) xb_add(&bar[XB_TOPGEN], 1u);
            else XB_SPIN(xb_ld(&bar[XB_TOPGEN]) == tg, bar);
            __builtin_amdgcn_fence(__ATOMIC_ACQUIRE, "agent");
            xb_add(&bar[XB_XGEN(b.x)], 1u);
            asm volatile("s_waitcnt vmcnt(0)" ::: "memory");
        } else {
            XB_SPIN(xb_ld(&bar[XB_XGEN(b.x)]) == gen, bar);
            __builtin_amdgcn_fence(__ATOMIC_ACQUIRE, "agent");
            asm volatile("s_waitcnt vmcnt(0)" ::: "memory");
        }
    }
    __syncthreads();
}

struct GA { const bf16_t* base; unsigned off[4]; };
struct GB { const float* ptr; unsigned ldb; unsigned lcol; unsigned woff; };
__device__ __forceinline__ int a_piece_row(int wid, int lane, int i) { const int sb = lane * 16, swz = sb ^ (((sb >> 9) & 1) << 5); return ((wid >> 1) + 4 * i) * 16 + (swz >> 6); }
__device__ __forceinline__ int a_piece_col(int wid, int lane) { const int sb = lane * 16, swz = sb ^ (((sb >> 9) & 1) << 5); return (wid & 1) * 32 + ((swz & 63) >> 1); }

__device__ __forceinline__ void gemm_tile(LAS unsigned char* lds, const GA& ga, const GB& gb, const int nt_, f32x4 (&acc)[8][4], const int wid, const int lane) {
    int nt = nt_; asm volatile("" : "+s"(nt));
    const int wr = wid >> 2, wc = wid & 3, fr = lane & 15, fq = lane >> 4;
    const unsigned a_w = (unsigned)(wid * 1024 + lane * 16);
    const unsigned b_w = (unsigned)(A_TILE_B + ((wid >> 2) * 32 + 4 * (wid & 3)) * B_ROWB) + gb.woff;
    const unsigned a_r = (unsigned)(wr * 16384 + ((fr * 64 + fq * 16) ^ ((fr >> 3) << 5)));
    const unsigned b_r = (unsigned)(A_TILE_B + (4 * fq + (fr >> 2)) * B_ROWB + (wc * 64 + (fr & 3) * 4) * 2);
    f32x4 sb[8];
    const unsigned ldb4 = gb.ldb * 4u; const unsigned lcolb = gb.lcol * 4u; unsigned aoff[4];
    const __amdgpu_buffer_rsrc_t ra = __builtin_amdgcn_make_buffer_rsrc((void*)ga.base, 0, 0x7fffffff, 0x00020000);
    const __amdgpu_buffer_rsrc_t rb = __builtin_amdgcn_make_buffer_rsrc((void*)gb.ptr, 0, 0x7fffffff, 0x00020000);
#pragma unroll
    for (int i = 0; i < 4; ++i) aoff[i] = ga.off[i] * 2u;
#pragma unroll
    for (int m = 0; m < 8; ++m)
#pragma unroll
        for (int n = 0; n < 4; ++n) acc[m][n] = (f32x4){0.f, 0.f, 0.f, 0.f};
#define G_GLDS_A(buf, kt) do { _Pragma("unroll") for (int i = 0; i < 4; ++i) \
        __builtin_amdgcn_raw_ptr_buffer_load_lds(ra, (LAS void*)(lds + (buf) + wid * 1024 + i * 8192), 16, (int)aoff[i], (kt) * 128, 0, 0); } while (0)
#define G_ISSUE_B(kt) do { \
        _Pragma("unroll") for (int i = 0; i < 8; ++i) sb[i] = __builtin_bit_cast(f32x4, __builtin_amdgcn_raw_buffer_load_b128(rb, (int)lcolb, (int)(((unsigned)(kt) * 64u + i) * ldb4), 0)); \
        __builtin_amdgcn_sched_barrier(0); } while (0)
#define G_WRITE_B(buf) do { \
        _Pragma("unroll") for (int i = 0; i < 8; ++i) { u32x2 w; w.x = pk2(sb[i][0], sb[i][1]); w.y = pk2(sb[i][2], sb[i][3]); \
            *(LAS u32x2*)(lds + (buf) + b_w + (16 * (i >> 2) + (i & 3)) * B_ROWB) = w; } __builtin_amdgcn_sched_barrier(0); } while (0)
#define G_KSTEP(buf, ks) do { bf16x8 Bf[4]; \
        _Pragma("unroll") for (int n = 0; n < 4; ++n) { \
            const s16x4 lo = __builtin_amdgcn_ds_read_tr16_b64_v4i16((LAS s16x4*)(lds + (buf) + b_r + (ks) * 32 * B_ROWB + n * 32)); \
            const s16x4 hi = __builtin_amdgcn_ds_read_tr16_b64_v4i16((LAS s16x4*)(lds + (buf) + b_r + (ks) * 32 * B_ROWB + 16 * B_ROWB + n * 32)); \
            Bf[n] = (bf16x8){lo[0], lo[1], lo[2], lo[3], hi[0], hi[1], hi[2], hi[3]}; } \
        _Pragma("unroll") for (int mh = 0; mh < 2; ++mh) { bf16x8 At[4]; \
            _Pragma("unroll") for (int m = 0; m < 4; ++m) At[m] = *(const LAS bf16x8*)(lds + (buf) + a_r + (mh * 4 + m) * 2048 + (ks) * 1024); \
            _Pragma("unroll") for (int m = 0; m < 4; ++m) _Pragma("unroll") for (int n = 0; n < 4; ++n) \
                acc[mh * 4 + m][n] = __builtin_amdgcn_mfma_f32_16x16x32_bf16(Bf[n], At[m], acc[mh * 4 + m][n], 0, 0, 0); } \
        __builtin_amdgcn_sched_barrier(0); } while (0)
    { unsigned b0 = 0; asm volatile("" : "+s"(b0));
      G_GLDS_A(b0, 0); G_ISSUE_B(0); G_WRITE_B(b0); if (nt > 1) G_ISSUE_B(1); }
    asm volatile("s_waitcnt vmcnt(8)" ::: "memory");
    __syncthreads();
    for (int t = 0; t < nt; ++t) {
        unsigned bc = (unsigned)(t & 1) * STAGE_B, bn = (unsigned)((t & 1) ^ 1) * STAGE_B; asm volatile("" : "+s"(bc), "+s"(bn));
        if (t + 1 < nt) { G_WRITE_B(bn); G_GLDS_A(bn, t + 1); }
        if (t + 2 < nt) G_ISSUE_B(t + 2);
        G_KSTEP(bc, 0); G_KSTEP(bc, 1);
        asm volatile("s_waitcnt vmcnt(0)" ::: "memory");
        __syncthreads();
    }
#undef G_GLDS_A
#undef G_ISSUE_B
#undef G_WRITE_B
#undef G_KSTEP
}

struct Frame { LAS unsigned char* lds; int tid, lane, wid, bid, G; unsigned char* ws; };
__device__ __forceinline__ const void* ldp(const Frame& F, int off) {
    const u32x2 v = *(const volatile LAS u32x2*)(F.lds + PARAM_OFF + off);
    const unsigned lo = __builtin_amdgcn_readfirstlane(v.x), hi = __builtin_amdgcn_readfirstlane(v.y);
    return (const void*)(((unsigned long long)hi << 32) | lo);
}
#define PP(f) ((const float*)ldp(F, (int)__builtin_offsetof(Params, f)))
#define F_mod ((float*)(F.ws + WS_MOD))
#define F_M1 ((bf16_t*)(F.ws + WS_M1))
#define F_M2 ((bf16_t*)(F.ws + WS_M2))
#define F_ROPE ((f32x2*)(F.ws + WS_ROPE))
#define F_TW ((f32x2*)(F.ws + WS_TW))
#define F_WF ((float*)(F.ws + WS_WF))
#define F_TOPW ((float*)(F.ws + WS_TOPW))
#define F_POS ((int*)(F.ws + WS_POS))
#define F_LIST ((int*)(F.ws + WS_LIST))
#define F_H ((bf16_t*)(F.ws + WS_H))
#define F_MIX ((bf16_t*)(F.ws + WS_MIX))
#define F_XS ((float*)(F.ws + WS_XS))
#define F_PROJ ((bf16_t*)(F.ws + WS_PROJ))
#define F_Z ((float*)(F.ws + WS_Z))
#define F_A1 ((float*)(F.ws + WS_A1))
#define F_ACT ((bf16_t*)(F.ws + WS_ACT))
#define F_Y ((bf16_t*)(F.ws + WS_Y))
#define F_cnt ((unsigned*)(F.ws + WS_CTL) + CW_CNT)

__device__ __forceinline__ const float* modp(const Frame& F, int l, int r, int which) { return F_mod + ((size_t)(l * 5 + r)) * 6144 + which * 1024; }
__device__ __forceinline__ int mod_row(int row) { return row < NMAIN ? (row >> 12) : 4; }

__device__ __forceinline__ float row_rstd(const f32x4 (&v)[4]) {
    float s = 0.f;
#pragma unroll
    for (int j = 0; j < 4; ++j) s += (v[j][0] * v[j][0] + v[j][1] * v[j][1]) + (v[j][2] * v[j][2] + v[j][3] * v[j][3]);
    return __builtin_amdgcn_rsqf(wave_sum(s) * (1.f / D) + NORM_EPS);
}
__device__ __forceinline__ void norm_mod_store(const f32x4 (&v)[4], float rstd, const float* gam, const float* sc, const float* sh, bf16_t* dst, int lane, f32x4 (*keep)[4] = nullptr) {
#pragma unroll
    for (int j = 0; j < 4; ++j) {
        const int c = 4 * lane + 256 * j;
        const f32x4 g = *(const f32x4*)(gam + c), s1 = *(const f32x4*)(sc + c), s0 = *(const f32x4*)(sh + c);
        f32x4 h;
#pragma unroll
        for (int i = 0; i < 4; ++i) h[i] = v[j][i] * rstd * g[i] * (1.f + s1[i]) + s0[i];
        u32x2 w; w.x = pk2(h[0], h[1]); w.y = pk2(h[2], h[3]);
        *(u32x2*)(dst + c) = w;
        if (keep) (*keep)[j] = h;
    }
}

__device__ __forceinline__ void phase_prep(Frame& F) {
    LAS float* sil = (LAS float*)F.lds;
    LAS float* red = (LAS float*)(F.lds + 20480);
    LAS float* ct = (LAS float*)(F.lds + 32768);
    for (int idx = F.tid; idx < 5120; idx += 512) { const int r = idx >> 10, k = idx & 1023; const float v = r < 4 ? PP(c)[r * 1024 + k] : PP(c_ctx)[k]; sil[idx] = v / (1.f + __expf(-v)); }
    if (F.tid < 128) ct[F.tid] = cospif((float)F.tid / 64.f);
    __syncthreads();
    constexpr int N_ADA = 192, N_CONST = 8, N_FOLD = 256;
    for (int it = F.bid; it < N_ADA + N_CONST + N_FOLD; it += F.G) {
        if (it < N_ADA) {
            const int l = it / 96, j0 = (it % 96) * 64, col = j0 + F.lane;
            const float* w = PP(ada_w) + ((size_t)l * 1024 + F.wid * 128) * 6144 + col;
            float a[5] = {0.f, 0.f, 0.f, 0.f, 0.f};
#pragma unroll 8
            for (int k = 0; k < 128; ++k) { const float wv = w[(size_t)k * 6144];
#pragma unroll
                for (int r = 0; r < 5; ++r) a[r] += sil[r * 1024 + F.wid * 128 + k] * wv; }
#pragma unroll
            for (int r = 0; r < 5; ++r) red[(F.wid * 5 + r) * 64 + F.lane] = a[r];
            __syncthreads();
            if (F.tid < 320) { const int r = F.tid >> 6, ln = F.tid & 63; float s = 0.f;
#pragma unroll
                for (int w8 = 0; w8 < 8; ++w8) s += red[(w8 * 5 + r) * 64 + ln];
                F_mod[(size_t)(l * 5 + r) * 6144 + j0 + ln] = s + PP(ada_b)[l * 6144 + j0 + ln]; }
            __syncthreads();
        } else if (it < N_ADA + N_CONST) {
            const int gt = (it - N_ADA) * 512 + F.tid;
            for (int e = gt; e < 32768; e += 4096) {
                const int row = e >> 7, kk = e & 127;
                float v1 = 0.f, v2 = 0.f;
                if (row < 128) { const int ro = row >> 6, k1 = row & 63, n1 = kk >> 1, ri = kk & 1; const float ph = (float)((n1 * k1) & 63) / 32.f; const float cs = cospif(ph), sn = sinpif(ph);
                    v1 = (ro == ri) ? cs : (ro == 0 ? sn : -sn); }
                if (row < 64) { const int ro = kk >> 6, n2 = kk & 63; const float ph = (float)((row * n2) & 63) / 32.f; v2 = ro == 0 ? cospif(ph) : sinpif(ph); }
                F_M1[e] = (bf16_t)(pk2(v1, 0.f) & 0xffffu); F_M2[e] = (bf16_t)(pk2(v2, 0.f) & 0xffffu);
            }
            if (gt < 1024) { const int pos = gt >> 4, f = gt & 15; const double ang = (double)pos * pow(10000.0, -(double)f / 16.0); F_ROPE[gt] = (f32x2){(float)cos(ang), (float)sin(ang)}; }
            { const float ph = (float)gt / 2048.f; F_TW[gt] = (f32x2){cospif(ph), sinpif(ph)}; }
        } else {
            const int fi = it - N_ADA - N_CONST, rc = fi >> 2, g = fi & 3, half = F.tid >> 8, j = F.tid & 255, jj = j & 127;
            for (int i2 = 0; i2 < 8; ++i2) {
                const int row = rc * 16 + i2 * 2 + half;
                const float* wr_ = PP(odd_w_in) + (size_t)row * 2048 + 1536 + g * 128;
                float s = 0.f;
                if (j < 128) { for (int cc = 0; cc < 128; ++cc) s += wr_[cc] * ct[(cc * jj) & 127]; }
                else { for (int cc = 0; cc < 128; ++cc) s -= wr_[cc] * ct[((cc * jj) - 32) & 127]; }
                F_WF[(size_t)row * 1024 + g * 256 + j] = s;
            }
        }
    }
}

__device__ __forceinline__ void phase_norm1_l0(Frame& F) {
    const int gw = F.bid * 8 + F.wid, NGW = F.G * 8;
    for (int row = gw; row < NTOK; row += NGW) {
        const float* src = row < NMAIN ? PP(x) + (size_t)row * D : PP(ctx) + (size_t)(row - NMAIN) * D;
        f32x4 v[4];
#pragma unroll
        for (int j = 0; j < 4; ++j) v[j] = *(const f32x4*)(src + 4 * F.lane + 256 * j);
        const float rstd = row_rstd(v); const int r = mod_row(row);
        norm_mod_store(v, rstd, PP(norm_mix), modp(F, 0, r, 1), modp(F, 0, r, 0), F_H + (size_t)row * D, F.lane);
    }
}

#define EPI_ROW(pm, m) ((pm) * 256 + wr * 128 + (m) * 16 + fr)
__device__ __forceinline__ void phase_inproj_l0(Frame& F) {
    const int wid = F.wid, lane = F.lane, wr = wid >> 2, wc = wid & 3, fr = lane & 15, fq = lane >> 4;
    constexpr int nM = NTOK / 256, nN = EVEN_IN / 256;
    f32x4 acc[8][4];
    for (int t = F.bid; t < nM * nN; t += F.G) {
        const int pm = t / nN, pn = t % nN;
        GA ga; ga.base = F_H; { const int C = a_piece_col(wid, lane);
#pragma unroll
            for (int i = 0; i < 4; ++i) ga.off[i] = (unsigned)((pm * 256 + a_piece_row(wid, lane, i)) * D + C); }
        GB gb; gb.ptr = PP(even_w_in) + (size_t)(wid * 8) * EVEN_IN + pn * 256; gb.lcol = 4 * lane; gb.ldb = EVEN_IN; gb.woff = 8 * lane;
        gemm_tile(F.lds, ga, gb, D / 64, acc, wid, lane);
        const int colb = pn * 256 + wc * 64;
        const bool rope = (colb < 640) && (pm < NMAIN / 256);
#pragma unroll
        for (int m = 0; m < 8; ++m) {
            const int row = EPI_ROW(pm, m);
            if (rope) {
                const int tt = row & (SEQ - 1), gr = tt >> 6, gc = tt & 63;
#pragma unroll
                for (int n = 0; n < 2; ++n) {
                    const int pos = n == 0 ? gr : gc;
#pragma unroll
                    for (int j = 0; j < 4; ++j) { const f32x2 cs = F_ROPE[pos * 16 + 4 * fq + j]; const float x1 = acc[m][n][j], x2 = acc[m][n + 2][j];
                        acc[m][n][j] = x1 * cs.x - x2 * cs.y; acc[m][n + 2][j] = x2 * cs.x + x1 * cs.y; }
                }
            }
#pragma unroll
            for (int n = 0; n < 4; ++n) { u32x2 w; w.x = pk2(acc[m][n][0], acc[m][n][1]); w.y = pk2(acc[m][n][2], acc[m][n][3]);
                *(u32x2*)(F_PROJ + (size_t)row * EVEN_IN + colb + n * 16 + 4 * fq) = w; }
        }
    }
}

__device__ __forceinline__ void phase_outproj(Frame& F, const int layer) {
    const int wid = F.wid, lane = F.lane, wr = wid >> 2, wc = wid & 3, fr = lane & 15, fq = lane >> 4;
    const int nM = (layer == 0 ? NTOK : NMAIN) / 256, nN = 4;
    const float* W = layer == 0 ? PP(even_w_out) : PP(odd_w_out);
    f32x4 acc[8][4];
    for (int t = F.bid; t < nM * nN; t += F.G) {
        const int pm = t / nN, pn = t % nN;
        GA ga; ga.base = F_MIX; { const int C = a_piece_col(wid, lane);
#pragma unroll
            for (int i = 0; i < 4; ++i) ga.off[i] = (unsigned)((pm * 256 + a_piece_row(wid, lane, i)) * D + C); }
        GB gb; gb.ptr = W + (size_t)(wid * 8) * D + pn * 256; gb.lcol = 4 * lane; gb.ldb = D; gb.woff = 8 * lane;
        gemm_tile(F.lds, ga, gb, D / 64, acc, wid, lane);
        const int colb = pn * 256 + wc * 64;
#pragma unroll
        for (int m = 0; m < 8; ++m) {
            const int row = EPI_ROW(pm, m); const int r = mod_row(row);
            const float* xin = layer == 0 ? (row < NMAIN ? PP(x) + (size_t)row * D : PP(ctx) + (size_t)(row - NMAIN) * D) : F_XS + (size_t)row * D;
            const float* g1 = modp(F, layer, r, 2);
#pragma unroll
            for (int n = 0; n < 4; ++n) { const int c = colb + n * 16 + 4 * fq; const f32x4 xv = *(const f32x4*)(xin + c), gv = *(const f32x4*)(g1 + c);
                f32x4 o;
#pragma unroll
                for (int j = 0; j < 4; ++j) o[j] = xv[j] + gv[j] * acc[m][n][j];
                *(f32x4*)(F_XS + (size_t)row * D + c) = o; }
        }
    }
}

constexpr int QT = 2;
struct AttnSt { f32x4 o[4][QT]; float m[QT], l[QT]; };
#define V_ROWB 160
__device__ __forceinline__ void v_stage(LAS unsigned char* vl, const bf16_t* vsrc, int ld, int lane) {
    i32x4 t[4];
#pragma unroll
    for (int i = 0; i < 4; ++i) t[i] = *(const i32x4*)(vsrc + (size_t)((lane >> 3) + 8 * i) * ld + (lane & 7) * 8);
#pragma unroll
    for (int i = 0; i < 4; ++i) *(LAS i32x4*)(vl + ((lane >> 3) + 8 * i) * V_ROWB + (lane & 7) * 16) = t[i];
}
#define ATTN_STEP(ksrc, kld, vsrc, vld, SCALE, BIAS) do { \
    bf16x8 kf[2][2]; \
    _Pragma("unroll") for (int kt = 0; kt < 2; ++kt) _Pragma("unroll") for (int ks = 0; ks < 2; ++ks) \
        kf[kt][ks] = *(const bf16x8*)((ksrc) + (size_t)(kt * 16 + fr) * (kld) + ks * 32 + 8 * fq); \
    v_stage(vl, (vsrc), (vld), lane); \
    bf16x8 vf[4]; \
    _Pragma("unroll") for (int dt = 0; dt < 4; ++dt) { \
        const s16x4 lo = __builtin_amdgcn_ds_read_tr16_b64_v4i16((LAS s16x4*)(vl + (4 * fq + (fr >> 2)) * V_ROWB + (dt * 16 + (fr & 3) * 4) * 2)); \
        const s16x4 hi = __builtin_amdgcn_ds_read_tr16_b64_v4i16((LAS s16x4*)(vl + (16 + 4 * fq + (fr >> 2)) * V_ROWB + (dt * 16 + (fr & 3) * 4) * 2)); \
        vf[dt] = (bf16x8){lo[0], lo[1], lo[2], lo[3], hi[0], hi[1], hi[2], hi[3]}; } \
    _Pragma("unroll") for (int qt = 0; qt < QT; ++qt) { \
        f32x4 s[2]; \
        _Pragma("unroll") for (int kt = 0; kt < 2; ++kt) { s[kt] = (f32x4){0.f, 0.f, 0.f, 0.f}; \
            _Pragma("unroll") for (int ks = 0; ks < 2; ++ks) s[kt] = __builtin_amdgcn_mfma_f32_16x16x32_bf16(kf[kt][ks], qf[qt][ks], s[kt], 0, 0, 0); } \
        float mx = -INFINITY; \
        _Pragma("unroll") for (int kt = 0; kt < 2; ++kt) _Pragma("unroll") for (int j = 0; j < 4; ++j) { const float tv = s[kt][j] * (SCALE) + BIAS(qt, kt, j); s[kt][j] = tv; mx = fmaxf(mx, tv); } \
        mx = fmaxf(mx, __shfl_xor(mx, 16)); mx = fmaxf(mx, __shfl_xor(mx, 32)); \
        const float mn = fmaxf(st.m[qt], mx), al = fexp2(st.m[qt] - mn); st.m[qt] = mn; \
        float ps = 0.f; \
        _Pragma("unroll") for (int kt = 0; kt < 2; ++kt) _Pragma("unroll") for (int j = 0; j < 4; ++j) { const float pv = fexp2(s[kt][j] - mn); s[kt][j] = pv; ps += pv; } \
        st.l[qt] = st.l[qt] * al + ps; \
        const unsigned w0 = pk2(s[0][0], s[0][1]), w1 = pk2(s[0][2], s[0][3]), w2 = pk2(s[1][0], s[1][1]), w3 = pk2(s[1][2], s[1][3]); \
        const bf16x8 pf = __builtin_bit_cast(bf16x8, ((u32x4){w0, w1, w2, w3})); \
        _Pragma("unroll") for (int dt = 0; dt < 4; ++dt) st.o[dt][qt] = __builtin_amdgcn_mfma_f32_16x16x32_bf16(vf[dt], pf, st.o[dt][qt] * al, 0, 0, 0); } \
    } while (0)

__device__ __forceinline__ void attn_store(AttnSt& st, bf16_t* dst  , int dld, int fr, int fq) {
#pragma unroll
    for (int qt = 0; qt < QT; ++qt) {
        float l = st.l[qt]; l += __shfl_xor(l, 16); l += __shfl_xor(l, 32);
        const float inv = 1.f / l;
#pragma unroll
        for (int dt = 0; dt < 4; ++dt) { const f32x4 o = st.o[dt][qt] * inv; u32x2 w; w.x = pk2(o[0], o[1]); w.y = pk2(o[2], o[3]);
            *(u32x2*)(dst + (size_t)(qt * 16 + fr) * dld + dt * 16 + 4 * fq) = w; }
    }
}

__device__ __forceinline__ void phase_attn_l0(Frame& F) {
    const int wid = F.wid, lane = F.lane, fr = lane & 15, fq = lane >> 4;
    LAS unsigned char* vl = F.lds + wid * 8192;
    constexpr int N_WIN = 256, N_CTXA = 16, N_CONV = NTOK / 64;
    const float SC = 0.125f * LOG2E;
    for (int it = F.bid; it < N_WIN + N_CTXA + N_CONV; it += F.G) {
        if (it < N_WIN + N_CTXA) {
            const bool isctx = it >= N_WIN;
            int b, kvh, qb;
            if (!isctx) { b = it >> 6; kvh = (it >> 5) & 1; qb = it & 31; } else { const int c = it - N_WIN; b = c >> 2; kvh = (c >> 1) & 1; qb = c & 1; }
            const int g = wid >> 1, h = kvh * 4 + g;
            for (int qh = 0; qh < 4 / QT; ++qh) {
            const int qq0 = (wid & 1) * 64 + qh * (16 * QT);
            const int qrow0 = (isctx ? NMAIN + b * CTXL : b * SEQ) + qb * 128 + qq0;
            bf16x8 qf[QT][2];
#pragma unroll
            for (int qt = 0; qt < QT; ++qt)
#pragma unroll
                for (int ks = 0; ks < 2; ++ks) qf[qt][ks] = *(const bf16x8*)(F_PROJ + (size_t)(qrow0 + qt * 16 + fr) * EVEN_IN + h * 64 + ks * 32 + 8 * fq);
            AttnSt st;
            const float sink = PP(even_sink)[h] * LOG2E;
#pragma unroll
            for (int qt = 0; qt < QT; ++qt) { st.m[qt] = sink; st.l[qt] = (fq == 0) ? 1.f : 0.f;
#pragma unroll
                for (int dt = 0; dt < 4; ++dt) st.o[dt][qt] = (f32x4){0.f, 0.f, 0.f, 0.f}; }
            const int kcol = 512 + kvh * 64, vcol = 640 + kvh * 64;
            for (int ch = isctx ? 3 : 0; ch < 5; ++ch) {
                int krow0;
                if (ch < 3) { const int kb = qb - 1 + ch; if (kb < 0 || kb >= SEQ / 128) continue; krow0 = b * SEQ + kb * 128; } else krow0 = NMAIN + b * CTXL + (ch - 3) * 128;
                for (int s32 = 0; s32 < 4; ++s32) {
                    const bf16_t* kp = F_PROJ + (size_t)(krow0 + s32 * 32) * EVEN_IN + kcol;
                    const bf16_t* vp = F_PROJ + (size_t)(krow0 + s32 * 32) * EVEN_IN + vcol;
                    if (ch == 0) {
#define BIAS_PREV(qt, kt, j) ((s32 * 32 + kt * 16 + 4 * fq + j) >= (qq0 + qt * 16 + fr) ? 0.f : -INFINITY)
                        ATTN_STEP(kp, EVEN_IN, vp, EVEN_IN, SC, BIAS_PREV);
                    } else if (ch == 2) {
#define BIAS_NEXT(qt, kt, j) ((s32 * 32 + kt * 16 + 4 * fq + j) <= (qq0 + qt * 16 + fr) ? 0.f : -INFINITY)
                        ATTN_STEP(kp, EVEN_IN, vp, EVEN_IN, SC, BIAS_NEXT);
                    } else {
#define BIAS_NONE(qt, kt, j) 0.f
                        ATTN_STEP(kp, EVEN_IN, vp, EVEN_IN, SC, BIAS_NONE);
                    }
                }
            }
            attn_store(st, F_MIX + (size_t)qrow0 * D + h * 64, D, fr, fq);
            }
        } else {
            const int ci = it - N_WIN - N_CTXA, c4 = (F.tid & 127) * 4, r0 = ci * 64 + (F.tid >> 7) * 16;
            const f32x4 w0 = *(const f32x4*)(PP(even_conv_w) + c4), w1 = *(const f32x4*)(PP(even_conv_w) + 512 + c4), w2 = *(const f32x4*)(PP(even_conv_w) + 1024 + c4);
#define LOADZ(dst, row_) do { const u32x2 gc_ = *(const u32x2*)(F_PROJ + (size_t)(row_) * EVEN_IN + 1280 + c4), uu_ = *(const u32x2*)(F_PROJ + (size_t)(row_) * EVEN_IN + 1792 + c4); \
                dst = (f32x4){bflo(gc_.x) * bflo(uu_.x), bfhi(gc_.x) * bfhi(uu_.x), bflo(gc_.y) * bflo(uu_.y), bfhi(gc_.y) * bfhi(uu_.y)}; } while (0)
            const int seqmask = r0 < NMAIN ? (SEQ - 1) : (CTXL - 1);
            f32x4 zp = (f32x4){0.f, 0.f, 0.f, 0.f}, zc, zn;
            if ((r0 & seqmask) != 0) LOADZ(zp, r0 - 1);
            LOADZ(zc, r0);
            for (int i = 0; i < 16; ++i) {
                const int row = r0 + i;
                zn = (f32x4){0.f, 0.f, 0.f, 0.f}; if ((row & seqmask) != seqmask) LOADZ(zn, row + 1);
                const u32x2 gb = *(const u32x2*)(F_PROJ + (size_t)row * EVEN_IN + 768 + c4);
                const f32x4 y = zp * w0 + zc * w1 + zn * w2;
                u32x2 w; w.x = pk2(bflo(gb.x) * y[0], bfhi(gb.x) * y[1]); w.y = pk2(bflo(gb.y) * y[2], bfhi(gb.y) * y[3]);
                *(u32x2*)(F_MIX + (size_t)row * D + 512 + c4) = w;
                zp = zc; zc = zn;
            }
        }
    }
}

constexpr int RW_LD = 1028;
__device__ __forceinline__ void phase_route(Frame& F, const int layer) {
    const int nrows = layer == 0 ? NTOK : NMAIN;
    LAS float* rwT = (LAS float*)F.lds;
    LAS int* cntL = (LAS int*)(F.lds + 32 * RW_LD * 4);
    LAS int* baseL = cntL + 32;
    LAS int* selE = baseL + 32;
    LAS int* selR = selE + 288;
    const float* rw = PP(router_w) + (size_t)layer * D * NEXP;
    for (int idx = F.tid; idx < D * NEXP; idx += 512) rwT[(idx & 31) * RW_LD + (idx >> 5)] = rw[idx];
    if (F.tid < 32) cntL[F.tid] = 0;
    __syncthreads();
    const int lane = F.lane, gw = F.bid * 8 + F.wid, NGW = F.G * 8;
    const float* gam = PP(norm_ffn) + layer * D;
    int slot = F.wid;
    for (int row = gw; row < nrows; row += NGW, slot += 8) {
        f32x4 v[4], h[4];
#pragma unroll
        for (int j = 0; j < 4; ++j) v[j] = *(const f32x4*)(F_XS + (size_t)row * D + 4 * lane + 256 * j);
        const float rstd = row_rstd(v); const int r = mod_row(row);
        norm_mod_store(v, rstd, gam, modp(F, layer, r, 4), modp(F, layer, r, 3), F_H + (size_t)row * D, lane, &h);
        float pe[32];
#pragma unroll
        for (int e = 0; e < 32; ++e) { float s = 0.f;
#pragma unroll
            for (int j = 0; j < 4; ++j) { const f32x4 w = *(const LAS f32x4*)(rwT + e * RW_LD + 4 * lane + 256 * j); s += (h[j][0] * w[0] + h[j][1] * w[1]) + (h[j][2] * w[2] + h[j][3] * w[3]); }
            pe[e] = s; }
        float q16[16], q8[8], q4[4], q2[2], q1;
        { const bool hi = lane & 32;
#pragma unroll
          for (int i = 0; i < 16; ++i) { const float snd = hi ? pe[i] : pe[16 + i], mine = hi ? pe[16 + i] : pe[i]; q16[i] = mine + __shfl_xor(snd, 32); } }
        { const bool hi = lane & 16;
#pragma unroll
          for (int i = 0; i < 8; ++i) { const float snd = hi ? q16[i] : q16[8 + i], mine = hi ? q16[8 + i] : q16[i]; q8[i] = mine + __shfl_xor(snd, 16); } }
        { const bool hi = lane & 8;
#pragma unroll
          for (int i = 0; i < 4; ++i) { const float snd = hi ? q8[i] : q8[4 + i], mine = hi ? q8[4 + i] : q8[i]; q4[i] = mine + __shfl_xor(snd, 8); } }
        { const bool hi = lane & 4;
#pragma unroll
          for (int i = 0; i < 2; ++i) { const float snd = hi ? q4[i] : q4[2 + i], mine = hi ? q4[2 + i] : q4[i]; q2[i] = mine + __shfl_xor(snd, 4); } }
        { const bool hi = lane & 2; const float snd = hi ? q2[0] : q2[1], mine = hi ? q2[1] : q2[0]; q1 = mine + __shfl_xor(snd, 2); }
        q1 += __shfl_xor(q1, 1);
        const int myE = (lane >> 1) & 31;
        float val = q1 + PP(router_b)[layer * NEXP + myE];
        float tv[4]; int te[4];
#pragma unroll
        for (int k = 0; k < 4; ++k) {
            float bv = val; int be = myE;
#pragma unroll
            for (int o = 1; o < 64; o <<= 1) { const float ov = __shfl_xor(bv, o); const int oe = __shfl_xor(be, o); if (ov > bv || (ov == bv && oe < be)) { bv = ov; be = oe; } }
            tv[k] = bv; te[k] = be; if (myE == be) val = -INFINITY;
        }
        const float e1 = __expf(tv[1] - tv[0]), e2 = __expf(tv[2] - tv[0]), e3 = __expf(tv[3] - tv[0]), inv = 1.f / (1.f + e1 + e2 + e3);
        if (lane == 0) {
            *(f32x4*)(F_TOPW + (size_t)row * 4) = (f32x4){inv, e1 * inv, e2 * inv, e3 * inv};
#pragma unroll
            for (int k = 0; k < 4; ++k) { selE[slot * 4 + k] = te[k]; selR[slot * 4 + k] = atomicAdd((int*)(cntL + te[k]), 1); }
        }
    }
    __syncthreads();
    if (F.tid < 32) { const int c = cntL[F.tid]; baseL[F.tid] = c ? (int)atomicAdd(F_cnt + layer * 32 + F.tid, (unsigned)c) : 0; }
    __syncthreads();
    if (F.tid < 288) { const int s = F.tid >> 2, k = F.tid & 3; const int row = F.bid * 8 + (s & 7) + (s >> 3) * NGW;
        if (row < nrows) { const int e = selE[F.tid], pos = baseL[e] + selR[F.tid]; F_POS[(size_t)row * 4 + k] = e | (pos << 8); F_LIST[(size_t)e * NTOK + pos] = row; } }
    __syncthreads();
}

__device__ __forceinline__ void moe_prefix(Frame& F, const int layer, LAS int* mtp, LAS int* roff) {
    if (F.tid == 0) { int a = 0, b = 0; for (int e = 0; e < 32; ++e) { const int c = (int)__hip_atomic_load(F_cnt + layer * 32 + e, __ATOMIC_RELAXED, __HIP_MEMORY_SCOPE_AGENT); mtp[e] = a; roff[e] = b; a += (c + 255) >> 8; b += c; } mtp[32] = a; roff[32] = b; }
    __syncthreads();
}
__device__ __forceinline__ void phase_moe1(Frame& F, const int layer) {
    const int wid = F.wid, lane = F.lane, wr = wid >> 2, wc = wid & 3, fr = lane & 15, fq = lane >> 4;
    LAS int* mtp = (LAS int*)(F.lds + 2 * STAGE_B); LAS int* roff = mtp + 40;
    moe_prefix(F, layer, mtp, roff);
    const int RT = mtp[32];
    f32x4 acc[8][4];
    for (int id = F.bid; id < RT * 8; id += F.G) {
        const int ct = id & 7, rt = id >> 3;
        int e = 0; while (mtp[e + 1] <= rt) ++e;
        const int rbase = (rt - mtp[e]) * 256, cnt = roff[e + 1] - roff[e], ro = roff[e];
        const int* list = F_LIST + (size_t)e * NTOK;
        GA ga; ga.base = F_H; { const int C = a_piece_col(wid, lane);
#pragma unroll
            for (int i = 0; i < 4; ++i) { int rr = rbase + a_piece_row(wid, lane, i); rr = rr < cnt ? rr : cnt - 1; ga.off[i] = (unsigned)(list[rr] * D + C); } }
        const float* W = PP(moe_w_gu) + ((size_t)(layer * NEXP + e) * D) * (2 * DFF);
        const int l2 = lane & 31, gcol = (lane >> 5) * DFF + ct * 128 + 4 * l2, tcol = ((4 * l2) >> 5) * 64 + (lane >> 5) * 32 + ((4 * l2) & 31);
        GB gb; gb.ptr = W + (size_t)(wid * 8) * (2 * DFF); gb.lcol = gcol; gb.ldb = 2 * DFF; gb.woff = 2 * tcol;
        gemm_tile(F.lds, ga, gb, D / 64, acc, wid, lane);
        const float* bias = PP(moe_b_gu) + (size_t)(layer * NEXP + e) * (2 * DFF);
#pragma unroll
        for (int n = 0; n < 2; ++n) {
            const int gc = ct * 128 + wc * 32 + n * 16 + 4 * fq;
            const f32x4 bg = *(const f32x4*)(bias + gc), bu = *(const f32x4*)(bias + DFF + gc);
#pragma unroll
            for (int m = 0; m < 8; ++m) {
                const int r = rbase + wr * 128 + m * 16 + fr;
                float a[4];
#pragma unroll
                for (int j = 0; j < 4; ++j) { const float gg = fminf(acc[m][n][j] + bg[j], 7.f), uu = fminf(fmaxf(acc[m][n + 2][j] + bu[j], -7.f), 7.f);
                    a[j] = (uu + 1.f) * gg / (1.f + __expf(-1.702f * gg)); }
                if (r < cnt) { u32x2 w; w.x = pk2(a[0], a[1]); w.y = pk2(a[2], a[3]); *(u32x2*)(F_ACT + (size_t)(ro + r) * DFF + gc) = w; }
            }
        }
    }
}
__device__ __forceinline__ void phase_moe2(Frame& F, const int layer) {
    const int wid = F.wid, lane = F.lane, wr = wid >> 2, wc = wid & 3, fr = lane & 15, fq = lane >> 4;
    LAS int* mtp = (LAS int*)(F.lds + 2 * STAGE_B); LAS int* roff = mtp + 40;
    moe_prefix(F, layer, mtp, roff);
    const int RT = mtp[32];
    f32x4 acc[8][4];
    for (int id = F.bid; id < RT * 4; id += F.G) {
        const int ct = id & 3, rt = id >> 2;
        int e = 0; while (mtp[e + 1] <= rt) ++e;
        const int rbase = (rt - mtp[e]) * 256, cnt = roff[e + 1] - roff[e], ro = roff[e];
        GA ga; ga.base = F_ACT; { const int C = a_piece_col(wid, lane);
#pragma unroll
            for (int i = 0; i < 4; ++i) { int rr = rbase + a_piece_row(wid, lane, i); rr = rr < cnt ? rr : cnt - 1; ga.off[i] = (unsigned)((ro + rr) * DFF + C); } }
        const float* W = PP(moe_w_dn) + ((size_t)(layer * NEXP + e) * DFF) * D;
        GB gb; gb.ptr = W + (size_t)(wid * 8) * D + ct * 256; gb.lcol = 4 * lane; gb.ldb = D; gb.woff = 8 * lane;
        gemm_tile(F.lds, ga, gb, DFF / 64, acc, wid, lane);
        const float* bias = PP(moe_b_dn) + (size_t)(layer * NEXP + e) * D;
#pragma unroll
        for (int n = 0; n < 4; ++n) {
            const int c = ct * 256 + wc * 64 + n * 16 + 4 * fq;
            const f32x4 bv = *(const f32x4*)(bias + c);
#pragma unroll
            for (int m = 0; m < 8; ++m) {
                const int r = rbase + wr * 128 + m * 16 + fr;
                if (r < cnt) { u32x2 w; w.x = pk2(acc[m][n][0] + bv[0], acc[m][n][1] + bv[1]); w.y = pk2(acc[m][n][2] + bv[2], acc[m][n][3] + bv[3]); *(u32x2*)(F_Y + (size_t)(ro + r) * D + c) = w; }
            }
        }
    }
}

__device__ __forceinline__ void phase_combine(Frame& F, const int layer) {
    LAS int* mtp = (LAS int*)(F.lds + 2 * STAGE_B); LAS int* roff = mtp + 40;
    moe_prefix(F, layer, mtp, roff);
    const int nrows = layer == 0 ? NTOK : NMAIN, lane = F.lane;
    const int gw = F.bid * 8 + F.wid, NGW = F.G * 8;
    for (int row = gw; row < nrows; row += NGW) {
        const i32x4 ps = *(const i32x4*)(F_POS + (size_t)row * 4); const f32x4 tw = *(const f32x4*)(F_TOPW + (size_t)row * 4);
        const int r = mod_row(row); const float* g2 = modp(F, layer, r, 5);
        f32x4 v[4];
#pragma unroll
        for (int j = 0; j < 4; ++j) v[j] = (f32x4){0.f, 0.f, 0.f, 0.f};
#pragma unroll
        for (int k = 0; k < 4; ++k) { const int e = ps[k] & 255, pos = ps[k] >> 8; const bf16_t* y = F_Y + (size_t)(roff[e] + pos) * D; const float w = tw[k];
#pragma unroll
            for (int j = 0; j < 4; ++j) { const u32x2 u = *(const u32x2*)(y + 4 * lane + 256 * j); v[j][0] += w * bflo(u.x); v[j][1] += w * bfhi(u.x); v[j][2] += w * bflo(u.y); v[j][3] += w * bfhi(u.y); } }
#pragma unroll
        for (int j = 0; j < 4; ++j) { const int c = 4 * lane + 256 * j; const f32x4 xs = *(const f32x4*)(F_XS + (size_t)row * D + c), gv = *(const f32x4*)(g2 + c); v[j] = xs + gv * v[j]; }
        const float rstd = row_rstd(v);
        if (layer == 0) {
#pragma unroll
            for (int j = 0; j < 4; ++j) *(f32x4*)(F_XS + (size_t)row * D + 4 * lane + 256 * j) = v[j];
            norm_mod_store(v, rstd, PP(norm_mix) + D, modp(F, 1, r, 1), modp(F, 1, r, 0), F_H + (size_t)row * D, lane);
        } else {
#pragma unroll
            for (int j = 0; j < 4; ++j) { const int c = 4 * lane + 256 * j; const f32x4 g = *(const f32x4*)(PP(final_norm) + c); *(f32x4*)(((float*)ldp(F, (int)__builtin_offsetof(Params, out))) + (size_t)row * D + c) = v[j] * rstd * g; }
        }
    }
}

__device__ __forceinline__ void phase_inproj_l1(Frame& F) {
    const int wid = F.wid, lane = F.lane, wr = wid >> 2, wc = wid & 3, fr = lane & 15, fq = lane >> 4;
    constexpr int N_MAIN_T = (NMAIN / 256) * 10, N_CTX_T = (NCTX / 256) * 4;
    f32x4 acc[8][4];
    for (int t = F.bid; t < N_MAIN_T + N_CTX_T; t += F.G) {
        int pm, pn;
        if (t < N_MAIN_T) { pm = t / 10; pn = t % 10; } else { const int c = t - N_MAIN_T; pm = NMAIN / 256 + (c >> 2); pn = 2 + (c & 3); }
        GA ga; ga.base = F_H; { const int C = a_piece_col(wid, lane);
#pragma unroll
            for (int i = 0; i < 4; ++i) ga.off[i] = (unsigned)((pm * 256 + a_piece_row(wid, lane, i)) * D + C); }
        GB gb;
        if (pn < 6) { gb.ptr = PP(odd_w_in) + (size_t)(wid * 8) * 2048 + pn * 256; gb.ldb = 2048; }
        else { gb.ptr = F_WF + (size_t)(wid * 8) * 1024 + (pn - 6) * 256; gb.ldb = 1024; }
        gb.lcol = 4 * lane; gb.woff = 8 * lane;
        gemm_tile(F.lds, ga, gb, D / 64, acc, wid, lane);
        if (pn < 6) {
#pragma unroll
            for (int m = 0; m < 8; ++m) { const int row = EPI_ROW(pm, m);
#pragma unroll
                for (int n = 0; n < 4; ++n) { u32x2 w; w.x = pk2(acc[m][n][0], acc[m][n][1]); w.y = pk2(acc[m][n][2], acc[m][n][3]);
                    *(u32x2*)(F_PROJ + (size_t)row * QKV_LD + pn * 256 + wc * 64 + n * 16 + 4 * fq) = w; } }
        } else {
            const int g = pn - 6, ri = wc >> 1;
#pragma unroll
            for (int m = 0; m < 8; ++m) { const int row = EPI_ROW(pm, m), b = row >> 12, n1 = (row >> 6) & 63, n2 = row & 63;
                float* zb = F_Z + ((((size_t)(b * 64 + n1) * 2 + ri) * 64 + n2) * 512) + g * 128 + (wc & 1) * 64;
#pragma unroll
                for (int n = 0; n < 4; ++n) *(f32x4*)(zb + n * 16 + 4 * fq) = acc[m][n]; }
        }
    }
}

__device__ __forceinline__ void phase_attn_l1(Frame& F) {
    const int wid = F.wid, lane = F.lane, wr = wid >> 2, wc = wid & 3, fr = lane & 15, fq = lane >> 4;
    constexpr int N_NA = NB * 64, N_F1 = NB * 128;
    const float SC = 0.125f * LOG2E;
    f32x4 acc[8][4];
    for (int it = F.bid; it < N_NA + N_F1; it += F.G) {
        if (it < N_NA) {
            LAS unsigned char* vl = F.lds + wid * 8192;
            LAS float* rp = (LAS float*)(vl + 5120);
            const int b = it >> 6, r = it & 63, h = wid;
            for (int i = lane; i < 465; i += 64) rp[i] = PP(odd_rpb)[h * 465 + i] * LOG2E;
            for (int qh = 0; qh < 4 / QT; ++qh) {
            const int qc0 = qh * (16 * QT), qrow0 = b * SEQ + r * 64 + qc0;
            bf16x8 qf[QT][2];
#pragma unroll
            for (int qt = 0; qt < QT; ++qt)
#pragma unroll
                for (int ks = 0; ks < 2; ++ks) qf[qt][ks] = *(const bf16x8*)(F_PROJ + (size_t)(qrow0 + qt * 16 + fr) * QKV_LD + h * 64 + ks * 32 + 8 * fq);
            AttnSt st;
#pragma unroll
            for (int qt = 0; qt < QT; ++qt) { st.m[qt] = -1e30f; st.l[qt] = 0.f;
#pragma unroll
                for (int dt = 0; dt < 4; ++dt) st.o[dt][qt] = (f32x4){0.f, 0.f, 0.f, 0.f}; }
            const int r0 = min(max(r - 4, 0), 56);
            int c0q[QT];
#pragma unroll
            for (int qt = 0; qt < QT; ++qt) c0q[qt] = min(max(qc0 + qt * 16 + fr - 8, 0), 48);
            for (int s = 0; s < 16; ++s) {
                const int kr = r0 + (s >> 1), half = s & 1;
                const bf16_t* kp = F_PROJ + (size_t)(b * SEQ + kr * 64 + half * 32) * QKV_LD + 512 + h * 64;
                const bf16_t* vp = kp + 512;
                const LAS float* rpr = rp + (kr - r + 7) * 31 + 15;
#define BIAS_NA(qt, kt, j) ({ const int kc = half * 32 + kt * 16 + 4 * fq + j; const int dc = kc - (qc0 + qt * 16 + fr); (kc >= c0q[qt] && kc < c0q[qt] + 16) ? rpr[dc] : -INFINITY; })
                ATTN_STEP(kp, QKV_LD, vp, QKV_LD, SC, BIAS_NA);
            }
            for (int s = 0; s < 8; ++s) {
                const bf16_t* kp = F_PROJ + (size_t)(NMAIN + b * CTXL + s * 32) * QKV_LD + 512 + h * 64;
                const bf16_t* vp = kp + 512;
                ATTN_STEP(kp, QKV_LD, vp, QKV_LD, SC, BIAS_NONE);
            }
            attn_store(st, F_MIX + (size_t)qrow0 * D + h * 64, D, fr, fq);
            }
            __syncthreads();
        } else {
            const int fi = it - N_NA, b = fi >> 7, ct = fi & 127;
            GA ga; ga.base = F_M1; { const int C = a_piece_col(wid, lane);
#pragma unroll
                for (int i = 0; i < 4; ++i) ga.off[i] = (unsigned)(a_piece_row(wid, lane, i) * 128 + C); }
            GB gb; gb.ptr = F_Z + (size_t)b * 128 * 32768 + (size_t)(wid * 8) * 32768 + ct * 256; gb.lcol = 4 * lane; gb.ldb = 32768; gb.woff = 8 * lane;
            gemm_tile(F.lds, ga, gb, 2, acc, wid, lane);
            if (wr == 0) {
#pragma unroll
                for (int m = 0; m < 4; ++m) { const int k1 = m * 16 + fr;
#pragma unroll
                    for (int n = 0; n < 4; ++n) { const int col = ct * 256 + wc * 64 + n * 16 + 4 * fq, n2 = col >> 9, c = col & 511;
                        const f32x2 tw = F_TW[n2 * k1];
                        const f32x4 re = acc[m][n], im = acc[m + 4][n];
                        const f32x4 ore = re * tw.x + im * tw.y, oim = im * tw.x - re * tw.y;
                        *(f32x4*)(F_A1 + ((((size_t)(b * 2 + 0) * 64 + n2) * 64 + k1) * 512) + c) = ore;
                        *(f32x4*)(F_A1 + ((((size_t)(b * 2 + 1) * 64 + n2) * 64 + k1) * 512) + c) = oim; } }
            }
        }
    }
}

__device__ __forceinline__ void phase_fst2(Frame& F) {
    const int wid = F.wid, lane = F.lane, wr = wid >> 2, wc = wid & 3, fr = lane & 15, fq = lane >> 4;
    const float scl = 1.f / 724.0773439350247f;
    f32x4 acc[8][4];
    for (int it = F.bid; it < NB * 128; it += F.G) {
        const int b = it >> 7, ct = it & 127;
        GA ga; ga.base = F_M2; { const int C = a_piece_col(wid, lane);
#pragma unroll
            for (int i = 0; i < 4; ++i) ga.off[i] = (unsigned)(a_piece_row(wid, lane, i) * 128 + C); }
        GB gb; gb.ptr = F_A1 + (size_t)b * 128 * 32768 + (size_t)(wid * 8) * 32768 + ct * 256; gb.lcol = 4 * lane; gb.ldb = 32768; gb.woff = 8 * lane;
        gemm_tile(F.lds, ga, gb, 2, acc, wid, lane);
        if (wr == 0) {
#pragma unroll
            for (int m = 0; m < 4; ++m) { const int k2 = m * 16 + fr;
#pragma unroll
                for (int n = 0; n < 4; ++n) { const int col = ct * 256 + wc * 64 + n * 16 + 4 * fq, k1 = col >> 9, c = col & 511;
                    const f32x4 o = acc[m][n] * scl; u32x2 w; w.x = pk2(o[0], o[1]); w.y = pk2(o[2], o[3]);
                    *(u32x2*)(F_MIX + (size_t)(b * SEQ + k1 + 64 * k2) * D + 512 + c) = w; } }
        }
    }
}

__global__ void __launch_bounds__(512, 2) fwd_kernel(Params p) {
    extern __shared__ __attribute__((aligned(16))) unsigned char lds_raw[];
    Frame F;
    F.lds = (LAS unsigned char*)lds_raw;
    F.tid = threadIdx.x; F.lane = F.tid & 63; F.wid = __builtin_amdgcn_readfirstlane(F.tid >> 6); F.bid = blockIdx.x; F.G = gridDim.x;
    unsigned char* ws = p.ws; F.ws = ws;
    volatile LAS unsigned* MISC = (volatile LAS unsigned*)(F.lds + MISC_OFF);
    if (F.tid < 64) MISC[F.tid] = 0u;
    if (F.tid == 64) { LAS unsigned long long* LP = (LAS unsigned long long*)(F.lds + PARAM_OFF);
        LP[0] = (unsigned long long)p.x; LP[1] = (unsigned long long)p.c; LP[2] = (unsigned long long)p.ctx; LP[3] = (unsigned long long)p.c_ctx; LP[4] = (unsigned long long)p.ada_w; LP[5] = (unsigned long long)p.ada_b;
        LP[6] = (unsigned long long)p.norm_mix; LP[7] = (unsigned long long)p.norm_ffn; LP[8] = (unsigned long long)p.even_w_in; LP[9] = (unsigned long long)p.even_w_out; LP[10] = (unsigned long long)p.even_conv_w;
        LP[11] = (unsigned long long)p.even_sink; LP[12] = (unsigned long long)p.odd_w_in; LP[13] = (unsigned long long)p.odd_w_out; LP[14] = (unsigned long long)p.odd_rpb; LP[15] = (unsigned long long)p.router_w;
        LP[16] = (unsigned long long)p.router_b; LP[17] = (unsigned long long)p.moe_w_gu; LP[18] = (unsigned long long)p.moe_b_gu; LP[19] = (unsigned long long)p.moe_w_dn; LP[20] = (unsigned long long)p.moe_b_dn;
        LP[21] = (unsigned long long)p.final_norm; LP[22] = (unsigned long long)p.out; }
    __syncthreads();
    const int lo = p.ph_lo, hi = p.ph_hi;
    XcdBarrier bar; bar.bar = (unsigned*)(ws + WS_CTL) + CW_BAR; bar.x = 0; bar.st = MISC + 8;
    if (hi - lo > 1) bar = xcd_barrier_post((unsigned*)(ws + WS_CTL) + CW_BAR, MISC + 8);
#define RUN_PHASE(ph, call) do { if (PH_ON(ph) && lo <= (ph) && (ph) < hi) { call; } if (lo <= (ph) && (ph) + 1 < hi) xcd_barrier(bar); } while (0)
    RUN_PHASE(PH_PREP, phase_prep(F));
    RUN_PHASE(PH_NORM1_0, phase_norm1_l0(F));
    RUN_PHASE(PH_INPROJ_0, phase_inproj_l0(F));
    RUN_PHASE(PH_ATTN_0, phase_attn_l0(F));
    RUN_PHASE(PH_OUTPROJ_0, phase_outproj(F, 0));
    RUN_PHASE(PH_ROUTE_0, phase_route(F, 0));
    RUN_PHASE(PH_MOE1_0, phase_moe1(F, 0));
    RUN_PHASE(PH_MOE2_0, phase_moe2(F, 0));
    RUN_PHASE(PH_COMB_0, phase_combine(F, 0));
    RUN_PHASE(PH_INPROJ_1, phase_inproj_l1(F));
    RUN_PHASE(PH_ATTN_1, phase_attn_l1(F));
    RUN_PHASE(PH_FST2_1, phase_fst2(F));
    RUN_PHASE(PH_OUTPROJ_1, phase_outproj(F, 1));
    RUN_PHASE(PH_ROUTE_1, phase_route(F, 1));
    RUN_PHASE(PH_MOE1_1, phase_moe1(F, 1));
    RUN_PHASE(PH_MOE2_1, phase_moe2(F, 1));
    RUN_PHASE(PH_FINAL, phase_combine(F, 1));
}

extern "C" void kernel_launch(void* const* d_in, const int* in_sizes, int n_in, void* d_out, int out_size, void* d_ws, size_t ws_size, hipStream_t stream) {
    static int grid = 0;
    if (grid == 0) {
        if (n_in != 22 || ws_size < WS_END) { fprintf(stderr, "kernel_launch: unexpected inputs (n_in %d, ws %zu)\n", n_in, ws_size); grid = -1; return; }
        int dev = 0, cus = 0, per_cu = 0;
        hipGetDevice(&dev);
        hipDeviceGetAttribute(&cus, hipDeviceAttributeMultiprocessorCount, dev);
        hipFuncSetAttribute((const void*)fwd_kernel, hipFuncAttributeMaxDynamicSharedMemorySize, LDS_BYTES);
        hipOccupancyMaxActiveBlocksPerMultiprocessor(&per_cu, (const void*)fwd_kernel, 512, LDS_BYTES);
        if (per_cu < 1) { fprintf(stderr, "kernel_launch: occupancy query says %d blocks/CU\n", per_cu); per_cu = 1; }
        (void)hipGetLastError();
        grid = cus;
    }
    if (grid < 0) return;
    hipMemsetAsync((char*)d_ws + WS_CTL, 0, CTL_BYTES, stream);
    Params p{};
    const float** pp = (const float**)&p;
    for (int i = 0; i < 22; ++i) pp[i] = (const float*)d_in[i];
    p.out = (float*)d_out; p.ws = (unsigned char*)d_ws;
#if N_LAUNCH_MODE == 1
    for (int ph = 0; ph < NPHASE; ++ph) { p.ph_lo = ph; p.ph_hi = ph + 1; hipLaunchKernelGGL(fwd_kernel, dim3(grid), dim3(512), LDS_BYTES, stream, p); }
#else
    p.ph_lo = 0; p.ph_hi = NPHASE;
    void* args[] = {&p};
    hipError_t e = hipLaunchCooperativeKernel((const void*)fwd_kernel, dim3(grid), dim3(512), args, LDS_BYTES, stream);
    if (e != hipSuccess) fprintf(stderr, "kernel_launch: cooperative launch failed: %s (grid %d)\n", hipGetErrorString(e), grid);
#endif
}
```

```cpp
#include <hip/hip_runtime.h>
#include <cstdio>
#include <cstdint>

#ifndef N_LAUNCH_MODE
#define N_LAUNCH_MODE 0
#endif

#ifndef PHASE_MASK
#define PHASE_MASK 0x1FFFF
#endif
#define PH_ON(ph) ((PHASE_MASK >> (ph)) & 1)
#ifndef REPEAT_MASK
#define REPEAT_MASK 0
#endif
#define PH_REP(ph) ((REPEAT_MASK >> (ph)) & 1)
#define LAS __attribute__((address_space(3)))
#define GAS __attribute__((address_space(1)))
typedef unsigned short bf16_t;
typedef short bf16x8 __attribute__((ext_vector_type(8)));
typedef short s16x4 __attribute__((ext_vector_type(4)));
typedef float f32x4 __attribute__((ext_vector_type(4)));
typedef float f32x2 __attribute__((ext_vector_type(2)));
typedef int i32x4 __attribute__((ext_vector_type(4)));
typedef unsigned u32x2 __attribute__((ext_vector_type(2)));
typedef unsigned u32x4 __attribute__((ext_vector_type(4)));

constexpr int D = 1024, NB = 4, SEQ = 4096, CTXL = 256;
constexpr int NMAIN = NB * SEQ, NCTX = NB * CTXL, NTOK = NMAIN + NCTX;
constexpr int EVEN_IN = 2304, NEXP = 32, DFF = 1024;
constexpr int QKV_LD = 1536;
constexpr float NORM_EPS = 1e-6f;
constexpr float LOG2E = 1.4426950408889634f;

constexpr size_t MiB = 1ull << 20;
constexpr size_t WS_CTL = 0, CTL_BYTES = 1 * MiB;
constexpr size_t WS_MOD = 1 * MiB;
constexpr size_t WS_M1 = 2 * MiB;
constexpr size_t WS_M2 = WS_M1 + 65536;
constexpr size_t WS_ROPE = WS_M2 + 65536;
constexpr size_t WS_TW = WS_ROPE + 8192;
constexpr size_t WS_WF = 4 * MiB;
constexpr size_t WS_TOPW = 8 * MiB;
constexpr size_t WS_POS = 9 * MiB;
constexpr size_t WS_LIST = 12 * MiB;
constexpr size_t WS_H = 16 * MiB;
constexpr size_t WS_MIX = 52 * MiB;
constexpr size_t WS_XS = 88 * MiB;
constexpr size_t WS_PROJ = 160 * MiB;
constexpr size_t WS_Z = 240 * MiB;
constexpr size_t WS_A1 = 304 * MiB;
constexpr size_t WS_ACT = 368 * MiB;
constexpr size_t WS_Y = 512 * MiB;
constexpr size_t WS_END = 656 * MiB;
constexpr int CW_BAR = 4096;
constexpr int CW_CNT = 8192;

constexpr int LDS_BYTES = 147456;
constexpr int PARAM_OFF = LDS_BYTES - 512;
constexpr int MISC_OFF = LDS_BYTES - 256;
constexpr int A_TILE_B = 32768, B_ROWB = 544, B_TILE_B = 64 * B_ROWB, STAGE_B = A_TILE_B + B_TILE_B;
static_assert(2 * STAGE_B + 1024 <= PARAM_OFF, "LDS");

enum { PH_PREP = 0, PH_NORM1_0, PH_INPROJ_0, PH_ATTN_0, PH_OUTPROJ_0, PH_ROUTE_0, PH_MOE1_0, PH_MOE2_0, PH_COMB_0,
       PH_INPROJ_1, PH_ATTN_1, PH_FST2_1, PH_OUTPROJ_1, PH_ROUTE_1, PH_MOE1_1, PH_MOE2_1, PH_FINAL, NPHASE };

struct Params {
    const float *x, *c, *ctx, *c_ctx, *ada_w, *ada_b, *norm_mix, *norm_ffn, *even_w_in, *even_w_out, *even_conv_w, *even_sink,
                *odd_w_in, *odd_w_out, *odd_rpb, *router_w, *router_b, *moe_w_gu, *moe_b_gu, *moe_w_dn, *moe_b_dn, *final_norm;
    float* out; unsigned char* ws; int ph_lo, ph_hi;
};

__device__ __forceinline__ unsigned pk2(float lo, float hi) { unsigned r; asm("v_cvt_pk_bf16_f32 %0, %1, %2" : "=v"(r) : "v"(lo), "v"(hi)); return r; }
__device__ __forceinline__ float bflo(unsigned u) { return __builtin_bit_cast(float, u << 16); }
__device__ __forceinline__ float bfhi(unsigned u) { return __builtin_bit_cast(float, u & 0xffff0000u); }
__device__ __forceinline__ float wave_sum(float v) {
#pragma unroll
    for (int o = 1; o < 64; o <<= 1) v += __shfl_xor(v, o);
    return v;
}
__device__ __forceinline__ float fexp2(float x) { return __builtin_amdgcn_exp2f(x); }

#define XB_TMO      128
#define XB_XCNT(j)  (256  + 64 * (j))
#define XB_XSUB(j)  (1280 + 64 * (j))
#define XB_XGEN(j)  (2304 + 64 * (j))
#define XB_TOP      3328
#define XB_TOPGEN   3392
#define XB_SPIN_CAP (1u << 22)
__device__ __forceinline__ unsigned xb_ld(unsigned* p)              { return __hip_atomic_load(p, __ATOMIC_RELAXED, __HIP_MEMORY_SCOPE_AGENT); }
__device__ __forceinline__ unsigned xb_add(unsigned* p, unsigned v) { return __hip_atomic_fetch_add(p, v, __ATOMIC_RELAXED, __HIP_MEMORY_SCOPE_AGENT); }
__device__ __forceinline__ unsigned xb_xcc_id() { return (unsigned)__builtin_amdgcn_s_getreg((3 << 11) | 20) & 0xFu; }
#define XB_SPIN(cond, bar) do { unsigned _sp = 0; while (cond) { __builtin_amdgcn_s_sleep(1); \
    if ((++_sp & 255u) == 0u) { if (xb_ld(&(bar)[XB_TMO])) break; if (_sp > XB_SPIN_CAP) { atomicAdd(&(bar)[XB_TMO], 1u); break; } } } } while (0)
struct XcdBarrier { unsigned* bar; unsigned x; volatile LAS unsigned* st; };
__device__ __forceinline__ XcdBarrier xcd_barrier_post(unsigned* bar, volatile LAS unsigned* st) {
    XcdBarrier b; b.bar = bar; b.x = xb_xcc_id(); b.st = st;
    if (threadIdx.x == 0) (void)xb_add(&bar[XB_XCNT(b.x)], 1u);
    return b;
}
__device__ __forceinline__ void xcd_barrier_complete(unsigned* bar, unsigned x, unsigned& nloc, unsigned& nx) {
    const unsigned G = gridDim.x * gridDim.y * gridDim.z;
    unsigned sum, cnt, mine, sp = 0u;
    for (;;) {
        sum = 0u; cnt = 0u; mine = 0u;
#pragma unroll
        for (unsigned j = 0; j < 16; ++j) { const unsigned c = xb_ld(&bar[XB_XCNT(j)]); sum += c; cnt += (c > 0u) ? 1u : 0u; mine = (j == x) ? c : mine; }
        if (sum == G) break;
        __builtin_amdgcn_s_sleep(1);
        if ((++sp & 255u) == 0u) { if (xb_ld(&bar[XB_TMO])) break; if (sp > XB_SPIN_CAP) { atomicAdd(&bar[XB_TMO], 1u); break; } }
    }
    nloc = mine > 0u ? mine : 1u; nx = cnt > 0u ? cnt : 1u;
}
__device__ __forceinline__ void xcd_barrier(const XcdBarrier& b) {
    asm volatile("s_waitcnt vmcnt(0)" ::: "memory");
    __syncthreads();
    if (threadIdx.x == 0) {
        unsigned* bar = b.bar;
        __builtin_amdgcn_s_waitcnt(0);
        unsigned nloc = b.st[0], nx = b.st[1];
        if (nloc == 0u) { xcd_barrier_complete(bar, b.x, nloc, nx); b.st[0] = nloc; b.st[1] = nx; }
        const unsigned old = xb_add(&bar[XB_XSUB(b.x)], 1u);
        const unsigned gen = old / nloc;
        if (old + 1u == (gen + 1u) * nloc) {
            __builtin_amdgcn_fence(__ATOMIC_RELEASE, "agent");
            asm volatile("s_waitcnt vmcnt(0)" ::: "memory");
            const unsigned og = xb_add(&bar[XB_TOP], 1u);
            const unsigned tg = og / nx;
            if (og + 1u == (tg + 1u) * nx) xb_add(&bar[XB_TOPGEN], 1u);
            else XB_SPIN(xb_ld(&bar[XB_TOPGEN]) == tg, bar);
            __builtin_amdgcn_fence(__ATOMIC_ACQUIRE, "agent");
            xb_add(&bar[XB_XGEN(b.x)], 1u);
            asm volatile("s_waitcnt vmcnt(0)" ::: "memory");
        } else {
            XB_SPIN(xb_ld(&bar[XB_XGEN(b.x)]) == gen, bar);
            __builtin_amdgcn_fence(__ATOMIC_ACQUIRE, "agent");
            asm volatile("s_waitcnt vmcnt(0)" ::: "memory");
        }
    }
    __syncthreads();
}

struct GA { const bf16_t* base; unsigned off[4]; };
struct GB { const float* ptr; unsigned ldb; unsigned lcol; unsigned woff; };
__device__ __forceinline__ int a_piece_row(int wid, int lane, int i) { const int sb = lane * 16, swz = sb ^ (((sb >> 9) & 1) << 5); return ((wid >> 1) + 4 * i) * 16 + (swz >> 6); }
__device__ __forceinline__ int a_piece_col(int wid, int lane) { const int sb = lane * 16, swz = sb ^ (((sb >> 9) & 1) << 5); return (wid & 1) * 32 + ((swz & 63) >> 1); }

__device__ __forceinline__ void gemm_tile(LAS unsigned char* lds, const GA& ga, const GB& gb, const int nt_, f32x4 (&acc)[8][4], const int wid, const int lane) {
    int nt = nt_; asm volatile("" : "+s"(nt));
    const int wr = wid >> 2, wc = wid & 3, fr = lane & 15, fq = lane >> 4;
    const unsigned a_w = (unsigned)(wid * 1024 + lane * 16);
    const unsigned b_w = (unsigned)(A_TILE_B + ((wid >> 2) * 32 + 4 * (wid & 3)) * B_ROWB) + gb.woff;
    const unsigned a_r = (unsigned)(wr * 16384 + ((fr * 64 + fq * 16) ^ ((fr >> 3) << 5)));
    const unsigned b_r = (unsigned)(A_TILE_B + (4 * fq + (fr >> 2)) * B_ROWB + (wc * 64 + (fr & 3) * 4) * 2);
    f32x4 sb[8];
    const unsigned ldb4 = gb.ldb * 4u; const unsigned lcolb = gb.lcol * 4u; unsigned aoff[4];
    u32x4 rau; { const unsigned long long ab = (unsigned long long)ga.base; rau.x = __builtin_amdgcn_readfirstlane((unsigned)ab); rau.y = __builtin_amdgcn_readfirstlane((unsigned)(ab >> 32)) & 0xffffu; rau.z = 0x7fffffffu; rau.w = 0x00020000u; }
    const unsigned ldsa = (unsigned)(__UINTPTR_TYPE__)lds + (unsigned)(wid * 1024);
    const __amdgpu_buffer_rsrc_t rb = __builtin_amdgcn_make_buffer_rsrc((void*)gb.ptr, 0, 0x7fffffff, 0x00020000);
#pragma unroll
    for (int i = 0; i < 4; ++i) aoff[i] = ga.off[i] * 2u;
#pragma unroll
    for (int m = 0; m < 8; ++m)
#pragma unroll
        for (int n = 0; n < 4; ++n) acc[m][n] = (f32x4){0.f, 0.f, 0.f, 0.f};
#define G_GLDS_A(buf, kt) do { _Pragma("unroll") for (int i = 0; i < 4; ++i) { unsigned keep_; \
        asm volatile("s_mov_b32 %0, m0\n\ts_mov_b32 m0, %3\n\ts_nop 0\n\tbuffer_load_dwordx4 %1, %2, %4 offen lds\n\ts_mov_b32 m0, %0" \
            : "=&s"(keep_) : "v"(aoff[i]), "s"(rau), "s"(ldsa + (buf) + (unsigned)(i * 8192)), "s"((unsigned)((kt) * 128)) : "memory"); } } while (0)
#define G_ISSUE_BH(kt, h) do { \
        _Pragma("unroll") for (int i = 4 * (h); i < 4 * (h) + 4; ++i) sb[i] = __builtin_bit_cast(f32x4, __builtin_amdgcn_raw_buffer_load_b128(rb, (int)lcolb, (int)(((unsigned)(kt) * 64u + i) * ldb4), 0)); \
        __builtin_amdgcn_sched_barrier(0); } while (0)
#define G_WRITE_BH(buf, h) do { \
        _Pragma("unroll") for (int i = 4 * (h); i < 4 * (h) + 4; ++i) { u32x2 w; w.x = pk2(sb[i][0], sb[i][1]); w.y = pk2(sb[i][2], sb[i][3]); \
            *(LAS u32x2*)(lds + (buf) + b_w + (16 * (i >> 2) + (i & 3)) * B_ROWB) = w; } __builtin_amdgcn_sched_barrier(0); } while (0)
#define G_ISSUE_B(kt) do { G_ISSUE_BH(kt, 0); G_ISSUE_BH(kt, 1); } while (0)
#define G_WRITE_B(buf) do { G_WRITE_BH(buf, 0); G_WRITE_BH(buf, 1); } while (0)
#define G_KSTEP(buf, ks) do { bf16x8 Bf[4]; \
        _Pragma("unroll") for (int n = 0; n < 4; ++n) { \
            const s16x4 lo = __builtin_amdgcn_ds_read_tr16_b64_v4i16((LAS s16x4*)(lds + (buf) + b_r + (ks) * 32 * B_ROWB + n * 32)); \
            const s16x4 hi = __builtin_amdgcn_ds_read_tr16_b64_v4i16((LAS s16x4*)(lds + (buf) + b_r + (ks) * 32 * B_ROWB + 16 * B_ROWB + n * 32)); \
            Bf[n] = (bf16x8){lo[0], lo[1], lo[2], lo[3], hi[0], hi[1], hi[2], hi[3]}; } \
        _Pragma("unroll") for (int mh = 0; mh < 2; ++mh) { bf16x8 At[4]; \
            _Pragma("unroll") for (int m = 0; m < 4; ++m) At[m] = *(const LAS bf16x8*)(lds + (buf) + a_r + (mh * 4 + m) * 2048 + (ks) * 1024); \
            _Pragma("unroll") for (int m = 0; m < 4; ++m) _Pragma("unroll") for (int n = 0; n < 4; ++n) \
                acc[mh * 4 + m][n] = __builtin_amdgcn_mfma_f32_16x16x32_bf16(Bf[n], At[m], acc[mh * 4 + m][n], 0, 0, 0); } \
        __builtin_amdgcn_sched_barrier(0); } while (0)
    { unsigned b0 = 0; asm volatile("" : "+s"(b0));
      G_GLDS_A(b0, 0); G_ISSUE_B(0); G_WRITE_B(b0); if (nt > 1) G_ISSUE_B(1); }
    asm volatile("s_waitcnt vmcnt(8)" ::: "memory");
    __syncthreads();
    for (int t = 0; t < nt; ++t) {
        unsigned bc = (unsigned)(t & 1) * STAGE_B, bn = (unsigned)((t & 1) ^ 1) * STAGE_B; asm volatile("" : "+s"(bc), "+s"(bn));
        const bool w1 = t + 1 < nt, i2 = t + 2 < nt;
        if (w1) G_GLDS_A(bn, t + 1);
        G_KSTEP(bc, 0);
        if (w1) G_WRITE_BH(bn, 0);
        if (i2) G_ISSUE_BH(t + 2, 0);
        G_KSTEP(bc, 1);
        if (w1) G_WRITE_BH(bn, 1);
        if (i2) { G_ISSUE_BH(t + 2, 1); asm volatile("s_waitcnt vmcnt(8)" ::: "memory"); }
        else asm volatile("s_waitcnt vmcnt(0)" ::: "memory");
        asm volatile("s_waitcnt lgkmcnt(0)" ::: "memory");
        __builtin_amdgcn_s_barrier();
    }
#undef G_GLDS_A
#undef G_ISSUE_B
#undef G_ISSUE_BH
#undef G_WRITE_BH
#undef G_WRITE_B
#undef G_KSTEP
}


struct XOrder {
    int c1, step, cur;
    __device__ __forceinline__ void init(int T, int G, int bid) {
        if ((G & 7) == 0) { const int x = bid & 7; cur = (int)(((long)x * T) >> 3) + (bid >> 3); c1 = (int)(((long)(x + 1) * T) >> 3); step = G >> 3; }
        else { cur = bid; c1 = T; step = G; }
    }
    __device__ __forceinline__ bool next(int& L) { if (cur >= c1) return false; L = cur; cur += step; return true; }
};
__device__ __forceinline__ void dense_tile(int L, int nM, int nN, int& pm, int& pn) { const int per = 8 * nN, g = L / per, w = L - g * per, fm = g * 8, gs = (nM - fm) < 8 ? (nM - fm) : 8; pn = w / gs; pm = fm + w - pn * gs; }

struct Frame { LAS unsigned char* lds; int tid, lane, wid, bid, G; unsigned char* ws; };
__device__ __forceinline__ const void* ldp(const Frame& F, int off) {
    const u32x2 v = *(const volatile LAS u32x2*)(F.lds + PARAM_OFF + off);
    const unsigned lo = __builtin_amdgcn_readfirstlane(v.x), hi = __builtin_amdgcn_readfirstlane(v.y);
    return (const void*)(((unsigned long long)hi << 32) | lo);
}
#define PP(f) ((const float*)ldp(F, (int)__builtin_offsetof(Params, f)))
#define F_mod ((float*)(F.ws + WS_MOD))
#define F_M1 ((bf16_t*)(F.ws + WS_M1))
#define F_M2 ((bf16_t*)(F.ws + WS_M2))
#define F_ROPE ((f32x2*)(F.ws + WS_ROPE))
#define F_TW ((f32x2*)(F.ws + WS_TW))
#define F_WF ((float*)(F.ws + WS_WF))
#define F_TOPW ((float*)(F.ws + WS_TOPW))
#define F_POS ((int*)(F.ws + WS_POS))
#define F_LIST ((int*)(F.ws + WS_LIST))
#define F_H ((bf16_t*)(F.ws + WS_H))
#define F_MIX ((bf16_t*)(F.ws + WS_MIX))
#define F_XS ((float*)(F.ws + WS_XS))
#define F_PROJ ((bf16_t*)(F.ws + WS_PROJ))
#define F_Z ((float*)(F.ws + WS_Z))
#define F_A1 ((float*)(F.ws + WS_A1))
#define F_ACT ((bf16_t*)(F.ws + WS_ACT))
#define F_Y ((bf16_t*)(F.ws + WS_Y))
#define F_cnt ((unsigned*)(F.ws + WS_CTL) + CW_CNT)

__device__ __forceinline__ const float* modp(const Frame& F, int l, int r, int which) { return F_mod + ((size_t)(l * 5 + r)) * 6144 + which * 1024; }
__device__ __forceinline__ int mod_row(int row) { return row < NMAIN ? (row >> 12) : 4; }

__device__ __forceinline__ float row_rstd(const f32x4 (&v)[4]) {
    float s = 0.f;
#pragma unroll
    for (int j = 0; j < 4; ++j) s += (v[j][0] * v[j][0] + v[j][1] * v[j][1]) + (v[j][2] * v[j][2] + v[j][3] * v[j][3]);
    return __builtin_amdgcn_rsqf(wave_sum(s) * (1.f / D) + NORM_EPS);
}
__device__ __forceinline__ void norm_mod_store(const f32x4 (&v)[4], float rstd, const float* gam, const float* sc, const float* sh, bf16_t* dst, int lane, f32x4 (*keep)[4] = nullptr) {
#pragma unroll
    for (int j = 0; j < 4; ++j) {
        const int c = 4 * lane + 256 * j;
        const f32x4 g = *(const f32x4*)(gam + c), s1 = *(const f32x4*)(sc + c), s0 = *(const f32x4*)(sh + c);
        f32x4 h;
#pragma unroll
        for (int i = 0; i < 4; ++i) h[i] = v[j][i] * rstd * g[i] * (1.f + s1[i]) + s0[i];
        u32x2 w; w.x = pk2(h[0], h[1]); w.y = pk2(h[2], h[3]);
        *(u32x2*)(dst + c) = w;
        if (keep) (*keep)[j] = h;
    }
}

__device__ __forceinline__ void phase_prep(Frame& F) {
    LAS float* sil = (LAS float*)F.lds;
    LAS float* red = (LAS float*)(F.lds + 20480);
    LAS float* ct = (LAS float*)(F.lds + 32768);
    for (int idx = F.tid; idx < 5120; idx += 512) { const int r = idx >> 10, k = idx & 1023; const float v = r < 4 ? PP(c)[r * 1024 + k] : PP(c_ctx)[k]; sil[idx] = v / (1.f + __expf(-v)); }
    if (F.tid < 128) ct[F.tid] = cospif((float)F.tid / 64.f);
    __syncthreads();
    constexpr int N_ADA = 192, N_CONST = 8, N_FOLD = 256;
    for (int it = F.bid; it < N_ADA + N_CONST + N_FOLD; it += F.G) {
        if (it < N_ADA) {
            const int l = it / 96, j0 = (it % 96) * 64, col = j0 + F.lane;
            const float* w = PP(ada_w) + ((size_t)l * 1024 + F.wid * 128) * 6144 + col;
            float a[5] = {0.f, 0.f, 0.f, 0.f, 0.f};
#pragma unroll 8
            for (int k = 0; k < 128; ++k) { const float wv = w[(size_t)k * 6144];
#pragma unroll
                for (int r = 0; r < 5; ++r) a[r] += sil[r * 1024 + F.wid * 128 + k] * wv; }
#pragma unroll
            for (int r = 0; r < 5; ++r) red[(F.wid * 5 + r) * 64 + F.lane] = a[r];
            __syncthreads();
            if (F.tid < 320) { const int r = F.tid >> 6, ln = F.tid & 63; float s = 0.f;
#pragma unroll
                for (int w8 = 0; w8 < 8; ++w8) s += red[(w8 * 5 + r) * 64 + ln];
                F_mod[(size_t)(l * 5 + r) * 6144 + j0 + ln] = s + PP(ada_b)[l * 6144 + j0 + ln]; }
            __syncthreads();
        } else if (it < N_ADA + N_CONST) {
            const int gt = (it - N_ADA) * 512 + F.tid;
            for (int e = gt; e < 32768; e += 4096) {
                const int row = e >> 7, kk = e & 127;
                float v1 = 0.f, v2 = 0.f;
                if (row < 128) { const int ro = row >> 6, k1 = row & 63, n1 = kk >> 1, ri = kk & 1; const float ph = (float)((n1 * k1) & 63) / 32.f; const float cs = cospif(ph), sn = sinpif(ph);
                    v1 = (ro == ri) ? cs : (ro == 0 ? sn : -sn); }
                if (row < 64) { const int ro = kk >> 6, n2 = kk & 63; const float ph = (float)((row * n2) & 63) / 32.f; v2 = ro == 0 ? cospif(ph) : sinpif(ph); }
                F_M1[e] = (bf16_t)(pk2(v1, 0.f) & 0xffffu); F_M2[e] = (bf16_t)(pk2(v2, 0.f) & 0xffffu);
            }
            if (gt < 1024) { const int pos = gt >> 4, f = gt & 15; const double ang = (double)pos * pow(10000.0, -(double)f / 16.0); F_ROPE[gt] = (f32x2){(float)cos(ang), (float)sin(ang)}; }
            { const float ph = (float)gt / 2048.f; F_TW[gt] = (f32x2){cospif(ph), sinpif(ph)}; }
        } else {
            const int fi = it - N_ADA - N_CONST, rc = fi >> 2, g = fi & 3, half = F.tid >> 8, j = F.tid & 255, jj = j & 127;
            for (int i2 = 0; i2 < 8; ++i2) {
                const int row = rc * 16 + i2 * 2 + half;
                const float* wr_ = PP(odd_w_in) + (size_t)row * 2048 + 1536 + g * 128;
                float s = 0.f;
                if (j < 128) { for (int cc = 0; cc < 128; ++cc) s += wr_[cc] * ct[(cc * jj) & 127]; }
                else { for (int cc = 0; cc < 128; ++cc) s -= wr_[cc] * ct[((cc * jj) - 32) & 127]; }
                F_WF[(size_t)row * 1024 + g * 256 + j] = s;
            }
        }
    }
}

__device__ __forceinline__ void phase_norm1_l0(Frame& F) {
    const int gw = F.bid * 8 + F.wid, NGW = F.G * 8;
    for (int row = gw; row < NTOK; row += NGW) {
        const float* src = row < NMAIN ? PP(x) + (size_t)row * D : PP(ctx) + (size_t)(row - NMAIN) * D;
        f32x4 v[4];
#pragma unroll
        for (int j = 0; j < 4; ++j) v[j] = *(const f32x4*)(src + 4 * F.lane + 256 * j);
        const float rstd = row_rstd(v); const int r = mod_row(row);
        norm_mod_store(v, rstd, PP(norm_mix), modp(F, 0, r, 1), modp(F, 0, r, 0), F_H + (size_t)row * D, F.lane);
    }
}

#define EPI_ROW(pm, m) ((pm) * 256 + wr * 128 + (m) * 16 + fr)
__device__ __forceinline__ void phase_inproj_l0(Frame& F) {
    const int wid = F.wid, lane = F.lane, wr = wid >> 2, wc = wid & 3, fr = lane & 15, fq = lane >> 4;
    constexpr int nM = NTOK / 256, nN = EVEN_IN / 256;
    f32x4 acc[8][4];
    XOrder xo; xo.init(nM * nN, F.G, F.bid);
    for (int L; xo.next(L);) {
        int pm, pn; dense_tile(L, nM, nN, pm, pn);
        GA ga; ga.base = F_H; { const int C = a_piece_col(wid, lane);
#pragma unroll
            for (int i = 0; i < 4; ++i) ga.off[i] = (unsigned)((pm * 256 + a_piece_row(wid, lane, i)) * D + C); }
        GB gb; gb.ptr = PP(even_w_in) + (size_t)(wid * 8) * EVEN_IN + pn * 256; gb.lcol = 4 * lane; gb.ldb = EVEN_IN; gb.woff = 8 * lane;
        gemm_tile(F.lds, ga, gb, D / 64, acc, wid, lane);
        const int colb = pn * 256 + wc * 64;
        const bool rope = (colb < 640) && (pm < NMAIN / 256);
#pragma unroll
        for (int m = 0; m < 8; ++m) {
            const int row = EPI_ROW(pm, m);
            if (rope) {
                const int tt = row & (SEQ - 1), gr = tt >> 6, gc = tt & 63;
#pragma unroll
                for (int n = 0; n < 2; ++n) {
                    const int pos = n == 0 ? gr : gc;
#pragma unroll
                    for (int j = 0; j < 4; ++j) { const f32x2 cs = F_ROPE[pos * 16 + 4 * fq + j]; const float x1 = acc[m][n][j], x2 = acc[m][n + 2][j];
                        acc[m][n][j] = x1 * cs.x - x2 * cs.y; acc[m][n + 2][j] = x2 * cs.x + x1 * cs.y; }
                }
            }
#pragma unroll
            for (int n = 0; n < 4; ++n) { u32x2 w; w.x = pk2(acc[m][n][0], acc[m][n][1]); w.y = pk2(acc[m][n][2], acc[m][n][3]);
                *(u32x2*)(F_PROJ + (size_t)row * EVEN_IN + colb + n * 16 + 4 * fq) = w; }
        }
    }
}

__device__ __forceinline__ void phase_outproj(Frame& F, const int layer) {
    const int wid = F.wid, lane = F.lane, wr = wid >> 2, wc = wid & 3, fr = lane & 15, fq = lane >> 4;
    const int nM = (layer == 0 ? NTOK : NMAIN) / 256, nN = 4;
    const float* W = layer == 0 ? PP(even_w_out) : PP(odd_w_out);
    f32x4 acc[8][4];
    XOrder xo; xo.init(nM * nN, F.G, F.bid);
    for (int L; xo.next(L);) {
        int pm, pn; dense_tile(L, nM, nN, pm, pn);
        GA ga; ga.base = F_MIX; { const int C = a_piece_col(wid, lane);
#pragma unroll
            for (int i = 0; i < 4; ++i) ga.off[i] = (unsigned)((pm * 256 + a_piece_row(wid, lane, i)) * D + C); }
        GB gb; gb.ptr = W + (size_t)(wid * 8) * D + pn * 256; gb.lcol = 4 * lane; gb.ldb = D; gb.woff = 8 * lane;
        gemm_tile(F.lds, ga, gb, D / 64, acc, wid, lane);
        const int colb = pn * 256 + wc * 64;
#pragma unroll
        for (int m = 0; m < 8; ++m) {
            const int row = EPI_ROW(pm, m); const int r = mod_row(row);
            const float* xin = layer == 0 ? (row < NMAIN ? PP(x) + (size_t)row * D : PP(ctx) + (size_t)(row - NMAIN) * D) : F_XS + (size_t)row * D;
            const float* g1 = modp(F, layer, r, 2);
#pragma unroll
            for (int n = 0; n < 4; ++n) { const int c = colb + n * 16 + 4 * fq; const f32x4 xv = *(const f32x4*)(xin + c), gv = *(const f32x4*)(g1 + c);
                f32x4 o;
#pragma unroll
                for (int j = 0; j < 4; ++j) o[j] = xv[j] + gv[j] * acc[m][n][j];
                *(f32x4*)(F_XS + (size_t)row * D + c) = o; }
        }
    }
}

constexpr int QT = 2;
struct AttnSt { f32x4 o[4][QT]; float m[QT], l[QT]; };
#define V_ROWB 160
__device__ __forceinline__ void v_stage(LAS unsigned char* vl, const bf16_t* vsrc, int ld, int lane) {
    i32x4 t[4];
#pragma unroll
    for (int i = 0; i < 4; ++i) t[i] = *(const i32x4*)(vsrc + (size_t)((lane >> 3) + 8 * i) * ld + (lane & 7) * 8);
#pragma unroll
    for (int i = 0; i < 4; ++i) *(LAS i32x4*)(vl + ((lane >> 3) + 8 * i) * V_ROWB + (lane & 7) * 16) = t[i];
}
#define ATTN_STEP(ksrc, kld, vsrc, vld, SCALE, BIAS) do { \
    bf16x8 kf[2][2]; \
    _Pragma("unroll") for (int kt = 0; kt < 2; ++kt) _Pragma("unroll") for (int ks = 0; ks < 2; ++ks) \
        kf[kt][ks] = *(const bf16x8*)((ksrc) + (size_t)(kt * 16 + fr) * (kld) + ks * 32 + 8 * fq); \
    v_stage(vl, (vsrc), (vld), lane); \
    bf16x8 vf[4]; \
    _Pragma("unroll") for (int dt = 0; dt < 4; ++dt) { \
        const s16x4 lo = __builtin_amdgcn_ds_read_tr16_b64_v4i16((LAS s16x4*)(vl + (4 * fq + (fr >> 2)) * V_ROWB + (dt * 16 + (fr & 3) * 4) * 2)); \
        const s16x4 hi = __builtin_amdgcn_ds_read_tr16_b64_v4i16((LAS s16x4*)(vl + (16 + 4 * fq + (fr >> 2)) * V_ROWB + (dt * 16 + (fr & 3) * 4) * 2)); \
        vf[dt] = (bf16x8){lo[0], lo[1], lo[2], lo[3], hi[0], hi[1], hi[2], hi[3]}; } \
    _Pragma("unroll") for (int qt = 0; qt < QT; ++qt) { \
        f32x4 s[2]; \
        _Pragma("unroll") for (int kt = 0; kt < 2; ++kt) { s[kt] = (f32x4){0.f, 0.f, 0.f, 0.f}; \
            _Pragma("unroll") for (int ks = 0; ks < 2; ++ks) s[kt] = __builtin_amdgcn_mfma_f32_16x16x32_bf16(kf[kt][ks], qf[qt][ks], s[kt], 0, 0, 0); } \
        float mx = -INFINITY; \
        _Pragma("unroll") for (int kt = 0; kt < 2; ++kt) _Pragma("unroll") for (int j = 0; j < 4; ++j) { const float tv = s[kt][j] * (SCALE) + BIAS(qt, kt, j); s[kt][j] = tv; mx = fmaxf(mx, tv); } \
        mx = fmaxf(mx, __shfl_xor(mx, 16)); mx = fmaxf(mx, __shfl_xor(mx, 32)); \
        const float mn = fmaxf(st.m[qt], mx), al = fexp2(st.m[qt] - mn); st.m[qt] = mn; \
        float ps = 0.f; \
        _Pragma("unroll") for (int kt = 0; kt < 2; ++kt) _Pragma("unroll") for (int j = 0; j < 4; ++j) { const float pv = fexp2(s[kt][j] - mn); s[kt][j] = pv; ps += pv; } \
        st.l[qt] = st.l[qt] * al + ps; \
        const unsigned w0 = pk2(s[0][0], s[0][1]), w1 = pk2(s[0][2], s[0][3]), w2 = pk2(s[1][0], s[1][1]), w3 = pk2(s[1][2], s[1][3]); \
        const bf16x8 pf = __builtin_bit_cast(bf16x8, ((u32x4){w0, w1, w2, w3})); \
        _Pragma("unroll") for (int dt = 0; dt < 4; ++dt) st.o[dt][qt] = __builtin_amdgcn_mfma_f32_16x16x32_bf16(vf[dt], pf, st.o[dt][qt] * al, 0, 0, 0); } \
    } while (0)

__device__ __forceinline__ void attn_store(AttnSt& st, bf16_t* dst  , int dld, int fr, int fq) {
#pragma unroll
    for (int qt = 0; qt < QT; ++qt) {
        float l = st.l[qt]; l += __shfl_xor(l, 16); l += __shfl_xor(l, 32);
        const float inv = 1.f / l;
#pragma unroll
        for (int dt = 0; dt < 4; ++dt) { const f32x4 o = st.o[dt][qt] * inv; u32x2 w; w.x = pk2(o[0], o[1]); w.y = pk2(o[2], o[3]);
            *(u32x2*)(dst + (size_t)(qt * 16 + fr) * dld + dt * 16 + 4 * fq) = w; }
    }
}

__device__ __forceinline__ void phase_attn_l0(Frame& F) {
    const int wid = F.wid, lane = F.lane, fr = lane & 15, fq = lane >> 4;
    LAS unsigned char* vl = F.lds + wid * 8192;
    constexpr int N_WIN = 256, N_CTXA = 16, N_CONV = NTOK / 64;
    const float SC = 0.125f * LOG2E;
    for (int it = F.bid; it < N_WIN + N_CTXA + N_CONV; it += F.G) {
        if (it < N_WIN + N_CTXA) {
            const bool isctx = it >= N_WIN;
            int b, kvh, qb;
            if (!isctx) { b = it >> 6; kvh = (it >> 5) & 1; qb = it & 31; } else { const int c = it - N_WIN; b = c >> 2; kvh = (c >> 1) & 1; qb = c & 1; }
            const int g = wid >> 1, h = kvh * 4 + g;
            for (int qh = 0; qh < 4 / QT; ++qh) {
            const int qq0 = (wid & 1) * 64 + qh * (16 * QT);
            const int qrow0 = (isctx ? NMAIN + b * CTXL : b * SEQ) + qb * 128 + qq0;
            bf16x8 qf[QT][2];
#pragma unroll
            for (int qt = 0; qt < QT; ++qt)
#pragma unroll
                for (int ks = 0; ks < 2; ++ks) qf[qt][ks] = *(const bf16x8*)(F_PROJ + (size_t)(qrow0 + qt * 16 + fr) * EVEN_IN + h * 64 + ks * 32 + 8 * fq);
            AttnSt st;
            const float sink = PP(even_sink)[h] * LOG2E;
#pragma unroll
            for (int qt = 0; qt < QT; ++qt) { st.m[qt] = sink; st.l[qt] = (fq == 0) ? 1.f : 0.f;
#pragma unroll
                for (int dt = 0; dt < 4; ++dt) st.o[dt][qt] = (f32x4){0.f, 0.f, 0.f, 0.f}; }
            const int kcol = 512 + kvh * 64, vcol = 640 + kvh * 64;
            for (int ch = isctx ? 3 : 0; ch < 5; ++ch) {
                int krow0;
                if (ch < 3) { const int kb = qb - 1 + ch; if (kb < 0 || kb >= SEQ / 128) continue; krow0 = b * SEQ + kb * 128; } else krow0 = NMAIN + b * CTXL + (ch - 3) * 128;
                for (int s32 = 0; s32 < 4; ++s32) {
                    const bf16_t* kp = F_PROJ + (size_t)(krow0 + s32 * 32) * EVEN_IN + kcol;
                    const bf16_t* vp = F_PROJ + (size_t)(krow0 + s32 * 32) * EVEN_IN + vcol;
                    if (ch == 0) {
#define BIAS_PREV(qt, kt, j) ((s32 * 32 + kt * 16 + 4 * fq + j) >= (qq0 + qt * 16 + fr) ? 0.f : -INFINITY)
                        ATTN_STEP(kp, EVEN_IN, vp, EVEN_IN, SC, BIAS_PREV);
                    } else if (ch == 2) {
#define BIAS_NEXT(qt, kt, j) ((s32 * 32 + kt * 16 + 4 * fq + j) <= (qq0 + qt * 16 + fr) ? 0.f : -INFINITY)
                        ATTN_STEP(kp, EVEN_IN, vp, EVEN_IN, SC, BIAS_NEXT);
                    } else {
#define BIAS_NONE(qt, kt, j) 0.f
                        ATTN_STEP(kp, EVEN_IN, vp, EVEN_IN, SC, BIAS_NONE);
                    }
                }
            }
            attn_store(st, F_MIX + (size_t)qrow0 * D + h * 64, D, fr, fq);
            }
        } else {
            const int ci = it - N_WIN - N_CTXA, c4 = (F.tid & 127) * 4, r0 = ci * 64 + (F.tid >> 7) * 16;
            const f32x4 w0 = *(const f32x4*)(PP(even_conv_w) + c4), w1 = *(const f32x4*)(PP(even_conv_w) + 512 + c4), w2 = *(const f32x4*)(PP(even_conv_w) + 1024 + c4);
#define LOADZ(dst, row_) do { const u32x2 gc_ = *(const u32x2*)(F_PROJ + (size_t)(row_) * EVEN_IN + 1280 + c4), uu_ = *(const u32x2*)(F_PROJ + (size_t)(row_) * EVEN_IN + 1792 + c4); \
                dst = (f32x4){bflo(gc_.x) * bflo(uu_.x), bfhi(gc_.x) * bfhi(uu_.x), bflo(gc_.y) * bflo(uu_.y), bfhi(gc_.y) * bfhi(uu_.y)}; } while (0)
            const int seqmask = r0 < NMAIN ? (SEQ - 1) : (CTXL - 1);
            f32x4 zp = (f32x4){0.f, 0.f, 0.f, 0.f}, zc, zn;
            if ((r0 & seqmask) != 0) LOADZ(zp, r0 - 1);
            LOADZ(zc, r0);
            for (int i = 0; i < 16; ++i) {
                const int row = r0 + i;
                zn = (f32x4){0.f, 0.f, 0.f, 0.f}; if ((row & seqmask) != seqmask) LOADZ(zn, row + 1);
                const u32x2 gb = *(const u32x2*)(F_PROJ + (size_t)row * EVEN_IN + 768 + c4);
                const f32x4 y = zp * w0 + zc * w1 + zn * w2;
                u32x2 w; w.x = pk2(bflo(gb.x) * y[0], bfhi(gb.x) * y[1]); w.y = pk2(bflo(gb.y) * y[2], bfhi(gb.y) * y[3]);
                *(u32x2*)(F_MIX + (size_t)row * D + 512 + c4) = w;
                zp = zc; zc = zn;
            }
        }
    }
}

constexpr int RW_LD = 1028;
__device__ __forceinline__ void phase_route(Frame& F, const int layer) {
    const int nrows = layer == 0 ? NTOK : NMAIN;
    LAS float* rwT = (LAS float*)F.lds;
    LAS int* cntL = (LAS int*)(F.lds + 32 * RW_LD * 4);
    LAS int* baseL = cntL + 32;
    LAS int* selE = baseL + 32;
    LAS int* selR = selE + 288;
    const float* rw = PP(router_w) + (size_t)layer * D * NEXP;
    for (int idx = F.tid; idx < D * NEXP; idx += 512) rwT[(idx & 31) * RW_LD + (idx >> 5)] = rw[idx];
    if (F.tid < 32) cntL[F.tid] = 0;
    __syncthreads();
    const int lane = F.lane, gw = F.bid * 8 + F.wid, NGW = F.G * 8;
    const float* gam = PP(norm_ffn) + layer * D;
    int slot = F.wid;
    for (int row = gw; row < nrows; row += NGW, slot += 8) {
        f32x4 v[4], h[4];
#pragma unroll
        for (int j = 0; j < 4; ++j) v[j] = *(const f32x4*)(F_XS + (size_t)row * D + 4 * lane + 256 * j);
        const float rstd = row_rstd(v); const int r = mod_row(row);
        norm_mod_store(v, rstd, gam, modp(F, layer, r, 4), modp(F, layer, r, 3), F_H + (size_t)row * D, lane, &h);
        float pe[32];
#pragma unroll
        for (int e = 0; e < 32; ++e) { float s = 0.f;
#pragma unroll
            for (int j = 0; j < 4; ++j) { const f32x4 w = *(const LAS f32x4*)(rwT + e * RW_LD + 4 * lane + 256 * j); s += (h[j][0] * w[0] + h[j][1] * w[1]) + (h[j][2] * w[2] + h[j][3] * w[3]); }
            pe[e] = s; }
        float q16[16], q8[8], q4[4], q2[2], q1;
        { const bool hi = lane & 32;
#pragma unroll
          for (int i = 0; i < 16; ++i) { const float snd = hi ? pe[i] : pe[16 + i], mine = hi ? pe[16 + i] : pe[i]; q16[i] = mine + __shfl_xor(snd, 32); } }
        { const bool hi = lane & 16;
#pragma unroll
          for (int i = 0; i < 8; ++i) { const float snd = hi ? q16[i] : q16[8 + i], mine = hi ? q16[8 + i] : q16[i]; q8[i] = mine + __shfl_xor(snd, 16); } }
        { const bool hi = lane & 8;
#pragma unroll
          for (int i = 0; i < 4; ++i) { const float snd = hi ? q8[i] : q8[4 + i], mine = hi ? q8[4 + i] : q8[i]; q4[i] = mine + __shfl_xor(snd, 8); } }
        { const bool hi = lane & 4;
#pragma unroll
          for (int i = 0; i < 2; ++i) { const float snd = hi ? q4[i] : q4[2 + i], mine = hi ? q4[2 + i] : q4[i]; q2[i] = mine + __shfl_xor(snd, 4); } }
        { const bool hi = lane & 2; const float snd = hi ? q2[0] : q2[1], mine = hi ? q2[1] : q2[0]; q1 = mine + __shfl_xor(snd, 2); }
        q1 += __shfl_xor(q1, 1);
        const int myE = (lane >> 1) & 31;
        float val = q1 + PP(router_b)[layer * NEXP + myE];
        float tv[4]; int te[4];
#pragma unroll
        for (int k = 0; k < 4; ++k) {
            float bv = val; int be = myE;
#pragma unroll
            for (int o = 1; o < 64; o <<= 1) { const float ov = __shfl_xor(bv, o); const int oe = __shfl_xor(be, o); if (ov > bv || (ov == bv && oe < be)) { bv = ov; be = oe; } }
            tv[k] = bv; te[k] = be; if (myE == be) val = -INFINITY;
        }
        const float e1 = __expf(tv[1] - tv[0]), e2 = __expf(tv[2] - tv[0]), e3 = __expf(tv[3] - tv[0]), inv = 1.f / (1.f + e1 + e2 + e3);
        if (lane == 0) {
            *(f32x4*)(F_TOPW + (size_t)row * 4) = (f32x4){inv, e1 * inv, e2 * inv, e3 * inv};
#pragma unroll
            for (int k = 0; k < 4; ++k) { selE[slot * 4 + k] = te[k]; selR[slot * 4 + k] = atomicAdd((int*)(cntL + te[k]), 1); }
        }
    }
    __syncthreads();
    if (F.tid < 32) { const int c = cntL[F.tid]; baseL[F.tid] = c ? (int)atomicAdd(F_cnt + layer * 32 + F.tid, (unsigned)c) : 0; }
    __syncthreads();
    if (F.tid < 288) { const int s = F.tid >> 2, k = F.tid & 3; const int row = F.bid * 8 + (s & 7) + (s >> 3) * NGW;
        if (row < nrows) { const int e = selE[F.tid], pos = baseL[e] + selR[F.tid]; F_POS[(size_t)row * 4 + k] = e | (pos << 8); F_LIST[(size_t)e * NTOK + pos] = row; } }
    __syncthreads();
}

__device__ __forceinline__ void moe_prefix(Frame& F, const int layer, LAS int* mtp, LAS int* roff) {
    if (F.tid == 0) { int a = 0, b = 0; for (int e = 0; e < 32; ++e) { const int c = (int)__hip_atomic_load(F_cnt + layer * 32 + e, __ATOMIC_RELAXED, __HIP_MEMORY_SCOPE_AGENT); mtp[e] = a; roff[e] = b; a += (c + 255) >> 8; b += c; } mtp[32] = a; roff[32] = b; }
    __syncthreads();
}
__device__ __forceinline__ void phase_moe1(Frame& F, const int layer) {
    const int wid = F.wid, lane = F.lane, wr = wid >> 2, wc = wid & 3, fr = lane & 15, fq = lane >> 4;
    LAS int* mtp = (LAS int*)(F.lds + 2 * STAGE_B); LAS int* roff = mtp + 40;
    moe_prefix(F, layer, mtp, roff);
    const int RT = __builtin_amdgcn_readfirstlane(mtp[32]);
    f32x4 acc[8][4];
    XOrder xo; xo.init(RT * 8, F.G, F.bid);
    for (int L; xo.next(L);) {
        int e = 0; while (mtp[e + 1] * 8 <= L) ++e;
        e = __builtin_amdgcn_readfirstlane(e);
        const int mt = __builtin_amdgcn_readfirstlane(mtp[e + 1] - mtp[e]), w = L - __builtin_amdgcn_readfirstlane(mtp[e]) * 8, ct = w / mt, rbase = (w - ct * mt) * 256;
        const int ro = __builtin_amdgcn_readfirstlane(roff[e]), cnt = __builtin_amdgcn_readfirstlane(roff[e + 1]) - ro;
        const int* list = F_LIST + (size_t)e * NTOK;
        GA ga; ga.base = F_H; { const int C = a_piece_col(wid, lane);
#pragma unroll
            for (int i = 0; i < 4; ++i) { int rr = rbase + a_piece_row(wid, lane, i); rr = rr < cnt ? rr : cnt - 1; ga.off[i] = (unsigned)(list[rr] * D + C); } }
        const float* W = PP(moe_w_gu) + ((size_t)(layer * NEXP + e) * D) * (2 * DFF);
        const int l2 = lane & 31, gcol = (lane >> 5) * DFF + ct * 128 + 4 * l2, tcol = ((4 * l2) >> 5) * 64 + (lane >> 5) * 32 + ((4 * l2) & 31);
        GB gb; gb.ptr = W + (size_t)(wid * 8) * (2 * DFF); gb.lcol = gcol; gb.ldb = 2 * DFF; gb.woff = 2 * tcol;
        gemm_tile(F.lds, ga, gb, D / 64, acc, wid, lane);
        const float* bias = PP(moe_b_gu) + (size_t)(layer * NEXP + e) * (2 * DFF);
#pragma unroll
        for (int n = 0; n < 2; ++n) {
            const int gc = ct * 128 + wc * 32 + n * 16 + 4 * fq;
            const f32x4 bg = *(const f32x4*)(bias + gc), bu = *(const f32x4*)(bias + DFF + gc);
#pragma unroll
            for (int m = 0; m < 8; ++m) {
                const int r = rbase + wr * 128 + m * 16 + fr;
                float a[4];
#pragma unroll
                for (int j = 0; j < 4; ++j) { const float gg = fminf(acc[m][n][j] + bg[j], 7.f), uu = fminf(fmaxf(acc[m][n + 2][j] + bu[j], -7.f), 7.f);
                    a[j] = (uu + 1.f) * gg / (1.f + __expf(-1.702f * gg)); }
                if (r < cnt) { u32x2 w; w.x = pk2(a[0], a[1]); w.y = pk2(a[2], a[3]); *(u32x2*)(F_ACT + (size_t)(ro + r) * DFF + gc) = w; }
            }
        }
    }
}
__device__ __forceinline__ void phase_moe2(Frame& F, const int layer) {
    const int wid = F.wid, lane = F.lane, wr = wid >> 2, wc = wid & 3, fr = lane & 15, fq = lane >> 4;
    LAS int* mtp = (LAS int*)(F.lds + 2 * STAGE_B); LAS int* roff = mtp + 40;
    moe_prefix(F, layer, mtp, roff);
    const int RT = __builtin_amdgcn_readfirstlane(mtp[32]);
    f32x4 acc[8][4];
    XOrder xo; xo.init(RT * 4, F.G, F.bid);
    for (int L; xo.next(L);) {
        int e = 0; while (mtp[e + 1] * 4 <= L) ++e;
        e = __builtin_amdgcn_readfirstlane(e);
        const int mt = __builtin_amdgcn_readfirstlane(mtp[e + 1] - mtp[e]), w = L - __builtin_amdgcn_readfirstlane(mtp[e]) * 4, ct = w / mt, rbase = (w - ct * mt) * 256;
        const int ro = __builtin_amdgcn_readfirstlane(roff[e]), cnt = __builtin_amdgcn_readfirstlane(roff[e + 1]) - ro;
        GA ga; ga.base = F_ACT; { const int C = a_piece_col(wid, lane);
#pragma unroll
            for (int i = 0; i < 4; ++i) { int rr = rbase + a_piece_row(wid, lane, i); rr = rr < cnt ? rr : cnt - 1; ga.off[i] = (unsigned)((ro + rr) * DFF + C); } }
        const float* W = PP(moe_w_dn) + ((size_t)(layer * NEXP + e) * DFF) * D;
        GB gb; gb.ptr = W + (size_t)(wid * 8) * D + ct * 256; gb.lcol = 4 * lane; gb.ldb = D; gb.woff = 8 * lane;
        gemm_tile(F.lds, ga, gb, DFF / 64, acc, wid, lane);
        const float* bias = PP(moe_b_dn) + (size_t)(layer * NEXP + e) * D;
#pragma unroll
        for (int n = 0; n < 4; ++n) {
            const int c = ct * 256 + wc * 64 + n * 16 + 4 * fq;
            const f32x4 bv = *(const f32x4*)(bias + c);
#pragma unroll
            for (int m = 0; m < 8; ++m) {
                const int r = rbase + wr * 128 + m * 16 + fr;
                if (r < cnt) { u32x2 w; w.x = pk2(acc[m][n][0] + bv[0], acc[m][n][1] + bv[1]); w.y = pk2(acc[m][n][2] + bv[2], acc[m][n][3] + bv[3]); *(u32x2*)(F_Y + (size_t)(ro + r) * D + c) = w; }
            }
        }
    }
}

__device__ __forceinline__ void phase_combine(Frame& F, const int layer) {
    LAS int* mtp = (LAS int*)(F.lds + 2 * STAGE_B); LAS int* roff = mtp + 40;
    moe_prefix(F, layer, mtp, roff);
    const int nrows = layer == 0 ? NTOK : NMAIN, lane = F.lane;
    const int gw = F.bid * 8 + F.wid, NGW = F.G * 8;
    for (int row = gw; row < nrows; row += NGW) {
        const i32x4 ps = *(const i32x4*)(F_POS + (size_t)row * 4); const f32x4 tw = *(const f32x4*)(F_TOPW + (size_t)row * 4);
        const int r = mod_row(row); const float* g2 = modp(F, layer, r, 5);
        f32x4 v[4];
#pragma unroll
        for (int j = 0; j < 4; ++j) v[j] = (f32x4){0.f, 0.f, 0.f, 0.f};
#pragma unroll
        for (int k = 0; k < 4; ++k) { const int e = ps[k] & 255, pos = ps[k] >> 8; const bf16_t* y = F_Y + (size_t)(roff[e] + pos) * D; const float w = tw[k];
#pragma unroll
            for (int j = 0; j < 4; ++j) { const u32x2 u = *(const u32x2*)(y + 4 * lane + 256 * j); v[j][0] += w * bflo(u.x); v[j][1] += w * bfhi(u.x); v[j][2] += w * bflo(u.y); v[j][3] += w * bfhi(u.y); } }
#pragma unroll
        for (int j = 0; j < 4; ++j) { const int c = 4 * lane + 256 * j; const f32x4 xs = *(const f32x4*)(F_XS + (size_t)row * D + c), gv = *(const f32x4*)(g2 + c); v[j] = xs + gv * v[j]; }
        const float rstd = row_rstd(v);
        if (layer == 0) {
#pragma unroll
            for (int j = 0; j < 4; ++j) *(f32x4*)(F_XS + (size_t)row * D + 4 * lane + 256 * j) = v[j];
            norm_mod_store(v, rstd, PP(norm_mix) + D, modp(F, 1, r, 1), modp(F, 1, r, 0), F_H + (size_t)row * D, lane);
        } else {
#pragma unroll
            for (int j = 0; j < 4; ++j) { const int c = 4 * lane + 256 * j; const f32x4 g = *(const f32x4*)(PP(final_norm) + c); *(f32x4*)(((float*)ldp(F, (int)__builtin_offsetof(Params, out))) + (size_t)row * D + c) = v[j] * rstd * g; }
        }
    }
}

__device__ __forceinline__ void phase_inproj_l1(Frame& F) {
    const int wid = F.wid, lane = F.lane, wr = wid >> 2, wc = wid & 3, fr = lane & 15, fq = lane >> 4;
    constexpr int N_MAIN_T = (NMAIN / 256) * 10, N_CTX_T = (NCTX / 256) * 4;
    f32x4 acc[8][4];
    XOrder xo; xo.init(N_MAIN_T + N_CTX_T, F.G, F.bid);
    for (int t; xo.next(t);) {
        int pm, pn;
        if (t < N_MAIN_T) dense_tile(t, NMAIN / 256, 10, pm, pn); else { const int c = t - N_MAIN_T; pm = NMAIN / 256 + (c & 3); pn = 2 + (c >> 2); }
        GA ga; ga.base = F_H; { const int C = a_piece_col(wid, lane);
#pragma unroll
            for (int i = 0; i < 4; ++i) ga.off[i] = (unsigned)((pm * 256 + a_piece_row(wid, lane, i)) * D + C); }
        GB gb;
        if (pn < 6) { gb.ptr = PP(odd_w_in) + (size_t)(wid * 8) * 2048 + pn * 256; gb.ldb = 2048; }
        else { gb.ptr = F_WF + (size_t)(wid * 8) * 1024 + (pn - 6) * 256; gb.ldb = 1024; }
        gb.lcol = 4 * lane; gb.woff = 8 * lane;
        gemm_tile(F.lds, ga, gb, D / 64, acc, wid, lane);
        if (pn < 6) {
#pragma unroll
            for (int m = 0; m < 8; ++m) { const int row = EPI_ROW(pm, m);
#pragma unroll
                for (int n = 0; n < 4; ++n) { u32x2 w; w.x = pk2(acc[m][n][0], acc[m][n][1]); w.y = pk2(acc[m][n][2], acc[m][n][3]);
                    *(u32x2*)(F_PROJ + (size_t)row * QKV_LD + pn * 256 + wc * 64 + n * 16 + 4 * fq) = w; } }
        } else {
            const int g = pn - 6, ri = wc >> 1;
#pragma unroll
            for (int m = 0; m < 8; ++m) { const int row = EPI_ROW(pm, m), b = row >> 12, n1 = (row >> 6) & 63, n2 = row & 63;
                float* zb = F_Z + ((((size_t)(b * 64 + n1) * 2 + ri) * 64 + n2) * 512) + g * 128 + (wc & 1) * 64;
#pragma unroll
                for (int n = 0; n < 4; ++n) *(f32x4*)(zb + n * 16 + 4 * fq) = acc[m][n]; }
        }
    }
}

__device__ __forceinline__ void phase_attn_l1(Frame& F) {
    const int wid = F.wid, lane = F.lane, wr = wid >> 2, wc = wid & 3, fr = lane & 15, fq = lane >> 4;
    constexpr int N_NA = NB * 64, N_F1 = NB * 128;
    const float SC = 0.125f * LOG2E;
    f32x4 acc[8][4];
    for (int it = F.bid; it < N_NA + N_F1; it += F.G) {
        if (it < N_NA) {
            LAS unsigned char* vl = F.lds + wid * 8192;
            LAS float* rp = (LAS float*)(vl + 5120);
            const int b = it >> 6, r = it & 63, h = wid;
            for (int i = lane; i < 465; i += 64) rp[i] = PP(odd_rpb)[h * 465 + i] * LOG2E;
            for (int qh = 0; qh < 4 / QT; ++qh) {
            const int qc0 = qh * (16 * QT), qrow0 = b * SEQ + r * 64 + qc0;
            bf16x8 qf[QT][2];
#pragma unroll
            for (int qt = 0; qt < QT; ++qt)
#pragma unroll
                for (int ks = 0; ks < 2; ++ks) qf[qt][ks] = *(const bf16x8*)(F_PROJ + (size_t)(qrow0 + qt * 16 + fr) * QKV_LD + h * 64 + ks * 32 + 8 * fq);
            AttnSt st;
#pragma unroll
            for (int qt = 0; qt < QT; ++qt) { st.m[qt] = -1e30f; st.l[qt] = 0.f;
#pragma unroll
                for (int dt = 0; dt < 4; ++dt) st.o[dt][qt] = (f32x4){0.f, 0.f, 0.f, 0.f}; }
            const int r0 = min(max(r - 4, 0), 56);
            int c0q[QT];
#pragma unroll
            for (int qt = 0; qt < QT; ++qt) c0q[qt] = min(max(qc0 + qt * 16 + fr - 8, 0), 48);
            for (int s = 0; s < 16; ++s) {
                const int kr = r0 + (s >> 1), half = s & 1;
                const bf16_t* kp = F_PROJ + (size_t)(b * SEQ + kr * 64 + half * 32) * QKV_LD + 512 + h * 64;
                const bf16_t* vp = kp + 512;
                const LAS float* rpr = rp + (kr - r + 7) * 31 + 15;
#define BIAS_NA(qt, kt, j) ({ const int kc = half * 32 + kt * 16 + 4 * fq + j; const int dc = kc - (qc0 + qt * 16 + fr); (kc >= c0q[qt] && kc < c0q[qt] + 16) ? rpr[dc] : -INFINITY; })
                ATTN_STEP(kp, QKV_LD, vp, QKV_LD, SC, BIAS_NA);
            }
            for (int s = 0; s < 8; ++s) {
                const bf16_t* kp = F_PROJ + (size_t)(NMAIN + b * CTXL + s * 32) * QKV_LD + 512 + h * 64;
                const bf16_t* vp = kp + 512;
                ATTN_STEP(kp, QKV_LD, vp, QKV_LD, SC, BIAS_NONE);
            }
            attn_store(st, F_MIX + (size_t)qrow0 * D + h * 64, D, fr, fq);
            }
            __syncthreads();
        } else {
            const int fi = it - N_NA, b = fi >> 7, ct = fi & 127;
            GA ga; ga.base = F_M1; { const int C = a_piece_col(wid, lane);
#pragma unroll
                for (int i = 0; i < 4; ++i) ga.off[i] = (unsigned)(a_piece_row(wid, lane, i) * 128 + C); }
            GB gb; gb.ptr = F_Z + (size_t)b * 128 * 32768 + (size_t)(wid * 8) * 32768 + ct * 256; gb.lcol = 4 * lane; gb.ldb = 32768; gb.woff = 8 * lane;
            gemm_tile(F.lds, ga, gb, 2, acc, wid, lane);
            if (wr == 0) {
#pragma unroll
                for (int m = 0; m < 4; ++m) { const int k1 = m * 16 + fr;
#pragma unroll
                    for (int n = 0; n < 4; ++n) { const int col = ct * 256 + wc * 64 + n * 16 + 4 * fq, n2 = col >> 9, c = col & 511;
                        const f32x2 tw = F_TW[n2 * k1];
                        const f32x4 re = acc[m][n], im = acc[m + 4][n];
                        const f32x4 ore = re * tw.x + im * tw.y, oim = im * tw.x - re * tw.y;
                        *(f32x4*)(F_A1 + ((((size_t)(b * 2 + 0) * 64 + n2) * 64 + k1) * 512) + c) = ore;
                        *(f32x4*)(F_A1 + ((((size_t)(b * 2 + 1) * 64 + n2) * 64 + k1) * 512) + c) = oim; } }
            }
        }
    }
}

__device__ __forceinline__ void phase_fst2(Frame& F) {
    const int wid = F.wid, lane = F.lane, wr = wid >> 2, wc = wid & 3, fr = lane & 15, fq = lane >> 4;
    const float scl = 1.f / 724.0773439350247f;
    f32x4 acc[8][4];
    for (int it = F.bid; it < NB * 128; it += F.G) {
        const int b = it >> 7, ct = it & 127;
        GA ga; ga.base = F_M2; { const int C = a_piece_col(wid, lane);
#pragma unroll
            for (int i = 0; i < 4; ++i) ga.off[i] = (unsigned)(a_piece_row(wid, lane, i) * 128 + C); }
        GB gb; gb.ptr = F_A1 + (size_t)b * 128 * 32768 + (size_t)(wid * 8) * 32768 + ct * 256; gb.lcol = 4 * lane; gb.ldb = 32768; gb.woff = 8 * lane;
        gemm_tile(F.lds, ga, gb, 2, acc, wid, lane);
        if (wr == 0) {
#pragma unroll
            for (int m = 0; m < 4; ++m) { const int k2 = m * 16 + fr;
#pragma unroll
                for (int n = 0; n < 4; ++n) { const int col = ct * 256 + wc * 64 + n * 16 + 4 * fq, k1 = col >> 9, c = col & 511;
                    const f32x4 o = acc[m][n] * scl; u32x2 w; w.x = pk2(o[0], o[1]); w.y = pk2(o[2], o[3]);
                    *(u32x2*)(F_MIX + (size_t)(b * SEQ + k1 + 64 * k2) * D + 512 + c) = w; } }
        }
    }
}

__global__ void __launch_bounds__(512, 2) fwd_kernel(Params p) {
    extern __shared__ __attribute__((aligned(16))) unsigned char lds_raw[];
    Frame F;
    F.lds = (LAS unsigned char*)lds_raw;
    F.tid = threadIdx.x; F.lane = F.tid & 63; F.wid = __builtin_amdgcn_readfirstlane(F.tid >> 6); F.bid = blockIdx.x; F.G = gridDim.x;
    unsigned char* ws = p.ws; F.ws = ws;
    volatile LAS unsigned* MISC = (volatile LAS unsigned*)(F.lds + MISC_OFF);
    if (F.tid < 64) MISC[F.tid] = 0u;
    if (F.tid == 64) { LAS unsigned long long* LP = (LAS unsigned long long*)(F.lds + PARAM_OFF);
        LP[0] = (unsigned long long)p.x; LP[1] = (unsigned long long)p.c; LP[2] = (unsigned long long)p.ctx; LP[3] = (unsigned long long)p.c_ctx; LP[4] = (unsigned long long)p.ada_w; LP[5] = (unsigned long long)p.ada_b;
        LP[6] = (unsigned long long)p.norm_mix; LP[7] = (unsigned long long)p.norm_ffn; LP[8] = (unsigned long long)p.even_w_in; LP[9] = (unsigned long long)p.even_w_out; LP[10] = (unsigned long long)p.even_conv_w;
        LP[11] = (unsigned long long)p.even_sink; LP[12] = (unsigned long long)p.odd_w_in; LP[13] = (unsigned long long)p.odd_w_out; LP[14] = (unsigned long long)p.odd_rpb; LP[15] = (unsigned long long)p.router_w;
        LP[16] = (unsigned long long)p.router_b; LP[17] = (unsigned long long)p.moe_w_gu; LP[18] = (unsigned long long)p.moe_b_gu; LP[19] = (unsigned long long)p.moe_w_dn; LP[20] = (unsigned long long)p.moe_b_dn;
        LP[21] = (unsigned long long)p.final_norm; LP[22] = (unsigned long long)p.out; }
    __syncthreads();
    const int lo = p.ph_lo, hi = p.ph_hi;
    XcdBarrier bar; bar.bar = (unsigned*)(ws + WS_CTL) + CW_BAR; bar.x = 0; bar.st = MISC + 8;
    if (hi - lo > 1) bar = xcd_barrier_post((unsigned*)(ws + WS_CTL) + CW_BAR, MISC + 8);
#define RUN_PHASE(ph, call) do { if (PH_ON(ph) && lo <= (ph) && (ph) < hi) { call; if (PH_REP(ph)) { xcd_barrier(bar); call; } } if (lo <= (ph) && (ph) + 1 < hi) xcd_barrier(bar); } while (0)
    RUN_PHASE(PH_PREP, phase_prep(F));
    RUN_PHASE(PH_NORM1_0, phase_norm1_l0(F));
    RUN_PHASE(PH_INPROJ_0, phase_inproj_l0(F));
    RUN_PHASE(PH_ATTN_0, phase_attn_l0(F));
    RUN_PHASE(PH_OUTPROJ_0, phase_outproj(F, 0));
    RUN_PHASE(PH_ROUTE_0, phase_route(F, 0));
    RUN_PHASE(PH_MOE1_0, phase_moe1(F, 0));
    RUN_PHASE(PH_MOE2_0, phase_moe2(F, 0));
    RUN_PHASE(PH_COMB_0, phase_combine(F, 0));
    RUN_PHASE(PH_INPROJ_1, phase_inproj_l1(F));
    RUN_PHASE(PH_ATTN_1, phase_attn_l1(F));
    RUN_PHASE(PH_FST2_1, phase_fst2(F));
    RUN_PHASE(PH_OUTPROJ_1, phase_outproj(F, 1));
    RUN_PHASE(PH_ROUTE_1, phase_route(F, 1));
    RUN_PHASE(PH_MOE1_1, phase_moe1(F, 1));
    RUN_PHASE(PH_MOE2_1, phase_moe2(F, 1));
    RUN_PHASE(PH_FINAL, phase_combine(F, 1));
}

extern "C" void kernel_launch(void* const* d_in, const int* in_sizes, int n_in, void* d_out, int out_size, void* d_ws, size_t ws_size, hipStream_t stream) {
    static int grid = 0;
    if (grid == 0) {
        if (n_in != 22 || ws_size < WS_END) { fprintf(stderr, "kernel_launch: unexpected inputs (n_in %d, ws %zu)\n", n_in, ws_size); grid = -1; return; }
        int dev = 0, cus = 0, per_cu = 0;
        hipGetDevice(&dev);
        hipDeviceGetAttribute(&cus, hipDeviceAttributeMultiprocessorCount, dev);
        hipFuncSetAttribute((const void*)fwd_kernel, hipFuncAttributeMaxDynamicSharedMemorySize, LDS_BYTES);
        hipOccupancyMaxActiveBlocksPerMultiprocessor(&per_cu, (const void*)fwd_kernel, 512, LDS_BYTES);
        if (per_cu < 1) { fprintf(stderr, "kernel_launch: occupancy query says %d blocks/CU\n", per_cu); per_cu = 1; }
        (void)hipGetLastError();
        grid = cus;
    }
    if (grid < 0) return;
    hipMemsetAsync((char*)d_ws + WS_CTL, 0, CTL_BYTES, stream);
    Params p{};
    const float** pp = (const float**)&p;
    for (int i = 0; i < 22; ++i) pp[i] = (const float*)d_in[i];
    p.out = (float*)d_out; p.ws = (unsigned char*)d_ws;
#if N_LAUNCH_MODE == 1
    for (int ph = 0; ph < NPHASE; ++ph) { p.ph_lo = ph; p.ph_hi = ph + 1; hipLaunchKernelGGL(fwd_kernel, dim3(grid), dim3(512), LDS_BYTES, stream, p); }
#else
    p.ph_lo = 0; p.ph_hi = NPHASE;
    void* args[] = {&p};
    hipError_t e = hipLaunchCooperativeKernel((const void*)fwd_kernel, dim3(grid), dim3(512), args, LDS_BYTES, stream);
    if (e != hipSuccess) fprintf(stderr, "kernel_launch: cooperative launch failed: %s (grid %d)\n", hipGetErrorString(e), grid);
#endif
}
```

```cpp
#include <hip/hip_runtime.h>
#include <cstdio>
#include <cstdint>

#ifndef N_LAUNCH_MODE
#define N_LAUNCH_MODE 0
#endif

#ifndef PHASE_MASK
#define PHASE_MASK 0x1FFFF
#endif
#define PH_ON(ph) ((PHASE_MASK >> (ph)) & 1)
#ifndef REPEAT_MASK
#define REPEAT_MASK 0
#endif
#define PH_REP(ph) ((REPEAT_MASK >> (ph)) & 1)
#define LAS __attribute__((address_space(3)))
#define GAS __attribute__((address_space(1)))
typedef unsigned short bf16_t;
typedef short bf16x8 __attribute__((ext_vector_type(8)));
typedef short s16x4 __attribute__((ext_vector_type(4)));
typedef float f32x4 __attribute__((ext_vector_type(4)));
typedef float f32x2 __attribute__((ext_vector_type(2)));
typedef int i32x4 __attribute__((ext_vector_type(4)));
typedef unsigned u32x2 __attribute__((ext_vector_type(2)));
typedef unsigned u32x4 __attribute__((ext_vector_type(4)));

constexpr int D = 1024, NB = 4, SEQ = 4096, CTXL = 256;
constexpr int NMAIN = NB * SEQ, NCTX = NB * CTXL, NTOK = NMAIN + NCTX;
constexpr int EVEN_IN = 2304, NEXP = 32, DFF = 1024;
constexpr int QKV_LD = 1536;
constexpr float NORM_EPS = 1e-6f;
constexpr float LOG2E = 1.4426950408889634f;

constexpr size_t MiB = 1ull << 20;
constexpr size_t WS_CTL = 0, CTL_BYTES = 1 * MiB;
constexpr size_t WS_MOD = 1 * MiB;
constexpr size_t WS_M1 = 2 * MiB;
constexpr size_t WS_M2 = WS_M1 + 65536;
constexpr size_t WS_ROPE = WS_M2 + 65536;
constexpr size_t WS_TW = WS_ROPE + 8192;
constexpr size_t WS_WF = 4 * MiB;
constexpr size_t WS_TOPW = 8 * MiB;
constexpr size_t WS_POS = 9 * MiB;
constexpr size_t WS_LIST = 12 * MiB;
constexpr size_t WS_H = 16 * MiB;
constexpr size_t WS_MIX = 52 * MiB;
constexpr size_t WS_XS = 88 * MiB;
constexpr size_t WS_PROJ = 160 * MiB;
constexpr size_t WS_Z = 240 * MiB;
constexpr size_t WS_A1 = 304 * MiB;
constexpr size_t WS_ACT = 368 * MiB;
constexpr size_t WS_Y = 512 * MiB;
constexpr size_t WS_WB = 656 * MiB;
constexpr size_t WB_EIN = WS_WB, WB_EOUT = WB_EIN + (size_t)D * EVEN_IN * 2, WB_OIN = WB_EOUT + (size_t)D * D * 2, WB_OOUT = WB_OIN + (size_t)D * 2560 * 2;
constexpr size_t WS_BC = 672 * MiB;
constexpr size_t WS_BC2 = WS_BC + 128 * MiB;
constexpr size_t WS_END = 864 * MiB;
constexpr int CW_BAR = 4096;
constexpr int CW_CNT = 8192;

constexpr int LDS_BYTES = 147456;
constexpr int PARAM_OFF = LDS_BYTES - 512;
constexpr int MISC_OFF = LDS_BYTES - 256;
constexpr int A_TILE_B = 32768, B_ROWB = 544, B_TILE_B = 64 * B_ROWB, STAGE_B = A_TILE_B + B_TILE_B;
static_assert(2 * STAGE_B + 1024 <= PARAM_OFF, "LDS");

enum { PH_PREP = 0, PH_NORM1_0, PH_INPROJ_0, PH_ATTN_0, PH_OUTPROJ_0, PH_ROUTE_0, PH_MOE1_0, PH_MOE2_0, PH_COMB_0,
       PH_INPROJ_1, PH_ATTN_1, PH_FST2_1, PH_OUTPROJ_1, PH_ROUTE_1, PH_MOE1_1, PH_MOE2_1, PH_FINAL, NPHASE };

struct Params {
    const float *x, *c, *ctx, *c_ctx, *ada_w, *ada_b, *norm_mix, *norm_ffn, *even_w_in, *even_w_out, *even_conv_w, *even_sink,
                *odd_w_in, *odd_w_out, *odd_rpb, *router_w, *router_b, *moe_w_gu, *moe_b_gu, *moe_w_dn, *moe_b_dn, *final_norm;
    float* out; unsigned char* ws; int ph_lo, ph_hi;
};

__device__ __forceinline__ unsigned pk2(float lo, float hi) { unsigned r; asm("v_cvt_pk_bf16_f32 %0, %1, %2" : "=v"(r) : "v"(lo), "v"(hi)); return r; }
__device__ __forceinline__ float bflo(unsigned u) { return __builtin_bit_cast(float, u << 16); }
__device__ __forceinline__ float bfhi(unsigned u) { return __builtin_bit_cast(float, u & 0xffff0000u); }
__device__ __forceinline__ float wave_sum(float v) {
#pragma unroll
    for (int o = 1; o < 64; o <<= 1) v += __shfl_xor(v, o);
    return v;
}
__device__ __forceinline__ float fexp2(float x) { return __builtin_amdgcn_exp2f(x); }

#define XB_TMO      128
#define XB_XCNT(j)  (256  + 64 * (j))
#define XB_XSUB(j)  (1280 + 64 * (j))
#define XB_XGEN(j)  (2304 + 64 * (j))
#define XB_TOP      3328
#define XB_TOPGEN   3392
#define XB_SPIN_CAP (1u << 22)
__device__ __forceinline__ unsigned xb_ld(unsigned* p)              { return __hip_atomic_load(p, __ATOMIC_RELAXED, __HIP_MEMORY_SCOPE_AGENT); }
__device__ __forceinline__ unsigned xb_add(unsigned* p, unsigned v) { return __hip_atomic_fetch_add(p, v, __ATOMIC_RELAXED, __HIP_MEMORY_SCOPE_AGENT); }
__device__ __forceinline__ unsigned xb_xcc_id() { return (unsigned)__builtin_amdgcn_s_getreg((3 << 11) | 20) & 0xFu; }
#define XB_SPIN(cond, bar) do { unsigned _sp = 0; while (cond) { __builtin_amdgcn_s_sleep(1); \
    if ((++_sp & 255u) == 0u) { if (xb_ld(&(bar)[XB_TMO])) break; if (_sp > XB_SPIN_CAP) { atomicAdd(&(bar)[XB_TMO], 1u); break; } } } } while (0)
struct XcdBarrier { unsigned* bar; unsigned x; volatile LAS unsigned* st; };
__device__ __forceinline__ XcdBarrier xcd_barrier_post(unsigned* bar, volatile LAS unsigned* st) {
    XcdBarrier b; b.bar = bar; b.x = xb_xcc_id(); b.st = st;
    if (threadIdx.x == 0) (void)xb_add(&bar[XB_XCNT(b.x)], 1u);
    return b;
}
__device__ __forceinline__ void xcd_barrier_complete(unsigned* bar, unsigned x, unsigned& nloc, unsigned& nx) {
    const unsigned G = gridDim.x * gridDim.y * gridDim.z;
    unsigned sum, cnt, mine, sp = 0u;
    for (;;) {
        sum = 0u; cnt = 0u; mine = 0u;
#pragma unroll
        for (unsigned j = 0; j < 16; ++j) { const unsigned c = xb_ld(&bar[XB_XCNT(j)]); sum += c; cnt += (c > 0u) ? 1u : 0u; mine = (j == x) ? c : mine; }
        if (sum == G) break;
        __builtin_amdgcn_s_sleep(1);
        if ((++sp & 255u) == 0u) { if (xb_ld(&bar[XB_TMO])) break; if (sp > XB_SPIN_CAP) { atomicAdd(&bar[XB_TMO], 1u); break; } }
    }
    nloc = mine > 0u ? mine : 1u; nx = cnt > 0u ? cnt : 1u;
}
__device__ __forceinline__ void xcd_barrier(const XcdBarrier& b) {
    asm volatile("s_waitcnt vmcnt(0)" ::: "memory");
    __syncthreads();
    if (threadIdx.x == 0) {
        unsigned* bar = b.bar;
        __builtin_amdgcn_s_waitcnt(0);
        unsigned nloc = b.st[0], nx = b.st[1];
        if (nloc == 0u) { xcd_barrier_complete(bar, b.x, nloc, nx); b.st[0] = nloc; b.st[1] = nx; }
        const unsigned old = xb_add(&bar[XB_XSUB(b.x)], 1u);
        const unsigned gen = old / nloc;
        if (old + 1u == (gen + 1u) * nloc) {
            __builtin_amdgcn_fence(__ATOMIC_RELEASE, "agent");
            asm volatile("s_waitcnt vmcnt(0)" ::: "memory");
            const unsigned og = xb_add(&bar[XB_TOP], 1u);
            const unsigned tg = og / nx;
            if (og + 1u == (tg + 1u) * nx) xb_add(&bar[XB_TOPGEN], 1u);
            else XB_SPIN(xb_ld(&bar[XB_TOPGEN]) == tg, bar);
            __builtin_amdgcn_fence(__ATOMIC_ACQUIRE, "agent");
            xb_add(&bar[XB_XGEN(b.x)], 1u);
            asm volatile("s_waitcnt vmcnt(0)" ::: "memory");
        } else {
            XB_SPIN(xb_ld(&bar[XB_XGEN(b.x)]) == gen, bar);
            __builtin_amdgcn_fence(__ATOMIC_ACQUIRE, "agent");
            asm volatile("s_waitcnt vmcnt(0)" ::: "memory");
        }
    }
    __syncthreads();
}

struct TD { const bf16_t* A; const void* B; bf16_t* bco; unsigned ldb; unsigned aoff[4]; int i0, i1, i2, i3, i4; };
__device__ __forceinline__ int a_piece_row0(int wid, int lane) { const int sb = lane * 16, swz = sb ^ (((sb >> 9) & 1) << 5); return (wid >> 1) * 16 + (swz >> 6); }
__device__ __forceinline__ int a_piece_col(int wid, int lane) { const int sb = lane * 16, swz = sb ^ (((sb >> 9) & 1) << 5); return (wid & 1) * 32 + ((swz & 63) >> 1); }
__device__ __forceinline__ u32x4 make_rsrc(const void* p) { const unsigned long long ab = (unsigned long long)p; u32x4 r; r.x = __builtin_amdgcn_readfirstlane((unsigned)ab); r.y = __builtin_amdgcn_readfirstlane((unsigned)(ab >> 32)) & 0xffffu; r.z = 0x7fffffffu; r.w = 0x00020000u; return r; }

template <class Pol>
__device__ __forceinline__ void gemm_stream(LAS unsigned char* lds, Pol& P, const int wid, const int lane) {
    const int wr = wid >> 2, wc = wid & 3, fr = lane & 15, fq = lane >> 4;
    const unsigned b_w = (unsigned)(A_TILE_B + ((wid >> 2) * 32 + 4 * (wid & 3)) * B_ROWB) + P.woff;
    const unsigned a_r = (unsigned)(wr * 16384 + ((fr * 64 + fq * 16) ^ ((fr >> 3) << 5)));
    const unsigned b_r = (unsigned)(A_TILE_B + (4 * fq + (fr >> 2)) * B_ROWB + (wc * 64 + (fr & 3) * 4) * 2);
    const unsigned ldsa = (unsigned)(__UINTPTR_TYPE__)lds + (unsigned)(wid * 1024);
    const unsigned lcolb = P.lcolb;
    TD cur, nxt;
    if (!P.get(0, cur)) return;
    int nt = P.nt; asm volatile("" : "+s"(nt));
    f32x4 sb[8]; f32x4 acc[8][4];
    u32x4 ra_c = make_rsrc(cur.A), ra_n = ra_c;
    __amdgpu_buffer_rsrc_t rb_c = __builtin_amdgcn_make_buffer_rsrc((void*)cur.B, 0, 0x7fffffff, 0x00020000), rb_n = rb_c;
#define G_GLDS_A(buf, RA, AOFF, kt) do { _Pragma("unroll") for (int i = 0; i < 4; ++i) { unsigned keep_; \
        asm volatile("s_mov_b32 %0, m0\n\ts_mov_b32 m0, %3\n\ts_nop 0\n\tbuffer_load_dwordx4 %1, %2, %4 offen lds\n\ts_mov_b32 m0, %0" \
            : "=&s"(keep_) : "v"(AOFF[i]), "s"(RA), "s"(ldsa + (buf) + (unsigned)(i * 8192)), "s"((unsigned)((kt) * 128)) : "memory"); } } while (0)
#define G_ISSUE_BH(RB, LDB4, kt, h) do { \
        _Pragma("unroll") for (int i = 4 * (h); i < 4 * (h) + 4; ++i) sb[i] = __builtin_bit_cast(f32x4, __builtin_amdgcn_raw_buffer_load_b128(RB, (int)lcolb, (int)(((unsigned)(kt) * 64u + i) * (LDB4)), 0)); \
        __builtin_amdgcn_sched_barrier(0); } while (0)
#define G_WRITE_BH(buf, h, BCO, kt) do { \
        _Pragma("unroll") for (int i = 4 * (h); i < 4 * (h) + 4; ++i) { u32x2 w; w.x = pk2(sb[i][0], sb[i][1]); w.y = pk2(sb[i][2], sb[i][3]); \
            *(LAS u32x2*)(lds + (buf) + b_w + (16 * (i >> 2) + (i & 3)) * B_ROWB) = w; \
            if (BCO) *(u32x2*)((char*)(BCO) + (size_t)((kt) * 64 + wid * 8 + i) * 512 + P.woff) = w; } __builtin_amdgcn_sched_barrier(0); } while (0)
#define G_KSTEP(buf, ks) do { bf16x8 Bf[4]; \
        _Pragma("unroll") for (int n = 0; n < 4; ++n) { \
            const s16x4 lo = __builtin_amdgcn_ds_read_tr16_b64_v4i16((LAS s16x4*)(lds + (buf) + b_r + (ks) * 32 * B_ROWB + n * 32)); \
            const s16x4 hi = __builtin_amdgcn_ds_read_tr16_b64_v4i16((LAS s16x4*)(lds + (buf) + b_r + (ks) * 32 * B_ROWB + 16 * B_ROWB + n * 32)); \
            Bf[n] = (bf16x8){lo[0], lo[1], lo[2], lo[3], hi[0], hi[1], hi[2], hi[3]}; } \
        _Pragma("unroll") for (int mh = 0; mh < 2; ++mh) { bf16x8 At[4]; \
            _Pragma("unroll") for (int m = 0; m < 4; ++m) At[m] = *(const LAS bf16x8*)(lds + (buf) + a_r + (mh * 4 + m) * 2048 + (ks) * 1024); \
            _Pragma("unroll") for (int m = 0; m < 4; ++m) _Pragma("unroll") for (int n = 0; n < 4; ++n) \
                acc[mh * 4 + m][n] = __builtin_amdgcn_mfma_f32_16x16x32_bf16(Bf[n], At[m], acc[mh * 4 + m][n], 0, 0, 0); } \
        __builtin_amdgcn_sched_barrier(0); } while (0)
    { unsigned b0 = 0; asm volatile("" : "+s"(b0));
      const unsigned l4 = cur.ldb * 4u;
      G_GLDS_A(b0, ra_c, cur.aoff, 0); G_ISSUE_BH(rb_c, l4, 0, 0); G_ISSUE_BH(rb_c, l4, 0, 1); G_WRITE_BH(b0, 0, cur.bco, 0); G_WRITE_BH(b0, 1, cur.bco, 0);
      G_ISSUE_BH(rb_c, l4, 1, 0); G_ISSUE_BH(rb_c, l4, 1, 1); }
    asm volatile("s_waitcnt vmcnt(8)" ::: "memory");
    asm volatile("s_waitcnt lgkmcnt(0)" ::: "memory");
    __builtin_amdgcn_s_barrier();
    unsigned par = 0;
    for (int ti = 0;; ++ti) {
        const bool hasn = P.get(ti + 1, nxt);
        if (hasn) { ra_n = make_rsrc(nxt.A); rb_n = __builtin_amdgcn_make_buffer_rsrc((void*)nxt.B, 0, 0x7fffffff, 0x00020000); }
#pragma unroll
        for (int m = 0; m < 8; ++m)
#pragma unroll
            for (int n = 0; n < 4; ++n) acc[m][n] = (f32x4){0.f, 0.f, 0.f, 0.f};
        for (int t = 0; t < nt; ++t) {
            unsigned bc = par * STAGE_B, bn = (par ^ 1u) * STAGE_B; asm volatile("" : "+s"(bc), "+s"(bn));
            const bool c1 = t + 1 < nt, w1 = c1 || hasn, c2 = t + 2 < nt, i2 = c2 || hasn;
            if (w1) { const u32x4 ra = c1 ? ra_c : ra_n; unsigned ao[4];
#pragma unroll
                for (int i = 0; i < 4; ++i) ao[i] = c1 ? cur.aoff[i] : nxt.aoff[i];
                G_GLDS_A(bn, ra, ao, c1 ? t + 1 : 0); }
            G_KSTEP(bc, 0);
            const __amdgpu_buffer_rsrc_t rb = c2 ? rb_c : rb_n; const unsigned l4 = (c2 ? cur.ldb : nxt.ldb) * 4u; const int k2 = c2 ? t + 2 : t + 2 - nt;
            bf16_t* const bco = c1 ? cur.bco : nxt.bco; const int k1 = c1 ? t + 1 : 0;
            if (w1) G_WRITE_BH(bn, 0, bco, k1);
            if (i2) G_ISSUE_BH(rb, l4, k2, 0);
            G_KSTEP(bc, 1);
            if (w1) G_WRITE_BH(bn, 1, bco, k1);
            if (i2) { G_ISSUE_BH(rb, l4, k2, 1); asm volatile("s_waitcnt vmcnt(8)" ::: "memory"); }
            else asm volatile("s_waitcnt vmcnt(0)" ::: "memory");
            asm volatile("s_waitcnt lgkmcnt(0)" ::: "memory");
            __builtin_amdgcn_s_barrier();
            par ^= 1u;
        }
        P.epi(acc, cur, (const LAS float*)nullptr);
        if (!hasn) break;
        cur = nxt; ra_c = ra_n; rb_c = rb_n;
    }
#undef G_GLDS_A
#undef G_ISSUE_BH
#undef G_WRITE_BH
#undef G_KSTEP
}

constexpr int STEP_B = 32768;
constexpr unsigned BIAS_OFF = 4 * STEP_B;
template <class Pol, int ABL = 0>
__device__ __forceinline__ void gemm_stream_bf(LAS unsigned char* lds, Pol& P, const int wid, const int lane) {
    const int wr = wid >> 2, wc = wid & 3, fr = lane & 15, fq = lane >> 4;
    const unsigned a_r = (unsigned)(wr * 8192 + ((fr * 64 + fq * 16) ^ ((fr >> 3) << 5)));
    const int x7 = 4 * (fq & 1) + (fr >> 2);
    unsigned b_r[4];
#pragma unroll
    for (int n = 0; n < 4; ++n) b_r[n] = (unsigned)(16384 + (4 * fq + (fr >> 2)) * 512 + (((wc * 4 + n) ^ x7) * 32) + (fr & 3) * 8);
    const unsigned ldsa = (unsigned)(__UINTPTR_TYPE__)lds + (unsigned)(wid * 2048), ldsb = (unsigned)(__UINTPTR_TYPE__)lds + 16384u + (unsigned)(wid * 2048);
    const unsigned ldb2 = P.ldbB * 2u;
    unsigned boff[2];
#pragma unroll
    for (int j = 0; j < 2; ++j) { const int sl = 4 * wid + 2 * j + (lane >> 5), u = lane & 31, c = (u >> 1) ^ (sl & 7), n = c * 16 + (u & 1) * 8;
        const int k = 8 * ((sl >> 2) & 3) + 4 * (sl >> 4) + (sl & 3); boff[j] = (unsigned)k * ldb2 + (unsigned)n * 2u; }
    TD cur, nxt;
    if (!P.get(0, cur)) return;
    int nt = P.nt * 2; asm volatile("" : "+s"(nt));
    f32x4 acc[8][4];
    u32x4 ra_c = make_rsrc(cur.A), ra_n = ra_c, rb_c = make_rsrc(cur.B), rb_n = rb_c;
#define H_DMA(LDSADDR, RS, VOFF, SOFF) do { unsigned keep_; \
        asm volatile("s_mov_b32 %0, m0\n\ts_mov_b32 m0, %3\n\ts_nop 0\n\tbuffer_load_dwordx4 %1, %2, %4 offen lds\n\ts_mov_b32 m0, %0" \
            : "=&s"(keep_) : "v"(VOFF), "s"(RS), "s"(LDSADDR), "s"(SOFF) : "memory"); } while (0)
#define H_STAGE(sb_, RA, AO0, AO1, RB, st) do { \
        if (!(ABL & 2)) { H_DMA(ldsa + (sb_), RA, AO0, (unsigned)((st) * 64)); H_DMA(ldsa + (sb_) + 1024u, RA, AO1, (unsigned)((st) * 64)); } \
        if (!(ABL & 1)) { H_DMA(ldsb + (sb_), RB, boff[0], (unsigned)(st) * 32u * ldb2); H_DMA(ldsb + (sb_) + 1024u, RB, boff[1], (unsigned)(st) * 32u * ldb2); } } while (0)
#define H_READ(sb_) do { if (!(ABL & 16)) { \
        _Pragma("unroll") for (int n = 0; n < 4; ++n) { \
            const s16x4 lo = __builtin_amdgcn_ds_read_tr16_b64_v4i16((LAS s16x4*)(lds + (sb_) + b_r[n])); \
            const s16x4 hi = __builtin_amdgcn_ds_read_tr16_b64_v4i16((LAS s16x4*)(lds + (sb_) + b_r[n] + 8192)); \
            Bf[n] = (bf16x8){lo[0], lo[1], lo[2], lo[3], hi[0], hi[1], hi[2], hi[3]}; } \
        _Pragma("unroll") for (int m = 0; m < 8; ++m) At[m] = *(const LAS bf16x8*)(lds + (sb_) + a_r + m * 1024); } } while (0)
#define H_MMA() do { if (!(ABL & 16)) { __builtin_amdgcn_s_setprio(1); \
        if (!(ABL & 4)) { _Pragma("unroll") for (int m = 0; m < 8; ++m) _Pragma("unroll") for (int n = 0; n < 4; ++n) \
            acc[m][n] = __builtin_amdgcn_mfma_f32_16x16x32_bf16(Bf[n], At[m], acc[m][n], 0, 0, 0); } \
        else { _Pragma("unroll") for (int m = 0; m < 8; ++m) asm volatile("" :: "v"(At[m])); _Pragma("unroll") for (int n = 0; n < 4; ++n) asm volatile("" :: "v"(Bf[n])); } \
        __builtin_amdgcn_s_setprio(0); } } while (0)
#define H_BAR() do { asm volatile("s_waitcnt lgkmcnt(0)" ::: "memory"); __builtin_amdgcn_s_barrier(); __builtin_amdgcn_sched_barrier(0); } while (0)
    bf16x8 At[8], Bf[4];
    { unsigned s0 = 0, s1 = STEP_B, s2 = 2 * STEP_B; asm volatile("" : "+s"(s0), "+s"(s1), "+s"(s2));
      H_STAGE(s0, ra_c, cur.aoff[0], cur.aoff[1], rb_c, 0); H_STAGE(s1, ra_c, cur.aoff[0], cur.aoff[1], rb_c, 1); H_STAGE(s2, ra_c, cur.aoff[0], cur.aoff[1], rb_c, 2); }
    asm volatile("s_waitcnt vmcnt(8)" ::: "memory");
    H_BAR();
    if (wr == 1) H_BAR();
    unsigned g = 0;
    for (int ti = 0;; ++ti) {
        const bool hasn = P.get(ti + 1, nxt);
        if (hasn) { ra_n = make_rsrc(nxt.A); rb_n = make_rsrc(nxt.B); }
        const unsigned bias_lds = BIAS_OFF + (unsigned)(ti & 1) * 1024u;
        if (P.has_bias && wid == 0) { const u32x4 rbias = make_rsrc(P.bias); H_DMA((unsigned)(__UINTPTR_TYPE__)lds + bias_lds, rbias, P.bias_voff(cur), 0u); }
#pragma unroll
        for (int m = 0; m < 8; ++m)
#pragma unroll
            for (int n = 0; n < 4; ++n) acc[m][n] = (f32x4){0.f, 0.f, 0.f, 0.f};
        for (int t = 0; t < nt; ++t, ++g) {
            unsigned sc = (g & 3u) * STEP_B, sn = ((g + 3u) & 3u) * STEP_B; asm volatile("" : "+s"(sc), "+s"(sn));
            const bool c3 = t + 3 < nt, i3 = c3 || hasn, i2 = (t + 2 < nt) || hasn;
            if (i3) { const u32x4 ra = c3 ? ra_c : ra_n, rb = c3 ? rb_c : rb_n; const unsigned a0 = c3 ? cur.aoff[0] : nxt.aoff[0], a1 = c3 ? cur.aoff[1] : nxt.aoff[1];
                H_STAGE(sn, ra, a0, a1, rb, c3 ? t + 3 : t + 3 - nt); }
            H_READ(sc);
            if (i3) asm volatile("s_waitcnt vmcnt(8)" ::: "memory");
            else if (i2) asm volatile("s_waitcnt vmcnt(4)" ::: "memory");
            else asm volatile("s_waitcnt vmcnt(0)" ::: "memory");
            H_BAR();
            H_MMA();
            H_BAR();
        }
        if (!(ABL & 8)) P.epi(acc, cur, (const LAS float*)(lds + bias_lds)); else { _Pragma("unroll") for (int m = 0; m < 8; ++m) _Pragma("unroll") for (int n = 0; n < 4; ++n) asm volatile("" :: "v"(acc[m][n])); }
        if (!hasn) break;
        cur = nxt; ra_c = ra_n; rb_c = rb_n;
    }
    if (wr == 0) H_BAR();
#undef H_DMA
#undef H_STAGE
#undef H_READ
#undef H_MMA
#undef H_BAR
}

struct XOrder {
    int c1, step, cur;
    __device__ __forceinline__ void init(int T, int G, int bid) {
        if ((G & 7) == 0) { const int x = bid & 7; cur = (int)(((long)x * T) >> 3) + (bid >> 3); c1 = (int)(((long)(x + 1) * T) >> 3); step = G >> 3; }
        else { cur = bid; c1 = T; step = G; }
    }
    __device__ __forceinline__ bool next(int& L) { if (cur >= c1) return false; L = cur; cur += step; return true; }
};
__device__ __forceinline__ void dense_tile(int L, int nM, int nN, int& pm, int& pn) { const int per = 8 * nN, g = L / per, w = L - g * per, fm = g * 8, gs = (nM - fm) < 8 ? (nM - fm) : 8; pn = w / gs; pm = fm + w - pn * gs; }

struct Frame { LAS unsigned char* lds; int tid, lane, wid, bid, G; unsigned char* ws; };
__device__ __forceinline__ const void* ldp(const Frame& F, int off) {
    const u32x2 v = *(const volatile LAS u32x2*)(F.lds + PARAM_OFF + off);
    const unsigned lo = __builtin_amdgcn_readfirstlane(v.x), hi = __builtin_amdgcn_readfirstlane(v.y);
    return (const void*)(((unsigned long long)hi << 32) | lo);
}
#define PP(f) ((const float*)ldp(F, (int)__builtin_offsetof(Params, f)))
#define F_mod ((float*)(F.ws + WS_MOD))
#define F_M1 ((bf16_t*)(F.ws + WS_M1))
#define F_M2 ((bf16_t*)(F.ws + WS_M2))
#define F_ROPE ((f32x2*)(F.ws + WS_ROPE))
#define F_TW ((f32x2*)(F.ws + WS_TW))
#define F_WF ((float*)(F.ws + WS_WF))
#define F_TOPW ((float*)(F.ws + WS_TOPW))
#define F_POS ((int*)(F.ws + WS_POS))
#define F_LIST ((int*)(F.ws + WS_LIST))
#define F_H ((bf16_t*)(F.ws + WS_H))
#define F_MIX ((bf16_t*)(F.ws + WS_MIX))
#define F_XS ((float*)(F.ws + WS_XS))
#define F_PROJ ((bf16_t*)(F.ws + WS_PROJ))
#define F_Z ((float*)(F.ws + WS_Z))
#define F_A1 ((float*)(F.ws + WS_A1))
#define F_ACT ((bf16_t*)(F.ws + WS_ACT))
#define F_Y ((bf16_t*)(F.ws + WS_Y))
#define F_cnt ((unsigned*)(F.ws + WS_CTL) + CW_CNT)

__device__ __forceinline__ const float* modp(const Frame& F, int l, int r, int which) { return F_mod + ((size_t)(l * 5 + r)) * 6144 + which * 1024; }
__device__ __forceinline__ int mod_row(int row) { return row < NMAIN ? (row >> 12) : 4; }

__device__ __forceinline__ float row_rstd(const f32x4 (&v)[4]) {
    float s = 0.f;
#pragma unroll
    for (int j = 0; j < 4; ++j) s += (v[j][0] * v[j][0] + v[j][1] * v[j][1]) + (v[j][2] * v[j][2] + v[j][3] * v[j][3]);
    return __builtin_amdgcn_rsqf(wave_sum(s) * (1.f / D) + NORM_EPS);
}
__device__ __forceinline__ void norm_mod_store(const f32x4 (&v)[4], float rstd, const float* gam, const float* sc, const float* sh, bf16_t* dst, int lane, f32x4 (*keep)[4] = nullptr) {
#pragma unroll
    for (int j = 0; j < 4; ++j) {
        const int c = 4 * lane + 256 * j;
        const f32x4 g = *(const f32x4*)(gam + c), s1 = *(const f32x4*)(sc + c), s0 = *(const f32x4*)(sh + c);
        f32x4 h;
#pragma unroll
        for (int i = 0; i < 4; ++i) h[i] = v[j][i] * rstd * g[i] * (1.f + s1[i]) + s0[i];
        u32x2 w; w.x = pk2(h[0], h[1]); w.y = pk2(h[2], h[3]);
        *(u32x2*)(dst + c) = w;
        if (keep) (*keep)[j] = h;
    }
}

__device__ __forceinline__ void phase_prep(Frame& F) {
    LAS float* sil = (LAS float*)F.lds;
    LAS float* red = (LAS float*)(F.lds + 20480);
    LAS float* ct = (LAS float*)(F.lds + 32768);
    for (int idx = F.tid; idx < 5120; idx += 512) { const int r = idx >> 10, k = idx & 1023; const float v = r < 4 ? PP(c)[r * 1024 + k] : PP(c_ctx)[k]; sil[idx] = v / (1.f + __expf(-v)); }
    if (F.tid < 128) ct[F.tid] = cospif((float)F.tid / 64.f);
    __syncthreads();
    constexpr int N_ADA = 192, N_CONST = 8, N_FOLD = 256, N_CVT = 368;
    for (int it = F.bid; it < N_ADA + N_CONST + N_FOLD + N_CVT; it += F.G) {
        if (it < N_ADA) {
            const int l = it / 96, j0 = (it % 96) * 64, col = j0 + F.lane;
            const float* w = PP(ada_w) + ((size_t)l * 1024 + F.wid * 128) * 6144 + col;
            float a[5] = {0.f, 0.f, 0.f, 0.f, 0.f};
#pragma unroll 8
            for (int k = 0; k < 128; ++k) { const float wv = w[(size_t)k * 6144];
#pragma unroll
                for (int r = 0; r < 5; ++r) a[r] += sil[r * 1024 + F.wid * 128 + k] * wv; }
#pragma unroll
            for (int r = 0; r < 5; ++r) red[(F.wid * 5 + r) * 64 + F.lane] = a[r];
            __syncthreads();
            if (F.tid < 320) { const int r = F.tid >> 6, ln = F.tid & 63; float s = 0.f;
#pragma unroll
                for (int w8 = 0; w8 < 8; ++w8) s += red[(w8 * 5 + r) * 64 + ln];
                F_mod[(size_t)(l * 5 + r) * 6144 + j0 + ln] = s + PP(ada_b)[l * 6144 + j0 + ln]; }
            __syncthreads();
        } else if (it < N_ADA + N_CONST) {
            const int gt = (it - N_ADA) * 512 + F.tid;
            for (int e = gt; e < 32768; e += 4096) {
                const int row = e >> 7, kk = e & 127;
                float v1 = 0.f, v2 = 0.f;
                if (row < 128) { const int ro = row >> 6, k1 = row & 63, n1 = kk >> 1, ri = kk & 1; const float ph = (float)((n1 * k1) & 63) / 32.f; const float cs = cospif(ph), sn = sinpif(ph);
                    v1 = (ro == ri) ? cs : (ro == 0 ? sn : -sn); }
                if (row < 64) { const int ro = kk >> 6, n2 = kk & 63; const float ph = (float)((row * n2) & 63) / 32.f; v2 = ro == 0 ? cospif(ph) : sinpif(ph); }
                F_M1[e] = (bf16_t)(pk2(v1, 0.f) & 0xffffu); F_M2[e] = (bf16_t)(pk2(v2, 0.f) & 0xffffu);
            }
            if (gt < 1024) { const int pos = gt >> 4, f = gt & 15; const double ang = (double)pos * pow(10000.0, -(double)f / 16.0); F_ROPE[gt] = (f32x2){(float)cos(ang), (float)sin(ang)}; }
            { const float ph = (float)gt / 2048.f; F_TW[gt] = (f32x2){cospif(ph), sinpif(ph)}; }
        } else if (it >= N_ADA + N_CONST + N_FOLD) {
            int ci = it - (N_ADA + N_CONST + N_FOLD); const float* src; bf16_t* dst; int sld, dld, ncol;
            if (ci < 144) { src = PP(even_w_in); dst = (bf16_t*)(F.ws + WB_EIN); sld = EVEN_IN; dld = EVEN_IN; ncol = EVEN_IN; }
            else if (ci < 208) { ci -= 144; src = PP(even_w_out); dst = (bf16_t*)(F.ws + WB_EOUT); sld = D; dld = D; ncol = D; }
            else if (ci < 304) { ci -= 208; src = PP(odd_w_in); dst = (bf16_t*)(F.ws + WB_OIN); sld = 2048; dld = 2560; ncol = 1536; }
            else { ci -= 304; src = PP(odd_w_out); dst = (bf16_t*)(F.ws + WB_OOUT); sld = D; dld = D; ncol = D; }
            const int q4 = ncol >> 2;
#pragma unroll
            for (int u = 0; u < 8; ++u) { const int gidx = ci * 4096 + u * 512 + F.tid, row = gidx / q4, c4 = (gidx - row * q4) * 4;
                const f32x4 v = *(const f32x4*)(src + (size_t)row * sld + c4); u32x2 w; w.x = pk2(v[0], v[1]); w.y = pk2(v[2], v[3]); *(u32x2*)(dst + (size_t)row * dld + c4) = w; }
        } else {
            const int fi = it - N_ADA - N_CONST, rc = fi >> 2, g = fi & 3, half = F.tid >> 8, j = F.tid & 255, jj = j & 127;
            for (int i2 = 0; i2 < 8; ++i2) {
                const int row = rc * 16 + i2 * 2 + half;
                const float* wr_ = PP(odd_w_in) + (size_t)row * 2048 + 1536 + g * 128;
                float s = 0.f;
                if (j < 128) { for (int cc = 0; cc < 128; ++cc) s += wr_[cc] * ct[(cc * jj) & 127]; }
                else { for (int cc = 0; cc < 128; ++cc) s -= wr_[cc] * ct[((cc * jj) - 32) & 127]; }
                ((bf16_t*)(F.ws + WB_OIN))[(size_t)row * 2560 + 1536 + g * 256 + j] = (bf16_t)(pk2(s, 0.f) & 0xffffu);
            }
        }
    }
}

__device__ __forceinline__ void phase_norm1_l0(Frame& F) {
    const int gw = F.bid * 8 + F.wid, NGW = F.G * 8;
    for (int row = gw; row < NTOK; row += NGW) {
        const float* src = row < NMAIN ? PP(x) + (size_t)row * D : PP(ctx) + (size_t)(row - NMAIN) * D;
        f32x4 v[4];
#pragma unroll
        for (int j = 0; j < 4; ++j) v[j] = *(const f32x4*)(src + 4 * F.lane + 256 * j);
        const float rstd = row_rstd(v); const int r = mod_row(row);
        norm_mod_store(v, rstd, PP(norm_mix), modp(F, 0, r, 1), modp(F, 0, r, 0), F_H + (size_t)row * D, F.lane);
    }
}

#define EPI_GEOM const int wid = this->wid, lane = this->lane, wr = wid >> 2, wc = wid & 3, fr = lane & 15, fq = lane >> 4; (void)wr; (void)wc; (void)fr; (void)fq
struct PolBase { unsigned char* ws; LAS unsigned char* lds; int wid, lane, nt; unsigned lcolb, woff, ldbB; XOrder xo; int aC, aR0, aCb, aR0b; bool bfm;
    __device__ __forceinline__ void base_init(Frame& F, int nt_, int T) { ws = F.ws; lds = F.lds; wid = F.wid; lane = F.lane; nt = nt_; lcolb = 16u * (unsigned)F.lane; woff = 8u * (unsigned)F.lane;
        xo.init(T, F.G, F.bid); aC = a_piece_col(F.wid, F.lane); aR0 = a_piece_row0(F.wid, F.lane); bfm = true;
        { const int sbb = F.lane * 16, swz = sbb ^ (((sbb >> 9) & 1) << 5); aR0b = F.wid * 32 + (swz >> 6); aCb = (swz & 63) >> 1; } }
    bool has_bias = false; const float* bias = nullptr;
    __device__ __forceinline__ unsigned bias_voff(const TD&) const { return 0u; }
    __device__ __forceinline__ bool tileL(int i, int& L) const { L = xo.cur + i * xo.step; return L < xo.c1; }
    __device__ __forceinline__ int prow(int i) const { return bfm ? aR0b + 16 * (i & 1) : aR0 + 64 * i; }
    __device__ __forceinline__ int pcol() const { return bfm ? aCb : aC; }
    __device__ __forceinline__ void dense_aoff(TD& td, int row0, int pitch) const {
#pragma unroll
        for (int i = 0; i < 4; ++i) td.aoff[i] = (unsigned)(((row0 + prow(i)) * pitch + pcol()) * 2); }
};

struct PolInproj0 : PolBase {
    const float* W; Frame* Fp;
    __device__ __forceinline__ bool get(int i, TD& td) const { int L; if (!tileL(i, L)) return false; int pm, pn; dense_tile(L, NTOK / 256, EVEN_IN / 256, pm, pn);
        td.A = (const bf16_t*)(ws + WS_H); dense_aoff(td, pm * 256, D); td.B = (const bf16_t*)(ws + WB_EIN) + pn * 256; td.i0 = pm; td.i1 = pn; return true; }
    __device__ __forceinline__ void epi(f32x4 (&acc)[8][4], const TD& td, const LAS float* bl) const { (void)bl; EPI_GEOM; const int pm = td.i0, pn = td.i1;
        const int colb = pn * 256 + wc * 64; const bool rope = (colb < 640) && (pm < NMAIN / 256);
        const f32x2* ROPE = (const f32x2*)(ws + WS_ROPE); bf16_t* PROJ = (bf16_t*)(ws + WS_PROJ);
#pragma unroll
        for (int m = 0; m < 8; ++m) { const int row = pm * 256 + wr * 128 + m * 16 + fr;
            if (rope) { const int tt = row & (SEQ - 1), gr = tt >> 6, gc = tt & 63;
#pragma unroll
                for (int n = 0; n < 2; ++n) { const int pos = n == 0 ? gr : gc;
#pragma unroll
                    for (int j = 0; j < 4; ++j) { const f32x2 cs = ROPE[pos * 16 + 4 * fq + j]; const float x1 = acc[m][n][j], x2 = acc[m][n + 2][j];
                        acc[m][n][j] = x1 * cs.x - x2 * cs.y; acc[m][n + 2][j] = x2 * cs.x + x1 * cs.y; } } }
#pragma unroll
            for (int n = 0; n < 4; ++n) { u32x2 w; w.x = pk2(acc[m][n][0], acc[m][n][1]); w.y = pk2(acc[m][n][2], acc[m][n][3]);
                *(u32x2*)(PROJ + (size_t)row * EVEN_IN + colb + n * 16 + 4 * fq) = w; } } }
};
__device__ __forceinline__ void phase_inproj_l0(Frame& F) {
    PolInproj0 P; P.base_init(F, D / 64, (NTOK / 256) * (EVEN_IN / 256)); P.ldbB = EVEN_IN;
    gemm_stream_bf(F.lds, P, F.wid, F.lane);
}

struct PolOutproj : PolBase {
    const float *W, *x, *ctx; int layer, nM;
    __device__ __forceinline__ bool get(int i, TD& td) const { int L; if (!tileL(i, L)) return false; int pm, pn; dense_tile(L, nM, 4, pm, pn);
        td.A = (const bf16_t*)(ws + WS_MIX); dense_aoff(td, pm * 256, D); td.B = (const bf16_t*)(ws + (layer == 0 ? WB_EOUT : WB_OOUT)) + pn * 256; td.i0 = pm; td.i1 = pn; return true; }
    __device__ __forceinline__ void epi(f32x4 (&acc)[8][4], const TD& td, const LAS float* bl) const { (void)bl; EPI_GEOM; const int pm = td.i0, pn = td.i1;
        const int colb = pn * 256 + wc * 64; float* XS = (float*)(ws + WS_XS); const float* mod = (const float*)(ws + WS_MOD);
#pragma unroll
        for (int m = 0; m < 8; ++m) { const int row = pm * 256 + wr * 128 + m * 16 + fr; const int r = mod_row(row);
            const float* xin = layer == 0 ? (row < NMAIN ? x + (size_t)row * D : ctx + (size_t)(row - NMAIN) * D) : XS + (size_t)row * D;
            const float* g1 = mod + ((size_t)(layer * 5 + r)) * 6144 + 2 * 1024;
#pragma unroll
            for (int n = 0; n < 4; ++n) { const int c = colb + n * 16 + 4 * fq; const f32x4 xv = *(const f32x4*)(xin + c), gv = *(const f32x4*)(g1 + c);
                f32x4 o;
#pragma unroll
                for (int j = 0; j < 4; ++j) o[j] = xv[j] + gv[j] * acc[m][n][j];
                *(f32x4*)(XS + (size_t)row * D + c) = o; } } }
};
__device__ __forceinline__ void phase_outproj(Frame& F, const int layer) {
    PolOutproj P; P.layer = layer; P.nM = (layer == 0 ? NTOK : NMAIN) / 256; P.base_init(F, D / 64, P.nM * 4);
    P.ldbB = D; P.x = PP(x); P.ctx = PP(ctx);
    gemm_stream_bf(F.lds, P, F.wid, F.lane);
}

constexpr int QT = 2;
struct AttnSt { f32x4 o[4][QT]; float m[QT], l[QT]; };
#define V_ROWB 160
__device__ __forceinline__ void v_stage(LAS unsigned char* vl, const bf16_t* vsrc, int ld, int lane) {
    i32x4 t[4];
#pragma unroll
    for (int i = 0; i < 4; ++i) t[i] = *(const i32x4*)(vsrc + (size_t)((lane >> 3) + 8 * i) * ld + (lane & 7) * 8);
#pragma unroll
    for (int i = 0; i < 4; ++i) *(LAS i32x4*)(vl + ((lane >> 3) + 8 * i) * V_ROWB + (lane & 7) * 16) = t[i];
}
#define ATTN_STEP(ksrc, kld, vsrc, vld, SCALE, BIAS) do { \
    bf16x8 kf[2][2]; \
    _Pragma("unroll") for (int kt = 0; kt < 2; ++kt) _Pragma("unroll") for (int ks = 0; ks < 2; ++ks) \
        kf[kt][ks] = *(const bf16x8*)((ksrc) + (size_t)(kt * 16 + fr) * (kld) + ks * 32 + 8 * fq); \
    v_stage(vl, (vsrc), (vld), lane); \
    bf16x8 vf[4]; \
    _Pragma("unroll") for (int dt = 0; dt < 4; ++dt) { \
        const s16x4 lo = __builtin_amdgcn_ds_read_tr16_b64_v4i16((LAS s16x4*)(vl + (4 * fq + (fr >> 2)) * V_ROWB + (dt * 16 + (fr & 3) * 4) * 2)); \
        const s16x4 hi = __builtin_amdgcn_ds_read_tr16_b64_v4i16((LAS s16x4*)(vl + (16 + 4 * fq + (fr >> 2)) * V_ROWB + (dt * 16 + (fr & 3) * 4) * 2)); \
        vf[dt] = (bf16x8){lo[0], lo[1], lo[2], lo[3], hi[0], hi[1], hi[2], hi[3]}; } \
    _Pragma("unroll") for (int qt = 0; qt < QT; ++qt) { \
        f32x4 s[2]; \
        _Pragma("unroll") for (int kt = 0; kt < 2; ++kt) { s[kt] = (f32x4){0.f, 0.f, 0.f, 0.f}; \
            _Pragma("unroll") for (int ks = 0; ks < 2; ++ks) s[kt] = __builtin_amdgcn_mfma_f32_16x16x32_bf16(kf[kt][ks], qf[qt][ks], s[kt], 0, 0, 0); } \
        float mx = -INFINITY; \
        _Pragma("unroll") for (int kt = 0; kt < 2; ++kt) _Pragma("unroll") for (int j = 0; j < 4; ++j) { const float tv = s[kt][j] * (SCALE) + BIAS(qt, kt, j); s[kt][j] = tv; mx = fmaxf(mx, tv); } \
        mx = fmaxf(mx, __shfl_xor(mx, 16)); mx = fmaxf(mx, __shfl_xor(mx, 32)); \
        const float mn = fmaxf(st.m[qt], mx), al = fexp2(st.m[qt] - mn); st.m[qt] = mn; \
        float ps = 0.f; \
        _Pragma("unroll") for (int kt = 0; kt < 2; ++kt) _Pragma("unroll") for (int j = 0; j < 4; ++j) { const float pv = fexp2(s[kt][j] - mn); s[kt][j] = pv; ps += pv; } \
        st.l[qt] = st.l[qt] * al + ps; \
        const unsigned w0 = pk2(s[0][0], s[0][1]), w1 = pk2(s[0][2], s[0][3]), w2 = pk2(s[1][0], s[1][1]), w3 = pk2(s[1][2], s[1][3]); \
        const bf16x8 pf = __builtin_bit_cast(bf16x8, ((u32x4){w0, w1, w2, w3})); \
        _Pragma("unroll") for (int dt = 0; dt < 4; ++dt) st.o[dt][qt] = __builtin_amdgcn_mfma_f32_16x16x32_bf16(vf[dt], pf, st.o[dt][qt] * al, 0, 0, 0); } \
    } while (0)

__device__ __forceinline__ void attn_store(AttnSt& st, bf16_t* dst  , int dld, int fr, int fq) {
#pragma unroll
    for (int qt = 0; qt < QT; ++qt) {
        float l = st.l[qt]; l += __shfl_xor(l, 16); l += __shfl_xor(l, 32);
        const float inv = 1.f / l;
#pragma unroll
        for (int dt = 0; dt < 4; ++dt) { const f32x4 o = st.o[dt][qt] * inv; u32x2 w; w.x = pk2(o[0], o[1]); w.y = pk2(o[2], o[3]);
            *(u32x2*)(dst + (size_t)(qt * 16 + fr) * dld + dt * 16 + 4 * fq) = w; }
    }
}

__device__ __forceinline__ void phase_attn_l0(Frame& F) {
    const int wid = F.wid, lane = F.lane, fr = lane & 15, fq = lane >> 4;
    LAS unsigned char* vl = F.lds + wid * 8192;
    constexpr int N_WIN = 256, N_CTXA = 16, N_CONV = NTOK / 64;
    const float SC = 0.125f * LOG2E;
    for (int it = F.bid; it < N_WIN + N_CTXA + N_CONV; it += F.G) {
        if (it < N_WIN + N_CTXA) {
            const bool isctx = it >= N_WIN;
            int b, kvh, qb;
            if (!isctx) { b = it >> 6; kvh = (it >> 5) & 1; qb = it & 31; } else { const int c = it - N_WIN; b = c >> 2; kvh = (c >> 1) & 1; qb = c & 1; }
            const int g = wid >> 1, h = kvh * 4 + g;
            for (int qh = 0; qh < 4 / QT; ++qh) {
            const int qq0 = (wid & 1) * 64 + qh * (16 * QT);
            const int qrow0 = (isctx ? NMAIN + b * CTXL : b * SEQ) + qb * 128 + qq0;
            bf16x8 qf[QT][2];
#pragma unroll
            for (int qt = 0; qt < QT; ++qt)
#pragma unroll
                for (int ks = 0; ks < 2; ++ks) qf[qt][ks] = *(const bf16x8*)(F_PROJ + (size_t)(qrow0 + qt * 16 + fr) * EVEN_IN + h * 64 + ks * 32 + 8 * fq);
            AttnSt st;
            const float sink = PP(even_sink)[h] * LOG2E;
#pragma unroll
            for (int qt = 0; qt < QT; ++qt) { st.m[qt] = sink; st.l[qt] = (fq == 0) ? 1.f : 0.f;
#pragma unroll
                for (int dt = 0; dt < 4; ++dt) st.o[dt][qt] = (f32x4){0.f, 0.f, 0.f, 0.f}; }
            const int kcol = 512 + kvh * 64, vcol = 640 + kvh * 64;
            for (int ch = isctx ? 3 : 0; ch < 5; ++ch) {
                int krow0;
                if (ch < 3) { const int kb = qb - 1 + ch; if (kb < 0 || kb >= SEQ / 128) continue; krow0 = b * SEQ + kb * 128; } else krow0 = NMAIN + b * CTXL + (ch - 3) * 128;
                for (int s32 = 0; s32 < 4; ++s32) {
                    const bf16_t* kp = F_PROJ + (size_t)(krow0 + s32 * 32) * EVEN_IN + kcol;
                    const bf16_t* vp = F_PROJ + (size_t)(krow0 + s32 * 32) * EVEN_IN + vcol;
                    if (ch == 0) {
#define BIAS_PREV(qt, kt, j) ((s32 * 32 + kt * 16 + 4 * fq + j) >= (qq0 + qt * 16 + fr) ? 0.f : -INFINITY)
                        ATTN_STEP(kp, EVEN_IN, vp, EVEN_IN, SC, BIAS_PREV);
                    } else if (ch == 2) {
#define BIAS_NEXT(qt, kt, j) ((s32 * 32 + kt * 16 + 4 * fq + j) <= (qq0 + qt * 16 + fr) ? 0.f : -INFINITY)
                        ATTN_STEP(kp, EVEN_IN, vp, EVEN_IN, SC, BIAS_NEXT);
                    } else {
#define BIAS_NONE(qt, kt, j) 0.f
                        ATTN_STEP(kp, EVEN_IN, vp, EVEN_IN, SC, BIAS_NONE);
                    }
                }
            }
            attn_store(st, F_MIX + (size_t)qrow0 * D + h * 64, D, fr, fq);
            }
        } else {
            const int ci = it - N_WIN - N_CTXA, c4 = (F.tid & 127) * 4, r0 = ci * 64 + (F.tid >> 7) * 16;
            const f32x4 w0 = *(const f32x4*)(PP(even_conv_w) + c4), w1 = *(const f32x4*)(PP(even_conv_w) + 512 + c4), w2 = *(const f32x4*)(PP(even_conv_w) + 1024 + c4);
#define LOADZ(dst, row_) do { const u32x2 gc_ = *(const u32x2*)(F_PROJ + (size_t)(row_) * EVEN_IN + 1280 + c4), uu_ = *(const u32x2*)(F_PROJ + (size_t)(row_) * EVEN_IN + 1792 + c4); \
                dst = (f32x4){bflo(gc_.x) * bflo(uu_.x), bfhi(gc_.x) * bfhi(uu_.x), bflo(gc_.y) * bflo(uu_.y), bfhi(gc_.y) * bfhi(uu_.y)}; } while (0)
            const int seqmask = r0 < NMAIN ? (SEQ - 1) : (CTXL - 1);
            f32x4 zp = (f32x4){0.f, 0.f, 0.f, 0.f}, zc, zn;
            if ((r0 & seqmask) != 0) LOADZ(zp, r0 - 1);
            LOADZ(zc, r0);
            for (int i = 0; i < 16; ++i) {
                const int row = r0 + i;
                zn = (f32x4){0.f, 0.f, 0.f, 0.f}; if ((row & seqmask) != seqmask) LOADZ(zn, row + 1);
                const u32x2 gb = *(const u32x2*)(F_PROJ + (size_t)row * EVEN_IN + 768 + c4);
                const f32x4 y = zp * w0 + zc * w1 + zn * w2;
                u32x2 w; w.x = pk2(bflo(gb.x) * y[0], bfhi(gb.x) * y[1]); w.y = pk2(bflo(gb.y) * y[2], bfhi(gb.y) * y[3]);
                *(u32x2*)(F_MIX + (size_t)row * D + 512 + c4) = w;
                zp = zc; zc = zn;
            }
        }
    }
}

constexpr int RW_LD = 1028;
__device__ __forceinline__ void phase_route(Frame& F, const int layer) {
    const int nrows = layer == 0 ? NTOK : NMAIN;
    LAS float* rwT = (LAS float*)F.lds;
    LAS int* cntL = (LAS int*)(F.lds + 32 * RW_LD * 4);
    LAS int* baseL = cntL + 32;
    LAS int* selE = baseL + 32;
    LAS int* selR = selE + 288;
    const float* rw = PP(router_w) + (size_t)layer * D * NEXP;
    { const f32x4* rsrc4 = (const f32x4*)rw + F.tid; LAS float* wp = rwT + ((4 * F.tid) & 31) * RW_LD + (F.tid >> 3);
      for (int it = 0; it < 4; ++it) {
        f32x4 v[4];
#pragma unroll
        for (int u = 0; u < 4; ++u) v[u] = rsrc4[(it * 4 + u) * 512];
#pragma unroll
        for (int u = 0; u < 4; ++u)
#pragma unroll
            for (int j = 0; j < 4; ++j) wp[it * 256 + u * 64 + j * RW_LD] = v[u][j];
        asm volatile("" ::: "memory"); } }
    if (F.tid < 32) cntL[F.tid] = 0;
    __syncthreads();
    const int lane = F.lane, gw = F.bid * 8 + F.wid, NGW = F.G * 8;
    const float* gam = PP(norm_ffn) + layer * D;
    int slot = F.wid;
    f32x4 vn[4];
    if (gw < nrows) {
#pragma unroll
        for (int j = 0; j < 4; ++j) vn[j] = *(const f32x4*)(F_XS + (size_t)gw * D + 4 * lane + 256 * j); }
    for (int row = gw; row < nrows; row += NGW, slot += 8) {
        f32x4 v[4], h[4];
#pragma unroll
        for (int j = 0; j < 4; ++j) v[j] = vn[j];
        if (row + NGW < nrows) {
#pragma unroll
            for (int j = 0; j < 4; ++j) vn[j] = *(const f32x4*)(F_XS + (size_t)(row + NGW) * D + 4 * lane + 256 * j); }
        const float rstd = row_rstd(v); const int r = mod_row(row);
        norm_mod_store(v, rstd, gam, modp(F, layer, r, 4), modp(F, layer, r, 3), F_H + (size_t)row * D, lane, &h);
        float pe[32];
#pragma unroll
        for (int e = 0; e < 32; ++e) { float s = 0.f;
#pragma unroll
            for (int j = 0; j < 4; ++j) { const f32x4 w = *(const LAS f32x4*)(rwT + e * RW_LD + 4 * lane + 256 * j); s += (h[j][0] * w[0] + h[j][1] * w[1]) + (h[j][2] * w[2] + h[j][3] * w[3]); }
            pe[e] = s; if ((e & 3) == 3) __builtin_amdgcn_sched_barrier(0); }
        float q16[16], q8[8], q4[4], q2[2], q1;
        { const bool hi = lane & 32;
#pragma unroll
          for (int i = 0; i < 16; ++i) { const float snd = hi ? pe[i] : pe[16 + i], mine = hi ? pe[16 + i] : pe[i]; q16[i] = mine + __shfl_xor(snd, 32); } }
        { const bool hi = lane & 16;
#pragma unroll
          for (int i = 0; i < 8; ++i) { const float snd = hi ? q16[i] : q16[8 + i], mine = hi ? q16[8 + i] : q16[i]; q8[i] = mine + __shfl_xor(snd, 16); } }
        { const bool hi = lane & 8;
#pragma unroll
          for (int i = 0; i < 4; ++i) { const float snd = hi ? q8[i] : q8[4 + i], mine = hi ? q8[4 + i] : q8[i]; q4[i] = mine + __shfl_xor(snd, 8); } }
        { const bool hi = lane & 4;
#pragma unroll
          for (int i = 0; i < 2; ++i) { const float snd = hi ? q4[i] : q4[2 + i], mine = hi ? q4[2 + i] : q4[i]; q2[i] = mine + __shfl_xor(snd, 4); } }
        { const bool hi = lane & 2; const float snd = hi ? q2[0] : q2[1], mine = hi ? q2[1] : q2[0]; q1 = mine + __shfl_xor(snd, 2); }
        q1 += __shfl_xor(q1, 1);
        const int myE = (lane >> 1) & 31;
        float val = q1 + PP(router_b)[layer * NEXP + myE];
        float tv[4]; int te[4];
#pragma unroll
        for (int k = 0; k < 4; ++k) {
            float bv = val; int be = myE;
#pragma unroll
            for (int o = 1; o < 64; o <<= 1) { const float ov = __shfl_xor(bv, o); const int oe = __shfl_xor(be, o); if (ov > bv || (ov == bv && oe < be)) { bv = ov; be = oe; } }
            tv[k] = bv; te[k] = be; if (myE == be) val = -INFINITY;
        }
        const float e1 = __expf(tv[1] - tv[0]), e2 = __expf(tv[2] - tv[0]), e3 = __expf(tv[3] - tv[0]), inv = 1.f / (1.f + e1 + e2 + e3);
        if (lane == 0) {
            *(f32x4*)(F_TOPW + (size_t)row * 4) = (f32x4){inv, e1 * inv, e2 * inv, e3 * inv};
#pragma unroll
            for (int k = 0; k < 4; ++k) { selE[slot * 4 + k] = te[k]; selR[slot * 4 + k] = atomicAdd((int*)(cntL + te[k]), 1); }
        }
    }
    __syncthreads();
    if (F.tid < 32) { const int c = cntL[F.tid]; baseL[F.tid] = c ? (int)atomicAdd(F_cnt + layer * 32 + F.tid, (unsigned)c) : 0; }
    __syncthreads();
    if (F.tid < 288) { const int s = F.tid >> 2, k = F.tid & 3; const int row = F.bid * 8 + (s & 7) + (s >> 3) * NGW;
        if (row < nrows) { const int e = selE[F.tid], pos = baseL[e] + selR[F.tid]; F_POS[(size_t)row * 4 + k] = e | (pos << 8); F_LIST[(size_t)e * NTOK + pos] = row; } }
    __syncthreads();
}

struct MoeLds { LAS int *mtp, *roff, *mtq, *nz; };
__device__ __forceinline__ MoeLds moe_lds(Frame& F) { MoeLds L; L.mtp = (LAS int*)(F.lds + 2 * STAGE_B); L.roff = L.mtp + 40; L.mtq = L.roff + 40; L.nz = L.mtq + 40; return L; }
__device__ __forceinline__ void moe_prefix(Frame& F, const int layer, const MoeLds& L) {
    if (F.tid < 64) { const int e = F.lane & 31; const int c = (int)__hip_atomic_load(F_cnt + layer * 32 + e, __ATOMIC_RELAXED, __HIP_MEMORY_SCOPE_AGENT);
        const int mt = (c + 255) >> 8; int a = mt, b = c, q = mt > 0 ? mt - 1 : 0, z = mt > 0 ? 1 : 0;
#pragma unroll
        for (int o = 1; o < 32; o <<= 1) { const int ua = __shfl_up(a, o, 32), ub = __shfl_up(b, o, 32), uq = __shfl_up(q, o, 32), uz = __shfl_up(z, o, 32); if (e >= o) { a += ua; b += ub; q += uq; z += uz; } }
        if (F.lane < 32) { L.mtp[e + 1] = a; L.roff[e + 1] = b; L.mtq[e + 1] = q; if (mt > 0) L.nz[z - 1] = e; if (e == 31) L.nz[32] = z; if (e == 0) { L.mtp[0] = 0; L.roff[0] = 0; L.mtq[0] = 0; } } }
    __syncthreads();
}
struct PolMoe : PolBase {
    const float* W; MoeLds L; int layer, nct, round; size_t bc_off;
    __device__ __forceinline__ bool find(int i, int& e, int& ct, int& rbase, int& ro, int& cnt) const { int T; if (!tileL(i, T)) return false;
        if (round == 0) { const int q = T / nct; ct = T - q * nct; e = __builtin_amdgcn_readfirstlane(L.nz[q]); rbase = 0; }
        else { LAS int* pf = round == 1 ? L.mtq : L.mtp; e = 0; while (pf[e + 1] * nct <= T) ++e;
            e = __builtin_amdgcn_readfirstlane(e);
            const int mq = __builtin_amdgcn_readfirstlane(pf[e + 1] - pf[e]), w = T - __builtin_amdgcn_readfirstlane(pf[e]) * nct; ct = w / mq; rbase = ((round == 1 ? 1 : 0) + w - ct * mq) * 256; }
        ro = __builtin_amdgcn_readfirstlane(L.roff[e]); cnt = __builtin_amdgcn_readfirstlane(L.roff[e + 1]) - ro; return true; }
    __device__ __forceinline__ bf16_t* panel(int e, int ct) const { return (bf16_t*)(ws + bc_off) + (size_t)(e * nct + ct) * (1024 * 256); }
};
struct PolMoe1 : PolMoe {
    __device__ __forceinline__ unsigned bias_voff(const TD& td) const { return 4u * (unsigned)((layer * NEXP + td.i0) * (2 * DFF) + (lane >> 5) * DFF + td.i1 * 128 + (lane & 31) * 4); }
    __device__ __forceinline__ bool get(int i, TD& td) const { int e, ct, rbase, ro, cnt; if (!find(i, e, ct, rbase, ro, cnt)) return false;
        const int* list = (const int*)(ws + WS_LIST) + (size_t)e * NTOK; td.A = (const bf16_t*)(ws + WS_H);
#pragma unroll
        for (int i2 = 0; i2 < 4; ++i2) { int rr = rbase + prow(i2); rr = rr < cnt ? rr : cnt - 1; td.aoff[i2] = (unsigned)((list[rr] * D + pcol()) * 2); }
        if (round == 0) { td.B = W + ((size_t)(layer * NEXP + e) * D + wid * 8) * (2 * DFF) + ct * 128; td.ldb = 2 * DFF; td.bco = panel(e, ct); } else { td.B = panel(e, ct); td.bco = nullptr; }
        td.i0 = e; td.i1 = ct; td.i2 = rbase; td.i3 = ro; td.i4 = cnt; return true; }
    __device__ __forceinline__ void epi(f32x4 (&acc)[8][4], const TD& td, const LAS float* bl) const { (void)bl; EPI_GEOM; const int e = td.i0, ct = td.i1, rbase = td.i2, ro = td.i3, cnt = td.i4;
        bf16_t* ACT = (bf16_t*)(ws + WS_ACT);
#pragma unroll
        for (int n = 0; n < 2; ++n) { const int gc = ct * 128 + wc * 32 + n * 16 + 4 * fq;
            const int gl = wc * 32 + n * 16 + 4 * fq; const f32x4 bg = bl ? *(const LAS f32x4*)(bl + gl) : *(const f32x4*)(bias + (size_t)(layer * NEXP + e) * (2 * DFF) + gc), bu = bl ? *(const LAS f32x4*)(bl + 128 + gl) : *(const f32x4*)(bias + (size_t)(layer * NEXP + e) * (2 * DFF) + DFF + gc);
#pragma unroll
            for (int m = 0; m < 8; ++m) { const int r = rbase + wr * 128 + m * 16 + fr; float a[4];
#pragma unroll
                for (int j = 0; j < 4; ++j) { const float gg = fminf(acc[m][n][j] + bg[j], 7.f), uu = __builtin_amdgcn_fmed3f(acc[m][n + 2][j] + bu[j], -7.f, 7.f);
                    a[j] = (uu + 1.f) * gg * __builtin_amdgcn_rcpf(1.f + fexp2(-1.702f * LOG2E * gg)); }
                if (r < cnt) { u32x2 w; w.x = pk2(a[0], a[1]); w.y = pk2(a[2], a[3]); *(u32x2*)(ACT + (size_t)(ro + r) * DFF + gc) = w; } } } }
};
struct PolMoe2 : PolMoe {
    __device__ __forceinline__ unsigned bias_voff(const TD& td) const { return 4u * (unsigned)((layer * NEXP + td.i0) * D + td.i1 * 256 + lane * 4); }
    __device__ __forceinline__ bool get(int i, TD& td) const { int e, ct, rbase, ro, cnt; if (!find(i, e, ct, rbase, ro, cnt)) return false;
        td.A = (const bf16_t*)(ws + WS_ACT);
#pragma unroll
        for (int i2 = 0; i2 < 4; ++i2) { int rr = rbase + prow(i2); rr = rr < cnt ? rr : cnt - 1; td.aoff[i2] = (unsigned)(((ro + rr) * DFF + pcol()) * 2); }
        td.B = panel(e, ct); td.bco = nullptr;
        td.i0 = e; td.i1 = ct; td.i2 = rbase; td.i3 = ro; td.i4 = cnt; return true; }
    __device__ __forceinline__ void epi(f32x4 (&acc)[8][4], const TD& td, const LAS float* bl) const { (void)bl; EPI_GEOM; const int e = td.i0, ct = td.i1, rbase = td.i2, ro = td.i3, cnt = td.i4;
        bf16_t* Y = (bf16_t*)(ws + WS_Y);
#pragma unroll
        for (int n = 0; n < 4; ++n) { const int c = ct * 256 + wc * 64 + n * 16 + 4 * fq; const f32x4 bv = bl ? *(const LAS f32x4*)(bl + wc * 64 + n * 16 + 4 * fq) : *(const f32x4*)(bias + (size_t)(layer * NEXP + e) * D + c);
#pragma unroll
            for (int m = 0; m < 8; ++m) { const int r = rbase + wr * 128 + m * 16 + fr;
                if (r < cnt) { u32x2 w; w.x = pk2(acc[m][n][0] + bv[0], acc[m][n][1] + bv[1]); w.y = pk2(acc[m][n][2] + bv[2], acc[m][n][3] + bv[3]); *(u32x2*)(Y + (size_t)(ro + r) * D + c) = w; } } } }
};
__device__ __forceinline__ void phase_moe1(Frame& F, const XcdBarrier& bar, const bool use_bar, const int layer) {
    { const float* Wd = PP(moe_w_dn) + (size_t)layer * NEXP * DFF * D; bf16_t* pd = (bf16_t*)(F.ws + WS_BC2);
      for (int r0 = (F.bid * 8 + F.wid) * 8; r0 < NEXP * 4 * 1024; r0 += F.G * 64) {
          f32x4 v[8];
#pragma unroll
          for (int u = 0; u < 8; ++u) { const int pr = r0 + u, pnl = pr >> 10, k = pr & 1023, e = pnl >> 2, ct = pnl & 3;
              v[u] = *(const f32x4*)(Wd + ((size_t)e * DFF + k) * D + ct * 256 + 4 * F.lane); }
#pragma unroll
          for (int u = 0; u < 8; ++u) { const int pr = r0 + u; u32x2 w; w.x = pk2(v[u][0], v[u][1]); w.y = pk2(v[u][2], v[u][3]);
              *(u32x2*)(pd + (size_t)pr * 256 + 4 * F.lane) = w; } } }
    const MoeLds L = moe_lds(F);
    moe_prefix(F, layer, L);
    const int ne = __builtin_amdgcn_readfirstlane(L.nz[32]), tq = __builtin_amdgcn_readfirstlane(L.mtq[32]);
    const float* W = PP(moe_w_gu); const float* bias = PP(moe_b_gu);
    { PolMoe1 P; P.L = L; P.layer = layer; P.nct = 8; P.round = 0; P.bc_off = WS_BC; P.base_init(F, D / 64, ne * 8); P.bfm = false; P.W = W; P.bias = bias;
      { const int l2 = F.lane & 31; P.lcolb = 4u * (unsigned)((F.lane >> 5) * DFF + 4 * l2); P.woff = 2u * (unsigned)(((4 * l2) >> 5) * 64 + (F.lane >> 5) * 32 + ((4 * l2) & 31)); }
      gemm_stream(F.lds, P, F.wid, F.lane); }
    if (use_bar) xcd_barrier(bar);
    { PolMoe1 P; P.L = L; P.layer = layer; P.nct = 8; P.round = 1; P.bc_off = WS_BC; P.base_init(F, D / 64, tq * 8); P.ldbB = 256; P.W = W; P.bias = bias; P.has_bias = true;
      gemm_stream_bf(F.lds, P, F.wid, F.lane); }
}
__device__ __forceinline__ void phase_moe2(Frame& F, const int layer) {
    const MoeLds L = moe_lds(F);
    moe_prefix(F, layer, L);
    PolMoe2 P; P.L = L; P.layer = layer; P.nct = 4; P.round = 2; P.bc_off = WS_BC2; P.base_init(F, DFF / 64, __builtin_amdgcn_readfirstlane(L.mtp[32]) * 4); P.ldbB = 256; P.W = nullptr; P.bias = PP(moe_b_dn); P.has_bias = true;
    gemm_stream_bf(F.lds, P, F.wid, F.lane);
}

__device__ __forceinline__ void phase_combine(Frame& F, const int layer) {
    const MoeLds ML = moe_lds(F); LAS int* roff = ML.roff;
    moe_prefix(F, layer, ML);
    const int nrows = layer == 0 ? NTOK : NMAIN, lane = F.lane;
    const int gw = F.bid * 8 + F.wid, NGW = F.G * 8;
    i32x4 ps_n = (i32x4){0, 0, 0, 0}; f32x4 tw_n = (f32x4){0.f, 0.f, 0.f, 0.f}, tw_c = tw_n;
    u32x2 y_c[4][4], y_n[4][4]; f32x4 xs_c[4], xs_n[4];
#define CMB_IDX(row_) do { if ((row_) < nrows) { ps_n = *(const i32x4*)(F_POS + (size_t)(row_) * 4); tw_n = *(const f32x4*)(F_TOPW + (size_t)(row_) * 4); } } while (0)
#define CMB_DATA(row_, Y_, XS_) do { if ((row_) < nrows) { \
        _Pragma("unroll") for (int k = 0; k < 4; ++k) { const int e = ps_n[k] & 255, pos = ps_n[k] >> 8; const bf16_t* y = F_Y + (size_t)(roff[e] + pos) * D; \
            _Pragma("unroll") for (int j = 0; j < 4; ++j) Y_[k][j] = *(const u32x2*)(y + 4 * lane + 256 * j); } \
        _Pragma("unroll") for (int j = 0; j < 4; ++j) XS_[j] = *(const f32x4*)(F_XS + (size_t)(row_) * D + 4 * lane + 256 * j); } } while (0)
    CMB_IDX(gw); CMB_DATA(gw, y_c, xs_c); tw_c = tw_n; CMB_IDX(gw + NGW);
    for (int row = gw; row < nrows; row += NGW) {
        CMB_DATA(row + NGW, y_n, xs_n); const f32x4 tw_nn = tw_n; CMB_IDX(row + 2 * NGW);
        const int r = mod_row(row); const float* g2 = modp(F, layer, r, 5);
        f32x4 v[4];
#pragma unroll
        for (int j = 0; j < 4; ++j) v[j] = (f32x4){0.f, 0.f, 0.f, 0.f};
#pragma unroll
        for (int k = 0; k < 4; ++k) { const float w = tw_c[k];
#pragma unroll
            for (int j = 0; j < 4; ++j) { const u32x2 u = y_c[k][j]; v[j][0] += w * bflo(u.x); v[j][1] += w * bfhi(u.x); v[j][2] += w * bflo(u.y); v[j][3] += w * bfhi(u.y); } }
#pragma unroll
        for (int j = 0; j < 4; ++j) { const int c = 4 * lane + 256 * j; const f32x4 gv = *(const f32x4*)(g2 + c); v[j] = xs_c[j] + gv * v[j]; }
        const float rstd = row_rstd(v);
        if (layer == 0) {
#pragma unroll
            for (int j = 0; j < 4; ++j) *(f32x4*)(F_XS + (size_t)row * D + 4 * lane + 256 * j) = v[j];
            norm_mod_store(v, rstd, PP(norm_mix) + D, modp(F, 1, r, 1), modp(F, 1, r, 0), F_H + (size_t)row * D, lane);
        } else {
#pragma unroll
            for (int j = 0; j < 4; ++j) { const int c = 4 * lane + 256 * j; const f32x4 g = *(const f32x4*)(PP(final_norm) + c); *(f32x4*)(((float*)ldp(F, (int)__builtin_offsetof(Params, out))) + (size_t)row * D + c) = v[j] * rstd * g; }
        }
        tw_c = tw_nn;
#pragma unroll
        for (int k = 0; k < 4; ++k)
#pragma unroll
            for (int j = 0; j < 4; ++j) y_c[k][j] = y_n[k][j];
#pragma unroll
        for (int j = 0; j < 4; ++j) xs_c[j] = xs_n[j];
        __builtin_amdgcn_sched_barrier(0);
    }
#undef CMB_IDX
#undef CMB_DATA
}

struct PolInproj1 : PolBase {
    const float* W;
    __device__ __forceinline__ bool get(int i, TD& td) const { int t; if (!tileL(i, t)) return false; constexpr int N_MAIN_T = (NMAIN / 256) * 10; int pm, pn;
        if (t < N_MAIN_T) dense_tile(t, NMAIN / 256, 10, pm, pn); else { const int c = t - N_MAIN_T; pm = NMAIN / 256 + (c & 3); pn = 2 + (c >> 2); }
        td.A = (const bf16_t*)(ws + WS_H); dense_aoff(td, pm * 256, D);
        td.B = (const bf16_t*)(ws + WB_OIN) + pn * 256; td.i0 = pm; td.i1 = pn; return true; }
    __device__ __forceinline__ void epi(f32x4 (&acc)[8][4], const TD& td, const LAS float* bl) const { (void)bl; EPI_GEOM; const int pm = td.i0, pn = td.i1;
        if (pn < 6) { bf16_t* PROJ = (bf16_t*)(ws + WS_PROJ);
#pragma unroll
            for (int m = 0; m < 8; ++m) { const int row = pm * 256 + wr * 128 + m * 16 + fr;
#pragma unroll
                for (int n = 0; n < 4; ++n) { u32x2 w; w.x = pk2(acc[m][n][0], acc[m][n][1]); w.y = pk2(acc[m][n][2], acc[m][n][3]);
                    *(u32x2*)(PROJ + (size_t)row * QKV_LD + pn * 256 + wc * 64 + n * 16 + 4 * fq) = w; } }
        } else { const int g = pn - 6, ri = wc >> 1; bf16_t* Z = (bf16_t*)(ws + WS_Z);
#pragma unroll
            for (int m = 0; m < 8; ++m) { const int row = pm * 256 + wr * 128 + m * 16 + fr, b = row >> 12, n1 = (row >> 6) & 63, n2 = row & 63;
                bf16_t* zb = Z + ((((size_t)(b * 64 + n1) * 2 + ri) * 64 + n2) * 512) + g * 128 + (wc & 1) * 64;
#pragma unroll
                for (int n = 0; n < 4; ++n) { u32x2 w; w.x = pk2(acc[m][n][0], acc[m][n][1]); w.y = pk2(acc[m][n][2], acc[m][n][3]); *(u32x2*)(zb + n * 16 + 4 * fq) = w; } } } }
};
__device__ __forceinline__ void phase_inproj_l1(Frame& F) {
    PolInproj1 P; P.base_init(F, D / 64, (NMAIN / 256) * 10 + (NCTX / 256) * 4); P.ldbB = 2560;
    gemm_stream_bf(F.lds, P, F.wid, F.lane);
}

struct PolFour : PolBase {
    int stage;
    __device__ __forceinline__ bool get(int i, TD& td) const { int L; if (!tileL(i, L)) return false; const int b = L >> 7, ct = L & 127;
        td.A = (const bf16_t*)(ws + (stage == 1 ? WS_M1 : WS_M2)); dense_aoff(td, 0, 128);
        td.B = (const bf16_t*)(ws + (stage == 1 ? WS_Z : WS_A1)) + (size_t)b * 128 * 32768 + ct * 256; td.i0 = b; td.i1 = ct; return true; }
    __device__ __forceinline__ void epi(f32x4 (&acc)[8][4], const TD& td, const LAS float* bl) const { (void)bl; EPI_GEOM; const int b = td.i0, ct = td.i1;
        if (wr != 0) return;
        if (stage == 1) { const f32x2* TW = (const f32x2*)(ws + WS_TW); bf16_t* A1 = (bf16_t*)(ws + WS_A1);
#pragma unroll
            for (int m = 0; m < 4; ++m) { const int k1 = m * 16 + fr;
#pragma unroll
                for (int n = 0; n < 4; ++n) { const int col = ct * 256 + wc * 64 + n * 16 + 4 * fq, n2 = col >> 9, c = col & 511;
                    const f32x2 tw = TW[n2 * k1]; const f32x4 re = acc[m][n], im = acc[m + 4][n];
                    const f32x4 ore = re * tw.x + im * tw.y, oim = im * tw.x - re * tw.y; u32x2 w0, w1;
                    w0.x = pk2(ore[0], ore[1]); w0.y = pk2(ore[2], ore[3]); w1.x = pk2(oim[0], oim[1]); w1.y = pk2(oim[2], oim[3]);
                    *(u32x2*)(A1 + ((((size_t)(b * 2 + 0) * 64 + n2) * 64 + k1) * 512) + c) = w0;
                    *(u32x2*)(A1 + ((((size_t)(b * 2 + 1) * 64 + n2) * 64 + k1) * 512) + c) = w1; } }
        } else { const float scl = 1.f / 724.0773439350247f; bf16_t* MIX = (bf16_t*)(ws + WS_MIX);
#pragma unroll
            for (int m = 0; m < 4; ++m) { const int k2 = m * 16 + fr;
#pragma unroll
                for (int n = 0; n < 4; ++n) { const int col = ct * 256 + wc * 64 + n * 16 + 4 * fq, k1 = col >> 9, c = col & 511;
                    const f32x4 o = acc[m][n] * scl; u32x2 w; w.x = pk2(o[0], o[1]); w.y = pk2(o[2], o[3]);
                    *(u32x2*)(MIX + (size_t)(b * SEQ + k1 + 64 * k2) * D + 512 + c) = w; } } } }
};

__device__ __forceinline__ void phase_attn_l1(Frame& F) {
    const int wid = F.wid, lane = F.lane, fr = lane & 15, fq = lane >> 4;
    constexpr int N_NA = NB * 64, N_F1 = NB * 128;
    const float SC = 0.125f * LOG2E;
    for (int it = F.bid; it < N_NA; it += F.G) {
            LAS unsigned char* vl = F.lds + wid * 8192;
            LAS float* rp = (LAS float*)(vl + 5120);
            const int b = it >> 6, r = it & 63, h = wid;
            for (int i = lane; i < 465; i += 64) rp[i] = PP(odd_rpb)[h * 465 + i] * LOG2E;
            for (int qh = 0; qh < 4 / QT; ++qh) {
            const int qc0 = qh * (16 * QT), qrow0 = b * SEQ + r * 64 + qc0;
            bf16x8 qf[QT][2];
#pragma unroll
            for (int qt = 0; qt < QT; ++qt)
#pragma unroll
                for (int ks = 0; ks < 2; ++ks) qf[qt][ks] = *(const bf16x8*)(F_PROJ + (size_t)(qrow0 + qt * 16 + fr) * QKV_LD + h * 64 + ks * 32 + 8 * fq);
            AttnSt st;
#pragma unroll
            for (int qt = 0; qt < QT; ++qt) { st.m[qt] = -1e30f; st.l[qt] = 0.f;
#pragma unroll
                for (int dt = 0; dt < 4; ++dt) st.o[dt][qt] = (f32x4){0.f, 0.f, 0.f, 0.f}; }
            const int r0 = min(max(r - 4, 0), 56);
            int c0q[QT];
#pragma unroll
            for (int qt = 0; qt < QT; ++qt) c0q[qt] = min(max(qc0 + qt * 16 + fr - 8, 0), 48);
            for (int s = 0; s < 16; ++s) {
                const int kr = r0 + (s >> 1), half = s & 1;
                const bf16_t* kp = F_PROJ + (size_t)(b * SEQ + kr * 64 + half * 32) * QKV_LD + 512 + h * 64;
                const bf16_t* vp = kp + 512;
                const LAS float* rpr = rp + (kr - r + 7) * 31 + 15;
#define BIAS_NA(qt, kt, j) ({ const int kc = half * 32 + kt * 16 + 4 * fq + j; const int dc = kc - (qc0 + qt * 16 + fr); (kc >= c0q[qt] && kc < c0q[qt] + 16) ? rpr[dc] : -INFINITY; })
                ATTN_STEP(kp, QKV_LD, vp, QKV_LD, SC, BIAS_NA);
            }
            for (int s = 0; s < 8; ++s) {
                const bf16_t* kp = F_PROJ + (size_t)(NMAIN + b * CTXL + s * 32) * QKV_LD + 512 + h * 64;
                const bf16_t* vp = kp + 512;
                ATTN_STEP(kp, QKV_LD, vp, QKV_LD, SC, BIAS_NONE);
            }
            attn_store(st, F_MIX + (size_t)qrow0 * D + h * 64, D, fr, fq);
            }
    }
    __syncthreads();
    PolFour P; P.stage = 1; P.base_init(F, 2, N_F1); P.ldbB = 32768;
    gemm_stream_bf(F.lds, P, F.wid, F.lane);
}

__device__ __forceinline__ void phase_fst2(Frame& F) {
    PolFour P; P.stage = 2; P.base_init(F, 2, NB * 128); P.ldbB = 32768;
    gemm_stream_bf(F.lds, P, F.wid, F.lane);
}

__global__ void __launch_bounds__(512, 2) fwd_kernel(Params p) {
    extern __shared__ __attribute__((aligned(16))) unsigned char lds_raw[];
    Frame F;
    F.lds = (LAS unsigned char*)lds_raw;
    F.tid = threadIdx.x; F.lane = F.tid & 63; F.wid = __builtin_amdgcn_readfirstlane(F.tid >> 6); F.bid = blockIdx.x; F.G = gridDim.x;
    unsigned char* ws = p.ws; F.ws = ws;
    volatile LAS unsigned* MISC = (volatile LAS unsigned*)(F.lds + MISC_OFF);
    if (F.tid < 64) MISC[F.tid] = 0u;
    if (F.tid == 64) { LAS unsigned long long* LP = (LAS unsigned long long*)(F.lds + PARAM_OFF);
        LP[0] = (unsigned long long)p.x; LP[1] = (unsigned long long)p.c; LP[2] = (unsigned long long)p.ctx; LP[3] = (unsigned long long)p.c_ctx; LP[4] = (unsigned long long)p.ada_w; LP[5] = (unsigned long long)p.ada_b;
        LP[6] = (unsigned long long)p.norm_mix; LP[7] = (unsigned long long)p.norm_ffn; LP[8] = (unsigned long long)p.even_w_in; LP[9] = (unsigned long long)p.even_w_out; LP[10] = (unsigned long long)p.even_conv_w;
        LP[11] = (unsigned long long)p.even_sink; LP[12] = (unsigned long long)p.odd_w_in; LP[13] = (unsigned long long)p.odd_w_out; LP[14] = (unsigned long long)p.odd_rpb; LP[15] = (unsigned long long)p.router_w;
        LP[16] = (unsigned long long)p.router_b; LP[17] = (unsigned long long)p.moe_w_gu; LP[18] = (unsigned long long)p.moe_b_gu; LP[19] = (unsigned long long)p.moe_w_dn; LP[20] = (unsigned long long)p.moe_b_dn;
        LP[21] = (unsigned long long)p.final_norm; LP[22] = (unsigned long long)p.out; }
    __syncthreads();
    const int lo = p.ph_lo, hi = p.ph_hi;
    XcdBarrier bar; bar.bar = (unsigned*)(ws + WS_CTL) + CW_BAR; bar.x = 0; bar.st = MISC + 8;
    if (hi - lo > 1) bar = xcd_barrier_post((unsigned*)(ws + WS_CTL) + CW_BAR, MISC + 8);
#define RUN_PHASE(ph, call) do { if (PH_ON(ph) && lo <= (ph) && (ph) < hi) { call; if (PH_REP(ph)) { xcd_barrier(bar); call; } } if (lo <= (ph) && (ph) + 1 < hi) xcd_barrier(bar); } while (0)
    RUN_PHASE(PH_PREP, phase_prep(F));
    RUN_PHASE(PH_NORM1_0, phase_norm1_l0(F));
    RUN_PHASE(PH_INPROJ_0, phase_inproj_l0(F));
    RUN_PHASE(PH_ATTN_0, phase_attn_l0(F));
    RUN_PHASE(PH_OUTPROJ_0, phase_outproj(F, 0));
    RUN_PHASE(PH_ROUTE_0, phase_route(F, 0));
    RUN_PHASE(PH_MOE1_0, phase_moe1(F, bar, hi - lo > 1, 0));
    RUN_PHASE(PH_MOE2_0, phase_moe2(F, 0));
    RUN_PHASE(PH_COMB_0, phase_combine(F, 0));
    RUN_PHASE(PH_INPROJ_1, phase_inproj_l1(F));
    RUN_PHASE(PH_ATTN_1, phase_attn_l1(F));
    RUN_PHASE(PH_FST2_1, phase_fst2(F));
    RUN_PHASE(PH_OUTPROJ_1, phase_outproj(F, 1));
    RUN_PHASE(PH_ROUTE_1, phase_route(F, 1));
    RUN_PHASE(PH_MOE1_1, phase_moe1(F, bar, hi - lo > 1, 1));
    RUN_PHASE(PH_MOE2_1, phase_moe2(F, 1));
    RUN_PHASE(PH_FINAL, phase_combine(F, 1));
}

extern "C" void kernel_launch(void* const* d_in, const int* in_sizes, int n_in, void* d_out, int out_size, void* d_ws, size_t ws_size, hipStream_t stream) {
    static int grid = 0;
    if (grid == 0) {
        if (n_in != 22 || ws_size < WS_END) { fprintf(stderr, "kernel_launch: unexpected inputs (n_in %d, ws %zu)\n", n_in, ws_size); grid = -1; return; }
        int dev = 0, cus = 0, per_cu = 0;
        hipGetDevice(&dev);
        hipDeviceGetAttribute(&cus, hipDeviceAttributeMultiprocessorCount, dev);
        hipFuncSetAttribute((const void*)fwd_kernel, hipFuncAttributeMaxDynamicSharedMemorySize, LDS_BYTES);
        hipOccupancyMaxActiveBlocksPerMultiprocessor(&per_cu, (const void*)fwd_kernel, 512, LDS_BYTES);
        if (per_cu < 1) { fprintf(stderr, "kernel_launch: occupancy query says %d blocks/CU\n", per_cu); per_cu = 1; }
        (void)hipGetLastError();
        grid = cus;
    }
    if (grid < 0) return;
    hipMemsetAsync((char*)d_ws + WS_CTL, 0, CTL_BYTES, stream);
    Params p{};
    const float** pp = (const float**)&p;
    for (int i = 0; i < 22; ++i) pp[i] = (const float*)d_in[i];
    p.out = (float*)d_out; p.ws = (unsigned char*)d_ws;
#if N_LAUNCH_MODE == 1
    for (int ph = 0; ph < NPHASE; ++ph) { p.ph_lo = ph; p.ph_hi = ph + 1; hipLaunchKernelGGL(fwd_kernel, dim3(grid), dim3(512), LDS_BYTES, stream, p); }
#else
    p.ph_lo = 0; p.ph_hi = NPHASE;
    void* args[] = {&p};
    hipError_t e = hipLaunchCooperativeKernel((const void*)fwd_kernel, dim3(grid), dim3(512), args, LDS_BYTES, stream);
    if (e != hipSuccess) fprintf(stderr, "kernel_launch: cooperative launch failed: %s (grid %d)\n", hipGetErrorString(e), grid);
#endif
}
```

```cpp
#include <hip/hip_runtime.h>
#include <cstdio>
#include <cstdint>

#ifndef N_LAUNCH_MODE
#define N_LAUNCH_MODE 0
#endif

#ifndef PHASE_MASK
#define PHASE_MASK 0x1FFFF
#endif
#define PH_ON(ph) ((PHASE_MASK >> (ph)) & 1)
#ifndef REPEAT_MASK
#define REPEAT_MASK 0
#endif
#define PH_REP(ph) ((REPEAT_MASK >> (ph)) & 1)
#define LAS __attribute__((address_space(3)))
#define GAS __attribute__((address_space(1)))
typedef unsigned short bf16_t;
typedef short bf16x8 __attribute__((ext_vector_type(8)));
typedef short s16x4 __attribute__((ext_vector_type(4)));
typedef float f32x4 __attribute__((ext_vector_type(4)));
typedef float f32x2 __attribute__((ext_vector_type(2)));
typedef int i32x4 __attribute__((ext_vector_type(4)));
typedef unsigned u32x2 __attribute__((ext_vector_type(2)));
typedef unsigned u32x4 __attribute__((ext_vector_type(4)));

constexpr int D = 1024, NB = 4, SEQ = 4096, CTXL = 256;
constexpr int NMAIN = NB * SEQ, NCTX = NB * CTXL, NTOK = NMAIN + NCTX;
constexpr int EVEN_IN = 2304, NEXP = 32, DFF = 1024;
constexpr int QKV_LD = 1536;
constexpr float NORM_EPS = 1e-6f;
constexpr float LOG2E = 1.4426950408889634f;

constexpr size_t MiB = 1ull << 20;
constexpr size_t WS_CTL = 0, CTL_BYTES = 1 * MiB;
constexpr size_t WS_MOD = 1 * MiB;
constexpr size_t WS_M1 = 2 * MiB;
constexpr size_t WS_M2 = WS_M1 + 65536;
constexpr size_t WS_ROPE = WS_M2 + 65536;
constexpr size_t WS_TW = WS_ROPE + 8192;
constexpr size_t WS_WF = 4 * MiB;
constexpr size_t WS_TOPW = 8 * MiB;
constexpr size_t WS_POS = 9 * MiB;
constexpr size_t WS_LIST = 12 * MiB;
constexpr size_t WS_H = 16 * MiB;
constexpr size_t WS_MIX = 52 * MiB;
constexpr size_t WS_XS = 88 * MiB;
constexpr size_t WS_PROJ = 160 * MiB;
constexpr size_t WS_Z = 240 * MiB;
constexpr size_t WS_A1 = 304 * MiB;
constexpr size_t WS_ACT = 368 * MiB;
constexpr size_t WS_Y = 512 * MiB;
constexpr size_t WS_WB = 656 * MiB;
constexpr size_t WB_EIN = WS_WB, WB_EOUT = WB_EIN + (size_t)D * EVEN_IN * 2, WB_OIN = WB_EOUT + (size_t)D * D * 2, WB_OOUT = WB_OIN + (size_t)D * 2560 * 2;
constexpr size_t WS_BC = 672 * MiB;
constexpr size_t WS_BC2 = WS_BC + 128 * MiB;
constexpr size_t WS_END = 864 * MiB;
constexpr int CW_BAR = 4096;
constexpr int CW_CNT = 8192;

constexpr int LDS_BYTES = 147456;
constexpr int PARAM_OFF = LDS_BYTES - 512;
constexpr int MISC_OFF = LDS_BYTES - 256;
constexpr int A_TILE_B = 32768, B_ROWB = 544, B_TILE_B = 64 * B_ROWB, STAGE_B = A_TILE_B + B_TILE_B;
static_assert(2 * STAGE_B + 1024 + 8192 <= PARAM_OFF, "LDS");

enum { PH_PREP = 0, PH_NORM1_0, PH_INPROJ_0, PH_ATTN_0, PH_OUTPROJ_0, PH_ROUTE_0, PH_MOE1_0, PH_MOE2_0, PH_COMB_0,
       PH_INPROJ_1, PH_ATTN_1, PH_FST2_1, PH_OUTPROJ_1, PH_ROUTE_1, PH_MOE1_1, PH_MOE2_1, PH_FINAL, NPHASE };

struct Params {
    const float *x, *c, *ctx, *c_ctx, *ada_w, *ada_b, *norm_mix, *norm_ffn, *even_w_in, *even_w_out, *even_conv_w, *even_sink,
                *odd_w_in, *odd_w_out, *odd_rpb, *router_w, *router_b, *moe_w_gu, *moe_b_gu, *moe_w_dn, *moe_b_dn, *final_norm;
    float* out; unsigned char* ws; int ph_lo, ph_hi;
};

__device__ __forceinline__ unsigned pk2(float lo, float hi) { unsigned r; asm("v_cvt_pk_bf16_f32 %0, %1, %2" : "=v"(r) : "v"(lo), "v"(hi)); return r; }
__device__ __forceinline__ float bflo(unsigned u) { return __builtin_bit_cast(float, u << 16); }
__device__ __forceinline__ float bfhi(unsigned u) { return __builtin_bit_cast(float, u & 0xffff0000u); }
__device__ __forceinline__ float wave_sum(float v) {
#pragma unroll
    for (int o = 1; o < 64; o <<= 1) v += __shfl_xor(v, o);
    return v;
}
__device__ __forceinline__ float fexp2(float x) { return __builtin_amdgcn_exp2f(x); }

#define XB_TMO      128
#define XB_XCNT(j)  (256  + 64 * (j))
#define XB_XSUB(j)  (1280 + 64 * (j))
#define XB_XGEN(j)  (2304 + 64 * (j))
#define XB_TOP      3328
#define XB_TOPGEN   3392
#define XB_SPIN_CAP (1u << 22)
__device__ __forceinline__ unsigned xb_ld(unsigned* p)              { return __hip_atomic_load(p, __ATOMIC_RELAXED, __HIP_MEMORY_SCOPE_AGENT); }
__device__ __forceinline__ unsigned xb_add(unsigned* p, unsigned v) { return __hip_atomic_fetch_add(p, v, __ATOMIC_RELAXED, __HIP_MEMORY_SCOPE_AGENT); }
__device__ __forceinline__ unsigned xb_xcc_id() { return (unsigned)__builtin_amdgcn_s_getreg((3 << 11) | 20) & 0xFu; }
#define XB_SPIN(cond, bar) do { unsigned _sp = 0; while (cond) { __builtin_amdgcn_s_sleep(1); \
    if ((++_sp & 255u) == 0u) { if (xb_ld(&(bar)[XB_TMO])) break; if (_sp > XB_SPIN_CAP) { atomicAdd(&(bar)[XB_TMO], 1u); break; } } } } while (0)
struct XcdBarrier { unsigned* bar; unsigned x; volatile LAS unsigned* st; };
__device__ __forceinline__ XcdBarrier xcd_barrier_post(unsigned* bar, volatile LAS unsigned* st) {
    XcdBarrier b; b.bar = bar; b.x = xb_xcc_id(); b.st = st;
    if (threadIdx.x == 0) (void)xb_add(&bar[XB_XCNT(b.x)], 1u);
    return b;
}
__device__ __forceinline__ void xcd_barrier_complete(unsigned* bar, unsigned x, unsigned& nloc, unsigned& nx) {
    const unsigned G = gridDim.x * gridDim.y * gridDim.z;
    unsigned sum, cnt, mine, sp = 0u;
    for (;;) {
        sum = 0u; cnt = 0u; mine = 0u;
#pragma unroll
        for (unsigned j = 0; j < 16; ++j) { const unsigned c = xb_ld(&bar[XB_XCNT(j)]); sum += c; cnt += (c > 0u) ? 1u : 0u; mine = (j == x) ? c : mine; }
        if (sum == G) break;
        __builtin_amdgcn_s_sleep(1);
        if ((++sp & 255u) == 0u) { if (xb_ld(&bar[XB_TMO])) break; if (sp > XB_SPIN_CAP) { atomicAdd(&bar[XB_TMO], 1u); break; } }
    }
    nloc = mine > 0u ? mine : 1u; nx = cnt > 0u ? cnt : 1u;
}
__device__ __forceinline__ void xcd_barrier(const XcdBarrier& b) {
    asm volatile("s_waitcnt vmcnt(0)" ::: "memory");
    __syncthreads();
    if (threadIdx.x == 0) {
        unsigned* bar = b.bar;
        __builtin_amdgcn_s_waitcnt(0);
        unsigned nloc = b.st[0], nx = b.st[1];
        if (nloc == 0u) { xcd_barrier_complete(bar, b.x, nloc, nx); b.st[0] = nloc; b.st[1] = nx; }
        const unsigned old = xb_add(&bar[XB_XSUB(b.x)], 1u);
        const unsigned gen = old / nloc;
        if (old + 1u == (gen + 1u) * nloc) {
            __builtin_amdgcn_fence(__ATOMIC_RELEASE, "agent");
            asm volatile("s_waitcnt vmcnt(0)" ::: "memory");
            const unsigned og = xb_add(&bar[XB_TOP], 1u);
            const unsigned tg = og / nx;
            if (og + 1u == (tg + 1u) * nx) xb_add(&bar[XB_TOPGEN], 1u);
            else XB_SPIN(xb_ld(&bar[XB_TOPGEN]) == tg, bar);
            __builtin_amdgcn_fence(__ATOMIC_ACQUIRE, "agent");
            xb_add(&bar[XB_XGEN(b.x)], 1u);
            asm volatile("s_waitcnt vmcnt(0)" ::: "memory");
        } else {
            XB_SPIN(xb_ld(&bar[XB_XGEN(b.x)]) == gen, bar);
            __builtin_amdgcn_fence(__ATOMIC_ACQUIRE, "agent");
            asm volatile("s_waitcnt vmcnt(0)" ::: "memory");
        }
    }
    __syncthreads();
}

struct TD { const bf16_t* A; const void* B; bf16_t* bco; unsigned ldb; unsigned aoff[4]; int i0, i1, i2, i3, i4; };
__device__ __forceinline__ int a_piece_row0(int wid, int lane) { const int sb = lane * 16, swz = sb ^ (((sb >> 9) & 1) << 5); return (wid >> 1) * 16 + (swz >> 6); }
__device__ __forceinline__ int a_piece_col(int wid, int lane) { const int sb = lane * 16, swz = sb ^ (((sb >> 9) & 1) << 5); return (wid & 1) * 32 + ((swz & 63) >> 1); }
__device__ __forceinline__ u32x4 make_rsrc(const void* p) { const unsigned long long ab = (unsigned long long)p; u32x4 r; r.x = __builtin_amdgcn_readfirstlane((unsigned)ab); r.y = __builtin_amdgcn_readfirstlane((unsigned)(ab >> 32)) & 0xffffu; r.z = 0x7fffffffu; r.w = 0x00020000u; return r; }

template <class Pol>
__device__ __forceinline__ void gemm_stream(LAS unsigned char* lds, Pol& P, const int wid, const int lane) {
    const int wr = wid >> 2, wc = wid & 3, fr = lane & 15, fq = lane >> 4;
    const unsigned b_w = (unsigned)(A_TILE_B + ((wid >> 2) * 32 + 4 * (wid & 3)) * B_ROWB) + P.woff;
    const unsigned a_r = (unsigned)(wr * 16384 + ((fr * 64 + fq * 16) ^ ((fr >> 3) << 5)));
    const unsigned b_r = (unsigned)(A_TILE_B + (4 * fq + (fr >> 2)) * B_ROWB + (wc * 64 + (fr & 3) * 4) * 2);
    const unsigned ldsa = (unsigned)(__UINTPTR_TYPE__)lds + (unsigned)(wid * 1024);
    const unsigned lcolb = P.lcolb;
    TD cur, nxt;
    if (!P.get(0, cur)) return;
    int nt = P.nt; asm volatile("" : "+s"(nt));
    f32x4 sb[8]; f32x4 acc[8][4];
    u32x4 ra_c = make_rsrc(cur.A), ra_n = ra_c;
    __amdgpu_buffer_rsrc_t rb_c = __builtin_amdgcn_make_buffer_rsrc((void*)cur.B, 0, 0x7fffffff, 0x00020000), rb_n = rb_c;
#define G_GLDS_A(buf, RA, AOFF, kt) do { _Pragma("unroll") for (int i = 0; i < 4; ++i) { unsigned keep_; \
        asm volatile("s_mov_b32 %0, m0\n\ts_mov_b32 m0, %3\n\ts_nop 0\n\tbuffer_load_dwordx4 %1, %2, %4 offen lds\n\ts_mov_b32 m0, %0" \
            : "=&s"(keep_) : "v"(AOFF[i]), "s"(RA), "s"(ldsa + (buf) + (unsigned)(i * 8192)), "s"((unsigned)((kt) * 128)) : "memory"); } } while (0)
#define G_ISSUE_BH(RB, LDB4, kt, h) do { \
        _Pragma("unroll") for (int i = 4 * (h); i < 4 * (h) + 4; ++i) sb[i] = __builtin_bit_cast(f32x4, __builtin_amdgcn_raw_buffer_load_b128(RB, (int)lcolb, (int)(((unsigned)(kt) * 64u + i) * (LDB4)), 0)); \
        __builtin_amdgcn_sched_barrier(0); } while (0)
#define G_WRITE_BH(buf, h, BCO, kt) do { \
        _Pragma("unroll") for (int i = 4 * (h); i < 4 * (h) + 4; ++i) { u32x2 w; w.x = pk2(sb[i][0], sb[i][1]); w.y = pk2(sb[i][2], sb[i][3]); \
            *(LAS u32x2*)(lds + (buf) + b_w + (16 * (i >> 2) + (i & 3)) * B_ROWB) = w; \
            if (BCO) *(u32x2*)((char*)(BCO) + (size_t)((kt) * 64 + wid * 8 + i) * 512 + P.woff) = w; } __builtin_amdgcn_sched_barrier(0); } while (0)
#define G_KSTEP(buf, ks) do { bf16x8 Bf[4]; \
        _Pragma("unroll") for (int n = 0; n < 4; ++n) { \
            const s16x4 lo = __builtin_amdgcn_ds_read_tr16_b64_v4i16((LAS s16x4*)(lds + (buf) + b_r + (ks) * 32 * B_ROWB + n * 32)); \
            const s16x4 hi = __builtin_amdgcn_ds_read_tr16_b64_v4i16((LAS s16x4*)(lds + (buf) + b_r + (ks) * 32 * B_ROWB + 16 * B_ROWB + n * 32)); \
            Bf[n] = (bf16x8){lo[0], lo[1], lo[2], lo[3], hi[0], hi[1], hi[2], hi[3]}; } \
        _Pragma("unroll") for (int mh = 0; mh < 2; ++mh) { bf16x8 At[4]; \
            _Pragma("unroll") for (int m = 0; m < 4; ++m) At[m] = *(const LAS bf16x8*)(lds + (buf) + a_r + (mh * 4 + m) * 2048 + (ks) * 1024); \
            _Pragma("unroll") for (int m = 0; m < 4; ++m) _Pragma("unroll") for (int n = 0; n < 4; ++n) \
                acc[mh * 4 + m][n] = __builtin_amdgcn_mfma_f32_16x16x32_bf16(Bf[n], At[m], acc[mh * 4 + m][n], 0, 0, 0); } \
        __builtin_amdgcn_sched_barrier(0); } while (0)
    { unsigned b0 = 0; asm volatile("" : "+s"(b0));
      const unsigned l4 = cur.ldb * 4u;
      G_GLDS_A(b0, ra_c, cur.aoff, 0); G_ISSUE_BH(rb_c, l4, 0, 0); G_ISSUE_BH(rb_c, l4, 0, 1); G_WRITE_BH(b0, 0, cur.bco, 0); G_WRITE_BH(b0, 1, cur.bco, 0);
      G_ISSUE_BH(rb_c, l4, 1, 0); G_ISSUE_BH(rb_c, l4, 1, 1); }
    asm volatile("s_waitcnt vmcnt(8)" ::: "memory");
    asm volatile("s_waitcnt lgkmcnt(0)" ::: "memory");
    __builtin_amdgcn_s_barrier();
    unsigned par = 0;
    for (int ti = 0;; ++ti) {
        const bool hasn = P.get(ti + 1, nxt);
        if (hasn) { ra_n = make_rsrc(nxt.A); rb_n = __builtin_amdgcn_make_buffer_rsrc((void*)nxt.B, 0, 0x7fffffff, 0x00020000); }
#pragma unroll
        for (int m = 0; m < 8; ++m)
#pragma unroll
            for (int n = 0; n < 4; ++n) acc[m][n] = (f32x4){0.f, 0.f, 0.f, 0.f};
        for (int t = 0; t < nt; ++t) {
            unsigned bc = par * STAGE_B, bn = (par ^ 1u) * STAGE_B; asm volatile("" : "+s"(bc), "+s"(bn));
            const bool c1 = t + 1 < nt, w1 = c1 || hasn, c2 = t + 2 < nt, i2 = c2 || hasn;
            if (w1) { const u32x4 ra = c1 ? ra_c : ra_n; unsigned ao[4];
#pragma unroll
                for (int i = 0; i < 4; ++i) ao[i] = c1 ? cur.aoff[i] : nxt.aoff[i];
                G_GLDS_A(bn, ra, ao, c1 ? t + 1 : 0); }
            G_KSTEP(bc, 0);
            const __amdgpu_buffer_rsrc_t rb = c2 ? rb_c : rb_n; const unsigned l4 = (c2 ? cur.ldb : nxt.ldb) * 4u; const int k2 = c2 ? t + 2 : t + 2 - nt;
            bf16_t* const bco = c1 ? cur.bco : nxt.bco; const int k1 = c1 ? t + 1 : 0;
            if (w1) G_WRITE_BH(bn, 0, bco, k1);
            if (i2) G_ISSUE_BH(rb, l4, k2, 0);
            G_KSTEP(bc, 1);
            if (w1) G_WRITE_BH(bn, 1, bco, k1);
            if (i2) { G_ISSUE_BH(rb, l4, k2, 1); asm volatile("s_waitcnt vmcnt(8)" ::: "memory"); }
            else asm volatile("s_waitcnt vmcnt(0)" ::: "memory");
            asm volatile("s_waitcnt lgkmcnt(0)" ::: "memory");
            __builtin_amdgcn_s_barrier();
            par ^= 1u;
        }
        P.epi(acc, cur, (const LAS float*)nullptr);
        if (!hasn) break;
        cur = nxt; ra_c = ra_n; rb_c = rb_n;
    }
#undef G_GLDS_A
#undef G_ISSUE_BH
#undef G_WRITE_BH
#undef G_KSTEP
}

constexpr int STEP_B = 32768;
constexpr unsigned ROPE_LDS = 2 * STAGE_B + 1024;
constexpr unsigned BIAS_OFF = 4 * STEP_B;
template <class Pol, int ABL = 0>
__device__ __forceinline__ void gemm_stream_bf(LAS unsigned char* lds, Pol& P, const int wid, const int lane) {
    const int wr = wid >> 2, wc = wid & 3, fr = lane & 15, fq = lane >> 4;
    const unsigned a_r = (unsigned)(wr * 8192 + ((fr * 64 + fq * 16) ^ ((fr >> 3) << 5)));
    const int x7 = 4 * (fq & 1) + (fr >> 2);
    unsigned b_r[4];
#pragma unroll
    for (int n = 0; n < 4; ++n) b_r[n] = (unsigned)(16384 + (4 * fq + (fr >> 2)) * 512 + (((wc * 4 + n) ^ x7) * 32) + (fr & 3) * 8);
    const unsigned ldsa = (unsigned)(__UINTPTR_TYPE__)lds + (unsigned)(wid * 2048), ldsb = (unsigned)(__UINTPTR_TYPE__)lds + 16384u + (unsigned)(wid * 2048);
    const unsigned ldb2 = P.ldbB * 2u;
    unsigned boff[2];
#pragma unroll
    for (int j = 0; j < 2; ++j) { const int sl = 4 * wid + 2 * j + (lane >> 5), u = lane & 31, c = (u >> 1) ^ (sl & 7), n = c * 16 + (u & 1) * 8;
        const int k = 8 * ((sl >> 2) & 3) + 4 * (sl >> 4) + (sl & 3); boff[j] = (unsigned)k * ldb2 + (unsigned)n * 2u; }
    TD cur, nxt;
    if (!P.get(0, cur)) return;
    int nt = P.nt * 2; asm volatile("" : "+s"(nt));
    f32x4 acc[8][4];
    u32x4 ra_c = make_rsrc(cur.A), ra_n = ra_c, rb_c = make_rsrc(cur.B), rb_n = rb_c;
#define H_DMA(LDSADDR, RS, VOFF, SOFF) do { unsigned keep_; \
        asm volatile("s_mov_b32 %0, m0\n\ts_mov_b32 m0, %3\n\ts_nop 0\n\tbuffer_load_dwordx4 %1, %2, %4 offen lds\n\ts_mov_b32 m0, %0" \
            : "=&s"(keep_) : "v"(VOFF), "s"(RS), "s"(LDSADDR), "s"(SOFF) : "memory"); } while (0)
#define H_STAGE(sb_, RA, AO0, AO1, RB, st) do { \
        if (!(ABL & 2)) { H_DMA(ldsa + (sb_), RA, AO0, (unsigned)((st) * 64)); H_DMA(ldsa + (sb_) + 1024u, RA, AO1, (unsigned)((st) * 64)); } \
        if (!(ABL & 1)) { H_DMA(ldsb + (sb_), RB, boff[0], (unsigned)(st) * 32u * ldb2); H_DMA(ldsb + (sb_) + 1024u, RB, boff[1], (unsigned)(st) * 32u * ldb2); } } while (0)
#define H_READ(sb_) do { if (!(ABL & 16)) { \
        _Pragma("unroll") for (int n = 0; n < 4; ++n) { \
            const s16x4 lo = __builtin_amdgcn_ds_read_tr16_b64_v4i16((LAS s16x4*)(lds + (sb_) + b_r[n])); \
            const s16x4 hi = __builtin_amdgcn_ds_read_tr16_b64_v4i16((LAS s16x4*)(lds + (sb_) + b_r[n] + 8192)); \
            Bf[n] = (bf16x8){lo[0], lo[1], lo[2], lo[3], hi[0], hi[1], hi[2], hi[3]}; } \
        _Pragma("unroll") for (int m = 0; m < 8; ++m) At[m] = *(const LAS bf16x8*)(lds + (sb_) + a_r + m * 1024); } } while (0)
#define H_MMA() do { if (!(ABL & 16)) { __builtin_amdgcn_s_setprio(1); \
        if (!(ABL & 4)) { _Pragma("unroll") for (int m = 0; m < 8; ++m) _Pragma("unroll") for (int n = 0; n < 4; ++n) \
            acc[m][n] = __builtin_amdgcn_mfma_f32_16x16x32_bf16(Bf[n], At[m], acc[m][n], 0, 0, 0); } \
        else { _Pragma("unroll") for (int m = 0; m < 8; ++m) asm volatile("" :: "v"(At[m])); _Pragma("unroll") for (int n = 0; n < 4; ++n) asm volatile("" :: "v"(Bf[n])); } \
        __builtin_amdgcn_s_setprio(0); } } while (0)
#define H_BAR() do { asm volatile("s_waitcnt lgkmcnt(0)" ::: "memory"); __builtin_amdgcn_s_barrier(); __builtin_amdgcn_sched_barrier(0); } while (0)
    bf16x8 At[8], Bf[4];
    { unsigned s0 = 0, s1 = STEP_B, s2 = 2 * STEP_B; asm volatile("" : "+s"(s0), "+s"(s1), "+s"(s2));
      H_STAGE(s0, ra_c, cur.aoff[0], cur.aoff[1], rb_c, 0); H_STAGE(s1, ra_c, cur.aoff[0], cur.aoff[1], rb_c, 1); H_STAGE(s2, ra_c, cur.aoff[0], cur.aoff[1], rb_c, 2); }
    asm volatile("s_waitcnt vmcnt(8)" ::: "memory");
    H_BAR();
    if (wr == 1) H_BAR();
    unsigned g = 0;
    for (int ti = 0;; ++ti) {
        const bool hasn = P.get(ti + 1, nxt);
        if (hasn) { ra_n = make_rsrc(nxt.A); rb_n = make_rsrc(nxt.B); }
        const unsigned bias_lds = BIAS_OFF + (unsigned)(ti & 1) * 1024u, list_lds = BIAS_OFF + 2048u + (unsigned)(ti & 1) * 1024u;
        if (P.has_bias && wid == 0) { const u32x4 rbias = make_rsrc(P.bias); H_DMA((unsigned)(__UINTPTR_TYPE__)lds + bias_lds, rbias, P.bias_voff(cur), 0u); }
        if (P.has_list && hasn && wid == 1) { const u32x4 rl = make_rsrc(P.listp); H_DMA((unsigned)(__UINTPTR_TYPE__)lds + list_lds, rl, P.list_voff(nxt), 0u); }
#pragma unroll
        for (int m = 0; m < 8; ++m)
#pragma unroll
            for (int n = 0; n < 4; ++n) acc[m][n] = (f32x4){0.f, 0.f, 0.f, 0.f};
        for (int t = 0; t < nt; ++t, ++g) {
            unsigned sc = (g & 3u) * STEP_B, sn = ((g + 3u) & 3u) * STEP_B; asm volatile("" : "+s"(sc), "+s"(sn));
            const bool c3 = t + 3 < nt, i3 = c3 || hasn, i2 = (t + 2 < nt) || hasn;
            if (P.has_list && hasn && t == nt - 3) P.late(nxt, (const LAS int*)(lds + list_lds));
            if (i3) { const u32x4 ra = c3 ? ra_c : ra_n, rb = c3 ? rb_c : rb_n; const unsigned a0 = c3 ? cur.aoff[0] : nxt.aoff[0], a1 = c3 ? cur.aoff[1] : nxt.aoff[1];
                H_STAGE(sn, ra, a0, a1, rb, c3 ? t + 3 : t + 3 - nt); }
            H_READ(sc);
            if (i3) asm volatile("s_waitcnt vmcnt(8)" ::: "memory");
            else if (i2) asm volatile("s_waitcnt vmcnt(4)" ::: "memory");
            else asm volatile("s_waitcnt vmcnt(0)" ::: "memory");
            H_BAR();
            H_MMA();
            H_BAR();
        }
        if (!(ABL & 8)) P.epi(acc, cur, (const LAS float*)(lds + bias_lds)); else { _Pragma("unroll") for (int m = 0; m < 8; ++m) _Pragma("unroll") for (int n = 0; n < 4; ++n) asm volatile("" :: "v"(acc[m][n])); }
        if (!hasn) break;
        cur = nxt; ra_c = ra_n; rb_c = rb_n;
    }
    if (wr == 0) H_BAR();
#undef H_DMA
#undef H_STAGE
#undef H_READ
#undef H_MMA
#undef H_BAR
}

struct XOrder {
    int c1, step, cur;
    __device__ __forceinline__ void init(int T, int G, int bid) {
        if ((G & 7) == 0) { const int x = bid & 7; cur = (int)(((long)x * T) >> 3) + (bid >> 3); c1 = (int)(((long)(x + 1) * T) >> 3); step = G >> 3; }
        else { cur = bid; c1 = T; step = G; }
    }
    __device__ __forceinline__ bool next(int& L) { if (cur >= c1) return false; L = cur; cur += step; return true; }
};
__device__ __forceinline__ void dense_tile(int L, int nM, int nN, int& pm, int& pn) { const int per = 8 * nN, g = L / per, w = L - g * per, fm = g * 8, gs = (nM - fm) < 8 ? (nM - fm) : 8; pn = w / gs; pm = fm + w - pn * gs; }

struct Frame { LAS unsigned char* lds; int tid, lane, wid, bid, G; unsigned char* ws; };
__device__ __forceinline__ const void* ldp(const Frame& F, int off) {
    const u32x2 v = *(const volatile LAS u32x2*)(F.lds + PARAM_OFF + off);
    const unsigned lo = __builtin_amdgcn_readfirstlane(v.x), hi = __builtin_amdgcn_readfirstlane(v.y);
    return (const void*)(((unsigned long long)hi << 32) | lo);
}
#define PP(f) ((const float*)ldp(F, (int)__builtin_offsetof(Params, f)))
#define F_mod ((float*)(F.ws + WS_MOD))
#define F_M1 ((bf16_t*)(F.ws + WS_M1))
#define F_M2 ((bf16_t*)(F.ws + WS_M2))
#define F_ROPE ((f32x2*)(F.ws + WS_ROPE))
#define F_TW ((f32x2*)(F.ws + WS_TW))
#define F_WF ((float*)(F.ws + WS_WF))
#define F_TOPW ((float*)(F.ws + WS_TOPW))
#define F_POS ((int*)(F.ws + WS_POS))
#define F_LIST ((int*)(F.ws + WS_LIST))
#define F_H ((bf16_t*)(F.ws + WS_H))
#define F_MIX ((bf16_t*)(F.ws + WS_MIX))
#define F_XS ((float*)(F.ws + WS_XS))
#define F_PROJ ((bf16_t*)(F.ws + WS_PROJ))
#define F_Z ((float*)(F.ws + WS_Z))
#define F_A1 ((float*)(F.ws + WS_A1))
#define F_ACT ((bf16_t*)(F.ws + WS_ACT))
#define F_Y ((bf16_t*)(F.ws + WS_Y))
#define F_cnt ((unsigned*)(F.ws + WS_CTL) + CW_CNT)

__device__ __forceinline__ const float* modp(const Frame& F, int l, int r, int which) { return F_mod + ((size_t)(l * 5 + r)) * 6144 + which * 1024; }
__device__ __forceinline__ int mod_row(int row) { return row < NMAIN ? (row >> 12) : 4; }

__device__ __forceinline__ float row_rstd(const f32x4 (&v)[4]) {
    float s = 0.f;
#pragma unroll
    for (int j = 0; j < 4; ++j) s += (v[j][0] * v[j][0] + v[j][1] * v[j][1]) + (v[j][2] * v[j][2] + v[j][3] * v[j][3]);
    return __builtin_amdgcn_rsqf(wave_sum(s) * (1.f / D) + NORM_EPS);
}
__device__ __forceinline__ void norm_mod_store(const f32x4 (&v)[4], float rstd, const float* gam, const float* sc, const float* sh, bf16_t* dst, int lane, f32x4 (*keep)[4] = nullptr) {
#pragma unroll
    for (int j = 0; j < 4; ++j) {
        const int c = 4 * lane + 256 * j;
        const f32x4 g = *(const f32x4*)(gam + c), s1 = *(const f32x4*)(sc + c), s0 = *(const f32x4*)(sh + c);
        f32x4 h;
#pragma unroll
        for (int i = 0; i < 4; ++i) h[i] = v[j][i] * rstd * g[i] * (1.f + s1[i]) + s0[i];
        u32x2 w; w.x = pk2(h[0], h[1]); w.y = pk2(h[2], h[3]);
        *(u32x2*)(dst + c) = w;
        if (keep) (*keep)[j] = h;
    }
}

__device__ __forceinline__ void phase_prep(Frame& F) {
    LAS float* sil = (LAS float*)F.lds;
    LAS float* red = (LAS float*)(F.lds + 20480);
    LAS float* ct = (LAS float*)(F.lds + 32768);
    for (int idx = F.tid; idx < 5120; idx += 512) { const int r = idx >> 10, k = idx & 1023; const float v = r < 4 ? PP(c)[r * 1024 + k] : PP(c_ctx)[k]; sil[idx] = v / (1.f + __expf(-v)); }
    if (F.tid < 128) ct[F.tid] = cospif((float)F.tid / 64.f);
    __syncthreads();
    constexpr int N_ADA = 192, N_CONST = 8, N_FOLD = 256, N_CVT = 368;
    for (int it = F.bid; it < N_ADA + N_CONST + N_FOLD + N_CVT; it += F.G) {
        if (it < N_ADA) {
            const int l = it / 96, j0 = (it % 96) * 64, col = j0 + F.lane;
            const float* w = PP(ada_w) + ((size_t)l * 1024 + F.wid * 128) * 6144 + col;
            float a[5] = {0.f, 0.f, 0.f, 0.f, 0.f};
#pragma unroll 8
            for (int k = 0; k < 128; ++k) { const float wv = w[(size_t)k * 6144];
#pragma unroll
                for (int r = 0; r < 5; ++r) a[r] += sil[r * 1024 + F.wid * 128 + k] * wv; }
#pragma unroll
            for (int r = 0; r < 5; ++r) red[(F.wid * 5 + r) * 64 + F.lane] = a[r];
            __syncthreads();
            if (F.tid < 320) { const int r = F.tid >> 6, ln = F.tid & 63; float s = 0.f;
#pragma unroll
                for (int w8 = 0; w8 < 8; ++w8) s += red[(w8 * 5 + r) * 64 + ln];
                F_mod[(size_t)(l * 5 + r) * 6144 + j0 + ln] = s + PP(ada_b)[l * 6144 + j0 + ln]; }
            __syncthreads();
        } else if (it < N_ADA + N_CONST) {
            const int gt = (it - N_ADA) * 512 + F.tid;
            for (int e = gt; e < 32768; e += 4096) {
                const int row = e >> 7, kk = e & 127;
                float v1 = 0.f, v2 = 0.f;
                if (row < 128) { const int ro = row >> 6, k1 = row & 63, n1 = kk >> 1, ri = kk & 1; const float ph = (float)((n1 * k1) & 63) / 32.f; const float cs = cospif(ph), sn = sinpif(ph);
                    v1 = (ro == ri) ? cs : (ro == 0 ? sn : -sn); }
                if (row < 64) { const int ro = kk >> 6, n2 = kk & 63; const float ph = (float)((row * n2) & 63) / 32.f; v2 = ro == 0 ? cospif(ph) : sinpif(ph); }
                F_M1[e] = (bf16_t)(pk2(v1, 0.f) & 0xffffu); F_M2[e] = (bf16_t)(pk2(v2, 0.f) & 0xffffu);
            }
            if (gt < 1024) { const int pos = gt >> 4, f = gt & 15; const double ang = (double)pos * pow(10000.0, -(double)f / 16.0); F_ROPE[gt] = (f32x2){(float)cos(ang), (float)sin(ang)}; }
            { const float ph = (float)gt / 2048.f; F_TW[gt] = (f32x2){cospif(ph), sinpif(ph)}; }
        } else if (it >= N_ADA + N_CONST + N_FOLD) {
            int ci = it - (N_ADA + N_CONST + N_FOLD); const float* src; bf16_t* dst; int sld, dld, ncol;
            if (ci < 144) { src = PP(even_w_in); dst = (bf16_t*)(F.ws + WB_EIN); sld = EVEN_IN; dld = EVEN_IN; ncol = EVEN_IN; }
            else if (ci < 208) { ci -= 144; src = PP(even_w_out); dst = (bf16_t*)(F.ws + WB_EOUT); sld = D; dld = D; ncol = D; }
            else if (ci < 304) { ci -= 208; src = PP(odd_w_in); dst = (bf16_t*)(F.ws + WB_OIN); sld = 2048; dld = 2560; ncol = 1536; }
            else { ci -= 304; src = PP(odd_w_out); dst = (bf16_t*)(F.ws + WB_OOUT); sld = D; dld = D; ncol = D; }
            const int q4 = ncol >> 2;
#pragma unroll
            for (int u = 0; u < 8; ++u) { const int gidx = ci * 4096 + u * 512 + F.tid, row = gidx / q4, c4 = (gidx - row * q4) * 4;
                const f32x4 v = *(const f32x4*)(src + (size_t)row * sld + c4); u32x2 w; w.x = pk2(v[0], v[1]); w.y = pk2(v[2], v[3]); *(u32x2*)(dst + (size_t)row * dld + c4) = w; }
        } else {
            const int fi = it - N_ADA - N_CONST, rc = fi >> 2, g = fi & 3, half = F.tid >> 8, j = F.tid & 255, jj = j & 127;
            for (int i2 = 0; i2 < 8; ++i2) {
                const int row = rc * 16 + i2 * 2 + half;
                const float* wr_ = PP(odd_w_in) + (size_t)row * 2048 + 1536 + g * 128;
                float s = 0.f;
                if (j < 128) { for (int cc = 0; cc < 128; ++cc) s += wr_[cc] * ct[(cc * jj) & 127]; }
                else { for (int cc = 0; cc < 128; ++cc) s -= wr_[cc] * ct[((cc * jj) - 32) & 127]; }
                ((bf16_t*)(F.ws + WB_OIN))[(size_t)row * 2560 + 1536 + g * 256 + j] = (bf16_t)(pk2(s, 0.f) & 0xffffu);
            }
        }
    }
}

__device__ __forceinline__ void phase_norm1_l0(Frame& F) {
    const int gw = F.bid * 8 + F.wid, NGW = F.G * 8;
    for (int row = gw; row < NTOK; row += NGW) {
        const float* src = row < NMAIN ? PP(x) + (size_t)row * D : PP(ctx) + (size_t)(row - NMAIN) * D;
        f32x4 v[4];
#pragma unroll
        for (int j = 0; j < 4; ++j) v[j] = *(const f32x4*)(src + 4 * F.lane + 256 * j);
        const float rstd = row_rstd(v); const int r = mod_row(row);
        norm_mod_store(v, rstd, PP(norm_mix), modp(F, 0, r, 1), modp(F, 0, r, 0), F_H + (size_t)row * D, F.lane);
    }
}

#define EPI_GEOM const int wid = this->wid, lane = this->lane, wr = wid >> 2, wc = wid & 3, fr = lane & 15, fq = lane >> 4; (void)wr; (void)wc; (void)fr; (void)fq
struct PolBase { unsigned char* ws; LAS unsigned char* lds; int wid, lane, nt; unsigned lcolb, woff, ldbB; XOrder xo; int aC, aR0, aCb, aR0b; bool bfm;
    __device__ __forceinline__ void base_init(Frame& F, int nt_, int T) { ws = F.ws; lds = F.lds; wid = F.wid; lane = F.lane; nt = nt_; lcolb = 16u * (unsigned)F.lane; woff = 8u * (unsigned)F.lane;
        xo.init(T, F.G, F.bid); aC = a_piece_col(F.wid, F.lane); aR0 = a_piece_row0(F.wid, F.lane); bfm = true;
        { const int sbb = F.lane * 16, swz = sbb ^ (((sbb >> 9) & 1) << 5); aR0b = F.wid * 32 + (swz >> 6); aCb = (swz & 63) >> 1; } }
    bool has_bias = false; const float* bias = nullptr;
    bool has_list = false; const int* listp = nullptr;
    __device__ __forceinline__ unsigned list_voff(const TD&) const { return 0u; }
    __device__ __forceinline__ void late(TD&, const LAS int*) const {}
    __device__ __forceinline__ unsigned bias_voff(const TD&) const { return 0u; }
    __device__ __forceinline__ bool tileL(int i, int& L) const { L = xo.cur + i * xo.step; return L < xo.c1; }
    __device__ __forceinline__ int prow(int i) const { return bfm ? aR0b + 16 * (i & 1) : aR0 + 64 * i; }
    __device__ __forceinline__ int pcol() const { return bfm ? aCb : aC; }
    __device__ __forceinline__ void dense_aoff(TD& td, int row0, int pitch) const {
#pragma unroll
        for (int i = 0; i < 4; ++i) td.aoff[i] = (unsigned)(((row0 + prow(i)) * pitch + pcol()) * 2); }
};

struct PolInproj0 : PolBase {
    const float* W; Frame* Fp;
    __device__ __forceinline__ bool get(int i, TD& td) const { int L; if (!tileL(i, L)) return false; int pm, pn; dense_tile(L, NTOK / 256, EVEN_IN / 256, pm, pn);
        td.A = (const bf16_t*)(ws + WS_H); dense_aoff(td, pm * 256, D); td.B = (const bf16_t*)(ws + WB_EIN) + pn * 256; td.i0 = pm; td.i1 = pn; return true; }
    __device__ __forceinline__ void epi(f32x4 (&acc)[8][4], const TD& td, const LAS float* bl) const { (void)bl; EPI_GEOM; const int pm = td.i0, pn = td.i1;
        const int colb = pn * 256 + wc * 64; const bool rope = (colb < 640) && (pm < NMAIN / 256);
        const LAS f32x2* ROPE = (const LAS f32x2*)(lds + ROPE_LDS); bf16_t* PROJ = (bf16_t*)(ws + WS_PROJ);
#pragma unroll
        for (int m = 0; m < 8; ++m) { const int row = pm * 256 + wr * 128 + m * 16 + fr;
            if (rope) { const int tt = row & (SEQ - 1), gr = tt >> 6, gc = tt & 63;
#pragma unroll
                for (int n = 0; n < 2; ++n) { const int pos = n == 0 ? gr : gc;
#pragma unroll
                    for (int j = 0; j < 4; ++j) { const f32x2 cs = ROPE[pos * 16 + 4 * fq + j]; const float x1 = acc[m][n][j], x2 = acc[m][n + 2][j];
                        acc[m][n][j] = x1 * cs.x - x2 * cs.y; acc[m][n + 2][j] = x2 * cs.x + x1 * cs.y; } } }
#pragma unroll
            for (int n = 0; n < 4; ++n) { u32x2 w; w.x = pk2(acc[m][n][0], acc[m][n][1]); w.y = pk2(acc[m][n][2], acc[m][n][3]);
                *(u32x2*)(PROJ + (size_t)row * EVEN_IN + colb + n * 16 + 4 * fq) = w; } } }
};
__device__ __forceinline__ void phase_inproj_l0(Frame& F) {
    for (int i = F.tid; i < 1024; i += 512) ((LAS f32x2*)(F.lds + ROPE_LDS))[i] = F_ROPE[i];
    __syncthreads();
    PolInproj0 P; P.base_init(F, D / 64, (NTOK / 256) * (EVEN_IN / 256)); P.ldbB = EVEN_IN;
    gemm_stream_bf(F.lds, P, F.wid, F.lane);
}

struct PolOutproj : PolBase {
    const float *W, *x, *ctx; int layer, nM;
    __device__ __forceinline__ bool get(int i, TD& td) const { int L; if (!tileL(i, L)) return false; int pm, pn; dense_tile(L, nM, 4, pm, pn);
        td.A = (const bf16_t*)(ws + WS_MIX); dense_aoff(td, pm * 256, D); td.B = (const bf16_t*)(ws + (layer == 0 ? WB_EOUT : WB_OOUT)) + pn * 256; td.i0 = pm; td.i1 = pn; return true; }
    __device__ __forceinline__ void epi(f32x4 (&acc)[8][4], const TD& td, const LAS float* bl) const { (void)bl; EPI_GEOM; const int pm = td.i0, pn = td.i1;
        const int colb = pn * 256 + wc * 64; float* XS = (float*)(ws + WS_XS); const float* mod = (const float*)(ws + WS_MOD);
#pragma unroll
        for (int m = 0; m < 8; ++m) { const int row = pm * 256 + wr * 128 + m * 16 + fr; const int r = mod_row(row);
            const float* xin = layer == 0 ? (row < NMAIN ? x + (size_t)row * D : ctx + (size_t)(row - NMAIN) * D) : XS + (size_t)row * D;
            const float* g1 = mod + ((size_t)(layer * 5 + r)) * 6144 + 2 * 1024;
#pragma unroll
            for (int n = 0; n < 4; ++n) { const int c = colb + n * 16 + 4 * fq; const f32x4 xv = *(const f32x4*)(xin + c), gv = *(const f32x4*)(g1 + c);
                f32x4 o;
#pragma unroll
                for (int j = 0; j < 4; ++j) o[j] = xv[j] + gv[j] * acc[m][n][j];
                *(f32x4*)(XS + (size_t)row * D + c) = o; } } }
};
__device__ __forceinline__ void phase_outproj(Frame& F, const int layer) {
    PolOutproj P; P.layer = layer; P.nM = (layer == 0 ? NTOK : NMAIN) / 256; P.base_init(F, D / 64, P.nM * 4);
    P.ldbB = D; P.x = PP(x); P.ctx = PP(ctx);
    gemm_stream_bf(F.lds, P, F.wid, F.lane);
}

constexpr int QT = 2;
struct AttnSt { f32x4 o[4][QT]; float m[QT], l[QT]; };
#define V_ROWB 160
__device__ __forceinline__ void v_stage(LAS unsigned char* vl, const bf16_t* vsrc, int ld, int lane) {
    i32x4 t[4];
#pragma unroll
    for (int i = 0; i < 4; ++i) t[i] = *(const i32x4*)(vsrc + (size_t)((lane >> 3) + 8 * i) * ld + (lane & 7) * 8);
#pragma unroll
    for (int i = 0; i < 4; ++i) *(LAS i32x4*)(vl + ((lane >> 3) + 8 * i) * V_ROWB + (lane & 7) * 16) = t[i];
}
#define ATTN_STEP(ksrc, kld, vsrc, vld, SCALE, BIAS) do { \
    bf16x8 kf[2][2]; \
    _Pragma("unroll") for (int kt = 0; kt < 2; ++kt) _Pragma("unroll") for (int ks = 0; ks < 2; ++ks) \
        kf[kt][ks] = *(const bf16x8*)((ksrc) + (size_t)(kt * 16 + fr) * (kld) + ks * 32 + 8 * fq); \
    v_stage(vl, (vsrc), (vld), lane); \
    bf16x8 vf[4]; \
    _Pragma("unroll") for (int dt = 0; dt < 4; ++dt) { \
        const s16x4 lo = __builtin_amdgcn_ds_read_tr16_b64_v4i16((LAS s16x4*)(vl + (4 * fq + (fr >> 2)) * V_ROWB + (dt * 16 + (fr & 3) * 4) * 2)); \
        const s16x4 hi = __builtin_amdgcn_ds_read_tr16_b64_v4i16((LAS s16x4*)(vl + (16 + 4 * fq + (fr >> 2)) * V_ROWB + (dt * 16 + (fr & 3) * 4) * 2)); \
        vf[dt] = (bf16x8){lo[0], lo[1], lo[2], lo[3], hi[0], hi[1], hi[2], hi[3]}; } \
    _Pragma("unroll") for (int qt = 0; qt < QT; ++qt) { \
        f32x4 s[2]; \
        _Pragma("unroll") for (int kt = 0; kt < 2; ++kt) { s[kt] = (f32x4){0.f, 0.f, 0.f, 0.f}; \
            _Pragma("unroll") for (int ks = 0; ks < 2; ++ks) s[kt] = __builtin_amdgcn_mfma_f32_16x16x32_bf16(kf[kt][ks], qf[qt][ks], s[kt], 0, 0, 0); } \
        float mx = -INFINITY; \
        _Pragma("unroll") for (int kt = 0; kt < 2; ++kt) _Pragma("unroll") for (int j = 0; j < 4; ++j) { const float tv = s[kt][j] * (SCALE) + BIAS(qt, kt, j); s[kt][j] = tv; mx = fmaxf(mx, tv); } \
        mx = fmaxf(mx, __shfl_xor(mx, 16)); mx = fmaxf(mx, __shfl_xor(mx, 32)); \
        const float mn = fmaxf(st.m[qt], mx), al = fexp2(st.m[qt] - mn); st.m[qt] = mn; \
        float ps = 0.f; \
        _Pragma("unroll") for (int kt = 0; kt < 2; ++kt) _Pragma("unroll") for (int j = 0; j < 4; ++j) { const float pv = fexp2(s[kt][j] - mn); s[kt][j] = pv; ps += pv; } \
        st.l[qt] = st.l[qt] * al + ps; \
        const unsigned w0 = pk2(s[0][0], s[0][1]), w1 = pk2(s[0][2], s[0][3]), w2 = pk2(s[1][0], s[1][1]), w3 = pk2(s[1][2], s[1][3]); \
        const bf16x8 pf = __builtin_bit_cast(bf16x8, ((u32x4){w0, w1, w2, w3})); \
        _Pragma("unroll") for (int dt = 0; dt < 4; ++dt) st.o[dt][qt] = __builtin_amdgcn_mfma_f32_16x16x32_bf16(vf[dt], pf, st.o[dt][qt] * al, 0, 0, 0); } \
    } while (0)

__device__ __forceinline__ void attn_store(AttnSt& st, bf16_t* dst  , int dld, int fr, int fq) {
#pragma unroll
    for (int qt = 0; qt < QT; ++qt) {
        float l = st.l[qt]; l += __shfl_xor(l, 16); l += __shfl_xor(l, 32);
        const float inv = 1.f / l;
#pragma unroll
        for (int dt = 0; dt < 4; ++dt) { const f32x4 o = st.o[dt][qt] * inv; u32x2 w; w.x = pk2(o[0], o[1]); w.y = pk2(o[2], o[3]);
            *(u32x2*)(dst + (size_t)(qt * 16 + fr) * dld + dt * 16 + 4 * fq) = w; }
    }
}

__device__ __forceinline__ void phase_attn_l0(Frame& F) {
    const int wid = F.wid, lane = F.lane, fr = lane & 15, fq = lane >> 4;
    LAS unsigned char* vl = F.lds + wid * 8192;
    constexpr int N_WIN = 256, N_CTXA = 16, N_CONV = NTOK / 64;
    const float SC = 0.125f * LOG2E;
    for (int it = F.bid; it < N_WIN + N_CTXA + N_CONV; it += F.G) {
        if (it < N_WIN + N_CTXA) {
            const bool isctx = it >= N_WIN;
            int b, kvh, qb;
            if (!isctx) { b = it >> 6; kvh = (it >> 5) & 1; qb = it & 31; } else { const int c = it - N_WIN; b = c >> 2; kvh = (c >> 1) & 1; qb = c & 1; }
            const int g = wid >> 1, h = kvh * 4 + g;
            for (int qh = 0; qh < 4 / QT; ++qh) {
            const int qq0 = (wid & 1) * 64 + qh * (16 * QT);
            const int qrow0 = (isctx ? NMAIN + b * CTXL : b * SEQ) + qb * 128 + qq0;
            bf16x8 qf[QT][2];
#pragma unroll
            for (int qt = 0; qt < QT; ++qt)
#pragma unroll
                for (int ks = 0; ks < 2; ++ks) qf[qt][ks] = *(const bf16x8*)(F_PROJ + (size_t)(qrow0 + qt * 16 + fr) * EVEN_IN + h * 64 + ks * 32 + 8 * fq);
            AttnSt st;
            const float sink = PP(even_sink)[h] * LOG2E;
#pragma unroll
            for (int qt = 0; qt < QT; ++qt) { st.m[qt] = sink; st.l[qt] = (fq == 0) ? 1.f : 0.f;
#pragma unroll
                for (int dt = 0; dt < 4; ++dt) st.o[dt][qt] = (f32x4){0.f, 0.f, 0.f, 0.f}; }
            const int kcol = 512 + kvh * 64, vcol = 640 + kvh * 64;
            for (int ch = isctx ? 3 : 0; ch < 5; ++ch) {
                int krow0;
                if (ch < 3) { const int kb = qb - 1 + ch; if (kb < 0 || kb >= SEQ / 128) continue; krow0 = b * SEQ + kb * 128; } else krow0 = NMAIN + b * CTXL + (ch - 3) * 128;
                for (int s32 = 0; s32 < 4; ++s32) {
                    const bf16_t* kp = F_PROJ + (size_t)(krow0 + s32 * 32) * EVEN_IN + kcol;
                    const bf16_t* vp = F_PROJ + (size_t)(krow0 + s32 * 32) * EVEN_IN + vcol;
                    if (ch == 0) {
#define BIAS_PREV(qt, kt, j) ((s32 * 32 + kt * 16 + 4 * fq + j) >= (qq0 + qt * 16 + fr) ? 0.f : -INFINITY)
                        ATTN_STEP(kp, EVEN_IN, vp, EVEN_IN, SC, BIAS_PREV);
                    } else if (ch == 2) {
#define BIAS_NEXT(qt, kt, j) ((s32 * 32 + kt * 16 + 4 * fq + j) <= (qq0 + qt * 16 + fr) ? 0.f : -INFINITY)
                        ATTN_STEP(kp, EVEN_IN, vp, EVEN_IN, SC, BIAS_NEXT);
                    } else {
#define BIAS_NONE(qt, kt, j) 0.f
                        ATTN_STEP(kp, EVEN_IN, vp, EVEN_IN, SC, BIAS_NONE);
                    }
                }
            }
            attn_store(st, F_MIX + (size_t)qrow0 * D + h * 64, D, fr, fq);
            }
        } else {
            const int ci = it - N_WIN - N_CTXA, c4 = (F.tid & 127) * 4, r0 = ci * 64 + (F.tid >> 7) * 16;
            const f32x4 w0 = *(const f32x4*)(PP(even_conv_w) + c4), w1 = *(const f32x4*)(PP(even_conv_w) + 512 + c4), w2 = *(const f32x4*)(PP(even_conv_w) + 1024 + c4);
#define LOADZ(dst, row_) do { const u32x2 gc_ = *(const u32x2*)(F_PROJ + (size_t)(row_) * EVEN_IN + 1280 + c4), uu_ = *(const u32x2*)(F_PROJ + (size_t)(row_) * EVEN_IN + 1792 + c4); \
                dst = (f32x4){bflo(gc_.x) * bflo(uu_.x), bfhi(gc_.x) * bfhi(uu_.x), bflo(gc_.y) * bflo(uu_.y), bfhi(gc_.y) * bfhi(uu_.y)}; } while (0)
            const int seqmask = r0 < NMAIN ? (SEQ - 1) : (CTXL - 1);
            f32x4 zp = (f32x4){0.f, 0.f, 0.f, 0.f}, zc, zn;
            if ((r0 & seqmask) != 0) LOADZ(zp, r0 - 1);
            LOADZ(zc, r0);
            for (int i = 0; i < 16; ++i) {
                const int row = r0 + i;
                zn = (f32x4){0.f, 0.f, 0.f, 0.f}; if ((row & seqmask) != seqmask) LOADZ(zn, row + 1);
                const u32x2 gb = *(const u32x2*)(F_PROJ + (size_t)row * EVEN_IN + 768 + c4);
                const f32x4 y = zp * w0 + zc * w1 + zn * w2;
                u32x2 w; w.x = pk2(bflo(gb.x) * y[0], bfhi(gb.x) * y[1]); w.y = pk2(bflo(gb.y) * y[2], bfhi(gb.y) * y[3]);
                *(u32x2*)(F_MIX + (size_t)row * D + 512 + c4) = w;
                zp = zc; zc = zn;
            }
        }
    }
}

constexpr int RW_LD = 1028;
__device__ __forceinline__ void phase_route(Frame& F, const int layer) {
    const int nrows = layer == 0 ? NTOK : NMAIN;
    LAS float* rwT = (LAS float*)F.lds;
    LAS int* cntL = (LAS int*)(F.lds + 32 * RW_LD * 4);
    LAS int* baseL = cntL + 32;
    LAS int* selE = baseL + 32;
    LAS int* selR = selE + 384;
    const float* rw = PP(router_w) + (size_t)layer * D * NEXP;
    { const f32x4* rsrc4 = (const f32x4*)rw + F.tid; LAS float* wp = rwT + ((4 * F.tid) & 31) * RW_LD + (F.tid >> 3);
      for (int it = 0; it < 4; ++it) {
        f32x4 v[4];
#pragma unroll
        for (int u = 0; u < 4; ++u) v[u] = rsrc4[(it * 4 + u) * 512];
#pragma unroll
        for (int u = 0; u < 4; ++u)
#pragma unroll
            for (int j = 0; j < 4; ++j) wp[it * 256 + u * 64 + j * RW_LD] = v[u][j];
        asm volatile("" ::: "memory"); } }
    if (F.tid < 32) cntL[F.tid] = 0;
    __syncthreads();
    const int lane = F.lane, gw = F.bid * 8 + F.wid, NGW = F.G * 8;
    const float* gam = PP(norm_ffn) + layer * D;
    int slot = F.wid;
    f32x4 vn[4];
    if (gw < nrows) {
#pragma unroll
        for (int j = 0; j < 4; ++j) vn[j] = *(const f32x4*)(F_XS + (size_t)gw * D + 4 * lane + 256 * j); }
    for (int row = gw; row < nrows; row += NGW, slot += 8) {
        f32x4 v[4], h[4];
#pragma unroll
        for (int j = 0; j < 4; ++j) v[j] = vn[j];
        if (row + NGW < nrows) {
#pragma unroll
            for (int j = 0; j < 4; ++j) vn[j] = *(const f32x4*)(F_XS + (size_t)(row + NGW) * D + 4 * lane + 256 * j); }
        const float rstd = row_rstd(v); const int r = mod_row(row);
        norm_mod_store(v, rstd, gam, modp(F, layer, r, 4), modp(F, layer, r, 3), F_H + (size_t)row * D, lane, &h);
        float pe[32];
#pragma unroll
        for (int e = 0; e < 32; ++e) { float s = 0.f;
#pragma unroll
            for (int j = 0; j < 4; ++j) { const f32x4 w = *(const LAS f32x4*)(rwT + e * RW_LD + 4 * lane + 256 * j); s += (h[j][0] * w[0] + h[j][1] * w[1]) + (h[j][2] * w[2] + h[j][3] * w[3]); }
            pe[e] = s; if ((e & 3) == 3) __builtin_amdgcn_sched_barrier(0); }
        float q16[16], q8[8], q4[4], q2[2], q1;
        { const bool hi = lane & 32;
#pragma unroll
          for (int i = 0; i < 16; ++i) { const float snd = hi ? pe[i] : pe[16 + i], mine = hi ? pe[16 + i] : pe[i]; q16[i] = mine + __shfl_xor(snd, 32); } }
        { const bool hi = lane & 16;
#pragma unroll
          for (int i = 0; i < 8; ++i) { const float snd = hi ? q16[i] : q16[8 + i], mine = hi ? q16[8 + i] : q16[i]; q8[i] = mine + __shfl_xor(snd, 16); } }
        { const bool hi = lane & 8;
#pragma unroll
          for (int i = 0; i < 4; ++i) { const float snd = hi ? q8[i] : q8[4 + i], mine = hi ? q8[4 + i] : q8[i]; q4[i] = mine + __shfl_xor(snd, 8); } }
        { const bool hi = lane & 4;
#pragma unroll
          for (int i = 0; i < 2; ++i) { const float snd = hi ? q4[i] : q4[2 + i], mine = hi ? q4[2 + i] : q4[i]; q2[i] = mine + __shfl_xor(snd, 4); } }
        { const bool hi = lane & 2; const float snd = hi ? q2[0] : q2[1], mine = hi ? q2[1] : q2[0]; q1 = mine + __shfl_xor(snd, 2); }
        q1 += __shfl_xor(q1, 1);
        const int myE = (lane >> 1) & 31;
        float val = q1 + PP(router_b)[layer * NEXP + myE];
        float tv[4]; int te[4];
        { int rank = 0; const int vb = __builtin_bit_cast(int, val);
#pragma unroll
          for (int e2 = 0; e2 < 32; ++e2) { const float o = __builtin_bit_cast(float, __builtin_amdgcn_readlane(vb, 2 * e2)); rank += (o > val || (o == val && e2 < myE)) ? 1 : 0; }
#pragma unroll
          for (int k = 0; k < 4; ++k) { const unsigned long long mk = __ballot(rank == k); const int src = __builtin_amdgcn_readfirstlane((int)__builtin_ctzll(mk));
              tv[k] = __builtin_bit_cast(float, __builtin_amdgcn_readlane(vb, src)); te[k] = (src >> 1) & 31; } }
        const float e1 = __expf(tv[1] - tv[0]), e2 = __expf(tv[2] - tv[0]), e3 = __expf(tv[3] - tv[0]), inv = 1.f / (1.f + e1 + e2 + e3);
        if (lane == 0) {
            *(f32x4*)(F_TOPW + (size_t)row * 4) = (f32x4){inv, e1 * inv, e2 * inv, e3 * inv};
#pragma unroll
            for (int k = 0; k < 4; ++k) { selE[slot * 4 + k] = te[k]; selR[slot * 4 + k] = atomicAdd((int*)(cntL + te[k]), 1); }
        }
    }
    __syncthreads();
    if (F.tid < 32) { const int c = cntL[F.tid]; baseL[F.tid] = c ? (int)atomicAdd(F_cnt + layer * 32 + F.tid, (unsigned)c) : 0; }
    __syncthreads();
    if (F.tid < 384) { const int s = F.tid >> 2, k = F.tid & 3; const int row = F.bid * 8 + (s & 7) + (s >> 3) * NGW;
        if (row < nrows) { const int e = selE[F.tid], pos = baseL[e] + selR[F.tid]; F_POS[(size_t)row * 4 + k] = e | (pos << 8); F_LIST[(size_t)e * NTOK + pos] = row; } }
    __syncthreads();
}

struct MoeLds { LAS int *mtp, *roff, *mtq, *nz; };
__device__ __forceinline__ MoeLds moe_lds(Frame& F) { MoeLds L; L.mtp = (LAS int*)(F.lds + 2 * STAGE_B); L.roff = L.mtp + 40; L.mtq = L.roff + 40; L.nz = L.mtq + 40; return L; }
__device__ __forceinline__ void moe_prefix(Frame& F, const int layer, const MoeLds& L) {
    if (F.tid < 64) { const int e = F.lane & 31; const int c = (int)__hip_atomic_load(F_cnt + layer * 32 + e, __ATOMIC_RELAXED, __HIP_MEMORY_SCOPE_AGENT);
        const int mt = (c + 255) >> 8; int a = mt, b = c, q = mt > 0 ? mt - 1 : 0, z = mt > 0 ? 1 : 0;
#pragma unroll
        for (int o = 1; o < 32; o <<= 1) { const int ua = __shfl_up(a, o, 32), ub = __shfl_up(b, o, 32), uq = __shfl_up(q, o, 32), uz = __shfl_up(z, o, 32); if (e >= o) { a += ua; b += ub; q += uq; z += uz; } }
        if (F.lane < 32) { L.mtp[e + 1] = a; L.roff[e + 1] = b; L.mtq[e + 1] = q; if (mt > 0) L.nz[z - 1] = e; if (e == 31) L.nz[32] = z; if (e == 0) { L.mtp[0] = 0; L.roff[0] = 0; L.mtq[0] = 0; } } }
    __syncthreads();
}
struct PolMoe : PolBase {
    const float* W; MoeLds L; int layer, nct, round; size_t bc_off;
    __device__ __forceinline__ bool find(int i, int& e, int& ct, int& rbase, int& ro, int& cnt) const { int T; if (!tileL(i, T)) return false;
        if (round == 0) { const int q = T / nct; ct = T - q * nct; e = __builtin_amdgcn_readfirstlane(L.nz[q]); rbase = 0; }
        else { LAS int* pf = round == 1 ? L.mtq : L.mtp; e = 0; while (pf[e + 1] * nct <= T) ++e;
            e = __builtin_amdgcn_readfirstlane(e);
            const int mq = __builtin_amdgcn_readfirstlane(pf[e + 1] - pf[e]), w = T - __builtin_amdgcn_readfirstlane(pf[e]) * nct; ct = w / mq; rbase = ((round == 1 ? 1 : 0) + w - ct * mq) * 256; }
        ro = __builtin_amdgcn_readfirstlane(L.roff[e]); cnt = __builtin_amdgcn_readfirstlane(L.roff[e + 1]) - ro; return true; }
    __device__ __forceinline__ bf16_t* panel(int e, int ct) const { return (bf16_t*)(ws + bc_off) + (size_t)(e * nct + ct) * (1024 * 256); }
};
struct PolMoe1 : PolMoe {
    __device__ __forceinline__ unsigned list_voff(const TD& td) const { return 4u * (unsigned)(td.i0 * NTOK + td.i2 + lane * 4); }
    __device__ __forceinline__ void late(TD& td, const LAS int* ll) const { const int cl = td.i4 - 1 - td.i2;
#pragma unroll
        for (int i2 = 0; i2 < 2; ++i2) { int rl = prow(i2); rl = rl < cl ? rl : cl; td.aoff[i2] = (unsigned)((ll[rl] * D + pcol()) * 2); } }
    __device__ __forceinline__ unsigned bias_voff(const TD& td) const { return 4u * (unsigned)((layer * NEXP + td.i0) * (2 * DFF) + (lane >> 5) * DFF + td.i1 * 128 + (lane & 31) * 4); }
    __device__ __forceinline__ bool get(int i, TD& td) const { int e, ct, rbase, ro, cnt; if (!find(i, e, ct, rbase, ro, cnt)) return false;
        const int* list = (const int*)(ws + WS_LIST) + (size_t)e * NTOK; td.A = (const bf16_t*)(ws + WS_H);
        if (!has_list || i == 0) {
#pragma unroll
            for (int i2 = 0; i2 < 4; ++i2) { int rr = rbase + prow(i2); rr = rr < cnt ? rr : cnt - 1; td.aoff[i2] = (unsigned)((list[rr] * D + pcol()) * 2); } }
        if (round == 0) { td.B = W + ((size_t)(layer * NEXP + e) * D + wid * 8) * (2 * DFF) + ct * 128; td.ldb = 2 * DFF; td.bco = panel(e, ct); } else { td.B = panel(e, ct); td.bco = nullptr; }
        td.i0 = e; td.i1 = ct; td.i2 = rbase; td.i3 = ro; td.i4 = cnt; return true; }
    __device__ __forceinline__ void epi(f32x4 (&acc)[8][4], const TD& td, const LAS float* bl) const { (void)bl; EPI_GEOM; const int e = td.i0, ct = td.i1, rbase = td.i2, ro = td.i3, cnt = td.i4;
        bf16_t* ACT = (bf16_t*)(ws + WS_ACT);
#pragma unroll
        for (int n = 0; n < 2; ++n) { const int gc = ct * 128 + wc * 32 + n * 16 + 4 * fq;
            const int gl = wc * 32 + n * 16 + 4 * fq; const f32x4 bg = bl ? *(const LAS f32x4*)(bl + gl) : *(const f32x4*)(bias + (size_t)(layer * NEXP + e) * (2 * DFF) + gc), bu = bl ? *(const LAS f32x4*)(bl + 128 + gl) : *(const f32x4*)(bias + (size_t)(layer * NEXP + e) * (2 * DFF) + DFF + gc);
#pragma unroll
            for (int m = 0; m < 8; ++m) { const int r = rbase + wr * 128 + m * 16 + fr; float a[4];
#pragma unroll
                for (int j = 0; j < 4; ++j) { const float gg = fminf(acc[m][n][j] + bg[j], 7.f), uu = __builtin_amdgcn_fmed3f(acc[m][n + 2][j] + bu[j], -7.f, 7.f);
                    a[j] = (uu + 1.f) * gg * __builtin_amdgcn_rcpf(1.f + fexp2(-1.702f * LOG2E * gg)); }
                if (r < cnt) { u32x2 w; w.x = pk2(a[0], a[1]); w.y = pk2(a[2], a[3]); *(u32x2*)(ACT + (size_t)(ro + r) * DFF + gc) = w; } } } }
};
struct PolMoe2 : PolMoe {
    __device__ __forceinline__ unsigned bias_voff(const TD& td) const { return 4u * (unsigned)((layer * NEXP + td.i0) * D + td.i1 * 256 + lane * 4); }
    __device__ __forceinline__ bool get(int i, TD& td) const { int e, ct, rbase, ro, cnt; if (!find(i, e, ct, rbase, ro, cnt)) return false;
        td.A = (const bf16_t*)(ws + WS_ACT);
#pragma unroll
        for (int i2 = 0; i2 < 4; ++i2) { int rr = rbase + prow(i2); rr = rr < cnt ? rr : cnt - 1; td.aoff[i2] = (unsigned)(((ro + rr) * DFF + pcol()) * 2); }
        td.B = panel(e, ct); td.bco = nullptr;
        td.i0 = e; td.i1 = ct; td.i2 = rbase; td.i3 = ro; td.i4 = cnt; return true; }
    __device__ __forceinline__ void epi(f32x4 (&acc)[8][4], const TD& td, const LAS float* bl) const { (void)bl; EPI_GEOM; const int e = td.i0, ct = td.i1, rbase = td.i2, ro = td.i3, cnt = td.i4;
        bf16_t* Y = (bf16_t*)(ws + WS_Y);
#pragma unroll
        for (int n = 0; n < 4; ++n) { const int c = ct * 256 + wc * 64 + n * 16 + 4 * fq; const f32x4 bv = bl ? *(const LAS f32x4*)(bl + wc * 64 + n * 16 + 4 * fq) : *(const f32x4*)(bias + (size_t)(layer * NEXP + e) * D + c);
#pragma unroll
            for (int m = 0; m < 8; ++m) { const int r = rbase + wr * 128 + m * 16 + fr;
                if (r < cnt) { u32x2 w; w.x = pk2(acc[m][n][0] + bv[0], acc[m][n][1] + bv[1]); w.y = pk2(acc[m][n][2] + bv[2], acc[m][n][3] + bv[3]); *(u32x2*)(Y + (size_t)(ro + r) * D + c) = w; } } } }
};
__device__ __forceinline__ void phase_moe1(Frame& F, const XcdBarrier& bar, const bool use_bar, const int layer) {
    { const float* Wd = PP(moe_w_dn) + (size_t)layer * NEXP * DFF * D; bf16_t* pd = (bf16_t*)(F.ws + WS_BC2);
      for (int r0 = (F.bid * 8 + F.wid) * 8; r0 < NEXP * 4 * 1024; r0 += F.G * 64) {
          f32x4 v[8];
#pragma unroll
          for (int u = 0; u < 8; ++u) { const int pr = r0 + u, pnl = pr >> 10, k = pr & 1023, e = pnl >> 2, ct = pnl & 3;
              v[u] = *(const f32x4*)(Wd + ((size_t)e * DFF + k) * D + ct * 256 + 4 * F.lane); }
#pragma unroll
          for (int u = 0; u < 8; ++u) { const int pr = r0 + u; u32x2 w; w.x = pk2(v[u][0], v[u][1]); w.y = pk2(v[u][2], v[u][3]);
              *(u32x2*)(pd + (size_t)pr * 256 + 4 * F.lane) = w; } } }
    const MoeLds L = moe_lds(F);
    moe_prefix(F, layer, L);
    const int ne = __builtin_amdgcn_readfirstlane(L.nz[32]), tq = __builtin_amdgcn_readfirstlane(L.mtq[32]);
    const float* W = PP(moe_w_gu); const float* bias = PP(moe_b_gu);
    { PolMoe1 P; P.L = L; P.layer = layer; P.nct = 8; P.round = 0; P.bc_off = WS_BC; P.base_init(F, D / 64, ne * 8); P.bfm = false; P.W = W; P.bias = bias;
      { const int l2 = F.lane & 31; P.lcolb = 4u * (unsigned)((F.lane >> 5) * DFF + 4 * l2); P.woff = 2u * (unsigned)(((4 * l2) >> 5) * 64 + (F.lane >> 5) * 32 + ((4 * l2) & 31)); }
      gemm_stream(F.lds, P, F.wid, F.lane); }
    if (use_bar) xcd_barrier(bar);
    { PolMoe1 P; P.L = L; P.layer = layer; P.nct = 8; P.round = 1; P.bc_off = WS_BC; P.base_init(F, D / 64, tq * 8); P.ldbB = 256; P.W = W; P.bias = bias; P.has_bias = true; P.has_list = true; P.listp = (const int*)(F.ws + WS_LIST);
      gemm_stream_bf(F.lds, P, F.wid, F.lane); }
}
__device__ __forceinline__ void phase_moe2(Frame& F, const int layer) {
    const MoeLds L = moe_lds(F);
    moe_prefix(F, layer, L);
    PolMoe2 P; P.L = L; P.layer = layer; P.nct = 4; P.round = 2; P.bc_off = WS_BC2; P.base_init(F, DFF / 64, __builtin_amdgcn_readfirstlane(L.mtp[32]) * 4); P.ldbB = 256; P.W = nullptr; P.bias = PP(moe_b_dn); P.has_bias = true;
    gemm_stream_bf(F.lds, P, F.wid, F.lane);
}

__device__ __forceinline__ void phase_combine(Frame& F, const int layer) {
    const MoeLds ML = moe_lds(F); LAS int* roff = ML.roff;
    moe_prefix(F, layer, ML);
    const int nrows = layer == 0 ? NTOK : NMAIN, lane = F.lane;
    const int gw = F.bid * 8 + F.wid, NGW = F.G * 8;
    i32x4 ps_n = (i32x4){0, 0, 0, 0}; f32x4 tw_n = (f32x4){0.f, 0.f, 0.f, 0.f}, tw_c = tw_n;
    u32x2 y_c[4][4], y_n[4][4]; f32x4 xs_c[4], xs_n[4];
#define CMB_IDX(row_) do { if ((row_) < nrows) { ps_n = *(const i32x4*)(F_POS + (size_t)(row_) * 4); tw_n = *(const f32x4*)(F_TOPW + (size_t)(row_) * 4); } } while (0)
#define CMB_DATA(row_, Y_, XS_) do { if ((row_) < nrows) { \
        _Pragma("unroll") for (int k = 0; k < 4; ++k) { const int e = ps_n[k] & 255, pos = ps_n[k] >> 8; const bf16_t* y = F_Y + (size_t)(roff[e] + pos) * D; \
            _Pragma("unroll") for (int j = 0; j < 4; ++j) Y_[k][j] = *(const u32x2*)(y + 4 * lane + 256 * j); } \
        _Pragma("unroll") for (int j = 0; j < 4; ++j) XS_[j] = *(const f32x4*)(F_XS + (size_t)(row_) * D + 4 * lane + 256 * j); } } while (0)
    CMB_IDX(gw); CMB_DATA(gw, y_c, xs_c); tw_c = tw_n; CMB_IDX(gw + NGW);
    for (int row = gw; row < nrows; row += NGW) {
        CMB_DATA(row + NGW, y_n, xs_n); const f32x4 tw_nn = tw_n; CMB_IDX(row + 2 * NGW);
        const int r = mod_row(row); const float* g2 = modp(F, layer, r, 5);
        f32x4 v[4];
#pragma unroll
        for (int j = 0; j < 4; ++j) v[j] = (f32x4){0.f, 0.f, 0.f, 0.f};
#pragma unroll
        for (int k = 0; k < 4; ++k) { const float w = tw_c[k];
#pragma unroll
            for (int j = 0; j < 4; ++j) { const u32x2 u = y_c[k][j]; v[j][0] += w * bflo(u.x); v[j][1] += w * bfhi(u.x); v[j][2] += w * bflo(u.y); v[j][3] += w * bfhi(u.y); } }
#pragma unroll
        for (int j = 0; j < 4; ++j) { const int c = 4 * lane + 256 * j; const f32x4 gv = *(const f32x4*)(g2 + c); v[j] = xs_c[j] + gv * v[j]; }
        const float rstd = row_rstd(v);
        if (layer == 0) {
#pragma unroll
            for (int j = 0; j < 4; ++j) *(f32x4*)(F_XS + (size_t)row * D + 4 * lane + 256 * j) = v[j];
            norm_mod_store(v, rstd, PP(norm_mix) + D, modp(F, 1, r, 1), modp(F, 1, r, 0), F_H + (size_t)row * D, lane);
        } else {
#pragma unroll
            for (int j = 0; j < 4; ++j) { const int c = 4 * lane + 256 * j; const f32x4 g = *(const f32x4*)(PP(final_norm) + c); *(f32x4*)(((float*)ldp(F, (int)__builtin_offsetof(Params, out))) + (size_t)row * D + c) = v[j] * rstd * g; }
        }
        tw_c = tw_nn;
#pragma unroll
        for (int k = 0; k < 4; ++k)
#pragma unroll
            for (int j = 0; j < 4; ++j) y_c[k][j] = y_n[k][j];
#pragma unroll
        for (int j = 0; j < 4; ++j) xs_c[j] = xs_n[j];
        __builtin_amdgcn_sched_barrier(0);
    }
#undef CMB_IDX
#undef CMB_DATA
}

struct PolInproj1 : PolBase {
    const float* W;
    __device__ __forceinline__ bool get(int i, TD& td) const { int t; if (!tileL(i, t)) return false; constexpr int N_MAIN_T = (NMAIN / 256) * 10; int pm, pn;
        if (t < N_MAIN_T) dense_tile(t, NMAIN / 256, 10, pm, pn); else { const int c = t - N_MAIN_T; pm = NMAIN / 256 + (c & 3); pn = 2 + (c >> 2); }
        td.A = (const bf16_t*)(ws + WS_H); dense_aoff(td, pm * 256, D);
        td.B = (const bf16_t*)(ws + WB_OIN) + pn * 256; td.i0 = pm; td.i1 = pn; return true; }
    __device__ __forceinline__ void epi(f32x4 (&acc)[8][4], const TD& td, const LAS float* bl) const { (void)bl; EPI_GEOM; const int pm = td.i0, pn = td.i1;
        if (pn < 6) { bf16_t* PROJ = (bf16_t*)(ws + WS_PROJ);
#pragma unroll
            for (int m = 0; m < 8; ++m) { const int row = pm * 256 + wr * 128 + m * 16 + fr;
#pragma unroll
                for (int n = 0; n < 4; ++n) { u32x2 w; w.x = pk2(acc[m][n][0], acc[m][n][1]); w.y = pk2(acc[m][n][2], acc[m][n][3]);
                    *(u32x2*)(PROJ + (size_t)row * QKV_LD + pn * 256 + wc * 64 + n * 16 + 4 * fq) = w; } }
        } else { const int g = pn - 6, ri = wc >> 1; bf16_t* Z = (bf16_t*)(ws + WS_Z);
#pragma unroll
            for (int m = 0; m < 8; ++m) { const int row = pm * 256 + wr * 128 + m * 16 + fr, b = row >> 12, n1 = (row >> 6) & 63, n2 = row & 63;
                bf16_t* zb = Z + ((((size_t)(b * 64 + n1) * 2 + ri) * 64 + n2) * 512) + g * 128 + (wc & 1) * 64;
#pragma unroll
                for (int n = 0; n < 4; ++n) { u32x2 w; w.x = pk2(acc[m][n][0], acc[m][n][1]); w.y = pk2(acc[m][n][2], acc[m][n][3]); *(u32x2*)(zb + n * 16 + 4 * fq) = w; } } } }
};
__device__ __forceinline__ void phase_inproj_l1(Frame& F) {
    PolInproj1 P; P.base_init(F, D / 64, (NMAIN / 256) * 10 + (NCTX / 256) * 4); P.ldbB = 2560;
    gemm_stream_bf(F.lds, P, F.wid, F.lane);
}

struct PolFour : PolBase {
    int stage;
    __device__ __forceinline__ bool get(int i, TD& td) const { int L; if (!tileL(i, L)) return false; const int b = L >> 7, ct = L & 127;
        td.A = (const bf16_t*)(ws + (stage == 1 ? WS_M1 : WS_M2)); dense_aoff(td, 0, 128);
        td.B = (const bf16_t*)(ws + (stage == 1 ? WS_Z : WS_A1)) + (size_t)b * 128 * 32768 + ct * 256; td.i0 = b; td.i1 = ct; return true; }
    __device__ __forceinline__ void epi(f32x4 (&acc)[8][4], const TD& td, const LAS float* bl) const { (void)bl; EPI_GEOM; const int b = td.i0, ct = td.i1;
        if (wr != 0) return;
        if (stage == 1) { const f32x2* TW = (const f32x2*)(ws + WS_TW); bf16_t* A1 = (bf16_t*)(ws + WS_A1);
#pragma unroll
            for (int m = 0; m < 4; ++m) { const int k1 = m * 16 + fr;
#pragma unroll
                for (int n = 0; n < 4; ++n) { const int col = ct * 256 + wc * 64 + n * 16 + 4 * fq, n2 = col >> 9, c = col & 511;
                    const f32x2 tw = TW[n2 * k1]; const f32x4 re = acc[m][n], im = acc[m + 4][n];
                    const f32x4 ore = re * tw.x + im * tw.y, oim = im * tw.x - re * tw.y; u32x2 w0, w1;
                    w0.x = pk2(ore[0], ore[1]); w0.y = pk2(ore[2], ore[3]); w1.x = pk2(oim[0], oim[1]); w1.y = pk2(oim[2], oim[3]);
                    *(u32x2*)(A1 + ((((size_t)(b * 2 + 0) * 64 + n2) * 64 + k1) * 512) + c) = w0;
                    *(u32x2*)(A1 + ((((size_t)(b * 2 + 1) * 64 + n2) * 64 + k1) * 512) + c) = w1; } }
        } else { const float scl = 1.f / 724.0773439350247f; bf16_t* MIX = (bf16_t*)(ws + WS_MIX);
#pragma unroll
            for (int m = 0; m < 4; ++m) { const int k2 = m * 16 + fr;
#pragma unroll
                for (int n = 0; n < 4; ++n) { const int col = ct * 256 + wc * 64 + n * 16 + 4 * fq, k1 = col >> 9, c = col & 511;
                    const f32x4 o = acc[m][n] * scl; u32x2 w; w.x = pk2(o[0], o[1]); w.y = pk2(o[2], o[3]);
                    *(u32x2*)(MIX + (size_t)(b * SEQ + k1 + 64 * k2) * D + 512 + c) = w; } } } }
};

__device__ __forceinline__ void phase_attn_l1(Frame& F) {
    const int wid = F.wid, lane = F.lane, fr = lane & 15, fq = lane >> 4;
    constexpr int N_NA = NB * 64, N_F1 = NB * 128;
    const float SC = 0.125f * LOG2E;
    for (int it = F.bid; it < N_NA; it += F.G) {
            LAS unsigned char* vl = F.lds + wid * 8192;
            LAS float* rp = (LAS float*)(vl + 5120);
            const int b = it >> 6, r = it & 63, h = wid;
            for (int i = lane; i < 465; i += 64) rp[i] = PP(odd_rpb)[h * 465 + i] * LOG2E;
            for (int qh = 0; qh < 4 / QT; ++qh) {
            const int qc0 = qh * (16 * QT), qrow0 = b * SEQ + r * 64 + qc0;
            bf16x8 qf[QT][2];
#pragma unroll
            for (int qt = 0; qt < QT; ++qt)
#pragma unroll
                for (int ks = 0; ks < 2; ++ks) qf[qt][ks] = *(const bf16x8*)(F_PROJ + (size_t)(qrow0 + qt * 16 + fr) * QKV_LD + h * 64 + ks * 32 + 8 * fq);
            AttnSt st;
#pragma unroll
            for (int qt = 0; qt < QT; ++qt) { st.m[qt] = -1e30f; st.l[qt] = 0.f;
#pragma unroll
                for (int dt = 0; dt < 4; ++dt) st.o[dt][qt] = (f32x4){0.f, 0.f, 0.f, 0.f}; }
            const int r0 = min(max(r - 4, 0), 56);
            int c0q[QT];
#pragma unroll
            for (int qt = 0; qt < QT; ++qt) c0q[qt] = min(max(qc0 + qt * 16 + fr - 8, 0), 48);
            for (int s = 0; s < 16; ++s) {
                const int kr = r0 + (s >> 1), half = s & 1;
                const bf16_t* kp = F_PROJ + (size_t)(b * SEQ + kr * 64 + half * 32) * QKV_LD + 512 + h * 64;
                const bf16_t* vp = kp + 512;
                const LAS float* rpr = rp + (kr - r + 7) * 31 + 15;
#define BIAS_NA(qt, kt, j) ({ const int kc = half * 32 + kt * 16 + 4 * fq + j; const int dc = kc - (qc0 + qt * 16 + fr); (kc >= c0q[qt] && kc < c0q[qt] + 16) ? rpr[dc] : -INFINITY; })
                ATTN_STEP(kp, QKV_LD, vp, QKV_LD, SC, BIAS_NA);
            }
            for (int s = 0; s < 8; ++s) {
                const bf16_t* kp = F_PROJ + (size_t)(NMAIN + b * CTXL + s * 32) * QKV_LD + 512 + h * 64;
                const bf16_t* vp = kp + 512;
                ATTN_STEP(kp, QKV_LD, vp, QKV_LD, SC, BIAS_NONE);
            }
            attn_store(st, F_MIX + (size_t)qrow0 * D + h * 64, D, fr, fq);
            }
    }
    __syncthreads();
    PolFour P; P.stage = 1; P.base_init(F, 2, N_F1); P.ldbB = 32768;
    gemm_stream_bf(F.lds, P, F.wid, F.lane);
}

__device__ __forceinline__ void phase_fst2(Frame& F) {
    PolFour P; P.stage = 2; P.base_init(F, 2, NB * 128); P.ldbB = 32768;
    gemm_stream_bf(F.lds, P, F.wid, F.lane);
}

__global__ void __launch_bounds__(512, 2) fwd_kernel(Params p) {
    extern __shared__ __attribute__((aligned(16))) unsigned char lds_raw[];
    Frame F;
    F.lds = (LAS unsigned char*)lds_raw;
    F.tid = threadIdx.x; F.lane = F.tid & 63; F.wid = __builtin_amdgcn_readfirstlane(F.tid >> 6); F.bid = blockIdx.x; F.G = gridDim.x;
    unsigned char* ws = p.ws; F.ws = ws;
    volatile LAS unsigned* MISC = (volatile LAS unsigned*)(F.lds + MISC_OFF);
    if (F.tid < 64) MISC[F.tid] = 0u;
    if (F.tid == 64) { LAS unsigned long long* LP = (LAS unsigned long long*)(F.lds + PARAM_OFF);
        LP[0] = (unsigned long long)p.x; LP[1] = (unsigned long long)p.c; LP[2] = (unsigned long long)p.ctx; LP[3] = (unsigned long long)p.c_ctx; LP[4] = (unsigned long long)p.ada_w; LP[5] = (unsigned long long)p.ada_b;
        LP[6] = (unsigned long long)p.norm_mix; LP[7] = (unsigned long long)p.norm_ffn; LP[8] = (unsigned long long)p.even_w_in; LP[9] = (unsigned long long)p.even_w_out; LP[10] = (unsigned long long)p.even_conv_w;
        LP[11] = (unsigned long long)p.even_sink; LP[12] = (unsigned long long)p.odd_w_in; LP[13] = (unsigned long long)p.odd_w_out; LP[14] = (unsigned long long)p.odd_rpb; LP[15] = (unsigned long long)p.router_w;
        LP[16] = (unsigned long long)p.router_b; LP[17] = (unsigned long long)p.moe_w_gu; LP[18] = (unsigned long long)p.moe_b_gu; LP[19] = (unsigned long long)p.moe_w_dn; LP[20] = (unsigned long long)p.moe_b_dn;
        LP[21] = (unsigned long long)p.final_norm; LP[22] = (unsigned long long)p.out; }
    __syncthreads();
    const int lo = p.ph_lo, hi = p.ph_hi;
    XcdBarrier bar; bar.bar = (unsigned*)(ws + WS_CTL) + CW_BAR; bar.x = 0; bar.st = MISC + 8;
    if (hi - lo > 1) bar = xcd_barrier_post((unsigned*)(ws + WS_CTL) + CW_BAR, MISC + 8);
#define RUN_PHASE(ph, call) do { if (PH_ON(ph) && lo <= (ph) && (ph) < hi) { call; if (PH_REP(ph)) { xcd_barrier(bar); call; } } if (lo <= (ph) && (ph) + 1 < hi) xcd_barrier(bar); } while (0)
    RUN_PHASE(PH_PREP, phase_prep(F));
    RUN_PHASE(PH_NORM1_0, phase_norm1_l0(F));
    RUN_PHASE(PH_INPROJ_0, phase_inproj_l0(F));
    RUN_PHASE(PH_ATTN_0, phase_attn_l0(F));
    RUN_PHASE(PH_OUTPROJ_0, phase_outproj(F, 0));
    RUN_PHASE(PH_ROUTE_0, phase_route(F, 0));
    RUN_PHASE(PH_MOE1_0, phase_moe1(F, bar, hi - lo > 1, 0));
    RUN_PHASE(PH_MOE2_0, phase_moe2(F, 0));
    RUN_PHASE(PH_COMB_0, phase_combine(F, 0));
    RUN_PHASE(PH_INPROJ_1, phase_inproj_l1(F));
    RUN_PHASE(PH_ATTN_1, phase_attn_l1(F));
    RUN_PHASE(PH_FST2_1, phase_fst2(F));
    RUN_PHASE(PH_OUTPROJ_1, phase_outproj(F, 1));
    RUN_PHASE(PH_ROUTE_1, phase_route(F, 1));
    RUN_PHASE(PH_MOE1_1, phase_moe1(F, bar, hi - lo > 1, 1));
    RUN_PHASE(PH_MOE2_1, phase_moe2(F, 1));
    RUN_PHASE(PH_FINAL, phase_combine(F, 1));
}

extern "C" void kernel_launch(void* const* d_in, const int* in_sizes, int n_in, void* d_out, int out_size, void* d_ws, size_t ws_size, hipStream_t stream) {
    static int grid = 0;
    if (grid == 0) {
        if (n_in != 22 || ws_size < WS_END) { fprintf(stderr, "kernel_launch: unexpected inputs (n_in %d, ws %zu)\n", n_in, ws_size); grid = -1; return; }
        int dev = 0, cus = 0, per_cu = 0;
        hipGetDevice(&dev);
        hipDeviceGetAttribute(&cus, hipDeviceAttributeMultiprocessorCount, dev);
        hipFuncSetAttribute((const void*)fwd_kernel, hipFuncAttributeMaxDynamicSharedMemorySize, LDS_BYTES);
        hipOccupancyMaxActiveBlocksPerMultiprocessor(&per_cu, (const void*)fwd_kernel, 512, LDS_BYTES);
        if (per_cu < 1) { fprintf(stderr, "kernel_launch: occupancy query says %d blocks/CU\n", per_cu); per_cu = 1; }
        (void)hipGetLastError();
        grid = cus;
    }
    if (grid < 0) return;
    hipMemsetAsync((char*)d_ws + WS_CTL, 0, CTL_BYTES, stream);
    Params p{};
    const float** pp = (const float**)&p;
    for (int i = 0; i < 22; ++i) pp[i] = (const float*)d_in[i];
    p.out = (float*)d_out; p.ws = (unsigned char*)d_ws;
#if N_LAUNCH_MODE == 1
    for (int ph = 0; ph < NPHASE; ++ph) { p.ph_lo = ph; p.ph_hi = ph + 1; hipLaunchKernelGGL(fwd_kernel, dim3(grid), dim3(512), LDS_BYTES, stream, p); }
#else
    p.ph_lo = 0; p.ph_hi = NPHASE;
    void* args[] = {&p};
    hipError_t e = hipLaunchCooperativeKernel((const void*)fwd_kernel, dim3(grid), dim3(512), args, LDS_BYTES, stream);
    if (e != hipSuccess) fprintf(stderr, "kernel_launch: cooperative launch failed: %s (grid %d)\n", hipGetErrorString(e), grid);
#endif
}
```

```cpp
#include <hip/hip_runtime.h>
#include <cstdio>
#include <cstdint>

#ifndef N_LAUNCH_MODE
#define N_LAUNCH_MODE 0
#endif

#ifndef PHASE_MASK
#define PHASE_MASK 0x1FFFF
#endif
#define PH_ON(ph) ((PHASE_MASK >> (ph)) & 1)
#ifndef REPEAT_MASK
#define REPEAT_MASK 0
#endif
#define PH_REP(ph) ((REPEAT_MASK >> (ph)) & 1)
#define LAS __attribute__((address_space(3)))
#define GAS __attribute__((address_space(1)))
typedef unsigned short bf16_t;
typedef short bf16x8 __attribute__((ext_vector_type(8)));
typedef short s16x4 __attribute__((ext_vector_type(4)));
typedef float f32x4 __attribute__((ext_vector_type(4)));
typedef float f32x2 __attribute__((ext_vector_type(2)));
typedef int i32x4 __attribute__((ext_vector_type(4)));
typedef unsigned u32x2 __attribute__((ext_vector_type(2)));
typedef unsigned u32x4 __attribute__((ext_vector_type(4)));

constexpr int D = 1024, NB = 4, SEQ = 4096, CTXL = 256;
constexpr int NMAIN = NB * SEQ, NCTX = NB * CTXL, NTOK = NMAIN + NCTX;
constexpr int EVEN_IN = 2304, NEXP = 32, DFF = 1024;
constexpr int QKV_LD = 1536;
constexpr float NORM_EPS = 1e-6f;
constexpr float LOG2E = 1.4426950408889634f;

constexpr size_t MiB = 1ull << 20;
constexpr size_t WS_CTL = 0, CTL_BYTES = 1 * MiB;
constexpr size_t WS_MOD = 1 * MiB;
constexpr size_t WS_M1 = 2 * MiB;
constexpr size_t WS_M2 = WS_M1 + 65536;
constexpr size_t WS_ROPE = WS_M2 + 65536;
constexpr size_t WS_TW = WS_ROPE + 8192;
constexpr size_t WS_WF = 4 * MiB;
constexpr size_t WS_TOPW = 8 * MiB;
constexpr size_t WS_POS = 9 * MiB;
constexpr size_t WS_LIST = 12 * MiB;
constexpr size_t WS_H = 16 * MiB;
constexpr size_t WS_MIX = 52 * MiB;
constexpr size_t WS_XS = 88 * MiB;
constexpr size_t WS_PROJ = 160 * MiB;
constexpr size_t WS_Z = 240 * MiB;
constexpr size_t WS_A1 = 304 * MiB;
constexpr size_t WS_ACT = 368 * MiB;
constexpr size_t WS_Y = 512 * MiB;
constexpr size_t WS_WB = 656 * MiB;
constexpr size_t WB_EIN = WS_WB, WB_EOUT = WB_EIN + (size_t)D * EVEN_IN * 2, WB_OIN = WB_EOUT + (size_t)D * D * 2, WB_OOUT = WB_OIN + (size_t)D * 2560 * 2;
constexpr size_t WS_BC = 672 * MiB;
constexpr size_t WS_BC2 = WS_BC + 128 * MiB;
constexpr size_t WS_END = 864 * MiB;
constexpr int CW_BAR = 4096;
constexpr int CW_CNT = 8192;

constexpr int LDS_BYTES = 147456;
constexpr int PARAM_OFF = LDS_BYTES - 512;
constexpr int MISC_OFF = LDS_BYTES - 256;
constexpr int A_TILE_B = 32768, B_ROWB = 544, B_TILE_B = 64 * B_ROWB, STAGE_B = A_TILE_B + B_TILE_B;
static_assert(2 * STAGE_B + 1024 + 8192 <= PARAM_OFF, "LDS");

enum { PH_PREP = 0, PH_NORM1_0, PH_INPROJ_0, PH_ATTN_0, PH_OUTPROJ_0, PH_ROUTE_0, PH_MOE1_0, PH_MOE2_0, PH_COMB_0,
       PH_INPROJ_1, PH_ATTN_1, PH_FST2_1, PH_OUTPROJ_1, PH_ROUTE_1, PH_MOE1_1, PH_MOE2_1, PH_FINAL, NPHASE };

struct Params {
    const float *x, *c, *ctx, *c_ctx, *ada_w, *ada_b, *norm_mix, *norm_ffn, *even_w_in, *even_w_out, *even_conv_w, *even_sink,
                *odd_w_in, *odd_w_out, *odd_rpb, *router_w, *router_b, *moe_w_gu, *moe_b_gu, *moe_w_dn, *moe_b_dn, *final_norm;
    float* out; unsigned char* ws; int ph_lo, ph_hi;
};

__device__ __forceinline__ unsigned pk2(float lo, float hi) { unsigned r; asm("v_cvt_pk_bf16_f32 %0, %1, %2" : "=v"(r) : "v"(lo), "v"(hi)); return r; }
__device__ __forceinline__ float bflo(unsigned u) { return __builtin_bit_cast(float, u << 16); }
__device__ __forceinline__ float bfhi(unsigned u) { return __builtin_bit_cast(float, u & 0xffff0000u); }
__device__ __forceinline__ float wave_sum(float v) {
#pragma unroll
    for (int o = 1; o < 64; o <<= 1) v += __shfl_xor(v, o);
    return v;
}
__device__ __forceinline__ float fexp2(float x) { return __builtin_amdgcn_exp2f(x); }

#define XB_TMO      128
#define XB_XCNT(j)  (256  + 64 * (j))
#define XB_XSUB(j)  (1280 + 64 * (j))
#define XB_XGEN(j)  (2304 + 64 * (j))
#define XB_TOP      3328
#define XB_TOPGEN   3392
#define XB_SPIN_CAP (1u << 22)
__device__ __forceinline__ unsigned xb_ld(unsigned* p)              { return __hip_atomic_load(p, __ATOMIC_RELAXED, __HIP_MEMORY_SCOPE_AGENT); }
__device__ __forceinline__ unsigned xb_add(unsigned* p, unsigned v) { return __hip_atomic_fetch_add(p, v, __ATOMIC_RELAXED, __HIP_MEMORY_SCOPE_AGENT); }
__device__ __forceinline__ unsigned xb_xcc_id() { return (unsigned)__builtin_amdgcn_s_getreg((3 << 11) | 20) & 0xFu; }
#define XB_SPIN(cond, bar) do { unsigned _sp = 0; while (cond) { __builtin_amdgcn_s_sleep(1); \
    if ((++_sp & 255u) == 0u) { if (xb_ld(&(bar)[XB_TMO])) break; if (_sp > XB_SPIN_CAP) { atomicAdd(&(bar)[XB_TMO], 1u); break; } } } } while (0)
struct XcdBarrier { unsigned* bar; unsigned x; volatile LAS unsigned* st; };
__device__ __forceinline__ XcdBarrier xcd_barrier_post(unsigned* bar, volatile LAS unsigned* st) {
    XcdBarrier b; b.bar = bar; b.x = xb_xcc_id(); b.st = st;
    if (threadIdx.x == 0) (void)xb_add(&bar[XB_XCNT(b.x)], 1u);
    return b;
}
__device__ __forceinline__ void xcd_barrier_complete(unsigned* bar, unsigned x, unsigned& nloc, unsigned& nx) {
    const unsigned G = gridDim.x * gridDim.y * gridDim.z;
    unsigned sum, cnt, mine, sp = 0u;
    for (;;) {
        sum = 0u; cnt = 0u; mine = 0u;
#pragma unroll
        for (unsigned j = 0; j < 16; ++j) { const unsigned c = xb_ld(&bar[XB_XCNT(j)]); sum += c; cnt += (c > 0u) ? 1u : 0u; mine = (j == x) ? c : mine; }
        if (sum == G) break;
        __builtin_amdgcn_s_sleep(1);
        if ((++sp & 255u) == 0u) { if (xb_ld(&bar[XB_TMO])) break; if (sp > XB_SPIN_CAP) { atomicAdd(&bar[XB_TMO], 1u); break; } }
    }
    nloc = mine > 0u ? mine : 1u; nx = cnt > 0u ? cnt : 1u;
}
__device__ __forceinline__ void xcd_barrier(const XcdBarrier& b) {
    asm volatile("s_waitcnt vmcnt(0)" ::: "memory");
    __syncthreads();
    if (threadIdx.x == 0) {
        unsigned* bar = b.bar;
        __builtin_amdgcn_s_waitcnt(0);
        unsigned nloc = b.st[0], nx = b.st[1];
        if (nloc == 0u) { xcd_barrier_complete(bar, b.x, nloc, nx); b.st[0] = nloc; b.st[1] = nx; }
        const unsigned old = xb_add(&bar[XB_XSUB(b.x)], 1u);
        const unsigned gen = old / nloc;
        if (old + 1u == (gen + 1u) * nloc) {
            __builtin_amdgcn_fence(__ATOMIC_RELEASE, "agent");
            asm volatile("s_waitcnt vmcnt(0)" ::: "memory");
            const unsigned og = xb_add(&bar[XB_TOP], 1u);
            const unsigned tg = og / nx;
            if (og + 1u == (tg + 1u) * nx) xb_add(&bar[XB_TOPGEN], 1u);
            else XB_SPIN(xb_ld(&bar[XB_TOPGEN]) == tg, bar);
            __builtin_amdgcn_fence(__ATOMIC_ACQUIRE, "agent");
            xb_add(&bar[XB_XGEN(b.x)], 1u);
            asm volatile("s_waitcnt vmcnt(0)" ::: "memory");
        } else {
            XB_SPIN(xb_ld(&bar[XB_XGEN(b.x)]) == gen, bar);
            __builtin_amdgcn_fence(__ATOMIC_ACQUIRE, "agent");
            asm volatile("s_waitcnt vmcnt(0)" ::: "memory");
        }
    }
    __syncthreads();
}

struct TD { const bf16_t* A; const void* B; bf16_t* bco; unsigned ldb; unsigned aoff[4]; int i0, i1, i2, i3, i4; };
__device__ __forceinline__ int a_piece_row0(int wid, int lane) { const int sb = lane * 16, swz = sb ^ (((sb >> 9) & 1) << 5); return (wid >> 1) * 16 + (swz >> 6); }
__device__ __forceinline__ int a_piece_col(int wid, int lane) { const int sb = lane * 16, swz = sb ^ (((sb >> 9) & 1) << 5); return (wid & 1) * 32 + ((swz & 63) >> 1); }
__device__ __forceinline__ u32x4 make_rsrc(const void* p) { const unsigned long long ab = (unsigned long long)p; u32x4 r; r.x = __builtin_amdgcn_readfirstlane((unsigned)ab); r.y = __builtin_amdgcn_readfirstlane((unsigned)(ab >> 32)) & 0xffffu; r.z = 0x7fffffffu; r.w = 0x00020000u; return r; }

template <class Pol>
__device__ __forceinline__ void gemm_stream(LAS unsigned char* lds, Pol& P, const int wid, const int lane) {
    const int wr = wid >> 2, wc = wid & 3, fr = lane & 15, fq = lane >> 4;
    const unsigned b_w = (unsigned)(A_TILE_B + ((wid >> 2) * 32 + 4 * (wid & 3)) * B_ROWB) + P.woff;
    const unsigned a_r = (unsigned)(wr * 16384 + ((fr * 64 + fq * 16) ^ ((fr >> 3) << 5)));
    const unsigned b_r = (unsigned)(A_TILE_B + (4 * fq + (fr >> 2)) * B_ROWB + (wc * 64 + (fr & 3) * 4) * 2);
    const unsigned ldsa = (unsigned)(__UINTPTR_TYPE__)lds + (unsigned)(wid * 1024);
    const unsigned lcolb = P.lcolb;
    TD cur, nxt;
    if (!P.get(0, cur)) return;
    int nt = P.nt; asm volatile("" : "+s"(nt));
    f32x4 sb[8]; f32x4 acc[8][4];
    u32x4 ra_c = make_rsrc(cur.A), ra_n = ra_c;
    __amdgpu_buffer_rsrc_t rb_c = __builtin_amdgcn_make_buffer_rsrc((void*)cur.B, 0, 0x7fffffff, 0x00020000), rb_n = rb_c;
#define G_GLDS_A(buf, RA, AOFF, kt) do { _Pragma("unroll") for (int i = 0; i < 4; ++i) { unsigned keep_; \
        asm volatile("s_mov_b32 %0, m0\n\ts_mov_b32 m0, %3\n\ts_nop 0\n\tbuffer_load_dwordx4 %1, %2, %4 offen lds\n\ts_mov_b32 m0, %0" \
            : "=&s"(keep_) : "v"(AOFF[i]), "s"(RA), "s"(ldsa + (buf) + (unsigned)(i * 8192)), "s"((unsigned)((kt) * 128)) : "memory"); } } while (0)
#define G_ISSUE_BH(RB, LDB4, kt, h) do { \
        _Pragma("unroll") for (int i = 4 * (h); i < 4 * (h) + 4; ++i) sb[i] = __builtin_bit_cast(f32x4, __builtin_amdgcn_raw_buffer_load_b128(RB, (int)lcolb, (int)(((unsigned)(kt) * 64u + i) * (LDB4)), 0)); \
        __builtin_amdgcn_sched_barrier(0); } while (0)
#define G_WRITE_BH(buf, h, BCO, kt) do { \
        _Pragma("unroll") for (int i = 4 * (h); i < 4 * (h) + 4; ++i) { u32x2 w; w.x = pk2(sb[i][0], sb[i][1]); w.y = pk2(sb[i][2], sb[i][3]); \
            *(LAS u32x2*)(lds + (buf) + b_w + (16 * (i >> 2) + (i & 3)) * B_ROWB) = w; \
            if (BCO) *(u32x2*)((char*)(BCO) + (size_t)((kt) * 64 + wid * 8 + i) * 512 + P.woff) = w; } __builtin_amdgcn_sched_barrier(0); } while (0)
#define G_KSTEP(buf, ks) do { bf16x8 Bf[4]; \
        _Pragma("unroll") for (int n = 0; n < 4; ++n) { \
            const s16x4 lo = __builtin_amdgcn_ds_read_tr16_b64_v4i16((LAS s16x4*)(lds + (buf) + b_r + (ks) * 32 * B_ROWB + n * 32)); \
            const s16x4 hi = __builtin_amdgcn_ds_read_tr16_b64_v4i16((LAS s16x4*)(lds + (buf) + b_r + (ks) * 32 * B_ROWB + 16 * B_ROWB + n * 32)); \
            Bf[n] = (bf16x8){lo[0], lo[1], lo[2], lo[3], hi[0], hi[1], hi[2], hi[3]}; } \
        _Pragma("unroll") for (int mh = 0; mh < 2; ++mh) { bf16x8 At[4]; \
            _Pragma("unroll") for (int m = 0; m < 4; ++m) At[m] = *(const LAS bf16x8*)(lds + (buf) + a_r + (mh * 4 + m) * 2048 + (ks) * 1024); \
            _Pragma("unroll") for (int m = 0; m < 4; ++m) _Pragma("unroll") for (int n = 0; n < 4; ++n) \
                acc[mh * 4 + m][n] = __builtin_amdgcn_mfma_f32_16x16x32_bf16(Bf[n], At[m], acc[mh * 4 + m][n], 0, 0, 0); } \
        __builtin_amdgcn_sched_barrier(0); } while (0)
    { unsigned b0 = 0; asm volatile("" : "+s"(b0));
      const unsigned l4 = cur.ldb * 4u;
      G_GLDS_A(b0, ra_c, cur.aoff, 0); G_ISSUE_BH(rb_c, l4, 0, 0); G_ISSUE_BH(rb_c, l4, 0, 1); G_WRITE_BH(b0, 0, cur.bco, 0); G_WRITE_BH(b0, 1, cur.bco, 0);
      G_ISSUE_BH(rb_c, l4, 1, 0); G_ISSUE_BH(rb_c, l4, 1, 1); }
    asm volatile("s_waitcnt vmcnt(8)" ::: "memory");
    asm volatile("s_waitcnt lgkmcnt(0)" ::: "memory");
    __builtin_amdgcn_s_barrier();
    unsigned par = 0;
    for (int ti = 0;; ++ti) {
        const bool hasn = P.get(ti + 1, nxt);
        if (hasn) { ra_n = make_rsrc(nxt.A); rb_n = __builtin_amdgcn_make_buffer_rsrc((void*)nxt.B, 0, 0x7fffffff, 0x00020000); }
#pragma unroll
        for (int m = 0; m < 8; ++m)
#pragma unroll
            for (int n = 0; n < 4; ++n) acc[m][n] = (f32x4){0.f, 0.f, 0.f, 0.f};
        for (int t = 0; t < nt; ++t) {
            unsigned bc = par * STAGE_B, bn = (par ^ 1u) * STAGE_B; asm volatile("" : "+s"(bc), "+s"(bn));
            const bool c1 = t + 1 < nt, w1 = c1 || hasn, c2 = t + 2 < nt, i2 = c2 || hasn;
            if (w1) { const u32x4 ra = c1 ? ra_c : ra_n; unsigned ao[4];
#pragma unroll
                for (int i = 0; i < 4; ++i) ao[i] = c1 ? cur.aoff[i] : nxt.aoff[i];
                G_GLDS_A(bn, ra, ao, c1 ? t + 1 : 0); }
            G_KSTEP(bc, 0);
            const __amdgpu_buffer_rsrc_t rb = c2 ? rb_c : rb_n; const unsigned l4 = (c2 ? cur.ldb : nxt.ldb) * 4u; const int k2 = c2 ? t + 2 : t + 2 - nt;
            bf16_t* const bco = c1 ? cur.bco : nxt.bco; const int k1 = c1 ? t + 1 : 0;
            if (w1) G_WRITE_BH(bn, 0, bco, k1);
            if (i2) G_ISSUE_BH(rb, l4, k2, 0);
            G_KSTEP(bc, 1);
            if (w1) G_WRITE_BH(bn, 1, bco, k1);
            if (i2) { G_ISSUE_BH(rb, l4, k2, 1); asm volatile("s_waitcnt vmcnt(8)" ::: "memory"); }
            else asm volatile("s_waitcnt vmcnt(0)" ::: "memory");
            asm volatile("s_waitcnt lgkmcnt(0)" ::: "memory");
            __builtin_amdgcn_s_barrier();
            par ^= 1u;
        }
        P.epi(acc, cur, (const LAS float*)nullptr);
        if (!hasn) break;
        cur = nxt; ra_c = ra_n; rb_c = rb_n;
    }
#undef G_GLDS_A
#undef G_ISSUE_BH
#undef G_WRITE_BH
#undef G_KSTEP
}

constexpr int STEP_B = 32768;
constexpr unsigned ROPE_LDS = 2 * STAGE_B + 1024;
constexpr unsigned BIAS_OFF = 4 * STEP_B;
template <class Pol, int ABL = 0>
__device__ __forceinline__ void gemm_stream_bf(LAS unsigned char* lds, Pol& P, const int wid, const int lane) {
    const int wr = wid >> 2, wc = wid & 3, fr = lane & 15, fq = lane >> 4;
    const unsigned a_r = (unsigned)(wr * 8192 + ((fr * 64 + fq * 16) ^ ((fr >> 3) << 5)));
    const int x7 = 4 * (fq & 1) + (fr >> 2);
    unsigned b_r[4];
#pragma unroll
    for (int n = 0; n < 4; ++n) b_r[n] = (unsigned)(16384 + (4 * fq + (fr >> 2)) * 512 + (((wc * 4 + n) ^ x7) * 32) + (fr & 3) * 8);
    const unsigned ldsa = (unsigned)(__UINTPTR_TYPE__)lds + (unsigned)(wid * 2048), ldsb = (unsigned)(__UINTPTR_TYPE__)lds + 16384u + (unsigned)(wid * 2048);
    const unsigned ldb2 = P.ldbB * 2u;
    unsigned boff[2];
#pragma unroll
    for (int j = 0; j < 2; ++j) { const int sl = 4 * wid + 2 * j + (lane >> 5), u = lane & 31, c = (u >> 1) ^ (sl & 7), n = c * 16 + (u & 1) * 8;
        const int k = 8 * ((sl >> 2) & 3) + 4 * (sl >> 4) + (sl & 3); boff[j] = (unsigned)k * ldb2 + (unsigned)n * 2u; }
    TD cur, nxt;
    if (!P.get(0, cur)) return;
    int nt = P.nt * 2; asm volatile("" : "+s"(nt));
    f32x4 acc[8][4];
    u32x4 ra_c = make_rsrc(cur.A), ra_n = ra_c, rb_c = make_rsrc(cur.B), rb_n = rb_c;
#define H_DMA(LDSADDR, RS, VOFF, SOFF) do { unsigned keep_; \
        asm volatile("s_mov_b32 %0, m0\n\ts_mov_b32 m0, %3\n\ts_nop 0\n\tbuffer_load_dwordx4 %1, %2, %4 offen lds\n\ts_mov_b32 m0, %0" \
            : "=&s"(keep_) : "v"(VOFF), "s"(RS), "s"(LDSADDR), "s"(SOFF) : "memory"); } while (0)
#define H_STAGE(sb_, RA, AO0, AO1, RB, st) do { \
        if (!(ABL & 2)) { H_DMA(ldsa + (sb_), RA, AO0, (unsigned)((st) * 64)); H_DMA(ldsa + (sb_) + 1024u, RA, AO1, (unsigned)((st) * 64)); } \
        if (!(ABL & 1)) { H_DMA(ldsb + (sb_), RB, boff[0], (unsigned)(st) * 32u * ldb2); H_DMA(ldsb + (sb_) + 1024u, RB, boff[1], (unsigned)(st) * 32u * ldb2); } } while (0)
#define H_READ(sb_) do { if (!(ABL & 16)) { \
        _Pragma("unroll") for (int n = 0; n < 4; ++n) { \
            const s16x4 lo = __builtin_amdgcn_ds_read_tr16_b64_v4i16((LAS s16x4*)(lds + (sb_) + b_r[n])); \
            const s16x4 hi = __builtin_amdgcn_ds_read_tr16_b64_v4i16((LAS s16x4*)(lds + (sb_) + b_r[n] + 8192)); \
            Bf[n] = (bf16x8){lo[0], lo[1], lo[2], lo[3], hi[0], hi[1], hi[2], hi[3]}; } \
        _Pragma("unroll") for (int m = 0; m < 8; ++m) At[m] = *(const LAS bf16x8*)(lds + (sb_) + a_r + m * 1024); } } while (0)
#define H_MMA() do { if (!(ABL & 16)) { __builtin_amdgcn_s_setprio(1); \
        if (!(ABL & 4)) { _Pragma("unroll") for (int m = 0; m < 8; ++m) _Pragma("unroll") for (int n = 0; n < 4; ++n) \
            acc[m][n] = __builtin_amdgcn_mfma_f32_16x16x32_bf16(Bf[n], At[m], acc[m][n], 0, 0, 0); } \
        else { _Pragma("unroll") for (int m = 0; m < 8; ++m) asm volatile("" :: "v"(At[m])); _Pragma("unroll") for (int n = 0; n < 4; ++n) asm volatile("" :: "v"(Bf[n])); } \
        __builtin_amdgcn_s_setprio(0); } } while (0)
#define H_BAR() do { asm volatile("s_waitcnt lgkmcnt(0)" ::: "memory"); __builtin_amdgcn_s_barrier(); __builtin_amdgcn_sched_barrier(0); } while (0)
    bf16x8 At[8], Bf[4];
    { unsigned s0 = 0, s1 = STEP_B, s2 = 2 * STEP_B; asm volatile("" : "+s"(s0), "+s"(s1), "+s"(s2));
      H_STAGE(s0, ra_c, cur.aoff[0], cur.aoff[1], rb_c, 0); H_STAGE(s1, ra_c, cur.aoff[0], cur.aoff[1], rb_c, 1); H_STAGE(s2, ra_c, cur.aoff[0], cur.aoff[1], rb_c, 2); }
    asm volatile("s_waitcnt vmcnt(8)" ::: "memory");
    H_BAR();
    if (wr == 1) H_BAR();
    unsigned g = 0;
    for (int ti = 0;; ++ti) {
        const bool hasn = P.get(ti + 1, nxt);
        if (hasn) { ra_n = make_rsrc(nxt.A); rb_n = make_rsrc(nxt.B); }
        const unsigned bias_lds = BIAS_OFF + (unsigned)(ti & 1) * 1024u, list_lds = BIAS_OFF + 2048u + (unsigned)(ti & 1) * 1024u;
        if (P.has_bias && wid == 0) { const u32x4 rbias = make_rsrc(P.bias); H_DMA((unsigned)(__UINTPTR_TYPE__)lds + bias_lds, rbias, P.bias_voff(cur), 0u); }
        if (P.has_list && hasn && wid == 1) { const u32x4 rl = make_rsrc(P.listp); H_DMA((unsigned)(__UINTPTR_TYPE__)lds + list_lds, rl, P.list_voff(nxt), 0u); }
#pragma unroll
        for (int m = 0; m < 8; ++m)
#pragma unroll
            for (int n = 0; n < 4; ++n) acc[m][n] = (f32x4){0.f, 0.f, 0.f, 0.f};
        for (int t = 0; t < nt; ++t, ++g) {
            unsigned sc = (g & 3u) * STEP_B, sn = ((g + 3u) & 3u) * STEP_B; asm volatile("" : "+s"(sc), "+s"(sn));
            const bool c3 = t + 3 < nt, i3 = c3 || hasn, i2 = (t + 2 < nt) || hasn;
            if (P.has_list && hasn && t == nt - 3) P.late(nxt, (const LAS int*)(lds + list_lds));
            if (i3) { const u32x4 ra = c3 ? ra_c : ra_n, rb = c3 ? rb_c : rb_n; const unsigned a0 = c3 ? cur.aoff[0] : nxt.aoff[0], a1 = c3 ? cur.aoff[1] : nxt.aoff[1];
                H_STAGE(sn, ra, a0, a1, rb, c3 ? t + 3 : t + 3 - nt); }
            H_READ(sc);
            if (i3) asm volatile("s_waitcnt vmcnt(8)" ::: "memory");
            else if (i2) asm volatile("s_waitcnt vmcnt(4)" ::: "memory");
            else asm volatile("s_waitcnt vmcnt(0)" ::: "memory");
            H_BAR();
            H_MMA();
            H_BAR();
        }
        if (!(ABL & 8)) P.epi(acc, cur, (const LAS float*)(lds + bias_lds)); else { _Pragma("unroll") for (int m = 0; m < 8; ++m) _Pragma("unroll") for (int n = 0; n < 4; ++n) asm volatile("" :: "v"(acc[m][n])); }
        if (!hasn) break;
        cur = nxt; ra_c = ra_n; rb_c = rb_n;
    }
    if (wr == 0) H_BAR();
#undef H_DMA
#undef H_STAGE
#undef H_READ
#undef H_MMA
#undef H_BAR
}

struct XOrder {
    int c1, step, cur;
    __device__ __forceinline__ void init(int T, int G, int bid) {
        if ((G & 7) == 0) { const int x = bid & 7; cur = (int)(((long)x * T) >> 3) + (bid >> 3); c1 = (int)(((long)(x + 1) * T) >> 3); step = G >> 3; }
        else { cur = bid; c1 = T; step = G; }
    }
    __device__ __forceinline__ bool next(int& L) { if (cur >= c1) return false; L = cur; cur += step; return true; }
};
__device__ __forceinline__ void dense_tile(int L, int nM, int nN, int& pm, int& pn) { const int per = 8 * nN, g = L / per, w = L - g * per, fm = g * 8, gs = (nM - fm) < 8 ? (nM - fm) : 8; pn = w / gs; pm = fm + w - pn * gs; }

struct Frame { LAS unsigned char* lds; int tid, lane, wid, bid, G; unsigned char* ws; };
__device__ __forceinline__ const void* ldp(const Frame& F, int off) {
    const u32x2 v = *(const volatile LAS u32x2*)(F.lds + PARAM_OFF + off);
    const unsigned lo = __builtin_amdgcn_readfirstlane(v.x), hi = __builtin_amdgcn_readfirstlane(v.y);
    return (const void*)(((unsigned long long)hi << 32) | lo);
}
#define PP(f) ((const float*)ldp(F, (int)__builtin_offsetof(Params, f)))
#define F_mod ((float*)(F.ws + WS_MOD))
#define F_M1 ((bf16_t*)(F.ws + WS_M1))
#define F_M2 ((bf16_t*)(F.ws + WS_M2))
#define F_ROPE ((f32x2*)(F.ws + WS_ROPE))
#define F_TW ((f32x2*)(F.ws + WS_TW))
#define F_WF ((float*)(F.ws + WS_WF))
#define F_TOPW ((float*)(F.ws + WS_TOPW))
#define F_POS ((int*)(F.ws + WS_POS))
#define F_LIST ((int*)(F.ws + WS_LIST))
#define F_H ((bf16_t*)(F.ws + WS_H))
#define F_MIX ((bf16_t*)(F.ws + WS_MIX))
#define F_XS ((float*)(F.ws + WS_XS))
#define F_PROJ ((bf16_t*)(F.ws + WS_PROJ))
#define F_Z ((float*)(F.ws + WS_Z))
#define F_A1 ((float*)(F.ws + WS_A1))
#define F_ACT ((bf16_t*)(F.ws + WS_ACT))
#define F_Y ((bf16_t*)(F.ws + WS_Y))
#define F_cnt ((unsigned*)(F.ws + WS_CTL) + CW_CNT)

__device__ __forceinline__ const float* modp(const Frame& F, int l, int r, int which) { return F_mod + ((size_t)(l * 5 + r)) * 6144 + which * 1024; }
__device__ __forceinline__ int mod_row(int row) { return row < NMAIN ? (row >> 12) : 4; }

__device__ __forceinline__ float row_rstd(const f32x4 (&v)[4]) {
    float s = 0.f;
#pragma unroll
    for (int j = 0; j < 4; ++j) s += (v[j][0] * v[j][0] + v[j][1] * v[j][1]) + (v[j][2] * v[j][2] + v[j][3] * v[j][3]);
    return __builtin_amdgcn_rsqf(wave_sum(s) * (1.f / D) + NORM_EPS);
}
__device__ __forceinline__ void norm_mod_store(const f32x4 (&v)[4], float rstd, const float* gam, const float* sc, const float* sh, bf16_t* dst, int lane, f32x4 (*keep)[4] = nullptr) {
#pragma unroll
    for (int j = 0; j < 4; ++j) {
        const int c = 4 * lane + 256 * j;
        const f32x4 g = *(const f32x4*)(gam + c), s1 = *(const f32x4*)(sc + c), s0 = *(const f32x4*)(sh + c);
        f32x4 h;
#pragma unroll
        for (int i = 0; i < 4; ++i) h[i] = v[j][i] * rstd * g[i] * (1.f + s1[i]) + s0[i];
        u32x2 w; w.x = pk2(h[0], h[1]); w.y = pk2(h[2], h[3]);
        *(u32x2*)(dst + c) = w;
        if (keep) (*keep)[j] = h;
    }
}

__device__ __forceinline__ void phase_prep(Frame& F) {
    LAS float* sil = (LAS float*)F.lds;
    LAS float* red = (LAS float*)(F.lds + 20480);
    LAS float* ct = (LAS float*)(F.lds + 32768);
    for (int idx = F.tid; idx < 5120; idx += 512) { const int r = idx >> 10, k = idx & 1023; const float v = r < 4 ? PP(c)[r * 1024 + k] : PP(c_ctx)[k]; sil[idx] = v / (1.f + __expf(-v)); }
    if (F.tid < 128) ct[F.tid] = cospif((float)F.tid / 64.f);
    __syncthreads();
    constexpr int N_ADA = 192, N_CONST = 8, N_FOLD = 256, N_CVT = 368;
    for (int it = F.bid; it < N_ADA + N_CONST + N_FOLD + N_CVT; it += F.G) {
        if (it < N_ADA) {
            const int l = it / 96, j0 = (it % 96) * 64, col = j0 + F.lane;
            const float* w = PP(ada_w) + ((size_t)l * 1024 + F.wid * 128) * 6144 + col;
            float a[5] = {0.f, 0.f, 0.f, 0.f, 0.f};
#pragma unroll 8
            for (int k = 0; k < 128; ++k) { const float wv = w[(size_t)k * 6144];
#pragma unroll
                for (int r = 0; r < 5; ++r) a[r] += sil[r * 1024 + F.wid * 128 + k] * wv; }
#pragma unroll
            for (int r = 0; r < 5; ++r) red[(F.wid * 5 + r) * 64 + F.lane] = a[r];
            __syncthreads();
            if (F.tid < 320) { const int r = F.tid >> 6, ln = F.tid & 63; float s = 0.f;
#pragma unroll
                for (int w8 = 0; w8 < 8; ++w8) s += red[(w8 * 5 + r) * 64 + ln];
                F_mod[(size_t)(l * 5 + r) * 6144 + j0 + ln] = s + PP(ada_b)[l * 6144 + j0 + ln]; }
            __syncthreads();
        } else if (it < N_ADA + N_CONST) {
            const int gt = (it - N_ADA) * 512 + F.tid;
            for (int e = gt; e < 32768; e += 4096) {
                const int row = e >> 7, kk = e & 127;
                float v1 = 0.f, v2 = 0.f;
                if (row < 128) { const int ro = row >> 6, k1 = row & 63, n1 = kk >> 1, ri = kk & 1; const float ph = (float)((n1 * k1) & 63) / 32.f; const float cs = cospif(ph), sn = sinpif(ph);
                    v1 = (ro == ri) ? cs : (ro == 0 ? sn : -sn); }
                if (row < 64) { const int ro = kk >> 6, n2 = kk & 63; const float ph = (float)((row * n2) & 63) / 32.f; v2 = ro == 0 ? cospif(ph) : sinpif(ph); }
                F_M1[e] = (bf16_t)(pk2(v1, 0.f) & 0xffffu); F_M2[e] = (bf16_t)(pk2(v2, 0.f) & 0xffffu);
            }
            if (gt < 1024) { const int pos = gt >> 4, f = gt & 15; const double ang = (double)pos * pow(10000.0, -(double)f / 16.0); F_ROPE[gt] = (f32x2){(float)cos(ang), (float)sin(ang)}; }
            { const float ph = (float)gt / 2048.f; F_TW[gt] = (f32x2){cospif(ph), sinpif(ph)}; }
        } else if (it >= N_ADA + N_CONST + N_FOLD) {
            int ci = it - (N_ADA + N_CONST + N_FOLD); const float* src; bf16_t* dst; int sld, dld, ncol;
            if (ci < 144) { src = PP(even_w_in); dst = (bf16_t*)(F.ws + WB_EIN); sld = EVEN_IN; dld = EVEN_IN; ncol = EVEN_IN; }
            else if (ci < 208) { ci -= 144; src = PP(even_w_out); dst = (bf16_t*)(F.ws + WB_EOUT); sld = D; dld = D; ncol = D; }
            else if (ci < 304) { ci -= 208; src = PP(odd_w_in); dst = (bf16_t*)(F.ws + WB_OIN); sld = 2048; dld = 2560; ncol = 1536; }
            else { ci -= 304; src = PP(odd_w_out); dst = (bf16_t*)(F.ws + WB_OOUT); sld = D; dld = D; ncol = D; }
            const int q4 = ncol >> 2;
#pragma unroll
            for (int u = 0; u < 8; ++u) { const int gidx = ci * 4096 + u * 512 + F.tid, row = gidx / q4, c4 = (gidx - row * q4) * 4;
                const f32x4 v = *(const f32x4*)(src + (size_t)row * sld + c4); u32x2 w; w.x = pk2(v[0], v[1]); w.y = pk2(v[2], v[3]); *(u32x2*)(dst + (size_t)row * dld + c4) = w; }
        } else {
            const int fi = it - N_ADA - N_CONST, rc = fi >> 2, g = fi & 3, half = F.tid >> 8, j = F.tid & 255, jj = j & 127;
            for (int i2 = 0; i2 < 8; ++i2) {
                const int row = rc * 16 + i2 * 2 + half;
                const float* wr_ = PP(odd_w_in) + (size_t)row * 2048 + 1536 + g * 128;
                float s = 0.f;
                if (j < 128) { for (int cc = 0; cc < 128; ++cc) s += wr_[cc] * ct[(cc * jj) & 127]; }
                else { for (int cc = 0; cc < 128; ++cc) s -= wr_[cc] * ct[((cc * jj) - 32) & 127]; }
                ((bf16_t*)(F.ws + WB_OIN))[(size_t)row * 2560 + 1536 + g * 256 + j] = (bf16_t)(pk2(s, 0.f) & 0xffffu);
            }
        }
    }
}

__device__ __forceinline__ void phase_norm1_l0(Frame& F) {
    const int gw = F.bid * 8 + F.wid, NGW = F.G * 8;
    for (int row = gw; row < NTOK; row += NGW) {
        const float* src = row < NMAIN ? PP(x) + (size_t)row * D : PP(ctx) + (size_t)(row - NMAIN) * D;
        f32x4 v[4];
#pragma unroll
        for (int j = 0; j < 4; ++j) v[j] = *(const f32x4*)(src + 4 * F.lane + 256 * j);
        const float rstd = row_rstd(v); const int r = mod_row(row);
        norm_mod_store(v, rstd, PP(norm_mix), modp(F, 0, r, 1), modp(F, 0, r, 0), F_H + (size_t)row * D, F.lane);
    }
}

#define EPI_GEOM const int wid = this->wid, lane = this->lane, wr = wid >> 2, wc = wid & 3, fr = lane & 15, fq = lane >> 4; (void)wr; (void)wc; (void)fr; (void)fq
struct PolBase { unsigned char* ws; LAS unsigned char* lds; int wid, lane, nt; unsigned lcolb, woff, ldbB; XOrder xo; int aC, aR0, aCb, aR0b; bool bfm;
    __device__ __forceinline__ void base_init(Frame& F, int nt_, int T) { ws = F.ws; lds = F.lds; wid = F.wid; lane = F.lane; nt = nt_; lcolb = 16u * (unsigned)F.lane; woff = 8u * (unsigned)F.lane;
        xo.init(T, F.G, F.bid); aC = a_piece_col(F.wid, F.lane); aR0 = a_piece_row0(F.wid, F.lane); bfm = true;
        { const int sbb = F.lane * 16, swz = sbb ^ (((sbb >> 9) & 1) << 5); aR0b = F.wid * 32 + (swz >> 6); aCb = (swz & 63) >> 1; } }
    bool has_bias = false; const float* bias = nullptr;
    bool has_list = false; const int* listp = nullptr;
    __device__ __forceinline__ unsigned list_voff(const TD&) const { return 0u; }
    __device__ __forceinline__ void late(TD&, const LAS int*) const {}
    __device__ __forceinline__ unsigned bias_voff(const TD&) const { return 0u; }
    __device__ __forceinline__ bool tileL(int i, int& L) const { L = xo.cur + i * xo.step; return L < xo.c1; }
    __device__ __forceinline__ int prow(int i) const { return bfm ? aR0b + 16 * (i & 1) : aR0 + 64 * i; }
    __device__ __forceinline__ int pcol() const { return bfm ? aCb : aC; }
    __device__ __forceinline__ void dense_aoff(TD& td, int row0, int pitch) const {
#pragma unroll
        for (int i = 0; i < 4; ++i) td.aoff[i] = (unsigned)(((row0 + prow(i)) * pitch + pcol()) * 2); }
};

struct PolInproj0 : PolBase {
    const float* W; Frame* Fp;
    __device__ __forceinline__ bool get(int i, TD& td) const { int L; if (!tileL(i, L)) return false; int pm, pn; dense_tile(L, NTOK / 256, EVEN_IN / 256, pm, pn);
        td.A = (const bf16_t*)(ws + WS_H); dense_aoff(td, pm * 256, D); td.B = (const bf16_t*)(ws + WB_EIN) + pn * 256; td.i0 = pm; td.i1 = pn; return true; }
    __device__ __forceinline__ void epi(f32x4 (&acc)[8][4], const TD& td, const LAS float* bl) const { (void)bl; EPI_GEOM; const int pm = td.i0, pn = td.i1;
        const int colb = pn * 256 + wc * 64; const bool rope = (colb < 640) && (pm < NMAIN / 256);
        const LAS f32x2* ROPE = (const LAS f32x2*)(lds + ROPE_LDS); bf16_t* PROJ = (bf16_t*)(ws + WS_PROJ);
#pragma unroll
        for (int m = 0; m < 8; ++m) { const int row = pm * 256 + wr * 128 + m * 16 + fr;
            if (rope) { const int tt = row & (SEQ - 1), gr = tt >> 6, gc = tt & 63;
#pragma unroll
                for (int n = 0; n < 2; ++n) { const int pos = n == 0 ? gr : gc;
#pragma unroll
                    for (int j = 0; j < 4; ++j) { const f32x2 cs = ROPE[pos * 16 + 4 * fq + j]; const float x1 = acc[m][n][j], x2 = acc[m][n + 2][j];
                        acc[m][n][j] = x1 * cs.x - x2 * cs.y; acc[m][n + 2][j] = x2 * cs.x + x1 * cs.y; } } }
#pragma unroll
            for (int n = 0; n < 4; ++n) { u32x2 w; w.x = pk2(acc[m][n][0], acc[m][n][1]); w.y = pk2(acc[m][n][2], acc[m][n][3]);
                *(u32x2*)(PROJ + (size_t)row * EVEN_IN + colb + n * 16 + 4 * fq) = w; } } }
};
__device__ __forceinline__ void phase_inproj_l0(Frame& F) {
    for (int i = F.tid; i < 1024; i += 512) ((LAS f32x2*)(F.lds + ROPE_LDS))[i] = F_ROPE[i];
    __syncthreads();
    PolInproj0 P; P.base_init(F, D / 64, (NTOK / 256) * (EVEN_IN / 256)); P.ldbB = EVEN_IN;
    gemm_stream_bf(F.lds, P, F.wid, F.lane);
}

struct PolOutproj : PolBase {
    const float *W, *x, *ctx; int layer, nM;
    __device__ __forceinline__ bool get(int i, TD& td) const { int L; if (!tileL(i, L)) return false; int pm, pn; dense_tile(L, nM, 4, pm, pn);
        td.A = (const bf16_t*)(ws + WS_MIX); dense_aoff(td, pm * 256, D); td.B = (const bf16_t*)(ws + (layer == 0 ? WB_EOUT : WB_OOUT)) + pn * 256; td.i0 = pm; td.i1 = pn; return true; }
    __device__ __forceinline__ void epi(f32x4 (&acc)[8][4], const TD& td, const LAS float* bl) const { (void)bl; EPI_GEOM; const int pm = td.i0, pn = td.i1;
        const int colb = pn * 256 + wc * 64; float* XS = (float*)(ws + WS_XS); const float* mod = (const float*)(ws + WS_MOD);
#pragma unroll
        for (int m = 0; m < 8; ++m) { const int row = pm * 256 + wr * 128 + m * 16 + fr; const int r = mod_row(row);
            const float* xin = layer == 0 ? (row < NMAIN ? x + (size_t)row * D : ctx + (size_t)(row - NMAIN) * D) : XS + (size_t)row * D;
            const float* g1 = mod + ((size_t)(layer * 5 + r)) * 6144 + 2 * 1024;
#pragma unroll
            for (int n = 0; n < 4; ++n) { const int c = colb + n * 16 + 4 * fq; const f32x4 xv = *(const f32x4*)(xin + c), gv = *(const f32x4*)(g1 + c);
                f32x4 o;
#pragma unroll
                for (int j = 0; j < 4; ++j) o[j] = xv[j] + gv[j] * acc[m][n][j];
                *(f32x4*)(XS + (size_t)row * D + c) = o; } } }
};
__device__ __forceinline__ void phase_outproj(Frame& F, const int layer) {
    PolOutproj P; P.layer = layer; P.nM = (layer == 0 ? NTOK : NMAIN) / 256; P.base_init(F, D / 64, P.nM * 4);
    P.ldbB = D; P.x = PP(x); P.ctx = PP(ctx);
    gemm_stream_bf(F.lds, P, F.wid, F.lane);
}

constexpr int QT = 2;
struct AttnSt { f32x4 o[4][QT]; float m[QT], l[QT]; };
#define V_ROWB 160
__device__ __forceinline__ void v_stage(LAS unsigned char* vl, const bf16_t* vsrc, int ld, int lane) {
    i32x4 t[4];
    asm volatile("" ::: "memory");
#pragma unroll
    for (int i = 0; i < 4; ++i) t[i] = *(const i32x4*)(vsrc + (size_t)((lane >> 3) + 8 * i) * ld + (lane & 7) * 8);
#pragma unroll
    for (int i = 0; i < 4; ++i) *(LAS i32x4*)(vl + ((lane >> 3) + 8 * i) * V_ROWB + (lane & 7) * 16) = t[i];
    asm volatile("s_waitcnt lgkmcnt(0)" ::: "memory");
}
#define ATTN_STEP(ksrc, kld, vsrc, vld, SCALE, BIAS) do { \
    bf16x8 kf[2][2]; \
    _Pragma("unroll") for (int kt = 0; kt < 2; ++kt) _Pragma("unroll") for (int ks = 0; ks < 2; ++ks) \
        kf[kt][ks] = *(const bf16x8*)((ksrc) + (size_t)(kt * 16 + fr) * (kld) + ks * 32 + 8 * fq); \
    v_stage(vl, (vsrc), (vld), lane); \
    bf16x8 vf[4]; \
    _Pragma("unroll") for (int dt = 0; dt < 4; ++dt) { \
        const s16x4 lo = __builtin_amdgcn_ds_read_tr16_b64_v4i16((LAS s16x4*)(vl + (4 * fq + (fr >> 2)) * V_ROWB + (dt * 16 + (fr & 3) * 4) * 2)); \
        const s16x4 hi = __builtin_amdgcn_ds_read_tr16_b64_v4i16((LAS s16x4*)(vl + (16 + 4 * fq + (fr >> 2)) * V_ROWB + (dt * 16 + (fr & 3) * 4) * 2)); \
        vf[dt] = (bf16x8){lo[0], lo[1], lo[2], lo[3], hi[0], hi[1], hi[2], hi[3]}; } \
    _Pragma("unroll") for (int qt = 0; qt < QT; ++qt) { \
        f32x4 s[2]; \
        _Pragma("unroll") for (int kt = 0; kt < 2; ++kt) { s[kt] = (f32x4){0.f, 0.f, 0.f, 0.f}; \
            _Pragma("unroll") for (int ks = 0; ks < 2; ++ks) s[kt] = __builtin_amdgcn_mfma_f32_16x16x32_bf16(kf[kt][ks], qf[qt][ks], s[kt], 0, 0, 0); } \
        float mx = -INFINITY; \
        _Pragma("unroll") for (int kt = 0; kt < 2; ++kt) _Pragma("unroll") for (int j = 0; j < 4; ++j) { const float tv = s[kt][j] * (SCALE) + BIAS(qt, kt, j); s[kt][j] = tv; mx = fmaxf(mx, tv); } \
        mx = fmaxf(mx, __shfl_xor(mx, 16)); mx = fmaxf(mx, __shfl_xor(mx, 32)); \
        const float mn = fmaxf(st.m[qt], mx), al = fexp2(st.m[qt] - mn); st.m[qt] = mn; \
        float ps = 0.f; \
        _Pragma("unroll") for (int kt = 0; kt < 2; ++kt) _Pragma("unroll") for (int j = 0; j < 4; ++j) { const float pv = fexp2(s[kt][j] - mn); s[kt][j] = pv; ps += pv; } \
        st.l[qt] = st.l[qt] * al + ps; \
        const unsigned w0 = pk2(s[0][0], s[0][1]), w1 = pk2(s[0][2], s[0][3]), w2 = pk2(s[1][0], s[1][1]), w3 = pk2(s[1][2], s[1][3]); \
        const bf16x8 pf = __builtin_bit_cast(bf16x8, ((u32x4){w0, w1, w2, w3})); \
        _Pragma("unroll") for (int dt = 0; dt < 4; ++dt) st.o[dt][qt] = __builtin_amdgcn_mfma_f32_16x16x32_bf16(vf[dt], pf, st.o[dt][qt] * al, 0, 0, 0); } \
    } while (0)

__device__ __forceinline__ void attn_store(AttnSt& st, bf16_t* dst  , int dld, int fr, int fq) {
#pragma unroll
    for (int qt = 0; qt < QT; ++qt) {
        float l = st.l[qt]; l += __shfl_xor(l, 16); l += __shfl_xor(l, 32);
        const float inv = 1.f / l;
#pragma unroll
        for (int dt = 0; dt < 4; ++dt) { const f32x4 o = st.o[dt][qt] * inv; u32x2 w; w.x = pk2(o[0], o[1]); w.y = pk2(o[2], o[3]);
            *(u32x2*)(dst + (size_t)(qt * 16 + fr) * dld + dt * 16 + 4 * fq) = w; }
    }
}

__device__ __forceinline__ void phase_attn_l0(Frame& F) {
    const int wid = F.wid, lane = F.lane, fr = lane & 15, fq = lane >> 4;
    LAS unsigned char* vl = F.lds + wid * 8192;
    constexpr int N_WIN = 256, N_CTXA = 16, N_CONV = NTOK / 64;
    const float SC = 0.125f * LOG2E;
    for (int it = F.bid; it < N_WIN + N_CTXA + N_CONV; it += F.G) {
        if (it < N_WIN + N_CTXA) {
            const bool isctx = it >= N_WIN;
            int b, kvh, qb;
            if (!isctx) { b = it >> 6; kvh = (it >> 5) & 1; qb = it & 31; } else { const int c = it - N_WIN; b = c >> 2; kvh = (c >> 1) & 1; qb = c & 1; }
            const int g = wid >> 1, h = kvh * 4 + g;
            for (int qh = 0; qh < 4 / QT; ++qh) {
            const int qq0 = (wid & 1) * 64 + qh * (16 * QT);
            const int qrow0 = (isctx ? NMAIN + b * CTXL : b * SEQ) + qb * 128 + qq0;
            bf16x8 qf[QT][2];
#pragma unroll
            for (int qt = 0; qt < QT; ++qt)
#pragma unroll
                for (int ks = 0; ks < 2; ++ks) qf[qt][ks] = *(const bf16x8*)(F_PROJ + (size_t)(qrow0 + qt * 16 + fr) * EVEN_IN + h * 64 + ks * 32 + 8 * fq);
            AttnSt st;
            const float sink = PP(even_sink)[h] * LOG2E;
#pragma unroll
            for (int qt = 0; qt < QT; ++qt) { st.m[qt] = sink; st.l[qt] = (fq == 0) ? 1.f : 0.f;
#pragma unroll
                for (int dt = 0; dt < 4; ++dt) st.o[dt][qt] = (f32x4){0.f, 0.f, 0.f, 0.f}; }
            const int kcol = 512 + kvh * 64, vcol = 640 + kvh * 64;
            for (int ch = isctx ? 3 : 0; ch < 5; ++ch) {
                int krow0;
                if (ch < 3) { const int kb = qb - 1 + ch; if (kb < 0 || kb >= SEQ / 128) continue; krow0 = b * SEQ + kb * 128; } else krow0 = NMAIN + b * CTXL + (ch - 3) * 128;
                for (int s32 = 0; s32 < 4; ++s32) {
                    const bf16_t* kp = F_PROJ + (size_t)(krow0 + s32 * 32) * EVEN_IN + kcol;
                    const bf16_t* vp = F_PROJ + (size_t)(krow0 + s32 * 32) * EVEN_IN + vcol;
                    if (ch == 0) {
#define BIAS_PREV(qt, kt, j) ((s32 * 32 + kt * 16 + 4 * fq + j) >= (qq0 + qt * 16 + fr) ? 0.f : -INFINITY)
                        ATTN_STEP(kp, EVEN_IN, vp, EVEN_IN, SC, BIAS_PREV);
                    } else if (ch == 2) {
#define BIAS_NEXT(qt, kt, j) ((s32 * 32 + kt * 16 + 4 * fq + j) <= (qq0 + qt * 16 + fr) ? 0.f : -INFINITY)
                        ATTN_STEP(kp, EVEN_IN, vp, EVEN_IN, SC, BIAS_NEXT);
                    } else {
#define BIAS_NONE(qt, kt, j) 0.f
                        ATTN_STEP(kp, EVEN_IN, vp, EVEN_IN, SC, BIAS_NONE);
                    }
                }
            }
            attn_store(st, F_MIX + (size_t)qrow0 * D + h * 64, D, fr, fq);
            }
        } else {
            const int ci = it - N_WIN - N_CTXA, c4 = (F.tid & 127) * 4, r0 = ci * 64 + (F.tid >> 7) * 16;
            const f32x4 w0 = *(const f32x4*)(PP(even_conv_w) + c4), w1 = *(const f32x4*)(PP(even_conv_w) + 512 + c4), w2 = *(const f32x4*)(PP(even_conv_w) + 1024 + c4);
#define LOADZ(dst, row_) do { const u32x2 gc_ = *(const u32x2*)(F_PROJ + (size_t)(row_) * EVEN_IN + 1280 + c4), uu_ = *(const u32x2*)(F_PROJ + (size_t)(row_) * EVEN_IN + 1792 + c4); \
                dst = (f32x4){bflo(gc_.x) * bflo(uu_.x), bfhi(gc_.x) * bfhi(uu_.x), bflo(gc_.y) * bflo(uu_.y), bfhi(gc_.y) * bfhi(uu_.y)}; } while (0)
            const int seqmask = r0 < NMAIN ? (SEQ - 1) : (CTXL - 1);
            f32x4 zp = (f32x4){0.f, 0.f, 0.f, 0.f}, zc, zn;
            if ((r0 & seqmask) != 0) LOADZ(zp, r0 - 1);
            LOADZ(zc, r0);
            for (int i = 0; i < 16; ++i) {
                const int row = r0 + i;
                zn = (f32x4){0.f, 0.f, 0.f, 0.f}; if ((row & seqmask) != seqmask) LOADZ(zn, row + 1);
                const u32x2 gb = *(const u32x2*)(F_PROJ + (size_t)row * EVEN_IN + 768 + c4);
                const f32x4 y = zp * w0 + zc * w1 + zn * w2;
                u32x2 w; w.x = pk2(bflo(gb.x) * y[0], bfhi(gb.x) * y[1]); w.y = pk2(bflo(gb.y) * y[2], bfhi(gb.y) * y[3]);
                *(u32x2*)(F_MIX + (size_t)row * D + 512 + c4) = w;
                zp = zc; zc = zn;
            }
        }
    }
}

constexpr int RW_LD = 1028;
__device__ __forceinline__ void phase_route(Frame& F, const int layer) {
    const int nrows = layer == 0 ? NTOK : NMAIN;
    LAS float* rwT = (LAS float*)F.lds;
    LAS int* cntL = (LAS int*)(F.lds + 32 * RW_LD * 4);
    LAS int* baseL = cntL + 32;
    LAS int* selE = baseL + 32;
    LAS int* selR = selE + 384;
    const float* rw = PP(router_w) + (size_t)layer * D * NEXP;
    { const f32x4* rsrc4 = (const f32x4*)rw + F.tid; LAS float* wp = rwT + ((4 * F.tid) & 31) * RW_LD + (F.tid >> 3);
      for (int it = 0; it < 4; ++it) {
        f32x4 v[4];
#pragma unroll
        for (int u = 0; u < 4; ++u) v[u] = rsrc4[(it * 4 + u) * 512];
#pragma unroll
        for (int u = 0; u < 4; ++u)
#pragma unroll
            for (int j = 0; j < 4; ++j) wp[it * 256 + u * 64 + j * RW_LD] = v[u][j];
        asm volatile("" ::: "memory"); } }
    if (F.tid < 32) cntL[F.tid] = 0;
    __syncthreads();
    const int lane = F.lane, gw = F.bid * 8 + F.wid, NGW = F.G * 8;
    const float* gam = PP(norm_ffn) + layer * D;
    int slot = F.wid;
    f32x4 vn[4];
    if (gw < nrows) {
#pragma unroll
        for (int j = 0; j < 4; ++j) vn[j] = *(const f32x4*)(F_XS + (size_t)gw * D + 4 * lane + 256 * j); }
    for (int row = gw; row < nrows; row += NGW, slot += 8) {
        f32x4 v[4], h[4];
#pragma unroll
        for (int j = 0; j < 4; ++j) v[j] = vn[j];
        if (row + NGW < nrows) {
#pragma unroll
            for (int j = 0; j < 4; ++j) vn[j] = *(const f32x4*)(F_XS + (size_t)(row + NGW) * D + 4 * lane + 256 * j); }
        const float rstd = row_rstd(v); const int r = mod_row(row);
        norm_mod_store(v, rstd, gam, modp(F, layer, r, 4), modp(F, layer, r, 3), F_H + (size_t)row * D, lane, &h);
        float pe[32];
#pragma unroll
        for (int e = 0; e < 32; ++e) { float s = 0.f;
#pragma unroll
            for (int j = 0; j < 4; ++j) { const f32x4 w = *(const LAS f32x4*)(rwT + e * RW_LD + 4 * lane + 256 * j); s += (h[j][0] * w[0] + h[j][1] * w[1]) + (h[j][2] * w[2] + h[j][3] * w[3]); }
            pe[e] = s; if ((e & 3) == 3) __builtin_amdgcn_sched_barrier(0); }
        float q16[16], q8[8], q4[4], q2[2], q1;
        { const bool hi = lane & 32;
#pragma unroll
          for (int i = 0; i < 16; ++i) { const float snd = hi ? pe[i] : pe[16 + i], mine = hi ? pe[16 + i] : pe[i]; q16[i] = mine + __shfl_xor(snd, 32); } }
        { const bool hi = lane & 16;
#pragma unroll
          for (int i = 0; i < 8; ++i) { const float snd = hi ? q16[i] : q16[8 + i], mine = hi ? q16[8 + i] : q16[i]; q8[i] = mine + __shfl_xor(snd, 16); } }
        { const bool hi = lane & 8;
#pragma unroll
          for (int i = 0; i < 4; ++i) { const float snd = hi ? q8[i] : q8[4 + i], mine = hi ? q8[4 + i] : q8[i]; q4[i] = mine + __shfl_xor(snd, 8); } }
        { const bool hi = lane & 4;
#pragma unroll
          for (int i = 0; i < 2; ++i) { const float snd = hi ? q4[i] : q4[2 + i], mine = hi ? q4[2 + i] : q4[i]; q2[i] = mine + __shfl_xor(snd, 4); } }
        { const bool hi = lane & 2; const float snd = hi ? q2[0] : q2[1], mine = hi ? q2[1] : q2[0]; q1 = mine + __shfl_xor(snd, 2); }
        q1 += __shfl_xor(q1, 1);
        const int myE = (lane >> 1) & 31;
        float val = q1 + PP(router_b)[layer * NEXP + myE];
        float tv[4]; int te[4];
        { int rank = 0; const int vb = __builtin_bit_cast(int, val);
#pragma unroll
          for (int e2 = 0; e2 < 32; ++e2) { const float o = __builtin_bit_cast(float, __builtin_amdgcn_readlane(vb, 2 * e2)); rank += (o > val || (o == val && e2 < myE)) ? 1 : 0; }
#pragma unroll
          for (int k = 0; k < 4; ++k) { const unsigned long long mk = __ballot(rank == k); const int src = __builtin_amdgcn_readfirstlane((int)__builtin_ctzll(mk));
              tv[k] = __builtin_bit_cast(float, __builtin_amdgcn_readlane(vb, src)); te[k] = (src >> 1) & 31; } }
        const float e1 = __expf(tv[1] - tv[0]), e2 = __expf(tv[2] - tv[0]), e3 = __expf(tv[3] - tv[0]), inv = 1.f / (1.f + e1 + e2 + e3);
        if (lane == 0) {
            *(f32x4*)(F_TOPW + (size_t)row * 4) = (f32x4){inv, e1 * inv, e2 * inv, e3 * inv};
#pragma unroll
            for (int k = 0; k < 4; ++k) { selE[slot * 4 + k] = te[k]; selR[slot * 4 + k] = atomicAdd((int*)(cntL + te[k]), 1); }
        }
    }
    __syncthreads();
    if (F.tid < 32) { const int c = cntL[F.tid]; baseL[F.tid] = c ? (int)atomicAdd(F_cnt + layer * 32 + F.tid, (unsigned)c) : 0; }
    __syncthreads();
    if (F.tid < 384) { const int s = F.tid >> 2, k = F.tid & 3; const int row = F.bid * 8 + (s & 7) + (s >> 3) * NGW;
        if (row < nrows) { const int e = selE[F.tid], pos = baseL[e] + selR[F.tid]; F_POS[(size_t)row * 4 + k] = e | (pos << 8); F_LIST[(size_t)e * NTOK + pos] = row; } }
    __syncthreads();
}

struct MoeLds { LAS int *mtp, *roff, *mtq, *nz; };
__device__ __forceinline__ MoeLds moe_lds(Frame& F) { MoeLds L; L.mtp = (LAS int*)(F.lds + 2 * STAGE_B); L.roff = L.mtp + 40; L.mtq = L.roff + 40; L.nz = L.mtq + 40; return L; }
__device__ __forceinline__ void moe_prefix(Frame& F, const int layer, const MoeLds& L) {
    if (F.tid < 64) { const int e = F.lane & 31; const int c = (int)__hip_atomic_load(F_cnt + layer * 32 + e, __ATOMIC_RELAXED, __HIP_MEMORY_SCOPE_AGENT);
        const int mt = (c + 255) >> 8; int a = mt, b = c, q = mt > 0 ? mt - 1 : 0, z = mt > 0 ? 1 : 0;
#pragma unroll
        for (int o = 1; o < 32; o <<= 1) { const int ua = __shfl_up(a, o, 32), ub = __shfl_up(b, o, 32), uq = __shfl_up(q, o, 32), uz = __shfl_up(z, o, 32); if (e >= o) { a += ua; b += ub; q += uq; z += uz; } }
        if (F.lane < 32) { L.mtp[e + 1] = a; L.roff[e + 1] = b; L.mtq[e + 1] = q; if (mt > 0) L.nz[z - 1] = e; if (e == 31) L.nz[32] = z; if (e == 0) { L.mtp[0] = 0; L.roff[0] = 0; L.mtq[0] = 0; } } }
    __syncthreads();
}
struct PolMoe : PolBase {
    const float* W; MoeLds L; int layer, nct, round; size_t bc_off;
    __device__ __forceinline__ bool find(int i, int& e, int& ct, int& rbase, int& ro, int& cnt) const { int T; if (!tileL(i, T)) return false;
        if (round == 0) { const int q = T / nct; ct = T - q * nct; e = __builtin_amdgcn_readfirstlane(L.nz[q]); rbase = 0; }
        else { LAS int* pf = round == 1 ? L.mtq : L.mtp; e = 0; while (pf[e + 1] * nct <= T) ++e;
            e = __builtin_amdgcn_readfirstlane(e);
            const int mq = __builtin_amdgcn_readfirstlane(pf[e + 1] - pf[e]), w = T - __builtin_amdgcn_readfirstlane(pf[e]) * nct; ct = w / mq; rbase = ((round == 1 ? 1 : 0) + w - ct * mq) * 256; }
        ro = __builtin_amdgcn_readfirstlane(L.roff[e]); cnt = __builtin_amdgcn_readfirstlane(L.roff[e + 1]) - ro; return true; }
    __device__ __forceinline__ bf16_t* panel(int e, int ct) const { return (bf16_t*)(ws + bc_off) + (size_t)(e * nct + ct) * (1024 * 256); }
};
struct PolMoe1 : PolMoe {
    __device__ __forceinline__ unsigned list_voff(const TD& td) const { return 4u * (unsigned)(td.i0 * NTOK + td.i2 + lane * 4); }
    __device__ __forceinline__ void late(TD& td, const LAS int* ll) const { const int cl = td.i4 - 1 - td.i2;
#pragma unroll
        for (int i2 = 0; i2 < 2; ++i2) { int rl = prow(i2); rl = rl < cl ? rl : cl; td.aoff[i2] = (unsigned)((ll[rl] * D + pcol()) * 2); } }
    __device__ __forceinline__ unsigned bias_voff(const TD& td) const { return 4u * (unsigned)((layer * NEXP + td.i0) * (2 * DFF) + (lane >> 5) * DFF + td.i1 * 128 + (lane & 31) * 4); }
    __device__ __forceinline__ bool get(int i, TD& td) const { int e, ct, rbase, ro, cnt; if (!find(i, e, ct, rbase, ro, cnt)) return false;
        const int* list = (const int*)(ws + WS_LIST) + (size_t)e * NTOK; td.A = (const bf16_t*)(ws + WS_H);
        if (!has_list || i == 0) {
#pragma unroll
            for (int i2 = 0; i2 < 4; ++i2) { int rr = rbase + prow(i2); rr = rr < cnt ? rr : cnt - 1; td.aoff[i2] = (unsigned)((list[rr] * D + pcol()) * 2); } }
        if (round == 0) { td.B = W + ((size_t)(layer * NEXP + e) * D + wid * 8) * (2 * DFF) + ct * 128; td.ldb = 2 * DFF; td.bco = panel(e, ct); } else { td.B = panel(e, ct); td.bco = nullptr; }
        td.i0 = e; td.i1 = ct; td.i2 = rbase; td.i3 = ro; td.i4 = cnt; return true; }
    __device__ __forceinline__ void epi(f32x4 (&acc)[8][4], const TD& td, const LAS float* bl) const { (void)bl; EPI_GEOM; const int e = td.i0, ct = td.i1, rbase = td.i2, ro = td.i3, cnt = td.i4;
        bf16_t* ACT = (bf16_t*)(ws + WS_ACT);
#pragma unroll
        for (int n = 0; n < 2; ++n) { const int gc = ct * 128 + wc * 32 + n * 16 + 4 * fq;
            const int gl = wc * 32 + n * 16 + 4 * fq; const f32x4 bg = bl ? *(const LAS f32x4*)(bl + gl) : *(const f32x4*)(bias + (size_t)(layer * NEXP + e) * (2 * DFF) + gc), bu = bl ? *(const LAS f32x4*)(bl + 128 + gl) : *(const f32x4*)(bias + (size_t)(layer * NEXP + e) * (2 * DFF) + DFF + gc);
#pragma unroll
            for (int m = 0; m < 8; ++m) { const int r = rbase + wr * 128 + m * 16 + fr; float a[4];
#pragma unroll
                for (int j = 0; j < 4; ++j) { const float gg = fminf(acc[m][n][j] + bg[j], 7.f), uu = __builtin_amdgcn_fmed3f(acc[m][n + 2][j] + bu[j], -7.f, 7.f);
                    a[j] = (uu + 1.f) * gg * __builtin_amdgcn_rcpf(1.f + fexp2(-1.702f * LOG2E * gg)); }
                if (r < cnt) { u32x2 w; w.x = pk2(a[0], a[1]); w.y = pk2(a[2], a[3]); *(u32x2*)(ACT + (size_t)(ro + r) * DFF + gc) = w; } } } }
};
struct PolMoe2 : PolMoe {
    __device__ __forceinline__ unsigned bias_voff(const TD& td) const { return 4u * (unsigned)((layer * NEXP + td.i0) * D + td.i1 * 256 + lane * 4); }
    __device__ __forceinline__ bool get(int i, TD& td) const { int e, ct, rbase, ro, cnt; if (!find(i, e, ct, rbase, ro, cnt)) return false;
        td.A = (const bf16_t*)(ws + WS_ACT);
#pragma unroll
        for (int i2 = 0; i2 < 4; ++i2) { int rr = rbase + prow(i2); rr = rr < cnt ? rr : cnt - 1; td.aoff[i2] = (unsigned)(((ro + rr) * DFF + pcol()) * 2); }
        td.B = panel(e, ct); td.bco = nullptr;
        td.i0 = e; td.i1 = ct; td.i2 = rbase; td.i3 = ro; td.i4 = cnt; return true; }
    __device__ __forceinline__ void epi(f32x4 (&acc)[8][4], const TD& td, const LAS float* bl) const { (void)bl; EPI_GEOM; const int e = td.i0, ct = td.i1, rbase = td.i2, ro = td.i3, cnt = td.i4;
        bf16_t* Y = (bf16_t*)(ws + WS_Y);
#pragma unroll
        for (int n = 0; n < 4; ++n) { const int c = ct * 256 + wc * 64 + n * 16 + 4 * fq; const f32x4 bv = bl ? *(const LAS f32x4*)(bl + wc * 64 + n * 16 + 4 * fq) : *(const f32x4*)(bias + (size_t)(layer * NEXP + e) * D + c);
#pragma unroll
            for (int m = 0; m < 8; ++m) { const int r = rbase + wr * 128 + m * 16 + fr;
                if (r < cnt) { u32x2 w; w.x = pk2(acc[m][n][0] + bv[0], acc[m][n][1] + bv[1]); w.y = pk2(acc[m][n][2] + bv[2], acc[m][n][3] + bv[3]); *(u32x2*)(Y + (size_t)(ro + r) * D + c) = w; } } } }
};
__device__ __forceinline__ void phase_moe1(Frame& F, const XcdBarrier& bar, const bool use_bar, const int layer) {
    { const float* Wd = PP(moe_w_dn) + (size_t)layer * NEXP * DFF * D; bf16_t* pd = (bf16_t*)(F.ws + WS_BC2);
      for (int r0 = (F.bid * 8 + F.wid) * 8; r0 < NEXP * 4 * 1024; r0 += F.G * 64) {
          f32x4 v[8];
#pragma unroll
          for (int u = 0; u < 8; ++u) { const int pr = r0 + u, pnl = pr >> 10, k = pr & 1023, e = pnl >> 2, ct = pnl & 3;
              v[u] = *(const f32x4*)(Wd + ((size_t)e * DFF + k) * D + ct * 256 + 4 * F.lane); }
#pragma unroll
          for (int u = 0; u < 8; ++u) { const int pr = r0 + u; u32x2 w; w.x = pk2(v[u][0], v[u][1]); w.y = pk2(v[u][2], v[u][3]);
              *(u32x2*)(pd + (size_t)pr * 256 + 4 * F.lane) = w; } } }
    const MoeLds L = moe_lds(F);
    moe_prefix(F, layer, L);
    const int ne = __builtin_amdgcn_readfirstlane(L.nz[32]), tq = __builtin_amdgcn_readfirstlane(L.mtq[32]);
    const float* W = PP(moe_w_gu); const float* bias = PP(moe_b_gu);
    { PolMoe1 P; P.L = L; P.layer = layer; P.nct = 8; P.round = 0; P.bc_off = WS_BC; P.base_init(F, D / 64, ne * 8); P.bfm = false; P.W = W; P.bias = bias;
      { const int l2 = F.lane & 31; P.lcolb = 4u * (unsigned)((F.lane >> 5) * DFF + 4 * l2); P.woff = 2u * (unsigned)(((4 * l2) >> 5) * 64 + (F.lane >> 5) * 32 + ((4 * l2) & 31)); }
      gemm_stream(F.lds, P, F.wid, F.lane); }
    if (use_bar) xcd_barrier(bar);
    { PolMoe1 P; P.L = L; P.layer = layer; P.nct = 8; P.round = 1; P.bc_off = WS_BC; P.base_init(F, D / 64, tq * 8); P.ldbB = 256; P.W = W; P.bias = bias; P.has_bias = true; P.has_list = true; P.listp = (const int*)(F.ws + WS_LIST);
      gemm_stream_bf(F.lds, P, F.wid, F.lane); }
}
__device__ __forceinline__ void phase_moe2(Frame& F, const int layer) {
    const MoeLds L = moe_lds(F);
    moe_prefix(F, layer, L);
    PolMoe2 P; P.L = L; P.layer = layer; P.nct = 4; P.round = 2; P.bc_off = WS_BC2; P.base_init(F, DFF / 64, __builtin_amdgcn_readfirstlane(L.mtp[32]) * 4); P.ldbB = 256; P.W = nullptr; P.bias = PP(moe_b_dn); P.has_bias = true;
    gemm_stream_bf(F.lds, P, F.wid, F.lane);
}

__device__ __forceinline__ void phase_combine(Frame& F, const int layer) {
    const MoeLds ML = moe_lds(F); LAS int* roff = ML.roff;
    moe_prefix(F, layer, ML);
    const int nrows = layer == 0 ? NTOK : NMAIN, lane = F.lane;
    const int gw = F.bid * 8 + F.wid, NGW = F.G * 8;
    i32x4 ps_n = (i32x4){0, 0, 0, 0}; f32x4 tw_n = (f32x4){0.f, 0.f, 0.f, 0.f}, tw_c = tw_n;
    u32x2 y_c[4][4], y_n[4][4]; f32x4 xs_c[4], xs_n[4];
#define CMB_IDX(row_) do { if ((row_) < nrows) { ps_n = *(const i32x4*)(F_POS + (size_t)(row_) * 4); tw_n = *(const f32x4*)(F_TOPW + (size_t)(row_) * 4); } } while (0)
#define CMB_DATA(row_, Y_, XS_) do { if ((row_) < nrows) { \
        _Pragma("unroll") for (int k = 0; k < 4; ++k) { const int e = ps_n[k] & 255, pos = ps_n[k] >> 8; const bf16_t* y = F_Y + (size_t)(roff[e] + pos) * D; \
            _Pragma("unroll") for (int j = 0; j < 4; ++j) Y_[k][j] = *(const u32x2*)(y + 4 * lane + 256 * j); } \
        _Pragma("unroll") for (int j = 0; j < 4; ++j) XS_[j] = *(const f32x4*)(F_XS + (size_t)(row_) * D + 4 * lane + 256 * j); } } while (0)
    CMB_IDX(gw); CMB_DATA(gw, y_c, xs_c); tw_c = tw_n; CMB_IDX(gw + NGW);
    for (int row = gw; row < nrows; row += NGW) {
        CMB_DATA(row + NGW, y_n, xs_n); const f32x4 tw_nn = tw_n; CMB_IDX(row + 2 * NGW);
        const int r = mod_row(row); const float* g2 = modp(F, layer, r, 5);
        f32x4 v[4];
#pragma unroll
        for (int j = 0; j < 4; ++j) v[j] = (f32x4){0.f, 0.f, 0.f, 0.f};
#pragma unroll
        for (int k = 0; k < 4; ++k) { const float w = tw_c[k];
#pragma unroll
            for (int j = 0; j < 4; ++j) { const u32x2 u = y_c[k][j]; v[j][0] += w * bflo(u.x); v[j][1] += w * bfhi(u.x); v[j][2] += w * bflo(u.y); v[j][3] += w * bfhi(u.y); } }
#pragma unroll
        for (int j = 0; j < 4; ++j) { const int c = 4 * lane + 256 * j; const f32x4 gv = *(const f32x4*)(g2 + c); v[j] = xs_c[j] + gv * v[j]; }
        const float rstd = row_rstd(v);
        if (layer == 0) {
#pragma unroll
            for (int j = 0; j < 4; ++j) *(f32x4*)(F_XS + (size_t)row * D + 4 * lane + 256 * j) = v[j];
            norm_mod_store(v, rstd, PP(norm_mix) + D, modp(F, 1, r, 1), modp(F, 1, r, 0), F_H + (size_t)row * D, lane);
        } else {
#pragma unroll
            for (int j = 0; j < 4; ++j) { const int c = 4 * lane + 256 * j; const f32x4 g = *(const f32x4*)(PP(final_norm) + c); *(f32x4*)(((float*)ldp(F, (int)__builtin_offsetof(Params, out))) + (size_t)row * D + c) = v[j] * rstd * g; }
        }
        tw_c = tw_nn;
#pragma unroll
        for (int k = 0; k < 4; ++k)
#pragma unroll
            for (int j = 0; j < 4; ++j) y_c[k][j] = y_n[k][j];
#pragma unroll
        for (int j = 0; j < 4; ++j) xs_c[j] = xs_n[j];
        __builtin_amdgcn_sched_barrier(0);
    }
#undef CMB_IDX
#undef CMB_DATA
}

struct PolInproj1 : PolBase {
    const float* W;
    __device__ __forceinline__ bool get(int i, TD& td) const { int t; if (!tileL(i, t)) return false; constexpr int N_MAIN_T = (NMAIN / 256) * 10; int pm, pn;
        if (t < N_MAIN_T) dense_tile(t, NMAIN / 256, 10, pm, pn); else { const int c = t - N_MAIN_T; pm = NMAIN / 256 + (c & 3); pn = 2 + (c >> 2); }
        td.A = (const bf16_t*)(ws + WS_H); dense_aoff(td, pm * 256, D);
        td.B = (const bf16_t*)(ws + WB_OIN) + pn * 256; td.i0 = pm; td.i1 = pn; return true; }
    __device__ __forceinline__ void epi(f32x4 (&acc)[8][4], const TD& td, const LAS float* bl) const { (void)bl; EPI_GEOM; const int pm = td.i0, pn = td.i1;
        if (pn < 6) { bf16_t* PROJ = (bf16_t*)(ws + WS_PROJ);
#pragma unroll
            for (int m = 0; m < 8; ++m) { const int row = pm * 256 + wr * 128 + m * 16 + fr;
#pragma unroll
                for (int n = 0; n < 4; ++n) { u32x2 w; w.x = pk2(acc[m][n][0], acc[m][n][1]); w.y = pk2(acc[m][n][2], acc[m][n][3]);
                    *(u32x2*)(PROJ + (size_t)row * QKV_LD + pn * 256 + wc * 64 + n * 16 + 4 * fq) = w; } }
        } else { const int g = pn - 6, ri = wc >> 1; bf16_t* Z = (bf16_t*)(ws + WS_Z);
#pragma unroll
            for (int m = 0; m < 8; ++m) { const int row = pm * 256 + wr * 128 + m * 16 + fr, b = row >> 12, n1 = (row >> 6) & 63, n2 = row & 63;
                bf16_t* zb = Z + ((((size_t)(b * 64 + n1) * 2 + ri) * 64 + n2) * 512) + g * 128 + (wc & 1) * 64;
#pragma unroll
                for (int n = 0; n < 4; ++n) { u32x2 w; w.x = pk2(acc[m][n][0], acc[m][n][1]); w.y = pk2(acc[m][n][2], acc[m][n][3]); *(u32x2*)(zb + n * 16 + 4 * fq) = w; } } } }
};
__device__ __forceinline__ void phase_inproj_l1(Frame& F) {
    PolInproj1 P; P.base_init(F, D / 64, (NMAIN / 256) * 10 + (NCTX / 256) * 4); P.ldbB = 2560;
    gemm_stream_bf(F.lds, P, F.wid, F.lane);
}

struct PolFour : PolBase {
    int stage;
    __device__ __forceinline__ bool get(int i, TD& td) const { int L; if (!tileL(i, L)) return false; const int b = L >> 7, ct = L & 127;
        td.A = (const bf16_t*)(ws + (stage == 1 ? WS_M1 : WS_M2)); dense_aoff(td, 0, 128);
        td.B = (const bf16_t*)(ws + (stage == 1 ? WS_Z : WS_A1)) + (size_t)b * 128 * 32768 + ct * 256; td.i0 = b; td.i1 = ct; return true; }
    __device__ __forceinline__ void epi(f32x4 (&acc)[8][4], const TD& td, const LAS float* bl) const { (void)bl; EPI_GEOM; const int b = td.i0, ct = td.i1;
        if (wr != 0) return;
        if (stage == 1) { const f32x2* TW = (const f32x2*)(ws + WS_TW); bf16_t* A1 = (bf16_t*)(ws + WS_A1);
#pragma unroll
            for (int m = 0; m < 4; ++m) { const int k1 = m * 16 + fr;
#pragma unroll
                for (int n = 0; n < 4; ++n) { const int col = ct * 256 + wc * 64 + n * 16 + 4 * fq, n2 = col >> 9, c = col & 511;
                    const f32x2 tw = TW[n2 * k1]; const f32x4 re = acc[m][n], im = acc[m + 4][n];
                    const f32x4 ore = re * tw.x + im * tw.y, oim = im * tw.x - re * tw.y; u32x2 w0, w1;
                    w0.x = pk2(ore[0], ore[1]); w0.y = pk2(ore[2], ore[3]); w1.x = pk2(oim[0], oim[1]); w1.y = pk2(oim[2], oim[3]);
                    *(u32x2*)(A1 + ((((size_t)(b * 2 + 0) * 64 + n2) * 64 + k1) * 512) + c) = w0;
                    *(u32x2*)(A1 + ((((size_t)(b * 2 + 1) * 64 + n2) * 64 + k1) * 512) + c) = w1; } }
        } else { const float scl = 1.f / 724.0773439350247f; bf16_t* MIX = (bf16_t*)(ws + WS_MIX);
#pragma unroll
            for (int m = 0; m < 4; ++m) { const int k2 = m * 16 + fr;
#pragma unroll
                for (int n = 0; n < 4; ++n) { const int col = ct * 256 + wc * 64 + n * 16 + 4 * fq, k1 = col >> 9, c = col & 511;
                    const f32x4 o = acc[m][n] * scl; u32x2 w; w.x = pk2(o[0], o[1]); w.y = pk2(o[2], o[3]);
                    *(u32x2*)(MIX + (size_t)(b * SEQ + k1 + 64 * k2) * D + 512 + c) = w; } } } }
};

__device__ __forceinline__ void phase_attn_l1(Frame& F) {
    const int wid = F.wid, lane = F.lane, fr = lane & 15, fq = lane >> 4;
    constexpr int N_NA = NB * 64, N_F1 = NB * 128;
    const float SC = 0.125f * LOG2E;
    for (int it = F.bid; it < N_NA; it += F.G) {
            LAS unsigned char* vl = F.lds + wid * 8192;
            LAS float* rp = (LAS float*)(vl + 5120);
            const int b = it >> 6, r = it & 63, h = wid;
            for (int i = lane; i < 465; i += 64) rp[i] = PP(odd_rpb)[h * 465 + i] * LOG2E;
            for (int qh = 0; qh < 4 / QT; ++qh) {
            const int qc0 = qh * (16 * QT), qrow0 = b * SEQ + r * 64 + qc0;
            bf16x8 qf[QT][2];
#pragma unroll
            for (int qt = 0; qt < QT; ++qt)
#pragma unroll
                for (int ks = 0; ks < 2; ++ks) qf[qt][ks] = *(const bf16x8*)(F_PROJ + (size_t)(qrow0 + qt * 16 + fr) * QKV_LD + h * 64 + ks * 32 + 8 * fq);
            AttnSt st;
#pragma unroll
            for (int qt = 0; qt < QT; ++qt) { st.m[qt] = -1e30f; st.l[qt] = 0.f;
#pragma unroll
                for (int dt = 0; dt < 4; ++dt) st.o[dt][qt] = (f32x4){0.f, 0.f, 0.f, 0.f}; }
            const int r0 = min(max(r - 4, 0), 56);
            int c0q[QT];
#pragma unroll
            for (int qt = 0; qt < QT; ++qt) c0q[qt] = min(max(qc0 + qt * 16 + fr - 8, 0), 48);
            for (int s = 0; s < 16; ++s) {
                const int kr = r0 + (s >> 1), half = s & 1;
                const bf16_t* kp = F_PROJ + (size_t)(b * SEQ + kr * 64 + half * 32) * QKV_LD + 512 + h * 64;
                const bf16_t* vp = kp + 512;
                const LAS float* rpr = rp + (kr - r + 7) * 31 + 15;
#define BIAS_NA(qt, kt, j) ({ const int kc = half * 32 + kt * 16 + 4 * fq + j; const int dc = kc - (qc0 + qt * 16 + fr); (kc >= c0q[qt] && kc < c0q[qt] + 16) ? rpr[dc] : -INFINITY; })
                ATTN_STEP(kp, QKV_LD, vp, QKV_LD, SC, BIAS_NA);
            }
            for (int s = 0; s < 8; ++s) {
                const bf16_t* kp = F_PROJ + (size_t)(NMAIN + b * CTXL + s * 32) * QKV_LD + 512 + h * 64;
                const bf16_t* vp = kp + 512;
                ATTN_STEP(kp, QKV_LD, vp, QKV_LD, SC, BIAS_NONE);
            }
            attn_store(st, F_MIX + (size_t)qrow0 * D + h * 64, D, fr, fq);
            }
    }
    __syncthreads();
    PolFour P; P.stage = 1; P.base_init(F, 2, N_F1); P.ldbB = 32768;
    gemm_stream_bf(F.lds, P, F.wid, F.lane);
}

__device__ __forceinline__ void phase_fst2(Frame& F) {
    PolFour P; P.stage = 2; P.base_init(F, 2, NB * 128); P.ldbB = 32768;
    gemm_stream_bf(F.lds, P, F.wid, F.lane);
}

__global__ void __launch_bounds__(512, 2) fwd_kernel(Params p) {
    extern __shared__ __attribute__((aligned(16))) unsigned char lds_raw[];
    Frame F;
    F.lds = (LAS unsigned char*)lds_raw;
    F.tid = threadIdx.x; F.lane = F.tid & 63; F.wid = __builtin_amdgcn_readfirstlane(F.tid >> 6); F.bid = blockIdx.x; F.G = gridDim.x;
    unsigned char* ws = p.ws; F.ws = ws;
    volatile LAS unsigned* MISC = (volatile LAS unsigned*)(F.lds + MISC_OFF);
    if (F.tid < 64) MISC[F.tid] = 0u;
    if (F.tid == 64) { LAS unsigned long long* LP = (LAS unsigned long long*)(F.lds + PARAM_OFF);
        LP[0] = (unsigned long long)p.x; LP[1] = (unsigned long long)p.c; LP[2] = (unsigned long long)p.ctx; LP[3] = (unsigned long long)p.c_ctx; LP[4] = (unsigned long long)p.ada_w; LP[5] = (unsigned long long)p.ada_b;
        LP[6] = (unsigned long long)p.norm_mix; LP[7] = (unsigned long long)p.norm_ffn; LP[8] = (unsigned long long)p.even_w_in; LP[9] = (unsigned long long)p.even_w_out; LP[10] = (unsigned long long)p.even_conv_w;
        LP[11] = (unsigned long long)p.even_sink; LP[12] = (unsigned long long)p.odd_w_in; LP[13] = (unsigned long long)p.odd_w_out; LP[14] = (unsigned long long)p.odd_rpb; LP[15] = (unsigned long long)p.router_w;
        LP[16] = (unsigned long long)p.router_b; LP[17] = (unsigned long long)p.moe_w_gu; LP[18] = (unsigned long long)p.moe_b_gu; LP[19] = (unsigned long long)p.moe_w_dn; LP[20] = (unsigned long long)p.moe_b_dn;
        LP[21] = (unsigned long long)p.final_norm; LP[22] = (unsigned long long)p.out; }
    __syncthreads();
    const int lo = p.ph_lo, hi = p.ph_hi;
    XcdBarrier bar; bar.bar = (unsigned*)(ws + WS_CTL) + CW_BAR; bar.x = 0; bar.st = MISC + 8;
    if (hi - lo > 1) bar = xcd_barrier_post((unsigned*)(ws + WS_CTL) + CW_BAR, MISC + 8);
#define RUN_PHASE(ph, call) do { if (PH_ON(ph) && lo <= (ph) && (ph) < hi) { call; if (PH_REP(ph)) { xcd_barrier(bar); call; } } if (lo <= (ph) && (ph) + 1 < hi) xcd_barrier(bar); } while (0)
    RUN_PHASE(PH_PREP, phase_prep(F));
    RUN_PHASE(PH_NORM1_0, phase_norm1_l0(F));
    RUN_PHASE(PH_INPROJ_0, phase_inproj_l0(F));
    RUN_PHASE(PH_ATTN_0, phase_attn_l0(F));
    RUN_PHASE(PH_OUTPROJ_0, phase_outproj(F, 0));
    RUN_PHASE(PH_ROUTE_0, phase_route(F, 0));
    RUN_PHASE(PH_MOE1_0, phase_moe1(F, bar, hi - lo > 1, 0));
    RUN_PHASE(PH_MOE2_0, phase_moe2(F, 0));
    RUN_PHASE(PH_COMB_0, phase_combine(F, 0));
    RUN_PHASE(PH_INPROJ_1, phase_inproj_l1(F));
    RUN_PHASE(PH_ATTN_1, phase_attn_l1(F));
    RUN_PHASE(PH_FST2_1, phase_fst2(F));
    RUN_PHASE(PH_OUTPROJ_1, phase_outproj(F, 1));
    RUN_PHASE(PH_ROUTE_1, phase_route(F, 1));
    RUN_PHASE(PH_MOE1_1, phase_moe1(F, bar, hi - lo > 1, 1));
    RUN_PHASE(PH_MOE2_1, phase_moe2(F, 1));
    RUN_PHASE(PH_FINAL, phase_combine(F, 1));
}

extern "C" void kernel_launch(void* const* d_in, const int* in_sizes, int n_in, void* d_out, int out_size, void* d_ws, size_t ws_size, hipStream_t stream) {
    static int grid = 0;
    if (grid == 0) {
        if (n_in != 22 || ws_size < WS_END) { fprintf(stderr, "kernel_launch: unexpected inputs (n_in %d, ws %zu)\n", n_in, ws_size); grid = -1; return; }
        int dev = 0, cus = 0, per_cu = 0;
        hipGetDevice(&dev);
        hipDeviceGetAttribute(&cus, hipDeviceAttributeMultiprocessorCount, dev);
        hipFuncSetAttribute((const void*)fwd_kernel, hipFuncAttributeMaxDynamicSharedMemorySize, LDS_BYTES);
        hipOccupancyMaxActiveBlocksPerMultiprocessor(&per_cu, (const void*)fwd_kernel, 512, LDS_BYTES);
        if (per_cu < 1) { fprintf(stderr, "kernel_launch: occupancy query says %d blocks/CU\n", per_cu); per_cu = 1; }
        (void)hipGetLastError();
        grid = cus;
    }
    if (grid < 0) return;
    hipMemsetAsync((char*)d_ws + WS_CTL, 0, CTL_BYTES, stream);
    Params p{};
    const float** pp = (const float**)&p;
    for (int i = 0; i < 22; ++i) pp[i] = (const float*)d_in[i];
    p.out = (float*)d_out; p.ws = (unsigned char*)d_ws;
#if N_LAUNCH_MODE == 1
    for (int ph = 0; ph < NPHASE; ++ph) { p.ph_lo = ph; p.ph_hi = ph + 1; hipLaunchKernelGGL(fwd_kernel, dim3(grid), dim3(512), LDS_BYTES, stream, p); }
#else
    p.ph_lo = 0; p.ph_hi = NPHASE;
    void* args[] = {&p};
    hipError_t e = hipLaunchCooperativeKernel((const void*)fwd_kernel, dim3(grid), dim3(512), args, LDS_BYTES, stream);
    if (e != hipSuccess) fprintf(stderr, "kernel_launch: cooperative launch failed: %s (grid %d)\n", hipGetErrorString(e), grid);
#endif
}
```

```cpp
#include <hip/hip_runtime.h>
#include <cstdio>
#include <cstdint>

#ifndef N_LAUNCH_MODE
#define N_LAUNCH_MODE 0
#endif

#ifndef PHASE_MASK
#define PHASE_MASK 0x1FFFF
#endif
#define PH_ON(ph) ((PHASE_MASK >> (ph)) & 1)
#ifndef REPEAT_MASK
#define REPEAT_MASK 0
#endif
#define PH_REP(ph) ((REPEAT_MASK >> (ph)) & 1)
#define LAS __attribute__((address_space(3)))
#define GAS __attribute__((address_space(1)))
typedef unsigned short bf16_t;
typedef short bf16x8 __attribute__((ext_vector_type(8)));
typedef short s16x4 __attribute__((ext_vector_type(4)));
typedef float f32x4 __attribute__((ext_vector_type(4)));
typedef float f32x2 __attribute__((ext_vector_type(2)));
typedef int i32x4 __attribute__((ext_vector_type(4)));
typedef unsigned u32x2 __attribute__((ext_vector_type(2)));
typedef unsigned u32x4 __attribute__((ext_vector_type(4)));

constexpr int D = 1024, NB = 4, SEQ = 4096, CTXL = 256;
constexpr int NMAIN = NB * SEQ, NCTX = NB * CTXL, NTOK = NMAIN + NCTX;
constexpr int EVEN_IN = 2304, NEXP = 32, DFF = 1024;
constexpr int QKV_LD = 1536;
constexpr float NORM_EPS = 1e-6f;
constexpr float LOG2E = 1.4426950408889634f;

constexpr size_t MiB = 1ull << 20;
constexpr size_t WS_CTL = 0, CTL_BYTES = 1 * MiB;
constexpr size_t WS_MOD = 1 * MiB;
constexpr size_t WS_M1 = 2 * MiB;
constexpr size_t WS_M2 = WS_M1 + 65536;
constexpr size_t WS_ROPE = WS_M2 + 65536;
constexpr size_t WS_TW = WS_ROPE + 8192;
constexpr size_t WS_WF = 4 * MiB;
constexpr size_t WS_TOPW = 8 * MiB;
constexpr size_t WS_POS = 9 * MiB;
constexpr size_t WS_LIST = 12 * MiB;
constexpr size_t WS_H = 16 * MiB;
constexpr size_t WS_MIX = 52 * MiB;
constexpr size_t WS_XS = 88 * MiB;
constexpr size_t WS_PROJ = 160 * MiB;
constexpr size_t WS_Z = 240 * MiB;
constexpr size_t WS_A1 = 304 * MiB;
constexpr size_t WS_ACT = 368 * MiB;
constexpr size_t WS_Y = 512 * MiB;
constexpr size_t WS_WB = 656 * MiB;
constexpr size_t WB_EIN = WS_WB, WB_EOUT = WB_EIN + (size_t)D * EVEN_IN * 2, WB_OIN = WB_EOUT + (size_t)D * D * 2, WB_OOUT = WB_OIN + (size_t)D * 2560 * 2;
constexpr size_t WS_BC = 672 * MiB;
constexpr size_t WS_BC2 = WS_BC + 128 * MiB;
constexpr size_t WS_END = 864 * MiB;
constexpr int CW_BAR = 4096;
constexpr int CW_CNT = 8192;

constexpr int LDS_BYTES = 147456;
constexpr int PARAM_OFF = LDS_BYTES - 512;
constexpr int MISC_OFF = LDS_BYTES - 256;
constexpr int A_TILE_B = 32768, B_ROWB = 544, B_TILE_B = 64 * B_ROWB, STAGE_B = A_TILE_B + B_TILE_B;
static_assert(2 * STAGE_B + 1024 + 8192 <= PARAM_OFF, "LDS");

enum { PH_PREP = 0, PH_NORM1_0, PH_INPROJ_0, PH_ATTN_0, PH_OUTPROJ_0, PH_ROUTE_0, PH_MOE1_0, PH_MOE2_0, PH_COMB_0,
       PH_INPROJ_1, PH_ATTN_1, PH_FST2_1, PH_OUTPROJ_1, PH_ROUTE_1, PH_MOE1_1, PH_MOE2_1, PH_FINAL, NPHASE };

struct Params {
    const float *x, *c, *ctx, *c_ctx, *ada_w, *ada_b, *norm_mix, *norm_ffn, *even_w_in, *even_w_out, *even_conv_w, *even_sink,
                *odd_w_in, *odd_w_out, *odd_rpb, *router_w, *router_b, *moe_w_gu, *moe_b_gu, *moe_w_dn, *moe_b_dn, *final_norm;
    float* out; unsigned char* ws; int ph_lo, ph_hi;
};

__device__ __forceinline__ unsigned pk2(float lo, float hi) { unsigned r; asm("v_cvt_pk_bf16_f32 %0, %1, %2" : "=v"(r) : "v"(lo), "v"(hi)); return r; }
__device__ __forceinline__ float bflo(unsigned u) { return __builtin_bit_cast(float, u << 16); }
__device__ __forceinline__ float bfhi(unsigned u) { return __builtin_bit_cast(float, u & 0xffff0000u); }
__device__ __forceinline__ float wave_sum(float v) {
#pragma unroll
    for (int o = 1; o < 64; o <<= 1) v += __shfl_xor(v, o);
    return v;
}
__device__ __forceinline__ float fexp2(float x) { return __builtin_amdgcn_exp2f(x); }

#define XB_TMO      128
#define XB_XCNT(j)  (256  + 64 * (j))
#define XB_XSUB(j)  (1280 + 64 * (j))
#define XB_XGEN(j)  (2304 + 64 * (j))
#define XB_TOP      3328
#define XB_TOPGEN   3392
#define XB_SPIN_CAP (1u << 22)
__device__ __forceinline__ unsigned xb_ld(unsigned* p)              { return __hip_atomic_load(p, __ATOMIC_RELAXED, __HIP_MEMORY_SCOPE_AGENT); }
__device__ __forceinline__ unsigned xb_add(unsigned* p, unsigned v) { return __hip_atomic_fetch_add(p, v, __ATOMIC_RELAXED, __HIP_MEMORY_SCOPE_AGENT); }
__device__ __forceinline__ unsigned xb_xcc_id() { return (unsigned)__builtin_amdgcn_s_getreg((3 << 11) | 20) & 0xFu; }
#define XB_SPIN(cond, bar) do { unsigned _sp = 0; while (cond) { __builtin_amdgcn_s_sleep(1); \
    if ((++_sp & 255u) == 0u) { if (xb_ld(&(bar)[XB_TMO])) break; if (_sp > XB_SPIN_CAP) { atomicAdd(&(bar)[XB_TMO], 1u); break; } } } } while (0)
struct XcdBarrier { unsigned* bar; unsigned x; volatile LAS unsigned* st; };
__device__ __forceinline__ XcdBarrier xcd_barrier_post(unsigned* bar, volatile LAS unsigned* st) {
    XcdBarrier b; b.bar = bar; b.x = xb_xcc_id(); b.st = st;
    if (threadIdx.x == 0) (void)xb_add(&bar[XB_XCNT(b.x)], 1u);
    return b;
}
__device__ __forceinline__ void xcd_barrier_complete(unsigned* bar, unsigned x, unsigned& nloc, unsigned& nx) {
    const unsigned G = gridDim.x * gridDim.y * gridDim.z;
    unsigned sum, cnt, mine, sp = 0u;
    for (;;) {
        sum = 0u; cnt = 0u; mine = 0u;
#pragma unroll
        for (unsigned j = 0; j < 16; ++j) { const unsigned c = xb_ld(&bar[XB_XCNT(j)]); sum += c; cnt += (c > 0u) ? 1u : 0u; mine = (j == x) ? c : mine; }
        if (sum == G) break;
        __builtin_amdgcn_s_sleep(1);
        if ((++sp & 255u) == 0u) { if (xb_ld(&bar[XB_TMO])) break; if (sp > XB_SPIN_CAP) { atomicAdd(&bar[XB_TMO], 1u); break; } }
    }
    nloc = mine > 0u ? mine : 1u; nx = cnt > 0u ? cnt : 1u;
}
__device__ __forceinline__ void xcd_barrier(const XcdBarrier& b) {
    asm volatile("s_waitcnt vmcnt(0)" ::: "memory");
    __syncthreads();
    if (threadIdx.x == 0) {
        unsigned* bar = b.bar;
        __builtin_amdgcn_s_waitcnt(0);
        unsigned nloc = b.st[0], nx = b.st[1];
        if (nloc == 0u) { xcd_barrier_complete(bar, b.x, nloc, nx); b.st[0] = nloc; b.st[1] = nx; }
        const unsigned old = xb_add(&bar[XB_XSUB(b.x)], 1u);
        const unsigned gen = old / nloc;
        if (old + 1u == (gen + 1u) * nloc) {
            __builtin_amdgcn_fence(__ATOMIC_RELEASE, "agent");
            asm volatile("s_waitcnt vmcnt(0)" ::: "memory");
            const unsigned og = xb_add(&bar[XB_TOP], 1u);
            const unsigned tg = og / nx;
            if (og + 1u == (tg + 1u) * nx) xb_add(&bar[XB_TOPGEN], 1u);
            else XB_SPIN(xb_ld(&bar[XB_TOPGEN]) == tg, bar);
            __builtin_amdgcn_fence(__ATOMIC_ACQUIRE, "agent");
            xb_add(&bar[XB_XGEN(b.x)], 1u);
            asm volatile("s_waitcnt vmcnt(0)" ::: "memory");
        } else {
            XB_SPIN(xb_ld(&bar[XB_XGEN(b.x)]) == gen, bar);
            __builtin_amdgcn_fence(__ATOMIC_ACQUIRE, "agent");
            asm volatile("s_waitcnt vmcnt(0)" ::: "memory");
        }
    }
    __syncthreads();
}

struct TD { const bf16_t* A; const void* B; bf16_t* bco; unsigned ldb; unsigned aoff[4]; int i0, i1, i2, i3, i4; };
__device__ __forceinline__ int a_piece_row0(int wid, int lane) { const int sb = lane * 16, swz = sb ^ (((sb >> 9) & 1) << 5); return (wid >> 1) * 16 + (swz >> 6); }
__device__ __forceinline__ int a_piece_col(int wid, int lane) { const int sb = lane * 16, swz = sb ^ (((sb >> 9) & 1) << 5); return (wid & 1) * 32 + ((swz & 63) >> 1); }
__device__ __forceinline__ u32x4 make_rsrc(const void* p) { const unsigned long long ab = (unsigned long long)p; u32x4 r; r.x = __builtin_amdgcn_readfirstlane((unsigned)ab); r.y = __builtin_amdgcn_readfirstlane((unsigned)(ab >> 32)) & 0xffffu; r.z = 0x7fffffffu; r.w = 0x00020000u; return r; }

template <class Pol>
__device__ __forceinline__ void gemm_stream(LAS unsigned char* lds, Pol& P, const int wid, const int lane) {
    const int wr = wid >> 2, wc = wid & 3, fr = lane & 15, fq = lane >> 4;
    const unsigned b_w = (unsigned)(A_TILE_B + ((wid >> 2) * 32 + 4 * (wid & 3)) * B_ROWB) + P.woff;
    const unsigned a_r = (unsigned)(wr * 16384 + ((fr * 64 + fq * 16) ^ ((fr >> 3) << 5)));
    const unsigned b_r = (unsigned)(A_TILE_B + (4 * fq + (fr >> 2)) * B_ROWB + (wc * 64 + (fr & 3) * 4) * 2);
    const unsigned ldsa = (unsigned)(__UINTPTR_TYPE__)lds + (unsigned)(wid * 1024);
    const unsigned lcolb = P.lcolb;
    TD cur, nxt;
    if (!P.get(0, cur)) return;
    int nt = P.nt; asm volatile("" : "+s"(nt));
    f32x4 sb[8]; f32x4 acc[8][4];
    u32x4 ra_c = make_rsrc(cur.A), ra_n = ra_c;
    __amdgpu_buffer_rsrc_t rb_c = __builtin_amdgcn_make_buffer_rsrc((void*)cur.B, 0, 0x7fffffff, 0x00020000), rb_n = rb_c;
#define G_GLDS_A(buf, RA, AOFF, kt) do { _Pragma("unroll") for (int i = 0; i < 4; ++i) { unsigned keep_; \
        asm volatile("s_mov_b32 %0, m0\n\ts_mov_b32 m0, %3\n\ts_nop 0\n\tbuffer_load_dwordx4 %1, %2, %4 offen lds\n\ts_mov_b32 m0, %0" \
            : "=&s"(keep_) : "v"(AOFF[i]), "s"(RA), "s"(ldsa + (buf) + (unsigned)(i * 8192)), "s"((unsigned)((kt) * 128)) : "memory"); } } while (0)
#define G_ISSUE_BH(RB, LDB4, kt, h) do { \
        _Pragma("unroll") for (int i = 4 * (h); i < 4 * (h) + 4; ++i) sb[i] = __builtin_bit_cast(f32x4, __builtin_amdgcn_raw_buffer_load_b128(RB, (int)lcolb, (int)(((unsigned)(kt) * 64u + i) * (LDB4)), 0)); \
        __builtin_amdgcn_sched_barrier(0); } while (0)
#define G_WRITE_BH(buf, h, BCO, kt) do { \
        _Pragma("unroll") for (int i = 4 * (h); i < 4 * (h) + 4; ++i) { u32x2 w; w.x = pk2(sb[i][0], sb[i][1]); w.y = pk2(sb[i][2], sb[i][3]); \
            *(LAS u32x2*)(lds + (buf) + b_w + (16 * (i >> 2) + (i & 3)) * B_ROWB) = w; \
            if (BCO) *(u32x2*)((char*)(BCO) + (size_t)((kt) * 64 + wid * 8 + i) * 512 + P.woff) = w; } __builtin_amdgcn_sched_barrier(0); } while (0)
#define G_KSTEP(buf, ks) do { bf16x8 Bf[4]; \
        _Pragma("unroll") for (int n = 0; n < 4; ++n) { \
            const s16x4 lo = __builtin_amdgcn_ds_read_tr16_b64_v4i16((LAS s16x4*)(lds + (buf) + b_r + (ks) * 32 * B_ROWB + n * 32)); \
            const s16x4 hi = __builtin_amdgcn_ds_read_tr16_b64_v4i16((LAS s16x4*)(lds + (buf) + b_r + (ks) * 32 * B_ROWB + 16 * B_ROWB + n * 32)); \
            Bf[n] = (bf16x8){lo[0], lo[1], lo[2], lo[3], hi[0], hi[1], hi[2], hi[3]}; } \
        _Pragma("unroll") for (int mh = 0; mh < 2; ++mh) { bf16x8 At[4]; \
            _Pragma("unroll") for (int m = 0; m < 4; ++m) At[m] = *(const LAS bf16x8*)(lds + (buf) + a_r + (mh * 4 + m) * 2048 + (ks) * 1024); \
            _Pragma("unroll") for (int m = 0; m < 4; ++m) _Pragma("unroll") for (int n = 0; n < 4; ++n) \
                acc[mh * 4 + m][n] = __builtin_amdgcn_mfma_f32_16x16x32_bf16(Bf[n], At[m], acc[mh * 4 + m][n], 0, 0, 0); } \
        __builtin_amdgcn_sched_barrier(0); } while (0)
    { unsigned b0 = 0; asm volatile("" : "+s"(b0));
      const unsigned l4 = cur.ldb * 4u;
      G_GLDS_A(b0, ra_c, cur.aoff, 0); G_ISSUE_BH(rb_c, l4, 0, 0); G_ISSUE_BH(rb_c, l4, 0, 1); G_WRITE_BH(b0, 0, cur.bco, 0); G_WRITE_BH(b0, 1, cur.bco, 0);
      G_ISSUE_BH(rb_c, l4, 1, 0); G_ISSUE_BH(rb_c, l4, 1, 1); }
    asm volatile("s_waitcnt vmcnt(8)" ::: "memory");
    asm volatile("s_waitcnt lgkmcnt(0)" ::: "memory");
    __builtin_amdgcn_s_barrier();
    unsigned par = 0;
    for (int ti = 0;; ++ti) {
        const bool hasn = P.get(ti + 1, nxt);
        if (hasn) { ra_n = make_rsrc(nxt.A); rb_n = __builtin_amdgcn_make_buffer_rsrc((void*)nxt.B, 0, 0x7fffffff, 0x00020000); }
#pragma unroll
        for (int m = 0; m < 8; ++m)
#pragma unroll
            for (int n = 0; n < 4; ++n) acc[m][n] = (f32x4){0.f, 0.f, 0.f, 0.f};
        for (int t = 0; t < nt; ++t) {
            unsigned bc = par * STAGE_B, bn = (par ^ 1u) * STAGE_B; asm volatile("" : "+s"(bc), "+s"(bn));
            const bool c1 = t + 1 < nt, w1 = c1 || hasn, c2 = t + 2 < nt, i2 = c2 || hasn;
            if (w1) { const u32x4 ra = c1 ? ra_c : ra_n; unsigned ao[4];
#pragma unroll
                for (int i = 0; i < 4; ++i) ao[i] = c1 ? cur.aoff[i] : nxt.aoff[i];
                G_GLDS_A(bn, ra, ao, c1 ? t + 1 : 0); }
            G_KSTEP(bc, 0);
            const __amdgpu_buffer_rsrc_t rb = c2 ? rb_c : rb_n; const unsigned l4 = (c2 ? cur.ldb : nxt.ldb) * 4u; const int k2 = c2 ? t + 2 : t + 2 - nt;
            bf16_t* const bco = c1 ? cur.bco : nxt.bco; const int k1 = c1 ? t + 1 : 0;
            if (w1) G_WRITE_BH(bn, 0, bco, k1);
            if (i2) G_ISSUE_BH(rb, l4, k2, 0);
            G_KSTEP(bc, 1);
            if (w1) G_WRITE_BH(bn, 1, bco, k1);
            if (i2) { G_ISSUE_BH(rb, l4, k2, 1); asm volatile("s_waitcnt vmcnt(8)" ::: "memory"); }
            else asm volatile("s_waitcnt vmcnt(0)" ::: "memory");
            asm volatile("s_waitcnt lgkmcnt(0)" ::: "memory");
            __builtin_amdgcn_s_barrier();
            par ^= 1u;
        }
        P.epi(acc, cur, (const LAS float*)nullptr);
        if (!hasn) break;
        cur = nxt; ra_c = ra_n; rb_c = rb_n;
    }
#undef G_GLDS_A
#undef G_ISSUE_BH
#undef G_WRITE_BH
#undef G_KSTEP
}

constexpr int STEP_B = 32768;
constexpr unsigned ROPE_LDS = 2 * STAGE_B + 1024;
constexpr unsigned BIAS_OFF = 4 * STEP_B;
template <class Pol, int ABL = 0>
__device__ __forceinline__ void gemm_stream_bf(LAS unsigned char* lds, Pol& P, const int wid, const int lane) {
    const int wr = wid >> 2, wc = wid & 3, fr = lane & 15, fq = lane >> 4;
    const unsigned a_r = (unsigned)(wr * 8192 + ((fr * 64 + fq * 16) ^ ((fr >> 3) << 5)));
    const int x7 = 4 * (fq & 1) + (fr >> 2);
    unsigned b_r[4];
#pragma unroll
    for (int n = 0; n < 4; ++n) b_r[n] = (unsigned)(16384 + (4 * fq + (fr >> 2)) * 512 + (((wc * 4 + n) ^ x7) * 32) + (fr & 3) * 8);
    const unsigned ldsa = (unsigned)(__UINTPTR_TYPE__)lds + (unsigned)(wid * 2048), ldsb = (unsigned)(__UINTPTR_TYPE__)lds + 16384u + (unsigned)(wid * 2048);
    const unsigned ldb2 = P.ldbB * 2u;
    unsigned boff[2];
#pragma unroll
    for (int j = 0; j < 2; ++j) { const int sl = 4 * wid + 2 * j + (lane >> 5), u = lane & 31, c = (u >> 1) ^ (sl & 7), n = c * 16 + (u & 1) * 8;
        const int k = 8 * ((sl >> 2) & 3) + 4 * (sl >> 4) + (sl & 3); boff[j] = (unsigned)k * ldb2 + (unsigned)n * 2u; }
    TD cur, nxt;
    if (!P.get(0, cur)) return;
    int nt = P.nt * 2; asm volatile("" : "+s"(nt));
    f32x4 acc[8][4];
    u32x4 ra_c = make_rsrc(cur.A), ra_n = ra_c, rb_c = make_rsrc(cur.B), rb_n = rb_c;
#define H_DMA(LDSADDR, RS, VOFF, SOFF) do { unsigned keep_; \
        asm volatile("s_mov_b32 %0, m0\n\ts_mov_b32 m0, %3\n\ts_nop 0\n\tbuffer_load_dwordx4 %1, %2, %4 offen lds\n\ts_mov_b32 m0, %0" \
            : "=&s"(keep_) : "v"(VOFF), "s"(RS), "s"(LDSADDR), "s"(SOFF) : "memory"); } while (0)
#define H_STAGE(sb_, RA, AO0, AO1, RB, st) do { \
        if (!(ABL & 2)) { H_DMA(ldsa + (sb_), RA, AO0, (unsigned)((st) * 64)); H_DMA(ldsa + (sb_) + 1024u, RA, AO1, (unsigned)((st) * 64)); } \
        if (!(ABL & 1)) { H_DMA(ldsb + (sb_), RB, boff[0], (unsigned)(st) * 32u * ldb2); H_DMA(ldsb + (sb_) + 1024u, RB, boff[1], (unsigned)(st) * 32u * ldb2); } } while (0)
#define H_READ(sb_) do { if (!(ABL & 16)) { \
        _Pragma("unroll") for (int n = 0; n < 4; ++n) { \
            const s16x4 lo = __builtin_amdgcn_ds_read_tr16_b64_v4i16((LAS s16x4*)(lds + (sb_) + b_r[n])); \
            const s16x4 hi = __builtin_amdgcn_ds_read_tr16_b64_v4i16((LAS s16x4*)(lds + (sb_) + b_r[n] + 8192)); \
            Bf[n] = (bf16x8){lo[0], lo[1], lo[2], lo[3], hi[0], hi[1], hi[2], hi[3]}; } \
        _Pragma("unroll") for (int m = 0; m < 8; ++m) At[m] = *(const LAS bf16x8*)(lds + (sb_) + a_r + m * 1024); } } while (0)
#define H_MMA() do { if (!(ABL & 16)) { __builtin_amdgcn_s_setprio(1); \
        if (!(ABL & 4)) { _Pragma("unroll") for (int m = 0; m < 8; ++m) _Pragma("unroll") for (int n = 0; n < 4; ++n) \
            acc[m][n] = __builtin_amdgcn_mfma_f32_16x16x32_bf16(Bf[n], At[m], acc[m][n], 0, 0, 0); } \
        else { _Pragma("unroll") for (int m = 0; m < 8; ++m) asm volatile("" :: "v"(At[m])); _Pragma("unroll") for (int n = 0; n < 4; ++n) asm volatile("" :: "v"(Bf[n])); } \
        __builtin_amdgcn_s_setprio(0); } } while (0)
#define H_BAR() do { asm volatile("s_waitcnt lgkmcnt(0)" ::: "memory"); __builtin_amdgcn_s_barrier(); __builtin_amdgcn_sched_barrier(0); } while (0)
    bf16x8 At[8], Bf[4];
    { unsigned s0 = 0, s1 = STEP_B, s2 = 2 * STEP_B; asm volatile("" : "+s"(s0), "+s"(s1), "+s"(s2));
      H_STAGE(s0, ra_c, cur.aoff[0], cur.aoff[1], rb_c, 0); H_STAGE(s1, ra_c, cur.aoff[0], cur.aoff[1], rb_c, 1); H_STAGE(s2, ra_c, cur.aoff[0], cur.aoff[1], rb_c, 2); }
    asm volatile("s_waitcnt vmcnt(8)" ::: "memory");
    H_BAR();
    if (wr == 1) H_BAR();
    unsigned g = 0;
    for (int ti = 0;; ++ti) {
        const bool hasn = P.get(ti + 1, nxt);
        if (hasn) { ra_n = make_rsrc(nxt.A); rb_n = make_rsrc(nxt.B); }
        const unsigned bias_lds = BIAS_OFF + (unsigned)(ti & 1) * 1024u, list_lds = BIAS_OFF + 2048u + (unsigned)(ti & 1) * 1024u;
        if (P.has_bias && wid == 0) { const u32x4 rbias = make_rsrc(P.bias); H_DMA((unsigned)(__UINTPTR_TYPE__)lds + bias_lds, rbias, P.bias_voff(cur), 0u); }
        if (P.has_list && hasn && wid == 1) { const u32x4 rl = make_rsrc(P.listp); H_DMA((unsigned)(__UINTPTR_TYPE__)lds + list_lds, rl, P.list_voff(nxt), 0u); }
#pragma unroll
        for (int m = 0; m < 8; ++m)
#pragma unroll
            for (int n = 0; n < 4; ++n) acc[m][n] = (f32x4){0.f, 0.f, 0.f, 0.f};
        for (int t = 0; t < nt; ++t, ++g) {
            unsigned sc = (g & 3u) * STEP_B, sn = ((g + 3u) & 3u) * STEP_B; asm volatile("" : "+s"(sc), "+s"(sn));
            const bool c3 = t + 3 < nt, i3 = c3 || hasn, i2 = (t + 2 < nt) || hasn;
            if (P.has_list && hasn && t == nt - 3) P.late(nxt, (const LAS int*)(lds + list_lds));
            if (i3) { const u32x4 ra = c3 ? ra_c : ra_n, rb = c3 ? rb_c : rb_n; const unsigned a0 = c3 ? cur.aoff[0] : nxt.aoff[0], a1 = c3 ? cur.aoff[1] : nxt.aoff[1];
                H_STAGE(sn, ra, a0, a1, rb, c3 ? t + 3 : t + 3 - nt); }
            H_READ(sc);
            if (i3) asm volatile("s_waitcnt vmcnt(8)" ::: "memory");
            else if (i2) asm volatile("s_waitcnt vmcnt(4)" ::: "memory");
            else asm volatile("s_waitcnt vmcnt(0)" ::: "memory");
            H_BAR();
            H_MMA();
            H_BAR();
        }
        if (!(ABL & 8)) P.epi(acc, cur, (const LAS float*)(lds + bias_lds)); else { _Pragma("unroll") for (int m = 0; m < 8; ++m) _Pragma("unroll") for (int n = 0; n < 4; ++n) asm volatile("" :: "v"(acc[m][n])); }
        if (!hasn) break;
        cur = nxt; ra_c = ra_n; rb_c = rb_n;
    }
    if (wr == 0) H_BAR();
#undef H_DMA
#undef H_STAGE
#undef H_READ
#undef H_MMA
#undef H_BAR
}

struct XOrder {
    int c1, step, cur;
    __device__ __forceinline__ void init(int T, int G, int bid) {
        if ((G & 7) == 0) { const int x = bid & 7; cur = (int)(((long)x * T) >> 3) + (bid >> 3); c1 = (int)(((long)(x + 1) * T) >> 3); step = G >> 3; }
        else { cur = bid; c1 = T; step = G; }
    }
    __device__ __forceinline__ bool next(int& L) { if (cur >= c1) return false; L = cur; cur += step; return true; }
};
__device__ __forceinline__ void dense_tile(int L, int nM, int nN, int& pm, int& pn) { const int per = 8 * nN, g = L / per, w = L - g * per, fm = g * 8, gs = (nM - fm) < 8 ? (nM - fm) : 8; pn = w / gs; pm = fm + w - pn * gs; }

struct Frame { LAS unsigned char* lds; int tid, lane, wid, bid, G; unsigned char* ws; };
__device__ __forceinline__ const void* ldp(const Frame& F, int off) {
    const u32x2 v = *(const volatile LAS u32x2*)(F.lds + PARAM_OFF + off);
    const unsigned lo = __builtin_amdgcn_readfirstlane(v.x), hi = __builtin_amdgcn_readfirstlane(v.y);
    return (const void*)(((unsigned long long)hi << 32) | lo);
}
#define PP(f) ((const float*)ldp(F, (int)__builtin_offsetof(Params, f)))
#define F_mod ((float*)(F.ws + WS_MOD))
#define F_M1 ((bf16_t*)(F.ws + WS_M1))
#define F_M2 ((bf16_t*)(F.ws + WS_M2))
#define F_ROPE ((f32x2*)(F.ws + WS_ROPE))
#define F_TW ((f32x2*)(F.ws + WS_TW))
#define F_WF ((float*)(F.ws + WS_WF))
#define F_TOPW ((float*)(F.ws + WS_TOPW))
#define F_POS ((int*)(F.ws + WS_POS))
#define F_LIST ((int*)(F.ws + WS_LIST))
#define F_H ((bf16_t*)(F.ws + WS_H))
#define F_MIX ((bf16_t*)(F.ws + WS_MIX))
#define F_XS ((float*)(F.ws + WS_XS))
#define F_PROJ ((bf16_t*)(F.ws + WS_PROJ))
#define F_Z ((float*)(F.ws + WS_Z))
#define F_A1 ((float*)(F.ws + WS_A1))
#define F_ACT ((bf16_t*)(F.ws + WS_ACT))
#define F_Y ((bf16_t*)(F.ws + WS_Y))
#define F_cnt ((unsigned*)(F.ws + WS_CTL) + CW_CNT)

__device__ __forceinline__ const float* modp(const Frame& F, int l, int r, int which) { return F_mod + ((size_t)(l * 5 + r)) * 6144 + which * 1024; }
__device__ __forceinline__ int mod_row(int row) { return row < NMAIN ? (row >> 12) : 4; }

__device__ __forceinline__ float row_rstd(const f32x4 (&v)[4]) {
    float s = 0.f;
#pragma unroll
    for (int j = 0; j < 4; ++j) s += (v[j][0] * v[j][0] + v[j][1] * v[j][1]) + (v[j][2] * v[j][2] + v[j][3] * v[j][3]);
    return __builtin_amdgcn_rsqf(wave_sum(s) * (1.f / D) + NORM_EPS);
}
__device__ __forceinline__ void norm_mod_store(const f32x4 (&v)[4], float rstd, const float* gam, const float* sc, const float* sh, bf16_t* dst, int lane, f32x4 (*keep)[4] = nullptr) {
#pragma unroll
    for (int j = 0; j < 4; ++j) {
        const int c = 4 * lane + 256 * j;
        const f32x4 g = *(const f32x4*)(gam + c), s1 = *(const f32x4*)(sc + c), s0 = *(const f32x4*)(sh + c);
        f32x4 h;
#pragma unroll
        for (int i = 0; i < 4; ++i) h[i] = v[j][i] * rstd * g[i] * (1.f + s1[i]) + s0[i];
        u32x2 w; w.x = pk2(h[0], h[1]); w.y = pk2(h[2], h[3]);
        *(u32x2*)(dst + c) = w;
        if (keep) (*keep)[j] = h;
    }
}

__device__ __forceinline__ void phase_prep(Frame& F) {
    LAS float* sil = (LAS float*)F.lds;
    LAS float* red = (LAS float*)(F.lds + 20480);
    LAS float* ct = (LAS float*)(F.lds + 32768);
    for (int idx = F.tid; idx < 5120; idx += 512) { const int r = idx >> 10, k = idx & 1023; const float v = r < 4 ? PP(c)[r * 1024 + k] : PP(c_ctx)[k]; sil[idx] = v / (1.f + __expf(-v)); }
    if (F.tid < 128) ct[F.tid] = cospif((float)F.tid / 64.f);
    __syncthreads();
    constexpr int N_ADA = 192, N_CONST = 8, N_FOLD = 256, N_CVT = 368;
    for (int it = F.bid; it < N_ADA + N_CONST + N_FOLD + N_CVT; it += F.G) {
        if (it < N_ADA) {
            const int l = it / 96, j0 = (it % 96) * 64, col = j0 + F.lane;
            const float* w = PP(ada_w) + ((size_t)l * 1024 + F.wid * 128) * 6144 + col;
            float a[5] = {0.f, 0.f, 0.f, 0.f, 0.f};
#pragma unroll 8
            for (int k = 0; k < 128; ++k) { const float wv = w[(size_t)k * 6144];
#pragma unroll
                for (int r = 0; r < 5; ++r) a[r] += sil[r * 1024 + F.wid * 128 + k] * wv; }
#pragma unroll
            for (int r = 0; r < 5; ++r) red[(F.wid * 5 + r) * 64 + F.lane] = a[r];
            __syncthreads();
            if (F.tid < 320) { const int r = F.tid >> 6, ln = F.tid & 63; float s = 0.f;
#pragma unroll
                for (int w8 = 0; w8 < 8; ++w8) s += red[(w8 * 5 + r) * 64 + ln];
                F_mod[(size_t)(l * 5 + r) * 6144 + j0 + ln] = s + PP(ada_b)[l * 6144 + j0 + ln]; }
            __syncthreads();
        } else if (it < N_ADA + N_CONST) {
            const int gt = (it - N_ADA) * 512 + F.tid;
            for (int e = gt; e < 32768; e += 4096) {
                const int row = e >> 7, kk = e & 127;
                float v1 = 0.f, v2 = 0.f;
                if (row < 128) { const int ro = row >> 6, k1 = row & 63, n1 = kk >> 1, ri = kk & 1; const float ph = (float)((n1 * k1) & 63) / 32.f; const float cs = cospif(ph), sn = sinpif(ph);
                    v1 = (ro == ri) ? cs : (ro == 0 ? sn : -sn); }
                if (row < 64) { const int ro = kk >> 6, n2 = kk & 63; const float ph = (float)((row * n2) & 63) / 32.f; v2 = ro == 0 ? cospif(ph) : sinpif(ph); }
                F_M1[e] = (bf16_t)(pk2(v1, 0.f) & 0xffffu); F_M2[e] = (bf16_t)(pk2(v2, 0.f) & 0xffffu);
            }
            if (gt < 1024) { const int pos = gt >> 4, f = gt & 15; const double ang = (double)pos * pow(10000.0, -(double)f / 16.0); F_ROPE[gt] = (f32x2){(float)cos(ang), (float)sin(ang)}; }
            { const float ph = (float)gt / 2048.f; F_TW[gt] = (f32x2){cospif(ph), sinpif(ph)}; }
        } else if (it >= N_ADA + N_CONST + N_FOLD) {
            int ci = it - (N_ADA + N_CONST + N_FOLD); const float* src; bf16_t* dst; int sld, dld, ncol;
            if (ci < 144) { src = PP(even_w_in); dst = (bf16_t*)(F.ws + WB_EIN); sld = EVEN_IN; dld = EVEN_IN; ncol = EVEN_IN; }
            else if (ci < 208) { ci -= 144; src = PP(even_w_out); dst = (bf16_t*)(F.ws + WB_EOUT); sld = D; dld = D; ncol = D; }
            else if (ci < 304) { ci -= 208; src = PP(odd_w_in); dst = (bf16_t*)(F.ws + WB_OIN); sld = 2048; dld = 2560; ncol = 1536; }
            else { ci -= 304; src = PP(odd_w_out); dst = (bf16_t*)(F.ws + WB_OOUT); sld = D; dld = D; ncol = D; }
            const int q4 = ncol >> 2;
#pragma unroll
            for (int u = 0; u < 8; ++u) { const int gidx = ci * 4096 + u * 512 + F.tid, row = gidx / q4, c4 = (gidx - row * q4) * 4;
                const f32x4 v = *(const f32x4*)(src + (size_t)row * sld + c4); u32x2 w; w.x = pk2(v[0], v[1]); w.y = pk2(v[2], v[3]); *(u32x2*)(dst + (size_t)row * dld + c4) = w; }
        } else {
            const int fi = it - N_ADA - N_CONST, rc = fi >> 2, g = fi & 3, half = F.tid >> 8, j = F.tid & 255, jj = j & 127;
            for (int i2 = 0; i2 < 8; ++i2) {
                const int row = rc * 16 + i2 * 2 + half;
                const float* wr_ = PP(odd_w_in) + (size_t)row * 2048 + 1536 + g * 128;
                float s = 0.f;
                if (j < 128) { for (int cc = 0; cc < 128; ++cc) s += wr_[cc] * ct[(cc * jj) & 127]; }
                else { for (int cc = 0; cc < 128; ++cc) s -= wr_[cc] * ct[((cc * jj) - 32) & 127]; }
                ((bf16_t*)(F.ws + WB_OIN))[(size_t)row * 2560 + 1536 + g * 256 + j] = (bf16_t)(pk2(s, 0.f) & 0xffffu);
            }
        }
    }
}

__device__ __forceinline__ void phase_norm1_l0(Frame& F) {
    const int gw = F.bid * 8 + F.wid, NGW = F.G * 8;
    for (int row = gw; row < NTOK; row += NGW) {
        const float* src = row < NMAIN ? PP(x) + (size_t)row * D : PP(ctx) + (size_t)(row - NMAIN) * D;
        f32x4 v[4];
#pragma unroll
        for (int j = 0; j < 4; ++j) v[j] = *(const f32x4*)(src + 4 * F.lane + 256 * j);
        const float rstd = row_rstd(v); const int r = mod_row(row);
        norm_mod_store(v, rstd, PP(norm_mix), modp(F, 0, r, 1), modp(F, 0, r, 0), F_H + (size_t)row * D, F.lane);
    }
}

#define EPI_GEOM const int wid = this->wid, lane = this->lane, wr = wid >> 2, wc = wid & 3, fr = lane & 15, fq = lane >> 4; (void)wr; (void)wc; (void)fr; (void)fq
struct PolBase { unsigned char* ws; LAS unsigned char* lds; int wid, lane, nt; unsigned lcolb, woff, ldbB; XOrder xo; int aC, aR0, aCb, aR0b; bool bfm;
    __device__ __forceinline__ void base_init(Frame& F, int nt_, int T) { ws = F.ws; lds = F.lds; wid = F.wid; lane = F.lane; nt = nt_; lcolb = 16u * (unsigned)F.lane; woff = 8u * (unsigned)F.lane;
        xo.init(T, F.G, F.bid); aC = a_piece_col(F.wid, F.lane); aR0 = a_piece_row0(F.wid, F.lane); bfm = true;
        { const int sbb = F.lane * 16, swz = sbb ^ (((sbb >> 9) & 1) << 5); aR0b = F.wid * 32 + (swz >> 6); aCb = (swz & 63) >> 1; } }
    bool has_bias = false; const float* bias = nullptr;
    bool has_list = false; const int* listp = nullptr;
    __device__ __forceinline__ unsigned list_voff(const TD&) const { return 0u; }
    __device__ __forceinline__ void late(TD&, const LAS int*) const {}
    __device__ __forceinline__ unsigned bias_voff(const TD&) const { return 0u; }
    __device__ __forceinline__ bool tileL(int i, int& L) const { L = xo.cur + i * xo.step; return L < xo.c1; }
    __device__ __forceinline__ int prow(int i) const { return bfm ? aR0b + 16 * (i & 1) : aR0 + 64 * i; }
    __device__ __forceinline__ int pcol() const { return bfm ? aCb : aC; }
    __device__ __forceinline__ void dense_aoff(TD& td, int row0, int pitch) const {
#pragma unroll
        for (int i = 0; i < 4; ++i) td.aoff[i] = (unsigned)(((row0 + prow(i)) * pitch + pcol()) * 2); }
};

struct PolInproj0 : PolBase {
    const float* W; Frame* Fp;
    __device__ __forceinline__ bool get(int i, TD& td) const { int L; if (!tileL(i, L)) return false; int pm, pn; dense_tile(L, NTOK / 256, EVEN_IN / 256, pm, pn);
        td.A = (const bf16_t*)(ws + WS_H); dense_aoff(td, pm * 256, D); td.B = (const bf16_t*)(ws + WB_EIN) + pn * 256; td.i0 = pm; td.i1 = pn; return true; }
    __device__ __forceinline__ void epi(f32x4 (&acc)[8][4], const TD& td, const LAS float* bl) const { (void)bl; EPI_GEOM; const int pm = td.i0, pn = td.i1;
        const int colb = pn * 256 + wc * 64; const bool rope = (colb < 640) && (pm < NMAIN / 256);
        const LAS f32x2* ROPE = (const LAS f32x2*)(lds + ROPE_LDS); bf16_t* PROJ = (bf16_t*)(ws + WS_PROJ);
#pragma unroll
        for (int m = 0; m < 8; ++m) { const int row = pm * 256 + wr * 128 + m * 16 + fr;
            if (rope) { const int tt = row & (SEQ - 1), gr = tt >> 6, gc = tt & 63;
#pragma unroll
                for (int n = 0; n < 2; ++n) { const int pos = n == 0 ? gr : gc;
#pragma unroll
                    for (int j = 0; j < 4; ++j) { const f32x2 cs = ROPE[pos * 16 + 4 * fq + j]; const float x1 = acc[m][n][j], x2 = acc[m][n + 2][j];
                        acc[m][n][j] = x1 * cs.x - x2 * cs.y; acc[m][n + 2][j] = x2 * cs.x + x1 * cs.y; } } }
#pragma unroll
            for (int n = 0; n < 4; ++n) { u32x2 w; w.x = pk2(acc[m][n][0], acc[m][n][1]); w.y = pk2(acc[m][n][2], acc[m][n][3]);
                *(u32x2*)(PROJ + (size_t)row * EVEN_IN + colb + n * 16 + 4 * fq) = w; } } }
};
__device__ __forceinline__ void phase_inproj_l0(Frame& F) {
    for (int i = F.tid; i < 1024; i += 512) ((LAS f32x2*)(F.lds + ROPE_LDS))[i] = F_ROPE[i];
    __syncthreads();
    PolInproj0 P; P.base_init(F, D / 64, (NTOK / 256) * (EVEN_IN / 256)); P.ldbB = EVEN_IN;
    gemm_stream_bf(F.lds, P, F.wid, F.lane);
}

struct PolOutproj : PolBase {
    const float *W, *x, *ctx; int layer, nM;
    __device__ __forceinline__ bool get(int i, TD& td) const { int L; if (!tileL(i, L)) return false; int pm, pn; dense_tile(L, nM, 4, pm, pn);
        td.A = (const bf16_t*)(ws + WS_MIX); dense_aoff(td, pm * 256, D); td.B = (const bf16_t*)(ws + (layer == 0 ? WB_EOUT : WB_OOUT)) + pn * 256; td.i0 = pm; td.i1 = pn; return true; }
    __device__ __forceinline__ void epi(f32x4 (&acc)[8][4], const TD& td, const LAS float* bl) const { (void)bl; EPI_GEOM; const int pm = td.i0, pn = td.i1;
        const int colb = pn * 256 + wc * 64; float* XS = (float*)(ws + WS_XS); const float* mod = (const float*)(ws + WS_MOD);
#pragma unroll
        for (int m = 0; m < 8; ++m) { const int row = pm * 256 + wr * 128 + m * 16 + fr; const int r = mod_row(row);
            const float* xin = layer == 0 ? (row < NMAIN ? x + (size_t)row * D : ctx + (size_t)(row - NMAIN) * D) : XS + (size_t)row * D;
            const float* g1 = mod + ((size_t)(layer * 5 + r)) * 6144 + 2 * 1024;
#pragma unroll
            for (int n = 0; n < 4; ++n) { const int c = colb + n * 16 + 4 * fq; const f32x4 xv = *(const f32x4*)(xin + c), gv = *(const f32x4*)(g1 + c);
                f32x4 o;
#pragma unroll
                for (int j = 0; j < 4; ++j) o[j] = xv[j] + gv[j] * acc[m][n][j];
                *(f32x4*)(XS + (size_t)row * D + c) = o; } } }
};
__device__ __forceinline__ void phase_outproj(Frame& F, const int layer) {
    PolOutproj P; P.layer = layer; P.nM = (layer == 0 ? NTOK : NMAIN) / 256; P.base_init(F, D / 64, P.nM * 4);
    P.ldbB = D; P.x = PP(x); P.ctx = PP(ctx);
    gemm_stream_bf(F.lds, P, F.wid, F.lane);
}

constexpr int QT = 2;
struct AttnSt { f32x4 o[4][QT]; float m[QT], l[QT]; };
#define V_ROWB 160
__device__ __forceinline__ void v_stage(LAS unsigned char* vl, const bf16_t* vsrc, int ld, int lane) {
    i32x4 t[4];
    asm volatile("" ::: "memory");
#pragma unroll
    for (int i = 0; i < 4; ++i) t[i] = *(const i32x4*)(vsrc + (size_t)((lane >> 3) + 8 * i) * ld + (lane & 7) * 8);
#pragma unroll
    for (int i = 0; i < 4; ++i) *(LAS i32x4*)(vl + ((lane >> 3) + 8 * i) * V_ROWB + (lane & 7) * 16) = t[i];
    asm volatile("s_waitcnt lgkmcnt(0)" ::: "memory");
}
#define ATTN_STEP(ksrc, kld, vsrc, vld, SCALE, BIAS) do { \
    bf16x8 kf[2][2]; \
    _Pragma("unroll") for (int kt = 0; kt < 2; ++kt) _Pragma("unroll") for (int ks = 0; ks < 2; ++ks) \
        kf[kt][ks] = *(const bf16x8*)((ksrc) + (size_t)(kt * 16 + fr) * (kld) + ks * 32 + 8 * fq); \
    v_stage(vl, (vsrc), (vld), lane); \
    bf16x8 vf[4]; \
    _Pragma("unroll") for (int dt = 0; dt < 4; ++dt) { \
        const s16x4 lo = __builtin_amdgcn_ds_read_tr16_b64_v4i16((LAS s16x4*)(vl + (4 * fq + (fr >> 2)) * V_ROWB + (dt * 16 + (fr & 3) * 4) * 2)); \
        const s16x4 hi = __builtin_amdgcn_ds_read_tr16_b64_v4i16((LAS s16x4*)(vl + (16 + 4 * fq + (fr >> 2)) * V_ROWB + (dt * 16 + (fr & 3) * 4) * 2)); \
        vf[dt] = (bf16x8){lo[0], lo[1], lo[2], lo[3], hi[0], hi[1], hi[2], hi[3]}; } \
    _Pragma("unroll") for (int qt = 0; qt < QT; ++qt) { \
        f32x4 s[2]; \
        _Pragma("unroll") for (int kt = 0; kt < 2; ++kt) { s[kt] = (f32x4){0.f, 0.f, 0.f, 0.f}; \
            _Pragma("unroll") for (int ks = 0; ks < 2; ++ks) s[kt] = __builtin_amdgcn_mfma_f32_16x16x32_bf16(kf[kt][ks], qf[qt][ks], s[kt], 0, 0, 0); } \
        float mx = -INFINITY; \
        _Pragma("unroll") for (int kt = 0; kt < 2; ++kt) _Pragma("unroll") for (int j = 0; j < 4; ++j) { const float tv = s[kt][j] * (SCALE) + BIAS(qt, kt, j); s[kt][j] = tv; mx = fmaxf(mx, tv); } \
        mx = fmaxf(mx, __shfl_xor(mx, 16)); mx = fmaxf(mx, __shfl_xor(mx, 32)); \
        const float mn = fmaxf(st.m[qt], mx), al = fexp2(st.m[qt] - mn); st.m[qt] = mn; \
        float ps = 0.f; \
        _Pragma("unroll") for (int kt = 0; kt < 2; ++kt) _Pragma("unroll") for (int j = 0; j < 4; ++j) { const float pv = fexp2(s[kt][j] - mn); s[kt][j] = pv; ps += pv; } \
        st.l[qt] = st.l[qt] * al + ps; \
        const unsigned w0 = pk2(s[0][0], s[0][1]), w1 = pk2(s[0][2], s[0][3]), w2 = pk2(s[1][0], s[1][1]), w3 = pk2(s[1][2], s[1][3]); \
        const bf16x8 pf = __builtin_bit_cast(bf16x8, ((u32x4){w0, w1, w2, w3})); \
        _Pragma("unroll") for (int dt = 0; dt < 4; ++dt) st.o[dt][qt] = __builtin_amdgcn_mfma_f32_16x16x32_bf16(vf[dt], pf, st.o[dt][qt] * al, 0, 0, 0); } \
    } while (0)

__device__ __forceinline__ void attn_store(AttnSt& st, bf16_t* dst  , int dld, int fr, int fq) {
#pragma unroll
    for (int qt = 0; qt < QT; ++qt) {
        float l = st.l[qt]; l += __shfl_xor(l, 16); l += __shfl_xor(l, 32);
        const float inv = 1.f / l;
#pragma unroll
        for (int dt = 0; dt < 4; ++dt) { const f32x4 o = st.o[dt][qt] * inv; u32x2 w; w.x = pk2(o[0], o[1]); w.y = pk2(o[2], o[3]);
            *(u32x2*)(dst + (size_t)(qt * 16 + fr) * dld + dt * 16 + 4 * fq) = w; }
    }
}

__device__ __forceinline__ void phase_attn_l0(Frame& F) {
    const int wid = F.wid, lane = F.lane, fr = lane & 15, fq = lane >> 4;
    LAS unsigned char* vl = F.lds + wid * 8192;
    constexpr int N_WIN = 256, N_CTXA = 16, N_CONV = NTOK / 64;
    const float SC = 0.125f * LOG2E;
    for (int it = F.bid; it < N_WIN + N_CTXA + N_CONV; it += F.G) {
        if (it < N_WIN + N_CTXA) {
            const bool isctx = it >= N_WIN;
            int b, kvh, qb;
            if (!isctx) { b = it >> 6; kvh = (it >> 5) & 1; qb = it & 31; } else { const int c = it - N_WIN; b = c >> 2; kvh = (c >> 1) & 1; qb = c & 1; }
            const int g = wid >> 1, h = kvh * 4 + g;
            for (int qh = 0; qh < 4 / QT; ++qh) {
            const int qq0 = (wid & 1) * 64 + qh * (16 * QT);
            const int qrow0 = (isctx ? NMAIN + b * CTXL : b * SEQ) + qb * 128 + qq0;
            bf16x8 qf[QT][2];
#pragma unroll
            for (int qt = 0; qt < QT; ++qt)
#pragma unroll
                for (int ks = 0; ks < 2; ++ks) qf[qt][ks] = *(const bf16x8*)(F_PROJ + (size_t)(qrow0 + qt * 16 + fr) * EVEN_IN + h * 64 + ks * 32 + 8 * fq);
            AttnSt st;
            const float sink = PP(even_sink)[h] * LOG2E;
#pragma unroll
            for (int qt = 0; qt < QT; ++qt) { st.m[qt] = sink; st.l[qt] = (fq == 0) ? 1.f : 0.f;
#pragma unroll
                for (int dt = 0; dt < 4; ++dt) st.o[dt][qt] = (f32x4){0.f, 0.f, 0.f, 0.f}; }
            const int kcol = 512 + kvh * 64, vcol = 640 + kvh * 64;
            for (int ch = isctx ? 3 : 0; ch < 5; ++ch) {
                int krow0;
                if (ch < 3) { const int kb = qb - 1 + ch; if (kb < 0 || kb >= SEQ / 128) continue; krow0 = b * SEQ + kb * 128; } else krow0 = NMAIN + b * CTXL + (ch - 3) * 128;
                for (int s32 = 0; s32 < 4; ++s32) {
                    const bf16_t* kp = F_PROJ + (size_t)(krow0 + s32 * 32) * EVEN_IN + kcol;
                    const bf16_t* vp = F_PROJ + (size_t)(krow0 + s32 * 32) * EVEN_IN + vcol;
                    if (ch == 0) {
#define BIAS_PREV(qt, kt, j) ((s32 * 32 + kt * 16 + 4 * fq + j) >= (qq0 + qt * 16 + fr) ? 0.f : -INFINITY)
                        ATTN_STEP(kp, EVEN_IN, vp, EVEN_IN, SC, BIAS_PREV);
                    } else if (ch == 2) {
#define BIAS_NEXT(qt, kt, j) ((s32 * 32 + kt * 16 + 4 * fq + j) <= (qq0 + qt * 16 + fr) ? 0.f : -INFINITY)
                        ATTN_STEP(kp, EVEN_IN, vp, EVEN_IN, SC, BIAS_NEXT);
                    } else {
#define BIAS_NONE(qt, kt, j) 0.f
                        ATTN_STEP(kp, EVEN_IN, vp, EVEN_IN, SC, BIAS_NONE);
                    }
                }
            }
            attn_store(st, F_MIX + (size_t)qrow0 * D + h * 64, D, fr, fq);
            }
        } else {
            const int ci = it - N_WIN - N_CTXA, c4 = (F.tid & 127) * 4, r0 = ci * 64 + (F.tid >> 7) * 16;
            const f32x4 w0 = *(const f32x4*)(PP(even_conv_w) + c4), w1 = *(const f32x4*)(PP(even_conv_w) + 512 + c4), w2 = *(const f32x4*)(PP(even_conv_w) + 1024 + c4);
#define LOADZ(dst, row_) do { const u32x2 gc_ = *(const u32x2*)(F_PROJ + (size_t)(row_) * EVEN_IN + 1280 + c4), uu_ = *(const u32x2*)(F_PROJ + (size_t)(row_) * EVEN_IN + 1792 + c4); \
                dst = (f32x4){bflo(gc_.x) * bflo(uu_.x), bfhi(gc_.x) * bfhi(uu_.x), bflo(gc_.y) * bflo(uu_.y), bfhi(gc_.y) * bfhi(uu_.y)}; } while (0)
            const int seqmask = r0 < NMAIN ? (SEQ - 1) : (CTXL - 1);
            f32x4 zp = (f32x4){0.f, 0.f, 0.f, 0.f}, zc, zn;
            if ((r0 & seqmask) != 0) LOADZ(zp, r0 - 1);
            LOADZ(zc, r0);
            for (int i = 0; i < 16; ++i) {
                const int row = r0 + i;
                zn = (f32x4){0.f, 0.f, 0.f, 0.f}; if ((row & seqmask) != seqmask) LOADZ(zn, row + 1);
                const u32x2 gb = *(const u32x2*)(F_PROJ + (size_t)row * EVEN_IN + 768 + c4);
                const f32x4 y = zp * w0 + zc * w1 + zn * w2;
                u32x2 w; w.x = pk2(bflo(gb.x) * y[0], bfhi(gb.x) * y[1]); w.y = pk2(bflo(gb.y) * y[2], bfhi(gb.y) * y[3]);
                *(u32x2*)(F_MIX + (size_t)row * D + 512 + c4) = w;
                zp = zc; zc = zn;
            }
        }
    }
}

constexpr int RW_LD = 1028;
__device__ __forceinline__ void phase_route(Frame& F, const int layer) {
    const int nrows = layer == 0 ? NTOK : NMAIN;
    LAS float* rwT = (LAS float*)F.lds;
    LAS int* cntL = (LAS int*)(F.lds + 32 * RW_LD * 4);
    LAS int* baseL = cntL + 32;
    LAS int* selE = baseL + 32;
    LAS int* selR = selE + 384;
    const float* rw = PP(router_w) + (size_t)layer * D * NEXP;
    { const f32x4* rsrc4 = (const f32x4*)rw + F.tid; LAS float* wp = rwT + ((4 * F.tid) & 31) * RW_LD + (F.tid >> 3);
      for (int it = 0; it < 4; ++it) {
        f32x4 v[4];
#pragma unroll
        for (int u = 0; u < 4; ++u) v[u] = rsrc4[(it * 4 + u) * 512];
#pragma unroll
        for (int u = 0; u < 4; ++u)
#pragma unroll
            for (int j = 0; j < 4; ++j) wp[it * 256 + u * 64 + j * RW_LD] = v[u][j];
        asm volatile("" ::: "memory"); } }
    if (F.tid < 32) cntL[F.tid] = 0;
    __syncthreads();
    const int lane = F.lane, gw = F.bid * 8 + F.wid, NGW = F.G * 8;
    const float* gam = PP(norm_ffn) + layer * D;
    int slot = F.wid;
    const float* Wd = PP(moe_w_dn) + (size_t)layer * NEXP * DFF * D; bf16_t* pd = (bf16_t*)(F.ws + WS_BC2);
    constexpr int CV_TOTAL = NEXP * 4 * 1024;
    const int cv_q = (CV_TOTAL + NGW - 1) / NGW, cv_end = min((gw + 1) * cv_q, CV_TOTAL); int cv_u = gw * cv_q;
#define CV_LOAD(v_, u0_) do { _Pragma("unroll") for (int u = 0; u < 8; ++u) { const int pr = min((u0_) + u, CV_TOTAL - 1), pnl = pr >> 10, k = pr & 1023, e = pnl >> 2, ct = pnl & 3; \
        v_[u] = *(const f32x4*)(Wd + ((size_t)e * DFF + k) * D + ct * 256 + 4 * lane); } } while (0)
#define CV_STORE(v_, u0_, uend_) do { _Pragma("unroll") for (int u = 0; u < 8; ++u) { const int pr = (u0_) + u; if (pr < (uend_)) { u32x2 w; w.x = pk2(v_[u][0], v_[u][1]); w.y = pk2(v_[u][2], v_[u][3]); \
        *(u32x2*)(pd + (size_t)pr * 256 + 4 * lane) = w; } } } while (0)
    f32x4 vn[4];
    if (gw < nrows) {
#pragma unroll
        for (int j = 0; j < 4; ++j) vn[j] = *(const f32x4*)(F_XS + (size_t)gw * D + 4 * lane + 256 * j); }
    for (int row = gw; row < nrows; row += NGW, slot += 8) {
        f32x4 v[4], h[4], cvv[8];
        const int cv_u0 = cv_u; CV_LOAD(cvv, cv_u0); cv_u += 8;
#pragma unroll
        for (int j = 0; j < 4; ++j) v[j] = vn[j];
        if (row + NGW < nrows) {
#pragma unroll
            for (int j = 0; j < 4; ++j) vn[j] = *(const f32x4*)(F_XS + (size_t)(row + NGW) * D + 4 * lane + 256 * j); }
        const float rstd = row_rstd(v); const int r = mod_row(row);
        norm_mod_store(v, rstd, gam, modp(F, layer, r, 4), modp(F, layer, r, 3), F_H + (size_t)row * D, lane, &h);
        float pe[32];
#pragma unroll
        for (int e = 0; e < 32; ++e) { float s = 0.f;
            f32x2 s2 = (f32x2){0.f, 0.f};
#pragma unroll
            for (int j = 0; j < 4; ++j) { const f32x4 w = *(const LAS f32x4*)(rwT + e * RW_LD + 4 * lane + 256 * j);
                s2 = __builtin_elementwise_fma((f32x2){h[j][0], h[j][1]}, (f32x2){w[0], w[1]}, s2); s2 = __builtin_elementwise_fma((f32x2){h[j][2], h[j][3]}, (f32x2){w[2], w[3]}, s2); }
            s = s2.x + s2.y;
            pe[e] = s; if ((e & 3) == 3) __builtin_amdgcn_sched_barrier(0); }
        float q16[16], q8[8], q4[4], q2[2], q1;
        { const bool hi = lane & 32;
#pragma unroll
          for (int i = 0; i < 16; ++i) { const float snd = hi ? pe[i] : pe[16 + i], mine = hi ? pe[16 + i] : pe[i]; q16[i] = mine + __shfl_xor(snd, 32); } }
        { const bool hi = lane & 16;
#pragma unroll
          for (int i = 0; i < 8; ++i) { const float snd = hi ? q16[i] : q16[8 + i], mine = hi ? q16[8 + i] : q16[i]; q8[i] = mine + __shfl_xor(snd, 16); } }
        { const bool hi = lane & 8;
#pragma unroll
          for (int i = 0; i < 4; ++i) { const float snd = hi ? q8[i] : q8[4 + i], mine = hi ? q8[4 + i] : q8[i]; q4[i] = mine + __shfl_xor(snd, 8); } }
        { const bool hi = lane & 4;
#pragma unroll
          for (int i = 0; i < 2; ++i) { const float snd = hi ? q4[i] : q4[2 + i], mine = hi ? q4[2 + i] : q4[i]; q2[i] = mine + __shfl_xor(snd, 4); } }
        { const bool hi = lane & 2; const float snd = hi ? q2[0] : q2[1], mine = hi ? q2[1] : q2[0]; q1 = mine + __shfl_xor(snd, 2); }
        q1 += __shfl_xor(q1, 1);
        const int myE = (lane >> 1) & 31;
        float val = q1 + PP(router_b)[layer * NEXP + myE];
        float tv[4]; int te[4];
        { int rank = 0; const int vb = __builtin_bit_cast(int, val);
#pragma unroll
          for (int e2 = 0; e2 < 32; ++e2) { const float o = __builtin_bit_cast(float, __builtin_amdgcn_readlane(vb, 2 * e2)); rank += (o > val || (o == val && e2 < myE)) ? 1 : 0; }
#pragma unroll
          for (int k = 0; k < 4; ++k) { const unsigned long long mk = __ballot(rank == k); const int src = __builtin_amdgcn_readfirstlane((int)__builtin_ctzll(mk));
              tv[k] = __builtin_bit_cast(float, __builtin_amdgcn_readlane(vb, src)); te[k] = (src >> 1) & 31; } }
        const float e1 = __expf(tv[1] - tv[0]), e2 = __expf(tv[2] - tv[0]), e3 = __expf(tv[3] - tv[0]), inv = 1.f / (1.f + e1 + e2 + e3);
        if (lane == 0) {
            *(f32x4*)(F_TOPW + (size_t)row * 4) = (f32x4){inv, e1 * inv, e2 * inv, e3 * inv};
#pragma unroll
            for (int k = 0; k < 4; ++k) { selE[slot * 4 + k] = te[k]; selR[slot * 4 + k] = atomicAdd((int*)(cntL + te[k]), 1); }
        }
        CV_STORE(cvv, cv_u0, cv_end);
    }
    for (; cv_u < cv_end; cv_u += 8) { f32x4 cvv[8]; CV_LOAD(cvv, cv_u); CV_STORE(cvv, cv_u, cv_end); }
#undef CV_LOAD
#undef CV_STORE
    __syncthreads();
    if (F.tid < 32) { const int c = cntL[F.tid]; baseL[F.tid] = c ? (int)atomicAdd(F_cnt + layer * 32 + F.tid, (unsigned)c) : 0; }
    __syncthreads();
    if (F.tid < 384) { const int s = F.tid >> 2, k = F.tid & 3; const int row = F.bid * 8 + (s & 7) + (s >> 3) * NGW;
        if (row < nrows) { const int e = selE[F.tid], pos = baseL[e] + selR[F.tid]; F_POS[(size_t)row * 4 + k] = e | (pos << 8); F_LIST[(size_t)e * NTOK + pos] = row; } }
    __syncthreads();
}

struct MoeLds { LAS int *mtp, *roff, *mtq, *nz; };
__device__ __forceinline__ MoeLds moe_lds(Frame& F) { MoeLds L; L.mtp = (LAS int*)(F.lds + 2 * STAGE_B); L.roff = L.mtp + 40; L.mtq = L.roff + 40; L.nz = L.mtq + 40; return L; }
__device__ __forceinline__ void moe_prefix(Frame& F, const int layer, const MoeLds& L) {
    if (F.tid < 64) { const int e = F.lane & 31; const int c = (int)__hip_atomic_load(F_cnt + layer * 32 + e, __ATOMIC_RELAXED, __HIP_MEMORY_SCOPE_AGENT);
        const int mt = (c + 255) >> 8; int a = mt, b = c, q = mt > 0 ? mt - 1 : 0, z = mt > 0 ? 1 : 0;
#pragma unroll
        for (int o = 1; o < 32; o <<= 1) { const int ua = __shfl_up(a, o, 32), ub = __shfl_up(b, o, 32), uq = __shfl_up(q, o, 32), uz = __shfl_up(z, o, 32); if (e >= o) { a += ua; b += ub; q += uq; z += uz; } }
        if (F.lane < 32) { L.mtp[e + 1] = a; L.roff[e + 1] = b; L.mtq[e + 1] = q; if (mt > 0) L.nz[z - 1] = e; if (e == 31) L.nz[32] = z; if (e == 0) { L.mtp[0] = 0; L.roff[0] = 0; L.mtq[0] = 0; } } }
    __syncthreads();
}
struct PolMoe : PolBase {
    const float* W; MoeLds L; int layer, nct, round; size_t bc_off;
    __device__ __forceinline__ bool find(int i, int& e, int& ct, int& rbase, int& ro, int& cnt) const { int T; if (!tileL(i, T)) return false;
        if (round == 0) { const int q = T / nct; ct = T - q * nct; e = __builtin_amdgcn_readfirstlane(L.nz[q]); rbase = 0; }
        else { LAS int* pf = round == 1 ? L.mtq : L.mtp; e = 0; while (pf[e + 1] * nct <= T) ++e;
            e = __builtin_amdgcn_readfirstlane(e);
            const int mq = __builtin_amdgcn_readfirstlane(pf[e + 1] - pf[e]), w = T - __builtin_amdgcn_readfirstlane(pf[e]) * nct; ct = w / mq; rbase = ((round == 1 ? 1 : 0) + w - ct * mq) * 256; }
        ro = __builtin_amdgcn_readfirstlane(L.roff[e]); cnt = __builtin_amdgcn_readfirstlane(L.roff[e + 1]) - ro; return true; }
    __device__ __forceinline__ bf16_t* panel(int e, int ct) const { return (bf16_t*)(ws + bc_off) + (size_t)(e * nct + ct) * (1024 * 256); }
};
struct PolMoe1 : PolMoe {
    __device__ __forceinline__ unsigned list_voff(const TD& td) const { return 4u * (unsigned)(td.i0 * NTOK + td.i2 + lane * 4); }
    __device__ __forceinline__ void late(TD& td, const LAS int* ll) const { const int cl = td.i4 - 1 - td.i2;
#pragma unroll
        for (int i2 = 0; i2 < 2; ++i2) { int rl = prow(i2); rl = rl < cl ? rl : cl; td.aoff[i2] = (unsigned)((ll[rl] * D + pcol()) * 2); } }
    __device__ __forceinline__ unsigned bias_voff(const TD& td) const { return 4u * (unsigned)((layer * NEXP + td.i0) * (2 * DFF) + (lane >> 5) * DFF + td.i1 * 128 + (lane & 31) * 4); }
    __device__ __forceinline__ bool get(int i, TD& td) const { int e, ct, rbase, ro, cnt; if (!find(i, e, ct, rbase, ro, cnt)) return false;
        const int* list = (const int*)(ws + WS_LIST) + (size_t)e * NTOK; td.A = (const bf16_t*)(ws + WS_H);
        if (!has_list || i == 0) {
#pragma unroll
            for (int i2 = 0; i2 < 4; ++i2) { int rr = rbase + prow(i2); rr = rr < cnt ? rr : cnt - 1; td.aoff[i2] = (unsigned)((list[rr] * D + pcol()) * 2); } }
        if (round == 0) { td.B = W + ((size_t)(layer * NEXP + e) * D + wid * 8) * (2 * DFF) + ct * 128; td.ldb = 2 * DFF; td.bco = panel(e, ct); } else { td.B = panel(e, ct); td.bco = nullptr; }
        td.i0 = e; td.i1 = ct; td.i2 = rbase; td.i3 = ro; td.i4 = cnt; return true; }
    __device__ __forceinline__ void epi(f32x4 (&acc)[8][4], const TD& td, const LAS float* bl) const { (void)bl; EPI_GEOM; const int e = td.i0, ct = td.i1, rbase = td.i2, ro = td.i3, cnt = td.i4;
        bf16_t* ACT = (bf16_t*)(ws + WS_ACT);
#pragma unroll
        for (int n = 0; n < 2; ++n) { const int gc = ct * 128 + wc * 32 + n * 16 + 4 * fq;
            const int gl = wc * 32 + n * 16 + 4 * fq; const f32x4 bg = bl ? *(const LAS f32x4*)(bl + gl) : *(const f32x4*)(bias + (size_t)(layer * NEXP + e) * (2 * DFF) + gc), bu = bl ? *(const LAS f32x4*)(bl + 128 + gl) : *(const f32x4*)(bias + (size_t)(layer * NEXP + e) * (2 * DFF) + DFF + gc);
#pragma unroll
            for (int m = 0; m < 8; ++m) { const int r = rbase + wr * 128 + m * 16 + fr; float a[4];
#pragma unroll
                for (int j = 0; j < 4; ++j) { const float gg = fminf(acc[m][n][j] + bg[j], 7.f), uu = __builtin_amdgcn_fmed3f(acc[m][n + 2][j] + bu[j], -7.f, 7.f);
                    a[j] = (uu + 1.f) * gg * __builtin_amdgcn_rcpf(1.f + fexp2(-1.702f * LOG2E * gg)); }
                if (r < cnt) { u32x2 w; w.x = pk2(a[0], a[1]); w.y = pk2(a[2], a[3]); *(u32x2*)(ACT + (size_t)(ro + r) * DFF + gc) = w; } } } }
};
struct PolMoe2 : PolMoe {
    __device__ __forceinline__ unsigned bias_voff(const TD& td) const { return 4u * (unsigned)((layer * NEXP + td.i0) * D + td.i1 * 256 + lane * 4); }
    __device__ __forceinline__ bool get(int i, TD& td) const { int e, ct, rbase, ro, cnt; if (!find(i, e, ct, rbase, ro, cnt)) return false;
        td.A = (const bf16_t*)(ws + WS_ACT);
#pragma unroll
        for (int i2 = 0; i2 < 4; ++i2) { int rr = rbase + prow(i2); rr = rr < cnt ? rr : cnt - 1; td.aoff[i2] = (unsigned)(((ro + rr) * DFF + pcol()) * 2); }
        td.B = panel(e, ct); td.bco = nullptr;
        td.i0 = e; td.i1 = ct; td.i2 = rbase; td.i3 = ro; td.i4 = cnt; return true; }
    __device__ __forceinline__ void epi(f32x4 (&acc)[8][4], const TD& td, const LAS float* bl) const { (void)bl; EPI_GEOM; const int e = td.i0, ct = td.i1, rbase = td.i2, ro = td.i3, cnt = td.i4;
        bf16_t* Y = (bf16_t*)(ws + WS_Y);
#pragma unroll
        for (int n = 0; n < 4; ++n) { const int c = ct * 256 + wc * 64 + n * 16 + 4 * fq; const f32x4 bv = bl ? *(const LAS f32x4*)(bl + wc * 64 + n * 16 + 4 * fq) : *(const f32x4*)(bias + (size_t)(layer * NEXP + e) * D + c);
#pragma unroll
            for (int m = 0; m < 8; ++m) { const int r = rbase + wr * 128 + m * 16 + fr;
                if (r < cnt) { u32x2 w; w.x = pk2(acc[m][n][0] + bv[0], acc[m][n][1] + bv[1]); w.y = pk2(acc[m][n][2] + bv[2], acc[m][n][3] + bv[3]); *(u32x2*)(Y + (size_t)(ro + r) * D + c) = w; } } } }
};
__device__ __forceinline__ void phase_moe1(Frame& F, const XcdBarrier& bar, const bool use_bar, const int layer) {
    const MoeLds L = moe_lds(F);
    moe_prefix(F, layer, L);
    const int ne = __builtin_amdgcn_readfirstlane(L.nz[32]), tq = __builtin_amdgcn_readfirstlane(L.mtq[32]);
    const float* W = PP(moe_w_gu); const float* bias = PP(moe_b_gu);
    { PolMoe1 P; P.L = L; P.layer = layer; P.nct = 8; P.round = 0; P.bc_off = WS_BC; P.base_init(F, D / 64, ne * 8); P.bfm = false; P.W = W; P.bias = bias;
      { const int l2 = F.lane & 31; P.lcolb = 4u * (unsigned)((F.lane >> 5) * DFF + 4 * l2); P.woff = 2u * (unsigned)(((4 * l2) >> 5) * 64 + (F.lane >> 5) * 32 + ((4 * l2) & 31)); }
      gemm_stream(F.lds, P, F.wid, F.lane); }
    if (use_bar) xcd_barrier(bar);
    { PolMoe1 P; P.L = L; P.layer = layer; P.nct = 8; P.round = 1; P.bc_off = WS_BC; P.base_init(F, D / 64, tq * 8); P.ldbB = 256; P.W = W; P.bias = bias; P.has_bias = true; P.has_list = true; P.listp = (const int*)(F.ws + WS_LIST);
      gemm_stream_bf(F.lds, P, F.wid, F.lane); }
}
__device__ __forceinline__ void phase_moe2(Frame& F, const int layer) {
    const MoeLds L = moe_lds(F);
    moe_prefix(F, layer, L);
    PolMoe2 P; P.L = L; P.layer = layer; P.nct = 4; P.round = 2; P.bc_off = WS_BC2; P.base_init(F, DFF / 64, __builtin_amdgcn_readfirstlane(L.mtp[32]) * 4); P.ldbB = 256; P.W = nullptr; P.bias = PP(moe_b_dn); P.has_bias = true;
    gemm_stream_bf(F.lds, P, F.wid, F.lane);
}

__device__ __forceinline__ void phase_combine(Frame& F, const int layer) {
    const MoeLds ML = moe_lds(F); LAS int* roff = ML.roff;
    moe_prefix(F, layer, ML);
    const int nrows = layer == 0 ? NTOK : NMAIN, lane = F.lane;
    const int gw = F.bid * 8 + F.wid, NGW = F.G * 8;
    i32x4 ps_n = (i32x4){0, 0, 0, 0}; f32x4 tw_n = (f32x4){0.f, 0.f, 0.f, 0.f}, tw_c = tw_n;
    u32x2 y_c[4][4], y_n[4][4]; f32x4 xs_c[4], xs_n[4];
#define CMB_IDX(row_) do { if ((row_) < nrows) { ps_n = *(const i32x4*)(F_POS + (size_t)(row_) * 4); tw_n = *(const f32x4*)(F_TOPW + (size_t)(row_) * 4); } } while (0)
#define CMB_DATA(row_, Y_, XS_) do { if ((row_) < nrows) { \
        _Pragma("unroll") for (int k = 0; k < 4; ++k) { const int e = ps_n[k] & 255, pos = ps_n[k] >> 8; const bf16_t* y = F_Y + (size_t)(roff[e] + pos) * D; \
            _Pragma("unroll") for (int j = 0; j < 4; ++j) Y_[k][j] = *(const u32x2*)(y + 4 * lane + 256 * j); } \
        _Pragma("unroll") for (int j = 0; j < 4; ++j) XS_[j] = *(const f32x4*)(F_XS + (size_t)(row_) * D + 4 * lane + 256 * j); } } while (0)
    CMB_IDX(gw); CMB_DATA(gw, y_c, xs_c); tw_c = tw_n; CMB_IDX(gw + NGW);
    for (int row = gw; row < nrows; row += NGW) {
        CMB_DATA(row + NGW, y_n, xs_n); const f32x4 tw_nn = tw_n; CMB_IDX(row + 2 * NGW);
        const int r = mod_row(row); const float* g2 = modp(F, layer, r, 5);
        f32x4 v[4];
#pragma unroll
        for (int j = 0; j < 4; ++j) v[j] = (f32x4){0.f, 0.f, 0.f, 0.f};
#pragma unroll
        for (int k = 0; k < 4; ++k) { const float w = tw_c[k];
#pragma unroll
            for (int j = 0; j < 4; ++j) { const u32x2 u = y_c[k][j]; v[j][0] += w * bflo(u.x); v[j][1] += w * bfhi(u.x); v[j][2] += w * bflo(u.y); v[j][3] += w * bfhi(u.y); } }
#pragma unroll
        for (int j = 0; j < 4; ++j) { const int c = 4 * lane + 256 * j; const f32x4 gv = *(const f32x4*)(g2 + c); v[j] = xs_c[j] + gv * v[j]; }
        const float rstd = row_rstd(v);
        if (layer == 0) {
#pragma unroll
            for (int j = 0; j < 4; ++j) *(f32x4*)(F_XS + (size_t)row * D + 4 * lane + 256 * j) = v[j];
            norm_mod_store(v, rstd, PP(norm_mix) + D, modp(F, 1, r, 1), modp(F, 1, r, 0), F_H + (size_t)row * D, lane);
        } else {
#pragma unroll
            for (int j = 0; j < 4; ++j) { const int c = 4 * lane + 256 * j; const f32x4 g = *(const f32x4*)(PP(final_norm) + c); *(f32x4*)(((float*)ldp(F, (int)__builtin_offsetof(Params, out))) + (size_t)row * D + c) = v[j] * rstd * g; }
        }
        tw_c = tw_nn;
#pragma unroll
        for (int k = 0; k < 4; ++k)
#pragma unroll
            for (int j = 0; j < 4; ++j) y_c[k][j] = y_n[k][j];
#pragma unroll
        for (int j = 0; j < 4; ++j) xs_c[j] = xs_n[j];
        __builtin_amdgcn_sched_barrier(0);
    }
#undef CMB_IDX
#undef CMB_DATA
}

struct PolInproj1 : PolBase {
    const float* W;
    __device__ __forceinline__ bool get(int i, TD& td) const { int t; if (!tileL(i, t)) return false; constexpr int N_MAIN_T = (NMAIN / 256) * 10; int pm, pn;
        if (t < N_MAIN_T) dense_tile(t, NMAIN / 256, 10, pm, pn); else { const int c = t - N_MAIN_T; pm = NMAIN / 256 + (c & 3); pn = 2 + (c >> 2); }
        td.A = (const bf16_t*)(ws + WS_H); dense_aoff(td, pm * 256, D);
        td.B = (const bf16_t*)(ws + WB_OIN) + pn * 256; td.i0 = pm; td.i1 = pn; return true; }
    __device__ __forceinline__ void epi(f32x4 (&acc)[8][4], const TD& td, const LAS float* bl) const { (void)bl; EPI_GEOM; const int pm = td.i0, pn = td.i1;
        if (pn < 6) { bf16_t* PROJ = (bf16_t*)(ws + WS_PROJ);
#pragma unroll
            for (int m = 0; m < 8; ++m) { const int row = pm * 256 + wr * 128 + m * 16 + fr;
#pragma unroll
                for (int n = 0; n < 4; ++n) { u32x2 w; w.x = pk2(acc[m][n][0], acc[m][n][1]); w.y = pk2(acc[m][n][2], acc[m][n][3]);
                    *(u32x2*)(PROJ + (size_t)row * QKV_LD + pn * 256 + wc * 64 + n * 16 + 4 * fq) = w; } }
        } else { const int g = pn - 6, ri = wc >> 1; bf16_t* Z = (bf16_t*)(ws + WS_Z);
#pragma unroll
            for (int m = 0; m < 8; ++m) { const int row = pm * 256 + wr * 128 + m * 16 + fr, b = row >> 12, n1 = (row >> 6) & 63, n2 = row & 63;
                bf16_t* zb = Z + ((((size_t)(b * 64 + n1) * 2 + ri) * 64 + n2) * 512) + g * 128 + (wc & 1) * 64;
#pragma unroll
                for (int n = 0; n < 4; ++n) { u32x2 w; w.x = pk2(acc[m][n][0], acc[m][n][1]); w.y = pk2(acc[m][n][2], acc[m][n][3]); *(u32x2*)(zb + n * 16 + 4 * fq) = w; } } } }
};
__device__ __forceinline__ void phase_inproj_l1(Frame& F) {
    PolInproj1 P; P.base_init(F, D / 64, (NMAIN / 256) * 10 + (NCTX / 256) * 4); P.ldbB = 2560;
    gemm_stream_bf(F.lds, P, F.wid, F.lane);
}

struct PolFour : PolBase {
    int stage;
    __device__ __forceinline__ bool get(int i, TD& td) const { int L; if (!tileL(i, L)) return false; const int b = L >> 7, ct = L & 127;
        td.A = (const bf16_t*)(ws + (stage == 1 ? WS_M1 : WS_M2)); dense_aoff(td, 0, 128);
        td.B = (const bf16_t*)(ws + (stage == 1 ? WS_Z : WS_A1)) + (size_t)b * 128 * 32768 + ct * 256; td.i0 = b; td.i1 = ct; return true; }
    __device__ __forceinline__ void epi(f32x4 (&acc)[8][4], const TD& td, const LAS float* bl) const { (void)bl; EPI_GEOM; const int b = td.i0, ct = td.i1;
        if (wr != 0) return;
        if (stage == 1) { const f32x2* TW = (const f32x2*)(ws + WS_TW); bf16_t* A1 = (bf16_t*)(ws + WS_A1);
#pragma unroll
            for (int m = 0; m < 4; ++m) { const int k1 = m * 16 + fr;
#pragma unroll
                for (int n = 0; n < 4; ++n) { const int col = ct * 256 + wc * 64 + n * 16 + 4 * fq, n2 = col >> 9, c = col & 511;
                    const f32x2 tw = TW[n2 * k1]; const f32x4 re = acc[m][n], im = acc[m + 4][n];
                    const f32x4 ore = re * tw.x + im * tw.y, oim = im * tw.x - re * tw.y; u32x2 w0, w1;
                    w0.x = pk2(ore[0], ore[1]); w0.y = pk2(ore[2], ore[3]); w1.x = pk2(oim[0], oim[1]); w1.y = pk2(oim[2], oim[3]);
                    *(u32x2*)(A1 + ((((size_t)(b * 2 + 0) * 64 + n2) * 64 + k1) * 512) + c) = w0;
                    *(u32x2*)(A1 + ((((size_t)(b * 2 + 1) * 64 + n2) * 64 + k1) * 512) + c) = w1; } }
        } else { const float scl = 1.f / 724.0773439350247f; bf16_t* MIX = (bf16_t*)(ws + WS_MIX);
#pragma unroll
            for (int m = 0; m < 4; ++m) { const int k2 = m * 16 + fr;
#pragma unroll
                for (int n = 0; n < 4; ++n) { const int col = ct * 256 + wc * 64 + n * 16 + 4 * fq, k1 = col >> 9, c = col & 511;
                    const f32x4 o = acc[m][n] * scl; u32x2 w; w.x = pk2(o[0], o[1]); w.y = pk2(o[2], o[3]);
                    *(u32x2*)(MIX + (size_t)(b * SEQ + k1 + 64 * k2) * D + 512 + c) = w; } } } }
};

__device__ __forceinline__ void phase_attn_l1(Frame& F) {
    const int wid = F.wid, lane = F.lane, fr = lane & 15, fq = lane >> 4;
    constexpr int N_NA = NB * 64, N_F1 = NB * 128;
    const float SC = 0.125f * LOG2E;
    for (int it = F.bid; it < N_NA; it += F.G) {
            LAS unsigned char* vl = F.lds + wid * 8192;
            LAS float* rp = (LAS float*)(vl + 5120);
            const int b = it >> 6, r = it & 63, h = wid;
            for (int i = lane; i < 465; i += 64) rp[i] = PP(odd_rpb)[h * 465 + i] * LOG2E;
            for (int qh = 0; qh < 4 / QT; ++qh) {
            const int qc0 = qh * (16 * QT), qrow0 = b * SEQ + r * 64 + qc0;
            bf16x8 qf[QT][2];
#pragma unroll
            for (int qt = 0; qt < QT; ++qt)
#pragma unroll
                for (int ks = 0; ks < 2; ++ks) qf[qt][ks] = *(const bf16x8*)(F_PROJ + (size_t)(qrow0 + qt * 16 + fr) * QKV_LD + h * 64 + ks * 32 + 8 * fq);
            AttnSt st;
#pragma unroll
            for (int qt = 0; qt < QT; ++qt) { st.m[qt] = -1e30f; st.l[qt] = 0.f;
#pragma unroll
                for (int dt = 0; dt < 4; ++dt) st.o[dt][qt] = (f32x4){0.f, 0.f, 0.f, 0.f}; }
            const int r0 = min(max(r - 4, 0), 56);
            int c0q[QT];
#pragma unroll
            for (int qt = 0; qt < QT; ++qt) c0q[qt] = min(max(qc0 + qt * 16 + fr - 8, 0), 48);
            for (int s = 0; s < 16; ++s) {
                const int kr = r0 + (s >> 1), half = s & 1;
                const bf16_t* kp = F_PROJ + (size_t)(b * SEQ + kr * 64 + half * 32) * QKV_LD + 512 + h * 64;
                const bf16_t* vp = kp + 512;
                const LAS float* rpr = rp + (kr - r + 7) * 31 + 15;
#define BIAS_NA(qt, kt, j) ({ const int kc = half * 32 + kt * 16 + 4 * fq + j; const int dc = kc - (qc0 + qt * 16 + fr); (kc >= c0q[qt] && kc < c0q[qt] + 16) ? rpr[dc] : -INFINITY; })
                ATTN_STEP(kp, QKV_LD, vp, QKV_LD, SC, BIAS_NA);
            }
            for (int s = 0; s < 8; ++s) {
                const bf16_t* kp = F_PROJ + (size_t)(NMAIN + b * CTXL + s * 32) * QKV_LD + 512 + h * 64;
                const bf16_t* vp = kp + 512;
                ATTN_STEP(kp, QKV_LD, vp, QKV_LD, SC, BIAS_NONE);
            }
            attn_store(st, F_MIX + (size_t)qrow0 * D + h * 64, D, fr, fq);
            }
    }
    __syncthreads();
    PolFour P; P.stage = 1; P.base_init(F, 2, N_F1); P.ldbB = 32768;
    gemm_stream_bf(F.lds, P, F.wid, F.lane);
}

__device__ __forceinline__ void phase_fst2(Frame& F) {
    PolFour P; P.stage = 2; P.base_init(F, 2, NB * 128); P.ldbB = 32768;
    gemm_stream_bf(F.lds, P, F.wid, F.lane);
}

__global__ void __launch_bounds__(512, 2) fwd_kernel(Params p) {
    extern __shared__ __attribute__((aligned(16))) unsigned char lds_raw[];
    Frame F;
    F.lds = (LAS unsigned char*)lds_raw;
    F.tid = threadIdx.x; F.lane = F.tid & 63; F.wid = __builtin_amdgcn_readfirstlane(F.tid >> 6); F.bid = blockIdx.x; F.G = gridDim.x;
    unsigned char* ws = p.ws; F.ws = ws;
    volatile LAS unsigned* MISC = (volatile LAS unsigned*)(F.lds + MISC_OFF);
    if (F.tid < 64) MISC[F.tid] = 0u;
    if (F.tid == 64) { LAS unsigned long long* LP = (LAS unsigned long long*)(F.lds + PARAM_OFF);
        LP[0] = (unsigned long long)p.x; LP[1] = (unsigned long long)p.c; LP[2] = (unsigned long long)p.ctx; LP[3] = (unsigned long long)p.c_ctx; LP[4] = (unsigned long long)p.ada_w; LP[5] = (unsigned long long)p.ada_b;
        LP[6] = (unsigned long long)p.norm_mix; LP[7] = (unsigned long long)p.norm_ffn; LP[8] = (unsigned long long)p.even_w_in; LP[9] = (unsigned long long)p.even_w_out; LP[10] = (unsigned long long)p.even_conv_w;
        LP[11] = (unsigned long long)p.even_sink; LP[12] = (unsigned long long)p.odd_w_in; LP[13] = (unsigned long long)p.odd_w_out; LP[14] = (unsigned long long)p.odd_rpb; LP[15] = (unsigned long long)p.router_w;
        LP[16] = (unsigned long long)p.router_b; LP[17] = (unsigned long long)p.moe_w_gu; LP[18] = (unsigned long long)p.moe_b_gu; LP[19] = (unsigned long long)p.moe_w_dn; LP[20] = (unsigned long long)p.moe_b_dn;
        LP[21] = (unsigned long long)p.final_norm; LP[22] = (unsigned long long)p.out; }
    __syncthreads();
    const int lo = p.ph_lo, hi = p.ph_hi;
    XcdBarrier bar; bar.bar = (unsigned*)(ws + WS_CTL) + CW_BAR; bar.x = 0; bar.st = MISC + 8;
    if (hi - lo > 1) bar = xcd_barrier_post((unsigned*)(ws + WS_CTL) + CW_BAR, MISC + 8);
#define RUN_PHASE(ph, call) do { if (PH_ON(ph) && lo <= (ph) && (ph) < hi) { call; if (PH_REP(ph)) { xcd_barrier(bar); call; } } if (lo <= (ph) && (ph) + 1 < hi) xcd_barrier(bar); } while (0)
    RUN_PHASE(PH_PREP, phase_prep(F));
    RUN_PHASE(PH_NORM1_0, phase_norm1_l0(F));
    RUN_PHASE(PH_INPROJ_0, phase_inproj_l0(F));
    RUN_PHASE(PH_ATTN_0, phase_attn_l0(F));
    RUN_PHASE(PH_OUTPROJ_0, phase_outproj(F, 0));
    RUN_PHASE(PH_ROUTE_0, phase_route(F, 0));
    RUN_PHASE(PH_MOE1_0, phase_moe1(F, bar, hi - lo > 1, 0));
    RUN_PHASE(PH_MOE2_0, phase_moe2(F, 0));
    RUN_PHASE(PH_COMB_0, phase_combine(F, 0));
    RUN_PHASE(PH_INPROJ_1, phase_inproj_l1(F));
    RUN_PHASE(PH_ATTN_1, phase_attn_l1(F));
    RUN_PHASE(PH_FST2_1, phase_fst2(F));
    RUN_PHASE(PH_OUTPROJ_1, phase_outproj(F, 1));
    RUN_PHASE(PH_ROUTE_1, phase_route(F, 1));
    RUN_PHASE(PH_MOE1_1, phase_moe1(F, bar, hi - lo > 1, 1));
    RUN_PHASE(PH_MOE2_1, phase_moe2(F, 1));
    RUN_PHASE(PH_FINAL, phase_combine(F, 1));
}

extern "C" void kernel_launch(void* const* d_in, const int* in_sizes, int n_in, void* d_out, int out_size, void* d_ws, size_t ws_size, hipStream_t stream) {
    static int grid = 0;
    if (grid == 0) {
        if (n_in != 22 || ws_size < WS_END) { fprintf(stderr, "kernel_launch: unexpected inputs (n_in %d, ws %zu)\n", n_in, ws_size); grid = -1; return; }
        int dev = 0, cus = 0, per_cu = 0;
        hipGetDevice(&dev);
        hipDeviceGetAttribute(&cus, hipDeviceAttributeMultiprocessorCount, dev);
        hipFuncSetAttribute((const void*)fwd_kernel, hipFuncAttributeMaxDynamicSharedMemorySize, LDS_BYTES);
        hipOccupancyMaxActiveBlocksPerMultiprocessor(&per_cu, (const void*)fwd_kernel, 512, LDS_BYTES);
        if (per_cu < 1) { fprintf(stderr, "kernel_launch: occupancy query says %d blocks/CU\n", per_cu); per_cu = 1; }
        (void)hipGetLastError();
        grid = cus;
    }
    if (grid < 0) return;
    hipMemsetAsync((char*)d_ws + WS_CTL, 0, CTL_BYTES, stream);
    Params p{};
    const float** pp = (const float**)&p;
    for (int i = 0; i < 22; ++i) pp[i] = (const float*)d_in[i];
    p.out = (float*)d_out; p.ws = (unsigned char*)d_ws;
#if N_LAUNCH_MODE == 1
    for (int ph = 0; ph < NPHASE; ++ph) { p.ph_lo = ph; p.ph_hi = ph + 1; hipLaunchKernelGGL(fwd_kernel, dim3(grid), dim3(512), LDS_BYTES, stream, p); }
#else
    p.ph_lo = 0; p.ph_hi = NPHASE;
    void* args[] = {&p};
    hipError_t e = hipLaunchCooperativeKernel((const void*)fwd_kernel, dim3(grid), dim3(512), args, LDS_BYTES, stream);
    if (e != hipSuccess) fprintf(stderr, "kernel_launch: cooperative launch failed: %s (grid %d)\n", hipGetErrorString(e), grid);
#endif
}
```

```cpp
#include <hip/hip_runtime.h>
#include <cstdio>
#include <cstdint>

#ifndef N_LAUNCH_MODE
#define N_LAUNCH_MODE 0
#endif

#ifndef PHASE_MASK
#define PHASE_MASK 0x1FFFF
#endif
#define PH_ON(ph) ((PHASE_MASK >> (ph)) & 1)
#ifndef REPEAT_MASK
#define REPEAT_MASK 0
#endif
#define PH_REP(ph) ((REPEAT_MASK >> (ph)) & 1)
#define LAS __attribute__((address_space(3)))
#define GAS __attribute__((address_space(1)))
typedef unsigned short bf16_t;
typedef short bf16x8 __attribute__((ext_vector_type(8)));
typedef short s16x4 __attribute__((ext_vector_type(4)));
typedef float f32x4 __attribute__((ext_vector_type(4)));
typedef float f32x2 __attribute__((ext_vector_type(2)));
typedef int i32x4 __attribute__((ext_vector_type(4)));
typedef unsigned u32x2 __attribute__((ext_vector_type(2)));
typedef unsigned u32x4 __attribute__((ext_vector_type(4)));

constexpr int D = 1024, NB = 4, SEQ = 4096, CTXL = 256;
constexpr int NMAIN = NB * SEQ, NCTX = NB * CTXL, NTOK = NMAIN + NCTX;
constexpr int EVEN_IN = 2304, NEXP = 32, DFF = 1024;
constexpr int QKV_LD = 1536;
constexpr float NORM_EPS = 1e-6f;
constexpr float LOG2E = 1.4426950408889634f;

constexpr size_t MiB = 1ull << 20;
constexpr size_t WS_CTL = 0, CTL_BYTES = 1 * MiB;
constexpr size_t WS_MOD = 1 * MiB;
constexpr size_t WS_M1 = 2 * MiB;
constexpr size_t WS_M2 = WS_M1 + 65536;
constexpr size_t WS_ROPE = WS_M2 + 65536;
constexpr size_t WS_TW = WS_ROPE + 8192;
constexpr size_t WS_WF = 4 * MiB;
constexpr size_t WS_TOPW = 8 * MiB;
constexpr size_t WS_POS = 9 * MiB;
constexpr size_t WS_LIST = 12 * MiB;
constexpr size_t WS_H = 16 * MiB;
constexpr size_t WS_MIX = 52 * MiB;
constexpr size_t WS_XS = 88 * MiB;
constexpr size_t WS_PROJ = 160 * MiB;
constexpr size_t WS_Z = 240 * MiB;
constexpr size_t WS_A1 = 304 * MiB;
constexpr size_t WS_ACT = 368 * MiB;
constexpr size_t WS_Y = 512 * MiB;
constexpr size_t WS_WB = 656 * MiB;
constexpr size_t WB_EIN = WS_WB, WB_EOUT = WB_EIN + (size_t)D * EVEN_IN * 2, WB_OIN = WB_EOUT + (size_t)D * D * 2, WB_OOUT = WB_OIN + (size_t)D * 2560 * 2;
constexpr size_t WS_BC = 672 * MiB;
constexpr size_t WS_BC2 = WS_BC + 128 * MiB;
constexpr size_t WS_END = 864 * MiB;
constexpr int CW_BAR = 4096;
constexpr int CW_CNT = 8192;

constexpr int LDS_BYTES = 147456;
constexpr int PARAM_OFF = LDS_BYTES - 512;
constexpr int MISC_OFF = LDS_BYTES - 256;
constexpr int A_TILE_B = 32768, B_ROWB = 544, B_TILE_B = 64 * B_ROWB, STAGE_B = A_TILE_B + B_TILE_B;
static_assert(2 * STAGE_B + 1024 + 8192 <= PARAM_OFF, "LDS");

enum { PH_PREP = 0, PH_NORM1_0, PH_INPROJ_0, PH_ATTN_0, PH_OUTPROJ_0, PH_ROUTE_0, PH_MOE1_0, PH_MOE2_0, PH_COMB_0,
       PH_INPROJ_1, PH_ATTN_1, PH_FST2_1, PH_OUTPROJ_1, PH_ROUTE_1, PH_MOE1_1, PH_MOE2_1, PH_FINAL, NPHASE };

struct Params {
    const float *x, *c, *ctx, *c_ctx, *ada_w, *ada_b, *norm_mix, *norm_ffn, *even_w_in, *even_w_out, *even_conv_w, *even_sink,
                *odd_w_in, *odd_w_out, *odd_rpb, *router_w, *router_b, *moe_w_gu, *moe_b_gu, *moe_w_dn, *moe_b_dn, *final_norm;
    float* out; unsigned char* ws; int ph_lo, ph_hi;
};

__device__ __forceinline__ unsigned pk2(float lo, float hi) { unsigned r; asm("v_cvt_pk_bf16_f32 %0, %1, %2" : "=v"(r) : "v"(lo), "v"(hi)); return r; }
__device__ __forceinline__ float bflo(unsigned u) { return __builtin_bit_cast(float, u << 16); }
__device__ __forceinline__ float bfhi(unsigned u) { return __builtin_bit_cast(float, u & 0xffff0000u); }
__device__ __forceinline__ float wave_sum(float v) {
#pragma unroll
    for (int o = 1; o < 64; o <<= 1) v += __shfl_xor(v, o);
    return v;
}
__device__ __forceinline__ float fexp2(float x) { return __builtin_amdgcn_exp2f(x); }

#define XB_TMO      128
#define XB_XCNT(j)  (256  + 64 * (j))
#define XB_XSUB(j)  (1280 + 64 * (j))
#define XB_XGEN(j)  (2304 + 64 * (j))
#define XB_TOP      3328
#define XB_TOPGEN   3392
#define XB_SPIN_CAP (1u << 22)
__device__ __forceinline__ unsigned xb_ld(unsigned* p)              { return __hip_atomic_load(p, __ATOMIC_RELAXED, __HIP_MEMORY_SCOPE_AGENT); }
__device__ __forceinline__ unsigned xb_add(unsigned* p, unsigned v) { return __hip_atomic_fetch_add(p, v, __ATOMIC_RELAXED, __HIP_MEMORY_SCOPE_AGENT); }
__device__ __forceinline__ unsigned xb_xcc_id() { return (unsigned)__builtin_amdgcn_s_getreg((3 << 11) | 20) & 0xFu; }
#define XB_SPIN(cond, bar) do { unsigned _sp = 0; while (cond) { __builtin_amdgcn_s_sleep(1); \
    if ((++_sp & 255u) == 0u) { if (xb_ld(&(bar)[XB_TMO])) break; if (_sp > XB_SPIN_CAP) { atomicAdd(&(bar)[XB_TMO], 1u); break; } } } } while (0)
struct XcdBarrier { unsigned* bar; unsigned x; volatile LAS unsigned* st; };
__device__ __forceinline__ XcdBarrier xcd_barrier_post(unsigned* bar, volatile LAS unsigned* st) {
    XcdBarrier b; b.bar = bar; b.x = xb_xcc_id(); b.st = st;
    if (threadIdx.x == 0) (void)xb_add(&bar[XB_XCNT(b.x)], 1u);
    return b;
}
__device__ __forceinline__ void xcd_barrier_complete(unsigned* bar, unsigned x, unsigned& nloc, unsigned& nx) {
    const unsigned G = gridDim.x * gridDim.y * gridDim.z;
    unsigned sum, cnt, mine, sp = 0u;
    for (;;) {
        sum = 0u; cnt = 0u; mine = 0u;
#pragma unroll
        for (unsigned j = 0; j < 16; ++j) { const unsigned c = xb_ld(&bar[XB_XCNT(j)]); sum += c; cnt += (c > 0u) ? 1u : 0u; mine = (j == x) ? c : mine; }
        if (sum == G) break;
        __builtin_amdgcn_s_sleep(1);
        if ((++sp & 255u) == 0u) { if (xb_ld(&bar[XB_TMO])) break; if (sp > XB_SPIN_CAP) { atomicAdd(&bar[XB_TMO], 1u); break; } }
    }
    nloc = mine > 0u ? mine : 1u; nx = cnt > 0u ? cnt : 1u;
}
__device__ __forceinline__ void xcd_barrier(const XcdBarrier& b) {
    asm volatile("s_waitcnt vmcnt(0)" ::: "memory");
    __syncthreads();
    if (threadIdx.x == 0) {
        unsigned* bar = b.bar;
        __builtin_amdgcn_s_waitcnt(0);
        unsigned nloc = b.st[0], nx = b.st[1];
        if (nloc == 0u) { xcd_barrier_complete(bar, b.x, nloc, nx); b.st[0] = nloc; b.st[1] = nx; }
        const unsigned old = xb_add(&bar[XB_XSUB(b.x)], 1u);
        const unsigned gen = old / nloc;
        if (old + 1u == (gen + 1u) * nloc) {
            __builtin_amdgcn_fence(__ATOMIC_RELEASE, "agent");
            asm volatile("s_waitcnt vmcnt(0)" ::: "memory");
            const unsigned og = xb_add(&bar[XB_TOP], 1u);
            const unsigned tg = og / nx;
            if (og + 1u == (tg + 1u) * nx) xb_add(&bar[XB_TOPGEN], 1u);
            else XB_SPIN(xb_ld(&bar[XB_TOPGEN]) == tg, bar);
            __builtin_amdgcn_fence(__ATOMIC_ACQUIRE, "agent");
            xb_add(&bar[XB_XGEN(b.x)], 1u);
            asm volatile("s_waitcnt vmcnt(0)" ::: "memory");
        } else {
            XB_SPIN(xb_ld(&bar[XB_XGEN(b.x)]) == gen, bar);
            __builtin_amdgcn_fence(__ATOMIC_ACQUIRE, "agent");
            asm volatile("s_waitcnt vmcnt(0)" ::: "memory");
        }
    }
    __syncthreads();
}

struct TD { const bf16_t* A; const void* B; bf16_t* bco; unsigned ldb; unsigned aoff[4]; int i0, i1, i2, i3, i4; };
__device__ __forceinline__ int a_piece_row0(int wid, int lane) { const int sb = lane * 16, swz = sb ^ (((sb >> 9) & 1) << 5); return (wid >> 1) * 16 + (swz >> 6); }
__device__ __forceinline__ int a_piece_col(int wid, int lane) { const int sb = lane * 16, swz = sb ^ (((sb >> 9) & 1) << 5); return (wid & 1) * 32 + ((swz & 63) >> 1); }
__device__ __forceinline__ u32x4 make_rsrc(const void* p) { const unsigned long long ab = (unsigned long long)p; u32x4 r; r.x = __builtin_amdgcn_readfirstlane((unsigned)ab); r.y = __builtin_amdgcn_readfirstlane((unsigned)(ab >> 32)) & 0xffffu; r.z = 0x7fffffffu; r.w = 0x00020000u; return r; }

template <class Pol>
__device__ __forceinline__ void gemm_stream(LAS unsigned char* lds, Pol& P, const int wid, const int lane) {
    const int wr = wid >> 2, wc = wid & 3, fr = lane & 15, fq = lane >> 4;
    const unsigned b_w = (unsigned)(A_TILE_B + ((wid >> 2) * 32 + 4 * (wid & 3)) * B_ROWB) + P.woff;
    const unsigned a_r = (unsigned)(wr * 16384 + ((fr * 64 + fq * 16) ^ ((fr >> 3) << 5)));
    const unsigned b_r = (unsigned)(A_TILE_B + (4 * fq + (fr >> 2)) * B_ROWB + (wc * 64 + (fr & 3) * 4) * 2);
    const unsigned ldsa = (unsigned)(__UINTPTR_TYPE__)lds + (unsigned)(wid * 1024);
    const unsigned lcolb = P.lcolb;
    TD cur, nxt;
    if (!P.get(0, cur)) return;
    int nt = P.nt; asm volatile("" : "+s"(nt));
    f32x4 sb[8]; f32x4 acc[8][4];
    u32x4 ra_c = make_rsrc(cur.A), ra_n = ra_c;
    __amdgpu_buffer_rsrc_t rb_c = __builtin_amdgcn_make_buffer_rsrc((void*)cur.B, 0, 0x7fffffff, 0x00020000), rb_n = rb_c;
#define G_GLDS_A(buf, RA, AOFF, kt) do { _Pragma("unroll") for (int i = 0; i < 4; ++i) { unsigned keep_; \
        asm volatile("s_mov_b32 %0, m0\n\ts_mov_b32 m0, %3\n\ts_nop 0\n\tbuffer_load_dwordx4 %1, %2, %4 offen lds\n\ts_mov_b32 m0, %0" \
            : "=&s"(keep_) : "v"(AOFF[i]), "s"(RA), "s"(ldsa + (buf) + (unsigned)(i * 8192)), "s"((unsigned)((kt) * 128)) : "memory"); } } while (0)
#define G_ISSUE_BH(RB, LDB4, kt, h) do { \
        _Pragma("unroll") for (int i = 4 * (h); i < 4 * (h) + 4; ++i) sb[i] = __builtin_bit_cast(f32x4, __builtin_amdgcn_raw_buffer_load_b128(RB, (int)lcolb, (int)(((unsigned)(kt) * 64u + i) * (LDB4)), 0)); \
        __builtin_amdgcn_sched_barrier(0); } while (0)
#define G_WRITE_BH(buf, h, BCO, kt) do { \
        _Pragma("unroll") for (int i = 4 * (h); i < 4 * (h) + 4; ++i) { u32x2 w; w.x = pk2(sb[i][0], sb[i][1]); w.y = pk2(sb[i][2], sb[i][3]); \
            *(LAS u32x2*)(lds + (buf) + b_w + (16 * (i >> 2) + (i & 3)) * B_ROWB) = w; \
            if (BCO) *(u32x2*)((char*)(BCO) + (size_t)((kt) * 64 + wid * 8 + i) * 512 + P.woff) = w; } __builtin_amdgcn_sched_barrier(0); } while (0)
#define G_KSTEP(buf, ks) do { bf16x8 Bf[4]; \
        _Pragma("unroll") for (int n = 0; n < 4; ++n) { \
            const s16x4 lo = __builtin_amdgcn_ds_read_tr16_b64_v4i16((LAS s16x4*)(lds + (buf) + b_r + (ks) * 32 * B_ROWB + n * 32)); \
            const s16x4 hi = __builtin_amdgcn_ds_read_tr16_b64_v4i16((LAS s16x4*)(lds + (buf) + b_r + (ks) * 32 * B_ROWB + 16 * B_ROWB + n * 32)); \
            Bf[n] = (bf16x8){lo[0], lo[1], lo[2], lo[3], hi[0], hi[1], hi[2], hi[3]}; } \
        _Pragma("unroll") for (int mh = 0; mh < 2; ++mh) { bf16x8 At[4]; \
            _Pragma("unroll") for (int m = 0; m < 4; ++m) At[m] = *(const LAS bf16x8*)(lds + (buf) + a_r + (mh * 4 + m) * 2048 + (ks) * 1024); \
            _Pragma("unroll") for (int m = 0; m < 4; ++m) _Pragma("unroll") for (int n = 0; n < 4; ++n) \
                acc[mh * 4 + m][n] = __builtin_amdgcn_mfma_f32_16x16x32_bf16(Bf[n], At[m], acc[mh * 4 + m][n], 0, 0, 0); } \
        __builtin_amdgcn_sched_barrier(0); } while (0)
    { unsigned b0 = 0; asm volatile("" : "+s"(b0));
      const unsigned l4 = cur.ldb * 4u;
      G_GLDS_A(b0, ra_c, cur.aoff, 0); G_ISSUE_BH(rb_c, l4, 0, 0); G_ISSUE_BH(rb_c, l4, 0, 1); G_WRITE_BH(b0, 0, cur.bco, 0); G_WRITE_BH(b0, 1, cur.bco, 0);
      G_ISSUE_BH(rb_c, l4, 1, 0); G_ISSUE_BH(rb_c, l4, 1, 1); }
    asm volatile("s_waitcnt vmcnt(8)" ::: "memory");
    asm volatile("s_waitcnt lgkmcnt(0)" ::: "memory");
    __builtin_amdgcn_s_barrier();
    unsigned par = 0;
    for (int ti = 0;; ++ti) {
        const bool hasn = P.get(ti + 1, nxt);
        if (hasn) { ra_n = make_rsrc(nxt.A); rb_n = __builtin_amdgcn_make_buffer_rsrc((void*)nxt.B, 0, 0x7fffffff, 0x00020000); }
#pragma unroll
        for (int m = 0; m < 8; ++m)
#pragma unroll
            for (int n = 0; n < 4; ++n) acc[m][n] = (f32x4){0.f, 0.f, 0.f, 0.f};
        for (int t = 0; t < nt; ++t) {
            unsigned bc = par * STAGE_B, bn = (par ^ 1u) * STAGE_B; asm volatile("" : "+s"(bc), "+s"(bn));
            const bool c1 = t + 1 < nt, w1 = c1 || hasn, c2 = t + 2 < nt, i2 = c2 || hasn;
            if (w1) { const u32x4 ra = c1 ? ra_c : ra_n; unsigned ao[4];
#pragma unroll
                for (int i = 0; i < 4; ++i) ao[i] = c1 ? cur.aoff[i] : nxt.aoff[i];
                G_GLDS_A(bn, ra, ao, c1 ? t + 1 : 0); }
            G_KSTEP(bc, 0);
            const __amdgpu_buffer_rsrc_t rb = c2 ? rb_c : rb_n; const unsigned l4 = (c2 ? cur.ldb : nxt.ldb) * 4u; const int k2 = c2 ? t + 2 : t + 2 - nt;
            bf16_t* const bco = c1 ? cur.bco : nxt.bco; const int k1 = c1 ? t + 1 : 0;
            if (w1) G_WRITE_BH(bn, 0, bco, k1);
            if (i2) G_ISSUE_BH(rb, l4, k2, 0);
            G_KSTEP(bc, 1);
            if (w1) G_WRITE_BH(bn, 1, bco, k1);
            if (i2) { G_ISSUE_BH(rb, l4, k2, 1); asm volatile("s_waitcnt vmcnt(8)" ::: "memory"); }
            else asm volatile("s_waitcnt vmcnt(0)" ::: "memory");
            asm volatile("s_waitcnt lgkmcnt(0)" ::: "memory");
            __builtin_amdgcn_s_barrier();
            par ^= 1u;
        }
        P.epi(acc, cur, (const LAS float*)nullptr);
        if (!hasn) break;
        cur = nxt; ra_c = ra_n; rb_c = rb_n;
    }
#undef G_GLDS_A
#undef G_ISSUE_BH
#undef G_WRITE_BH
#undef G_KSTEP
}

constexpr int STEP_B = 32768;
constexpr unsigned ROPE_LDS = 2 * STAGE_B + 1024;
constexpr unsigned BIAS_OFF = 4 * STEP_B;
template <class Pol, int ABL = 0>
__device__ __forceinline__ void gemm_stream_bf(LAS unsigned char* lds, Pol& P, const int wid, const int lane) {
    const int wr = wid >> 2, wc = wid & 3, fr = lane & 15, fq = lane >> 4;
    const unsigned a_r = (unsigned)(wr * 8192 + ((fr * 64 + fq * 16) ^ ((fr >> 3) << 5)));
    const int x7 = 4 * (fq & 1) + (fr >> 2);
    unsigned b_r[4];
#pragma unroll
    for (int n = 0; n < 4; ++n) b_r[n] = (unsigned)(16384 + (4 * fq + (fr >> 2)) * 512 + (((wc * 4 + n) ^ x7) * 32) + (fr & 3) * 8);
    const unsigned ldsa = (unsigned)(__UINTPTR_TYPE__)lds + (unsigned)(wid * 2048), ldsb = (unsigned)(__UINTPTR_TYPE__)lds + 16384u + (unsigned)(wid * 2048);
    const unsigned ldb2 = P.ldbB * 2u;
    unsigned boff[2];
#pragma unroll
    for (int j = 0; j < 2; ++j) { const int sl = 4 * wid + 2 * j + (lane >> 5), u = lane & 31, c = (u >> 1) ^ (sl & 7), n = c * 16 + (u & 1) * 8;
        const int k = 8 * ((sl >> 2) & 3) + 4 * (sl >> 4) + (sl & 3); boff[j] = (unsigned)k * ldb2 + (unsigned)n * 2u; }
    TD cur, nxt;
    if (!P.get(0, cur)) return;
    int nt = P.nt * 2; asm volatile("" : "+s"(nt));
    f32x4 acc[8][4];
    u32x4 ra_c = make_rsrc(cur.A), ra_n = ra_c, rb_c = make_rsrc(cur.B), rb_n = rb_c;
#define H_DMA(LDSADDR, RS, VOFF, SOFF) do { unsigned keep_; \
        asm volatile("s_mov_b32 %0, m0\n\ts_mov_b32 m0, %3\n\ts_nop 0\n\tbuffer_load_dwordx4 %1, %2, %4 offen lds\n\ts_mov_b32 m0, %0" \
            : "=&s"(keep_) : "v"(VOFF), "s"(RS), "s"(LDSADDR), "s"(SOFF) : "memory"); } while (0)
#define H_STAGE(sb_, RA, AO0, AO1, RB, st) do { \
        if (!(ABL & 2)) { H_DMA(ldsa + (sb_), RA, AO0, (unsigned)((st) * 64)); H_DMA(ldsa + (sb_) + 1024u, RA, AO1, (unsigned)((st) * 64)); } \
        if (!(ABL & 1)) { H_DMA(ldsb + (sb_), RB, boff[0], (unsigned)(st) * 32u * ldb2); H_DMA(ldsb + (sb_) + 1024u, RB, boff[1], (unsigned)(st) * 32u * ldb2); } } while (0)
#define H_READ(sb_) do { if (!(ABL & 16)) { \
        _Pragma("unroll") for (int n = 0; n < 4; ++n) { \
            const s16x4 lo = __builtin_amdgcn_ds_read_tr16_b64_v4i16((LAS s16x4*)(lds + (sb_) + b_r[n])); \
            const s16x4 hi = __builtin_amdgcn_ds_read_tr16_b64_v4i16((LAS s16x4*)(lds + (sb_) + b_r[n] + 8192)); \
            Bf[n] = (bf16x8){lo[0], lo[1], lo[2], lo[3], hi[0], hi[1], hi[2], hi[3]}; } \
        _Pragma("unroll") for (int m = 0; m < 8; ++m) At[m] = *(const LAS bf16x8*)(lds + (sb_) + a_r + m * 1024); } } while (0)
#define H_MMA() do { if (!(ABL & 16)) { __builtin_amdgcn_s_setprio(1); \
        if (!(ABL & 4)) { _Pragma("unroll") for (int m = 0; m < 8; ++m) _Pragma("unroll") for (int n = 0; n < 4; ++n) \
            acc[m][n] = __builtin_amdgcn_mfma_f32_16x16x32_bf16(Bf[n], At[m], acc[m][n], 0, 0, 0); } \
        else { _Pragma("unroll") for (int m = 0; m < 8; ++m) asm volatile("" :: "v"(At[m])); _Pragma("unroll") for (int n = 0; n < 4; ++n) asm volatile("" :: "v"(Bf[n])); } \
        __builtin_amdgcn_s_setprio(0); } } while (0)
#define H_BAR() do { asm volatile("s_waitcnt lgkmcnt(0)" ::: "memory"); __builtin_amdgcn_s_barrier(); __builtin_amdgcn_sched_barrier(0); } while (0)
    bf16x8 At[8], Bf[4];
    { unsigned s0 = 0, s1 = STEP_B, s2 = 2 * STEP_B; asm volatile("" : "+s"(s0), "+s"(s1), "+s"(s2));
      H_STAGE(s0, ra_c, cur.aoff[0], cur.aoff[1], rb_c, 0); H_STAGE(s1, ra_c, cur.aoff[0], cur.aoff[1], rb_c, 1); H_STAGE(s2, ra_c, cur.aoff[0], cur.aoff[1], rb_c, 2); }
    asm volatile("s_waitcnt vmcnt(8)" ::: "memory");
    H_BAR();
    if (wr == 1) H_BAR();
    unsigned g = 0;
    for (int ti = 0;; ++ti) {
        const bool hasn = P.get(ti + 1, nxt);
        if (hasn) { ra_n = make_rsrc(nxt.A); rb_n = make_rsrc(nxt.B); }
        const unsigned bias_lds = BIAS_OFF + (unsigned)(ti & 1) * 1024u, list_lds = BIAS_OFF + 2048u + (unsigned)(ti & 1) * 1024u;
        if (P.has_bias && wid == 0) { const u32x4 rbias = make_rsrc(P.bias); H_DMA((unsigned)(__UINTPTR_TYPE__)lds + bias_lds, rbias, P.bias_voff(cur), 0u); }
        if (P.has_list && hasn && wid == 1) { const u32x4 rl = make_rsrc(P.listp); H_DMA((unsigned)(__UINTPTR_TYPE__)lds + list_lds, rl, P.list_voff(nxt), 0u); }
#pragma unroll
        for (int m = 0; m < 8; ++m)
#pragma unroll
            for (int n = 0; n < 4; ++n) acc[m][n] = (f32x4){0.f, 0.f, 0.f, 0.f};
        for (int t = 0; t < nt; ++t, ++g) {
            unsigned sc = (g & 3u) * STEP_B, sn = ((g + 3u) & 3u) * STEP_B; asm volatile("" : "+s"(sc), "+s"(sn));
            const bool c3 = t + 3 < nt, i3 = c3 || hasn, i2 = (t + 2 < nt) || hasn;
            if (P.has_list && hasn && t == nt - 3) P.late(nxt, (const LAS int*)(lds + list_lds));
            if (i3) { const u32x4 ra = c3 ? ra_c : ra_n, rb = c3 ? rb_c : rb_n; const unsigned a0 = c3 ? cur.aoff[0] : nxt.aoff[0], a1 = c3 ? cur.aoff[1] : nxt.aoff[1];
                H_STAGE(sn, ra, a0, a1, rb, c3 ? t + 3 : t + 3 - nt); }
            H_READ(sc);
            if (i3) asm volatile("s_waitcnt vmcnt(8)" ::: "memory");
            else if (i2) asm volatile("s_waitcnt vmcnt(4)" ::: "memory");
            else asm volatile("s_waitcnt vmcnt(0)" ::: "memory");
            H_BAR();
            H_MMA();
            H_BAR();
        }
        if (!(ABL & 8)) P.epi(acc, cur, (const LAS float*)(lds + bias_lds)); else { _Pragma("unroll") for (int m = 0; m < 8; ++m) _Pragma("unroll") for (int n = 0; n < 4; ++n) asm volatile("" :: "v"(acc[m][n])); }
        if (!hasn) break;
        cur = nxt; ra_c = ra_n; rb_c = rb_n;
    }
    if (wr == 0) H_BAR();
#undef H_DMA
#undef H_STAGE
#undef H_READ
#undef H_MMA
#undef H_BAR
}

struct XOrder {
    int c1, step, cur;
    __device__ __forceinline__ void init(int T, int G, int bid) {
        if ((G & 7) == 0) { const int x = bid & 7; cur = (int)(((long)x * T) >> 3) + (bid >> 3); c1 = (int)(((long)(x + 1) * T) >> 3); step = G >> 3; }
        else { cur = bid; c1 = T; step = G; }
    }
    __device__ __forceinline__ bool next(int& L) { if (cur >= c1) return false; L = cur; cur += step; return true; }
};
__device__ __forceinline__ void dense_tile(int L, int nM, int nN, int& pm, int& pn) { const int per = 8 * nN, g = L / per, w = L - g * per, fm = g * 8, gs = (nM - fm) < 8 ? (nM - fm) : 8; pn = w / gs; pm = fm + w - pn * gs; }

struct Frame { LAS unsigned char* lds; int tid, lane, wid, bid, G; unsigned char* ws; };
__device__ __forceinline__ const void* ldp(const Frame& F, int off) {
    const u32x2 v = *(const volatile LAS u32x2*)(F.lds + PARAM_OFF + off);
    const unsigned lo = __builtin_amdgcn_readfirstlane(v.x), hi = __builtin_amdgcn_readfirstlane(v.y);
    return (const void*)(((unsigned long long)hi << 32) | lo);
}
#define PP(f) ((const float*)ldp(F, (int)__builtin_offsetof(Params, f)))
#define F_mod ((float*)(F.ws + WS_MOD))
#define F_M1 ((bf16_t*)(F.ws + WS_M1))
#define F_M2 ((bf16_t*)(F.ws + WS_M2))
#define F_ROPE ((f32x2*)(F.ws + WS_ROPE))
#define F_TW ((f32x2*)(F.ws + WS_TW))
#define F_WF ((float*)(F.ws + WS_WF))
#define F_TOPW ((float*)(F.ws + WS_TOPW))
#define F_POS ((int*)(F.ws + WS_POS))
#define F_LIST ((int*)(F.ws + WS_LIST))
#define F_H ((bf16_t*)(F.ws + WS_H))
#define F_MIX ((bf16_t*)(F.ws + WS_MIX))
#define F_XS ((float*)(F.ws + WS_XS))
#define F_PROJ ((bf16_t*)(F.ws + WS_PROJ))
#define F_Z ((float*)(F.ws + WS_Z))
#define F_A1 ((float*)(F.ws + WS_A1))
#define F_ACT ((bf16_t*)(F.ws + WS_ACT))
#define F_Y ((bf16_t*)(F.ws + WS_Y))
#define F_cnt ((unsigned*)(F.ws + WS_CTL) + CW_CNT)

__device__ __forceinline__ const float* modp(const Frame& F, int l, int r, int which) { return F_mod + ((size_t)(l * 5 + r)) * 6144 + which * 1024; }
__device__ __forceinline__ int mod_row(int row) { return row < NMAIN ? (row >> 12) : 4; }

__device__ __forceinline__ float row_rstd(const f32x4 (&v)[4]) {
    float s = 0.f;
#pragma unroll
    for (int j = 0; j < 4; ++j) s += (v[j][0] * v[j][0] + v[j][1] * v[j][1]) + (v[j][2] * v[j][2] + v[j][3] * v[j][3]);
    return __builtin_amdgcn_rsqf(wave_sum(s) * (1.f / D) + NORM_EPS);
}
__device__ __forceinline__ void norm_mod_store(const f32x4 (&v)[4], float rstd, const float* gam, const float* sc, const float* sh, bf16_t* dst, int lane, f32x4 (*keep)[4] = nullptr) {
#pragma unroll
    for (int j = 0; j < 4; ++j) {
        const int c = 4 * lane + 256 * j;
        const f32x4 g = *(const f32x4*)(gam + c), s1 = *(const f32x4*)(sc + c), s0 = *(const f32x4*)(sh + c);
        f32x4 h;
#pragma unroll
        for (int i = 0; i < 4; ++i) h[i] = v[j][i] * rstd * g[i] * (1.f + s1[i]) + s0[i];
        u32x2 w; w.x = pk2(h[0], h[1]); w.y = pk2(h[2], h[3]);
        *(u32x2*)(dst + c) = w;
        if (keep) (*keep)[j] = h;
    }
}

__device__ __forceinline__ void phase_prep(Frame& F) {
    LAS float* sil = (LAS float*)F.lds;
    LAS float* red = (LAS float*)(F.lds + 20480);
    LAS float* ct = (LAS float*)(F.lds + 32768);
    for (int idx = F.tid; idx < 5120; idx += 512) { const int r = idx >> 10, k = idx & 1023; const float v = r < 4 ? PP(c)[r * 1024 + k] : PP(c_ctx)[k]; sil[idx] = v / (1.f + __expf(-v)); }
    if (F.tid < 128) ct[F.tid] = cospif((float)F.tid / 64.f);
    __syncthreads();
    constexpr int N_ADA = 192, N_CONST = 8, N_FOLD = 256, N_CVT = 368;
    for (int it = F.bid; it < N_ADA + N_CONST + N_FOLD + N_CVT; it += F.G) {
        if (it < N_ADA) {
            const int l = it / 96, j0 = (it % 96) * 64, col = j0 + F.lane;
            const float* w = PP(ada_w) + ((size_t)l * 1024 + F.wid * 128) * 6144 + col;
            float a[5] = {0.f, 0.f, 0.f, 0.f, 0.f};
            for (int k0 = 0; k0 < 128; k0 += 32) {
                float wv[32];
#pragma unroll
                for (int u = 0; u < 32; ++u) wv[u] = w[(size_t)(k0 + u) * 6144];
#pragma unroll
                for (int u = 0; u < 32; ++u)
#pragma unroll
                    for (int r = 0; r < 5; ++r) a[r] += sil[r * 1024 + F.wid * 128 + k0 + u] * wv[u];
            }
#pragma unroll
            for (int r = 0; r < 5; ++r) red[(F.wid * 5 + r) * 64 + F.lane] = a[r];
            __syncthreads();
            if (F.tid < 320) { const int r = F.tid >> 6, ln = F.tid & 63; float s = 0.f;
#pragma unroll
                for (int w8 = 0; w8 < 8; ++w8) s += red[(w8 * 5 + r) * 64 + ln];
                F_mod[(size_t)(l * 5 + r) * 6144 + j0 + ln] = s + PP(ada_b)[l * 6144 + j0 + ln]; }
            __syncthreads();
        } else if (it < N_ADA + N_CONST) {
            const int gt = (it - N_ADA) * 512 + F.tid;
            for (int e = gt; e < 32768; e += 4096) {
                const int row = e >> 7, kk = e & 127;
                float v1 = 0.f, v2 = 0.f;
                if (row < 128) { const int ro = row >> 6, k1 = row & 63, n1 = kk >> 1, ri = kk & 1; const float ph = (float)((n1 * k1) & 63) / 32.f; const float cs = cospif(ph), sn = sinpif(ph);
                    v1 = (ro == ri) ? cs : (ro == 0 ? sn : -sn); }
                if (row < 64) { const int ro = kk >> 6, n2 = kk & 63; const float ph = (float)((row * n2) & 63) / 32.f; v2 = ro == 0 ? cospif(ph) : sinpif(ph); }
                F_M1[e] = (bf16_t)(pk2(v1, 0.f) & 0xffffu); F_M2[e] = (bf16_t)(pk2(v2, 0.f) & 0xffffu);
            }
            if (gt < 1024) { const int pos = gt >> 4, f = gt & 15; const double ang = (double)pos * pow(10000.0, -(double)f / 16.0); F_ROPE[gt] = (f32x2){(float)cos(ang), (float)sin(ang)}; }
            { const float ph = (float)gt / 2048.f; F_TW[gt] = (f32x2){cospif(ph), sinpif(ph)}; }
        } else if (it >= N_ADA + N_CONST + N_FOLD) {
            int ci = it - (N_ADA + N_CONST + N_FOLD); const float* src; bf16_t* dst; int sld, dld, ncol;
            if (ci < 144) { src = PP(even_w_in); dst = (bf16_t*)(F.ws + WB_EIN); sld = EVEN_IN; dld = EVEN_IN; ncol = EVEN_IN; }
            else if (ci < 208) { ci -= 144; src = PP(even_w_out); dst = (bf16_t*)(F.ws + WB_EOUT); sld = D; dld = D; ncol = D; }
            else if (ci < 304) { ci -= 208; src = PP(odd_w_in); dst = (bf16_t*)(F.ws + WB_OIN); sld = 2048; dld = 2560; ncol = 1536; }
            else { ci -= 304; src = PP(odd_w_out); dst = (bf16_t*)(F.ws + WB_OOUT); sld = D; dld = D; ncol = D; }
            const int q4 = ncol >> 2;
#pragma unroll
            for (int u = 0; u < 8; ++u) { const int gidx = ci * 4096 + u * 512 + F.tid, row = gidx / q4, c4 = (gidx - row * q4) * 4;
                const f32x4 v = *(const f32x4*)(src + (size_t)row * sld + c4); u32x2 w; w.x = pk2(v[0], v[1]); w.y = pk2(v[2], v[3]); *(u32x2*)(dst + (size_t)row * dld + c4) = w; }
        } else {
            const int fi = it - N_ADA - N_CONST, rc = fi >> 2, g = fi & 3, half = F.tid >> 8, j = F.tid & 255, jj = j & 127;
            for (int i2 = 0; i2 < 8; ++i2) {
                const int row = rc * 16 + i2 * 2 + half;
                const float* wr_ = PP(odd_w_in) + (size_t)row * 2048 + 1536 + g * 128;
                float s = 0.f;
                if (j < 128) { for (int cc = 0; cc < 128; ++cc) s += wr_[cc] * ct[(cc * jj) & 127]; }
                else { for (int cc = 0; cc < 128; ++cc) s -= wr_[cc] * ct[((cc * jj) - 32) & 127]; }
                ((bf16_t*)(F.ws + WB_OIN))[(size_t)row * 2560 + 1536 + g * 256 + j] = (bf16_t)(pk2(s, 0.f) & 0xffffu);
            }
        }
    }
}

__device__ __forceinline__ void phase_norm1_l0(Frame& F) {
    const int gw = F.bid * 8 + F.wid, NGW = F.G * 8;
    for (int row = gw; row < NTOK; row += NGW) {
        const float* src = row < NMAIN ? PP(x) + (size_t)row * D : PP(ctx) + (size_t)(row - NMAIN) * D;
        f32x4 v[4];
#pragma unroll
        for (int j = 0; j < 4; ++j) v[j] = *(const f32x4*)(src + 4 * F.lane + 256 * j);
        const float rstd = row_rstd(v); const int r = mod_row(row);
        norm_mod_store(v, rstd, PP(norm_mix), modp(F, 0, r, 1), modp(F, 0, r, 0), F_H + (size_t)row * D, F.lane);
    }
}

#define EPI_GEOM const int wid = this->wid, lane = this->lane, wr = wid >> 2, wc = wid & 3, fr = lane & 15, fq = lane >> 4; (void)wr; (void)wc; (void)fr; (void)fq
struct PolBase { unsigned char* ws; LAS unsigned char* lds; int wid, lane, nt; unsigned lcolb, woff, ldbB; XOrder xo; int aC, aR0, aCb, aR0b; bool bfm;
    __device__ __forceinline__ void base_init(Frame& F, int nt_, int T) { ws = F.ws; lds = F.lds; wid = F.wid; lane = F.lane; nt = nt_; lcolb = 16u * (unsigned)F.lane; woff = 8u * (unsigned)F.lane;
        xo.init(T, F.G, F.bid); aC = a_piece_col(F.wid, F.lane); aR0 = a_piece_row0(F.wid, F.lane); bfm = true;
        { const int sbb = F.lane * 16, swz = sbb ^ (((sbb >> 9) & 1) << 5); aR0b = F.wid * 32 + (swz >> 6); aCb = (swz & 63) >> 1; } }
    bool has_bias = false; const float* bias = nullptr;
    bool has_list = false; const int* listp = nullptr;
    __device__ __forceinline__ unsigned list_voff(const TD&) const { return 0u; }
    __device__ __forceinline__ void late(TD&, const LAS int*) const {}
    __device__ __forceinline__ unsigned bias_voff(const TD&) const { return 0u; }
    __device__ __forceinline__ bool tileL(int i, int& L) const { L = xo.cur + i * xo.step; return L < xo.c1; }
    __device__ __forceinline__ int prow(int i) const { return bfm ? aR0b + 16 * (i & 1) : aR0 + 64 * i; }
    __device__ __forceinline__ int pcol() const { return bfm ? aCb : aC; }
    __device__ __forceinline__ void dense_aoff(TD& td, int row0, int pitch) const {
#pragma unroll
        for (int i = 0; i < 4; ++i) td.aoff[i] = (unsigned)(((row0 + prow(i)) * pitch + pcol()) * 2); }
};

struct PolInproj0 : PolBase {
    const float* W; Frame* Fp;
    __device__ __forceinline__ bool get(int i, TD& td) const { int L; if (!tileL(i, L)) return false; int pm, pn; dense_tile(L, NTOK / 256, EVEN_IN / 256, pm, pn);
        td.A = (const bf16_t*)(ws + WS_H); dense_aoff(td, pm * 256, D); td.B = (const bf16_t*)(ws + WB_EIN) + pn * 256; td.i0 = pm; td.i1 = pn; return true; }
    __device__ __forceinline__ void epi(f32x4 (&acc)[8][4], const TD& td, const LAS float* bl) const { (void)bl; EPI_GEOM; const int pm = td.i0, pn = td.i1;
        const int colb = pn * 256 + wc * 64; const bool rope = (colb < 640) && (pm < NMAIN / 256);
        const LAS f32x2* ROPE = (const LAS f32x2*)(lds + ROPE_LDS); bf16_t* PROJ = (bf16_t*)(ws + WS_PROJ);
#pragma unroll
        for (int m = 0; m < 8; ++m) { const int row = pm * 256 + wr * 128 + m * 16 + fr;
            if (rope) { const int tt = row & (SEQ - 1), gr = tt >> 6, gc = tt & 63;
#pragma unroll
                for (int n = 0; n < 2; ++n) { const int pos = n == 0 ? gr : gc;
#pragma unroll
                    for (int j = 0; j < 4; ++j) { const f32x2 cs = ROPE[pos * 16 + 4 * fq + j]; const float x1 = acc[m][n][j], x2 = acc[m][n + 2][j];
                        acc[m][n][j] = x1 * cs.x - x2 * cs.y; acc[m][n + 2][j] = x2 * cs.x + x1 * cs.y; } } }
#pragma unroll
            for (int n = 0; n < 4; ++n) { u32x2 w; w.x = pk2(acc[m][n][0], acc[m][n][1]); w.y = pk2(acc[m][n][2], acc[m][n][3]);
                *(u32x2*)(PROJ + (size_t)row * EVEN_IN + colb + n * 16 + 4 * fq) = w; } } }
};
__device__ __forceinline__ void phase_inproj_l0(Frame& F) {
    for (int i = F.tid; i < 1024; i += 512) ((LAS f32x2*)(F.lds + ROPE_LDS))[i] = F_ROPE[i];
    __syncthreads();
    PolInproj0 P; P.base_init(F, D / 64, (NTOK / 256) * (EVEN_IN / 256)); P.ldbB = EVEN_IN;
    gemm_stream_bf(F.lds, P, F.wid, F.lane);
}

struct PolOutproj : PolBase {
    const float *W, *x, *ctx; int layer, nM;
    __device__ __forceinline__ bool get(int i, TD& td) const { int L; if (!tileL(i, L)) return false; int pm, pn; dense_tile(L, nM, 4, pm, pn);
        td.A = (const bf16_t*)(ws + WS_MIX); dense_aoff(td, pm * 256, D); td.B = (const bf16_t*)(ws + (layer == 0 ? WB_EOUT : WB_OOUT)) + pn * 256; td.i0 = pm; td.i1 = pn; return true; }
    __device__ __forceinline__ void epi(f32x4 (&acc)[8][4], const TD& td, const LAS float* bl) const { (void)bl; EPI_GEOM; const int pm = td.i0, pn = td.i1;
        const int colb = pn * 256 + wc * 64; float* XS = (float*)(ws + WS_XS); const float* mod = (const float*)(ws + WS_MOD);
#pragma unroll
        for (int m = 0; m < 8; ++m) { const int row = pm * 256 + wr * 128 + m * 16 + fr; const int r = mod_row(row);
            const float* xin = layer == 0 ? (row < NMAIN ? x + (size_t)row * D : ctx + (size_t)(row - NMAIN) * D) : XS + (size_t)row * D;
            const float* g1 = mod + ((size_t)(layer * 5 + r)) * 6144 + 2 * 1024;
#pragma unroll
            for (int n = 0; n < 4; ++n) { const int c = colb + n * 16 + 4 * fq; const f32x4 xv = *(const f32x4*)(xin + c), gv = *(const f32x4*)(g1 + c);
                f32x4 o;
#pragma unroll
                for (int j = 0; j < 4; ++j) o[j] = xv[j] + gv[j] * acc[m][n][j];
                *(f32x4*)(XS + (size_t)row * D + c) = o; } } }
};
__device__ __forceinline__ void phase_outproj(Frame& F, const int layer) {
    PolOutproj P; P.layer = layer; P.nM = (layer == 0 ? NTOK : NMAIN) / 256; P.base_init(F, D / 64, P.nM * 4);
    P.ldbB = D; P.x = PP(x); P.ctx = PP(ctx);
    gemm_stream_bf(F.lds, P, F.wid, F.lane);
}

constexpr int QT = 2;
struct AttnSt { f32x4 o[4][QT]; float m[QT], l[QT]; };
#define V_ROWB 160
__device__ __forceinline__ void v_stage(LAS unsigned char* vl, const bf16_t* vsrc, int ld, int lane) {
    i32x4 t[4];
    asm volatile("" ::: "memory");
#pragma unroll
    for (int i = 0; i < 4; ++i) t[i] = *(const i32x4*)(vsrc + (size_t)((lane >> 3) + 8 * i) * ld + (lane & 7) * 8);
#pragma unroll
    for (int i = 0; i < 4; ++i) *(LAS i32x4*)(vl + ((lane >> 3) + 8 * i) * V_ROWB + (lane & 7) * 16) = t[i];
    asm volatile("s_waitcnt lgkmcnt(0)" ::: "memory");
}
#define ATTN_STEP(ksrc, kld, vsrc, vld, SCALE, BIAS, SKIP) do { \
    bf16x8 kf[2][2]; \
    _Pragma("unroll") for (int kt = 0; kt < 2; ++kt) _Pragma("unroll") for (int ks = 0; ks < 2; ++ks) \
        kf[kt][ks] = *(const bf16x8*)((ksrc) + (size_t)(kt * 16 + fr) * (kld) + ks * 32 + 8 * fq); \
    v_stage(vl, (vsrc), (vld), lane); \
    bf16x8 vf[4]; \
    _Pragma("unroll") for (int dt = 0; dt < 4; ++dt) { \
        const s16x4 lo = __builtin_amdgcn_ds_read_tr16_b64_v4i16((LAS s16x4*)(vl + (4 * fq + (fr >> 2)) * V_ROWB + (dt * 16 + (fr & 3) * 4) * 2)); \
        const s16x4 hi = __builtin_amdgcn_ds_read_tr16_b64_v4i16((LAS s16x4*)(vl + (16 + 4 * fq + (fr >> 2)) * V_ROWB + (dt * 16 + (fr & 3) * 4) * 2)); \
        vf[dt] = (bf16x8){lo[0], lo[1], lo[2], lo[3], hi[0], hi[1], hi[2], hi[3]}; } \
    _Pragma("unroll") for (int qt = 0; qt < QT; ++qt) { if (SKIP(qt)) continue;        \
        f32x4 s[2]; \
        _Pragma("unroll") for (int kt = 0; kt < 2; ++kt) { s[kt] = (f32x4){0.f, 0.f, 0.f, 0.f}; \
            _Pragma("unroll") for (int ks = 0; ks < 2; ++ks) s[kt] = __builtin_amdgcn_mfma_f32_16x16x32_bf16(kf[kt][ks], qf[qt][ks], s[kt], 0, 0, 0); } \
        float mx = -INFINITY; \
        _Pragma("unroll") for (int kt = 0; kt < 2; ++kt) _Pragma("unroll") for (int j = 0; j < 4; ++j) { const float tv = s[kt][j] * (SCALE) + BIAS(qt, kt, j); s[kt][j] = tv; mx = fmaxf(mx, tv); } \
        mx = fmaxf(mx, __shfl_xor(mx, 16)); mx = fmaxf(mx, __shfl_xor(mx, 32)); \
        const float mn = fmaxf(st.m[qt], mx), al = fexp2(st.m[qt] - mn); st.m[qt] = mn; \
        float ps = 0.f; \
        _Pragma("unroll") for (int kt = 0; kt < 2; ++kt) _Pragma("unroll") for (int j = 0; j < 4; ++j) { const float pv = fexp2(s[kt][j] - mn); s[kt][j] = pv; ps += pv; } \
        st.l[qt] = st.l[qt] * al + ps; \
        const unsigned w0 = pk2(s[0][0], s[0][1]), w1 = pk2(s[0][2], s[0][3]), w2 = pk2(s[1][0], s[1][1]), w3 = pk2(s[1][2], s[1][3]); \
        const bf16x8 pf = __builtin_bit_cast(bf16x8, ((u32x4){w0, w1, w2, w3})); \
        _Pragma("unroll") for (int dt = 0; dt < 4; ++dt) st.o[dt][qt] = __builtin_amdgcn_mfma_f32_16x16x32_bf16(vf[dt], pf, st.o[dt][qt] * al, 0, 0, 0); } \
    } while (0)

__device__ __forceinline__ void attn_store(AttnSt& st, bf16_t* dst  , int dld, int fr, int fq) {
#pragma unroll
    for (int qt = 0; qt < QT; ++qt) {
        float l = st.l[qt]; l += __shfl_xor(l, 16); l += __shfl_xor(l, 32);
        const float inv = 1.f / l;
#pragma unroll
        for (int dt = 0; dt < 4; ++dt) { const f32x4 o = st.o[dt][qt] * inv; u32x2 w; w.x = pk2(o[0], o[1]); w.y = pk2(o[2], o[3]);
            *(u32x2*)(dst + (size_t)(qt * 16 + fr) * dld + dt * 16 + 4 * fq) = w; }
    }
}

__device__ __forceinline__ void phase_attn_l0(Frame& F) {
    const int wid = F.wid, lane = F.lane, fr = lane & 15, fq = lane >> 4;
    LAS unsigned char* vl = F.lds + wid * 8192;
    constexpr int N_WIN = 256, N_CTXA = 16, N_CONV = NTOK / 64;
    const float SC = 0.125f * LOG2E;
    for (int it = F.bid; it < N_WIN + N_CTXA + N_CONV; it += F.G) {
        if (it < N_WIN + N_CTXA) {
            const bool isctx = it >= N_WIN;
            int b, kvh, qb;
            if (!isctx) { b = it >> 6; kvh = (it >> 5) & 1; qb = it & 31; } else { const int c = it - N_WIN; b = c >> 2; kvh = (c >> 1) & 1; qb = c & 1; }
            const int g = wid >> 1, h = kvh * 4 + g;
            for (int qh = 0; qh < 4 / QT; ++qh) {
            const int qq0 = (wid & 1) * 64 + qh * (16 * QT);
            const int qrow0 = (isctx ? NMAIN + b * CTXL : b * SEQ) + qb * 128 + qq0;
            bf16x8 qf[QT][2];
#pragma unroll
            for (int qt = 0; qt < QT; ++qt)
#pragma unroll
                for (int ks = 0; ks < 2; ++ks) qf[qt][ks] = *(const bf16x8*)(F_PROJ + (size_t)(qrow0 + qt * 16 + fr) * EVEN_IN + h * 64 + ks * 32 + 8 * fq);
            AttnSt st;
            const float sink = PP(even_sink)[h] * LOG2E;
#pragma unroll
            for (int qt = 0; qt < QT; ++qt) { st.m[qt] = sink; st.l[qt] = (fq == 0) ? 1.f : 0.f;
#pragma unroll
                for (int dt = 0; dt < 4; ++dt) st.o[dt][qt] = (f32x4){0.f, 0.f, 0.f, 0.f}; }
            const int kcol = 512 + kvh * 64, vcol = 640 + kvh * 64;
            for (int ch = isctx ? 3 : 0; ch < 5; ++ch) {
                int krow0;
                if (ch < 3) { const int kb = qb - 1 + ch; if (kb < 0 || kb >= SEQ / 128) continue; krow0 = b * SEQ + kb * 128; } else krow0 = NMAIN + b * CTXL + (ch - 3) * 128;
                for (int s32 = 0; s32 < 4; ++s32) {
                    const bf16_t* kp = F_PROJ + (size_t)(krow0 + s32 * 32) * EVEN_IN + kcol;
                    const bf16_t* vp = F_PROJ + (size_t)(krow0 + s32 * 32) * EVEN_IN + vcol;
                    if (ch == 0) {
#define SKIP_NONE(qt) false
#define SKIP_PREV(qt) ((s32 * 32 + 31) < (qq0 + qt * 16))
#define SKIP_NEXT(qt) ((s32 * 32) > (qq0 + qt * 16 + 15))
#define BIAS_PREV(qt, kt, j) ((s32 * 32 + kt * 16 + 4 * fq + j) >= (qq0 + qt * 16 + fr) ? 0.f : -INFINITY)
                        ATTN_STEP(kp, EVEN_IN, vp, EVEN_IN, SC, BIAS_PREV, SKIP_PREV);
                    } else if (ch == 2) {
#define BIAS_NEXT(qt, kt, j) ((s32 * 32 + kt * 16 + 4 * fq + j) <= (qq0 + qt * 16 + fr) ? 0.f : -INFINITY)
                        ATTN_STEP(kp, EVEN_IN, vp, EVEN_IN, SC, BIAS_NEXT, SKIP_NEXT);
                    } else {
#define BIAS_NONE(qt, kt, j) 0.f
                        ATTN_STEP(kp, EVEN_IN, vp, EVEN_IN, SC, BIAS_NONE, SKIP_NONE);
                    }
                }
            }
            attn_store(st, F_MIX + (size_t)qrow0 * D + h * 64, D, fr, fq);
            }
        } else {
            const int ci = it - N_WIN - N_CTXA, c4 = (F.tid & 127) * 4, r0 = ci * 64 + (F.tid >> 7) * 16;
            const f32x4 w0 = *(const f32x4*)(PP(even_conv_w) + c4), w1 = *(const f32x4*)(PP(even_conv_w) + 512 + c4), w2 = *(const f32x4*)(PP(even_conv_w) + 1024 + c4);
#define LOADZ(dst, row_) do { const u32x2 gc_ = *(const u32x2*)(F_PROJ + (size_t)(row_) * EVEN_IN + 1280 + c4), uu_ = *(const u32x2*)(F_PROJ + (size_t)(row_) * EVEN_IN + 1792 + c4); \
                dst = (f32x4){bflo(gc_.x) * bflo(uu_.x), bfhi(gc_.x) * bfhi(uu_.x), bflo(gc_.y) * bflo(uu_.y), bfhi(gc_.y) * bfhi(uu_.y)}; } while (0)
            const int seqmask = r0 < NMAIN ? (SEQ - 1) : (CTXL - 1);
            u32x2 gcv[18], uuv[18], gbv[16];
#pragma unroll
            for (int i = 0; i < 18; ++i) { const int row = r0 - 1 + i; const bool ok = (i == 0) ? ((r0 & seqmask) != 0) : (i == 17) ? (((r0 + 15) & seqmask) != seqmask) : true;
                const int rr = ok ? row : r0;
                gcv[i] = *(const u32x2*)(F_PROJ + (size_t)rr * EVEN_IN + 1280 + c4); uuv[i] = *(const u32x2*)(F_PROJ + (size_t)rr * EVEN_IN + 1792 + c4);
                if (!ok) { gcv[i] = (u32x2){0u, 0u}; } }
#pragma unroll
            for (int i = 0; i < 16; ++i) gbv[i] = *(const u32x2*)(F_PROJ + (size_t)(r0 + i) * EVEN_IN + 768 + c4);
            __builtin_amdgcn_sched_barrier(0);
#define ZOF(i_) ((f32x4){bflo(gcv[i_].x) * bflo(uuv[i_].x), bfhi(gcv[i_].x) * bfhi(uuv[i_].x), bflo(gcv[i_].y) * bflo(uuv[i_].y), bfhi(gcv[i_].y) * bfhi(uuv[i_].y)})
            f32x4 zp = ZOF(0), zc = ZOF(1);
#pragma unroll
            for (int i = 0; i < 16; ++i) {
                const int row = r0 + i;
                const f32x4 zn = ZOF(i + 2);
                const u32x2 gb = gbv[i];
                const f32x4 y = zp * w0 + zc * w1 + zn * w2;
                u32x2 w; w.x = pk2(bflo(gb.x) * y[0], bfhi(gb.x) * y[1]); w.y = pk2(bflo(gb.y) * y[2], bfhi(gb.y) * y[3]);
                *(u32x2*)(F_MIX + (size_t)row * D + 512 + c4) = w;
                zp = zc; zc = zn;
            }
#undef ZOF
        }
    }
}

constexpr int RW_LD = 1028;
__device__ __forceinline__ void phase_route(Frame& F, const int layer) {
    const int nrows = layer == 0 ? NTOK : NMAIN;
    LAS float* rwT = (LAS float*)F.lds;
    LAS int* cntL = (LAS int*)(F.lds + 32 * RW_LD * 4);
    LAS int* baseL = cntL + 32;
    LAS int* selE = baseL + 32;
    LAS int* selR = selE + 384;
    const float* rw = PP(router_w) + (size_t)layer * D * NEXP;
    { const f32x4* rsrc4 = (const f32x4*)rw + F.tid; LAS float* wp = rwT + ((4 * F.tid) & 31) * RW_LD + (F.tid >> 3);
      for (int it = 0; it < 4; ++it) {
        f32x4 v[4];
#pragma unroll
        for (int u = 0; u < 4; ++u) v[u] = rsrc4[(it * 4 + u) * 512];
#pragma unroll
        for (int u = 0; u < 4; ++u)
#pragma unroll
            for (int j = 0; j < 4; ++j) wp[it * 256 + u * 64 + j * RW_LD] = v[u][j];
        asm volatile("" ::: "memory"); } }
    if (F.tid < 32) cntL[F.tid] = 0;
    __syncthreads();
    const int lane = F.lane, gw = F.bid * 8 + F.wid, NGW = F.G * 8;
    const float* gam = PP(norm_ffn) + layer * D;
    int slot = F.wid;
    const float* Wd = PP(moe_w_dn) + (size_t)layer * NEXP * DFF * D; bf16_t* pd = (bf16_t*)(F.ws + WS_BC2);
    constexpr int CV_TOTAL = NEXP * 4 * 1024;
    const int cv_q = (CV_TOTAL + NGW - 1) / NGW, cv_end = min((gw + 1) * cv_q, CV_TOTAL); int cv_u = gw * cv_q;
#define CV_LOAD(v_, u0_) do { _Pragma("unroll") for (int u = 0; u < 8; ++u) { const int pr = min((u0_) + u, CV_TOTAL - 1), pnl = pr >> 10, k = pr & 1023, e = pnl >> 2, ct = pnl & 3; \
        v_[u] = *(const f32x4*)(Wd + ((size_t)e * DFF + k) * D + ct * 256 + 4 * lane); } } while (0)
#define CV_STORE(v_, u0_, uend_) do { _Pragma("unroll") for (int u = 0; u < 8; ++u) { const int pr = (u0_) + u; if (pr < (uend_)) { u32x2 w; w.x = pk2(v_[u][0], v_[u][1]); w.y = pk2(v_[u][2], v_[u][3]); \
        *(u32x2*)(pd + (size_t)pr * 256 + 4 * lane) = w; } } } while (0)
    f32x4 vn[4];
    if (gw < nrows) {
#pragma unroll
        for (int j = 0; j < 4; ++j) vn[j] = *(const f32x4*)(F_XS + (size_t)gw * D + 4 * lane + 256 * j); }
    for (int row = gw; row < nrows; row += NGW, slot += 8) {
        f32x4 v[4], h[4], cvv[8];
        const int cv_u0 = cv_u; CV_LOAD(cvv, cv_u0); cv_u += 8;
#pragma unroll
        for (int j = 0; j < 4; ++j) v[j] = vn[j];
        if (row + NGW < nrows) {
#pragma unroll
            for (int j = 0; j < 4; ++j) vn[j] = *(const f32x4*)(F_XS + (size_t)(row + NGW) * D + 4 * lane + 256 * j); }
        const float rstd = row_rstd(v); const int r = mod_row(row);
        norm_mod_store(v, rstd, gam, modp(F, layer, r, 4), modp(F, layer, r, 3), F_H + (size_t)row * D, lane, &h);
        float pe[32];
#pragma unroll
        for (int e = 0; e < 32; ++e) { float s = 0.f;
            f32x2 s2 = (f32x2){0.f, 0.f};
#pragma unroll
            for (int j = 0; j < 4; ++j) { const f32x4 w = *(const LAS f32x4*)(rwT + e * RW_LD + 4 * lane + 256 * j);
                s2 = __builtin_elementwise_fma((f32x2){h[j][0], h[j][1]}, (f32x2){w[0], w[1]}, s2); s2 = __builtin_elementwise_fma((f32x2){h[j][2], h[j][3]}, (f32x2){w[2], w[3]}, s2); }
            s = s2.x + s2.y;
            pe[e] = s; if ((e & 3) == 3) __builtin_amdgcn_sched_barrier(0); }
        float q16[16], q8[8], q4[4], q2[2], q1;
        { const bool hi = lane & 32;
#pragma unroll
          for (int i = 0; i < 16; ++i) { const float snd = hi ? pe[i] : pe[16 + i], mine = hi ? pe[16 + i] : pe[i]; q16[i] = mine + __shfl_xor(snd, 32); } }
        { const bool hi = lane & 16;
#pragma unroll
          for (int i = 0; i < 8; ++i) { const float snd = hi ? q16[i] : q16[8 + i], mine = hi ? q16[8 + i] : q16[i]; q8[i] = mine + __shfl_xor(snd, 16); } }
        { const bool hi = lane & 8;
#pragma unroll
          for (int i = 0; i < 4; ++i) { const float snd = hi ? q8[i] : q8[4 + i], mine = hi ? q8[4 + i] : q8[i]; q4[i] = mine + __shfl_xor(snd, 8); } }
        { const bool hi = lane & 4;
#pragma unroll
          for (int i = 0; i < 2; ++i) { const float snd = hi ? q4[i] : q4[2 + i], mine = hi ? q4[2 + i] : q4[i]; q2[i] = mine + __shfl_xor(snd, 4); } }
        { const bool hi = lane & 2; const float snd = hi ? q2[0] : q2[1], mine = hi ? q2[1] : q2[0]; q1 = mine + __shfl_xor(snd, 2); }
        q1 += __shfl_xor(q1, 1);
        const int myE = (lane >> 1) & 31;
        float val = q1 + PP(router_b)[layer * NEXP + myE];
        float tv[4]; int te[4];
        { int rank = 0; const int vb = __builtin_bit_cast(int, val);
#pragma unroll
          for (int e2 = 0; e2 < 32; ++e2) { const float o = __builtin_bit_cast(float, __builtin_amdgcn_readlane(vb, 2 * e2)); rank += (o > val || (o == val && e2 < myE)) ? 1 : 0; }
#pragma unroll
          for (int k = 0; k < 4; ++k) { const unsigned long long mk = __ballot(rank == k); const int src = __builtin_amdgcn_readfirstlane((int)__builtin_ctzll(mk));
              tv[k] = __builtin_bit_cast(float, __builtin_amdgcn_readlane(vb, src)); te[k] = (src >> 1) & 31; } }
        const float e1 = __expf(tv[1] - tv[0]), e2 = __expf(tv[2] - tv[0]), e3 = __expf(tv[3] - tv[0]), inv = 1.f / (1.f + e1 + e2 + e3);
        if (lane == 0) {
            *(f32x4*)(F_TOPW + (size_t)row * 4) = (f32x4){inv, e1 * inv, e2 * inv, e3 * inv};
#pragma unroll
            for (int k = 0; k < 4; ++k) { selE[slot * 4 + k] = te[k]; selR[slot * 4 + k] = atomicAdd((int*)(cntL + te[k]), 1); }
        }
        CV_STORE(cvv, cv_u0, cv_end);
    }
    for (; cv_u < cv_end; cv_u += 8) { f32x4 cvv[8]; CV_LOAD(cvv, cv_u); CV_STORE(cvv, cv_u, cv_end); }
#undef CV_LOAD
#undef CV_STORE
    __syncthreads();
    if (F.tid < 32) { const int c = cntL[F.tid]; baseL[F.tid] = c ? (int)atomicAdd(F_cnt + layer * 32 + F.tid, (unsigned)c) : 0; }
    __syncthreads();
    if (F.tid < 384) { const int s = F.tid >> 2, k = F.tid & 3; const int row = F.bid * 8 + (s & 7) + (s >> 3) * NGW;
        if (row < nrows) { const int e = selE[F.tid], pos = baseL[e] + selR[F.tid]; F_POS[(size_t)row * 4 + k] = e | (pos << 8); F_LIST[(size_t)e * NTOK + pos] = row; } }
    __syncthreads();
}

struct MoeLds { LAS int *mtp, *roff, *mtq, *nz; };
__device__ __forceinline__ MoeLds moe_lds(Frame& F) { MoeLds L; L.mtp = (LAS int*)(F.lds + 2 * STAGE_B); L.roff = L.mtp + 40; L.mtq = L.roff + 40; L.nz = L.mtq + 40; return L; }
__device__ __forceinline__ void moe_prefix(Frame& F, const int layer, const MoeLds& L) {
    if (F.tid < 64) { const int e = F.lane & 31; const int c = (int)__hip_atomic_load(F_cnt + layer * 32 + e, __ATOMIC_RELAXED, __HIP_MEMORY_SCOPE_AGENT);
        const int mt = (c + 255) >> 8; int a = mt, b = c, q = mt > 0 ? mt - 1 : 0, z = mt > 0 ? 1 : 0;
#pragma unroll
        for (int o = 1; o < 32; o <<= 1) { const int ua = __shfl_up(a, o, 32), ub = __shfl_up(b, o, 32), uq = __shfl_up(q, o, 32), uz = __shfl_up(z, o, 32); if (e >= o) { a += ua; b += ub; q += uq; z += uz; } }
        if (F.lane < 32) { L.mtp[e + 1] = a; L.roff[e + 1] = b; L.mtq[e + 1] = q; if (mt > 0) L.nz[z - 1] = e; if (e == 31) L.nz[32] = z; if (e == 0) { L.mtp[0] = 0; L.roff[0] = 0; L.mtq[0] = 0; } } }
    __syncthreads();
}
struct PolMoe : PolBase {
    const float* W; MoeLds L; int layer, nct, round; size_t bc_off;
    __device__ __forceinline__ bool find(int i, int& e, int& ct, int& rbase, int& ro, int& cnt) const { int T; if (!tileL(i, T)) return false;
        if (round == 0) { const int q = T / nct; ct = T - q * nct; e = __builtin_amdgcn_readfirstlane(L.nz[q]); rbase = 0; }
        else { LAS int* pf = round == 1 ? L.mtq : L.mtp; e = 0; while (pf[e + 1] * nct <= T) ++e;
            e = __builtin_amdgcn_readfirstlane(e);
            const int mq = __builtin_amdgcn_readfirstlane(pf[e + 1] - pf[e]), w = T - __builtin_amdgcn_readfirstlane(pf[e]) * nct; ct = w / mq; rbase = ((round == 1 ? 1 : 0) + w - ct * mq) * 256; }
        ro = __builtin_amdgcn_readfirstlane(L.roff[e]); cnt = __builtin_amdgcn_readfirstlane(L.roff[e + 1]) - ro; return true; }
    __device__ __forceinline__ bf16_t* panel(int e, int ct) const { return (bf16_t*)(ws + bc_off) + (size_t)(e * nct + ct) * (1024 * 256); }
};
struct PolMoe1 : PolMoe {
    __device__ __forceinline__ unsigned list_voff(const TD& td) const { return 4u * (unsigned)(td.i0 * NTOK + td.i2 + lane * 4); }
    __device__ __forceinline__ void late(TD& td, const LAS int* ll) const { const int cl = td.i4 - 1 - td.i2;
#pragma unroll
        for (int i2 = 0; i2 < 2; ++i2) { int rl = prow(i2); rl = rl < cl ? rl : cl; td.aoff[i2] = (unsigned)((ll[rl] * D + pcol()) * 2); } }
    __device__ __forceinline__ unsigned bias_voff(const TD& td) const { return 4u * (unsigned)((layer * NEXP + td.i0) * (2 * DFF) + (lane >> 5) * DFF + td.i1 * 128 + (lane & 31) * 4); }
    __device__ __forceinline__ bool get(int i, TD& td) const { int e, ct, rbase, ro, cnt; if (!find(i, e, ct, rbase, ro, cnt)) return false;
        const int* list = (const int*)(ws + WS_LIST) + (size_t)e * NTOK; td.A = (const bf16_t*)(ws + WS_H);
        if (!has_list || i == 0) {
#pragma unroll
            for (int i2 = 0; i2 < 4; ++i2) { int rr = rbase + prow(i2); rr = rr < cnt ? rr : cnt - 1; td.aoff[i2] = (unsigned)((list[rr] * D + pcol()) * 2); } }
        if (round == 0) { td.B = W + ((size_t)(layer * NEXP + e) * D + wid * 8) * (2 * DFF) + ct * 128; td.ldb = 2 * DFF; td.bco = panel(e, ct); } else { td.B = panel(e, ct); td.bco = nullptr; }
        td.i0 = e; td.i1 = ct; td.i2 = rbase; td.i3 = ro; td.i4 = cnt; return true; }
    __device__ __forceinline__ void epi(f32x4 (&acc)[8][4], const TD& td, const LAS float* bl) const { (void)bl; EPI_GEOM; const int e = td.i0, ct = td.i1, rbase = td.i2, ro = td.i3, cnt = td.i4;
        bf16_t* ACT = (bf16_t*)(ws + WS_ACT);
#pragma unroll
        for (int n = 0; n < 2; ++n) { const int gc = ct * 128 + wc * 32 + n * 16 + 4 * fq;
            const int gl = wc * 32 + n * 16 + 4 * fq; const f32x4 bg = bl ? *(const LAS f32x4*)(bl + gl) : *(const f32x4*)(bias + (size_t)(layer * NEXP + e) * (2 * DFF) + gc), bu = bl ? *(const LAS f32x4*)(bl + 128 + gl) : *(const f32x4*)(bias + (size_t)(layer * NEXP + e) * (2 * DFF) + DFF + gc);
#pragma unroll
            for (int m = 0; m < 8; ++m) { const int r = rbase + wr * 128 + m * 16 + fr; float a[4];
#pragma unroll
                for (int j = 0; j < 4; ++j) { const float gg = fminf(acc[m][n][j] + bg[j], 7.f), uu = __builtin_amdgcn_fmed3f(acc[m][n + 2][j] + bu[j], -7.f, 7.f);
                    a[j] = (uu + 1.f) * gg * __builtin_amdgcn_rcpf(1.f + fexp2(-1.702f * LOG2E * gg)); }
                if (r < cnt) { u32x2 w; w.x = pk2(a[0], a[1]); w.y = pk2(a[2], a[3]); *(u32x2*)(ACT + (size_t)(ro + r) * DFF + gc) = w; } } } }
};
struct PolMoe2 : PolMoe {
    __device__ __forceinline__ unsigned bias_voff(const TD& td) const { return 4u * (unsigned)((layer * NEXP + td.i0) * D + td.i1 * 256 + lane * 4); }
    __device__ __forceinline__ bool get(int i, TD& td) const { int e, ct, rbase, ro, cnt; if (!find(i, e, ct, rbase, ro, cnt)) return false;
        td.A = (const bf16_t*)(ws + WS_ACT);
#pragma unroll
        for (int i2 = 0; i2 < 4; ++i2) { int rr = rbase + prow(i2); rr = rr < cnt ? rr : cnt - 1; td.aoff[i2] = (unsigned)(((ro + rr) * DFF + pcol()) * 2); }
        td.B = panel(e, ct); td.bco = nullptr;
        td.i0 = e; td.i1 = ct; td.i2 = rbase; td.i3 = ro; td.i4 = cnt; return true; }
    __device__ __forceinline__ void epi(f32x4 (&acc)[8][4], const TD& td, const LAS float* bl) const { (void)bl; EPI_GEOM; const int e = td.i0, ct = td.i1, rbase = td.i2, ro = td.i3, cnt = td.i4;
        bf16_t* Y = (bf16_t*)(ws + WS_Y);
#pragma unroll
        for (int n = 0; n < 4; ++n) { const int c = ct * 256 + wc * 64 + n * 16 + 4 * fq; const f32x4 bv = bl ? *(const LAS f32x4*)(bl + wc * 64 + n * 16 + 4 * fq) : *(const f32x4*)(bias + (size_t)(layer * NEXP + e) * D + c);
#pragma unroll
            for (int m = 0; m < 8; ++m) { const int r = rbase + wr * 128 + m * 16 + fr;
                if (r < cnt) { u32x2 w; w.x = pk2(acc[m][n][0] + bv[0], acc[m][n][1] + bv[1]); w.y = pk2(acc[m][n][2] + bv[2], acc[m][n][3] + bv[3]); *(u32x2*)(Y + (size_t)(ro + r) * D + c) = w; } } } }
};
__device__ __forceinline__ void phase_moe1(Frame& F, const XcdBarrier& bar, const bool use_bar, const int layer) {
    const MoeLds L = moe_lds(F);
    moe_prefix(F, layer, L);
    const int ne = __builtin_amdgcn_readfirstlane(L.nz[32]), tq = __builtin_amdgcn_readfirstlane(L.mtq[32]);
    const float* W = PP(moe_w_gu); const float* bias = PP(moe_b_gu);
    { PolMoe1 P; P.L = L; P.layer = layer; P.nct = 8; P.round = 0; P.bc_off = WS_BC; P.base_init(F, D / 64, ne * 8); P.bfm = false; P.W = W; P.bias = bias;
      { const int l2 = F.lane & 31; P.lcolb = 4u * (unsigned)((F.lane >> 5) * DFF + 4 * l2); P.woff = 2u * (unsigned)(((4 * l2) >> 5) * 64 + (F.lane >> 5) * 32 + ((4 * l2) & 31)); }
      gemm_stream(F.lds, P, F.wid, F.lane); }
    if (use_bar) xcd_barrier(bar);
    { PolMoe1 P; P.L = L; P.layer = layer; P.nct = 8; P.round = 1; P.bc_off = WS_BC; P.base_init(F, D / 64, tq * 8); P.ldbB = 256; P.W = W; P.bias = bias; P.has_bias = true; P.has_list = true; P.listp = (const int*)(F.ws + WS_LIST);
      gemm_stream_bf(F.lds, P, F.wid, F.lane); }
}
__device__ __forceinline__ void phase_moe2(Frame& F, const int layer) {
    const MoeLds L = moe_lds(F);
    moe_prefix(F, layer, L);
    PolMoe2 P; P.L = L; P.layer = layer; P.nct = 4; P.round = 2; P.bc_off = WS_BC2; P.base_init(F, DFF / 64, __builtin_amdgcn_readfirstlane(L.mtp[32]) * 4); P.ldbB = 256; P.W = nullptr; P.bias = PP(moe_b_dn); P.has_bias = true;
    gemm_stream_bf(F.lds, P, F.wid, F.lane);
}

__device__ __forceinline__ void phase_combine(Frame& F, const int layer) {
    const MoeLds ML = moe_lds(F); LAS int* roff = ML.roff;
    moe_prefix(F, layer, ML);
    const int nrows = layer == 0 ? NTOK : NMAIN, lane = F.lane;
    const int gw = F.bid * 8 + F.wid, NGW = F.G * 8;
    i32x4 ps_n = (i32x4){0, 0, 0, 0}; f32x4 tw_n = (f32x4){0.f, 0.f, 0.f, 0.f}, tw_c = tw_n;
    u32x2 y_c[4][4], y_n[4][4]; f32x4 xs_c[4], xs_n[4];
#define CMB_IDX(row_) do { if ((row_) < nrows) { ps_n = *(const i32x4*)(F_POS + (size_t)(row_) * 4); tw_n = *(const f32x4*)(F_TOPW + (size_t)(row_) * 4); } } while (0)
#define CMB_DATA(row_, Y_, XS_) do { if ((row_) < nrows) { \
        _Pragma("unroll") for (int k = 0; k < 4; ++k) { const int e = ps_n[k] & 255, pos = ps_n[k] >> 8; const bf16_t* y = F_Y + (size_t)(roff[e] + pos) * D; \
            _Pragma("unroll") for (int j = 0; j < 4; ++j) Y_[k][j] = *(const u32x2*)(y + 4 * lane + 256 * j); } \
        _Pragma("unroll") for (int j = 0; j < 4; ++j) XS_[j] = *(const f32x4*)(F_XS + (size_t)(row_) * D + 4 * lane + 256 * j); } } while (0)
    CMB_IDX(gw); CMB_DATA(gw, y_c, xs_c); tw_c = tw_n; CMB_IDX(gw + NGW);
    for (int row = gw; row < nrows; row += NGW) {
        CMB_DATA(row + NGW, y_n, xs_n); const f32x4 tw_nn = tw_n; CMB_IDX(row + 2 * NGW);
        const int r = mod_row(row); const float* g2 = modp(F, layer, r, 5);
        f32x4 v[4];
#pragma unroll
        for (int j = 0; j < 4; ++j) v[j] = (f32x4){0.f, 0.f, 0.f, 0.f};
#pragma unroll
        for (int k = 0; k < 4; ++k) { const float w = tw_c[k];
#pragma unroll
            for (int j = 0; j < 4; ++j) { const u32x2 u = y_c[k][j]; v[j][0] += w * bflo(u.x); v[j][1] += w * bfhi(u.x); v[j][2] += w * bflo(u.y); v[j][3] += w * bfhi(u.y); } }
#pragma unroll
        for (int j = 0; j < 4; ++j) { const int c = 4 * lane + 256 * j; const f32x4 gv = *(const f32x4*)(g2 + c); v[j] = xs_c[j] + gv * v[j]; }
        const float rstd = row_rstd(v);
        if (layer == 0) {
#pragma unroll
            for (int j = 0; j < 4; ++j) *(f32x4*)(F_XS + (size_t)row * D + 4 * lane + 256 * j) = v[j];
            norm_mod_store(v, rstd, PP(norm_mix) + D, modp(F, 1, r, 1), modp(F, 1, r, 0), F_H + (size_t)row * D, lane);
        } else {
#pragma unroll
            for (int j = 0; j < 4; ++j) { const int c = 4 * lane + 256 * j; const f32x4 g = *(const f32x4*)(PP(final_norm) + c); *(f32x4*)(((float*)ldp(F, (int)__builtin_offsetof(Params, out))) + (size_t)row * D + c) = v[j] * rstd * g; }
        }
        tw_c = tw_nn;
#pragma unroll
        for (int k = 0; k < 4; ++k)
#pragma unroll
            for (int j = 0; j < 4; ++j) y_c[k][j] = y_n[k][j];
#pragma unroll
        for (int j = 0; j < 4; ++j) xs_c[j] = xs_n[j];
        __builtin_amdgcn_sched_barrier(0);
    }
#undef CMB_IDX
#undef CMB_DATA
}

struct PolInproj1 : PolBase {
    const float* W;
    __device__ __forceinline__ bool get(int i, TD& td) const { int t; if (!tileL(i, t)) return false; constexpr int N_MAIN_T = (NMAIN / 256) * 10; int pm, pn;
        if (t < N_MAIN_T) dense_tile(t, NMAIN / 256, 10, pm, pn); else { const int c = t - N_MAIN_T; pm = NMAIN / 256 + (c & 3); pn = 2 + (c >> 2); }
        td.A = (const bf16_t*)(ws + WS_H); dense_aoff(td, pm * 256, D);
        td.B = (const bf16_t*)(ws + WB_OIN) + pn * 256; td.i0 = pm; td.i1 = pn; return true; }
    __device__ __forceinline__ void epi(f32x4 (&acc)[8][4], const TD& td, const LAS float* bl) const { (void)bl; EPI_GEOM; const int pm = td.i0, pn = td.i1;
        if (pn < 6) { bf16_t* PROJ = (bf16_t*)(ws + WS_PROJ);
#pragma unroll
            for (int m = 0; m < 8; ++m) { const int row = pm * 256 + wr * 128 + m * 16 + fr;
#pragma unroll
                for (int n = 0; n < 4; ++n) { u32x2 w; w.x = pk2(acc[m][n][0], acc[m][n][1]); w.y = pk2(acc[m][n][2], acc[m][n][3]);
                    *(u32x2*)(PROJ + (size_t)row * QKV_LD + pn * 256 + wc * 64 + n * 16 + 4 * fq) = w; } }
        } else { const int g = pn - 6, ri = wc >> 1; bf16_t* Z = (bf16_t*)(ws + WS_Z);
#pragma unroll
            for (int m = 0; m < 8; ++m) { const int row = pm * 256 + wr * 128 + m * 16 + fr, b = row >> 12, n1 = (row >> 6) & 63, n2 = row & 63;
                bf16_t* zb = Z + ((((size_t)(b * 64 + n1) * 2 + ri) * 64 + n2) * 512) + g * 128 + (wc & 1) * 64;
#pragma unroll
                for (int n = 0; n < 4; ++n) { u32x2 w; w.x = pk2(acc[m][n][0], acc[m][n][1]); w.y = pk2(acc[m][n][2], acc[m][n][3]); *(u32x2*)(zb + n * 16 + 4 * fq) = w; } } } }
};
__device__ __forceinline__ void phase_inproj_l1(Frame& F) {
    PolInproj1 P; P.base_init(F, D / 64, (NMAIN / 256) * 10 + (NCTX / 256) * 4); P.ldbB = 2560;
    gemm_stream_bf(F.lds, P, F.wid, F.lane);
}

struct PolFour : PolBase {
    int stage;
    __device__ __forceinline__ bool get(int i, TD& td) const { int L; if (!tileL(i, L)) return false; const int b = L >> 7, ct = L & 127;
        td.A = (const bf16_t*)(ws + (stage == 1 ? WS_M1 : WS_M2)); dense_aoff(td, 0, 128);
        td.B = (const bf16_t*)(ws + (stage == 1 ? WS_Z : WS_A1)) + (size_t)b * 128 * 32768 + ct * 256; td.i0 = b; td.i1 = ct; return true; }
    __device__ __forceinline__ void epi(f32x4 (&acc)[8][4], const TD& td, const LAS float* bl) const { (void)bl; EPI_GEOM; const int b = td.i0, ct = td.i1;
        if (wr != 0) return;
        if (stage == 1) { const f32x2* TW = (const f32x2*)(ws + WS_TW); bf16_t* A1 = (bf16_t*)(ws + WS_A1);
#pragma unroll
            for (int m = 0; m < 4; ++m) { const int k1 = m * 16 + fr;
#pragma unroll
                for (int n = 0; n < 4; ++n) { const int col = ct * 256 + wc * 64 + n * 16 + 4 * fq, n2 = col >> 9, c = col & 511;
                    const f32x2 tw = TW[n2 * k1]; const f32x4 re = acc[m][n], im = acc[m + 4][n];
                    const f32x4 ore = re * tw.x + im * tw.y, oim = im * tw.x - re * tw.y; u32x2 w0, w1;
                    w0.x = pk2(ore[0], ore[1]); w0.y = pk2(ore[2], ore[3]); w1.x = pk2(oim[0], oim[1]); w1.y = pk2(oim[2], oim[3]);
                    *(u32x2*)(A1 + ((((size_t)(b * 2 + 0) * 64 + n2) * 64 + k1) * 512) + c) = w0;
                    *(u32x2*)(A1 + ((((size_t)(b * 2 + 1) * 64 + n2) * 64 + k1) * 512) + c) = w1; } }
        } else { const float scl = 1.f / 724.0773439350247f; bf16_t* MIX = (bf16_t*)(ws + WS_MIX);
#pragma unroll
            for (int m = 0; m < 4; ++m) { const int k2 = m * 16 + fr;
#pragma unroll
                for (int n = 0; n < 4; ++n) { const int col = ct * 256 + wc * 64 + n * 16 + 4 * fq, k1 = col >> 9, c = col & 511;
                    const f32x4 o = acc[m][n] * scl; u32x2 w; w.x = pk2(o[0], o[1]); w.y = pk2(o[2], o[3]);
                    *(u32x2*)(MIX + (size_t)(b * SEQ + k1 + 64 * k2) * D + 512 + c) = w; } } } }
};

__device__ __forceinline__ void phase_attn_l1(Frame& F) {
    const int wid = F.wid, lane = F.lane, fr = lane & 15, fq = lane >> 4;
    constexpr int N_NA = NB * 64, N_F1 = NB * 128;
    const float SC = 0.125f * LOG2E;
    for (int it = F.bid; it < N_NA; it += F.G) {
            LAS unsigned char* vl = F.lds + wid * 8192;
            LAS float* rp = (LAS float*)(vl + 5120);
            const int b = it >> 6, r = it & 63, h = wid;
            for (int i = lane; i < 465; i += 64) rp[i] = PP(odd_rpb)[h * 465 + i] * LOG2E;
            for (int qh = 0; qh < 4 / QT; ++qh) {
            const int qc0 = qh * (16 * QT), qrow0 = b * SEQ + r * 64 + qc0;
            bf16x8 qf[QT][2];
#pragma unroll
            for (int qt = 0; qt < QT; ++qt)
#pragma unroll
                for (int ks = 0; ks < 2; ++ks) qf[qt][ks] = *(const bf16x8*)(F_PROJ + (size_t)(qrow0 + qt * 16 + fr) * QKV_LD + h * 64 + ks * 32 + 8 * fq);
            AttnSt st;
#pragma unroll
            for (int qt = 0; qt < QT; ++qt) { st.m[qt] = -1e30f; st.l[qt] = 0.f;
#pragma unroll
                for (int dt = 0; dt < 4; ++dt) st.o[dt][qt] = (f32x4){0.f, 0.f, 0.f, 0.f}; }
            const int r0 = min(max(r - 4, 0), 56);
            int c0q[QT];
#pragma unroll
            for (int qt = 0; qt < QT; ++qt) c0q[qt] = min(max(qc0 + qt * 16 + fr - 8, 0), 48);
            for (int s = 0; s < 16; ++s) {
                const int kr = r0 + (s >> 1), half = s & 1;
                const bf16_t* kp = F_PROJ + (size_t)(b * SEQ + kr * 64 + half * 32) * QKV_LD + 512 + h * 64;
                const bf16_t* vp = kp + 512;
                const LAS float* rpr = rp + (kr - r + 7) * 31 + 15;
#define SKIP_NA(qt) ({ const int qlo_ = qc0 + qt * 16, wlo_ = min(max(qlo_ - 8, 0), 48), whi_ = min(max(qlo_ + 15 - 8, 0), 48) + 15; (half * 32 + 31 < wlo_) || (half * 32 > whi_); })
#define BIAS_NA(qt, kt, j) ({ const int kc = half * 32 + kt * 16 + 4 * fq + j; const int dc = kc - (qc0 + qt * 16 + fr); (kc >= c0q[qt] && kc < c0q[qt] + 16) ? rpr[dc] : -INFINITY; })
                ATTN_STEP(kp, QKV_LD, vp, QKV_LD, SC, BIAS_NA, SKIP_NA);
            }
            for (int s = 0; s < 8; ++s) {
                const bf16_t* kp = F_PROJ + (size_t)(NMAIN + b * CTXL + s * 32) * QKV_LD + 512 + h * 64;
                const bf16_t* vp = kp + 512;
                ATTN_STEP(kp, QKV_LD, vp, QKV_LD, SC, BIAS_NONE, SKIP_NONE);
            }
            attn_store(st, F_MIX + (size_t)qrow0 * D + h * 64, D, fr, fq);
            }
    }
    __syncthreads();
    PolFour P; P.stage = 1; P.base_init(F, 2, N_F1); P.ldbB = 32768;
    gemm_stream_bf(F.lds, P, F.wid, F.lane);
}

__device__ __forceinline__ void phase_fst2(Frame& F) {
    PolFour P; P.stage = 2; P.base_init(F, 2, NB * 128); P.ldbB = 32768;
    gemm_stream_bf(F.lds, P, F.wid, F.lane);
}

__global__ void __launch_bounds__(512, 2) fwd_kernel(Params p) {
    extern __shared__ __attribute__((aligned(16))) unsigned char lds_raw[];
    Frame F;
    F.lds = (LAS unsigned char*)lds_raw;
    F.tid = threadIdx.x; F.lane = F.tid & 63; F.wid = __builtin_amdgcn_readfirstlane(F.tid >> 6); F.bid = blockIdx.x; F.G = gridDim.x;
    unsigned char* ws = p.ws; F.ws = ws;
    volatile LAS unsigned* MISC = (volatile LAS unsigned*)(F.lds + MISC_OFF);
    if (F.tid < 64) MISC[F.tid] = 0u;
    if (F.tid == 64) { LAS unsigned long long* LP = (LAS unsigned long long*)(F.lds + PARAM_OFF);
        LP[0] = (unsigned long long)p.x; LP[1] = (unsigned long long)p.c; LP[2] = (unsigned long long)p.ctx; LP[3] = (unsigned long long)p.c_ctx; LP[4] = (unsigned long long)p.ada_w; LP[5] = (unsigned long long)p.ada_b;
        LP[6] = (unsigned long long)p.norm_mix; LP[7] = (unsigned long long)p.norm_ffn; LP[8] = (unsigned long long)p.even_w_in; LP[9] = (unsigned long long)p.even_w_out; LP[10] = (unsigned long long)p.even_conv_w;
        LP[11] = (unsigned long long)p.even_sink; LP[12] = (unsigned long long)p.odd_w_in; LP[13] = (unsigned long long)p.odd_w_out; LP[14] = (unsigned long long)p.odd_rpb; LP[15] = (unsigned long long)p.router_w;
        LP[16] = (unsigned long long)p.router_b; LP[17] = (unsigned long long)p.moe_w_gu; LP[18] = (unsigned long long)p.moe_b_gu; LP[19] = (unsigned long long)p.moe_w_dn; LP[20] = (unsigned long long)p.moe_b_dn;
        LP[21] = (unsigned long long)p.final_norm; LP[22] = (unsigned long long)p.out; }
    __syncthreads();
    const int lo = p.ph_lo, hi = p.ph_hi;
    XcdBarrier bar; bar.bar = (unsigned*)(ws + WS_CTL) + CW_BAR; bar.x = 0; bar.st = MISC + 8;
    if (hi - lo > 1) bar = xcd_barrier_post((unsigned*)(ws + WS_CTL) + CW_BAR, MISC + 8);
#define RUN_PHASE(ph, call) do { if (PH_ON(ph) && lo <= (ph) && (ph) < hi) { call; if (PH_REP(ph)) { xcd_barrier(bar); call; } } if (lo <= (ph) && (ph) + 1 < hi) xcd_barrier(bar); } while (0)
    RUN_PHASE(PH_PREP, phase_prep(F));
    RUN_PHASE(PH_NORM1_0, phase_norm1_l0(F));
    RUN_PHASE(PH_INPROJ_0, phase_inproj_l0(F));
    RUN_PHASE(PH_ATTN_0, phase_attn_l0(F));
    RUN_PHASE(PH_OUTPROJ_0, phase_outproj(F, 0));
    RUN_PHASE(PH_ROUTE_0, phase_route(F, 0));
    RUN_PHASE(PH_MOE1_0, phase_moe1(F, bar, hi - lo > 1, 0));
    RUN_PHASE(PH_MOE2_0, phase_moe2(F, 0));
    RUN_PHASE(PH_COMB_0, phase_combine(F, 0));
    RUN_PHASE(PH_INPROJ_1, phase_inproj_l1(F));
    RUN_PHASE(PH_ATTN_1, phase_attn_l1(F));
    RUN_PHASE(PH_FST2_1, phase_fst2(F));
    RUN_PHASE(PH_OUTPROJ_1, phase_outproj(F, 1));
    RUN_PHASE(PH_ROUTE_1, phase_route(F, 1));
    RUN_PHASE(PH_MOE1_1, phase_moe1(F, bar, hi - lo > 1, 1));
    RUN_PHASE(PH_MOE2_1, phase_moe2(F, 1));
    RUN_PHASE(PH_FINAL, phase_combine(F, 1));
}

extern "C" void kernel_launch(void* const* d_in, const int* in_sizes, int n_in, void* d_out, int out_size, void* d_ws, size_t ws_size, hipStream_t stream) {
    static int grid = 0;
    if (grid == 0) {
        if (n_in != 22 || ws_size < WS_END) { fprintf(stderr, "kernel_launch: unexpected inputs (n_in %d, ws %zu)\n", n_in, ws_size); grid = -1; return; }
        int dev = 0, cus = 0, per_cu = 0;
        hipGetDevice(&dev);
        hipDeviceGetAttribute(&cus, hipDeviceAttributeMultiprocessorCount, dev);
        hipFuncSetAttribute((const void*)fwd_kernel, hipFuncAttributeMaxDynamicSharedMemorySize, LDS_BYTES);
        hipOccupancyMaxActiveBlocksPerMultiprocessor(&per_cu, (const void*)fwd_kernel, 512, LDS_BYTES);
        if (per_cu < 1) { fprintf(stderr, "kernel_launch: occupancy query says %d blocks/CU\n", per_cu); per_cu = 1; }
        (void)hipGetLastError();
        grid = cus;
    }
    if (grid < 0) return;
    hipMemsetAsync((char*)d_ws + WS_CTL, 0, CTL_BYTES, stream);
    Params p{};
    const float** pp = (const float**)&p;
    for (int i = 0; i < 22; ++i) pp[i] = (const float*)d_in[i];
    p.out = (float*)d_out; p.ws = (unsigned char*)d_ws;
#if N_LAUNCH_MODE == 1
    for (int ph = 0; ph < NPHASE; ++ph) { p.ph_lo = ph; p.ph_hi = ph + 1; hipLaunchKernelGGL(fwd_kernel, dim3(grid), dim3(512), LDS_BYTES, stream, p); }
#else
    p.ph_lo = 0; p.ph_hi = NPHASE;
    void* args[] = {&p};
    hipError_t e = hipLaunchCooperativeKernel((const void*)fwd_kernel, dim3(grid), dim3(512), args, LDS_BYTES, stream);
    if (e != hipSuccess) fprintf(stderr, "kernel_launch: cooperative launch failed: %s (grid %d)\n", hipGetErrorString(e), grid);
#endif
}
```

```cpp
#include <hip/hip_runtime.h>
#include <cstdio>
#include <cstdint>

#ifndef N_LAUNCH_MODE
#define N_LAUNCH_MODE 0
#endif

#ifndef PHASE_MASK
#define PHASE_MASK 0x1FFFF
#endif
#define PH_ON(ph) ((PHASE_MASK >> (ph)) & 1)
#ifndef REPEAT_MASK
#define REPEAT_MASK 0
#endif
#define PH_REP(ph) ((REPEAT_MASK >> (ph)) & 1)
#define LAS __attribute__((address_space(3)))
#define GAS __attribute__((address_space(1)))
typedef unsigned short bf16_t;
typedef short bf16x8 __attribute__((ext_vector_type(8)));
typedef short s16x4 __attribute__((ext_vector_type(4)));
typedef float f32x4 __attribute__((ext_vector_type(4)));
typedef float f32x2 __attribute__((ext_vector_type(2)));
typedef int i32x4 __attribute__((ext_vector_type(4)));
typedef unsigned u32x2 __attribute__((ext_vector_type(2)));
typedef unsigned u32x4 __attribute__((ext_vector_type(4)));

constexpr int D = 1024, NB = 4, SEQ = 4096, CTXL = 256;
constexpr int NMAIN = NB * SEQ, NCTX = NB * CTXL, NTOK = NMAIN + NCTX;
constexpr int EVEN_IN = 2304, NEXP = 32, DFF = 1024;
constexpr int QKV_LD = 1536;
constexpr float NORM_EPS = 1e-6f;
constexpr float LOG2E = 1.4426950408889634f;

constexpr size_t MiB = 1ull << 20;
constexpr size_t WS_CTL = 0, CTL_BYTES = 1 * MiB;
constexpr size_t WS_MOD = 1 * MiB;
constexpr size_t WS_M1 = 2 * MiB;
constexpr size_t WS_M2 = WS_M1 + 65536;
constexpr size_t WS_ROPE = WS_M2 + 65536;
constexpr size_t WS_TW = WS_ROPE + 8192;
constexpr size_t WS_WF = 4 * MiB;
constexpr size_t WS_TOPW = 8 * MiB;
constexpr size_t WS_POS = 9 * MiB;
constexpr size_t WS_LIST = 12 * MiB;
constexpr size_t WS_H = 16 * MiB;
constexpr size_t WS_MIX = 52 * MiB;
constexpr size_t WS_XS = 88 * MiB;
constexpr size_t WS_PROJ = 160 * MiB;
constexpr size_t WS_Z = 240 * MiB;
constexpr size_t WS_A1 = 304 * MiB;
constexpr size_t WS_ACT = 368 * MiB;
constexpr size_t WS_Y = 512 * MiB;
constexpr size_t WS_WB = 656 * MiB;
constexpr size_t WB_EIN = WS_WB, WB_EOUT = WB_EIN + (size_t)D * EVEN_IN * 2, WB_OIN = WB_EOUT + (size_t)D * D * 2, WB_OOUT = WB_OIN + (size_t)D * 2560 * 2;
constexpr size_t WS_BC = 672 * MiB;
constexpr size_t WS_BC2 = WS_BC + 128 * MiB;
constexpr size_t WS_END = 864 * MiB;
constexpr int CW_BAR = 4096;
constexpr int CW_CNT = 8192;

constexpr int LDS_BYTES = 147456;
constexpr int PARAM_OFF = LDS_BYTES - 512;
constexpr int MISC_OFF = LDS_BYTES - 256;
constexpr int A_TILE_B = 32768, B_ROWB = 544, B_TILE_B = 64 * B_ROWB, STAGE_B = A_TILE_B + B_TILE_B;
static_assert(2 * STAGE_B + 1024 + 8192 <= PARAM_OFF, "LDS");

enum { PH_PREP = 0, PH_NORM1_0, PH_INPROJ_0, PH_ATTN_0, PH_OUTPROJ_0, PH_ROUTE_0, PH_MOE1_0, PH_MOE2_0, PH_COMB_0,
       PH_INPROJ_1, PH_ATTN_1, PH_FST2_1, PH_OUTPROJ_1, PH_ROUTE_1, PH_MOE1_1, PH_MOE2_1, PH_FINAL, NPHASE };

struct Params {
    const float *x, *c, *ctx, *c_ctx, *ada_w, *ada_b, *norm_mix, *norm_ffn, *even_w_in, *even_w_out, *even_conv_w, *even_sink,
                *odd_w_in, *odd_w_out, *odd_rpb, *router_w, *router_b, *moe_w_gu, *moe_b_gu, *moe_w_dn, *moe_b_dn, *final_norm;
    float* out; unsigned char* ws; int ph_lo, ph_hi;
};

__device__ __forceinline__ unsigned pk2(float lo, float hi) { unsigned r; asm("v_cvt_pk_bf16_f32 %0, %1, %2" : "=v"(r) : "v"(lo), "v"(hi)); return r; }
__device__ __forceinline__ float bflo(unsigned u) { return __builtin_bit_cast(float, u << 16); }
__device__ __forceinline__ float bfhi(unsigned u) { return __builtin_bit_cast(float, u & 0xffff0000u); }
__device__ __forceinline__ float wave_sum(float v) {
#pragma unroll
    for (int o = 1; o < 64; o <<= 1) v += __shfl_xor(v, o);
    return v;
}
__device__ __forceinline__ float fexp2(float x) { return __builtin_amdgcn_exp2f(x); }

#define XB_TMO      128
#define XB_XCNT(j)  (256  + 64 * (j))
#define XB_XSUB(j)  (1280 + 64 * (j))
#define XB_XGEN(j)  (2304 + 64 * (j))
#define XB_TOP      3328
#define XB_TOPGEN   3392
#define XB_SPIN_CAP (1u << 22)
__device__ __forceinline__ unsigned xb_ld(unsigned* p)              { return __hip_atomic_load(p, __ATOMIC_RELAXED, __HIP_MEMORY_SCOPE_AGENT); }
__device__ __forceinline__ unsigned xb_add(unsigned* p, unsigned v) { return __hip_atomic_fetch_add(p, v, __ATOMIC_RELAXED, __HIP_MEMORY_SCOPE_AGENT); }
__device__ __forceinline__ unsigned xb_xcc_id() { return (unsigned)__builtin_amdgcn_s_getreg((3 << 11) | 20) & 0xFu; }
#define XB_SPIN(cond, bar) do { unsigned _sp = 0; while (cond) { __builtin_amdgcn_s_sleep(1); \
    if ((++_sp & 255u) == 0u) { if (xb_ld(&(bar)[XB_TMO])) break; if (_sp > XB_SPIN_CAP) { atomicAdd(&(bar)[XB_TMO], 1u); break; } } } } while (0)
struct XcdBarrier { unsigned* bar; unsigned x; volatile LAS unsigned* st; };
__device__ __forceinline__ XcdBarrier xcd_barrier_post(unsigned* bar, volatile LAS unsigned* st) {
    XcdBarrier b; b.bar = bar; b.x = xb_xcc_id(); b.st = st;
    if (threadIdx.x == 0) (void)xb_add(&bar[XB_XCNT(b.x)], 1u);
    return b;
}
__device__ __forceinline__ void xcd_barrier_complete(unsigned* bar, unsigned x, unsigned& nloc, unsigned& nx) {
    const unsigned G = gridDim.x * gridDim.y * gridDim.z;
    unsigned sum, cnt, mine, sp = 0u;
    for (;;) {
        sum = 0u; cnt = 0u; mine = 0u;
#pragma unroll
        for (unsigned j = 0; j < 16; ++j) { const unsigned c = xb_ld(&bar[XB_XCNT(j)]); sum += c; cnt += (c > 0u) ? 1u : 0u; mine = (j == x) ? c : mine; }
        if (sum == G) break;
        __builtin_amdgcn_s_sleep(1);
        if ((++sp & 255u) == 0u) { if (xb_ld(&bar[XB_TMO])) break; if (sp > XB_SPIN_CAP) { atomicAdd(&bar[XB_TMO], 1u); break; } }
    }
    nloc = mine > 0u ? mine : 1u; nx = cnt > 0u ? cnt : 1u;
}
__device__ __forceinline__ void xcd_barrier(const XcdBarrier& b) {
    asm volatile("s_waitcnt vmcnt(0)" ::: "memory");
    __syncthreads();
    if (threadIdx.x == 0) {
        unsigned* bar = b.bar;
        __builtin_amdgcn_s_waitcnt(0);
        unsigned nloc = b.st[0], nx = b.st[1];
        if (nloc == 0u) { xcd_barrier_complete(bar, b.x, nloc, nx); b.st[0] = nloc; b.st[1] = nx; }
        const unsigned old = xb_add(&bar[XB_XSUB(b.x)], 1u);
        const unsigned gen = old / nloc;
        if (old + 1u == (gen + 1u) * nloc) {
            __builtin_amdgcn_fence(__ATOMIC_RELEASE, "agent");
            asm volatile("s_waitcnt vmcnt(0)" ::: "memory");
            const unsigned og = xb_add(&bar[XB_TOP], 1u);
            const unsigned tg = og / nx;
            if (og + 1u == (tg + 1u) * nx) xb_add(&bar[XB_TOPGEN], 1u);
            else XB_SPIN(xb_ld(&bar[XB_TOPGEN]) == tg, bar);
            __builtin_amdgcn_fence(__ATOMIC_ACQUIRE, "agent");
            xb_add(&bar[XB_XGEN(b.x)], 1u);
            asm volatile("s_waitcnt vmcnt(0)" ::: "memory");
        } else {
            XB_SPIN(xb_ld(&bar[XB_XGEN(b.x)]) == gen, bar);
            __builtin_amdgcn_fence(__ATOMIC_ACQUIRE, "agent");
            asm volatile("s_waitcnt vmcnt(0)" ::: "memory");
        }
    }
    __syncthreads();
}

struct TD { const bf16_t* A; const void* B; bf16_t* bco; unsigned ldb; unsigned aoff[4]; int i0, i1, i2, i3, i4; };
__device__ __forceinline__ int a_piece_row0(int wid, int lane) { const int sb = lane * 16, swz = sb ^ (((sb >> 9) & 1) << 5); return (wid >> 1) * 16 + (swz >> 6); }
__device__ __forceinline__ int a_piece_col(int wid, int lane) { const int sb = lane * 16, swz = sb ^ (((sb >> 9) & 1) << 5); return (wid & 1) * 32 + ((swz & 63) >> 1); }
__device__ __forceinline__ u32x4 make_rsrc(const void* p) { const unsigned long long ab = (unsigned long long)p; u32x4 r; r.x = __builtin_amdgcn_readfirstlane((unsigned)ab); r.y = __builtin_amdgcn_readfirstlane((unsigned)(ab >> 32)) & 0xffffu; r.z = 0x7fffffffu; r.w = 0x00020000u; return r; }

template <class Pol>
__device__ __forceinline__ void gemm_stream(LAS unsigned char* lds, Pol& P, const int wid, const int lane) {
    const int wr = wid >> 2, wc = wid & 3, fr = lane & 15, fq = lane >> 4;
    const unsigned b_w = (unsigned)(A_TILE_B + ((wid >> 2) * 32 + 4 * (wid & 3)) * B_ROWB) + P.woff;
    const unsigned a_r = (unsigned)(wr * 16384 + ((fr * 64 + fq * 16) ^ ((fr >> 3) << 5)));
    const unsigned b_r = (unsigned)(A_TILE_B + (4 * fq + (fr >> 2)) * B_ROWB + (wc * 64 + (fr & 3) * 4) * 2);
    const unsigned ldsa = (unsigned)(__UINTPTR_TYPE__)lds + (unsigned)(wid * 1024);
    const unsigned lcolb = P.lcolb;
    TD cur, nxt;
    if (!P.get(0, cur)) return;
    int nt = P.nt; asm volatile("" : "+s"(nt));
    f32x4 sb[8]; f32x4 acc[8][4];
    u32x4 ra_c = make_rsrc(cur.A), ra_n = ra_c;
    __amdgpu_buffer_rsrc_t rb_c = __builtin_amdgcn_make_buffer_rsrc((void*)cur.B, 0, 0x7fffffff, 0x00020000), rb_n = rb_c;
#define G_GLDS_A(buf, RA, AOFF, kt) do { _Pragma("unroll") for (int i = 0; i < 4; ++i) { unsigned keep_; \
        asm volatile("s_mov_b32 %0, m0\n\ts_mov_b32 m0, %3\n\ts_nop 0\n\tbuffer_load_dwordx4 %1, %2, %4 offen lds\n\ts_mov_b32 m0, %0" \
            : "=&s"(keep_) : "v"(AOFF[i]), "s"(RA), "s"(ldsa + (buf) + (unsigned)(i * 8192)), "s"((unsigned)((kt) * 128)) : "memory"); } } while (0)
#define G_ISSUE_BH(RB, LDB4, kt, h) do { \
        _Pragma("unroll") for (int i = 4 * (h); i < 4 * (h) + 4; ++i) sb[i] = __builtin_bit_cast(f32x4, __builtin_amdgcn_raw_buffer_load_b128(RB, (int)lcolb, (int)(((unsigned)(kt) * 64u + i) * (LDB4)), 0)); \
        __builtin_amdgcn_sched_barrier(0); } while (0)
#define G_WRITE_BH(buf, h, BCO, kt) do { \
        _Pragma("unroll") for (int i = 4 * (h); i < 4 * (h) + 4; ++i) { u32x2 w; w.x = pk2(sb[i][0], sb[i][1]); w.y = pk2(sb[i][2], sb[i][3]); \
            *(LAS u32x2*)(lds + (buf) + b_w + (16 * (i >> 2) + (i & 3)) * B_ROWB) = w; \
            if (BCO) *(u32x2*)((char*)(BCO) + (size_t)((kt) * 64 + wid * 8 + i) * 512 + P.woff) = w; } __builtin_amdgcn_sched_barrier(0); } while (0)
#define G_KSTEP(buf, ks) do { bf16x8 Bf[4]; \
        _Pragma("unroll") for (int n = 0; n < 4; ++n) { \
            const s16x4 lo = __builtin_amdgcn_ds_read_tr16_b64_v4i16((LAS s16x4*)(lds + (buf) + b_r + (ks) * 32 * B_ROWB + n * 32)); \
            const s16x4 hi = __builtin_amdgcn_ds_read_tr16_b64_v4i16((LAS s16x4*)(lds + (buf) + b_r + (ks) * 32 * B_ROWB + 16 * B_ROWB + n * 32)); \
            Bf[n] = (bf16x8){lo[0], lo[1], lo[2], lo[3], hi[0], hi[1], hi[2], hi[3]}; } \
        _Pragma("unroll") for (int mh = 0; mh < 2; ++mh) { bf16x8 At[4]; \
            _Pragma("unroll") for (int m = 0; m < 4; ++m) At[m] = *(const LAS bf16x8*)(lds + (buf) + a_r + (mh * 4 + m) * 2048 + (ks) * 1024); \
            _Pragma("unroll") for (int m = 0; m < 4; ++m) _Pragma("unroll") for (int n = 0; n < 4; ++n) \
                acc[mh * 4 + m][n] = __builtin_amdgcn_mfma_f32_16x16x32_bf16(Bf[n], At[m], acc[mh * 4 + m][n], 0, 0, 0); } \
        __builtin_amdgcn_sched_barrier(0); } while (0)
    { unsigned b0 = 0; asm volatile("" : "+s"(b0));
      const unsigned l4 = cur.ldb * 4u;
      G_GLDS_A(b0, ra_c, cur.aoff, 0); G_ISSUE_BH(rb_c, l4, 0, 0); G_ISSUE_BH(rb_c, l4, 0, 1); G_WRITE_BH(b0, 0, cur.bco, 0); G_WRITE_BH(b0, 1, cur.bco, 0);
      G_ISSUE_BH(rb_c, l4, 1, 0); G_ISSUE_BH(rb_c, l4, 1, 1); }
    asm volatile("s_waitcnt vmcnt(8)" ::: "memory");
    asm volatile("s_waitcnt lgkmcnt(0)" ::: "memory");
    __builtin_amdgcn_s_barrier();
    unsigned par = 0;
    for (int ti = 0;; ++ti) {
        const bool hasn = P.get(ti + 1, nxt);
        if (hasn) { ra_n = make_rsrc(nxt.A); rb_n = __builtin_amdgcn_make_buffer_rsrc((void*)nxt.B, 0, 0x7fffffff, 0x00020000); }
#pragma unroll
        for (int m = 0; m < 8; ++m)
#pragma unroll
            for (int n = 0; n < 4; ++n) acc[m][n] = (f32x4){0.f, 0.f, 0.f, 0.f};
        for (int t = 0; t < nt; ++t) {
            unsigned bc = par * STAGE_B, bn = (par ^ 1u) * STAGE_B; asm volatile("" : "+s"(bc), "+s"(bn));
            const bool c1 = t + 1 < nt, w1 = c1 || hasn, c2 = t + 2 < nt, i2 = c2 || hasn;
            if (w1) { const u32x4 ra = c1 ? ra_c : ra_n; unsigned ao[4];
#pragma unroll
                for (int i = 0; i < 4; ++i) ao[i] = c1 ? cur.aoff[i] : nxt.aoff[i];
                G_GLDS_A(bn, ra, ao, c1 ? t + 1 : 0); }
            G_KSTEP(bc, 0);
            const __amdgpu_buffer_rsrc_t rb = c2 ? rb_c : rb_n; const unsigned l4 = (c2 ? cur.ldb : nxt.ldb) * 4u; const int k2 = c2 ? t + 2 : t + 2 - nt;
            bf16_t* const bco = c1 ? cur.bco : nxt.bco; const int k1 = c1 ? t + 1 : 0;
            if (w1) G_WRITE_BH(bn, 0, bco, k1);
            if (i2) G_ISSUE_BH(rb, l4, k2, 0);
            G_KSTEP(bc, 1);
            if (w1) G_WRITE_BH(bn, 1, bco, k1);
            if (i2) { G_ISSUE_BH(rb, l4, k2, 1); asm volatile("s_waitcnt vmcnt(8)" ::: "memory"); }
            else asm volatile("s_waitcnt vmcnt(0)" ::: "memory");
            asm volatile("s_waitcnt lgkmcnt(0)" ::: "memory");
            __builtin_amdgcn_s_barrier();
            par ^= 1u;
        }
        P.epi(acc, cur, (const LAS float*)nullptr);
        if (!hasn) break;
        cur = nxt; ra_c = ra_n; rb_c = rb_n;
    }
#undef G_GLDS_A
#undef G_ISSUE_BH
#undef G_WRITE_BH
#undef G_KSTEP
}

constexpr int STEP_B = 32768;
constexpr unsigned ROPE_LDS = 2 * STAGE_B + 1024;
constexpr unsigned BIAS_OFF = 4 * STEP_B;
template <class Pol, int ABL = 0>
__device__ __forceinline__ void gemm_stream_bf(LAS unsigned char* lds, Pol& P, const int wid, const int lane) {
    const int wr = wid >> 2, wc = wid & 3, fr = lane & 15, fq = lane >> 4;
    const unsigned a_r = (unsigned)(wr * 8192 + ((fr * 64 + fq * 16) ^ ((fr >> 3) << 5)));
    const int x7 = 4 * (fq & 1) + (fr >> 2);
    unsigned b_r[4];
#pragma unroll
    for (int n = 0; n < 4; ++n) b_r[n] = (unsigned)(16384 + (4 * fq + (fr >> 2)) * 512 + (((wc * 4 + n) ^ x7) * 32) + (fr & 3) * 8);
    const unsigned ldsa = (unsigned)(__UINTPTR_TYPE__)lds + (unsigned)(wid * 2048), ldsb = (unsigned)(__UINTPTR_TYPE__)lds + 16384u + (unsigned)(wid * 2048);
    const unsigned ldb2 = P.ldbB * 2u;
    unsigned boff[2];
#pragma unroll
    for (int j = 0; j < 2; ++j) { const int sl = 4 * wid + 2 * j + (lane >> 5), u = lane & 31, c = (u >> 1) ^ (sl & 7), n = c * 16 + (u & 1) * 8;
        const int k = 8 * ((sl >> 2) & 3) + 4 * (sl >> 4) + (sl & 3); boff[j] = (unsigned)k * ldb2 + (unsigned)n * 2u; }
    TD cur, nxt;
    if (!P.get(0, cur)) return;
    int nt = P.nt * 2; asm volatile("" : "+s"(nt));
    f32x4 acc[8][4];
    u32x4 ra_c = make_rsrc(cur.A), ra_n = ra_c, rb_c = make_rsrc(cur.B), rb_n = rb_c;
#define H_DMA(LDSADDR, RS, VOFF, SOFF) do { unsigned keep_; \
        asm volatile("s_mov_b32 %0, m0\n\ts_mov_b32 m0, %3\n\ts_nop 0\n\tbuffer_load_dwordx4 %1, %2, %4 offen lds\n\ts_mov_b32 m0, %0" \
            : "=&s"(keep_) : "v"(VOFF), "s"(RS), "s"(LDSADDR), "s"(SOFF) : "memory"); } while (0)
#define H_STAGE(sb_, RA, AO0, AO1, RB, st) do { \
        if (!(ABL & 2)) { H_DMA(ldsa + (sb_), RA, AO0, (unsigned)((st) * 64)); H_DMA(ldsa + (sb_) + 1024u, RA, AO1, (unsigned)((st) * 64)); } \
        if (!(ABL & 1)) { H_DMA(ldsb + (sb_), RB, boff[0], (unsigned)(st) * 32u * ldb2); H_DMA(ldsb + (sb_) + 1024u, RB, boff[1], (unsigned)(st) * 32u * ldb2); } } while (0)
#define H_READ(sb_) do { if (!(ABL & 16)) { \
        _Pragma("unroll") for (int n = 0; n < 4; ++n) { \
            const s16x4 lo = __builtin_amdgcn_ds_read_tr16_b64_v4i16((LAS s16x4*)(lds + (sb_) + b_r[n])); \
            const s16x4 hi = __builtin_amdgcn_ds_read_tr16_b64_v4i16((LAS s16x4*)(lds + (sb_) + b_r[n] + 8192)); \
            Bf[n] = (bf16x8){lo[0], lo[1], lo[2], lo[3], hi[0], hi[1], hi[2], hi[3]}; } \
        _Pragma("unroll") for (int m = 0; m < 8; ++m) At[m] = *(const LAS bf16x8*)(lds + (sb_) + a_r + m * 1024); } } while (0)
#define H_MMA() do { if (!(ABL & 16)) { __builtin_amdgcn_s_setprio(1); \
        if (!(ABL & 4)) { _Pragma("unroll") for (int m = 0; m < 8; ++m) _Pragma("unroll") for (int n = 0; n < 4; ++n) \
            acc[m][n] = __builtin_amdgcn_mfma_f32_16x16x32_bf16(Bf[n], At[m], acc[m][n], 0, 0, 0); } \
        else { _Pragma("unroll") for (int m = 0; m < 8; ++m) asm volatile("" :: "v"(At[m])); _Pragma("unroll") for (int n = 0; n < 4; ++n) asm volatile("" :: "v"(Bf[n])); } \
        __builtin_amdgcn_s_setprio(0); } } while (0)
#define H_BAR() do { asm volatile("s_waitcnt lgkmcnt(0)" ::: "memory"); __builtin_amdgcn_s_barrier(); __builtin_amdgcn_sched_barrier(0); } while (0)
    bf16x8 At[8], Bf[4];
    { unsigned s0 = 0, s1 = STEP_B, s2 = 2 * STEP_B; asm volatile("" : "+s"(s0), "+s"(s1), "+s"(s2));
      H_STAGE(s0, ra_c, cur.aoff[0], cur.aoff[1], rb_c, 0); H_STAGE(s1, ra_c, cur.aoff[0], cur.aoff[1], rb_c, 1); H_STAGE(s2, ra_c, cur.aoff[0], cur.aoff[1], rb_c, 2); }
    asm volatile("s_waitcnt vmcnt(8)" ::: "memory");
    H_BAR();
    if (wr == 1) H_BAR();
    unsigned g = 0;
    for (int ti = 0;; ++ti) {
        const bool hasn = P.get(ti + 1, nxt);
        if (hasn) { ra_n = make_rsrc(nxt.A); rb_n = make_rsrc(nxt.B); }
        const unsigned bias_lds = BIAS_OFF + (unsigned)(ti & 1) * 1024u, list_lds = BIAS_OFF + 2048u + (unsigned)(ti & 1) * 1024u;
        if (P.has_bias && wid == 0) { const u32x4 rbias = make_rsrc(P.bias); H_DMA((unsigned)(__UINTPTR_TYPE__)lds + bias_lds, rbias, P.bias_voff(cur), 0u); }
        if (P.has_list && hasn && wid == 1) { const u32x4 rl = make_rsrc(P.listp); H_DMA((unsigned)(__UINTPTR_TYPE__)lds + list_lds, rl, P.list_voff(nxt), 0u); }
#pragma unroll
        for (int m = 0; m < 8; ++m)
#pragma unroll
            for (int n = 0; n < 4; ++n) acc[m][n] = (f32x4){0.f, 0.f, 0.f, 0.f};
        for (int t = 0; t < nt; ++t, ++g) {
            unsigned sc = (g & 3u) * STEP_B, sn = ((g + 3u) & 3u) * STEP_B; asm volatile("" : "+s"(sc), "+s"(sn));
            const bool c3 = t + 3 < nt, i3 = c3 || hasn, i2 = (t + 2 < nt) || hasn;
            if (P.has_list && hasn && t == nt - 3) P.late(nxt, (const LAS int*)(lds + list_lds));
            if (i3) { const u32x4 ra = c3 ? ra_c : ra_n, rb = c3 ? rb_c : rb_n; const unsigned a0 = c3 ? cur.aoff[0] : nxt.aoff[0], a1 = c3 ? cur.aoff[1] : nxt.aoff[1];
                H_STAGE(sn, ra, a0, a1, rb, c3 ? t + 3 : t + 3 - nt); }
            H_READ(sc);
            if (i3) asm volatile("s_waitcnt vmcnt(8)" ::: "memory");
            else if (i2) asm volatile("s_waitcnt vmcnt(4)" ::: "memory");
            else asm volatile("s_waitcnt vmcnt(0)" ::: "memory");
            H_BAR();
            H_MMA();
            H_BAR();
        }
        if (!(ABL & 8)) P.epi(acc, cur, (const LAS float*)(lds + bias_lds)); else { _Pragma("unroll") for (int m = 0; m < 8; ++m) _Pragma("unroll") for (int n = 0; n < 4; ++n) asm volatile("" :: "v"(acc[m][n])); }
        if (!hasn) break;
        cur = nxt; ra_c = ra_n; rb_c = rb_n;
    }
    if (wr == 0) H_BAR();
#undef H_DMA
#undef H_STAGE
#undef H_READ
#undef H_MMA
#undef H_BAR
}

struct XOrder {
    int c1, step, cur;
    __device__ __forceinline__ void init(int T, int G, int bid) {
        if ((G & 7) == 0) { const int x = bid & 7; cur = (int)(((long)x * T) >> 3) + (bid >> 3); c1 = (int)(((long)(x + 1) * T) >> 3); step = G >> 3; }
        else { cur = bid; c1 = T; step = G; }
    }
    __device__ __forceinline__ bool next(int& L) { if (cur >= c1) return false; L = cur; cur += step; return true; }
};
__device__ __forceinline__ void dense_tile(int L, int nM, int nN, int& pm, int& pn) { const int per = 8 * nN, g = L / per, w = L - g * per, fm = g * 8, gs = (nM - fm) < 8 ? (nM - fm) : 8; pn = w / gs; pm = fm + w - pn * gs; }

struct Frame { LAS unsigned char* lds; int tid, lane, wid, bid, G; unsigned char* ws; };
__device__ __forceinline__ const void* ldp(const Frame& F, int off) {
    const u32x2 v = *(const volatile LAS u32x2*)(F.lds + PARAM_OFF + off);
    const unsigned lo = __builtin_amdgcn_readfirstlane(v.x), hi = __builtin_amdgcn_readfirstlane(v.y);
    return (const void*)(((unsigned long long)hi << 32) | lo);
}
#define PP(f) ((const float*)ldp(F, (int)__builtin_offsetof(Params, f)))
#define F_mod ((float*)(F.ws + WS_MOD))
#define F_M1 ((bf16_t*)(F.ws + WS_M1))
#define F_M2 ((bf16_t*)(F.ws + WS_M2))
#define F_ROPE ((f32x2*)(F.ws + WS_ROPE))
#define F_TW ((f32x2*)(F.ws + WS_TW))
#define F_WF ((float*)(F.ws + WS_WF))
#define F_TOPW ((float*)(F.ws + WS_TOPW))
#define F_POS ((int*)(F.ws + WS_POS))
#define F_LIST ((int*)(F.ws + WS_LIST))
#define F_H ((bf16_t*)(F.ws + WS_H))
#define F_MIX ((bf16_t*)(F.ws + WS_MIX))
#define F_XS ((float*)(F.ws + WS_XS))
#define F_PROJ ((bf16_t*)(F.ws + WS_PROJ))
#define F_Z ((float*)(F.ws + WS_Z))
#define F_A1 ((float*)(F.ws + WS_A1))
#define F_ACT ((bf16_t*)(F.ws + WS_ACT))
#define F_Y ((bf16_t*)(F.ws + WS_Y))
#define F_cnt ((unsigned*)(F.ws + WS_CTL) + CW_CNT)

__device__ __forceinline__ const float* modp(const Frame& F, int l, int r, int which) { return F_mod + ((size_t)(l * 5 + r)) * 6144 + which * 1024; }
__device__ __forceinline__ int mod_row(int row) { return row < NMAIN ? (row >> 12) : 4; }

__device__ __forceinline__ float row_rstd(const f32x4 (&v)[4]) {
    float s = 0.f;
#pragma unroll
    for (int j = 0; j < 4; ++j) s += (v[j][0] * v[j][0] + v[j][1] * v[j][1]) + (v[j][2] * v[j][2] + v[j][3] * v[j][3]);
    return __builtin_amdgcn_rsqf(wave_sum(s) * (1.f / D) + NORM_EPS);
}
__device__ __forceinline__ void norm_mod_store(const f32x4 (&v)[4], float rstd, const float* gam, const float* sc, const float* sh, bf16_t* dst, int lane, f32x4 (*keep)[4] = nullptr) {
#pragma unroll
    for (int j = 0; j < 4; ++j) {
        const int c = 4 * lane + 256 * j;
        const f32x4 g = *(const f32x4*)(gam + c), s1 = *(const f32x4*)(sc + c), s0 = *(const f32x4*)(sh + c);
        f32x4 h;
#pragma unroll
        for (int i = 0; i < 4; ++i) h[i] = v[j][i] * rstd * g[i] * (1.f + s1[i]) + s0[i];
        u32x2 w; w.x = pk2(h[0], h[1]); w.y = pk2(h[2], h[3]);
        *(u32x2*)(dst + c) = w;
        if (keep) (*keep)[j] = h;
    }
}

__device__ __forceinline__ void phase_prep(Frame& F) {
    LAS float* sil = (LAS float*)F.lds;
    LAS float* red = (LAS float*)(F.lds + 20480);
    LAS float* ct = (LAS float*)(F.lds + 32768);
    for (int idx = F.tid; idx < 5120; idx += 512) { const int r = idx >> 10, k = idx & 1023; const float v = r < 4 ? PP(c)[r * 1024 + k] : PP(c_ctx)[k]; sil[idx] = v / (1.f + __expf(-v)); }
    if (F.tid < 128) ct[F.tid] = cospif((float)F.tid / 64.f);
    __syncthreads();
    constexpr int N_ADA = 192, N_CONST = 8, N_FOLD = 256, N_CVT = 368;
    for (int it = F.bid; it < N_ADA + N_CONST + N_FOLD + N_CVT; it += F.G) {
        if (it < N_ADA) {
            const int l = it / 96, j0 = (it % 96) * 64, col = j0 + F.lane;
            const float* w = PP(ada_w) + ((size_t)l * 1024 + F.wid * 128) * 6144 + col;
            float a[5] = {0.f, 0.f, 0.f, 0.f, 0.f};
            for (int k0 = 0; k0 < 128; k0 += 32) {
                float wv[32];
#pragma unroll
                for (int u = 0; u < 32; ++u) wv[u] = w[(size_t)(k0 + u) * 6144];
#pragma unroll
                for (int u = 0; u < 32; ++u)
#pragma unroll
                    for (int r = 0; r < 5; ++r) a[r] += sil[r * 1024 + F.wid * 128 + k0 + u] * wv[u];
            }
#pragma unroll
            for (int r = 0; r < 5; ++r) red[(F.wid * 5 + r) * 64 + F.lane] = a[r];
            __syncthreads();
            if (F.tid < 320) { const int r = F.tid >> 6, ln = F.tid & 63; float s = 0.f;
#pragma unroll
                for (int w8 = 0; w8 < 8; ++w8) s += red[(w8 * 5 + r) * 64 + ln];
                F_mod[(size_t)(l * 5 + r) * 6144 + j0 + ln] = s + PP(ada_b)[l * 6144 + j0 + ln]; }
            __syncthreads();
        } else if (it < N_ADA + N_CONST) {
            const int gt = (it - N_ADA) * 512 + F.tid;
            for (int e = gt; e < 32768; e += 4096) {
                const int row = e >> 7, kk = e & 127;
                float v1 = 0.f, v2 = 0.f;
                if (row < 128) { const int ro = row >> 6, k1 = row & 63, n1 = kk >> 1, ri = kk & 1; const float ph = (float)((n1 * k1) & 63) / 32.f; const float cs = cospif(ph), sn = sinpif(ph);
                    v1 = (ro == ri) ? cs : (ro == 0 ? sn : -sn); }
                if (row < 64) { const int ro = kk >> 6, n2 = kk & 63; const float ph = (float)((row * n2) & 63) / 32.f; v2 = ro == 0 ? cospif(ph) : sinpif(ph); }
                F_M1[e] = (bf16_t)(pk2(v1, 0.f) & 0xffffu); F_M2[e] = (bf16_t)(pk2(v2, 0.f) & 0xffffu);
            }
            if (gt < 1024) { const int pos = gt >> 4, f = gt & 15; const double ang = (double)pos * pow(10000.0, -(double)f / 16.0); F_ROPE[gt] = (f32x2){(float)cos(ang), (float)sin(ang)}; }
            { const float ph = (float)gt / 2048.f; F_TW[gt] = (f32x2){cospif(ph), sinpif(ph)}; }
        } else if (it >= N_ADA + N_CONST + N_FOLD) {
            int ci = it - (N_ADA + N_CONST + N_FOLD); const float* src; bf16_t* dst; int sld, dld, ncol;
            if (ci < 144) { src = PP(even_w_in); dst = (bf16_t*)(F.ws + WB_EIN); sld = EVEN_IN; dld = EVEN_IN; ncol = EVEN_IN; }
            else if (ci < 208) { ci -= 144; src = PP(even_w_out); dst = (bf16_t*)(F.ws + WB_EOUT); sld = D; dld = D; ncol = D; }
            else if (ci < 304) { ci -= 208; src = PP(odd_w_in); dst = (bf16_t*)(F.ws + WB_OIN); sld = 2048; dld = 2560; ncol = 1536; }
            else { ci -= 304; src = PP(odd_w_out); dst = (bf16_t*)(F.ws + WB_OOUT); sld = D; dld = D; ncol = D; }
            const int q4 = ncol >> 2;
#pragma unroll
            for (int u = 0; u < 8; ++u) { const int gidx = ci * 4096 + u * 512 + F.tid, row = gidx / q4, c4 = (gidx - row * q4) * 4;
                const f32x4 v = *(const f32x4*)(src + (size_t)row * sld + c4); u32x2 w; w.x = pk2(v[0], v[1]); w.y = pk2(v[2], v[3]); *(u32x2*)(dst + (size_t)row * dld + c4) = w; }
        } else {
            const int fi = it - N_ADA - N_CONST, rc = fi >> 2, g = fi & 3, half = F.tid >> 8, j = F.tid & 255, jj = j & 127;
            for (int i2 = 0; i2 < 8; ++i2) {
                const int row = rc * 16 + i2 * 2 + half;
                const float* wr_ = PP(odd_w_in) + (size_t)row * 2048 + 1536 + g * 128;
                float s = 0.f;
                if (j < 128) { for (int cc = 0; cc < 128; ++cc) s += wr_[cc] * ct[(cc * jj) & 127]; }
                else { for (int cc = 0; cc < 128; ++cc) s -= wr_[cc] * ct[((cc * jj) - 32) & 127]; }
                ((bf16_t*)(F.ws + WB_OIN))[(size_t)row * 2560 + 1536 + g * 256 + j] = (bf16_t)(pk2(s, 0.f) & 0xffffu);
            }
        }
    }
}

__device__ __forceinline__ void phase_norm1_l0(Frame& F) {
    const int gw = F.bid * 8 + F.wid, NGW = F.G * 8;
    for (int row = gw; row < NTOK; row += NGW) {
        const float* src = row < NMAIN ? PP(x) + (size_t)row * D : PP(ctx) + (size_t)(row - NMAIN) * D;
        f32x4 v[4];
#pragma unroll
        for (int j = 0; j < 4; ++j) v[j] = *(const f32x4*)(src + 4 * F.lane + 256 * j);
        const float rstd = row_rstd(v); const int r = mod_row(row);
        norm_mod_store(v, rstd, PP(norm_mix), modp(F, 0, r, 1), modp(F, 0, r, 0), F_H + (size_t)row * D, F.lane);
    }
}

#define EPI_GEOM const int wid = this->wid, lane = this->lane, wr = wid >> 2, wc = wid & 3, fr = lane & 15, fq = lane >> 4; (void)wr; (void)wc; (void)fr; (void)fq
struct PolBase { unsigned char* ws; LAS unsigned char* lds; int wid, lane, nt; unsigned lcolb, woff, ldbB; XOrder xo; int aC, aR0, aCb, aR0b; bool bfm;
    __device__ __forceinline__ void base_init(Frame& F, int nt_, int T) { ws = F.ws; lds = F.lds; wid = F.wid; lane = F.lane; nt = nt_; lcolb = 16u * (unsigned)F.lane; woff = 8u * (unsigned)F.lane;
        xo.init(T, F.G, F.bid); aC = a_piece_col(F.wid, F.lane); aR0 = a_piece_row0(F.wid, F.lane); bfm = true;
        { const int sbb = F.lane * 16, swz = sbb ^ (((sbb >> 9) & 1) << 5); aR0b = F.wid * 32 + (swz >> 6); aCb = (swz & 63) >> 1; } }
    bool has_bias = false; const float* bias = nullptr;
    bool has_list = false; const int* listp = nullptr;
    __device__ __forceinline__ unsigned list_voff(const TD&) const { return 0u; }
    __device__ __forceinline__ void late(TD&, const LAS int*) const {}
    __device__ __forceinline__ unsigned bias_voff(const TD&) const { return 0u; }
    __device__ __forceinline__ bool tileL(int i, int& L) const { L = xo.cur + i * xo.step; return L < xo.c1; }
    __device__ __forceinline__ int prow(int i) const { return bfm ? aR0b + 16 * (i & 1) : aR0 + 64 * i; }
    __device__ __forceinline__ int pcol() const { return bfm ? aCb : aC; }
    __device__ __forceinline__ void dense_aoff(TD& td, int row0, int pitch) const {
#pragma unroll
        for (int i = 0; i < 4; ++i) td.aoff[i] = (unsigned)(((row0 + prow(i)) * pitch + pcol()) * 2); }
};

struct PolInproj0 : PolBase {
    const float* W; Frame* Fp;
    __device__ __forceinline__ bool get(int i, TD& td) const { int L; if (!tileL(i, L)) return false; int pm, pn; dense_tile(L, NTOK / 256, EVEN_IN / 256, pm, pn);
        td.A = (const bf16_t*)(ws + WS_H); dense_aoff(td, pm * 256, D); td.B = (const bf16_t*)(ws + WB_EIN) + pn * 256; td.i0 = pm; td.i1 = pn; return true; }
    __device__ __forceinline__ void epi(f32x4 (&acc)[8][4], const TD& td, const LAS float* bl) const { (void)bl; EPI_GEOM; const int pm = td.i0, pn = td.i1;
        const int colb = pn * 256 + wc * 64; const bool rope = (colb < 640) && (pm < NMAIN / 256);
        const LAS f32x2* ROPE = (const LAS f32x2*)(lds + ROPE_LDS); bf16_t* PROJ = (bf16_t*)(ws + WS_PROJ);
#pragma unroll
        for (int m = 0; m < 8; ++m) { const int row = pm * 256 + wr * 128 + m * 16 + fr;
            if (rope) { const int tt = row & (SEQ - 1), gr = tt >> 6, gc = tt & 63;
#pragma unroll
                for (int n = 0; n < 2; ++n) { const int pos = n == 0 ? gr : gc;
#pragma unroll
                    for (int j = 0; j < 4; ++j) { const f32x2 cs = ROPE[pos * 16 + 4 * fq + j]; const float x1 = acc[m][n][j], x2 = acc[m][n + 2][j];
                        acc[m][n][j] = x1 * cs.x - x2 * cs.y; acc[m][n + 2][j] = x2 * cs.x + x1 * cs.y; } } }
#pragma unroll
            for (int n = 0; n < 4; ++n) { u32x2 w; w.x = pk2(acc[m][n][0], acc[m][n][1]); w.y = pk2(acc[m][n][2], acc[m][n][3]);
                *(u32x2*)(PROJ + (size_t)row * EVEN_IN + colb + n * 16 + 4 * fq) = w; } } }
};
__device__ __forceinline__ void phase_inproj_l0(Frame& F) {
    for (int i = F.tid; i < 1024; i += 512) ((LAS f32x2*)(F.lds + ROPE_LDS))[i] = F_ROPE[i];
    __syncthreads();
    PolInproj0 P; P.base_init(F, D / 64, (NTOK / 256) * (EVEN_IN / 256)); P.ldbB = EVEN_IN;
    gemm_stream_bf(F.lds, P, F.wid, F.lane);
}

struct PolOutproj : PolBase {
    const float *W, *x, *ctx; int layer, nM;
    __device__ __forceinline__ bool get(int i, TD& td) const { int L; if (!tileL(i, L)) return false; int pm, pn; dense_tile(L, nM, 4, pm, pn);
        td.A = (const bf16_t*)(ws + WS_MIX); dense_aoff(td, pm * 256, D); td.B = (const bf16_t*)(ws + (layer == 0 ? WB_EOUT : WB_OOUT)) + pn * 256; td.i0 = pm; td.i1 = pn; return true; }
    __device__ __forceinline__ void epi(f32x4 (&acc)[8][4], const TD& td, const LAS float* bl) const { (void)bl; EPI_GEOM; const int pm = td.i0, pn = td.i1;
        const int colb = pn * 256 + wc * 64; float* XS = (float*)(ws + WS_XS); const float* mod = (const float*)(ws + WS_MOD);
#pragma unroll
        for (int m = 0; m < 8; ++m) { const int row = pm * 256 + wr * 128 + m * 16 + fr; const int r = mod_row(row);
            const float* xin = layer == 0 ? (row < NMAIN ? x + (size_t)row * D : ctx + (size_t)(row - NMAIN) * D) : XS + (size_t)row * D;
            const float* g1 = mod + ((size_t)(layer * 5 + r)) * 6144 + 2 * 1024;
#pragma unroll
            for (int n = 0; n < 4; ++n) { const int c = colb + n * 16 + 4 * fq; const f32x4 xv = *(const f32x4*)(xin + c), gv = *(const f32x4*)(g1 + c);
                f32x4 o;
#pragma unroll
                for (int j = 0; j < 4; ++j) o[j] = xv[j] + gv[j] * acc[m][n][j];
                *(f32x4*)(XS + (size_t)row * D + c) = o; } } }
};
__device__ __forceinline__ void phase_outproj(Frame& F, const int layer) {
    PolOutproj P; P.layer = layer; P.nM = (layer == 0 ? NTOK : NMAIN) / 256; P.base_init(F, D / 64, P.nM * 4);
    P.ldbB = D; P.x = PP(x); P.ctx = PP(ctx);
    gemm_stream_bf(F.lds, P, F.wid, F.lane);
}

constexpr int QT = 2;
struct AttnSt { f32x4 o[4][QT]; float m[QT], l[QT]; };
#define V_ROWB 160
__device__ __forceinline__ void v_stage(LAS unsigned char* vl, const bf16_t* vsrc, int ld, int lane) {
    i32x4 t[4];
    asm volatile("" ::: "memory");
#pragma unroll
    for (int i = 0; i < 4; ++i) t[i] = *(const i32x4*)(vsrc + (size_t)((lane >> 3) + 8 * i) * ld + (lane & 7) * 8);
#pragma unroll
    for (int i = 0; i < 4; ++i) *(LAS i32x4*)(vl + ((lane >> 3) + 8 * i) * V_ROWB + (lane & 7) * 16) = t[i];
    asm volatile("s_waitcnt lgkmcnt(0)" ::: "memory");
}
#define ATTN_STEP(ksrc, kld, vsrc, vld, SCALE, BIAS, SKIP) do { \
    bf16x8 kf[2][2]; \
    _Pragma("unroll") for (int kt = 0; kt < 2; ++kt) _Pragma("unroll") for (int ks = 0; ks < 2; ++ks) \
        kf[kt][ks] = *(const bf16x8*)((ksrc) + (size_t)(kt * 16 + fr) * (kld) + ks * 32 + 8 * fq); \
    v_stage(vl, (vsrc), (vld), lane); \
    bf16x8 vf[4]; \
    _Pragma("unroll") for (int dt = 0; dt < 4; ++dt) { \
        const s16x4 lo = __builtin_amdgcn_ds_read_tr16_b64_v4i16((LAS s16x4*)(vl + (4 * fq + (fr >> 2)) * V_ROWB + (dt * 16 + (fr & 3) * 4) * 2)); \
        const s16x4 hi = __builtin_amdgcn_ds_read_tr16_b64_v4i16((LAS s16x4*)(vl + (16 + 4 * fq + (fr >> 2)) * V_ROWB + (dt * 16 + (fr & 3) * 4) * 2)); \
        vf[dt] = (bf16x8){lo[0], lo[1], lo[2], lo[3], hi[0], hi[1], hi[2], hi[3]}; } \
    _Pragma("unroll") for (int qt = 0; qt < QT; ++qt) { if (SKIP(qt)) continue;        \
        f32x4 s[2]; \
        _Pragma("unroll") for (int kt = 0; kt < 2; ++kt) { s[kt] = (f32x4){0.f, 0.f, 0.f, 0.f}; \
            _Pragma("unroll") for (int ks = 0; ks < 2; ++ks) s[kt] = __builtin_amdgcn_mfma_f32_16x16x32_bf16(kf[kt][ks], qf[qt][ks], s[kt], 0, 0, 0); } \
        float mx = -INFINITY; \
        _Pragma("unroll") for (int kt = 0; kt < 2; ++kt) _Pragma("unroll") for (int j = 0; j < 4; ++j) { const float tv = s[kt][j] * (SCALE) + BIAS(qt, kt, j); s[kt][j] = tv; mx = fmaxf(mx, tv); } \
        mx = fmaxf(mx, __shfl_xor(mx, 16)); mx = fmaxf(mx, __shfl_xor(mx, 32)); \
        const float mn = fmaxf(st.m[qt], mx), al = fexp2(st.m[qt] - mn); st.m[qt] = mn; \
        float ps = 0.f; \
        _Pragma("unroll") for (int kt = 0; kt < 2; ++kt) _Pragma("unroll") for (int j = 0; j < 4; ++j) { const float pv = fexp2(s[kt][j] - mn); s[kt][j] = pv; ps += pv; } \
        st.l[qt] = st.l[qt] * al + ps; \
        const unsigned w0 = pk2(s[0][0], s[0][1]), w1 = pk2(s[0][2], s[0][3]), w2 = pk2(s[1][0], s[1][1]), w3 = pk2(s[1][2], s[1][3]); \
        const bf16x8 pf = __builtin_bit_cast(bf16x8, ((u32x4){w0, w1, w2, w3})); \
        _Pragma("unroll") for (int dt = 0; dt < 4; ++dt) st.o[dt][qt] = __builtin_amdgcn_mfma_f32_16x16x32_bf16(vf[dt], pf, st.o[dt][qt] * al, 0, 0, 0); } \
    } while (0)

__device__ __forceinline__ void attn_store(AttnSt& st, bf16_t* dst  , int dld, int fr, int fq) {
#pragma unroll
    for (int qt = 0; qt < QT; ++qt) {
        float l = st.l[qt]; l += __shfl_xor(l, 16); l += __shfl_xor(l, 32);
        const float inv = 1.f / l;
#pragma unroll
        for (int dt = 0; dt < 4; ++dt) { const f32x4 o = st.o[dt][qt] * inv; u32x2 w; w.x = pk2(o[0], o[1]); w.y = pk2(o[2], o[3]);
            *(u32x2*)(dst + (size_t)(qt * 16 + fr) * dld + dt * 16 + 4 * fq) = w; }
    }
}

__device__ __forceinline__ void phase_attn_l0(Frame& F) {
    const int wid = F.wid, lane = F.lane, fr = lane & 15, fq = lane >> 4;
    LAS unsigned char* vl = F.lds + wid * 8192;
    constexpr int NPASS = 4 / QT, N_WIN = 256 * NPASS, N_CTXA = 16 * NPASS, N_CONV = NTOK / 64;
    const float SC = 0.125f * LOG2E;
    for (int it = F.bid; it < N_WIN + N_CTXA + N_CONV; it += F.G) {
        if (it < N_WIN + N_CTXA) {
            const bool isctx = it >= N_WIN;
            int b, kvh, qb, qh;
            if (!isctx) { const int c = it / NPASS; qh = it - c * NPASS; b = c >> 6; kvh = (c >> 5) & 1; qb = c & 31; } else { const int c2 = it - N_WIN, c = c2 / NPASS; qh = c2 - c * NPASS; b = c >> 2; kvh = (c >> 1) & 1; qb = c & 1; }
            const int g = wid >> 1, h = kvh * 4 + g;
            {
            const int qq0 = (wid & 1) * 64 + qh * (16 * QT);
            const int qrow0 = (isctx ? NMAIN + b * CTXL : b * SEQ) + qb * 128 + qq0;
            bf16x8 qf[QT][2];
#pragma unroll
            for (int qt = 0; qt < QT; ++qt)
#pragma unroll
                for (int ks = 0; ks < 2; ++ks) qf[qt][ks] = *(const bf16x8*)(F_PROJ + (size_t)(qrow0 + qt * 16 + fr) * EVEN_IN + h * 64 + ks * 32 + 8 * fq);
            AttnSt st;
            const float sink = PP(even_sink)[h] * LOG2E;
#pragma unroll
            for (int qt = 0; qt < QT; ++qt) { st.m[qt] = sink; st.l[qt] = (fq == 0) ? 1.f : 0.f;
#pragma unroll
                for (int dt = 0; dt < 4; ++dt) st.o[dt][qt] = (f32x4){0.f, 0.f, 0.f, 0.f}; }
            const int kcol = 512 + kvh * 64, vcol = 640 + kvh * 64;
            for (int ch = isctx ? 3 : 0; ch < 5; ++ch) {
                int krow0;
                if (ch < 3) { const int kb = qb - 1 + ch; if (kb < 0 || kb >= SEQ / 128) continue; krow0 = b * SEQ + kb * 128; } else krow0 = NMAIN + b * CTXL + (ch - 3) * 128;
                for (int s32 = 0; s32 < 4; ++s32) {
                    const bf16_t* kp = F_PROJ + (size_t)(krow0 + s32 * 32) * EVEN_IN + kcol;
                    const bf16_t* vp = F_PROJ + (size_t)(krow0 + s32 * 32) * EVEN_IN + vcol;
                    if (ch == 0) {
#define SKIP_NONE(qt) false
#define SKIP_PREV(qt) ((s32 * 32 + 31) < (qq0 + qt * 16))
#define SKIP_NEXT(qt) ((s32 * 32) > (qq0 + qt * 16 + 15))
#define BIAS_PREV(qt, kt, j) ((s32 * 32 + kt * 16 + 4 * fq + j) >= (qq0 + qt * 16 + fr) ? 0.f : -INFINITY)
                        ATTN_STEP(kp, EVEN_IN, vp, EVEN_IN, SC, BIAS_PREV, SKIP_PREV);
                    } else if (ch == 2) {
#define BIAS_NEXT(qt, kt, j) ((s32 * 32 + kt * 16 + 4 * fq + j) <= (qq0 + qt * 16 + fr) ? 0.f : -INFINITY)
                        ATTN_STEP(kp, EVEN_IN, vp, EVEN_IN, SC, BIAS_NEXT, SKIP_NEXT);
                    } else {
#define BIAS_NONE(qt, kt, j) 0.f
                        ATTN_STEP(kp, EVEN_IN, vp, EVEN_IN, SC, BIAS_NONE, SKIP_NONE);
                    }
                }
            }
            attn_store(st, F_MIX + (size_t)qrow0 * D + h * 64, D, fr, fq);
            }
        } else {
            const int ci = it - N_WIN - N_CTXA, c4 = (F.tid & 127) * 4, r0 = ci * 64 + (F.tid >> 7) * 16;
            const f32x4 w0 = *(const f32x4*)(PP(even_conv_w) + c4), w1 = *(const f32x4*)(PP(even_conv_w) + 512 + c4), w2 = *(const f32x4*)(PP(even_conv_w) + 1024 + c4);
#define LOADZ(dst, row_) do { const u32x2 gc_ = *(const u32x2*)(F_PROJ + (size_t)(row_) * EVEN_IN + 1280 + c4), uu_ = *(const u32x2*)(F_PROJ + (size_t)(row_) * EVEN_IN + 1792 + c4); \
                dst = (f32x4){bflo(gc_.x) * bflo(uu_.x), bfhi(gc_.x) * bfhi(uu_.x), bflo(gc_.y) * bflo(uu_.y), bfhi(gc_.y) * bfhi(uu_.y)}; } while (0)
            const int seqmask = r0 < NMAIN ? (SEQ - 1) : (CTXL - 1);
            u32x2 gcv[18], uuv[18], gbv[16];
#pragma unroll
            for (int i = 0; i < 18; ++i) { const int row = r0 - 1 + i; const bool ok = (i == 0) ? ((r0 & seqmask) != 0) : (i == 17) ? (((r0 + 15) & seqmask) != seqmask) : true;
                const int rr = ok ? row : r0;
                gcv[i] = *(const u32x2*)(F_PROJ + (size_t)rr * EVEN_IN + 1280 + c4); uuv[i] = *(const u32x2*)(F_PROJ + (size_t)rr * EVEN_IN + 1792 + c4);
                if (!ok) { gcv[i] = (u32x2){0u, 0u}; } }
#pragma unroll
            for (int i = 0; i < 16; ++i) gbv[i] = *(const u32x2*)(F_PROJ + (size_t)(r0 + i) * EVEN_IN + 768 + c4);
            __builtin_amdgcn_sched_barrier(0);
#define ZOF(i_) ((f32x4){bflo(gcv[i_].x) * bflo(uuv[i_].x), bfhi(gcv[i_].x) * bfhi(uuv[i_].x), bflo(gcv[i_].y) * bflo(uuv[i_].y), bfhi(gcv[i_].y) * bfhi(uuv[i_].y)})
            f32x4 zp = ZOF(0), zc = ZOF(1);
#pragma unroll
            for (int i = 0; i < 16; ++i) {
                const int row = r0 + i;
                const f32x4 zn = ZOF(i + 2);
                const u32x2 gb = gbv[i];
                const f32x4 y = zp * w0 + zc * w1 + zn * w2;
                u32x2 w; w.x = pk2(bflo(gb.x) * y[0], bfhi(gb.x) * y[1]); w.y = pk2(bflo(gb.y) * y[2], bfhi(gb.y) * y[3]);
                *(u32x2*)(F_MIX + (size_t)row * D + 512 + c4) = w;
                zp = zc; zc = zn;
            }
#undef ZOF
        }
    }
}

constexpr int RW_LD = 1028;
__device__ __forceinline__ void phase_route(Frame& F, const int layer) {
    const int nrows = layer == 0 ? NTOK : NMAIN;
    LAS float* rwT = (LAS float*)F.lds;
    LAS int* cntL = (LAS int*)(F.lds + 32 * RW_LD * 4);
    LAS int* baseL = cntL + 32;
    LAS int* selE = baseL + 32;
    LAS int* selR = selE + 384;
    const float* rw = PP(router_w) + (size_t)layer * D * NEXP;
    { const f32x4* rsrc4 = (const f32x4*)rw + F.tid; LAS float* wp = rwT + ((4 * F.tid) & 31) * RW_LD + (F.tid >> 3);
      for (int it = 0; it < 4; ++it) {
        f32x4 v[4];
#pragma unroll
        for (int u = 0; u < 4; ++u) v[u] = rsrc4[(it * 4 + u) * 512];
#pragma unroll
        for (int u = 0; u < 4; ++u)
#pragma unroll
            for (int j = 0; j < 4; ++j) wp[it * 256 + u * 64 + j * RW_LD] = v[u][j];
        asm volatile("" ::: "memory"); } }
    if (F.tid < 32) cntL[F.tid] = 0;
    __syncthreads();
    const int lane = F.lane, gw = F.bid * 8 + F.wid, NGW = F.G * 8;
    const float* gam = PP(norm_ffn) + layer * D;
    int slot = F.wid;
    const float* Wd = PP(moe_w_dn) + (size_t)layer * NEXP * DFF * D; bf16_t* pd = (bf16_t*)(F.ws + WS_BC2);
    constexpr int CV_TOTAL = NEXP * 4 * 1024;
    const int cv_q = (CV_TOTAL + NGW - 1) / NGW, cv_end = min((gw + 1) * cv_q, CV_TOTAL); int cv_u = gw * cv_q;
#define CV_LOAD(v_, u0_) do { _Pragma("unroll") for (int u = 0; u < 8; ++u) { const int pr = min((u0_) + u, CV_TOTAL - 1), pnl = pr >> 10, k = pr & 1023, e = pnl >> 2, ct = pnl & 3; \
        v_[u] = *(const f32x4*)(Wd + ((size_t)e * DFF + k) * D + ct * 256 + 4 * lane); } } while (0)
#define CV_STORE(v_, u0_, uend_) do { _Pragma("unroll") for (int u = 0; u < 8; ++u) { const int pr = (u0_) + u; if (pr < (uend_)) { u32x2 w; w.x = pk2(v_[u][0], v_[u][1]); w.y = pk2(v_[u][2], v_[u][3]); \
        *(u32x2*)(pd + (size_t)pr * 256 + 4 * lane) = w; } } } while (0)
    f32x4 vn[4];
    if (gw < nrows) {
#pragma unroll
        for (int j = 0; j < 4; ++j) vn[j] = *(const f32x4*)(F_XS + (size_t)gw * D + 4 * lane + 256 * j); }
    for (int row = gw; row < nrows; row += NGW, slot += 8) {
        f32x4 v[4], h[4], cvv[8];
        const int cv_u0 = cv_u; CV_LOAD(cvv, cv_u0); cv_u += 8;
#pragma unroll
        for (int j = 0; j < 4; ++j) v[j] = vn[j];
        if (row + NGW < nrows) {
#pragma unroll
            for (int j = 0; j < 4; ++j) vn[j] = *(const f32x4*)(F_XS + (size_t)(row + NGW) * D + 4 * lane + 256 * j); }
        const float rstd = row_rstd(v); const int r = mod_row(row);
        norm_mod_store(v, rstd, gam, modp(F, layer, r, 4), modp(F, layer, r, 3), F_H + (size_t)row * D, lane, &h);
        float pe[32];
#pragma unroll
        for (int e = 0; e < 32; ++e) { float s = 0.f;
            f32x2 s2 = (f32x2){0.f, 0.f};
#pragma unroll
            for (int j = 0; j < 4; ++j) { const f32x4 w = *(const LAS f32x4*)(rwT + e * RW_LD + 4 * lane + 256 * j);
                s2 = __builtin_elementwise_fma((f32x2){h[j][0], h[j][1]}, (f32x2){w[0], w[1]}, s2); s2 = __builtin_elementwise_fma((f32x2){h[j][2], h[j][3]}, (f32x2){w[2], w[3]}, s2); }
            s = s2.x + s2.y;
            pe[e] = s; if ((e & 3) == 3) __builtin_amdgcn_sched_barrier(0); }
        float q16[16], q8[8], q4[4], q2[2], q1;
        { const bool hi = lane & 32;
#pragma unroll
          for (int i = 0; i < 16; ++i) { const float snd = hi ? pe[i] : pe[16 + i], mine = hi ? pe[16 + i] : pe[i]; q16[i] = mine + __shfl_xor(snd, 32); } }
        { const bool hi = lane & 16;
#pragma unroll
          for (int i = 0; i < 8; ++i) { const float snd = hi ? q16[i] : q16[8 + i], mine = hi ? q16[8 + i] : q16[i]; q8[i] = mine + __shfl_xor(snd, 16); } }
        { const bool hi = lane & 8;
#pragma unroll
          for (int i = 0; i < 4; ++i) { const float snd = hi ? q8[i] : q8[4 + i], mine = hi ? q8[4 + i] : q8[i]; q4[i] = mine + __shfl_xor(snd, 8); } }
        { const bool hi = lane & 4;
#pragma unroll
          for (int i = 0; i < 2; ++i) { const float snd = hi ? q4[i] : q4[2 + i], mine = hi ? q4[2 + i] : q4[i]; q2[i] = mine + __shfl_xor(snd, 4); } }
        { const bool hi = lane & 2; const float snd = hi ? q2[0] : q2[1], mine = hi ? q2[1] : q2[0]; q1 = mine + __shfl_xor(snd, 2); }
        q1 += __shfl_xor(q1, 1);
        const int myE = (lane >> 1) & 31;
        float val = q1 + PP(router_b)[layer * NEXP + myE];
        float tv[4]; int te[4];
        { int rank = 0; const int vb = __builtin_bit_cast(int, val);
#pragma unroll
          for (int e2 = 0; e2 < 32; ++e2) { const float o = __builtin_bit_cast(float, __builtin_amdgcn_readlane(vb, 2 * e2)); rank += (o > val || (o == val && e2 < myE)) ? 1 : 0; }
#pragma unroll
          for (int k = 0; k < 4; ++k) { const unsigned long long mk = __ballot(rank == k); const int src = __builtin_amdgcn_readfirstlane((int)__builtin_ctzll(mk));
              tv[k] = __builtin_bit_cast(float, __builtin_amdgcn_readlane(vb, src)); te[k] = (src >> 1) & 31; } }
        const float e1 = __expf(tv[1] - tv[0]), e2 = __expf(tv[2] - tv[0]), e3 = __expf(tv[3] - tv[0]), inv = 1.f / (1.f + e1 + e2 + e3);
        if (lane == 0) {
            *(f32x4*)(F_TOPW + (size_t)row * 4) = (f32x4){inv, e1 * inv, e2 * inv, e3 * inv};
#pragma unroll
            for (int k = 0; k < 4; ++k) { selE[slot * 4 + k] = te[k]; selR[slot * 4 + k] = atomicAdd((int*)(cntL + te[k]), 1); }
        }
        CV_STORE(cvv, cv_u0, cv_end);
    }
    for (; cv_u < cv_end; cv_u += 8) { f32x4 cvv[8]; CV_LOAD(cvv, cv_u); CV_STORE(cvv, cv_u, cv_end); }
#undef CV_LOAD
#undef CV_STORE
    __syncthreads();
    if (F.tid < 32) { const int c = cntL[F.tid]; baseL[F.tid] = c ? (int)atomicAdd(F_cnt + layer * 32 + F.tid, (unsigned)c) : 0; }
    __syncthreads();
    if (F.tid < 384) { const int s = F.tid >> 2, k = F.tid & 3; const int row = F.bid * 8 + (s & 7) + (s >> 3) * NGW;
        if (row < nrows) { const int e = selE[F.tid], pos = baseL[e] + selR[F.tid]; F_POS[(size_t)row * 4 + k] = e | (pos << 8); F_LIST[(size_t)e * NTOK + pos] = row; } }
    __syncthreads();
}

struct MoeLds { LAS int *mtp, *roff, *mtq, *nz; };
__device__ __forceinline__ MoeLds moe_lds(Frame& F) { MoeLds L; L.mtp = (LAS int*)(F.lds + 2 * STAGE_B); L.roff = L.mtp + 40; L.mtq = L.roff + 40; L.nz = L.mtq + 40; return L; }
__device__ __forceinline__ void moe_prefix(Frame& F, const int layer, const MoeLds& L) {
    if (F.tid < 64) { const int e = F.lane & 31; const int c = (int)__hip_atomic_load(F_cnt + layer * 32 + e, __ATOMIC_RELAXED, __HIP_MEMORY_SCOPE_AGENT);
        const int mt = (c + 255) >> 8; int a = mt, b = c, q = mt > 0 ? mt - 1 : 0, z = mt > 0 ? 1 : 0;
#pragma unroll
        for (int o = 1; o < 32; o <<= 1) { const int ua = __shfl_up(a, o, 32), ub = __shfl_up(b, o, 32), uq = __shfl_up(q, o, 32), uz = __shfl_up(z, o, 32); if (e >= o) { a += ua; b += ub; q += uq; z += uz; } }
        if (F.lane < 32) { L.mtp[e + 1] = a; L.roff[e + 1] = b; L.mtq[e + 1] = q; if (mt > 0) L.nz[z - 1] = e; if (e == 31) L.nz[32] = z; if (e == 0) { L.mtp[0] = 0; L.roff[0] = 0; L.mtq[0] = 0; } } }
    __syncthreads();
}
struct PolMoe : PolBase {
    const float* W; MoeLds L; int layer, nct, round; size_t bc_off; mutable int ehint = 0;
    __device__ __forceinline__ bool find(int i, int& e, int& ct, int& rbase, int& ro, int& cnt) const { int T; if (!tileL(i, T)) return false;
        if (round == 0) { const int q = T / nct; ct = T - q * nct; e = __builtin_amdgcn_readfirstlane(L.nz[q]); rbase = 0; }
        else { LAS int* pf = round == 1 ? L.mtq : L.mtp; e = ehint; while (pf[e + 1] * nct <= T) ++e;
            ehint = e;
            e = __builtin_amdgcn_readfirstlane(e);
            const int mq = __builtin_amdgcn_readfirstlane(pf[e + 1] - pf[e]), w = T - __builtin_amdgcn_readfirstlane(pf[e]) * nct; ct = w / mq; rbase = ((round == 1 ? 1 : 0) + w - ct * mq) * 256; }
        ro = __builtin_amdgcn_readfirstlane(L.roff[e]); cnt = __builtin_amdgcn_readfirstlane(L.roff[e + 1]) - ro; return true; }
    __device__ __forceinline__ bf16_t* panel(int e, int ct) const { return (bf16_t*)(ws + bc_off) + (size_t)(e * nct + ct) * (1024 * 256); }
};
struct PolMoe1 : PolMoe {
    __device__ __forceinline__ unsigned list_voff(const TD& td) const { return 4u * (unsigned)(td.i0 * NTOK + td.i2 + lane * 4); }
    __device__ __forceinline__ void late(TD& td, const LAS int* ll) const { const int cl = td.i4 - 1 - td.i2;
#pragma unroll
        for (int i2 = 0; i2 < 2; ++i2) { int rl = prow(i2); rl = rl < cl ? rl : cl; td.aoff[i2] = (unsigned)((ll[rl] * D + pcol()) * 2); } }
    __device__ __forceinline__ unsigned bias_voff(const TD& td) const { return 4u * (unsigned)((layer * NEXP + td.i0) * (2 * DFF) + (lane >> 5) * DFF + td.i1 * 128 + (lane & 31) * 4); }
    __device__ __forceinline__ bool get(int i, TD& td) const { int e, ct, rbase, ro, cnt; if (!find(i, e, ct, rbase, ro, cnt)) return false;
        const int* list = (const int*)(ws + WS_LIST) + (size_t)e * NTOK; td.A = (const bf16_t*)(ws + WS_H);
        if (!has_list || i == 0) {
#pragma unroll
            for (int i2 = 0; i2 < 4; ++i2) { int rr = rbase + prow(i2); rr = rr < cnt ? rr : cnt - 1; td.aoff[i2] = (unsigned)((list[rr] * D + pcol()) * 2); } }
        if (round == 0) { td.B = W + ((size_t)(layer * NEXP + e) * D + wid * 8) * (2 * DFF) + ct * 128; td.ldb = 2 * DFF; td.bco = panel(e, ct); } else { td.B = panel(e, ct); td.bco = nullptr; }
        td.i0 = e; td.i1 = ct; td.i2 = rbase; td.i3 = ro; td.i4 = cnt; return true; }
    __device__ __forceinline__ void epi(f32x4 (&acc)[8][4], const TD& td, const LAS float* bl) const { (void)bl; EPI_GEOM; const int e = td.i0, ct = td.i1, rbase = td.i2, ro = td.i3, cnt = td.i4;
        bf16_t* ACT = (bf16_t*)(ws + WS_ACT);
#pragma unroll
        for (int n = 0; n < 2; ++n) { const int gc = ct * 128 + wc * 32 + n * 16 + 4 * fq;
            const int gl = wc * 32 + n * 16 + 4 * fq; const f32x4 bg = bl ? *(const LAS f32x4*)(bl + gl) : *(const f32x4*)(bias + (size_t)(layer * NEXP + e) * (2 * DFF) + gc), bu = bl ? *(const LAS f32x4*)(bl + 128 + gl) : *(const f32x4*)(bias + (size_t)(layer * NEXP + e) * (2 * DFF) + DFF + gc);
#pragma unroll
            for (int m = 0; m < 8; ++m) { const int r = rbase + wr * 128 + m * 16 + fr; float a[4];
#pragma unroll
                for (int j = 0; j < 4; ++j) { const float gg = fminf(acc[m][n][j] + bg[j], 7.f), uu = __builtin_amdgcn_fmed3f(acc[m][n + 2][j] + bu[j], -7.f, 7.f);
                    a[j] = (uu + 1.f) * gg * __builtin_amdgcn_rcpf(1.f + fexp2(-1.702f * LOG2E * gg)); }
                if (r < cnt) { u32x2 w; w.x = pk2(a[0], a[1]); w.y = pk2(a[2], a[3]); *(u32x2*)(ACT + (size_t)(ro + r) * DFF + gc) = w; } } } }
};
struct PolMoe2 : PolMoe {
    __device__ __forceinline__ unsigned bias_voff(const TD& td) const { return 4u * (unsigned)((layer * NEXP + td.i0) * D + td.i1 * 256 + lane * 4); }
    __device__ __forceinline__ bool get(int i, TD& td) const { int e, ct, rbase, ro, cnt; if (!find(i, e, ct, rbase, ro, cnt)) return false;
        td.A = (const bf16_t*)(ws + WS_ACT);
#pragma unroll
        for (int i2 = 0; i2 < 4; ++i2) { int rr = rbase + prow(i2); rr = rr < cnt ? rr : cnt - 1; td.aoff[i2] = (unsigned)(((ro + rr) * DFF + pcol()) * 2); }
        td.B = panel(e, ct); td.bco = nullptr;
        td.i0 = e; td.i1 = ct; td.i2 = rbase; td.i3 = ro; td.i4 = cnt; return true; }
    __device__ __forceinline__ void epi(f32x4 (&acc)[8][4], const TD& td, const LAS float* bl) const { (void)bl; EPI_GEOM; const int e = td.i0, ct = td.i1, rbase = td.i2, ro = td.i3, cnt = td.i4;
        bf16_t* Y = (bf16_t*)(ws + WS_Y);
#pragma unroll
        for (int n = 0; n < 4; ++n) { const int c = ct * 256 + wc * 64 + n * 16 + 4 * fq; const f32x4 bv = bl ? *(const LAS f32x4*)(bl + wc * 64 + n * 16 + 4 * fq) : *(const f32x4*)(bias + (size_t)(layer * NEXP + e) * D + c);
#pragma unroll
            for (int m = 0; m < 8; ++m) { const int r = rbase + wr * 128 + m * 16 + fr;
                if (r < cnt) { u32x2 w; w.x = pk2(acc[m][n][0] + bv[0], acc[m][n][1] + bv[1]); w.y = pk2(acc[m][n][2] + bv[2], acc[m][n][3] + bv[3]); *(u32x2*)(Y + (size_t)(ro + r) * D + c) = w; } } } }
};
__device__ __forceinline__ void phase_moe1(Frame& F, const XcdBarrier& bar, const bool use_bar, const int layer) {
    const MoeLds L = moe_lds(F);
    moe_prefix(F, layer, L);
    const int ne = __builtin_amdgcn_readfirstlane(L.nz[32]), tq = __builtin_amdgcn_readfirstlane(L.mtq[32]);
    const float* W = PP(moe_w_gu); const float* bias = PP(moe_b_gu);
    { PolMoe1 P; P.L = L; P.layer = layer; P.nct = 8; P.round = 0; P.bc_off = WS_BC; P.base_init(F, D / 64, ne * 8); P.bfm = false; P.W = W; P.bias = bias;
      { const int l2 = F.lane & 31; P.lcolb = 4u * (unsigned)((F.lane >> 5) * DFF + 4 * l2); P.woff = 2u * (unsigned)(((4 * l2) >> 5) * 64 + (F.lane >> 5) * 32 + ((4 * l2) & 31)); }
      gemm_stream(F.lds, P, F.wid, F.lane); }
    if (use_bar) xcd_barrier(bar);
    { PolMoe1 P; P.L = L; P.layer = layer; P.nct = 8; P.round = 1; P.bc_off = WS_BC; P.base_init(F, D / 64, tq * 8); P.ldbB = 256; P.W = W; P.bias = bias; P.has_bias = true; P.has_list = true; P.listp = (const int*)(F.ws + WS_LIST);
      gemm_stream_bf(F.lds, P, F.wid, F.lane); }
}
__device__ __forceinline__ void phase_moe2(Frame& F, const int layer) {
    const MoeLds L = moe_lds(F);
    moe_prefix(F, layer, L);
    PolMoe2 P; P.L = L; P.layer = layer; P.nct = 4; P.round = 2; P.bc_off = WS_BC2; P.base_init(F, DFF / 64, __builtin_amdgcn_readfirstlane(L.mtp[32]) * 4); P.ldbB = 256; P.W = nullptr; P.bias = PP(moe_b_dn); P.has_bias = true;
    gemm_stream_bf(F.lds, P, F.wid, F.lane);
}

__device__ __forceinline__ void phase_combine(Frame& F, const int layer) {
    const MoeLds ML = moe_lds(F); LAS int* roff = ML.roff;
    moe_prefix(F, layer, ML);
    const int nrows = layer == 0 ? NTOK : NMAIN, lane = F.lane;
    const int gw = F.bid * 8 + F.wid, NGW = F.G * 8;
    i32x4 ps_n = (i32x4){0, 0, 0, 0}; f32x4 tw_n = (f32x4){0.f, 0.f, 0.f, 0.f}, tw_c = tw_n;
    u32x2 y_c[4][4], y_n[4][4]; f32x4 xs_c[4], xs_n[4];
#define CMB_IDX(row_) do { if ((row_) < nrows) { ps_n = *(const i32x4*)(F_POS + (size_t)(row_) * 4); tw_n = *(const f32x4*)(F_TOPW + (size_t)(row_) * 4); } } while (0)
#define CMB_DATA(row_, Y_, XS_) do { if ((row_) < nrows) { \
        _Pragma("unroll") for (int k = 0; k < 4; ++k) { const int e = ps_n[k] & 255, pos = ps_n[k] >> 8; const bf16_t* y = F_Y + (size_t)(roff[e] + pos) * D; \
            _Pragma("unroll") for (int j = 0; j < 4; ++j) Y_[k][j] = *(const u32x2*)(y + 4 * lane + 256 * j); } \
        _Pragma("unroll") for (int j = 0; j < 4; ++j) XS_[j] = *(const f32x4*)(F_XS + (size_t)(row_) * D + 4 * lane + 256 * j); } } while (0)
    CMB_IDX(gw); CMB_DATA(gw, y_c, xs_c); tw_c = tw_n; CMB_IDX(gw + NGW);
    for (int row = gw; row < nrows; row += NGW) {
        CMB_DATA(row + NGW, y_n, xs_n); const f32x4 tw_nn = tw_n; CMB_IDX(row + 2 * NGW);
        const int r = mod_row(row); const float* g2 = modp(F, layer, r, 5);
        f32x4 v[4];
#pragma unroll
        for (int j = 0; j < 4; ++j) v[j] = (f32x4){0.f, 0.f, 0.f, 0.f};
#pragma unroll
        for (int k = 0; k < 4; ++k) { const float w = tw_c[k];
#pragma unroll
            for (int j = 0; j < 4; ++j) { const u32x2 u = y_c[k][j]; v[j][0] += w * bflo(u.x); v[j][1] += w * bfhi(u.x); v[j][2] += w * bflo(u.y); v[j][3] += w * bfhi(u.y); } }
#pragma unroll
        for (int j = 0; j < 4; ++j) { const int c = 4 * lane + 256 * j; const f32x4 gv = *(const f32x4*)(g2 + c); v[j] = xs_c[j] + gv * v[j]; }
        const float rstd = row_rstd(v);
        if (layer == 0) {
#pragma unroll
            for (int j = 0; j < 4; ++j) *(f32x4*)(F_XS + (size_t)row * D + 4 * lane + 256 * j) = v[j];
            norm_mod_store(v, rstd, PP(norm_mix) + D, modp(F, 1, r, 1), modp(F, 1, r, 0), F_H + (size_t)row * D, lane);
        } else {
#pragma unroll
            for (int j = 0; j < 4; ++j) { const int c = 4 * lane + 256 * j; const f32x4 g = *(const f32x4*)(PP(final_norm) + c); *(f32x4*)(((float*)ldp(F, (int)__builtin_offsetof(Params, out))) + (size_t)row * D + c) = v[j] * rstd * g; }
        }
        tw_c = tw_nn;
#pragma unroll
        for (int k = 0; k < 4; ++k)
#pragma unroll
            for (int j = 0; j < 4; ++j) y_c[k][j] = y_n[k][j];
#pragma unroll
        for (int j = 0; j < 4; ++j) xs_c[j] = xs_n[j];
        __builtin_amdgcn_sched_barrier(0);
    }
#undef CMB_IDX
#undef CMB_DATA
}

struct PolInproj1 : PolBase {
    const float* W;
    __device__ __forceinline__ bool get(int i, TD& td) const { int t; if (!tileL(i, t)) return false; constexpr int N_MAIN_T = (NMAIN / 256) * 10; int pm, pn;
        if (t < N_MAIN_T) dense_tile(t, NMAIN / 256, 10, pm, pn); else { const int c = t - N_MAIN_T; pm = NMAIN / 256 + (c & 3); pn = 2 + (c >> 2); }
        td.A = (const bf16_t*)(ws + WS_H); dense_aoff(td, pm * 256, D);
        td.B = (const bf16_t*)(ws + WB_OIN) + pn * 256; td.i0 = pm; td.i1 = pn; return true; }
    __device__ __forceinline__ void epi(f32x4 (&acc)[8][4], const TD& td, const LAS float* bl) const { (void)bl; EPI_GEOM; const int pm = td.i0, pn = td.i1;
        if (pn < 6) { bf16_t* PROJ = (bf16_t*)(ws + WS_PROJ);
#pragma unroll
            for (int m = 0; m < 8; ++m) { const int row = pm * 256 + wr * 128 + m * 16 + fr;
#pragma unroll
                for (int n = 0; n < 4; ++n) { u32x2 w; w.x = pk2(acc[m][n][0], acc[m][n][1]); w.y = pk2(acc[m][n][2], acc[m][n][3]);
                    *(u32x2*)(PROJ + (size_t)row * QKV_LD + pn * 256 + wc * 64 + n * 16 + 4 * fq) = w; } }
        } else { const int g = pn - 6, ri = wc >> 1; bf16_t* Z = (bf16_t*)(ws + WS_Z);
#pragma unroll
            for (int m = 0; m < 8; ++m) { const int row = pm * 256 + wr * 128 + m * 16 + fr, b = row >> 12, n1 = (row >> 6) & 63, n2 = row & 63;
                bf16_t* zb = Z + ((((size_t)(b * 64 + n1) * 2 + ri) * 64 + n2) * 512) + g * 128 + (wc & 1) * 64;
#pragma unroll
                for (int n = 0; n < 4; ++n) { u32x2 w; w.x = pk2(acc[m][n][0], acc[m][n][1]); w.y = pk2(acc[m][n][2], acc[m][n][3]); *(u32x2*)(zb + n * 16 + 4 * fq) = w; } } } }
};
__device__ __forceinline__ void phase_inproj_l1(Frame& F) {
    PolInproj1 P; P.base_init(F, D / 64, (NMAIN / 256) * 10 + (NCTX / 256) * 4); P.ldbB = 2560;
    gemm_stream_bf(F.lds, P, F.wid, F.lane);
}

struct PolFour : PolBase {
    int stage;
    __device__ __forceinline__ bool get(int i, TD& td) const { int L; if (!tileL(i, L)) return false; const int b = L >> 7, ct = L & 127;
        td.A = (const bf16_t*)(ws + (stage == 1 ? WS_M1 : WS_M2)); dense_aoff(td, 0, 128);
        td.B = (const bf16_t*)(ws + (stage == 1 ? WS_Z : WS_A1)) + (size_t)b * 128 * 32768 + ct * 256; td.i0 = b; td.i1 = ct; return true; }
    __device__ __forceinline__ void epi(f32x4 (&acc)[8][4], const TD& td, const LAS float* bl) const { (void)bl; EPI_GEOM; const int b = td.i0, ct = td.i1;
        if (wr != 0) return;
        if (stage == 1) { const f32x2* TW = (const f32x2*)(ws + WS_TW); bf16_t* A1 = (bf16_t*)(ws + WS_A1);
#pragma unroll
            for (int m = 0; m < 4; ++m) { const int k1 = m * 16 + fr;
#pragma unroll
                for (int n = 0; n < 4; ++n) { const int col = ct * 256 + wc * 64 + n * 16 + 4 * fq, n2 = col >> 9, c = col & 511;
                    const f32x2 tw = TW[n2 * k1]; const f32x4 re = acc[m][n], im = acc[m + 4][n];
                    const f32x4 ore = re * tw.x + im * tw.y, oim = im * tw.x - re * tw.y; u32x2 w0, w1;
                    w0.x = pk2(ore[0], ore[1]); w0.y = pk2(ore[2], ore[3]); w1.x = pk2(oim[0], oim[1]); w1.y = pk2(oim[2], oim[3]);
                    *(u32x2*)(A1 + ((((size_t)(b * 2 + 0) * 64 + n2) * 64 + k1) * 512) + c) = w0;
                    *(u32x2*)(A1 + ((((size_t)(b * 2 + 1) * 64 + n2) * 64 + k1) * 512) + c) = w1; } }
        } else { const float scl = 1.f / 724.0773439350247f; bf16_t* MIX = (bf16_t*)(ws + WS_MIX);
#pragma unroll
            for (int m = 0; m < 4; ++m) { const int k2 = m * 16 + fr;
#pragma unroll
                for (int n = 0; n < 4; ++n) { const int col = ct * 256 + wc * 64 + n * 16 + 4 * fq, k1 = col >> 9, c = col & 511;
                    const f32x4 o = acc[m][n] * scl; u32x2 w; w.x = pk2(o[0], o[1]); w.y = pk2(o[2], o[3]);
                    *(u32x2*)(MIX + (size_t)(b * SEQ + k1 + 64 * k2) * D + 512 + c) = w; } } } }
};

__device__ __forceinline__ void phase_attn_l1(Frame& F) {
    const int wid = F.wid, lane = F.lane, fr = lane & 15, fq = lane >> 4;
    constexpr int N_NA = NB * 64, N_F1 = NB * 128;
    const float SC = 0.125f * LOG2E;
    for (int it = F.bid; it < N_NA; it += F.G) {
            LAS unsigned char* vl = F.lds + wid * 8192;
            LAS float* rp = (LAS float*)(vl + 5120);
            const int b = it >> 6, r = it & 63, h = wid;
            for (int i = lane; i < 465; i += 64) rp[i] = PP(odd_rpb)[h * 465 + i] * LOG2E;
            for (int qh = 0; qh < 4 / QT; ++qh) {
            const int qc0 = qh * (16 * QT), qrow0 = b * SEQ + r * 64 + qc0;
            bf16x8 qf[QT][2];
#pragma unroll
            for (int qt = 0; qt < QT; ++qt)
#pragma unroll
                for (int ks = 0; ks < 2; ++ks) qf[qt][ks] = *(const bf16x8*)(F_PROJ + (size_t)(qrow0 + qt * 16 + fr) * QKV_LD + h * 64 + ks * 32 + 8 * fq);
            AttnSt st;
#pragma unroll
            for (int qt = 0; qt < QT; ++qt) { st.m[qt] = -1e30f; st.l[qt] = 0.f;
#pragma unroll
                for (int dt = 0; dt < 4; ++dt) st.o[dt][qt] = (f32x4){0.f, 0.f, 0.f, 0.f}; }
            const int r0 = min(max(r - 4, 0), 56);
            int c0q[QT];
#pragma unroll
            for (int qt = 0; qt < QT; ++qt) c0q[qt] = min(max(qc0 + qt * 16 + fr - 8, 0), 48);
            for (int s = 0; s < 16; ++s) {
                const int kr = r0 + (s >> 1), half = s & 1;
                const bf16_t* kp = F_PROJ + (size_t)(b * SEQ + kr * 64 + half * 32) * QKV_LD + 512 + h * 64;
                const bf16_t* vp = kp + 512;
                const LAS float* rpr = rp + (kr - r + 7) * 31 + 15;
#define SKIP_NA(qt) ({ const int qlo_ = qc0 + qt * 16, wlo_ = min(max(qlo_ - 8, 0), 48), whi_ = min(max(qlo_ + 15 - 8, 0), 48) + 15; (half * 32 + 31 < wlo_) || (half * 32 > whi_); })
#define BIAS_NA(qt, kt, j) ({ const int kc = half * 32 + kt * 16 + 4 * fq + j; const int dc = kc - (qc0 + qt * 16 + fr); (kc >= c0q[qt] && kc < c0q[qt] + 16) ? rpr[dc] : -INFINITY; })
                ATTN_STEP(kp, QKV_LD, vp, QKV_LD, SC, BIAS_NA, SKIP_NA);
            }
            for (int s = 0; s < 8; ++s) {
                const bf16_t* kp = F_PROJ + (size_t)(NMAIN + b * CTXL + s * 32) * QKV_LD + 512 + h * 64;
                const bf16_t* vp = kp + 512;
                ATTN_STEP(kp, QKV_LD, vp, QKV_LD, SC, BIAS_NONE, SKIP_NONE);
            }
            attn_store(st, F_MIX + (size_t)qrow0 * D + h * 64, D, fr, fq);
            }
    }
    __syncthreads();
    PolFour P; P.stage = 1; P.base_init(F, 2, N_F1); P.ldbB = 32768;
    gemm_stream_bf(F.lds, P, F.wid, F.lane);
}

__device__ __forceinline__ void phase_fst2(Frame& F) {
    PolFour P; P.stage = 2; P.base_init(F, 2, NB * 128); P.ldbB = 32768;
    gemm_stream_bf(F.lds, P, F.wid, F.lane);
}

__global__ void __launch_bounds__(512, 2) fwd_kernel(Params p) {
    extern __shared__ __attribute__((aligned(16))) unsigned char lds_raw[];
    Frame F;
    F.lds = (LAS unsigned char*)lds_raw;
    F.tid = threadIdx.x; F.lane = F.tid & 63; F.wid = __builtin_amdgcn_readfirstlane(F.tid >> 6); F.bid = blockIdx.x; F.G = gridDim.x;
    unsigned char* ws = p.ws; F.ws = ws;
    volatile LAS unsigned* MISC = (volatile LAS unsigned*)(F.lds + MISC_OFF);
    if (F.tid < 64) MISC[F.tid] = 0u;
    if (F.tid == 64) { LAS unsigned long long* LP = (LAS unsigned long long*)(F.lds + PARAM_OFF);
        LP[0] = (unsigned long long)p.x; LP[1] = (unsigned long long)p.c; LP[2] = (unsigned long long)p.ctx; LP[3] = (unsigned long long)p.c_ctx; LP[4] = (unsigned long long)p.ada_w; LP[5] = (unsigned long long)p.ada_b;
        LP[6] = (unsigned long long)p.norm_mix; LP[7] = (unsigned long long)p.norm_ffn; LP[8] = (unsigned long long)p.even_w_in; LP[9] = (unsigned long long)p.even_w_out; LP[10] = (unsigned long long)p.even_conv_w;
        LP[11] = (unsigned long long)p.even_sink; LP[12] = (unsigned long long)p.odd_w_in; LP[13] = (unsigned long long)p.odd_w_out; LP[14] = (unsigned long long)p.odd_rpb; LP[15] = (unsigned long long)p.router_w;
        LP[16] = (unsigned long long)p.router_b; LP[17] = (unsigned long long)p.moe_w_gu; LP[18] = (unsigned long long)p.moe_b_gu; LP[19] = (unsigned long long)p.moe_w_dn; LP[20] = (unsigned long long)p.moe_b_dn;
        LP[21] = (unsigned long long)p.final_norm; LP[22] = (unsigned long long)p.out; }
    __syncthreads();
    const int lo = p.ph_lo, hi = p.ph_hi;
    XcdBarrier bar; bar.bar = (unsigned*)(ws + WS_CTL) + CW_BAR; bar.x = 0; bar.st = MISC + 8;
    if (hi - lo > 1) bar = xcd_barrier_post((unsigned*)(ws + WS_CTL) + CW_BAR, MISC + 8);
#define RUN_PHASE(ph, call) do { if (PH_ON(ph) && lo <= (ph) && (ph) < hi) { call; if (PH_REP(ph)) { xcd_barrier(bar); call; } } if (lo <= (ph) && (ph) + 1 < hi) xcd_barrier(bar); } while (0)
    RUN_PHASE(PH_PREP, phase_prep(F));
    RUN_PHASE(PH_NORM1_0, phase_norm1_l0(F));
    RUN_PHASE(PH_INPROJ_0, phase_inproj_l0(F));
    RUN_PHASE(PH_ATTN_0, phase_attn_l0(F));
    RUN_PHASE(PH_OUTPROJ_0, phase_outproj(F, 0));
    RUN_PHASE(PH_ROUTE_0, phase_route(F, 0));
    RUN_PHASE(PH_MOE1_0, phase_moe1(F, bar, hi - lo > 1, 0));
    RUN_PHASE(PH_MOE2_0, phase_moe2(F, 0));
    RUN_PHASE(PH_COMB_0, phase_combine(F, 0));
    RUN_PHASE(PH_INPROJ_1, phase_inproj_l1(F));
    RUN_PHASE(PH_ATTN_1, phase_attn_l1(F));
    RUN_PHASE(PH_FST2_1, phase_fst2(F));
    RUN_PHASE(PH_OUTPROJ_1, phase_outproj(F, 1));
    RUN_PHASE(PH_ROUTE_1, phase_route(F, 1));
    RUN_PHASE(PH_MOE1_1, phase_moe1(F, bar, hi - lo > 1, 1));
    RUN_PHASE(PH_MOE2_1, phase_moe2(F, 1));
    RUN_PHASE(PH_FINAL, phase_combine(F, 1));
}

extern "C" void kernel_launch(void* const* d_in, const int* in_sizes, int n_in, void* d_out, int out_size, void* d_ws, size_t ws_size, hipStream_t stream) {
    static int grid = 0;
    if (grid == 0) {
        if (n_in != 22 || ws_size < WS_END) { fprintf(stderr, "kernel_launch: unexpected inputs (n_in %d, ws %zu)\n", n_in, ws_size); grid = -1; return; }
        int dev = 0, cus = 0, per_cu = 0;
        hipGetDevice(&dev);
        hipDeviceGetAttribute(&cus, hipDeviceAttributeMultiprocessorCount, dev);
        hipFuncSetAttribute((const void*)fwd_kernel, hipFuncAttributeMaxDynamicSharedMemorySize, LDS_BYTES);
        hipOccupancyMaxActiveBlocksPerMultiprocessor(&per_cu, (const void*)fwd_kernel, 512, LDS_BYTES);
        if (per_cu < 1) { fprintf(stderr, "kernel_launch: occupancy query says %d blocks/CU\n", per_cu); per_cu = 1; }
        (void)hipGetLastError();
        grid = cus;
    }
    if (grid < 0) return;
    hipMemsetAsync((char*)d_ws + WS_CTL, 0, CTL_BYTES, stream);
    Params p{};
    const float** pp = (const float**)&p;
    for (int i = 0; i < 22; ++i) pp[i] = (const float*)d_in[i];
    p.out = (float*)d_out; p.ws = (unsigned char*)d_ws;
#if N_LAUNCH_MODE == 1
    for (int ph = 0; ph < NPHASE; ++ph) { p.ph_lo = ph; p.ph_hi = ph + 1; hipLaunchKernelGGL(fwd_kernel, dim3(grid), dim3(512), LDS_BYTES, stream, p); }
#else
    p.ph_lo = 0; p.ph_hi = NPHASE;
    void* args[] = {&p};
    hipError_t e = hipLaunchCooperativeKernel((const void*)fwd_kernel, dim3(grid), dim3(512), args, LDS_BYTES, stream);
    if (e != hipSuccess) fprintf(stderr, "kernel_launch: cooperative launch failed: %s (grid %d)\n", hipGetErrorString(e), grid);
#endif
}
```

```cpp
#include <hip/hip_runtime.h>
#include <cstdio>
#include <cstdint>

#ifndef N_LAUNCH_MODE
#define N_LAUNCH_MODE 0
#endif

#ifndef PHASE_MASK
#define PHASE_MASK 0x1FFFF
#endif
#define PH_ON(ph) ((PHASE_MASK >> (ph)) & 1)
#ifndef REPEAT_MASK
#define REPEAT_MASK 0
#endif
#define PH_REP(ph) ((REPEAT_MASK >> (ph)) & 1)
#define LAS __attribute__((address_space(3)))
#define GAS __attribute__((address_space(1)))
typedef unsigned short bf16_t;
typedef short bf16x8 __attribute__((ext_vector_type(8)));
typedef short s16x4 __attribute__((ext_vector_type(4)));
typedef float f32x4 __attribute__((ext_vector_type(4)));
typedef float f32x2 __attribute__((ext_vector_type(2)));
typedef int i32x4 __attribute__((ext_vector_type(4)));
typedef unsigned u32x2 __attribute__((ext_vector_type(2)));
typedef unsigned u32x4 __attribute__((ext_vector_type(4)));

constexpr int D = 1024, NB = 4, SEQ = 4096, CTXL = 256;
constexpr int NMAIN = NB * SEQ, NCTX = NB * CTXL, NTOK = NMAIN + NCTX;
constexpr int EVEN_IN = 2304, NEXP = 32, DFF = 1024;
constexpr int QKV_LD = 1536;
constexpr float NORM_EPS = 1e-6f;
constexpr float LOG2E = 1.4426950408889634f;

constexpr size_t MiB = 1ull << 20;
constexpr size_t WS_CTL = 0, CTL_BYTES = 1 * MiB;
constexpr size_t WS_MOD = 1 * MiB;
constexpr size_t WS_M1 = 2 * MiB;
constexpr size_t WS_M2 = WS_M1 + 65536;
constexpr size_t WS_ROPE = WS_M2 + 65536;
constexpr size_t WS_TW = WS_ROPE + 8192;
constexpr size_t WS_WF = 4 * MiB;
constexpr size_t WS_TOPW = 8 * MiB;
constexpr size_t WS_POS = 9 * MiB;
constexpr size_t WS_LIST = 12 * MiB;
constexpr size_t WS_H = 16 * MiB;
constexpr size_t WS_MIX = 52 * MiB;
constexpr size_t WS_XS = 88 * MiB;
constexpr size_t WS_PROJ = 160 * MiB;
constexpr size_t WS_Z = 240 * MiB;
constexpr size_t WS_A1 = 304 * MiB;
constexpr size_t WS_ACT = 368 * MiB;
constexpr size_t WS_Y = 512 * MiB;
constexpr size_t WS_WB = 656 * MiB;
constexpr size_t WB_EIN = WS_WB, WB_EOUT = WB_EIN + (size_t)D * EVEN_IN * 2, WB_OIN = WB_EOUT + (size_t)D * D * 2, WB_OOUT = WB_OIN + (size_t)D * 2560 * 2;
constexpr size_t WS_BC = 672 * MiB;
constexpr size_t WS_BC2 = WS_BC + 128 * MiB;
constexpr size_t WS_END = 864 * MiB;
constexpr int CW_BAR = 4096;
constexpr int CW_CNT = 8192;

constexpr int LDS_BYTES = 147456;
constexpr int PARAM_OFF = LDS_BYTES - 512;
constexpr int MISC_OFF = LDS_BYTES - 256;
constexpr int A_TILE_B = 32768, B_ROWB = 544, B_TILE_B = 64 * B_ROWB, STAGE_B = A_TILE_B + B_TILE_B;
static_assert(2 * STAGE_B + 1024 + 8192 <= PARAM_OFF, "LDS");

enum { PH_PREP = 0, PH_NORM1_0, PH_INPROJ_0, PH_ATTN_0, PH_OUTPROJ_0, PH_ROUTE_0, PH_MOE1_0, PH_MOE2_0, PH_COMB_0,
       PH_INPROJ_1, PH_ATTN_1, PH_FST2_1, PH_OUTPROJ_1, PH_ROUTE_1, PH_MOE1_1, PH_MOE2_1, PH_FINAL, NPHASE };

struct Params {
    const float *x, *c, *ctx, *c_ctx, *ada_w, *ada_b, *norm_mix, *norm_ffn, *even_w_in, *even_w_out, *even_conv_w, *even_sink,
                *odd_w_in, *odd_w_out, *odd_rpb, *router_w, *router_b, *moe_w_gu, *moe_b_gu, *moe_w_dn, *moe_b_dn, *final_norm;
    float* out; unsigned char* ws; int ph_lo, ph_hi;
};

__device__ __forceinline__ unsigned pk2(float lo, float hi) { unsigned r; asm("v_cvt_pk_bf16_f32 %0, %1, %2" : "=v"(r) : "v"(lo), "v"(hi)); return r; }
__device__ __forceinline__ float bflo(unsigned u) { return __builtin_bit_cast(float, u << 16); }
__device__ __forceinline__ float bfhi(unsigned u) { return __builtin_bit_cast(float, u & 0xffff0000u); }
__device__ __forceinline__ float wave_sum(float v) {
#pragma unroll
    for (int o = 1; o < 64; o <<= 1) v += __shfl_xor(v, o);
    return v;
}
__device__ __forceinline__ float fexp2(float x) { return __builtin_amdgcn_exp2f(x); }

#define XB_TMO      128
#define XB_XCNT(j)  (256  + 64 * (j))
#define XB_XSUB(j)  (1280 + 64 * (j))
#define XB_XGEN(j)  (2304 + 64 * (j))
#define XB_TOP      3328
#define XB_TOPGEN   3392
#define XB_SPIN_CAP (1u << 22)
__device__ __forceinline__ unsigned xb_ld(unsigned* p)              { return __hip_atomic_load(p, __ATOMIC_RELAXED, __HIP_MEMORY_SCOPE_AGENT); }
__device__ __forceinline__ unsigned xb_add(unsigned* p, unsigned v) { return __hip_atomic_fetch_add(p, v, __ATOMIC_RELAXED, __HIP_MEMORY_SCOPE_AGENT); }
__device__ __forceinline__ unsigned xb_xcc_id() { return (unsigned)__builtin_amdgcn_s_getreg((3 << 11) | 20) & 0xFu; }
#define XB_SPIN(cond, bar) do { unsigned _sp = 0; while (cond) { __builtin_amdgcn_s_sleep(1); \
    if ((++_sp & 255u) == 0u) { if (xb_ld(&(bar)[XB_TMO])) break; if (_sp > XB_SPIN_CAP) { atomicAdd(&(bar)[XB_TMO], 1u); break; } } } } while (0)
struct XcdBarrier { unsigned* bar; unsigned x; volatile LAS unsigned* st; };
__device__ __forceinline__ XcdBarrier xcd_barrier_post(unsigned* bar, volatile LAS unsigned* st) {
    XcdBarrier b; b.bar = bar; b.x = xb_xcc_id(); b.st = st;
    if (threadIdx.x == 0) (void)xb_add(&bar[XB_XCNT(b.x)], 1u);
    return b;
}
__device__ __forceinline__ void xcd_barrier_complete(unsigned* bar, unsigned x, unsigned& nloc, unsigned& nx) {
    const unsigned G = gridDim.x * gridDim.y * gridDim.z;
    unsigned sum, cnt, mine, sp = 0u;
    for (;;) {
        sum = 0u; cnt = 0u; mine = 0u;
#pragma unroll
        for (unsigned j = 0; j < 16; ++j) { const unsigned c = xb_ld(&bar[XB_XCNT(j)]); sum += c; cnt += (c > 0u) ? 1u : 0u; mine = (j == x) ? c : mine; }
        if (sum == G) break;
        __builtin_amdgcn_s_sleep(1);
        if ((++sp & 255u) == 0u) { if (xb_ld(&bar[XB_TMO])) break; if (sp > XB_SPIN_CAP) { atomicAdd(&bar[XB_TMO], 1u); break; } }
    }
    nloc = mine > 0u ? mine : 1u; nx = cnt > 0u ? cnt : 1u;
}
__device__ __forceinline__ void xcd_barrier(const XcdBarrier& b) {
    asm volatile("s_waitcnt vmcnt(0)" ::: "memory");
    __syncthreads();
    if (threadIdx.x == 0) {
        unsigned* bar = b.bar;
        __builtin_amdgcn_s_waitcnt(0);
        unsigned nloc = b.st[0], nx = b.st[1];
        if (nloc == 0u) { xcd_barrier_complete(bar, b.x, nloc, nx); b.st[0] = nloc; b.st[1] = nx; }
        const unsigned old = xb_add(&bar[XB_XSUB(b.x)], 1u);
        const unsigned gen = old / nloc;
        if (old + 1u == (gen + 1u) * nloc) {
            __builtin_amdgcn_fence(__ATOMIC_RELEASE, "agent");
            asm volatile("s_waitcnt vmcnt(0)" ::: "memory");
            const unsigned og = xb_add(&bar[XB_TOP], 1u);
            const unsigned tg = og / nx;
            if (og + 1u == (tg + 1u) * nx) xb_add(&bar[XB_TOPGEN], 1u);
            else XB_SPIN(xb_ld(&bar[XB_TOPGEN]) == tg, bar);
            __builtin_amdgcn_fence(__ATOMIC_ACQUIRE, "agent");
            xb_add(&bar[XB_XGEN(b.x)], 1u);
            asm volatile("s_waitcnt vmcnt(0)" ::: "memory");
        } else {
            XB_SPIN(xb_ld(&bar[XB_XGEN(b.x)]) == gen, bar);
            __builtin_amdgcn_fence(__ATOMIC_ACQUIRE, "agent");
            asm volatile("s_waitcnt vmcnt(0)" ::: "memory");
        }
    }
    __syncthreads();
}

struct TD { const bf16_t* A; const void* B; bf16_t* bco; unsigned ldb; unsigned aoff[4]; int i0, i1, i2, i3, i4; };
__device__ __forceinline__ int a_piece_row0(int wid, int lane) { const int sb = lane * 16, swz = sb ^ (((sb >> 9) & 1) << 5); return (wid >> 1) * 16 + (swz >> 6); }
__device__ __forceinline__ int a_piece_col(int wid, int lane) { const int sb = lane * 16, swz = sb ^ (((sb >> 9) & 1) << 5); return (wid & 1) * 32 + ((swz & 63) >> 1); }
__device__ __forceinline__ u32x4 make_rsrc(const void* p) { const unsigned long long ab = (unsigned long long)p; u32x4 r; r.x = __builtin_amdgcn_readfirstlane((unsigned)ab); r.y = __builtin_amdgcn_readfirstlane((unsigned)(ab >> 32)) & 0xffffu; r.z = 0x7fffffffu; r.w = 0x00020000u; return r; }

template <class Pol>
__device__ __forceinline__ void gemm_stream(LAS unsigned char* lds, Pol& P, const int wid, const int lane) {
    const int wr = wid >> 2, wc = wid & 3, fr = lane & 15, fq = lane >> 4;
    const unsigned b_w = (unsigned)(A_TILE_B + ((wid >> 2) * 32 + 4 * (wid & 3)) * B_ROWB) + P.woff;
    const unsigned a_r = (unsigned)(wr * 16384 + ((fr * 64 + fq * 16) ^ ((fr >> 3) << 5)));
    const unsigned b_r = (unsigned)(A_TILE_B + (4 * fq + (fr >> 2)) * B_ROWB + (wc * 64 + (fr & 3) * 4) * 2);
    const unsigned ldsa = (unsigned)(__UINTPTR_TYPE__)lds + (unsigned)(wid * 1024);
    const unsigned lcolb = P.lcolb;
    TD cur, nxt;
    if (!P.get(0, cur)) return;
    int nt = P.nt; asm volatile("" : "+s"(nt));
    f32x4 sb[8]; f32x4 acc[8][4];
    u32x4 ra_c = make_rsrc(cur.A), ra_n = ra_c;
    __amdgpu_buffer_rsrc_t rb_c = __builtin_amdgcn_make_buffer_rsrc((void*)cur.B, 0, 0x7fffffff, 0x00020000), rb_n = rb_c;
#define G_GLDS_A(buf, RA, AOFF, kt) do { _Pragma("unroll") for (int i = 0; i < 4; ++i) { unsigned keep_; \
        asm volatile("s_mov_b32 %0, m0\n\ts_mov_b32 m0, %3\n\ts_nop 0\n\tbuffer_load_dwordx4 %1, %2, %4 offen lds\n\ts_mov_b32 m0, %0" \
            : "=&s"(keep_) : "v"(AOFF[i]), "s"(RA), "s"(ldsa + (buf) + (unsigned)(i * 8192)), "s"((unsigned)((kt) * 128)) : "memory"); } } while (0)
#define G_ISSUE_BH(RB, LDB4, kt, h) do { \
        _Pragma("unroll") for (int i = 4 * (h); i < 4 * (h) + 4; ++i) sb[i] = __builtin_bit_cast(f32x4, __builtin_amdgcn_raw_buffer_load_b128(RB, (int)lcolb, (int)(((unsigned)(kt) * 64u + i) * (LDB4)), 0)); \
        __builtin_amdgcn_sched_barrier(0); } while (0)
#define G_WRITE_BH(buf, h, BCO, kt) do { \
        _Pragma("unroll") for (int i = 4 * (h); i < 4 * (h) + 4; ++i) { u32x2 w; w.x = pk2(sb[i][0], sb[i][1]); w.y = pk2(sb[i][2], sb[i][3]); \
            *(LAS u32x2*)(lds + (buf) + b_w + (16 * (i >> 2) + (i & 3)) * B_ROWB) = w; \
            if (BCO) *(u32x2*)((char*)(BCO) + (size_t)((kt) * 64 + wid * 8 + i) * 512 + P.woff) = w; } __builtin_amdgcn_sched_barrier(0); } while (0)
#define G_KSTEP(buf, ks) do { bf16x8 Bf[4]; \
        _Pragma("unroll") for (int n = 0; n < 4; ++n) { \
            const s16x4 lo = __builtin_amdgcn_ds_read_tr16_b64_v4i16((LAS s16x4*)(lds + (buf) + b_r + (ks) * 32 * B_ROWB + n * 32)); \
            const s16x4 hi = __builtin_amdgcn_ds_read_tr16_b64_v4i16((LAS s16x4*)(lds + (buf) + b_r + (ks) * 32 * B_ROWB + 16 * B_ROWB + n * 32)); \
            Bf[n] = (bf16x8){lo[0], lo[1], lo[2], lo[3], hi[0], hi[1], hi[2], hi[3]}; } \
        _Pragma("unroll") for (int mh = 0; mh < 2; ++mh) { bf16x8 At[4]; \
            _Pragma("unroll") for (int m = 0; m < 4; ++m) At[m] = *(const LAS bf16x8*)(lds + (buf) + a_r + (mh * 4 + m) * 2048 + (ks) * 1024); \
            _Pragma("unroll") for (int m = 0; m < 4; ++m) _Pragma("unroll") for (int n = 0; n < 4; ++n) \
                acc[mh * 4 + m][n] = __builtin_amdgcn_mfma_f32_16x16x32_bf16(Bf[n], At[m], acc[mh * 4 + m][n], 0, 0, 0); } \
        __builtin_amdgcn_sched_barrier(0); } while (0)
    { unsigned b0 = 0; asm volatile("" : "+s"(b0));
      const unsigned l4 = cur.ldb * 4u;
      G_GLDS_A(b0, ra_c, cur.aoff, 0); G_ISSUE_BH(rb_c, l4, 0, 0); G_ISSUE_BH(rb_c, l4, 0, 1); G_WRITE_BH(b0, 0, cur.bco, 0); G_WRITE_BH(b0, 1, cur.bco, 0);
      G_ISSUE_BH(rb_c, l4, 1, 0); G_ISSUE_BH(rb_c, l4, 1, 1); }
    asm volatile("s_waitcnt vmcnt(8)" ::: "memory");
    asm volatile("s_waitcnt lgkmcnt(0)" ::: "memory");
    __builtin_amdgcn_s_barrier();
    unsigned par = 0;
    for (int ti = 0;; ++ti) {
        const bool hasn = P.get(ti + 1, nxt);
        if (hasn) { ra_n = make_rsrc(nxt.A); rb_n = __builtin_amdgcn_make_buffer_rsrc((void*)nxt.B, 0, 0x7fffffff, 0x00020000); }
#pragma unroll
        for (int m = 0; m < 8; ++m)
#pragma unroll
            for (int n = 0; n < 4; ++n) acc[m][n] = (f32x4){0.f, 0.f, 0.f, 0.f};
        for (int t = 0; t < nt; ++t) {
            unsigned bc = par * STAGE_B, bn = (par ^ 1u) * STAGE_B; asm volatile("" : "+s"(bc), "+s"(bn));
            const bool c1 = t + 1 < nt, w1 = c1 || hasn, c2 = t + 2 < nt, i2 = c2 || hasn;
            if (w1) { const u32x4 ra = c1 ? ra_c : ra_n; unsigned ao[4];
#pragma unroll
                for (int i = 0; i < 4; ++i) ao[i] = c1 ? cur.aoff[i] : nxt.aoff[i];
                G_GLDS_A(bn, ra, ao, c1 ? t + 1 : 0); }
            G_KSTEP(bc, 0);
            const __amdgpu_buffer_rsrc_t rb = c2 ? rb_c : rb_n; const unsigned l4 = (c2 ? cur.ldb : nxt.ldb) * 4u; const int k2 = c2 ? t + 2 : t + 2 - nt;
            bf16_t* const bco = c1 ? cur.bco : nxt.bco; const int k1 = c1 ? t + 1 : 0;
            if (w1) G_WRITE_BH(bn, 0, bco, k1);
            if (i2) G_ISSUE_BH(rb, l4, k2, 0);
            G_KSTEP(bc, 1);
            if (w1) G_WRITE_BH(bn, 1, bco, k1);
            if (i2) { G_ISSUE_BH(rb, l4, k2, 1); asm volatile("s_waitcnt vmcnt(8)" ::: "memory"); }
            else asm volatile("s_waitcnt vmcnt(0)" ::: "memory");
            asm volatile("s_waitcnt lgkmcnt(0)" ::: "memory");
            __builtin_amdgcn_s_barrier();
            par ^= 1u;
        }
        P.epi(acc, cur, (const LAS float*)nullptr);
        if (!hasn) break;
        cur = nxt; ra_c = ra_n; rb_c = rb_n;
    }
#undef G_GLDS_A
#undef G_ISSUE_BH
#undef G_WRITE_BH
#undef G_KSTEP
}

constexpr int STEP_B = 32768;
constexpr unsigned ROPE_LDS = 2 * STAGE_B + 1024;
constexpr unsigned BIAS_OFF = 4 * STEP_B;
template <class Pol, int ABL = 0>
__device__ __forceinline__ void gemm_stream_bf(LAS unsigned char* lds, Pol& P, const int wid, const int lane) {
    const int wr = wid >> 2, wc = wid & 3, fr = lane & 15, fq = lane >> 4;
    const unsigned a_r = (unsigned)(wr * 8192 + ((fr * 64 + fq * 16) ^ ((fr >> 3) << 5)));
    const int x7 = 4 * (fq & 1) + (fr >> 2);
    unsigned b_r[4];
#pragma unroll
    for (int n = 0; n < 4; ++n) b_r[n] = (unsigned)(16384 + (4 * fq + (fr >> 2)) * 512 + (((wc * 4 + n) ^ x7) * 32) + (fr & 3) * 8);
    const unsigned ldsa = (unsigned)(__UINTPTR_TYPE__)lds + (unsigned)(wid * 2048), ldsb = (unsigned)(__UINTPTR_TYPE__)lds + 16384u + (unsigned)(wid * 2048);
    const unsigned ldb2 = P.ldbB * 2u;
    unsigned boff[2];
#pragma unroll
    for (int j = 0; j < 2; ++j) { const int sl = 4 * wid + 2 * j + (lane >> 5), u = lane & 31, c = (u >> 1) ^ (sl & 7), n = c * 16 + (u & 1) * 8;
        const int k = 8 * ((sl >> 2) & 3) + 4 * (sl >> 4) + (sl & 3); boff[j] = (unsigned)k * ldb2 + (unsigned)n * 2u; }
    TD cur, nxt;
    if (!P.get(0, cur)) return;
    int nt = P.nt * 2; asm volatile("" : "+s"(nt));
    f32x4 acc[8][4];
    u32x4 ra_c = make_rsrc(cur.A), ra_n = ra_c, rb_c = make_rsrc(cur.B), rb_n = rb_c;
#define H_DMA(LDSADDR, RS, VOFF, SOFF) do { unsigned keep_; \
        asm volatile("s_mov_b32 %0, m0\n\ts_mov_b32 m0, %3\n\ts_nop 0\n\tbuffer_load_dwordx4 %1, %2, %4 offen lds\n\ts_mov_b32 m0, %0" \
            : "=&s"(keep_) : "v"(VOFF), "s"(RS), "s"(LDSADDR), "s"(SOFF) : "memory"); } while (0)
#define H_STAGE(sb_, RA, AO0, AO1, RB, st) do { \
        if (!(ABL & 2)) { H_DMA(ldsa + (sb_), RA, AO0, (unsigned)((st) * 64)); H_DMA(ldsa + (sb_) + 1024u, RA, AO1, (unsigned)((st) * 64)); } \
        if (!(ABL & 1)) { H_DMA(ldsb + (sb_), RB, boff[0], (unsigned)(st) * 32u * ldb2); H_DMA(ldsb + (sb_) + 1024u, RB, boff[1], (unsigned)(st) * 32u * ldb2); } } while (0)
#define H_READ(sb_) do { if (!(ABL & 16)) { \
        _Pragma("unroll") for (int n = 0; n < 4; ++n) { \
            const s16x4 lo = __builtin_amdgcn_ds_read_tr16_b64_v4i16((LAS s16x4*)(lds + (sb_) + b_r[n])); \
            const s16x4 hi = __builtin_amdgcn_ds_read_tr16_b64_v4i16((LAS s16x4*)(lds + (sb_) + b_r[n] + 8192)); \
            Bf[n] = (bf16x8){lo[0], lo[1], lo[2], lo[3], hi[0], hi[1], hi[2], hi[3]}; } \
        _Pragma("unroll") for (int m = 0; m < 8; ++m) At[m] = *(const LAS bf16x8*)(lds + (sb_) + a_r + m * 1024); } } while (0)
#define H_MMA() do { if (!(ABL & 16)) { __builtin_amdgcn_s_setprio(1); \
        if (!(ABL & 4)) { _Pragma("unroll") for (int m = 0; m < 8; ++m) _Pragma("unroll") for (int n = 0; n < 4; ++n) \
            acc[m][n] = __builtin_amdgcn_mfma_f32_16x16x32_bf16(Bf[n], At[m], acc[m][n], 0, 0, 0); } \
        else { _Pragma("unroll") for (int m = 0; m < 8; ++m) asm volatile("" :: "v"(At[m])); _Pragma("unroll") for (int n = 0; n < 4; ++n) asm volatile("" :: "v"(Bf[n])); } \
        __builtin_amdgcn_s_setprio(0); } } while (0)
#define H_MMA0() do { if (!(ABL & 16)) { __builtin_amdgcn_s_setprio(1); \
        _Pragma("unroll") for (int m = 0; m < 8; ++m) _Pragma("unroll") for (int n = 0; n < 4; ++n) \
            acc[m][n] = __builtin_amdgcn_mfma_f32_16x16x32_bf16(Bf[n], At[m], (f32x4){0.f, 0.f, 0.f, 0.f}, 0, 0, 0); \
        __builtin_amdgcn_s_setprio(0); } } while (0)
#define H_BAR() do { asm volatile("s_waitcnt lgkmcnt(0)" ::: "memory"); __builtin_amdgcn_s_barrier(); __builtin_amdgcn_sched_barrier(0); } while (0)
    bf16x8 At[8], Bf[4];
    { unsigned s0 = 0, s1 = STEP_B, s2 = 2 * STEP_B; asm volatile("" : "+s"(s0), "+s"(s1), "+s"(s2));
      H_STAGE(s0, ra_c, cur.aoff[0], cur.aoff[1], rb_c, 0); H_STAGE(s1, ra_c, cur.aoff[0], cur.aoff[1], rb_c, 1); H_STAGE(s2, ra_c, cur.aoff[0], cur.aoff[1], rb_c, 2); }
    asm volatile("s_waitcnt vmcnt(8)" ::: "memory");
    H_BAR();
    if (wr == 1) H_BAR();
    unsigned g = 0;
    for (int ti = 0;; ++ti) {
        const bool hasn = P.get(ti + 1, nxt);
        if (hasn) { ra_n = make_rsrc(nxt.A); rb_n = make_rsrc(nxt.B); }
        const unsigned bias_lds = BIAS_OFF + (unsigned)(ti & 1) * 1024u, list_lds = BIAS_OFF + 2048u + (unsigned)(ti & 1) * 1024u;
        if (P.has_bias && wid == 0) { const u32x4 rbias = make_rsrc(P.bias); H_DMA((unsigned)(__UINTPTR_TYPE__)lds + bias_lds, rbias, P.bias_voff(cur), 0u); }
        if (P.has_list && hasn && wid == 1) { const u32x4 rl = make_rsrc(P.listp); H_DMA((unsigned)(__UINTPTR_TYPE__)lds + list_lds, rl, P.list_voff(nxt), 0u); }
        for (int t = 0; t < nt; ++t, ++g) {
            unsigned sc = (g & 3u) * STEP_B, sn = ((g + 3u) & 3u) * STEP_B; asm volatile("" : "+s"(sc), "+s"(sn));
            const bool c3 = t + 3 < nt, i3 = c3 || hasn, i2 = (t + 2 < nt) || hasn;
            if (P.has_list && hasn && t == nt - 3) P.late(nxt, (const LAS int*)(lds + list_lds));
            if (c3) { H_STAGE(sn, ra_c, cur.aoff[0], cur.aoff[1], rb_c, (unsigned)(t + 3)); }
            else if (hasn) { u32x4 ra = ra_n, rb = rb_n;
#pragma unroll
                for (int q = 0; q < 4; ++q) { ra[q] = __builtin_amdgcn_readfirstlane(ra[q]); rb[q] = __builtin_amdgcn_readfirstlane(rb[q]); }
                H_STAGE(sn, ra, nxt.aoff[0], nxt.aoff[1], rb, (unsigned)__builtin_amdgcn_readfirstlane(t + 3 - nt)); }
            H_READ(sc);
            if (i3) asm volatile("s_waitcnt vmcnt(8)" ::: "memory");
            else if (i2) asm volatile("s_waitcnt vmcnt(4)" ::: "memory");
            else asm volatile("s_waitcnt vmcnt(0)" ::: "memory");
            H_BAR();
            if (t == 0) H_MMA0(); else H_MMA();
            H_BAR();
        }
        if (wr == 0) H_BAR();
        if (!(ABL & 8)) P.epi(acc, cur, (const LAS float*)(lds + bias_lds)); else { _Pragma("unroll") for (int m = 0; m < 8; ++m) _Pragma("unroll") for (int n = 0; n < 4; ++n) asm volatile("" :: "v"(acc[m][n])); }
        if (!hasn) break;
        cur = nxt; ra_c = ra_n; rb_c = rb_n;
        if (wr == 1) H_BAR();
    }
#undef H_DMA
#undef H_STAGE
#undef H_READ
#undef H_MMA
#undef H_MMA0
#undef H_BAR
}

struct XOrder {
    int c1, step, cur;
    __device__ __forceinline__ void init(int T, int G, int bid) {
        if ((G & 7) == 0) { const int x = bid & 7; cur = (int)(((long)x * T) >> 3) + (bid >> 3); c1 = (int)(((long)(x + 1) * T) >> 3); step = G >> 3; }
        else { cur = bid; c1 = T; step = G; }
    }
    __device__ __forceinline__ bool next(int& L) { if (cur >= c1) return false; L = cur; cur += step; return true; }
};
__device__ __forceinline__ void dense_tile(int L, int nM, int nN, int& pm, int& pn) { const int per = 8 * nN, g = L / per, w = L - g * per, fm = g * 8, gs = (nM - fm) < 8 ? (nM - fm) : 8; pn = w / gs; pm = fm + w - pn * gs; }

struct Frame { LAS unsigned char* lds; int tid, lane, wid, bid, G; unsigned char* ws; };
__device__ __forceinline__ const void* ldp(const Frame& F, int off) {
    const u32x2 v = *(const volatile LAS u32x2*)(F.lds + PARAM_OFF + off);
    const unsigned lo = __builtin_amdgcn_readfirstlane(v.x), hi = __builtin_amdgcn_readfirstlane(v.y);
    return (const void*)(((unsigned long long)hi << 32) | lo);
}
#define PP(f) ((const float*)ldp(F, (int)__builtin_offsetof(Params, f)))
#define F_mod ((float*)(F.ws + WS_MOD))
#define F_M1 ((bf16_t*)(F.ws + WS_M1))
#define F_M2 ((bf16_t*)(F.ws + WS_M2))
#define F_ROPE ((f32x2*)(F.ws + WS_ROPE))
#define F_TW ((f32x2*)(F.ws + WS_TW))
#define F_WF ((float*)(F.ws + WS_WF))
#define F_TOPW ((float*)(F.ws + WS_TOPW))
#define F_POS ((int*)(F.ws + WS_POS))
#define F_LIST ((int*)(F.ws + WS_LIST))
#define F_H ((bf16_t*)(F.ws + WS_H))
#define F_MIX ((bf16_t*)(F.ws + WS_MIX))
#define F_XS ((float*)(F.ws + WS_XS))
#define F_PROJ ((bf16_t*)(F.ws + WS_PROJ))
#define F_Z ((float*)(F.ws + WS_Z))
#define F_A1 ((float*)(F.ws + WS_A1))
#define F_ACT ((bf16_t*)(F.ws + WS_ACT))
#define F_Y ((bf16_t*)(F.ws + WS_Y))
#define F_cnt ((unsigned*)(F.ws + WS_CTL) + CW_CNT)

__device__ __forceinline__ const float* modp(const Frame& F, int l, int r, int which) { return F_mod + ((size_t)(l * 5 + r)) * 6144 + which * 1024; }
__device__ __forceinline__ int mod_row(int row) { return row < NMAIN ? (row >> 12) : 4; }

__device__ __forceinline__ float row_rstd(const f32x4 (&v)[4]) {
    float s = 0.f;
#pragma unroll
    for (int j = 0; j < 4; ++j) s += (v[j][0] * v[j][0] + v[j][1] * v[j][1]) + (v[j][2] * v[j][2] + v[j][3] * v[j][3]);
    return __builtin_amdgcn_rsqf(wave_sum(s) * (1.f / D) + NORM_EPS);
}
__device__ __forceinline__ void norm_mod_store(const f32x4 (&v)[4], float rstd, const float* gam, const float* sc, const float* sh, bf16_t* dst, int lane, f32x4 (*keep)[4] = nullptr) {
#pragma unroll
    for (int j = 0; j < 4; ++j) {
        const int c = 4 * lane + 256 * j;
        const f32x4 g = *(const f32x4*)(gam + c), s1 = *(const f32x4*)(sc + c), s0 = *(const f32x4*)(sh + c);
        f32x4 h;
#pragma unroll
        for (int i = 0; i < 4; ++i) h[i] = v[j][i] * rstd * g[i] * (1.f + s1[i]) + s0[i];
        u32x2 w; w.x = pk2(h[0], h[1]); w.y = pk2(h[2], h[3]);
        *(u32x2*)(dst + c) = w;
        if (keep) (*keep)[j] = h;
    }
}

__device__ __forceinline__ void phase_prep(Frame& F) {
    LAS float* sil = (LAS float*)F.lds;
    LAS float* red = (LAS float*)(F.lds + 20480);
    LAS float* ct = (LAS float*)(F.lds + 32768);
    for (int idx = F.tid; idx < 5120; idx += 512) { const int r = idx >> 10, k = idx & 1023; const float v = r < 4 ? PP(c)[r * 1024 + k] : PP(c_ctx)[k]; sil[idx] = v / (1.f + __expf(-v)); }
    if (F.tid < 128) ct[F.tid] = cospif((float)F.tid / 64.f);
    __syncthreads();
    constexpr int N_ADA = 192, N_CONST = 8, N_FOLD = 256, N_CVT = 368;
    for (int it = F.bid; it < N_ADA + N_CONST + N_FOLD + N_CVT; it += F.G) {
        if (it < N_ADA) {
            const int l = it / 96, j0 = (it % 96) * 64, col = j0 + F.lane;
            const float* w = PP(ada_w) + ((size_t)l * 1024 + F.wid * 128) * 6144 + col;
            float a[5] = {0.f, 0.f, 0.f, 0.f, 0.f};
            for (int k0 = 0; k0 < 128; k0 += 32) {
                float wv[32];
#pragma unroll
                for (int u = 0; u < 32; ++u) wv[u] = w[(size_t)(k0 + u) * 6144];
#pragma unroll
                for (int u = 0; u < 32; ++u)
#pragma unroll
                    for (int r = 0; r < 5; ++r) a[r] += sil[r * 1024 + F.wid * 128 + k0 + u] * wv[u];
            }
#pragma unroll
            for (int r = 0; r < 5; ++r) red[(F.wid * 5 + r) * 64 + F.lane] = a[r];
            __syncthreads();
            if (F.tid < 320) { const int r = F.tid >> 6, ln = F.tid & 63; float s = 0.f;
#pragma unroll
                for (int w8 = 0; w8 < 8; ++w8) s += red[(w8 * 5 + r) * 64 + ln];
                F_mod[(size_t)(l * 5 + r) * 6144 + j0 + ln] = s + PP(ada_b)[l * 6144 + j0 + ln]; }
            __syncthreads();
        } else if (it < N_ADA + N_CONST) {
            const int gt = (it - N_ADA) * 512 + F.tid;
            for (int e = gt; e < 32768; e += 4096) {
                const int row = e >> 7, kk = e & 127;
                float v1 = 0.f, v2 = 0.f;
                if (row < 128) { const int ro = row >> 6, k1 = row & 63, n1 = kk >> 1, ri = kk & 1; const float ph = (float)((n1 * k1) & 63) / 32.f; const float cs = cospif(ph), sn = sinpif(ph);
                    v1 = (ro == ri) ? cs : (ro == 0 ? sn : -sn); }
                if (row < 64) { const int ro = kk >> 6, n2 = kk & 63; const float ph = (float)((row * n2) & 63) / 32.f; v2 = ro == 0 ? cospif(ph) : sinpif(ph); }
                F_M1[e] = (bf16_t)(pk2(v1, 0.f) & 0xffffu); F_M2[e] = (bf16_t)(pk2(v2, 0.f) & 0xffffu);
            }
            if (gt < 1024) { const int pos = gt >> 4, f = gt & 15; const double ang = (double)pos * pow(10000.0, -(double)f / 16.0); F_ROPE[gt] = (f32x2){(float)cos(ang), (float)sin(ang)}; }
            { const float ph = (float)gt / 2048.f; F_TW[gt] = (f32x2){cospif(ph), sinpif(ph)}; }
        } else if (it >= N_ADA + N_CONST + N_FOLD) {
            int ci = it - (N_ADA + N_CONST + N_FOLD); const float* src; bf16_t* dst; int sld, dld, ncol;
            if (ci < 144) { src = PP(even_w_in); dst = (bf16_t*)(F.ws + WB_EIN); sld = EVEN_IN; dld = EVEN_IN; ncol = EVEN_IN; }
            else if (ci < 208) { ci -= 144; src = PP(even_w_out); dst = (bf16_t*)(F.ws + WB_EOUT); sld = D; dld = D; ncol = D; }
            else if (ci < 304) { ci -= 208; src = PP(odd_w_in); dst = (bf16_t*)(F.ws + WB_OIN); sld = 2048; dld = 2560; ncol = 1536; }
            else { ci -= 304; src = PP(odd_w_out); dst = (bf16_t*)(F.ws + WB_OOUT); sld = D; dld = D; ncol = D; }
            const int q4 = ncol >> 2;
#pragma unroll
            for (int u = 0; u < 8; ++u) { const int gidx = ci * 4096 + u * 512 + F.tid, row = gidx / q4, c4 = (gidx - row * q4) * 4;
                const f32x4 v = *(const f32x4*)(src + (size_t)row * sld + c4); u32x2 w; w.x = pk2(v[0], v[1]); w.y = pk2(v[2], v[3]); *(u32x2*)(dst + (size_t)row * dld + c4) = w; }
        } else {
            const int fi = it - N_ADA - N_CONST, rc = fi >> 2, g = fi & 3, half = F.tid >> 8, j = F.tid & 255, jj = j & 127;
            for (int i2 = 0; i2 < 8; ++i2) {
                const int row = rc * 16 + i2 * 2 + half;
                const float* wr_ = PP(odd_w_in) + (size_t)row * 2048 + 1536 + g * 128;
                float s = 0.f;
                if (j < 128) { for (int cc = 0; cc < 128; ++cc) s += wr_[cc] * ct[(cc * jj) & 127]; }
                else { for (int cc = 0; cc < 128; ++cc) s -= wr_[cc] * ct[((cc * jj) - 32) & 127]; }
                ((bf16_t*)(F.ws + WB_OIN))[(size_t)row * 2560 + 1536 + g * 256 + j] = (bf16_t)(pk2(s, 0.f) & 0xffffu);
            }
        }
    }
}

__device__ __forceinline__ void phase_norm1_l0(Frame& F) {
    const int gw = F.bid * 8 + F.wid, NGW = F.G * 8;
    for (int row = gw; row < NTOK; row += NGW) {
        const float* src = row < NMAIN ? PP(x) + (size_t)row * D : PP(ctx) + (size_t)(row - NMAIN) * D;
        f32x4 v[4];
#pragma unroll
        for (int j = 0; j < 4; ++j) v[j] = *(const f32x4*)(src + 4 * F.lane + 256 * j);
        const float rstd = row_rstd(v); const int r = mod_row(row);
        norm_mod_store(v, rstd, PP(norm_mix), modp(F, 0, r, 1), modp(F, 0, r, 0), F_H + (size_t)row * D, F.lane);
    }
}

#define EPI_GEOM const int wid = this->wid, lane = this->lane, wr = wid >> 2, wc = wid & 3, fr = lane & 15, fq = lane >> 4; (void)wr; (void)wc; (void)fr; (void)fq
struct PolBase { unsigned char* ws; LAS unsigned char* lds; int wid, lane, nt; unsigned lcolb, woff, ldbB; XOrder xo; int aC, aR0, aCb, aR0b; bool bfm;
    __device__ __forceinline__ void base_init(Frame& F, int nt_, int T) { ws = F.ws; lds = F.lds; wid = F.wid; lane = F.lane; nt = nt_; lcolb = 16u * (unsigned)F.lane; woff = 8u * (unsigned)F.lane;
        xo.init(T, F.G, F.bid); aC = a_piece_col(F.wid, F.lane); aR0 = a_piece_row0(F.wid, F.lane); bfm = true;
        { const int sbb = F.lane * 16, swz = sbb ^ (((sbb >> 9) & 1) << 5); aR0b = F.wid * 32 + (swz >> 6); aCb = (swz & 63) >> 1; } }
    bool has_bias = false; const float* bias = nullptr;
    bool has_list = false; const int* listp = nullptr;
    __device__ __forceinline__ unsigned list_voff(const TD&) const { return 0u; }
    __device__ __forceinline__ void late(TD&, const LAS int*) const {}
    __device__ __forceinline__ unsigned bias_voff(const TD&) const { return 0u; }
    __device__ __forceinline__ bool tileL(int i, int& L) const { L = xo.cur + i * xo.step; return L < xo.c1; }
    __device__ __forceinline__ int prow(int i) const { return bfm ? aR0b + 16 * (i & 1) : aR0 + 64 * i; }
    __device__ __forceinline__ int pcol() const { return bfm ? aCb : aC; }
    __device__ __forceinline__ void dense_aoff(TD& td, int row0, int pitch) const {
#pragma unroll
        for (int i = 0; i < 4; ++i) td.aoff[i] = (unsigned)(((row0 + prow(i)) * pitch + pcol()) * 2); }
};

struct PolInproj0 : PolBase {
    const float* W; Frame* Fp;
    __device__ __forceinline__ bool get(int i, TD& td) const { int L; if (!tileL(i, L)) return false; int pm, pn; dense_tile(L, NTOK / 256, EVEN_IN / 256, pm, pn);
        td.A = (const bf16_t*)(ws + WS_H); dense_aoff(td, pm * 256, D); td.B = (const bf16_t*)(ws + WB_EIN) + pn * 256; td.i0 = pm; td.i1 = pn; return true; }
    __device__ __forceinline__ void epi(f32x4 (&acc)[8][4], const TD& td, const LAS float* bl) const { (void)bl; EPI_GEOM; const int pm = td.i0, pn = td.i1;
        const int colb = pn * 256 + wc * 64; const bool rope = (colb < 640) && (pm < NMAIN / 256);
        const LAS f32x2* ROPE = (const LAS f32x2*)(lds + ROPE_LDS); bf16_t* PROJ = (bf16_t*)(ws + WS_PROJ);
#pragma unroll
        for (int m = 0; m < 8; ++m) { const int row = pm * 256 + wr * 128 + m * 16 + fr;
            if (rope) { const int tt = row & (SEQ - 1), gr = tt >> 6, gc = tt & 63;
#pragma unroll
                for (int n = 0; n < 2; ++n) { const int pos = n == 0 ? gr : gc;
#pragma unroll
                    for (int j = 0; j < 4; ++j) { const f32x2 cs = ROPE[pos * 16 + 4 * fq + j]; const float x1 = acc[m][n][j], x2 = acc[m][n + 2][j];
                        acc[m][n][j] = x1 * cs.x - x2 * cs.y; acc[m][n + 2][j] = x2 * cs.x + x1 * cs.y; } } }
#pragma unroll
            for (int n = 0; n < 4; ++n) { u32x2 w; w.x = pk2(acc[m][n][0], acc[m][n][1]); w.y = pk2(acc[m][n][2], acc[m][n][3]);
                *(u32x2*)(PROJ + (size_t)row * EVEN_IN + colb + n * 16 + 4 * fq) = w; } } }
};
__device__ __forceinline__ void phase_inproj_l0(Frame& F) {
    for (int i = F.tid; i < 1024; i += 512) ((LAS f32x2*)(F.lds + ROPE_LDS))[i] = F_ROPE[i];
    __syncthreads();
    PolInproj0 P; P.base_init(F, D / 64, (NTOK / 256) * (EVEN_IN / 256)); P.ldbB = EVEN_IN;
    gemm_stream_bf(F.lds, P, F.wid, F.lane);
}

struct PolOutproj : PolBase {
    const float *W, *x, *ctx; int layer, nM;
    __device__ __forceinline__ bool get(int i, TD& td) const { int L; if (!tileL(i, L)) return false; int pm, pn; dense_tile(L, nM, 4, pm, pn);
        td.A = (const bf16_t*)(ws + WS_MIX); dense_aoff(td, pm * 256, D); td.B = (const bf16_t*)(ws + (layer == 0 ? WB_EOUT : WB_OOUT)) + pn * 256; td.i0 = pm; td.i1 = pn; return true; }
    __device__ __forceinline__ void epi(f32x4 (&acc)[8][4], const TD& td, const LAS float* bl) const { (void)bl; EPI_GEOM; const int pm = td.i0, pn = td.i1;
        const int colb = pn * 256 + wc * 64; float* XS = (float*)(ws + WS_XS); const float* mod = (const float*)(ws + WS_MOD);
#pragma unroll
        for (int m = 0; m < 8; ++m) { const int row = pm * 256 + wr * 128 + m * 16 + fr; const int r = mod_row(row);
            const float* xin = layer == 0 ? (row < NMAIN ? x + (size_t)row * D : ctx + (size_t)(row - NMAIN) * D) : XS + (size_t)row * D;
            const float* g1 = mod + ((size_t)(layer * 5 + r)) * 6144 + 2 * 1024;
#pragma unroll
            for (int n = 0; n < 4; ++n) { const int c = colb + n * 16 + 4 * fq; const f32x4 xv = *(const f32x4*)(xin + c), gv = *(const f32x4*)(g1 + c);
                f32x4 o;
#pragma unroll
                for (int j = 0; j < 4; ++j) o[j] = xv[j] + gv[j] * acc[m][n][j];
                *(f32x4*)(XS + (size_t)row * D + c) = o; } } }
};
__device__ __forceinline__ void phase_outproj(Frame& F, const int layer) {
    PolOutproj P; P.layer = layer; P.nM = (layer == 0 ? NTOK : NMAIN) / 256; P.base_init(F, D / 64, P.nM * 4);
    P.ldbB = D; P.x = PP(x); P.ctx = PP(ctx);
    gemm_stream_bf(F.lds, P, F.wid, F.lane);
}

constexpr int QT = 2;
struct AttnSt { f32x4 o[4][QT]; float m[QT], l[QT]; };
#define V_ROWB 160
__device__ __forceinline__ void v_stage(LAS unsigned char* vl, const bf16_t* vsrc, int ld, int lane) {
    i32x4 t[4];
    asm volatile("" ::: "memory");
#pragma unroll
    for (int i = 0; i < 4; ++i) t[i] = *(const i32x4*)(vsrc + (size_t)((lane >> 3) + 8 * i) * ld + (lane & 7) * 8);
#pragma unroll
    for (int i = 0; i < 4; ++i) *(LAS i32x4*)(vl + ((lane >> 3) + 8 * i) * V_ROWB + (lane & 7) * 16) = t[i];
    asm volatile("s_waitcnt lgkmcnt(0)" ::: "memory");
}
#define ATTN_STEP(ksrc, kld, vsrc, vld, SCALE, BIAS, SKIP) do { \
    bf16x8 kf[2][2]; \
    _Pragma("unroll") for (int kt = 0; kt < 2; ++kt) _Pragma("unroll") for (int ks = 0; ks < 2; ++ks) \
        kf[kt][ks] = *(const bf16x8*)((ksrc) + (size_t)(kt * 16 + fr) * (kld) + ks * 32 + 8 * fq); \
    v_stage(vl, (vsrc), (vld), lane); \
    bf16x8 vf[4]; \
    _Pragma("unroll") for (int dt = 0; dt < 4; ++dt) { \
        const s16x4 lo = __builtin_amdgcn_ds_read_tr16_b64_v4i16((LAS s16x4*)(vl + (4 * fq + (fr >> 2)) * V_ROWB + (dt * 16 + (fr & 3) * 4) * 2)); \
        const s16x4 hi = __builtin_amdgcn_ds_read_tr16_b64_v4i16((LAS s16x4*)(vl + (16 + 4 * fq + (fr >> 2)) * V_ROWB + (dt * 16 + (fr & 3) * 4) * 2)); \
        vf[dt] = (bf16x8){lo[0], lo[1], lo[2], lo[3], hi[0], hi[1], hi[2], hi[3]}; } \
    _Pragma("unroll") for (int qt = 0; qt < QT; ++qt) { if (SKIP(qt)) continue;        \
        f32x4 s[2]; \
        _Pragma("unroll") for (int kt = 0; kt < 2; ++kt) { s[kt] = (f32x4){0.f, 0.f, 0.f, 0.f}; \
            _Pragma("unroll") for (int ks = 0; ks < 2; ++ks) s[kt] = __builtin_amdgcn_mfma_f32_16x16x32_bf16(kf[kt][ks], qf[qt][ks], s[kt], 0, 0, 0); } \
        float mx = -INFINITY; \
        _Pragma("unroll") for (int kt = 0; kt < 2; ++kt) _Pragma("unroll") for (int j = 0; j < 4; ++j) { const float tv = s[kt][j] * (SCALE) + BIAS(qt, kt, j); s[kt][j] = tv; mx = fmaxf(mx, tv); } \
        mx = fmaxf(mx, __shfl_xor(mx, 16)); mx = fmaxf(mx, __shfl_xor(mx, 32)); \
        const float mn = fmaxf(st.m[qt], mx), al = fexp2(st.m[qt] - mn); st.m[qt] = mn; \
        float ps = 0.f; \
        _Pragma("unroll") for (int kt = 0; kt < 2; ++kt) _Pragma("unroll") for (int j = 0; j < 4; ++j) { const float pv = fexp2(s[kt][j] - mn); s[kt][j] = pv; ps += pv; } \
        st.l[qt] = st.l[qt] * al + ps; \
        const unsigned w0 = pk2(s[0][0], s[0][1]), w1 = pk2(s[0][2], s[0][3]), w2 = pk2(s[1][0], s[1][1]), w3 = pk2(s[1][2], s[1][3]); \
        const bf16x8 pf = __builtin_bit_cast(bf16x8, ((u32x4){w0, w1, w2, w3})); \
        _Pragma("unroll") for (int dt = 0; dt < 4; ++dt) st.o[dt][qt] = __builtin_amdgcn_mfma_f32_16x16x32_bf16(vf[dt], pf, st.o[dt][qt] * al, 0, 0, 0); } \
    } while (0)

__device__ __forceinline__ void attn_store(AttnSt& st, bf16_t* dst  , int dld, int fr, int fq) {
#pragma unroll
    for (int qt = 0; qt < QT; ++qt) {
        float l = st.l[qt]; l += __shfl_xor(l, 16); l += __shfl_xor(l, 32);
        const float inv = 1.f / l;
#pragma unroll
        for (int dt = 0; dt < 4; ++dt) { const f32x4 o = st.o[dt][qt] * inv; u32x2 w; w.x = pk2(o[0], o[1]); w.y = pk2(o[2], o[3]);
            *(u32x2*)(dst + (size_t)(qt * 16 + fr) * dld + dt * 16 + 4 * fq) = w; }
    }
}

__device__ __forceinline__ void phase_attn_l0(Frame& F) {
    const int wid = F.wid, lane = F.lane, fr = lane & 15, fq = lane >> 4;
    LAS unsigned char* vl = F.lds + wid * 8192;
    constexpr int NPASS = 4 / QT, N_WIN = 256 * NPASS, N_CTXA = 16 * NPASS, N_CONV = NTOK / 64;
    const float SC = 0.125f * LOG2E;
    for (int it = F.bid; it < N_WIN + N_CTXA + N_CONV; it += F.G) {
        if (it < N_WIN + N_CTXA) {
            const bool isctx = it >= N_WIN;
            int b, kvh, qb, qh;
            if (!isctx) { const int c = it / NPASS; qh = it - c * NPASS; b = c >> 6; kvh = (c >> 5) & 1; qb = c & 31; } else { const int c2 = it - N_WIN, c = c2 / NPASS; qh = c2 - c * NPASS; b = c >> 2; kvh = (c >> 1) & 1; qb = c & 1; }
            const int g = wid >> 1, h = kvh * 4 + g;
            {
            const int qq0 = (wid & 1) * 64 + qh * (16 * QT);
            const int qrow0 = (isctx ? NMAIN + b * CTXL : b * SEQ) + qb * 128 + qq0;
            bf16x8 qf[QT][2];
#pragma unroll
            for (int qt = 0; qt < QT; ++qt)
#pragma unroll
                for (int ks = 0; ks < 2; ++ks) qf[qt][ks] = *(const bf16x8*)(F_PROJ + (size_t)(qrow0 + qt * 16 + fr) * EVEN_IN + h * 64 + ks * 32 + 8 * fq);
            AttnSt st;
            const float sink = PP(even_sink)[h] * LOG2E;
#pragma unroll
            for (int qt = 0; qt < QT; ++qt) { st.m[qt] = sink; st.l[qt] = (fq == 0) ? 1.f : 0.f;
#pragma unroll
                for (int dt = 0; dt < 4; ++dt) st.o[dt][qt] = (f32x4){0.f, 0.f, 0.f, 0.f}; }
            const int kcol = 512 + kvh * 64, vcol = 640 + kvh * 64;
            for (int ch = isctx ? 3 : 0; ch < 5; ++ch) {
                int krow0;
                if (ch < 3) { const int kb = qb - 1 + ch; if (kb < 0 || kb >= SEQ / 128) continue; krow0 = b * SEQ + kb * 128; } else krow0 = NMAIN + b * CTXL + (ch - 3) * 128;
                for (int s32 = 0; s32 < 4; ++s32) {
                    const bf16_t* kp = F_PROJ + (size_t)(krow0 + s32 * 32) * EVEN_IN + kcol;
                    const bf16_t* vp = F_PROJ + (size_t)(krow0 + s32 * 32) * EVEN_IN + vcol;
                    if (ch == 0) {
#define SKIP_NONE(qt) false
#define SKIP_PREV(qt) ((s32 * 32 + 31) < (qq0 + qt * 16))
#define SKIP_NEXT(qt) ((s32 * 32) > (qq0 + qt * 16 + 15))
#define BIAS_PREV(qt, kt, j) ((s32 * 32 + kt * 16 + 4 * fq + j) >= (qq0 + qt * 16 + fr) ? 0.f : -INFINITY)
                        ATTN_STEP(kp, EVEN_IN, vp, EVEN_IN, SC, BIAS_PREV, SKIP_PREV);
                    } else if (ch == 2) {
#define BIAS_NEXT(qt, kt, j) ((s32 * 32 + kt * 16 + 4 * fq + j) <= (qq0 + qt * 16 + fr) ? 0.f : -INFINITY)
                        ATTN_STEP(kp, EVEN_IN, vp, EVEN_IN, SC, BIAS_NEXT, SKIP_NEXT);
                    } else {
#define BIAS_NONE(qt, kt, j) 0.f
                        ATTN_STEP(kp, EVEN_IN, vp, EVEN_IN, SC, BIAS_NONE, SKIP_NONE);
                    }
                }
            }
            attn_store(st, F_MIX + (size_t)qrow0 * D + h * 64, D, fr, fq);
            }
        } else {
            const int ci = it - N_WIN - N_CTXA, c4 = (F.tid & 127) * 4, r0 = ci * 64 + (F.tid >> 7) * 16;
            const f32x4 w0 = *(const f32x4*)(PP(even_conv_w) + c4), w1 = *(const f32x4*)(PP(even_conv_w) + 512 + c4), w2 = *(const f32x4*)(PP(even_conv_w) + 1024 + c4);
#define LOADZ(dst, row_) do { const u32x2 gc_ = *(const u32x2*)(F_PROJ + (size_t)(row_) * EVEN_IN + 1280 + c4), uu_ = *(const u32x2*)(F_PROJ + (size_t)(row_) * EVEN_IN + 1792 + c4); \
                dst = (f32x4){bflo(gc_.x) * bflo(uu_.x), bfhi(gc_.x) * bfhi(uu_.x), bflo(gc_.y) * bflo(uu_.y), bfhi(gc_.y) * bfhi(uu_.y)}; } while (0)
            const int seqmask = r0 < NMAIN ? (SEQ - 1) : (CTXL - 1);
            u32x2 gcv[18], uuv[18], gbv[16];
#pragma unroll
            for (int i = 0; i < 18; ++i) { const int row = r0 - 1 + i; const bool ok = (i == 0) ? ((r0 & seqmask) != 0) : (i == 17) ? (((r0 + 15) & seqmask) != seqmask) : true;
                const int rr = ok ? row : r0;
                gcv[i] = *(const u32x2*)(F_PROJ + (size_t)rr * EVEN_IN + 1280 + c4); uuv[i] = *(const u32x2*)(F_PROJ + (size_t)rr * EVEN_IN + 1792 + c4);
                if (!ok) { gcv[i] = (u32x2){0u, 0u}; } }
#pragma unroll
            for (int i = 0; i < 16; ++i) gbv[i] = *(const u32x2*)(F_PROJ + (size_t)(r0 + i) * EVEN_IN + 768 + c4);
            __builtin_amdgcn_sched_barrier(0);
#define ZOF(i_) ((f32x4){bflo(gcv[i_].x) * bflo(uuv[i_].x), bfhi(gcv[i_].x) * bfhi(uuv[i_].x), bflo(gcv[i_].y) * bflo(uuv[i_].y), bfhi(gcv[i_].y) * bfhi(uuv[i_].y)})
            f32x4 zp = ZOF(0), zc = ZOF(1);
#pragma unroll
            for (int i = 0; i < 16; ++i) {
                const int row = r0 + i;
                const f32x4 zn = ZOF(i + 2);
                const u32x2 gb = gbv[i];
                const f32x4 y = zp * w0 + zc * w1 + zn * w2;
                u32x2 w; w.x = pk2(bflo(gb.x) * y[0], bfhi(gb.x) * y[1]); w.y = pk2(bflo(gb.y) * y[2], bfhi(gb.y) * y[3]);
                *(u32x2*)(F_MIX + (size_t)row * D + 512 + c4) = w;
                zp = zc; zc = zn;
            }
#undef ZOF
        }
    }
}

constexpr int RW_LD = 1028;
__device__ __forceinline__ void phase_route(Frame& F, const int layer) {
    const int nrows = layer == 0 ? NTOK : NMAIN;
    LAS float* rwT = (LAS float*)F.lds;
    LAS int* cntL = (LAS int*)(F.lds + 32 * RW_LD * 4);
    LAS int* baseL = cntL + 32;
    LAS int* selE = baseL + 32;
    LAS int* selR = selE + 384;
    const float* rw = PP(router_w) + (size_t)layer * D * NEXP;
    { const f32x4* rsrc4 = (const f32x4*)rw + F.tid; LAS float* wp = rwT + ((4 * F.tid) & 31) * RW_LD + (F.tid >> 3);
      for (int it = 0; it < 4; ++it) {
        f32x4 v[4];
#pragma unroll
        for (int u = 0; u < 4; ++u) v[u] = rsrc4[(it * 4 + u) * 512];
#pragma unroll
        for (int u = 0; u < 4; ++u)
#pragma unroll
            for (int j = 0; j < 4; ++j) wp[it * 256 + u * 64 + j * RW_LD] = v[u][j];
        asm volatile("" ::: "memory"); } }
    if (F.tid < 32) cntL[F.tid] = 0;
    __syncthreads();
    const int lane = F.lane, gw = F.bid * 8 + F.wid, NGW = F.G * 8;
    const float* gam = PP(norm_ffn) + layer * D;
    int slot = F.wid;
    const float* Wd = PP(moe_w_dn) + (size_t)layer * NEXP * DFF * D; bf16_t* pd = (bf16_t*)(F.ws + WS_BC2);
    constexpr int CV_TOTAL = NEXP * 4 * 1024;
    const int cv_q = (CV_TOTAL + NGW - 1) / NGW, cv_end = min((gw + 1) * cv_q, CV_TOTAL); int cv_u = gw * cv_q;
#define CV_LOAD(v_, u0_) do { _Pragma("unroll") for (int u = 0; u < 8; ++u) { const int pr = min((u0_) + u, CV_TOTAL - 1), pnl = pr >> 10, k = pr & 1023, e = pnl >> 2, ct = pnl & 3; \
        v_[u] = *(const f32x4*)(Wd + ((size_t)e * DFF + k) * D + ct * 256 + 4 * lane); } } while (0)
#define CV_STORE(v_, u0_, uend_) do { _Pragma("unroll") for (int u = 0; u < 8; ++u) { const int pr = (u0_) + u; if (pr < (uend_)) { u32x2 w; w.x = pk2(v_[u][0], v_[u][1]); w.y = pk2(v_[u][2], v_[u][3]); \
        *(u32x2*)(pd + (size_t)pr * 256 + 4 * lane) = w; } } } while (0)
    f32x4 vn[4];
    if (gw < nrows) {
#pragma unroll
        for (int j = 0; j < 4; ++j) vn[j] = *(const f32x4*)(F_XS + (size_t)gw * D + 4 * lane + 256 * j); }
    for (int row = gw; row < nrows; row += NGW, slot += 8) {
        f32x4 v[4], h[4], cvv[8];
        const int cv_u0 = cv_u; CV_LOAD(cvv, cv_u0); cv_u += 8;
#pragma unroll
        for (int j = 0; j < 4; ++j) v[j] = vn[j];
        if (row + NGW < nrows) {
#pragma unroll
            for (int j = 0; j < 4; ++j) vn[j] = *(const f32x4*)(F_XS + (size_t)(row + NGW) * D + 4 * lane + 256 * j); }
        const float rstd = row_rstd(v); const int r = mod_row(row);
        norm_mod_store(v, rstd, gam, modp(F, layer, r, 4), modp(F, layer, r, 3), F_H + (size_t)row * D, lane, &h);
        float pe[32];
#pragma unroll
        for (int e = 0; e < 32; ++e) { float s = 0.f;
            f32x2 s2 = (f32x2){0.f, 0.f};
#pragma unroll
            for (int j = 0; j < 4; ++j) { const f32x4 w = *(const LAS f32x4*)(rwT + e * RW_LD + 4 * lane + 256 * j);
                s2 = __builtin_elementwise_fma((f32x2){h[j][0], h[j][1]}, (f32x2){w[0], w[1]}, s2); s2 = __builtin_elementwise_fma((f32x2){h[j][2], h[j][3]}, (f32x2){w[2], w[3]}, s2); }
            s = s2.x + s2.y;
            pe[e] = s; if ((e & 3) == 3) __builtin_amdgcn_sched_barrier(0); }
        float q16[16], q8[8], q4[4], q2[2], q1;
        { const bool hi = lane & 32;
#pragma unroll
          for (int i = 0; i < 16; ++i) { const float snd = hi ? pe[i] : pe[16 + i], mine = hi ? pe[16 + i] : pe[i]; q16[i] = mine + __shfl_xor(snd, 32); } }
        { const bool hi = lane & 16;
#pragma unroll
          for (int i = 0; i < 8; ++i) { const float snd = hi ? q16[i] : q16[8 + i], mine = hi ? q16[8 + i] : q16[i]; q8[i] = mine + __shfl_xor(snd, 16); } }
        { const bool hi = lane & 8;
#pragma unroll
          for (int i = 0; i < 4; ++i) { const float snd = hi ? q8[i] : q8[4 + i], mine = hi ? q8[4 + i] : q8[i]; q4[i] = mine + __shfl_xor(snd, 8); } }
        { const bool hi = lane & 4;
#pragma unroll
          for (int i = 0; i < 2; ++i) { const float snd = hi ? q4[i] : q4[2 + i], mine = hi ? q4[2 + i] : q4[i]; q2[i] = mine + __shfl_xor(snd, 4); } }
        { const bool hi = lane & 2; const float snd = hi ? q2[0] : q2[1], mine = hi ? q2[1] : q2[0]; q1 = mine + __shfl_xor(snd, 2); }
        q1 += __shfl_xor(q1, 1);
        const int myE = (lane >> 1) & 31;
        float val = q1 + PP(router_b)[layer * NEXP + myE];
        float tv[4]; int te[4];
        { int rank = 0; const int vb = __builtin_bit_cast(int, val);
#pragma unroll
          for (int e2 = 0; e2 < 32; ++e2) { const float o = __builtin_bit_cast(float, __builtin_amdgcn_readlane(vb, 2 * e2)); rank += (o > val || (o == val && e2 < myE)) ? 1 : 0; }
#pragma unroll
          for (int k = 0; k < 4; ++k) { const unsigned long long mk = __ballot(rank == k); const int src = __builtin_amdgcn_readfirstlane((int)__builtin_ctzll(mk));
              tv[k] = __builtin_bit_cast(float, __builtin_amdgcn_readlane(vb, src)); te[k] = (src >> 1) & 31; } }
        const float e1 = __expf(tv[1] - tv[0]), e2 = __expf(tv[2] - tv[0]), e3 = __expf(tv[3] - tv[0]), inv = 1.f / (1.f + e1 + e2 + e3);
        if (lane == 0) {
            *(f32x4*)(F_TOPW + (size_t)row * 4) = (f32x4){inv, e1 * inv, e2 * inv, e3 * inv};
#pragma unroll
            for (int k = 0; k < 4; ++k) { selE[slot * 4 + k] = te[k]; selR[slot * 4 + k] = atomicAdd((int*)(cntL + te[k]), 1); }
        }
        CV_STORE(cvv, cv_u0, cv_end);
    }
    for (; cv_u < cv_end; cv_u += 8) { f32x4 cvv[8]; CV_LOAD(cvv, cv_u); CV_STORE(cvv, cv_u, cv_end); }
#undef CV_LOAD
#undef CV_STORE
    __syncthreads();
    if (F.tid < 32) { const int c = cntL[F.tid]; baseL[F.tid] = c ? (int)atomicAdd(F_cnt + layer * 32 + F.tid, (unsigned)c) : 0; }
    __syncthreads();
    if (F.tid < 384) { const int s = F.tid >> 2, k = F.tid & 3; const int row = F.bid * 8 + (s & 7) + (s >> 3) * NGW;
        if (row < nrows) { const int e = selE[F.tid], pos = baseL[e] + selR[F.tid]; F_POS[(size_t)row * 4 + k] = e | (pos << 8); F_LIST[(size_t)e * NTOK + pos] = row; } }
    __syncthreads();
}

struct MoeLds { LAS int *mtp, *roff, *mtq, *nz; };
__device__ __forceinline__ MoeLds moe_lds(Frame& F) { MoeLds L; L.mtp = (LAS int*)(F.lds + 2 * STAGE_B); L.roff = L.mtp + 40; L.mtq = L.roff + 40; L.nz = L.mtq + 40; return L; }
__device__ __forceinline__ void moe_prefix(Frame& F, const int layer, const MoeLds& L) {
    if (F.tid < 64) { const int e = F.lane & 31; const int c = (int)__hip_atomic_load(F_cnt + layer * 32 + e, __ATOMIC_RELAXED, __HIP_MEMORY_SCOPE_AGENT);
        const int mt = (c + 255) >> 8; int a = mt, b = c, q = mt > 0 ? mt - 1 : 0, z = mt > 0 ? 1 : 0;
#pragma unroll
        for (int o = 1; o < 32; o <<= 1) { const int ua = __shfl_up(a, o, 32), ub = __shfl_up(b, o, 32), uq = __shfl_up(q, o, 32), uz = __shfl_up(z, o, 32); if (e >= o) { a += ua; b += ub; q += uq; z += uz; } }
        if (F.lane < 32) { L.mtp[e + 1] = a; L.roff[e + 1] = b; L.mtq[e + 1] = q; if (mt > 0) L.nz[z - 1] = e; if (e == 31) L.nz[32] = z; if (e == 0) { L.mtp[0] = 0; L.roff[0] = 0; L.mtq[0] = 0; } } }
    __syncthreads();
}
struct PolMoe : PolBase {
    const float* W; MoeLds L; int layer, nct, round; size_t bc_off; mutable int ehint = 0;
    __device__ __forceinline__ bool find(int i, int& e, int& ct, int& rbase, int& ro, int& cnt) const { int T; if (!tileL(i, T)) return false;
        if (round == 0) { const int q = T / nct; ct = T - q * nct; e = __builtin_amdgcn_readfirstlane(L.nz[q]); rbase = 0; }
        else { LAS int* pf = round == 1 ? L.mtq : L.mtp; e = ehint; while (pf[e + 1] * nct <= T) ++e;
            ehint = e;
            e = __builtin_amdgcn_readfirstlane(e);
            const int mq = __builtin_amdgcn_readfirstlane(pf[e + 1] - pf[e]), w = T - __builtin_amdgcn_readfirstlane(pf[e]) * nct; ct = w / mq; rbase = ((round == 1 ? 1 : 0) + w - ct * mq) * 256; }
        ro = __builtin_amdgcn_readfirstlane(L.roff[e]); cnt = __builtin_amdgcn_readfirstlane(L.roff[e + 1]) - ro; return true; }
    __device__ __forceinline__ bf16_t* panel(int e, int ct) const { return (bf16_t*)(ws + bc_off) + (size_t)(e * nct + ct) * (1024 * 256); }
};
struct PolMoe1 : PolMoe {
    __device__ __forceinline__ unsigned list_voff(const TD& td) const { return 4u * (unsigned)(td.i0 * NTOK + td.i2 + lane * 4); }
    __device__ __forceinline__ void late(TD& td, const LAS int* ll) const { const int cl = td.i4 - 1 - td.i2;
#pragma unroll
        for (int i2 = 0; i2 < 2; ++i2) { int rl = prow(i2); rl = rl < cl ? rl : cl; td.aoff[i2] = (unsigned)((ll[rl] * D + pcol()) * 2); } }
    __device__ __forceinline__ unsigned bias_voff(const TD& td) const { return 4u * (unsigned)((layer * NEXP + td.i0) * (2 * DFF) + (lane >> 5) * DFF + td.i1 * 128 + (lane & 31) * 4); }
    __device__ __forceinline__ bool get(int i, TD& td) const { int e, ct, rbase, ro, cnt; if (!find(i, e, ct, rbase, ro, cnt)) return false;
        const int* list = (const int*)(ws + WS_LIST) + (size_t)e * NTOK; td.A = (const bf16_t*)(ws + WS_H);
        if (!has_list || i == 0) {
#pragma unroll
            for (int i2 = 0; i2 < 4; ++i2) { int rr = rbase + prow(i2); rr = rr < cnt ? rr : cnt - 1; td.aoff[i2] = (unsigned)((list[rr] * D + pcol()) * 2); } }
        if (round == 0) { td.B = W + ((size_t)(layer * NEXP + e) * D + wid * 8) * (2 * DFF) + ct * 128; td.ldb = 2 * DFF; td.bco = panel(e, ct); } else { td.B = panel(e, ct); td.bco = nullptr; }
        td.i0 = e; td.i1 = ct; td.i2 = rbase; td.i3 = ro; td.i4 = cnt; return true; }
    __device__ __forceinline__ void epi(f32x4 (&acc)[8][4], const TD& td, const LAS float* bl) const { (void)bl; EPI_GEOM; const int e = td.i0, ct = td.i1, rbase = td.i2, ro = td.i3, cnt = td.i4;
        bf16_t* ACT = (bf16_t*)(ws + WS_ACT);
#pragma unroll
        for (int n = 0; n < 2; ++n) { const int gc = ct * 128 + wc * 32 + n * 16 + 4 * fq;
            const int gl = wc * 32 + n * 16 + 4 * fq; const f32x4 bg = bl ? *(const LAS f32x4*)(bl + gl) : *(const f32x4*)(bias + (size_t)(layer * NEXP + e) * (2 * DFF) + gc), bu = bl ? *(const LAS f32x4*)(bl + 128 + gl) : *(const f32x4*)(bias + (size_t)(layer * NEXP + e) * (2 * DFF) + DFF + gc);
#pragma unroll
            for (int m = 0; m < 8; ++m) { const int r = rbase + wr * 128 + m * 16 + fr; float a[4];
#pragma unroll
                for (int j = 0; j < 4; ++j) { const float gg = fminf(acc[m][n][j] + bg[j], 7.f), uu = __builtin_amdgcn_fmed3f(acc[m][n + 2][j] + bu[j], -7.f, 7.f);
                    a[j] = (uu + 1.f) * gg * __builtin_amdgcn_rcpf(1.f + fexp2(-1.702f * LOG2E * gg)); }
                if (r < cnt) { u32x2 w; w.x = pk2(a[0], a[1]); w.y = pk2(a[2], a[3]); *(u32x2*)(ACT + (size_t)(ro + r) * DFF + gc) = w; } } } }
};
struct PolMoe2 : PolMoe {
    __device__ __forceinline__ unsigned bias_voff(const TD& td) const { return 4u * (unsigned)((layer * NEXP + td.i0) * D + td.i1 * 256 + lane * 4); }
    __device__ __forceinline__ bool get(int i, TD& td) const { int e, ct, rbase, ro, cnt; if (!find(i, e, ct, rbase, ro, cnt)) return false;
        td.A = (const bf16_t*)(ws + WS_ACT);
#pragma unroll
        for (int i2 = 0; i2 < 4; ++i2) { int rr = rbase + prow(i2); rr = rr < cnt ? rr : cnt - 1; td.aoff[i2] = (unsigned)(((ro + rr) * DFF + pcol()) * 2); }
        td.B = panel(e, ct); td.bco = nullptr;
        td.i0 = e; td.i1 = ct; td.i2 = rbase; td.i3 = ro; td.i4 = cnt; return true; }
    __device__ __forceinline__ void epi(f32x4 (&acc)[8][4], const TD& td, const LAS float* bl) const { (void)bl; EPI_GEOM; const int e = td.i0, ct = td.i1, rbase = td.i2, ro = td.i3, cnt = td.i4;
        bf16_t* Y = (bf16_t*)(ws + WS_Y);
#pragma unroll
        for (int n = 0; n < 4; ++n) { const int c = ct * 256 + wc * 64 + n * 16 + 4 * fq; const f32x4 bv = bl ? *(const LAS f32x4*)(bl + wc * 64 + n * 16 + 4 * fq) : *(const f32x4*)(bias + (size_t)(layer * NEXP + e) * D + c);
#pragma unroll
            for (int m = 0; m < 8; ++m) { const int r = rbase + wr * 128 + m * 16 + fr;
                if (r < cnt) { u32x2 w; w.x = pk2(acc[m][n][0] + bv[0], acc[m][n][1] + bv[1]); w.y = pk2(acc[m][n][2] + bv[2], acc[m][n][3] + bv[3]); *(u32x2*)(Y + (size_t)(ro + r) * D + c) = w; } } } }
};
__device__ __forceinline__ void phase_moe1(Frame& F, const XcdBarrier& bar, const bool use_bar, const int layer) {
    const MoeLds L = moe_lds(F);
    moe_prefix(F, layer, L);
    const int ne = __builtin_amdgcn_readfirstlane(L.nz[32]), tq = __builtin_amdgcn_readfirstlane(L.mtq[32]);
    const float* W = PP(moe_w_gu); const float* bias = PP(moe_b_gu);
    { PolMoe1 P; P.L = L; P.layer = layer; P.nct = 8; P.round = 0; P.bc_off = WS_BC; P.base_init(F, D / 64, ne * 8); P.bfm = false; P.W = W; P.bias = bias;
      { const int l2 = F.lane & 31; P.lcolb = 4u * (unsigned)((F.lane >> 5) * DFF + 4 * l2); P.woff = 2u * (unsigned)(((4 * l2) >> 5) * 64 + (F.lane >> 5) * 32 + ((4 * l2) & 31)); }
      gemm_stream(F.lds, P, F.wid, F.lane); }
    if (use_bar) xcd_barrier(bar);
    { PolMoe1 P; P.L = L; P.layer = layer; P.nct = 8; P.round = 1; P.bc_off = WS_BC; P.base_init(F, D / 64, tq * 8); P.ldbB = 256; P.W = W; P.bias = bias; P.has_bias = true; P.has_list = true; P.listp = (const int*)(F.ws + WS_LIST);
      gemm_stream_bf(F.lds, P, F.wid, F.lane); }
}
__device__ __forceinline__ void phase_moe2(Frame& F, const int layer) {
    const MoeLds L = moe_lds(F);
    moe_prefix(F, layer, L);
    PolMoe2 P; P.L = L; P.layer = layer; P.nct = 4; P.round = 2; P.bc_off = WS_BC2; P.base_init(F, DFF / 64, __builtin_amdgcn_readfirstlane(L.mtp[32]) * 4); P.ldbB = 256; P.W = nullptr; P.bias = PP(moe_b_dn); P.has_bias = true;
    gemm_stream_bf(F.lds, P, F.wid, F.lane);
}

__device__ __forceinline__ void phase_combine(Frame& F, const int layer) {
    const MoeLds ML = moe_lds(F); LAS int* roff = ML.roff;
    moe_prefix(F, layer, ML);
    const int nrows = layer == 0 ? NTOK : NMAIN, lane = F.lane;
    const int gw = F.bid * 8 + F.wid, NGW = F.G * 8;
    i32x4 ps_n = (i32x4){0, 0, 0, 0}; f32x4 tw_n = (f32x4){0.f, 0.f, 0.f, 0.f}, tw_c = tw_n;
    u32x2 y_c[4][4], y_n[4][4]; f32x4 xs_c[4], xs_n[4];
#define CMB_IDX(row_) do { if ((row_) < nrows) { ps_n = *(const i32x4*)(F_POS + (size_t)(row_) * 4); tw_n = *(const f32x4*)(F_TOPW + (size_t)(row_) * 4); } } while (0)
#define CMB_DATA(row_, Y_, XS_) do { if ((row_) < nrows) { \
        _Pragma("unroll") for (int k = 0; k < 4; ++k) { const int e = ps_n[k] & 255, pos = ps_n[k] >> 8; const bf16_t* y = F_Y + (size_t)(roff[e] + pos) * D; \
            _Pragma("unroll") for (int j = 0; j < 4; ++j) Y_[k][j] = *(const u32x2*)(y + 4 * lane + 256 * j); } \
        _Pragma("unroll") for (int j = 0; j < 4; ++j) XS_[j] = *(const f32x4*)(F_XS + (size_t)(row_) * D + 4 * lane + 256 * j); } } while (0)
    CMB_IDX(gw); CMB_DATA(gw, y_c, xs_c); tw_c = tw_n; CMB_IDX(gw + NGW);
    for (int row = gw; row < nrows; row += NGW) {
        CMB_DATA(row + NGW, y_n, xs_n); const f32x4 tw_nn = tw_n; CMB_IDX(row + 2 * NGW);
        const int r = mod_row(row); const float* g2 = modp(F, layer, r, 5);
        f32x4 v[4];
#pragma unroll
        for (int j = 0; j < 4; ++j) v[j] = (f32x4){0.f, 0.f, 0.f, 0.f};
#pragma unroll
        for (int k = 0; k < 4; ++k) { const float w = tw_c[k];
#pragma unroll
            for (int j = 0; j < 4; ++j) { const u32x2 u = y_c[k][j]; v[j][0] += w * bflo(u.x); v[j][1] += w * bfhi(u.x); v[j][2] += w * bflo(u.y); v[j][3] += w * bfhi(u.y); } }
#pragma unroll
        for (int j = 0; j < 4; ++j) { const int c = 4 * lane + 256 * j; const f32x4 gv = *(const f32x4*)(g2 + c); v[j] = xs_c[j] + gv * v[j]; }
        const float rstd = row_rstd(v);
        if (layer == 0) {
#pragma unroll
            for (int j = 0; j < 4; ++j) *(f32x4*)(F_XS + (size_t)row * D + 4 * lane + 256 * j) = v[j];
            norm_mod_store(v, rstd, PP(norm_mix) + D, modp(F, 1, r, 1), modp(F, 1, r, 0), F_H + (size_t)row * D, lane);
        } else {
#pragma unroll
            for (int j = 0; j < 4; ++j) { const int c = 4 * lane + 256 * j; const f32x4 g = *(const f32x4*)(PP(final_norm) + c); *(f32x4*)(((float*)ldp(F, (int)__builtin_offsetof(Params, out))) + (size_t)row * D + c) = v[j] * rstd * g; }
        }
        tw_c = tw_nn;
#pragma unroll
        for (int k = 0; k < 4; ++k)
#pragma unroll
            for (int j = 0; j < 4; ++j) y_c[k][j] = y_n[k][j];
#pragma unroll
        for (int j = 0; j < 4; ++j) xs_c[j] = xs_n[j];
        __builtin_amdgcn_sched_barrier(0);
    }
#undef CMB_IDX
#undef CMB_DATA
}

struct PolInproj1 : PolBase {
    const float* W;
    __device__ __forceinline__ bool get(int i, TD& td) const { int t; if (!tileL(i, t)) return false; constexpr int N_MAIN_T = (NMAIN / 256) * 10; int pm, pn;
        if (t < N_MAIN_T) dense_tile(t, NMAIN / 256, 10, pm, pn); else { const int c = t - N_MAIN_T; pm = NMAIN / 256 + (c & 3); pn = 2 + (c >> 2); }
        td.A = (const bf16_t*)(ws + WS_H); dense_aoff(td, pm * 256, D);
        td.B = (const bf16_t*)(ws + WB_OIN) + pn * 256; td.i0 = pm; td.i1 = pn; return true; }
    __device__ __forceinline__ void epi(f32x4 (&acc)[8][4], const TD& td, const LAS float* bl) const { (void)bl; EPI_GEOM; const int pm = td.i0, pn = td.i1;
        if (pn < 6) { bf16_t* PROJ = (bf16_t*)(ws + WS_PROJ);
#pragma unroll
            for (int m = 0; m < 8; ++m) { const int row = pm * 256 + wr * 128 + m * 16 + fr;
#pragma unroll
                for (int n = 0; n < 4; ++n) { u32x2 w; w.x = pk2(acc[m][n][0], acc[m][n][1]); w.y = pk2(acc[m][n][2], acc[m][n][3]);
                    *(u32x2*)(PROJ + (size_t)row * QKV_LD + pn * 256 + wc * 64 + n * 16 + 4 * fq) = w; } }
        } else { const int g = pn - 6, ri = wc >> 1; bf16_t* Z = (bf16_t*)(ws + WS_Z);
#pragma unroll
            for (int m = 0; m < 8; ++m) { const int row = pm * 256 + wr * 128 + m * 16 + fr, b = row >> 12, n1 = (row >> 6) & 63, n2 = row & 63;
                bf16_t* zb = Z + ((((size_t)(b * 64 + n1) * 2 + ri) * 64 + n2) * 512) + g * 128 + (wc & 1) * 64;
#pragma unroll
                for (int n = 0; n < 4; ++n) { u32x2 w; w.x = pk2(acc[m][n][0], acc[m][n][1]); w.y = pk2(acc[m][n][2], acc[m][n][3]); *(u32x2*)(zb + n * 16 + 4 * fq) = w; } } } }
};
__device__ __forceinline__ void phase_inproj_l1(Frame& F) {
    PolInproj1 P; P.base_init(F, D / 64, (NMAIN / 256) * 10 + (NCTX / 256) * 4); P.ldbB = 2560;
    gemm_stream_bf(F.lds, P, F.wid, F.lane);
}

struct PolFour : PolBase {
    int stage;
    __device__ __forceinline__ bool get(int i, TD& td) const { int L; if (!tileL(i, L)) return false; const int b = L >> 7, ct = L & 127;
        td.A = (const bf16_t*)(ws + (stage == 1 ? WS_M1 : WS_M2)); dense_aoff(td, 0, 128);
        td.B = (const bf16_t*)(ws + (stage == 1 ? WS_Z : WS_A1)) + (size_t)b * 128 * 32768 + ct * 256; td.i0 = b; td.i1 = ct; return true; }
    __device__ __forceinline__ void epi(f32x4 (&acc)[8][4], const TD& td, const LAS float* bl) const { (void)bl; EPI_GEOM; const int b = td.i0, ct = td.i1;
        if (wr != 0) return;
        if (stage == 1) { const f32x2* TW = (const f32x2*)(ws + WS_TW); bf16_t* A1 = (bf16_t*)(ws + WS_A1);
#pragma unroll
            for (int m = 0; m < 4; ++m) { const int k1 = m * 16 + fr;
#pragma unroll
                for (int n = 0; n < 4; ++n) { const int col = ct * 256 + wc * 64 + n * 16 + 4 * fq, n2 = col >> 9, c = col & 511;
                    const f32x2 tw = TW[n2 * k1]; const f32x4 re = acc[m][n], im = acc[m + 4][n];
                    const f32x4 ore = re * tw.x + im * tw.y, oim = im * tw.x - re * tw.y; u32x2 w0, w1;
                    w0.x = pk2(ore[0], ore[1]); w0.y = pk2(ore[2], ore[3]); w1.x = pk2(oim[0], oim[1]); w1.y = pk2(oim[2], oim[3]);
                    *(u32x2*)(A1 + ((((size_t)(b * 2 + 0) * 64 + n2) * 64 + k1) * 512) + c) = w0;
                    *(u32x2*)(A1 + ((((size_t)(b * 2 + 1) * 64 + n2) * 64 + k1) * 512) + c) = w1; } }
        } else { const float scl = 1.f / 724.0773439350247f; bf16_t* MIX = (bf16_t*)(ws + WS_MIX);
#pragma unroll
            for (int m = 0; m < 4; ++m) { const int k2 = m * 16 + fr;
#pragma unroll
                for (int n = 0; n < 4; ++n) { const int col = ct * 256 + wc * 64 + n * 16 + 4 * fq, k1 = col >> 9, c = col & 511;
                    const f32x4 o = acc[m][n] * scl; u32x2 w; w.x = pk2(o[0], o[1]); w.y = pk2(o[2], o[3]);
                    *(u32x2*)(MIX + (size_t)(b * SEQ + k1 + 64 * k2) * D + 512 + c) = w; } } } }
};

__device__ __forceinline__ void phase_attn_l1(Frame& F) {
    const int wid = F.wid, lane = F.lane, fr = lane & 15, fq = lane >> 4;
    constexpr int N_NA = NB * 64, N_F1 = NB * 128;
    const float SC = 0.125f * LOG2E;
    for (int it = F.bid; it < N_NA; it += F.G) {
            LAS unsigned char* vl = F.lds + wid * 8192;
            LAS float* rp = (LAS float*)(vl + 5120);
            const int b = it >> 6, r = it & 63, h = wid;
            for (int i = lane; i < 465; i += 64) rp[i] = PP(odd_rpb)[h * 465 + i] * LOG2E;
            for (int qh = 0; qh < 4 / QT; ++qh) {
            const int qc0 = qh * (16 * QT), qrow0 = b * SEQ + r * 64 + qc0;
            bf16x8 qf[QT][2];
#pragma unroll
            for (int qt = 0; qt < QT; ++qt)
#pragma unroll
                for (int ks = 0; ks < 2; ++ks) qf[qt][ks] = *(const bf16x8*)(F_PROJ + (size_t)(qrow0 + qt * 16 + fr) * QKV_LD + h * 64 + ks * 32 + 8 * fq);
            AttnSt st;
#pragma unroll
            for (int qt = 0; qt < QT; ++qt) { st.m[qt] = -1e30f; st.l[qt] = 0.f;
#pragma unroll
                for (int dt = 0; dt < 4; ++dt) st.o[dt][qt] = (f32x4){0.f, 0.f, 0.f, 0.f}; }
            const int r0 = min(max(r - 4, 0), 56);
            int c0q[QT];
#pragma unroll
            for (int qt = 0; qt < QT; ++qt) c0q[qt] = min(max(qc0 + qt * 16 + fr - 8, 0), 48);
            for (int s = 0; s < 16; ++s) {
                const int kr = r0 + (s >> 1), half = s & 1;
                const bf16_t* kp = F_PROJ + (size_t)(b * SEQ + kr * 64 + half * 32) * QKV_LD + 512 + h * 64;
                const bf16_t* vp = kp + 512;
                const LAS float* rpr = rp + (kr - r + 7) * 31 + 15;
#define SKIP_NA(qt) ({ const int qlo_ = qc0 + qt * 16, wlo_ = min(max(qlo_ - 8, 0), 48), whi_ = min(max(qlo_ + 15 - 8, 0), 48) + 15; (half * 32 + 31 < wlo_) || (half * 32 > whi_); })
#define BIAS_NA(qt, kt, j) ({ const int kc = half * 32 + kt * 16 + 4 * fq + j; const int dc = kc - (qc0 + qt * 16 + fr); (kc >= c0q[qt] && kc < c0q[qt] + 16) ? rpr[dc] : -INFINITY; })
                ATTN_STEP(kp, QKV_LD, vp, QKV_LD, SC, BIAS_NA, SKIP_NA);
            }
            for (int s = 0; s < 8; ++s) {
                const bf16_t* kp = F_PROJ + (size_t)(NMAIN + b * CTXL + s * 32) * QKV_LD + 512 + h * 64;
                const bf16_t* vp = kp + 512;
                ATTN_STEP(kp, QKV_LD, vp, QKV_LD, SC, BIAS_NONE, SKIP_NONE);
            }
            attn_store(st, F_MIX + (size_t)qrow0 * D + h * 64, D, fr, fq);
            }
    }
    __syncthreads();
    PolFour P; P.stage = 1; P.base_init(F, 2, N_F1); P.ldbB = 32768;
    gemm_stream_bf(F.lds, P, F.wid, F.lane);
}

__device__ __forceinline__ void phase_fst2(Frame& F) {
    PolFour P; P.stage = 2; P.base_init(F, 2, NB * 128); P.ldbB = 32768;
    gemm_stream_bf(F.lds, P, F.wid, F.lane);
}

__global__ void __launch_bounds__(512, 2) fwd_kernel(Params p) {
    extern __shared__ __attribute__((aligned(16))) unsigned char lds_raw[];
    Frame F;
    F.lds = (LAS unsigned char*)lds_raw;
    F.tid = threadIdx.x; F.lane = F.tid & 63; F.wid = __builtin_amdgcn_readfirstlane(F.tid >> 6); F.bid = blockIdx.x; F.G = gridDim.x;
    unsigned char* ws = p.ws; F.ws = ws;
    volatile LAS unsigned* MISC = (volatile LAS unsigned*)(F.lds + MISC_OFF);
    if (F.tid < 64) MISC[F.tid] = 0u;
    if (F.tid == 64) { LAS unsigned long long* LP = (LAS unsigned long long*)(F.lds + PARAM_OFF);
        LP[0] = (unsigned long long)p.x; LP[1] = (unsigned long long)p.c; LP[2] = (unsigned long long)p.ctx; LP[3] = (unsigned long long)p.c_ctx; LP[4] = (unsigned long long)p.ada_w; LP[5] = (unsigned long long)p.ada_b;
        LP[6] = (unsigned long long)p.norm_mix; LP[7] = (unsigned long long)p.norm_ffn; LP[8] = (unsigned long long)p.even_w_in; LP[9] = (unsigned long long)p.even_w_out; LP[10] = (unsigned long long)p.even_conv_w;
        LP[11] = (unsigned long long)p.even_sink; LP[12] = (unsigned long long)p.odd_w_in; LP[13] = (unsigned long long)p.odd_w_out; LP[14] = (unsigned long long)p.odd_rpb; LP[15] = (unsigned long long)p.router_w;
        LP[16] = (unsigned long long)p.router_b; LP[17] = (unsigned long long)p.moe_w_gu; LP[18] = (unsigned long long)p.moe_b_gu; LP[19] = (unsigned long long)p.moe_w_dn; LP[20] = (unsigned long long)p.moe_b_dn;
        LP[21] = (unsigned long long)p.final_norm; LP[22] = (unsigned long long)p.out; }
    __syncthreads();
    const int lo = p.ph_lo, hi = p.ph_hi;
    XcdBarrier bar; bar.bar = (unsigned*)(ws + WS_CTL) + CW_BAR; bar.x = 0; bar.st = MISC + 8;
    if (hi - lo > 1) bar = xcd_barrier_post((unsigned*)(ws + WS_CTL) + CW_BAR, MISC + 8);
#define RUN_PHASE(ph, call) do { if (PH_ON(ph) && lo <= (ph) && (ph) < hi) { call; if (PH_REP(ph)) { xcd_barrier(bar); call; } } if (lo <= (ph) && (ph) + 1 < hi) xcd_barrier(bar); } while (0)
    RUN_PHASE(PH_PREP, phase_prep(F));
    RUN_PHASE(PH_NORM1_0, phase_norm1_l0(F));
    RUN_PHASE(PH_INPROJ_0, phase_inproj_l0(F));
    RUN_PHASE(PH_ATTN_0, phase_attn_l0(F));
    RUN_PHASE(PH_OUTPROJ_0, phase_outproj(F, 0));
    RUN_PHASE(PH_ROUTE_0, phase_route(F, 0));
    RUN_PHASE(PH_MOE1_0, phase_moe1(F, bar, hi - lo > 1, 0));
    RUN_PHASE(PH_MOE2_0, phase_moe2(F, 0));
    RUN_PHASE(PH_COMB_0, phase_combine(F, 0));
    RUN_PHASE(PH_INPROJ_1, phase_inproj_l1(F));
    RUN_PHASE(PH_ATTN_1, phase_attn_l1(F));
    RUN_PHASE(PH_FST2_1, phase_fst2(F));
    RUN_PHASE(PH_OUTPROJ_1, phase_outproj(F, 1));
    RUN_PHASE(PH_ROUTE_1, phase_route(F, 1));
    RUN_PHASE(PH_MOE1_1, phase_moe1(F, bar, hi - lo > 1, 1));
    RUN_PHASE(PH_MOE2_1, phase_moe2(F, 1));
    RUN_PHASE(PH_FINAL, phase_combine(F, 1));
}

extern "C" void kernel_launch(void* const* d_in, const int* in_sizes, int n_in, void* d_out, int out_size, void* d_ws, size_t ws_size, hipStream_t stream) {
    static int grid = 0;
    if (grid == 0) {
        if (n_in != 22 || ws_size < WS_END) { fprintf(stderr, "kernel_launch: unexpected inputs (n_in %d, ws %zu)\n", n_in, ws_size); grid = -1; return; }
        int dev = 0, cus = 0, per_cu = 0;
        hipGetDevice(&dev);
        hipDeviceGetAttribute(&cus, hipDeviceAttributeMultiprocessorCount, dev);
        hipFuncSetAttribute((const void*)fwd_kernel, hipFuncAttributeMaxDynamicSharedMemorySize, LDS_BYTES);
        hipOccupancyMaxActiveBlocksPerMultiprocessor(&per_cu, (const void*)fwd_kernel, 512, LDS_BYTES);
        if (per_cu < 1) { fprintf(stderr, "kernel_launch: occupancy query says %d blocks/CU\n", per_cu); per_cu = 1; }
        (void)hipGetLastError();
        grid = cus;
    }
    if (grid < 0) return;
    hipMemsetAsync((char*)d_ws + WS_CTL, 0, CTL_BYTES, stream);
    Params p{};
    const float** pp = (const float**)&p;
    for (int i = 0; i < 22; ++i) pp[i] = (const float*)d_in[i];
    p.out = (float*)d_out; p.ws = (unsigned char*)d_ws;
#if N_LAUNCH_MODE == 1
    for (int ph = 0; ph < NPHASE; ++ph) { p.ph_lo = ph; p.ph_hi = ph + 1; hipLaunchKernelGGL(fwd_kernel, dim3(grid), dim3(512), LDS_BYTES, stream, p); }
#else
    p.ph_lo = 0; p.ph_hi = NPHASE;
    void* args[] = {&p};
    hipError_t e = hipLaunchCooperativeKernel((const void*)fwd_kernel, dim3(grid), dim3(512), args, LDS_BYTES, stream);
    if (e != hipSuccess) fprintf(stderr, "kernel_launch: cooperative launch failed: %s (grid %d)\n", hipGetErrorString(e), grid);
#endif
}
```

```cpp
#include <hip/hip_runtime.h>
#include <cstdio>
#include <cstdint>

#ifndef N_LAUNCH_MODE
#define N_LAUNCH_MODE 0
#endif

#ifndef PHASE_MASK
#define PHASE_MASK 0x1FFFF
#endif
#define PH_ON(ph) ((PHASE_MASK >> (ph)) & 1)
#ifndef REPEAT_MASK
#define REPEAT_MASK 0
#endif
#define PH_REP(ph) ((REPEAT_MASK >> (ph)) & 1)
#define LAS __attribute__((address_space(3)))
#define GAS __attribute__((address_space(1)))
typedef unsigned short bf16_t;
typedef short bf16x8 __attribute__((ext_vector_type(8)));
typedef short s16x4 __attribute__((ext_vector_type(4)));
typedef float f32x4 __attribute__((ext_vector_type(4)));
typedef float f32x2 __attribute__((ext_vector_type(2)));
typedef int i32x4 __attribute__((ext_vector_type(4)));
typedef unsigned u32x2 __attribute__((ext_vector_type(2)));
typedef unsigned u32x4 __attribute__((ext_vector_type(4)));

constexpr int D = 1024, NB = 4, SEQ = 4096, CTXL = 256;
constexpr int NMAIN = NB * SEQ, NCTX = NB * CTXL, NTOK = NMAIN + NCTX;
constexpr int EVEN_IN = 2304, NEXP = 32, DFF = 1024;
constexpr int QKV_LD = 1536;
constexpr float NORM_EPS = 1e-6f;
constexpr float LOG2E = 1.4426950408889634f;

constexpr size_t MiB = 1ull << 20;
constexpr size_t WS_CTL = 0, CTL_BYTES = 1 * MiB;
constexpr size_t WS_MOD = 1 * MiB;
constexpr size_t WS_M1 = 2 * MiB;
constexpr size_t WS_M2 = WS_M1 + 65536;
constexpr size_t WS_ROPE = WS_M2 + 65536;
constexpr size_t WS_TW = WS_ROPE + 8192;
constexpr size_t WS_WF = 4 * MiB;
constexpr size_t WS_TOPW = 8 * MiB;
constexpr size_t WS_POS = 9 * MiB;
constexpr size_t WS_LIST = 12 * MiB;
constexpr size_t WS_H = 16 * MiB;
constexpr size_t WS_MIX = 52 * MiB;
constexpr size_t WS_XS = 88 * MiB;
constexpr size_t WS_PROJ = 160 * MiB;
constexpr size_t WS_Z = 240 * MiB;
constexpr size_t WS_A1 = 304 * MiB;
constexpr size_t WS_ACT = 368 * MiB;
constexpr size_t WS_Y = 512 * MiB;
constexpr size_t WS_WB = 656 * MiB;
constexpr size_t WB_EIN = WS_WB, WB_EOUT = WB_EIN + (size_t)D * EVEN_IN * 2, WB_OIN = WB_EOUT + (size_t)D * D * 2, WB_OOUT = WB_OIN + (size_t)D * 2560 * 2;
constexpr size_t WS_BC = 672 * MiB;
constexpr size_t WS_BC2 = WS_BC + 128 * MiB;
constexpr size_t WS_END = 864 * MiB;
constexpr int CW_BAR = 4096;
constexpr int CW_CNT = 8192;

constexpr int LDS_BYTES = 147456;
constexpr int PARAM_OFF = LDS_BYTES - 512;
constexpr int MISC_OFF = LDS_BYTES - 256;
constexpr int A_TILE_B = 32768, B_ROWB = 544, B_TILE_B = 64 * B_ROWB, STAGE_B = A_TILE_B + B_TILE_B;
static_assert(2 * STAGE_B + 1024 + 8192 <= PARAM_OFF, "LDS");

enum { PH_PREP = 0, PH_NORM1_0, PH_INPROJ_0, PH_ATTN_0, PH_OUTPROJ_0, PH_ROUTE_0, PH_MOE1_0, PH_MOE2_0, PH_COMB_0,
       PH_INPROJ_1, PH_ATTN_1, PH_FST2_1, PH_OUTPROJ_1, PH_ROUTE_1, PH_MOE1_1, PH_MOE2_1, PH_FINAL, NPHASE };

struct Params {
    const float *x, *c, *ctx, *c_ctx, *ada_w, *ada_b, *norm_mix, *norm_ffn, *even_w_in, *even_w_out, *even_conv_w, *even_sink,
                *odd_w_in, *odd_w_out, *odd_rpb, *router_w, *router_b, *moe_w_gu, *moe_b_gu, *moe_w_dn, *moe_b_dn, *final_norm;
    float* out; unsigned char* ws; int ph_lo, ph_hi;
};

__device__ __forceinline__ unsigned pk2(float lo, float hi) { unsigned r; asm("v_cvt_pk_bf16_f32 %0, %1, %2" : "=v"(r) : "v"(lo), "v"(hi)); return r; }
__device__ __forceinline__ float bflo(unsigned u) { return __builtin_bit_cast(float, u << 16); }
__device__ __forceinline__ float bfhi(unsigned u) { return __builtin_bit_cast(float, u & 0xffff0000u); }
__device__ __forceinline__ float wave_sum(float v) {
#pragma unroll
    for (int o = 1; o < 64; o <<= 1) v += __shfl_xor(v, o);
    return v;
}
__device__ __forceinline__ float fexp2(float x) { return __builtin_amdgcn_exp2f(x); }

#define XB_TMO      128
#define XB_XCNT(j)  (256  + 64 * (j))
#define XB_XSUB(j)  (1280 + 64 * (j))
#define XB_XGEN(j)  (2304 + 64 * (j))
#define XB_TOP      3328
#define XB_TOPGEN   3392
#define XB_SPIN_CAP (1u << 22)
__device__ __forceinline__ unsigned xb_ld(unsigned* p)              { return __hip_atomic_load(p, __ATOMIC_RELAXED, __HIP_MEMORY_SCOPE_AGENT); }
__device__ __forceinline__ unsigned xb_add(unsigned* p, unsigned v) { return __hip_atomic_fetch_add(p, v, __ATOMIC_RELAXED, __HIP_MEMORY_SCOPE_AGENT); }
__device__ __forceinline__ unsigned xb_xcc_id() { return (unsigned)__builtin_amdgcn_s_getreg((3 << 11) | 20) & 0xFu; }
#define XB_SPIN(cond, bar) do { unsigned _sp = 0; while (cond) { __builtin_amdgcn_s_sleep(1); \
    if ((++_sp & 255u) == 0u) { if (xb_ld(&(bar)[XB_TMO])) break; if (_sp > XB_SPIN_CAP) { atomicAdd(&(bar)[XB_TMO], 1u); break; } } } } while (0)
struct XcdBarrier { unsigned* bar; unsigned x; volatile LAS unsigned* st; };
__device__ __forceinline__ XcdBarrier xcd_barrier_post(unsigned* bar, volatile LAS unsigned* st) {
    XcdBarrier b; b.bar = bar; b.x = xb_xcc_id(); b.st = st;
    if (threadIdx.x == 0) (void)xb_add(&bar[XB_XCNT(b.x)], 1u);
    return b;
}
__device__ __forceinline__ void xcd_barrier_complete(unsigned* bar, unsigned x, unsigned& nloc, unsigned& nx) {
    const unsigned G = gridDim.x * gridDim.y * gridDim.z;
    unsigned sum, cnt, mine, sp = 0u;
    for (;;) {
        sum = 0u; cnt = 0u; mine = 0u;
#pragma unroll
        for (unsigned j = 0; j < 16; ++j) { const unsigned c = xb_ld(&bar[XB_XCNT(j)]); sum += c; cnt += (c > 0u) ? 1u : 0u; mine = (j == x) ? c : mine; }
        if (sum == G) break;
        __builtin_amdgcn_s_sleep(1);
        if ((++sp & 255u) == 0u) { if (xb_ld(&bar[XB_TMO])) break; if (sp > XB_SPIN_CAP) { atomicAdd(&bar[XB_TMO], 1u); break; } }
    }
    nloc = mine > 0u ? mine : 1u; nx = cnt > 0u ? cnt : 1u;
}
__device__ __forceinline__ void xcd_barrier(const XcdBarrier& b) {
    asm volatile("s_waitcnt vmcnt(0)" ::: "memory");
    __syncthreads();
    if (threadIdx.x == 0) {
        unsigned* bar = b.bar;
        __builtin_amdgcn_s_waitcnt(0);
        unsigned nloc = b.st[0], nx = b.st[1];
        if (nloc == 0u) { xcd_barrier_complete(bar, b.x, nloc, nx); b.st[0] = nloc; b.st[1] = nx; }
        const unsigned old = xb_add(&bar[XB_XSUB(b.x)], 1u);
        const unsigned gen = old / nloc;
        if (old + 1u == (gen + 1u) * nloc) {
            __builtin_amdgcn_fence(__ATOMIC_RELEASE, "agent");
            asm volatile("s_waitcnt vmcnt(0)" ::: "memory");
            const unsigned og = xb_add(&bar[XB_TOP], 1u);
            const unsigned tg = og / nx;
            if (og + 1u == (tg + 1u) * nx) xb_add(&bar[XB_TOPGEN], 1u);
            else XB_SPIN(xb_ld(&bar[XB_TOPGEN]) == tg, bar);
            __builtin_amdgcn_fence(__ATOMIC_ACQUIRE, "agent");
            xb_add(&bar[XB_XGEN(b.x)], 1u);
            asm volatile("s_waitcnt vmcnt(0)" ::: "memory");
        } else {
            XB_SPIN(xb_ld(&bar[XB_XGEN(b.x)]) == gen, bar);
            __builtin_amdgcn_fence(__ATOMIC_ACQUIRE, "agent");
            asm volatile("s_waitcnt vmcnt(0)" ::: "memory");
        }
    }
    __syncthreads();
}

struct TD { const bf16_t* A; const void* B; bf16_t* bco; unsigned ldb; unsigned aoff[4]; int i0, i1, i2, i3, i4; };
__device__ __forceinline__ int a_piece_row0(int wid, int lane) { const int sb = lane * 16, swz = sb ^ (((sb >> 9) & 1) << 5); return (wid >> 1) * 16 + (swz >> 6); }
__device__ __forceinline__ int a_piece_col(int wid, int lane) { const int sb = lane * 16, swz = sb ^ (((sb >> 9) & 1) << 5); return (wid & 1) * 32 + ((swz & 63) >> 1); }
__device__ __forceinline__ u32x4 make_rsrc(const void* p) { const unsigned long long ab = (unsigned long long)p; u32x4 r; r.x = __builtin_amdgcn_readfirstlane((unsigned)ab); r.y = __builtin_amdgcn_readfirstlane((unsigned)(ab >> 32)) & 0xffffu; r.z = 0x7fffffffu; r.w = 0x00020000u; return r; }

template <class Pol>
__device__ __forceinline__ void gemm_stream(LAS unsigned char* lds, Pol& P, const int wid, const int lane) {
    const int wr = wid >> 2, wc = wid & 3, fr = lane & 15, fq = lane >> 4;
    const unsigned b_w = (unsigned)(A_TILE_B + ((wid >> 2) * 32 + 4 * (wid & 3)) * B_ROWB) + P.woff;
    const unsigned a_r = (unsigned)(wr * 16384 + ((fr * 64 + fq * 16) ^ ((fr >> 3) << 5)));
    const unsigned b_r = (unsigned)(A_TILE_B + (4 * fq + (fr >> 2)) * B_ROWB + (wc * 64 + (fr & 3) * 4) * 2);
    const unsigned ldsa = (unsigned)(__UINTPTR_TYPE__)lds + (unsigned)(wid * 1024);
    const unsigned lcolb = P.lcolb;
    TD cur, nxt;
    if (!P.get(0, cur)) return;
    int nt = P.nt; asm volatile("" : "+s"(nt));
    f32x4 sb[8]; f32x4 acc[8][4];
    u32x4 ra_c = make_rsrc(cur.A), ra_n = ra_c;
    __amdgpu_buffer_rsrc_t rb_c = __builtin_amdgcn_make_buffer_rsrc((void*)cur.B, 0, 0x7fffffff, 0x00020000), rb_n = rb_c;
#define G_GLDS_A(buf, RA, AOFF, kt) do { _Pragma("unroll") for (int i = 0; i < 4; ++i) { unsigned keep_; \
        asm volatile("s_mov_b32 %0, m0\n\ts_mov_b32 m0, %3\n\ts_nop 0\n\tbuffer_load_dwordx4 %1, %2, %4 offen lds\n\ts_mov_b32 m0, %0" \
            : "=&s"(keep_) : "v"(AOFF[i]), "s"(RA), "s"(ldsa + (buf) + (unsigned)(i * 8192)), "s"((unsigned)((kt) * 128)) : "memory"); } } while (0)
#define G_ISSUE_BH(RB, LDB4, kt, h) do { \
        _Pragma("unroll") for (int i = 4 * (h); i < 4 * (h) + 4; ++i) sb[i] = __builtin_bit_cast(f32x4, __builtin_amdgcn_raw_buffer_load_b128(RB, (int)lcolb, (int)(((unsigned)(kt) * 64u + i) * (LDB4)), 0)); \
        __builtin_amdgcn_sched_barrier(0); } while (0)
#define G_WRITE_BH(buf, h, BCO, kt) do { \
        _Pragma("unroll") for (int i = 4 * (h); i < 4 * (h) + 4; ++i) { u32x2 w; w.x = pk2(sb[i][0], sb[i][1]); w.y = pk2(sb[i][2], sb[i][3]); \
            *(LAS u32x2*)(lds + (buf) + b_w + (16 * (i >> 2) + (i & 3)) * B_ROWB) = w; \
            if (BCO) *(u32x2*)((char*)(BCO) + (size_t)((kt) * 64 + wid * 8 + i) * 512 + P.woff) = w; } __builtin_amdgcn_sched_barrier(0); } while (0)
#define G_KSTEP(buf, ks) do { bf16x8 Bf[4]; \
        _Pragma("unroll") for (int n = 0; n < 4; ++n) { \
            const s16x4 lo = __builtin_amdgcn_ds_read_tr16_b64_v4i16((LAS s16x4*)(lds + (buf) + b_r + (ks) * 32 * B_ROWB + n * 32)); \
            const s16x4 hi = __builtin_amdgcn_ds_read_tr16_b64_v4i16((LAS s16x4*)(lds + (buf) + b_r + (ks) * 32 * B_ROWB + 16 * B_ROWB + n * 32)); \
            Bf[n] = (bf16x8){lo[0], lo[1], lo[2], lo[3], hi[0], hi[1], hi[2], hi[3]}; } \
        _Pragma("unroll") for (int mh = 0; mh < 2; ++mh) { bf16x8 At[4]; \
            _Pragma("unroll") for (int m = 0; m < 4; ++m) At[m] = *(const LAS bf16x8*)(lds + (buf) + a_r + (mh * 4 + m) * 2048 + (ks) * 1024); \
            _Pragma("unroll") for (int m = 0; m < 4; ++m) _Pragma("unroll") for (int n = 0; n < 4; ++n) \
                acc[mh * 4 + m][n] = __builtin_amdgcn_mfma_f32_16x16x32_bf16(Bf[n], At[m], acc[mh * 4 + m][n], 0, 0, 0); } \
        __builtin_amdgcn_sched_barrier(0); } while (0)
    { unsigned b0 = 0; asm volatile("" : "+s"(b0));
      const unsigned l4 = cur.ldb * 4u;
      G_GLDS_A(b0, ra_c, cur.aoff, 0); G_ISSUE_BH(rb_c, l4, 0, 0); G_ISSUE_BH(rb_c, l4, 0, 1); G_WRITE_BH(b0, 0, cur.bco, 0); G_WRITE_BH(b0, 1, cur.bco, 0);
      G_ISSUE_BH(rb_c, l4, 1, 0); G_ISSUE_BH(rb_c, l4, 1, 1); }
    asm volatile("s_waitcnt vmcnt(8)" ::: "memory");
    asm volatile("s_waitcnt lgkmcnt(0)" ::: "memory");
    __builtin_amdgcn_s_barrier();
    unsigned par = 0;
    for (int ti = 0;; ++ti) {
        const bool hasn = P.get(ti + 1, nxt);
        if (hasn) { ra_n = make_rsrc(nxt.A); rb_n = __builtin_amdgcn_make_buffer_rsrc((void*)nxt.B, 0, 0x7fffffff, 0x00020000); }
#pragma unroll
        for (int m = 0; m < 8; ++m)
#pragma unroll
            for (int n = 0; n < 4; ++n) acc[m][n] = (f32x4){0.f, 0.f, 0.f, 0.f};
        for (int t = 0; t < nt; ++t) {
            unsigned bc = par * STAGE_B, bn = (par ^ 1u) * STAGE_B; asm volatile("" : "+s"(bc), "+s"(bn));
            const bool c1 = t + 1 < nt, w1 = c1 || hasn, c2 = t + 2 < nt, i2 = c2 || hasn;
            if (w1) { const u32x4 ra = c1 ? ra_c : ra_n; unsigned ao[4];
#pragma unroll
                for (int i = 0; i < 4; ++i) ao[i] = c1 ? cur.aoff[i] : nxt.aoff[i];
                G_GLDS_A(bn, ra, ao, c1 ? t + 1 : 0); }
            G_KSTEP(bc, 0);
            const __amdgpu_buffer_rsrc_t rb = c2 ? rb_c : rb_n; const unsigned l4 = (c2 ? cur.ldb : nxt.ldb) * 4u; const int k2 = c2 ? t + 2 : t + 2 - nt;
            bf16_t* const bco = c1 ? cur.bco : nxt.bco; const int k1 = c1 ? t + 1 : 0;
            if (w1) G_WRITE_BH(bn, 0, bco, k1);
            if (i2) G_ISSUE_BH(rb, l4, k2, 0);
            G_KSTEP(bc, 1);
            if (w1) G_WRITE_BH(bn, 1, bco, k1);
            if (i2) { G_ISSUE_BH(rb, l4, k2, 1); asm volatile("s_waitcnt vmcnt(8)" ::: "memory"); }
            else asm volatile("s_waitcnt vmcnt(0)" ::: "memory");
            asm volatile("s_waitcnt lgkmcnt(0)" ::: "memory");
            __builtin_amdgcn_s_barrier();
            par ^= 1u;
        }
        P.epi(acc, cur, (const LAS float*)nullptr);
        if (!hasn) break;
        cur = nxt; ra_c = ra_n; rb_c = rb_n;
    }
#undef G_GLDS_A
#undef G_ISSUE_BH
#undef G_WRITE_BH
#undef G_KSTEP
}

constexpr int STEP_B = 32768;
constexpr unsigned ROPE_LDS = 2 * STAGE_B + 1024;
constexpr unsigned BIAS_OFF = 4 * STEP_B;
template <class Pol, int ABL = 0>
__device__ __forceinline__ void gemm_stream_bf(LAS unsigned char* lds, Pol& P, const int wid, const int lane) {
    const int wr = wid >> 2, wc = wid & 3, fr = lane & 15, fq = lane >> 4;
    const unsigned a_r = (unsigned)(wr * 8192 + ((fr * 64 + fq * 16) ^ ((fr >> 3) << 5)));
    const int x7 = 4 * (fq & 1) + (fr >> 2);
    unsigned b_r[4];
#pragma unroll
    for (int n = 0; n < 4; ++n) b_r[n] = (unsigned)(16384 + (4 * fq + (fr >> 2)) * 512 + (((wc * 4 + n) ^ x7) * 32) + (fr & 3) * 8);
    const unsigned ldsa = (unsigned)(__UINTPTR_TYPE__)lds + (unsigned)(wid * 2048), ldsb = (unsigned)(__UINTPTR_TYPE__)lds + 16384u + (unsigned)(wid * 2048);
    const unsigned ldb2 = P.ldbB * 2u;
    unsigned boff[2];
#pragma unroll
    for (int j = 0; j < 2; ++j) { const int sl = 4 * wid + 2 * j + (lane >> 5), u = lane & 31, c = (u >> 1) ^ (sl & 7), n = c * 16 + (u & 1) * 8;
        const int k = 8 * ((sl >> 2) & 3) + 4 * (sl >> 4) + (sl & 3); boff[j] = (unsigned)k * ldb2 + (unsigned)n * 2u; }
    TD cur, nxt;
    if (!P.get(0, cur)) return;
    int nt = P.nt * 2; asm volatile("" : "+s"(nt));
    f32x4 acc[8][4];
    u32x4 ra_c = make_rsrc(cur.A), ra_n = ra_c, rb_c = make_rsrc(cur.B), rb_n = rb_c;
#define H_DMA(LDSADDR, RS, VOFF, SOFF) do { unsigned keep_; \
        asm volatile("s_mov_b32 %0, m0\n\ts_mov_b32 m0, %3\n\ts_nop 0\n\tbuffer_load_dwordx4 %1, %2, %4 offen lds\n\ts_mov_b32 m0, %0" \
            : "=&s"(keep_) : "v"(VOFF), "s"(RS), "s"(LDSADDR), "s"(SOFF) : "memory"); } while (0)
#define H_STAGE(sb_, RA, AO0, AO1, RB, st) do { \
        if (!(ABL & 2)) { H_DMA(ldsa + (sb_), RA, AO0, (unsigned)((st) * 64)); H_DMA(ldsa + (sb_) + 1024u, RA, AO1, (unsigned)((st) * 64)); } \
        if (!(ABL & 1)) { H_DMA(ldsb + (sb_), RB, boff[0], (unsigned)(st) * 32u * ldb2); H_DMA(ldsb + (sb_) + 1024u, RB, boff[1], (unsigned)(st) * 32u * ldb2); } } while (0)
#define H_READ(sb_) do { if (!(ABL & 16)) { \
        _Pragma("unroll") for (int n = 0; n < 4; ++n) { \
            const s16x4 lo = __builtin_amdgcn_ds_read_tr16_b64_v4i16((LAS s16x4*)(lds + (sb_) + b_r[n])); \
            const s16x4 hi = __builtin_amdgcn_ds_read_tr16_b64_v4i16((LAS s16x4*)(lds + (sb_) + b_r[n] + 8192)); \
            Bf[n] = (bf16x8){lo[0], lo[1], lo[2], lo[3], hi[0], hi[1], hi[2], hi[3]}; } \
        _Pragma("unroll") for (int m = 0; m < 8; ++m) At[m] = *(const LAS bf16x8*)(lds + (sb_) + a_r + m * 1024); } } while (0)
#define H_MMA() do { if (!(ABL & 16)) { __builtin_amdgcn_s_setprio(1); \
        if (!(ABL & 4)) { _Pragma("unroll") for (int m = 0; m < 8; ++m) _Pragma("unroll") for (int n = 0; n < 4; ++n) \
            acc[m][n] = __builtin_amdgcn_mfma_f32_16x16x32_bf16(Bf[n], At[m], acc[m][n], 0, 0, 0); } \
        else { _Pragma("unroll") for (int m = 0; m < 8; ++m) asm volatile("" :: "v"(At[m])); _Pragma("unroll") for (int n = 0; n < 4; ++n) asm volatile("" :: "v"(Bf[n])); } \
        __builtin_amdgcn_s_setprio(0); } } while (0)
#define H_MMA0() do { if (!(ABL & 16)) { __builtin_amdgcn_s_setprio(1); \
        _Pragma("unroll") for (int m = 0; m < 8; ++m) _Pragma("unroll") for (int n = 0; n < 4; ++n) \
            acc[m][n] = __builtin_amdgcn_mfma_f32_16x16x32_bf16(Bf[n], At[m], (f32x4){0.f, 0.f, 0.f, 0.f}, 0, 0, 0); \
        __builtin_amdgcn_s_setprio(0); } } while (0)
#define H_BAR() do { asm volatile("s_waitcnt lgkmcnt(0)" ::: "memory"); __builtin_amdgcn_s_barrier(); __builtin_amdgcn_sched_barrier(0); } while (0)
    bf16x8 At[8], Bf[4];
    { unsigned s0 = 0, s1 = STEP_B, s2 = 2 * STEP_B; asm volatile("" : "+s"(s0), "+s"(s1), "+s"(s2));
      H_STAGE(s0, ra_c, cur.aoff[0], cur.aoff[1], rb_c, 0); H_STAGE(s1, ra_c, cur.aoff[0], cur.aoff[1], rb_c, 1); H_STAGE(s2, ra_c, cur.aoff[0], cur.aoff[1], rb_c, 2); }
    asm volatile("s_waitcnt vmcnt(8)" ::: "memory");
    H_BAR();
    if (wr == 1) H_BAR();
    unsigned g = 0;
    for (int ti = 0;; ++ti) {
        const bool hasn = P.get(ti + 1, nxt);
        if (hasn) { ra_n = make_rsrc(nxt.A); rb_n = make_rsrc(nxt.B); }
        const unsigned bias_lds = BIAS_OFF + (unsigned)(ti & 1) * 1024u, list_lds = BIAS_OFF + 2048u + (unsigned)(ti & 1) * 1024u;
        if (P.has_bias && wid == 0) { const u32x4 rbias = make_rsrc(P.bias); H_DMA((unsigned)(__UINTPTR_TYPE__)lds + bias_lds, rbias, P.bias_voff(cur), 0u); }
        if (P.has_list && hasn && wid == 1) { const u32x4 rl = make_rsrc(P.listp); H_DMA((unsigned)(__UINTPTR_TYPE__)lds + list_lds, rl, P.list_voff(nxt), 0u); }
        for (int t = 0; t < nt; ++t, ++g) {
            unsigned sc = (g & 3u) * STEP_B, sn = ((g + 3u) & 3u) * STEP_B; asm volatile("" : "+s"(sc), "+s"(sn));
            const bool c3 = t + 3 < nt, i3 = c3 || hasn, i2 = (t + 2 < nt) || hasn;
            if (P.has_list && hasn && t == nt - 3) P.late(nxt, (const LAS int*)(lds + list_lds));
            if (c3) { H_STAGE(sn, ra_c, cur.aoff[0], cur.aoff[1], rb_c, (unsigned)(t + 3)); }
            else if (hasn) { u32x4 ra = ra_n, rb = rb_n;
#pragma unroll
                for (int q = 0; q < 4; ++q) { ra[q] = __builtin_amdgcn_readfirstlane(ra[q]); rb[q] = __builtin_amdgcn_readfirstlane(rb[q]); }
                H_STAGE(sn, ra, nxt.aoff[0], nxt.aoff[1], rb, (unsigned)__builtin_amdgcn_readfirstlane(t + 3 - nt)); }
            H_READ(sc);
            if (i3) asm volatile("s_waitcnt vmcnt(8)" ::: "memory");
            else if (i2) asm volatile("s_waitcnt vmcnt(4)" ::: "memory");
            else asm volatile("s_waitcnt vmcnt(0)" ::: "memory");
            H_BAR();
            if (t == 0) H_MMA0(); else H_MMA();
            H_BAR();
        }
        if (wr == 0) H_BAR();
        if (!(ABL & 8)) P.epi(acc, cur, (const LAS float*)(lds + bias_lds)); else { _Pragma("unroll") for (int m = 0; m < 8; ++m) _Pragma("unroll") for (int n = 0; n < 4; ++n) asm volatile("" :: "v"(acc[m][n])); }
        if (!hasn) break;
        cur = nxt; ra_c = ra_n; rb_c = rb_n;
        if (wr == 1) H_BAR();
    }
#undef H_DMA
#undef H_STAGE
#undef H_READ
#undef H_MMA
#undef H_MMA0
#undef H_BAR
}

struct XOrder {
    int c1, step, cur;
    __device__ __forceinline__ void init(int T, int G, int bid) {
        if ((G & 7) == 0) { const int x = bid & 7; cur = (int)(((long)x * T) >> 3) + (bid >> 3); c1 = (int)(((long)(x + 1) * T) >> 3); step = G >> 3; }
        else { cur = bid; c1 = T; step = G; }
    }
    __device__ __forceinline__ bool next(int& L) { if (cur >= c1) return false; L = cur; cur += step; return true; }
};
__device__ __forceinline__ void dense_tile(int L, int nM, int nN, int& pm, int& pn) { const int per = 8 * nN, g = L / per, w = L - g * per, fm = g * 8, gs = (nM - fm) < 8 ? (nM - fm) : 8; pn = w / gs; pm = fm + w - pn * gs; }

struct Frame { LAS unsigned char* lds; int tid, lane, wid, bid, G; unsigned char* ws; };
__device__ __forceinline__ const void* ldp(const Frame& F, int off) {
    const u32x2 v = *(const volatile LAS u32x2*)(F.lds + PARAM_OFF + off);
    const unsigned lo = __builtin_amdgcn_readfirstlane(v.x), hi = __builtin_amdgcn_readfirstlane(v.y);
    return (const void*)(((unsigned long long)hi << 32) | lo);
}
#define PP(f) ((const float*)ldp(F, (int)__builtin_offsetof(Params, f)))
#define F_mod ((float*)(F.ws + WS_MOD))
#define F_M1 ((bf16_t*)(F.ws + WS_M1))
#define F_M2 ((bf16_t*)(F.ws + WS_M2))
#define F_ROPE ((f32x2*)(F.ws + WS_ROPE))
#define F_TW ((f32x2*)(F.ws + WS_TW))
#define F_WF ((float*)(F.ws + WS_WF))
#define F_TOPW ((float*)(F.ws + WS_TOPW))
#define F_POS ((int*)(F.ws + WS_POS))
#define F_LIST ((int*)(F.ws + WS_LIST))
#define F_H ((bf16_t*)(F.ws + WS_H))
#define F_MIX ((bf16_t*)(F.ws + WS_MIX))
#define F_XS ((float*)(F.ws + WS_XS))
#define F_PROJ ((bf16_t*)(F.ws + WS_PROJ))
#define F_Z ((float*)(F.ws + WS_Z))
#define F_A1 ((float*)(F.ws + WS_A1))
#define F_ACT ((bf16_t*)(F.ws + WS_ACT))
#define F_Y ((bf16_t*)(F.ws + WS_Y))
#define F_cnt ((unsigned*)(F.ws + WS_CTL) + CW_CNT)

__device__ __forceinline__ const float* modp(const Frame& F, int l, int r, int which) { return F_mod + ((size_t)(l * 5 + r)) * 6144 + which * 1024; }
__device__ __forceinline__ int mod_row(int row) { return row < NMAIN ? (row >> 12) : 4; }

__device__ __forceinline__ float row_rstd(const f32x4 (&v)[4]) {
    float s = 0.f;
#pragma unroll
    for (int j = 0; j < 4; ++j) s += (v[j][0] * v[j][0] + v[j][1] * v[j][1]) + (v[j][2] * v[j][2] + v[j][3] * v[j][3]);
    return __builtin_amdgcn_rsqf(wave_sum(s) * (1.f / D) + NORM_EPS);
}
__device__ __forceinline__ void norm_mod_store(const f32x4 (&v)[4], float rstd, const float* gam, const float* sc, const float* sh, bf16_t* dst, int lane, f32x4 (*keep)[4] = nullptr) {
#pragma unroll
    for (int j = 0; j < 4; ++j) {
        const int c = 4 * lane + 256 * j;
        const f32x4 g = *(const f32x4*)(gam + c), s1 = *(const f32x4*)(sc + c), s0 = *(const f32x4*)(sh + c);
        f32x4 h;
#pragma unroll
        for (int i = 0; i < 4; ++i) h[i] = v[j][i] * rstd * g[i] * (1.f + s1[i]) + s0[i];
        u32x2 w; w.x = pk2(h[0], h[1]); w.y = pk2(h[2], h[3]);
        *(u32x2*)(dst + c) = w;
        if (keep) (*keep)[j] = h;
    }
}

__device__ __forceinline__ void phase_prep(Frame& F) {
    LAS float* sil = (LAS float*)F.lds;
    LAS float* red = (LAS float*)(F.lds + 20480);
    LAS float* ct = (LAS float*)(F.lds + 32768);
    for (int idx = F.tid; idx < 5120; idx += 512) { const int r = idx >> 10, k = idx & 1023; const float v = r < 4 ? PP(c)[r * 1024 + k] : PP(c_ctx)[k]; sil[idx] = v / (1.f + __expf(-v)); }
    if (F.tid < 128) ct[F.tid] = cospif((float)F.tid / 64.f);
    __syncthreads();
    constexpr int N_ADA = 192, N_CONST = 8, N_FOLD = 256, N_CVT = 368;
    for (int it = F.bid; it < N_ADA + N_CONST + N_FOLD + N_CVT; it += F.G) {
        if (it < N_ADA) {
            const int l = it / 96, j0 = (it % 96) * 64, col = j0 + F.lane;
            const float* w = PP(ada_w) + ((size_t)l * 1024 + F.wid * 128) * 6144 + col;
            float a[5] = {0.f, 0.f, 0.f, 0.f, 0.f};
            for (int k0 = 0; k0 < 128; k0 += 32) {
                float wv[32];
#pragma unroll
                for (int u = 0; u < 32; ++u) wv[u] = w[(size_t)(k0 + u) * 6144];
#pragma unroll
                for (int u = 0; u < 32; ++u)
#pragma unroll
                    for (int r = 0; r < 5; ++r) a[r] += sil[r * 1024 + F.wid * 128 + k0 + u] * wv[u];
            }
#pragma unroll
            for (int r = 0; r < 5; ++r) red[(F.wid * 5 + r) * 64 + F.lane] = a[r];
            __syncthreads();
            if (F.tid < 320) { const int r = F.tid >> 6, ln = F.tid & 63; float s = 0.f;
#pragma unroll
                for (int w8 = 0; w8 < 8; ++w8) s += red[(w8 * 5 + r) * 64 + ln];
                F_mod[(size_t)(l * 5 + r) * 6144 + j0 + ln] = s + PP(ada_b)[l * 6144 + j0 + ln]; }
            __syncthreads();
        } else if (it < N_ADA + N_CONST) {
            const int gt = (it - N_ADA) * 512 + F.tid;
            for (int e = gt; e < 32768; e += 4096) {
                const int row = e >> 7, kk = e & 127;
                float v1 = 0.f, v2 = 0.f;
                if (row < 128) { const int ro = row >> 6, k1 = row & 63, n1 = kk >> 1, ri = kk & 1; const float ph = (float)((n1 * k1) & 63) / 32.f; const float cs = cospif(ph), sn = sinpif(ph);
                    v1 = (ro == ri) ? cs : (ro == 0 ? sn : -sn); }
                if (row < 64) { const int ro = kk >> 6, n2 = kk & 63; const float ph = (float)((row * n2) & 63) / 32.f; v2 = ro == 0 ? cospif(ph) : sinpif(ph); }
                F_M1[e] = (bf16_t)(pk2(v1, 0.f) & 0xffffu); F_M2[e] = (bf16_t)(pk2(v2, 0.f) & 0xffffu);
            }
            if (gt < 1024) { const int pos = gt >> 4, f = gt & 15; const double ang = (double)pos * pow(10000.0, -(double)f / 16.0); F_ROPE[gt] = (f32x2){(float)cos(ang), (float)sin(ang)}; }
            { const float ph = (float)gt / 2048.f; F_TW[gt] = (f32x2){cospif(ph), sinpif(ph)}; }
        } else if (it >= N_ADA + N_CONST + N_FOLD) {
            int ci = it - (N_ADA + N_CONST + N_FOLD); const float* src; bf16_t* dst; int sld, dld, ncol;
            if (ci < 144) { src = PP(even_w_in); dst = (bf16_t*)(F.ws + WB_EIN); sld = EVEN_IN; dld = EVEN_IN; ncol = EVEN_IN; }
            else if (ci < 208) { ci -= 144; src = PP(even_w_out); dst = (bf16_t*)(F.ws + WB_EOUT); sld = D; dld = D; ncol = D; }
            else if (ci < 304) { ci -= 208; src = PP(odd_w_in); dst = (bf16_t*)(F.ws + WB_OIN); sld = 2048; dld = 2560; ncol = 1536; }
            else { ci -= 304; src = PP(odd_w_out); dst = (bf16_t*)(F.ws + WB_OOUT); sld = D; dld = D; ncol = D; }
            const int q4 = ncol >> 2;
#pragma unroll
            for (int u = 0; u < 8; ++u) { const int gidx = ci * 4096 + u * 512 + F.tid, row = gidx / q4, c4 = (gidx - row * q4) * 4;
                const f32x4 v = *(const f32x4*)(src + (size_t)row * sld + c4); u32x2 w; w.x = pk2(v[0], v[1]); w.y = pk2(v[2], v[3]); *(u32x2*)(dst + (size_t)row * dld + c4) = w; }
        } else {
            const int fi = it - N_ADA - N_CONST, rc = fi >> 2, g = fi & 3, half = F.tid >> 8, j = F.tid & 255, jj = j & 127;
            for (int i2 = 0; i2 < 8; ++i2) {
                const int row = rc * 16 + i2 * 2 + half;
                const float* wr_ = PP(odd_w_in) + (size_t)row * 2048 + 1536 + g * 128;
                float s = 0.f;
                if (j < 128) { for (int cc = 0; cc < 128; ++cc) s += wr_[cc] * ct[(cc * jj) & 127]; }
                else { for (int cc = 0; cc < 128; ++cc) s -= wr_[cc] * ct[((cc * jj) - 32) & 127]; }
                ((bf16_t*)(F.ws + WB_OIN))[(size_t)row * 2560 + 1536 + g * 256 + j] = (bf16_t)(pk2(s, 0.f) & 0xffffu);
            }
        }
    }
}

__device__ __forceinline__ void phase_norm1_l0(Frame& F) {
    const int gw = F.bid * 8 + F.wid, NGW = F.G * 8;
    for (int row = gw; row < NTOK; row += NGW) {
        const float* src = row < NMAIN ? PP(x) + (size_t)row * D : PP(ctx) + (size_t)(row - NMAIN) * D;
        f32x4 v[4];
#pragma unroll
        for (int j = 0; j < 4; ++j) v[j] = *(const f32x4*)(src + 4 * F.lane + 256 * j);
        const float rstd = row_rstd(v); const int r = mod_row(row);
        norm_mod_store(v, rstd, PP(norm_mix), modp(F, 0, r, 1), modp(F, 0, r, 0), F_H + (size_t)row * D, F.lane);
    }
}

#define EPI_GEOM const int wid = this->wid, lane = this->lane, wr = wid >> 2, wc = wid & 3, fr = lane & 15, fq = lane >> 4; (void)wr; (void)wc; (void)fr; (void)fq
struct PolBase { unsigned char* ws; LAS unsigned char* lds; int wid, lane, nt; unsigned lcolb, woff, ldbB; XOrder xo; int aC, aR0, aCb, aR0b; bool bfm;
    __device__ __forceinline__ void base_init(Frame& F, int nt_, int T) { ws = F.ws; lds = F.lds; wid = F.wid; lane = F.lane; nt = nt_; lcolb = 16u * (unsigned)F.lane; woff = 8u * (unsigned)F.lane;
        xo.init(T, F.G, F.bid); aC = a_piece_col(F.wid, F.lane); aR0 = a_piece_row0(F.wid, F.lane); bfm = true;
        { const int sbb = F.lane * 16, swz = sbb ^ (((sbb >> 9) & 1) << 5); aR0b = F.wid * 32 + (swz >> 6); aCb = (swz & 63) >> 1; } }
    bool has_bias = false; const float* bias = nullptr;
    bool has_list = false; const int* listp = nullptr;
    __device__ __forceinline__ unsigned list_voff(const TD&) const { return 0u; }
    __device__ __forceinline__ void late(TD&, const LAS int*) const {}
    __device__ __forceinline__ unsigned bias_voff(const TD&) const { return 0u; }
    __device__ __forceinline__ bool tileL(int i, int& L) const { L = xo.cur + i * xo.step; return L < xo.c1; }
    __device__ __forceinline__ int prow(int i) const { return bfm ? aR0b + 16 * (i & 1) : aR0 + 64 * i; }
    __device__ __forceinline__ int pcol() const { return bfm ? aCb : aC; }
    __device__ __forceinline__ void dense_aoff(TD& td, int row0, int pitch) const {
#pragma unroll
        for (int i = 0; i < 4; ++i) td.aoff[i] = (unsigned)(((row0 + prow(i)) * pitch + pcol()) * 2); }
};

struct PolInproj0 : PolBase {
    const float* W; Frame* Fp;
    __device__ __forceinline__ bool get(int i, TD& td) const { int L; if (!tileL(i, L)) return false; int pm, pn; dense_tile(L, NTOK / 256, EVEN_IN / 256, pm, pn);
        td.A = (const bf16_t*)(ws + WS_H); dense_aoff(td, pm * 256, D); td.B = (const bf16_t*)(ws + WB_EIN) + pn * 256; td.i0 = pm; td.i1 = pn; return true; }
    __device__ __forceinline__ void epi(f32x4 (&acc)[8][4], const TD& td, const LAS float* bl) const { (void)bl; EPI_GEOM; const int pm = td.i0, pn = td.i1;
        const int colb = pn * 256 + wc * 64; const bool rope = (colb < 640) && (pm < NMAIN / 256);
        const LAS f32x2* ROPE = (const LAS f32x2*)(lds + ROPE_LDS); bf16_t* PROJ = (bf16_t*)(ws + WS_PROJ);
#pragma unroll
        for (int m = 0; m < 8; ++m) { const int row = pm * 256 + wr * 128 + m * 16 + fr;
            if (rope) { const int tt = row & (SEQ - 1), gr = tt >> 6, gc = tt & 63;
#pragma unroll
                for (int n = 0; n < 2; ++n) { const int pos = n == 0 ? gr : gc;
#pragma unroll
                    for (int j = 0; j < 4; ++j) { const f32x2 cs = ROPE[pos * 16 + 4 * fq + j]; const float x1 = acc[m][n][j], x2 = acc[m][n + 2][j];
                        acc[m][n][j] = x1 * cs.x - x2 * cs.y; acc[m][n + 2][j] = x2 * cs.x + x1 * cs.y; } } }
#pragma unroll
            for (int n = 0; n < 4; ++n) { u32x2 w; w.x = pk2(acc[m][n][0], acc[m][n][1]); w.y = pk2(acc[m][n][2], acc[m][n][3]);
                *(u32x2*)(PROJ + (size_t)row * EVEN_IN + colb + n * 16 + 4 * fq) = w; } } }
};
__device__ __forceinline__ void phase_inproj_l0(Frame& F) {
    for (int i = F.tid; i < 1024; i += 512) ((LAS f32x2*)(F.lds + ROPE_LDS))[i] = F_ROPE[i];
    __syncthreads();
    PolInproj0 P; P.base_init(F, D / 64, (NTOK / 256) * (EVEN_IN / 256)); P.ldbB = EVEN_IN;
    gemm_stream_bf(F.lds, P, F.wid, F.lane);
}

struct PolOutproj : PolBase {
    const float *W, *x, *ctx; int layer, nM;
    __device__ __forceinline__ bool get(int i, TD& td) const { int L; if (!tileL(i, L)) return false; int pm, pn; dense_tile(L, nM, 4, pm, pn);
        td.A = (const bf16_t*)(ws + WS_MIX); dense_aoff(td, pm * 256, D); td.B = (const bf16_t*)(ws + (layer == 0 ? WB_EOUT : WB_OOUT)) + pn * 256; td.i0 = pm; td.i1 = pn; return true; }
    __device__ __forceinline__ void epi(f32x4 (&acc)[8][4], const TD& td, const LAS float* bl) const { (void)bl; EPI_GEOM; const int pm = td.i0, pn = td.i1;
        const int colb = pn * 256 + wc * 64; float* XS = (float*)(ws + WS_XS); const float* mod = (const float*)(ws + WS_MOD);
#pragma unroll
        for (int m = 0; m < 8; ++m) { const int row = pm * 256 + wr * 128 + m * 16 + fr; const int r = mod_row(row);
            const float* xin = layer == 0 ? (row < NMAIN ? x + (size_t)row * D : ctx + (size_t)(row - NMAIN) * D) : XS + (size_t)row * D;
            const float* g1 = mod + ((size_t)(layer * 5 + r)) * 6144 + 2 * 1024;
#pragma unroll
            for (int n = 0; n < 4; ++n) { const int c = colb + n * 16 + 4 * fq; const f32x4 xv = *(const f32x4*)(xin + c), gv = *(const f32x4*)(g1 + c);
                f32x4 o;
#pragma unroll
                for (int j = 0; j < 4; ++j) o[j] = xv[j] + gv[j] * acc[m][n][j];
                *(f32x4*)(XS + (size_t)row * D + c) = o; } } }
};
__device__ __forceinline__ void phase_outproj(Frame& F, const int layer) {
    PolOutproj P; P.layer = layer; P.nM = (layer == 0 ? NTOK : NMAIN) / 256; P.base_init(F, D / 64, P.nM * 4);
    P.ldbB = D; P.x = PP(x); P.ctx = PP(ctx);
    gemm_stream_bf(F.lds, P, F.wid, F.lane);
}

template <int Q> struct AttnStT { f32x4 o[4][Q]; float m[Q], l[Q]; };
#define V_ROWB 160
__device__ __forceinline__ void v_stage(LAS unsigned char* vl, const bf16_t* vsrc, int ld, int lane) {
    i32x4 t[4];
    asm volatile("" ::: "memory");
#pragma unroll
    for (int i = 0; i < 4; ++i) t[i] = *(const i32x4*)(vsrc + (size_t)((lane >> 3) + 8 * i) * ld + (lane & 7) * 8);
#pragma unroll
    for (int i = 0; i < 4; ++i) *(LAS i32x4*)(vl + ((lane >> 3) + 8 * i) * V_ROWB + (lane & 7) * 16) = t[i];
    asm volatile("s_waitcnt lgkmcnt(0)" ::: "memory");
}
#define ATTN_STEP(ksrc, kld, vsrc, vld, SCALE, BIAS, SKIP) do { \
    bf16x8 kf[2][2]; \
    _Pragma("unroll") for (int kt = 0; kt < 2; ++kt) _Pragma("unroll") for (int ks = 0; ks < 2; ++ks) \
        kf[kt][ks] = *(const bf16x8*)((ksrc) + (size_t)(kt * 16 + fr) * (kld) + ks * 32 + 8 * fq); \
    v_stage(vl, (vsrc), (vld), lane); \
    bf16x8 vf[4]; \
    _Pragma("unroll") for (int dt = 0; dt < 4; ++dt) { \
        const s16x4 lo = __builtin_amdgcn_ds_read_tr16_b64_v4i16((LAS s16x4*)(vl + (4 * fq + (fr >> 2)) * V_ROWB + (dt * 16 + (fr & 3) * 4) * 2)); \
        const s16x4 hi = __builtin_amdgcn_ds_read_tr16_b64_v4i16((LAS s16x4*)(vl + (16 + 4 * fq + (fr >> 2)) * V_ROWB + (dt * 16 + (fr & 3) * 4) * 2)); \
        vf[dt] = (bf16x8){lo[0], lo[1], lo[2], lo[3], hi[0], hi[1], hi[2], hi[3]}; } \
    _Pragma("unroll") for (int qt = 0; qt < QTL; ++qt) { if (SKIP(qt)) continue;        \
        f32x4 s[2]; \
        _Pragma("unroll") for (int kt = 0; kt < 2; ++kt) { s[kt] = (f32x4){0.f, 0.f, 0.f, 0.f}; \
            _Pragma("unroll") for (int ks = 0; ks < 2; ++ks) s[kt] = __builtin_amdgcn_mfma_f32_16x16x32_bf16(kf[kt][ks], qf[qt][ks], s[kt], 0, 0, 0); } \
        float mx = -INFINITY; \
        _Pragma("unroll") for (int kt = 0; kt < 2; ++kt) _Pragma("unroll") for (int j = 0; j < 4; ++j) { const float tv = s[kt][j] * (SCALE) + BIAS(qt, kt, j); s[kt][j] = tv; mx = fmaxf(mx, tv); } \
        mx = fmaxf(mx, __shfl_xor(mx, 16)); mx = fmaxf(mx, __shfl_xor(mx, 32)); \
        const float mn = fmaxf(st.m[qt], mx), al = fexp2(st.m[qt] - mn); st.m[qt] = mn; \
        float ps = 0.f; \
        _Pragma("unroll") for (int kt = 0; kt < 2; ++kt) _Pragma("unroll") for (int j = 0; j < 4; ++j) { const float pv = fexp2(s[kt][j] - mn); s[kt][j] = pv; ps += pv; } \
        st.l[qt] = st.l[qt] * al + ps; \
        const unsigned w0 = pk2(s[0][0], s[0][1]), w1 = pk2(s[0][2], s[0][3]), w2 = pk2(s[1][0], s[1][1]), w3 = pk2(s[1][2], s[1][3]); \
        const bf16x8 pf = __builtin_bit_cast(bf16x8, ((u32x4){w0, w1, w2, w3})); \
        _Pragma("unroll") for (int dt = 0; dt < 4; ++dt) st.o[dt][qt] = __builtin_amdgcn_mfma_f32_16x16x32_bf16(vf[dt], pf, st.o[dt][qt] * al, 0, 0, 0); } \
    } while (0)

template <int QTL>
__device__ __forceinline__ void attn_store(AttnStT<QTL>& st, bf16_t* dst  , int dld, int fr, int fq) {
#pragma unroll
    for (int qt = 0; qt < QTL; ++qt) {
        float l = st.l[qt]; l += __shfl_xor(l, 16); l += __shfl_xor(l, 32);
        const float inv = 1.f / l;
#pragma unroll
        for (int dt = 0; dt < 4; ++dt) { const f32x4 o = st.o[dt][qt] * inv; u32x2 w; w.x = pk2(o[0], o[1]); w.y = pk2(o[2], o[3]);
            *(u32x2*)(dst + (size_t)(qt * 16 + fr) * dld + dt * 16 + 4 * fq) = w; }
    }
}

__device__ __forceinline__ void phase_attn_l0(Frame& F) {
    constexpr int QTL = 2;
    const int wid = F.wid, lane = F.lane, fr = lane & 15, fq = lane >> 4;
    LAS unsigned char* vl = F.lds + wid * 8192;
    constexpr int NPASS = 4 / QTL, N_WIN = 256 * NPASS, N_CTXA = 16 * NPASS, N_CONV = NTOK / 64;
    const float SC = 0.125f * LOG2E;
    for (int it = F.bid; it < N_WIN + N_CTXA + N_CONV; it += F.G) {
        if (it < N_WIN + N_CTXA) {
            const bool isctx = it >= N_WIN;
            int b, kvh, qb, qh;
            if (!isctx) { const int c = it / NPASS; qh = it - c * NPASS; b = c >> 6; kvh = (c >> 5) & 1; qb = c & 31; } else { const int c2 = it - N_WIN, c = c2 / NPASS; qh = c2 - c * NPASS; b = c >> 2; kvh = (c >> 1) & 1; qb = c & 1; }
            const int g = wid >> 1, h = kvh * 4 + g;
            {
            const int qq0 = (wid & 1) * 64 + qh * (16 * QTL);
            const int qrow0 = (isctx ? NMAIN + b * CTXL : b * SEQ) + qb * 128 + qq0;
            bf16x8 qf[QTL][2];
#pragma unroll
            for (int qt = 0; qt < QTL; ++qt)
#pragma unroll
                for (int ks = 0; ks < 2; ++ks) qf[qt][ks] = *(const bf16x8*)(F_PROJ + (size_t)(qrow0 + qt * 16 + fr) * EVEN_IN + h * 64 + ks * 32 + 8 * fq);
            AttnStT<QTL> st;
            const float sink = PP(even_sink)[h] * LOG2E;
#pragma unroll
            for (int qt = 0; qt < QTL; ++qt) { st.m[qt] = sink; st.l[qt] = (fq == 0) ? 1.f : 0.f;
#pragma unroll
                for (int dt = 0; dt < 4; ++dt) st.o[dt][qt] = (f32x4){0.f, 0.f, 0.f, 0.f}; }
            const int kcol = 512 + kvh * 64, vcol = 640 + kvh * 64;
            for (int ch = isctx ? 3 : 0; ch < 5; ++ch) {
                int krow0;
                if (ch < 3) { const int kb = qb - 1 + ch; if (kb < 0 || kb >= SEQ / 128) continue; krow0 = b * SEQ + kb * 128; } else krow0 = NMAIN + b * CTXL + (ch - 3) * 128;
                for (int s32 = 0; s32 < 4; ++s32) {
                    const bf16_t* kp = F_PROJ + (size_t)(krow0 + s32 * 32) * EVEN_IN + kcol;
                    const bf16_t* vp = F_PROJ + (size_t)(krow0 + s32 * 32) * EVEN_IN + vcol;
                    if (ch == 0) {
#define SKIP_NONE(qt) false
#define SKIP_PREV(qt) ((s32 * 32 + 31) < (qq0 + qt * 16))
#define SKIP_NEXT(qt) ((s32 * 32) > (qq0 + qt * 16 + 15))
#define BIAS_PREV(qt, kt, j) ((s32 * 32 + kt * 16 + 4 * fq + j) >= (qq0 + qt * 16 + fr) ? 0.f : -INFINITY)
                        ATTN_STEP(kp, EVEN_IN, vp, EVEN_IN, SC, BIAS_PREV, SKIP_PREV);
                    } else if (ch == 2) {
#define BIAS_NEXT(qt, kt, j) ((s32 * 32 + kt * 16 + 4 * fq + j) <= (qq0 + qt * 16 + fr) ? 0.f : -INFINITY)
                        ATTN_STEP(kp, EVEN_IN, vp, EVEN_IN, SC, BIAS_NEXT, SKIP_NEXT);
                    } else {
#define BIAS_NONE(qt, kt, j) 0.f
                        ATTN_STEP(kp, EVEN_IN, vp, EVEN_IN, SC, BIAS_NONE, SKIP_NONE);
                    }
                }
            }
            attn_store(st, F_MIX + (size_t)qrow0 * D + h * 64, D, fr, fq);
            }
        } else {
            const int ci = it - N_WIN - N_CTXA, c4 = (F.tid & 127) * 4, r0 = ci * 64 + (F.tid >> 7) * 16;
            const f32x4 w0 = *(const f32x4*)(PP(even_conv_w) + c4), w1 = *(const f32x4*)(PP(even_conv_w) + 512 + c4), w2 = *(const f32x4*)(PP(even_conv_w) + 1024 + c4);
#define LOADZ(dst, row_) do { const u32x2 gc_ = *(const u32x2*)(F_PROJ + (size_t)(row_) * EVEN_IN + 1280 + c4), uu_ = *(const u32x2*)(F_PROJ + (size_t)(row_) * EVEN_IN + 1792 + c4); \
                dst = (f32x4){bflo(gc_.x) * bflo(uu_.x), bfhi(gc_.x) * bfhi(uu_.x), bflo(gc_.y) * bflo(uu_.y), bfhi(gc_.y) * bfhi(uu_.y)}; } while (0)
            const int seqmask = r0 < NMAIN ? (SEQ - 1) : (CTXL - 1);
            u32x2 gcv[18], uuv[18], gbv[16];
#pragma unroll
            for (int i = 0; i < 18; ++i) { const int row = r0 - 1 + i; const bool ok = (i == 0) ? ((r0 & seqmask) != 0) : (i == 17) ? (((r0 + 15) & seqmask) != seqmask) : true;
                const int rr = ok ? row : r0;
                gcv[i] = *(const u32x2*)(F_PROJ + (size_t)rr * EVEN_IN + 1280 + c4); uuv[i] = *(const u32x2*)(F_PROJ + (size_t)rr * EVEN_IN + 1792 + c4);
                if (!ok) { gcv[i] = (u32x2){0u, 0u}; } }
#pragma unroll
            for (int i = 0; i < 16; ++i) gbv[i] = *(const u32x2*)(F_PROJ + (size_t)(r0 + i) * EVEN_IN + 768 + c4);
            __builtin_amdgcn_sched_barrier(0);
#define ZOF(i_) ((f32x4){bflo(gcv[i_].x) * bflo(uuv[i_].x), bfhi(gcv[i_].x) * bfhi(uuv[i_].x), bflo(gcv[i_].y) * bflo(uuv[i_].y), bfhi(gcv[i_].y) * bfhi(uuv[i_].y)})
            f32x4 zp = ZOF(0), zc = ZOF(1);
#pragma unroll
            for (int i = 0; i < 16; ++i) {
                const int row = r0 + i;
                const f32x4 zn = ZOF(i + 2);
                const u32x2 gb = gbv[i];
                const f32x4 y = zp * w0 + zc * w1 + zn * w2;
                u32x2 w; w.x = pk2(bflo(gb.x) * y[0], bfhi(gb.x) * y[1]); w.y = pk2(bflo(gb.y) * y[2], bfhi(gb.y) * y[3]);
                *(u32x2*)(F_MIX + (size_t)row * D + 512 + c4) = w;
                zp = zc; zc = zn;
            }
#undef ZOF
        }
    }
}

constexpr int RW_LD = 1028;
__device__ __forceinline__ void phase_route(Frame& F, const int layer) {
    const int nrows = layer == 0 ? NTOK : NMAIN;
    LAS float* rwT = (LAS float*)F.lds;
    LAS int* cntL = (LAS int*)(F.lds + 32 * RW_LD * 4);
    LAS int* baseL = cntL + 32;
    LAS int* selE = baseL + 32;
    LAS int* selR = selE + 384;
    const float* rw = PP(router_w) + (size_t)layer * D * NEXP;
    { const f32x4* rsrc4 = (const f32x4*)rw + F.tid; LAS float* wp = rwT + ((4 * F.tid) & 31) * RW_LD + (F.tid >> 3);
      for (int it = 0; it < 4; ++it) {
        f32x4 v[4];
#pragma unroll
        for (int u = 0; u < 4; ++u) v[u] = rsrc4[(it * 4 + u) * 512];
#pragma unroll
        for (int u = 0; u < 4; ++u)
#pragma unroll
            for (int j = 0; j < 4; ++j) wp[it * 256 + u * 64 + j * RW_LD] = v[u][j];
        asm volatile("" ::: "memory"); } }
    if (F.tid < 32) cntL[F.tid] = 0;
    __syncthreads();
    const int lane = F.lane, gw = F.bid * 8 + F.wid, NGW = F.G * 8;
    const float* gam = PP(norm_ffn) + layer * D;
    int slot = F.wid;
    const float* Wd = PP(moe_w_dn) + (size_t)layer * NEXP * DFF * D; bf16_t* pd = (bf16_t*)(F.ws + WS_BC2);
    constexpr int CV_TOTAL = NEXP * 4 * 1024;
    const int cv_q = (CV_TOTAL + NGW - 1) / NGW, cv_end = min((gw + 1) * cv_q, CV_TOTAL); int cv_u = gw * cv_q;
#define CV_LOAD(v_, u0_) do { _Pragma("unroll") for (int u = 0; u < 8; ++u) { const int pr = min((u0_) + u, CV_TOTAL - 1), pnl = pr >> 10, k = pr & 1023, e = pnl >> 2, ct = pnl & 3; \
        v_[u] = *(const f32x4*)(Wd + ((size_t)e * DFF + k) * D + ct * 256 + 4 * lane); } } while (0)
#define CV_STORE(v_, u0_, uend_) do { _Pragma("unroll") for (int u = 0; u < 8; ++u) { const int pr = (u0_) + u; if (pr < (uend_)) { u32x2 w; w.x = pk2(v_[u][0], v_[u][1]); w.y = pk2(v_[u][2], v_[u][3]); \
        *(u32x2*)(pd + (size_t)pr * 256 + 4 * lane) = w; } } } while (0)
    f32x4 vn[4];
    if (gw < nrows) {
#pragma unroll
        for (int j = 0; j < 4; ++j) vn[j] = *(const f32x4*)(F_XS + (size_t)gw * D + 4 * lane + 256 * j); }
    for (int row = gw; row < nrows; row += NGW, slot += 8) {
        f32x4 v[4], h[4], cvv[8];
        const int cv_u0 = cv_u; CV_LOAD(cvv, cv_u0); cv_u += 8;
#pragma unroll
        for (int j = 0; j < 4; ++j) v[j] = vn[j];
        if (row + NGW < nrows) {
#pragma unroll
            for (int j = 0; j < 4; ++j) vn[j] = *(const f32x4*)(F_XS + (size_t)(row + NGW) * D + 4 * lane + 256 * j); }
        const float rstd = row_rstd(v); const int r = mod_row(row);
        norm_mod_store(v, rstd, gam, modp(F, layer, r, 4), modp(F, layer, r, 3), F_H + (size_t)row * D, lane, &h);
        float pe[32];
#pragma unroll
        for (int e = 0; e < 32; ++e) { float s = 0.f;
            f32x2 s2 = (f32x2){0.f, 0.f};
#pragma unroll
            for (int j = 0; j < 4; ++j) { const f32x4 w = *(const LAS f32x4*)(rwT + e * RW_LD + 4 * lane + 256 * j);
                s2 = __builtin_elementwise_fma((f32x2){h[j][0], h[j][1]}, (f32x2){w[0], w[1]}, s2); s2 = __builtin_elementwise_fma((f32x2){h[j][2], h[j][3]}, (f32x2){w[2], w[3]}, s2); }
            s = s2.x + s2.y;
            pe[e] = s; if ((e & 3) == 3) __builtin_amdgcn_sched_barrier(0); }
        float q16[16], q8[8], q4[4], q2[2], q1;
        { const bool hi = lane & 32;
#pragma unroll
          for (int i = 0; i < 16; ++i) { const float snd = hi ? pe[i] : pe[16 + i], mine = hi ? pe[16 + i] : pe[i]; q16[i] = mine + __shfl_xor(snd, 32); } }
        { const bool hi = lane & 16;
#pragma unroll
          for (int i = 0; i < 8; ++i) { const float snd = hi ? q16[i] : q16[8 + i], mine = hi ? q16[8 + i] : q16[i]; q8[i] = mine + __shfl_xor(snd, 16); } }
        { const bool hi = lane & 8;
#pragma unroll
          for (int i = 0; i < 4; ++i) { const float snd = hi ? q8[i] : q8[4 + i], mine = hi ? q8[4 + i] : q8[i]; q4[i] = mine + __shfl_xor(snd, 8); } }
        { const bool hi = lane & 4;
#pragma unroll
          for (int i = 0; i < 2; ++i) { const float snd = hi ? q4[i] : q4[2 + i], mine = hi ? q4[2 + i] : q4[i]; q2[i] = mine + __shfl_xor(snd, 4); } }
        { const bool hi = lane & 2; const float snd = hi ? q2[0] : q2[1], mine = hi ? q2[1] : q2[0]; q1 = mine + __shfl_xor(snd, 2); }
        q1 += __shfl_xor(q1, 1);
        const int myE = (lane >> 1) & 31;
        float val = q1 + PP(router_b)[layer * NEXP + myE];
        float tv[4]; int te[4];
        { int rank = 0; const int vb = __builtin_bit_cast(int, val);
#pragma unroll
          for (int e2 = 0; e2 < 32; ++e2) { const float o = __builtin_bit_cast(float, __builtin_amdgcn_readlane(vb, 2 * e2)); rank += (o > val || (o == val && e2 < myE)) ? 1 : 0; }
#pragma unroll
          for (int k = 0; k < 4; ++k) { const unsigned long long mk = __ballot(rank == k); const int src = __builtin_amdgcn_readfirstlane((int)__builtin_ctzll(mk));
              tv[k] = __builtin_bit_cast(float, __builtin_amdgcn_readlane(vb, src)); te[k] = (src >> 1) & 31; } }
        const float e1 = __expf(tv[1] - tv[0]), e2 = __expf(tv[2] - tv[0]), e3 = __expf(tv[3] - tv[0]), inv = 1.f / (1.f + e1 + e2 + e3);
        if (lane == 0) {
            *(f32x4*)(F_TOPW + (size_t)row * 4) = (f32x4){inv, e1 * inv, e2 * inv, e3 * inv};
#pragma unroll
            for (int k = 0; k < 4; ++k) { selE[slot * 4 + k] = te[k]; selR[slot * 4 + k] = atomicAdd((int*)(cntL + te[k]), 1); }
        }
        CV_STORE(cvv, cv_u0, cv_end);
    }
    for (; cv_u < cv_end; cv_u += 8) { f32x4 cvv[8]; CV_LOAD(cvv, cv_u); CV_STORE(cvv, cv_u, cv_end); }
#undef CV_LOAD
#undef CV_STORE
    __syncthreads();
    if (F.tid < 32) { const int c = cntL[F.tid]; baseL[F.tid] = c ? (int)atomicAdd(F_cnt + layer * 32 + F.tid, (unsigned)c) : 0; }
    __syncthreads();
    if (F.tid < 384) { const int s = F.tid >> 2, k = F.tid & 3; const int row = F.bid * 8 + (s & 7) + (s >> 3) * NGW;
        if (row < nrows) { const int e = selE[F.tid], pos = baseL[e] + selR[F.tid]; F_POS[(size_t)row * 4 + k] = e | (pos << 8); F_LIST[(size_t)e * NTOK + pos] = row; } }
    __syncthreads();
}

struct MoeLds { LAS int *mtp, *roff, *mtq, *nz; };
__device__ __forceinline__ MoeLds moe_lds(Frame& F) { MoeLds L; L.mtp = (LAS int*)(F.lds + 2 * STAGE_B); L.roff = L.mtp + 40; L.mtq = L.roff + 40; L.nz = L.mtq + 40; return L; }
__device__ __forceinline__ void moe_prefix(Frame& F, const int layer, const MoeLds& L) {
    if (F.tid < 64) { const int e = F.lane & 31; const int c = (int)__hip_atomic_load(F_cnt + layer * 32 + e, __ATOMIC_RELAXED, __HIP_MEMORY_SCOPE_AGENT);
        const int mt = (c + 255) >> 8; int a = mt, b = c, q = mt > 0 ? mt - 1 : 0, z = mt > 0 ? 1 : 0;
#pragma unroll
        for (int o = 1; o < 32; o <<= 1) { const int ua = __shfl_up(a, o, 32), ub = __shfl_up(b, o, 32), uq = __shfl_up(q, o, 32), uz = __shfl_up(z, o, 32); if (e >= o) { a += ua; b += ub; q += uq; z += uz; } }
        if (F.lane < 32) { L.mtp[e + 1] = a; L.roff[e + 1] = b; L.mtq[e + 1] = q; if (mt > 0) L.nz[z - 1] = e; if (e == 31) L.nz[32] = z; if (e == 0) { L.mtp[0] = 0; L.roff[0] = 0; L.mtq[0] = 0; } } }
    __syncthreads();
}
struct PolMoe : PolBase {
    const float* W; MoeLds L; int layer, nct, round; size_t bc_off; mutable int ehint = 0;
    __device__ __forceinline__ bool find(int i, int& e, int& ct, int& rbase, int& ro, int& cnt) const { int T; if (!tileL(i, T)) return false;
        if (round == 0) { const int q = T / nct; ct = T - q * nct; e = __builtin_amdgcn_readfirstlane(L.nz[q]); rbase = 0; }
        else { LAS int* pf = round == 1 ? L.mtq : L.mtp; e = ehint; while (pf[e + 1] * nct <= T) ++e;
            ehint = e;
            e = __builtin_amdgcn_readfirstlane(e);
            const int mq = __builtin_amdgcn_readfirstlane(pf[e + 1] - pf[e]), w = T - __builtin_amdgcn_readfirstlane(pf[e]) * nct; ct = w / mq; rbase = ((round == 1 ? 1 : 0) + w - ct * mq) * 256; }
        ro = __builtin_amdgcn_readfirstlane(L.roff[e]); cnt = __builtin_amdgcn_readfirstlane(L.roff[e + 1]) - ro; return true; }
    __device__ __forceinline__ bf16_t* panel(int e, int ct) const { return (bf16_t*)(ws + bc_off) + (size_t)(e * nct + ct) * (1024 * 256); }
};
struct PolMoe1 : PolMoe {
    __device__ __forceinline__ unsigned list_voff(const TD& td) const { return 4u * (unsigned)(td.i0 * NTOK + td.i2 + lane * 4); }
    __device__ __forceinline__ void late(TD& td, const LAS int* ll) const { const int cl = td.i4 - 1 - td.i2;
#pragma unroll
        for (int i2 = 0; i2 < 2; ++i2) { int rl = prow(i2); rl = rl < cl ? rl : cl; td.aoff[i2] = (unsigned)((ll[rl] * D + pcol()) * 2); } }
    __device__ __forceinline__ unsigned bias_voff(const TD& td) const { return 4u * (unsigned)((layer * NEXP + td.i0) * (2 * DFF) + (lane >> 5) * DFF + td.i1 * 128 + (lane & 31) * 4); }
    __device__ __forceinline__ bool get(int i, TD& td) const { int e, ct, rbase, ro, cnt; if (!find(i, e, ct, rbase, ro, cnt)) return false;
        const int* list = (const int*)(ws + WS_LIST) + (size_t)e * NTOK; td.A = (const bf16_t*)(ws + WS_H);
        if (!has_list || i == 0) {
#pragma unroll
            for (int i2 = 0; i2 < 4; ++i2) { int rr = rbase + prow(i2); rr = rr < cnt ? rr : cnt - 1; td.aoff[i2] = (unsigned)((list[rr] * D + pcol()) * 2); } }
        if (round == 0) { td.B = W + ((size_t)(layer * NEXP + e) * D + wid * 8) * (2 * DFF) + ct * 128; td.ldb = 2 * DFF; td.bco = panel(e, ct); } else { td.B = panel(e, ct); td.bco = nullptr; }
        td.i0 = e; td.i1 = ct; td.i2 = rbase; td.i3 = ro; td.i4 = cnt; return true; }
    __device__ __forceinline__ void epi(f32x4 (&acc)[8][4], const TD& td, const LAS float* bl) const { (void)bl; EPI_GEOM; const int e = td.i0, ct = td.i1, rbase = td.i2, ro = td.i3, cnt = td.i4;
        bf16_t* ACT = (bf16_t*)(ws + WS_ACT);
#pragma unroll
        for (int n = 0; n < 2; ++n) { const int gc = ct * 128 + wc * 32 + n * 16 + 4 * fq;
            const int gl = wc * 32 + n * 16 + 4 * fq; const f32x4 bg = bl ? *(const LAS f32x4*)(bl + gl) : *(const f32x4*)(bias + (size_t)(layer * NEXP + e) * (2 * DFF) + gc), bu = bl ? *(const LAS f32x4*)(bl + 128 + gl) : *(const f32x4*)(bias + (size_t)(layer * NEXP + e) * (2 * DFF) + DFF + gc);
#pragma unroll
            for (int m = 0; m < 8; ++m) { const int r = rbase + wr * 128 + m * 16 + fr; float a[4];
#pragma unroll
                for (int j = 0; j < 4; ++j) { const float gg = fminf(acc[m][n][j] + bg[j], 7.f), uu = __builtin_amdgcn_fmed3f(acc[m][n + 2][j] + bu[j], -7.f, 7.f);
                    a[j] = (uu + 1.f) * gg * __builtin_amdgcn_rcpf(1.f + fexp2(-1.702f * LOG2E * gg)); }
                if (r < cnt) { u32x2 w; w.x = pk2(a[0], a[1]); w.y = pk2(a[2], a[3]); *(u32x2*)(ACT + (size_t)(ro + r) * DFF + gc) = w; } } } }
};
struct PolMoe2 : PolMoe {
    __device__ __forceinline__ unsigned bias_voff(const TD& td) const { return 4u * (unsigned)((layer * NEXP + td.i0) * D + td.i1 * 256 + lane * 4); }
    __device__ __forceinline__ bool get(int i, TD& td) const { int e, ct, rbase, ro, cnt; if (!find(i, e, ct, rbase, ro, cnt)) return false;
        td.A = (const bf16_t*)(ws + WS_ACT);
#pragma unroll
        for (int i2 = 0; i2 < 4; ++i2) { int rr = rbase + prow(i2); rr = rr < cnt ? rr : cnt - 1; td.aoff[i2] = (unsigned)(((ro + rr) * DFF + pcol()) * 2); }
        td.B = panel(e, ct); td.bco = nullptr;
        td.i0 = e; td.i1 = ct; td.i2 = rbase; td.i3 = ro; td.i4 = cnt; return true; }
    __device__ __forceinline__ void epi(f32x4 (&acc)[8][4], const TD& td, const LAS float* bl) const { (void)bl; EPI_GEOM; const int e = td.i0, ct = td.i1, rbase = td.i2, ro = td.i3, cnt = td.i4;
        bf16_t* Y = (bf16_t*)(ws + WS_Y);
#pragma unroll
        for (int n = 0; n < 4; ++n) { const int c = ct * 256 + wc * 64 + n * 16 + 4 * fq; const f32x4 bv = bl ? *(const LAS f32x4*)(bl + wc * 64 + n * 16 + 4 * fq) : *(const f32x4*)(bias + (size_t)(layer * NEXP + e) * D + c);
#pragma unroll
            for (int m = 0; m < 8; ++m) { const int r = rbase + wr * 128 + m * 16 + fr;
                if (r < cnt) { u32x2 w; w.x = pk2(acc[m][n][0] + bv[0], acc[m][n][1] + bv[1]); w.y = pk2(acc[m][n][2] + bv[2], acc[m][n][3] + bv[3]); *(u32x2*)(Y + (size_t)(ro + r) * D + c) = w; } } } }
};
__device__ __forceinline__ void phase_moe1(Frame& F, const XcdBarrier& bar, const bool use_bar, const int layer) {
    const MoeLds L = moe_lds(F);
    moe_prefix(F, layer, L);
    const int ne = __builtin_amdgcn_readfirstlane(L.nz[32]), tq = __builtin_amdgcn_readfirstlane(L.mtq[32]);
    const float* W = PP(moe_w_gu); const float* bias = PP(moe_b_gu);
    { PolMoe1 P; P.L = L; P.layer = layer; P.nct = 8; P.round = 0; P.bc_off = WS_BC; P.base_init(F, D / 64, ne * 8); P.bfm = false; P.W = W; P.bias = bias;
      { const int l2 = F.lane & 31; P.lcolb = 4u * (unsigned)((F.lane >> 5) * DFF + 4 * l2); P.woff = 2u * (unsigned)(((4 * l2) >> 5) * 64 + (F.lane >> 5) * 32 + ((4 * l2) & 31)); }
      gemm_stream(F.lds, P, F.wid, F.lane); }
    if (use_bar) xcd_barrier(bar);
    { PolMoe1 P; P.L = L; P.layer = layer; P.nct = 8; P.round = 1; P.bc_off = WS_BC; P.base_init(F, D / 64, tq * 8); P.ldbB = 256; P.W = W; P.bias = bias; P.has_bias = true; P.has_list = true; P.listp = (const int*)(F.ws + WS_LIST);
      gemm_stream_bf(F.lds, P, F.wid, F.lane); }
}
__device__ __forceinline__ void phase_moe2(Frame& F, const int layer) {
    const MoeLds L = moe_lds(F);
    moe_prefix(F, layer, L);
    PolMoe2 P; P.L = L; P.layer = layer; P.nct = 4; P.round = 2; P.bc_off = WS_BC2; P.base_init(F, DFF / 64, __builtin_amdgcn_readfirstlane(L.mtp[32]) * 4); P.ldbB = 256; P.W = nullptr; P.bias = PP(moe_b_dn); P.has_bias = true;
    gemm_stream_bf(F.lds, P, F.wid, F.lane);
}

__device__ __forceinline__ void phase_combine(Frame& F, const int layer) {
    const MoeLds ML = moe_lds(F); LAS int* roff = ML.roff;
    moe_prefix(F, layer, ML);
    const int nrows = layer == 0 ? NTOK : NMAIN, lane = F.lane;
    const int gw = F.bid * 8 + F.wid, NGW = F.G * 8;
    i32x4 ps_n = (i32x4){0, 0, 0, 0}; f32x4 tw_n = (f32x4){0.f, 0.f, 0.f, 0.f}, tw_c = tw_n;
    u32x2 y_c[4][4], y_n[4][4]; f32x4 xs_c[4], xs_n[4];
#define CMB_IDX(row_) do { if ((row_) < nrows) { ps_n = *(const i32x4*)(F_POS + (size_t)(row_) * 4); tw_n = *(const f32x4*)(F_TOPW + (size_t)(row_) * 4); } } while (0)
#define CMB_DATA(row_, Y_, XS_) do { if ((row_) < nrows) { \
        _Pragma("unroll") for (int k = 0; k < 4; ++k) { const int e = ps_n[k] & 255, pos = ps_n[k] >> 8; const bf16_t* y = F_Y + (size_t)(roff[e] + pos) * D; \
            _Pragma("unroll") for (int j = 0; j < 4; ++j) Y_[k][j] = *(const u32x2*)(y + 4 * lane + 256 * j); } \
        _Pragma("unroll") for (int j = 0; j < 4; ++j) XS_[j] = *(const f32x4*)(F_XS + (size_t)(row_) * D + 4 * lane + 256 * j); } } while (0)
    CMB_IDX(gw); CMB_DATA(gw, y_c, xs_c); tw_c = tw_n; CMB_IDX(gw + NGW);
    for (int row = gw; row < nrows; row += NGW) {
        CMB_DATA(row + NGW, y_n, xs_n); const f32x4 tw_nn = tw_n; CMB_IDX(row + 2 * NGW);
        const int r = mod_row(row); const float* g2 = modp(F, layer, r, 5);
        f32x4 v[4];
#pragma unroll
        for (int j = 0; j < 4; ++j) v[j] = (f32x4){0.f, 0.f, 0.f, 0.f};
#pragma unroll
        for (int k = 0; k < 4; ++k) { const float w = tw_c[k];
#pragma unroll
            for (int j = 0; j < 4; ++j) { const u32x2 u = y_c[k][j]; v[j][0] += w * bflo(u.x); v[j][1] += w * bfhi(u.x); v[j][2] += w * bflo(u.y); v[j][3] += w * bfhi(u.y); } }
#pragma unroll
        for (int j = 0; j < 4; ++j) { const int c = 4 * lane + 256 * j; const f32x4 gv = *(const f32x4*)(g2 + c); v[j] = xs_c[j] + gv * v[j]; }
        const float rstd = row_rstd(v);
        if (layer == 0) {
#pragma unroll
            for (int j = 0; j < 4; ++j) *(f32x4*)(F_XS + (size_t)row * D + 4 * lane + 256 * j) = v[j];
            norm_mod_store(v, rstd, PP(norm_mix) + D, modp(F, 1, r, 1), modp(F, 1, r, 0), F_H + (size_t)row * D, lane);
        } else {
#pragma unroll
            for (int j = 0; j < 4; ++j) { const int c = 4 * lane + 256 * j; const f32x4 g = *(const f32x4*)(PP(final_norm) + c); *(f32x4*)(((float*)ldp(F, (int)__builtin_offsetof(Params, out))) + (size_t)row * D + c) = v[j] * rstd * g; }
        }
        tw_c = tw_nn;
#pragma unroll
        for (int k = 0; k < 4; ++k)
#pragma unroll
            for (int j = 0; j < 4; ++j) y_c[k][j] = y_n[k][j];
#pragma unroll
        for (int j = 0; j < 4; ++j) xs_c[j] = xs_n[j];
        __builtin_amdgcn_sched_barrier(0);
    }
#undef CMB_IDX
#undef CMB_DATA
}

struct PolInproj1 : PolBase {
    const float* W;
    __device__ __forceinline__ bool get(int i, TD& td) const { int t; if (!tileL(i, t)) return false; constexpr int N_MAIN_T = (NMAIN / 256) * 10; int pm, pn;
        if (t < N_MAIN_T) dense_tile(t, NMAIN / 256, 10, pm, pn); else { const int c = t - N_MAIN_T; pm = NMAIN / 256 + (c & 3); pn = 2 + (c >> 2); }
        td.A = (const bf16_t*)(ws + WS_H); dense_aoff(td, pm * 256, D);
        td.B = (const bf16_t*)(ws + WB_OIN) + pn * 256; td.i0 = pm; td.i1 = pn; return true; }
    __device__ __forceinline__ void epi(f32x4 (&acc)[8][4], const TD& td, const LAS float* bl) const { (void)bl; EPI_GEOM; const int pm = td.i0, pn = td.i1;
        if (pn < 6) { bf16_t* PROJ = (bf16_t*)(ws + WS_PROJ);
#pragma unroll
            for (int m = 0; m < 8; ++m) { const int row = pm * 256 + wr * 128 + m * 16 + fr;
#pragma unroll
                for (int n = 0; n < 4; ++n) { u32x2 w; w.x = pk2(acc[m][n][0], acc[m][n][1]); w.y = pk2(acc[m][n][2], acc[m][n][3]);
                    *(u32x2*)(PROJ + (size_t)row * QKV_LD + pn * 256 + wc * 64 + n * 16 + 4 * fq) = w; } }
        } else { const int g = pn - 6, ri = wc >> 1; bf16_t* Z = (bf16_t*)(ws + WS_Z);
#pragma unroll
            for (int m = 0; m < 8; ++m) { const int row = pm * 256 + wr * 128 + m * 16 + fr, b = row >> 12, n1 = (row >> 6) & 63, n2 = row & 63;
                bf16_t* zb = Z + ((((size_t)(b * 64 + n1) * 2 + ri) * 64 + n2) * 512) + g * 128 + (wc & 1) * 64;
#pragma unroll
                for (int n = 0; n < 4; ++n) { u32x2 w; w.x = pk2(acc[m][n][0], acc[m][n][1]); w.y = pk2(acc[m][n][2], acc[m][n][3]); *(u32x2*)(zb + n * 16 + 4 * fq) = w; } } } }
};
__device__ __forceinline__ void phase_inproj_l1(Frame& F) {
    PolInproj1 P; P.base_init(F, D / 64, (NMAIN / 256) * 10 + (NCTX / 256) * 4); P.ldbB = 2560;
    gemm_stream_bf(F.lds, P, F.wid, F.lane);
}

struct PolFour : PolBase {
    int stage;
    __device__ __forceinline__ bool get(int i, TD& td) const { int L; if (!tileL(i, L)) return false; const int b = L >> 7, ct = L & 127;
        td.A = (const bf16_t*)(ws + (stage == 1 ? WS_M1 : WS_M2)); dense_aoff(td, 0, 128);
        td.B = (const bf16_t*)(ws + (stage == 1 ? WS_Z : WS_A1)) + (size_t)b * 128 * 32768 + ct * 256; td.i0 = b; td.i1 = ct; return true; }
    __device__ __forceinline__ void epi(f32x4 (&acc)[8][4], const TD& td, const LAS float* bl) const { (void)bl; EPI_GEOM; const int b = td.i0, ct = td.i1;
        if (wr != 0) return;
        if (stage == 1) { const f32x2* TW = (const f32x2*)(ws + WS_TW); bf16_t* A1 = (bf16_t*)(ws + WS_A1);
#pragma unroll
            for (int m = 0; m < 4; ++m) { const int k1 = m * 16 + fr;
#pragma unroll
                for (int n = 0; n < 4; ++n) { const int col = ct * 256 + wc * 64 + n * 16 + 4 * fq, n2 = col >> 9, c = col & 511;
                    const f32x2 tw = TW[n2 * k1]; const f32x4 re = acc[m][n], im = acc[m + 4][n];
                    const f32x4 ore = re * tw.x + im * tw.y, oim = im * tw.x - re * tw.y; u32x2 w0, w1;
                    w0.x = pk2(ore[0], ore[1]); w0.y = pk2(ore[2], ore[3]); w1.x = pk2(oim[0], oim[1]); w1.y = pk2(oim[2], oim[3]);
                    *(u32x2*)(A1 + ((((size_t)(b * 2 + 0) * 64 + n2) * 64 + k1) * 512) + c) = w0;
                    *(u32x2*)(A1 + ((((size_t)(b * 2 + 1) * 64 + n2) * 64 + k1) * 512) + c) = w1; } }
        } else { const float scl = 1.f / 724.0773439350247f; bf16_t* MIX = (bf16_t*)(ws + WS_MIX);
#pragma unroll
            for (int m = 0; m < 4; ++m) { const int k2 = m * 16 + fr;
#pragma unroll
                for (int n = 0; n < 4; ++n) { const int col = ct * 256 + wc * 64 + n * 16 + 4 * fq, k1 = col >> 9, c = col & 511;
                    const f32x4 o = acc[m][n] * scl; u32x2 w; w.x = pk2(o[0], o[1]); w.y = pk2(o[2], o[3]);
                    *(u32x2*)(MIX + (size_t)(b * SEQ + k1 + 64 * k2) * D + 512 + c) = w; } } } }
};

__device__ __forceinline__ void phase_attn_l1(Frame& F) {
    constexpr int QTL = 4;
    const int wid = F.wid, lane = F.lane, fr = lane & 15, fq = lane >> 4;
    constexpr int N_NA = NB * 64, N_F1 = NB * 128;
    const float SC = 0.125f * LOG2E;
    for (int it = F.bid; it < N_NA; it += F.G) {
            LAS unsigned char* vl = F.lds + wid * 8192;
            LAS float* rp = (LAS float*)(vl + 5120);
            const int b = it >> 6, r = it & 63, h = wid;
            for (int i = lane; i < 465; i += 64) rp[i] = PP(odd_rpb)[h * 465 + i] * LOG2E;
            for (int qh = 0; qh < 4 / QTL; ++qh) {
            const int qc0 = qh * (16 * QTL), qrow0 = b * SEQ + r * 64 + qc0;
            bf16x8 qf[QTL][2];
#pragma unroll
            for (int qt = 0; qt < QTL; ++qt)
#pragma unroll
                for (int ks = 0; ks < 2; ++ks) qf[qt][ks] = *(const bf16x8*)(F_PROJ + (size_t)(qrow0 + qt * 16 + fr) * QKV_LD + h * 64 + ks * 32 + 8 * fq);
            AttnStT<QTL> st;
#pragma unroll
            for (int qt = 0; qt < QTL; ++qt) { st.m[qt] = -1e30f; st.l[qt] = 0.f;
#pragma unroll
                for (int dt = 0; dt < 4; ++dt) st.o[dt][qt] = (f32x4){0.f, 0.f, 0.f, 0.f}; }
            const int r0 = min(max(r - 4, 0), 56);
            int c0q[QTL];
#pragma unroll
            for (int qt = 0; qt < QTL; ++qt) c0q[qt] = min(max(qc0 + qt * 16 + fr - 8, 0), 48);
            for (int s = 0; s < 16; ++s) {
                const int kr = r0 + (s >> 1), half = s & 1;
                const bf16_t* kp = F_PROJ + (size_t)(b * SEQ + kr * 64 + half * 32) * QKV_LD + 512 + h * 64;
                const bf16_t* vp = kp + 512;
                const LAS float* rpr = rp + (kr - r + 7) * 31 + 15;
#define SKIP_NA(qt) ({ const int qlo_ = qc0 + qt * 16, wlo_ = min(max(qlo_ - 8, 0), 48), whi_ = min(max(qlo_ + 15 - 8, 0), 48) + 15; (half * 32 + 31 < wlo_) || (half * 32 > whi_); })
#define BIAS_NA(qt, kt, j) ({ const int kc = half * 32 + kt * 16 + 4 * fq + j; const int dc = kc - (qc0 + qt * 16 + fr); (kc >= c0q[qt] && kc < c0q[qt] + 16) ? rpr[dc] : -INFINITY; })
                ATTN_STEP(kp, QKV_LD, vp, QKV_LD, SC, BIAS_NA, SKIP_NA);
            }
            for (int s = 0; s < 8; ++s) {
                const bf16_t* kp = F_PROJ + (size_t)(NMAIN + b * CTXL + s * 32) * QKV_LD + 512 + h * 64;
                const bf16_t* vp = kp + 512;
                ATTN_STEP(kp, QKV_LD, vp, QKV_LD, SC, BIAS_NONE, SKIP_NONE);
            }
            attn_store(st, F_MIX + (size_t)qrow0 * D + h * 64, D, fr, fq);
            }
    }
    __syncthreads();
    PolFour P; P.stage = 1; P.base_init(F, 2, N_F1); P.ldbB = 32768;
    gemm_stream_bf(F.lds, P, F.wid, F.lane);
}

__device__ __forceinline__ void phase_fst2(Frame& F) {
    PolFour P; P.stage = 2; P.base_init(F, 2, NB * 128); P.ldbB = 32768;
    gemm_stream_bf(F.lds, P, F.wid, F.lane);
}

__global__ void __launch_bounds__(512, 2) fwd_kernel(Params p) {
    extern __shared__ __attribute__((aligned(16))) unsigned char lds_raw[];
    Frame F;
    F.lds = (LAS unsigned char*)lds_raw;
    F.tid = threadIdx.x; F.lane = F.tid & 63; F.wid = __builtin_amdgcn_readfirstlane(F.tid >> 6); F.bid = blockIdx.x; F.G = gridDim.x;
    unsigned char* ws = p.ws; F.ws = ws;
    volatile LAS unsigned* MISC = (volatile LAS unsigned*)(F.lds + MISC_OFF);
    if (F.tid < 64) MISC[F.tid] = 0u;
    if (F.tid == 64) { LAS unsigned long long* LP = (LAS unsigned long long*)(F.lds + PARAM_OFF);
        LP[0] = (unsigned long long)p.x; LP[1] = (unsigned long long)p.c; LP[2] = (unsigned long long)p.ctx; LP[3] = (unsigned long long)p.c_ctx; LP[4] = (unsigned long long)p.ada_w; LP[5] = (unsigned long long)p.ada_b;
        LP[6] = (unsigned long long)p.norm_mix; LP[7] = (unsigned long long)p.norm_ffn; LP[8] = (unsigned long long)p.even_w_in; LP[9] = (unsigned long long)p.even_w_out; LP[10] = (unsigned long long)p.even_conv_w;
        LP[11] = (unsigned long long)p.even_sink; LP[12] = (unsigned long long)p.odd_w_in; LP[13] = (unsigned long long)p.odd_w_out; LP[14] = (unsigned long long)p.odd_rpb; LP[15] = (unsigned long long)p.router_w;
        LP[16] = (unsigned long long)p.router_b; LP[17] = (unsigned long long)p.moe_w_gu; LP[18] = (unsigned long long)p.moe_b_gu; LP[19] = (unsigned long long)p.moe_w_dn; LP[20] = (unsigned long long)p.moe_b_dn;
        LP[21] = (unsigned long long)p.final_norm; LP[22] = (unsigned long long)p.out; }
    __syncthreads();
    const int lo = p.ph_lo, hi = p.ph_hi;
    XcdBarrier bar; bar.bar = (unsigned*)(ws + WS_CTL) + CW_BAR; bar.x = 0; bar.st = MISC + 8;
    if (hi - lo > 1) bar = xcd_barrier_post((unsigned*)(ws + WS_CTL) + CW_BAR, MISC + 8);
#define RUN_PHASE(ph, call) do { if (PH_ON(ph) && lo <= (ph) && (ph) < hi) { call; if (PH_REP(ph)) { xcd_barrier(bar); call; } } if (lo <= (ph) && (ph) + 1 < hi) xcd_barrier(bar); } while (0)
    RUN_PHASE(PH_PREP, phase_prep(F));
    RUN_PHASE(PH_NORM1_0, phase_norm1_l0(F));
    RUN_PHASE(PH_INPROJ_0, phase_inproj_l0(F));
    RUN_PHASE(PH_ATTN_0, phase_attn_l0(F));
    RUN_PHASE(PH_OUTPROJ_0, phase_outproj(F, 0));
    RUN_PHASE(PH_ROUTE_0, phase_route(F, 0));
    RUN_PHASE(PH_MOE1_0, phase_moe1(F, bar, hi - lo > 1, 0));
    RUN_PHASE(PH_MOE2_0, phase_moe2(F, 0));
    RUN_PHASE(PH_COMB_0, phase_combine(F, 0));
    RUN_PHASE(PH_INPROJ_1, phase_inproj_l1(F));
    RUN_PHASE(PH_ATTN_1, phase_attn_l1(F));
    RUN_PHASE(PH_FST2_1, phase_fst2(F));
    RUN_PHASE(PH_OUTPROJ_1, phase_outproj(F, 1));
    RUN_PHASE(PH_ROUTE_1, phase_route(F, 1));
    RUN_PHASE(PH_MOE1_1, phase_moe1(F, bar, hi - lo > 1, 1));
    RUN_PHASE(PH_MOE2_1, phase_moe2(F, 1));
    RUN_PHASE(PH_FINAL, phase_combine(F, 1));
}

extern "C" void kernel_launch(void* const* d_in, const int* in_sizes, int n_in, void* d_out, int out_size, void* d_ws, size_t ws_size, hipStream_t stream) {
    static int grid = 0;
    if (grid == 0) {
        if (n_in != 22 || ws_size < WS_END) { fprintf(stderr, "kernel_launch: unexpected inputs (n_in %d, ws %zu)\n", n_in, ws_size); grid = -1; return; }
        int dev = 0, cus = 0, per_cu = 0;
        hipGetDevice(&dev);
        hipDeviceGetAttribute(&cus, hipDeviceAttributeMultiprocessorCount, dev);
        hipFuncSetAttribute((const void*)fwd_kernel, hipFuncAttributeMaxDynamicSharedMemorySize, LDS_BYTES);
        hipOccupancyMaxActiveBlocksPerMultiprocessor(&per_cu, (const void*)fwd_kernel, 512, LDS_BYTES);
        if (per_cu < 1) { fprintf(stderr, "kernel_launch: occupancy query says %d blocks/CU\n", per_cu); per_cu = 1; }
        (void)hipGetLastError();
        grid = cus;
    }
    if (grid < 0) return;
    hipMemsetAsync((char*)d_ws + WS_CTL, 0, CTL_BYTES, stream);
    Params p{};
    const float** pp = (const float**)&p;
    for (int i = 0; i < 22; ++i) pp[i] = (const float*)d_in[i];
    p.out = (float*)d_out; p.ws = (unsigned char*)d_ws;
#if N_LAUNCH_MODE == 1
    for (int ph = 0; ph < NPHASE; ++ph) { p.ph_lo = ph; p.ph_hi = ph + 1; hipLaunchKernelGGL(fwd_kernel, dim3(grid), dim3(512), LDS_BYTES, stream, p); }
#else
    p.ph_lo = 0; p.ph_hi = NPHASE;
    void* args[] = {&p};
    hipError_t e = hipLaunchCooperativeKernel((const void*)fwd_kernel, dim3(grid), dim3(512), args, LDS_BYTES, stream);
    if (e != hipSuccess) fprintf(stderr, "kernel_launch: cooperative launch failed: %s (grid %d)\n", hipGetErrorString(e), grid);
#endif
}
```

```cpp
#include <hip/hip_runtime.h>
#include <cstdio>
#include <cstdint>

#ifndef N_LAUNCH_MODE
#define N_LAUNCH_MODE 0
#endif

#ifndef PHASE_MASK
#define PHASE_MASK 0x1FFFF
#endif
#define PH_ON(ph) ((PHASE_MASK >> (ph)) & 1)
#ifndef REPEAT_MASK
#define REPEAT_MASK 0
#endif
#define PH_REP(ph) ((REPEAT_MASK >> (ph)) & 1)
#define LAS __attribute__((address_space(3)))
#define GAS __attribute__((address_space(1)))
typedef unsigned short bf16_t;
typedef short bf16x8 __attribute__((ext_vector_type(8)));
typedef short s16x4 __attribute__((ext_vector_type(4)));
typedef float f32x4 __attribute__((ext_vector_type(4)));
typedef float f32x2 __attribute__((ext_vector_type(2)));
typedef int i32x4 __attribute__((ext_vector_type(4)));
typedef unsigned u32x2 __attribute__((ext_vector_type(2)));
typedef unsigned u32x4 __attribute__((ext_vector_type(4)));

constexpr int D = 1024, NB = 4, SEQ = 4096, CTXL = 256;
constexpr int NMAIN = NB * SEQ, NCTX = NB * CTXL, NTOK = NMAIN + NCTX;
constexpr int EVEN_IN = 2304, NEXP = 32, DFF = 1024;
constexpr int QKV_LD = 1536;
constexpr float NORM_EPS = 1e-6f;
constexpr float LOG2E = 1.4426950408889634f;

constexpr size_t MiB = 1ull << 20;
constexpr size_t WS_CTL = 0, CTL_BYTES = 1 * MiB;
constexpr size_t WS_MOD = 1 * MiB;
constexpr size_t WS_M1 = 2 * MiB;
constexpr size_t WS_M2 = WS_M1 + 65536;
constexpr size_t WS_ROPE = WS_M2 + 65536;
constexpr size_t WS_TW = WS_ROPE + 8192;
constexpr size_t WS_WF = 4 * MiB;
constexpr size_t WS_TOPW = 8 * MiB;
constexpr size_t WS_POS = 9 * MiB;
constexpr size_t WS_LIST = 12 * MiB;
constexpr size_t WS_H = 16 * MiB;
constexpr size_t WS_MIX = 52 * MiB;
constexpr size_t WS_XS = 88 * MiB;
constexpr size_t WS_PROJ = 160 * MiB;
constexpr size_t WS_Z = 240 * MiB;
constexpr size_t WS_A1 = 304 * MiB;
constexpr size_t WS_ACT = 368 * MiB;
constexpr size_t WS_Y = 512 * MiB;
constexpr size_t WS_WB = 656 * MiB;
constexpr size_t WB_EIN = WS_WB, WB_EOUT = WB_EIN + (size_t)D * EVEN_IN * 2, WB_OIN = WB_EOUT + (size_t)D * D * 2, WB_OOUT = WB_OIN + (size_t)D * 2560 * 2;
constexpr size_t WS_BC = 672 * MiB;
constexpr size_t WS_BC2 = WS_BC + 128 * MiB;
constexpr size_t WS_END = 864 * MiB;
constexpr int CW_BAR = 4096;
constexpr int CW_CNT = 8192;

constexpr int LDS_BYTES = 147456;
constexpr int PARAM_OFF = LDS_BYTES - 512;
constexpr int MISC_OFF = LDS_BYTES - 256;
constexpr int A_TILE_B = 32768, B_ROWB = 544, B_TILE_B = 64 * B_ROWB, STAGE_B = A_TILE_B + B_TILE_B;
static_assert(2 * STAGE_B + 1024 + 8192 <= PARAM_OFF, "LDS");

enum { PH_PREP = 0, PH_NORM1_0, PH_INPROJ_0, PH_ATTN_0, PH_OUTPROJ_0, PH_ROUTE_0, PH_MOE1_0, PH_MOE2_0, PH_COMB_0,
       PH_INPROJ_1, PH_ATTN_1, PH_FST2_1, PH_OUTPROJ_1, PH_ROUTE_1, PH_MOE1_1, PH_MOE2_1, PH_FINAL, NPHASE };

struct Params {
    const float *x, *c, *ctx, *c_ctx, *ada_w, *ada_b, *norm_mix, *norm_ffn, *even_w_in, *even_w_out, *even_conv_w, *even_sink,
                *odd_w_in, *odd_w_out, *odd_rpb, *router_w, *router_b, *moe_w_gu, *moe_b_gu, *moe_w_dn, *moe_b_dn, *final_norm;
    float* out; unsigned char* ws; int ph_lo, ph_hi;
};

__device__ __forceinline__ unsigned pk2(float lo, float hi) { unsigned r; asm("v_cvt_pk_bf16_f32 %0, %1, %2" : "=v"(r) : "v"(lo), "v"(hi)); return r; }
__device__ __forceinline__ float bflo(unsigned u) { return __builtin_bit_cast(float, u << 16); }
__device__ __forceinline__ float bfhi(unsigned u) { return __builtin_bit_cast(float, u & 0xffff0000u); }
__device__ __forceinline__ float wave_sum(float v) {
#pragma unroll
    for (int o = 1; o < 64; o <<= 1) v += __shfl_xor(v, o);
    return v;
}
__device__ __forceinline__ float fexp2(float x) { return __builtin_amdgcn_exp2f(x); }

#define XB_TMO      128
#define XB_XCNT(j)  (256  + 64 * (j))
#define XB_XSUB(j)  (1280 + 64 * (j))
#define XB_XGEN(j)  (2304 + 64 * (j))
#define XB_TOP      3328
#define XB_TOPGEN   3392
#define XB_SPIN_CAP (1u << 22)
__device__ __forceinline__ unsigned xb_ld(unsigned* p)              { return __hip_atomic_load(p, __ATOMIC_RELAXED, __HIP_MEMORY_SCOPE_AGENT); }
__device__ __forceinline__ unsigned xb_add(unsigned* p, unsigned v) { return __hip_atomic_fetch_add(p, v, __ATOMIC_RELAXED, __HIP_MEMORY_SCOPE_AGENT); }
__device__ __forceinline__ unsigned xb_xcc_id() { return (unsigned)__builtin_amdgcn_s_getreg((3 << 11) | 20) & 0xFu; }
#define XB_SPIN(cond, bar) do { unsigned _sp = 0; while (cond) { __builtin_amdgcn_s_sleep(1); \
    if ((++_sp & 255u) == 0u) { if (xb_ld(&(bar)[XB_TMO])) break; if (_sp > XB_SPIN_CAP) { atomicAdd(&(bar)[XB_TMO], 1u); break; } } } } while (0)
struct XcdBarrier { unsigned* bar; unsigned x; volatile LAS unsigned* st; };
__device__ __forceinline__ XcdBarrier xcd_barrier_post(unsigned* bar, volatile LAS unsigned* st) {
    XcdBarrier b; b.bar = bar; b.x = xb_xcc_id(); b.st = st;
    if (threadIdx.x == 0) (void)xb_add(&bar[XB_XCNT(b.x)], 1u);
    return b;
}
__device__ __forceinline__ void xcd_barrier_complete(unsigned* bar, unsigned x, unsigned& nloc, unsigned& nx) {
    const unsigned G = gridDim.x * gridDim.y * gridDim.z;
    unsigned sum, cnt, mine, sp = 0u;
    for (;;) {
        sum = 0u; cnt = 0u; mine = 0u;
#pragma unroll
        for (unsigned j = 0; j < 16; ++j) { const unsigned c = xb_ld(&bar[XB_XCNT(j)]); sum += c; cnt += (c > 0u) ? 1u : 0u; mine = (j == x) ? c : mine; }
        if (sum == G) break;
        __builtin_amdgcn_s_sleep(1);
        if ((++sp & 255u) == 0u) { if (xb_ld(&bar[XB_TMO])) break; if (sp > XB_SPIN_CAP) { atomicAdd(&bar[XB_TMO], 1u); break; } }
    }
    nloc = mine > 0u ? mine : 1u; nx = cnt > 0u ? cnt : 1u;
}
__device__ __forceinline__ void xcd_barrier(const XcdBarrier& b) {
    asm volatile("s_waitcnt vmcnt(0)" ::: "memory");
    __syncthreads();
    if (threadIdx.x == 0) {
        unsigned* bar = b.bar;
        __builtin_amdgcn_s_waitcnt(0);
        unsigned nloc = b.st[0], nx = b.st[1];
        if (nloc == 0u) { xcd_barrier_complete(bar, b.x, nloc, nx); b.st[0] = nloc; b.st[1] = nx; }
        const unsigned old = xb_add(&bar[XB_XSUB(b.x)], 1u);
        const unsigned gen = old / nloc;
        if (old + 1u == (gen + 1u) * nloc) {
            __builtin_amdgcn_fence(__ATOMIC_RELEASE, "agent");
            asm volatile("s_waitcnt vmcnt(0)" ::: "memory");
            const unsigned og = xb_add(&bar[XB_TOP], 1u);
            const unsigned tg = og / nx;
            if (og + 1u == (tg + 1u) * nx) xb_add(&bar[XB_TOPGEN], 1u);
            else XB_SPIN(xb_ld(&bar[XB_TOPGEN]) == tg, bar);
            __builtin_amdgcn_fence(__ATOMIC_ACQUIRE, "agent");
            xb_add(&bar[XB_XGEN(b.x)], 1u);
            asm volatile("s_waitcnt vmcnt(0)" ::: "memory");
        } else {
            XB_SPIN(xb_ld(&bar[XB_XGEN(b.x)]) == gen, bar);
            __builtin_amdgcn_fence(__ATOMIC_ACQUIRE, "agent");
            asm volatile("s_waitcnt vmcnt(0)" ::: "memory");
        }
    }
    __syncthreads();
}

struct TD { const bf16_t* A; const void* B; bf16_t* bco; unsigned ldb; unsigned aoff[4]; int i0, i1, i2, i3, i4; };
__device__ __forceinline__ int a_piece_row0(int wid, int lane) { const int sb = lane * 16, swz = sb ^ (((sb >> 9) & 1) << 5); return (wid >> 1) * 16 + (swz >> 6); }
__device__ __forceinline__ int a_piece_col(int wid, int lane) { const int sb = lane * 16, swz = sb ^ (((sb >> 9) & 1) << 5); return (wid & 1) * 32 + ((swz & 63) >> 1); }
__device__ __forceinline__ u32x4 make_rsrc(const void* p) { const unsigned long long ab = (unsigned long long)p; u32x4 r; r.x = __builtin_amdgcn_readfirstlane((unsigned)ab); r.y = __builtin_amdgcn_readfirstlane((unsigned)(ab >> 32)) & 0xffffu; r.z = 0x7fffffffu; r.w = 0x00020000u; return r; }

template <class Pol>
__device__ __forceinline__ void gemm_stream(LAS unsigned char* lds, Pol& P, const int wid, const int lane) {
    const int wr = wid >> 2, wc = wid & 3, fr = lane & 15, fq = lane >> 4;
    const unsigned b_w = (unsigned)(A_TILE_B + ((wid >> 2) * 32 + 4 * (wid & 3)) * B_ROWB) + P.woff;
    const unsigned a_r = (unsigned)(wr * 16384 + ((fr * 64 + fq * 16) ^ ((fr >> 3) << 5)));
    const unsigned b_r = (unsigned)(A_TILE_B + (4 * fq + (fr >> 2)) * B_ROWB + (wc * 64 + (fr & 3) * 4) * 2);
    const unsigned ldsa = (unsigned)(__UINTPTR_TYPE__)lds + (unsigned)(wid * 1024);
    const unsigned lcolb = P.lcolb;
    TD cur, nxt;
    if (!P.get(0, cur)) return;
    int nt = P.nt; asm volatile("" : "+s"(nt));
    f32x4 sb[8]; f32x4 acc[8][4];
    u32x4 ra_c = make_rsrc(cur.A), ra_n = ra_c;
    __amdgpu_buffer_rsrc_t rb_c = __builtin_amdgcn_make_buffer_rsrc((void*)cur.B, 0, 0x7fffffff, 0x00020000), rb_n = rb_c;
#define G_GLDS_A(buf, RA, AOFF, kt) do { _Pragma("unroll") for (int i = 0; i < 4; ++i) { unsigned keep_; \
        asm volatile("s_mov_b32 %0, m0\n\ts_mov_b32 m0, %3\n\ts_nop 0\n\tbuffer_load_dwordx4 %1, %2, %4 offen lds\n\ts_mov_b32 m0, %0" \
            : "=&s"(keep_) : "v"(AOFF[i]), "s"(RA), "s"(ldsa + (buf) + (unsigned)(i * 8192)), "s"((unsigned)((kt) * 128)) : "memory"); } } while (0)
#define G_ISSUE_BH(RB, LDB4, kt, h) do { \
        _Pragma("unroll") for (int i = 4 * (h); i < 4 * (h) + 4; ++i) sb[i] = __builtin_bit_cast(f32x4, __builtin_amdgcn_raw_buffer_load_b128(RB, (int)lcolb, (int)(((unsigned)(kt) * 64u + i) * (LDB4)), 0)); \
        __builtin_amdgcn_sched_barrier(0); } while (0)
#define G_WRITE_BH(buf, h, BCO, kt) do { \
        _Pragma("unroll") for (int i = 4 * (h); i < 4 * (h) + 4; ++i) { u32x2 w; w.x = pk2(sb[i][0], sb[i][1]); w.y = pk2(sb[i][2], sb[i][3]); \
            *(LAS u32x2*)(lds + (buf) + b_w + (16 * (i >> 2) + (i & 3)) * B_ROWB) = w; \
            if (BCO) *(u32x2*)((char*)(BCO) + (size_t)((kt) * 64 + wid * 8 + i) * 512 + P.woff) = w; } __builtin_amdgcn_sched_barrier(0); } while (0)
#define G_KSTEP(buf, ks) do { bf16x8 Bf[4]; \
        _Pragma("unroll") for (int n = 0; n < 4; ++n) { \
            const s16x4 lo = __builtin_amdgcn_ds_read_tr16_b64_v4i16((LAS s16x4*)(lds + (buf) + b_r + (ks) * 32 * B_ROWB + n * 32)); \
            const s16x4 hi = __builtin_amdgcn_ds_read_tr16_b64_v4i16((LAS s16x4*)(lds + (buf) + b_r + (ks) * 32 * B_ROWB + 16 * B_ROWB + n * 32)); \
            Bf[n] = (bf16x8){lo[0], lo[1], lo[2], lo[3], hi[0], hi[1], hi[2], hi[3]}; } \
        _Pragma("unroll") for (int mh = 0; mh < 2; ++mh) { bf16x8 At[4]; \
            _Pragma("unroll") for (int m = 0; m < 4; ++m) At[m] = *(const LAS bf16x8*)(lds + (buf) + a_r + (mh * 4 + m) * 2048 + (ks) * 1024); \
            _Pragma("unroll") for (int m = 0; m < 4; ++m) _Pragma("unroll") for (int n = 0; n < 4; ++n) \
                acc[mh * 4 + m][n] = __builtin_amdgcn_mfma_f32_16x16x32_bf16(Bf[n], At[m], acc[mh * 4 + m][n], 0, 0, 0); } \
        __builtin_amdgcn_sched_barrier(0); } while (0)
    { unsigned b0 = 0; asm volatile("" : "+s"(b0));
      const unsigned l4 = cur.ldb * 4u;
      G_GLDS_A(b0, ra_c, cur.aoff, 0); G_ISSUE_BH(rb_c, l4, 0, 0); G_ISSUE_BH(rb_c, l4, 0, 1); G_WRITE_BH(b0, 0, cur.bco, 0); G_WRITE_BH(b0, 1, cur.bco, 0);
      G_ISSUE_BH(rb_c, l4, 1, 0); G_ISSUE_BH(rb_c, l4, 1, 1); }
    asm volatile("s_waitcnt vmcnt(8)" ::: "memory");
    asm volatile("s_waitcnt lgkmcnt(0)" ::: "memory");
    __builtin_amdgcn_s_barrier();
    unsigned par = 0;
    for (int ti = 0;; ++ti) {
        const bool hasn = P.get(ti + 1, nxt);
        if (hasn) { ra_n = make_rsrc(nxt.A); rb_n = __builtin_amdgcn_make_buffer_rsrc((void*)nxt.B, 0, 0x7fffffff, 0x00020000); }
#pragma unroll
        for (int m = 0; m < 8; ++m)
#pragma unroll
            for (int n = 0; n < 4; ++n) acc[m][n] = (f32x4){0.f, 0.f, 0.f, 0.f};
        for (int t = 0; t < nt; ++t) {
            unsigned bc = par * STAGE_B, bn = (par ^ 1u) * STAGE_B; asm volatile("" : "+s"(bc), "+s"(bn));
            const bool c1 = t + 1 < nt, w1 = c1 || hasn, c2 = t + 2 < nt, i2 = c2 || hasn;
            if (w1) { const u32x4 ra = c1 ? ra_c : ra_n; unsigned ao[4];
#pragma unroll
                for (int i = 0; i < 4; ++i) ao[i] = c1 ? cur.aoff[i] : nxt.aoff[i];
                G_GLDS_A(bn, ra, ao, c1 ? t + 1 : 0); }
            G_KSTEP(bc, 0);
            const __amdgpu_buffer_rsrc_t rb = c2 ? rb_c : rb_n; const unsigned l4 = (c2 ? cur.ldb : nxt.ldb) * 4u; const int k2 = c2 ? t + 2 : t + 2 - nt;
            bf16_t* const bco = c1 ? cur.bco : nxt.bco; const int k1 = c1 ? t + 1 : 0;
            if (w1) G_WRITE_BH(bn, 0, bco, k1);
            if (i2) G_ISSUE_BH(rb, l4, k2, 0);
            G_KSTEP(bc, 1);
            if (w1) G_WRITE_BH(bn, 1, bco, k1);
            if (i2) { G_ISSUE_BH(rb, l4, k2, 1); asm volatile("s_waitcnt vmcnt(8)" ::: "memory"); }
            else asm volatile("s_waitcnt vmcnt(0)" ::: "memory");
            asm volatile("s_waitcnt lgkmcnt(0)" ::: "memory");
            __builtin_amdgcn_s_barrier();
            par ^= 1u;
        }
        P.epi(acc, cur, (const LAS float*)nullptr);
        if (!hasn) break;
        cur = nxt; ra_c = ra_n; rb_c = rb_n;
    }
#undef G_GLDS_A
#undef G_ISSUE_BH
#undef G_WRITE_BH
#undef G_KSTEP
}

constexpr int STEP_B = 32768;
constexpr unsigned ROPE_LDS = 2 * STAGE_B + 1024;
constexpr unsigned BIAS_OFF = 4 * STEP_B;
template <class Pol, int ABL = 0>
__device__ __forceinline__ void gemm_stream_bf(LAS unsigned char* lds, Pol& P, const int wid, const int lane) {
    const int wr = wid >> 2, wc = wid & 3, fr = lane & 15, fq = lane >> 4;
    const unsigned a_r = (unsigned)(wr * 8192 + ((fr * 64 + fq * 16) ^ ((fr >> 3) << 5)));
    const int x7 = 4 * (fq & 1) + (fr >> 2);
    unsigned b_r[4];
#pragma unroll
    for (int n = 0; n < 4; ++n) b_r[n] = (unsigned)(16384 + (4 * fq + (fr >> 2)) * 512 + (((wc * 4 + n) ^ x7) * 32) + (fr & 3) * 8);
    const unsigned ldsa = (unsigned)(__UINTPTR_TYPE__)lds + (unsigned)(wid * 2048), ldsb = (unsigned)(__UINTPTR_TYPE__)lds + 16384u + (unsigned)(wid * 2048);
    const unsigned ldb2 = P.ldbB * 2u;
    unsigned boff[2];
#pragma unroll
    for (int j = 0; j < 2; ++j) { const int sl = 4 * wid + 2 * j + (lane >> 5), u = lane & 31, c = (u >> 1) ^ (sl & 7), n = c * 16 + (u & 1) * 8;
        const int k = 8 * ((sl >> 2) & 3) + 4 * (sl >> 4) + (sl & 3); boff[j] = (unsigned)k * ldb2 + (unsigned)n * 2u; }
    TD cur, nxt;
    if (!P.get(0, cur)) return;
    int nt = P.nt * 2; asm volatile("" : "+s"(nt));
    f32x4 acc[8][4];
    u32x4 ra_c = make_rsrc(cur.A), ra_n = ra_c, rb_c = make_rsrc(cur.B), rb_n = rb_c;
#define H_DMA(LDSADDR, RS, VOFF, SOFF) do { unsigned keep_; \
        asm volatile("s_mov_b32 %0, m0\n\ts_mov_b32 m0, %3\n\ts_nop 0\n\tbuffer_load_dwordx4 %1, %2, %4 offen lds\n\ts_mov_b32 m0, %0" \
            : "=&s"(keep_) : "v"(VOFF), "s"(RS), "s"(LDSADDR), "s"(SOFF) : "memory"); } while (0)
#define H_STAGE(sb_, RA, AO0, AO1, RB, st) do { \
        if (!(ABL & 2)) { H_DMA(ldsa + (sb_), RA, AO0, (unsigned)((st) * 64)); H_DMA(ldsa + (sb_) + 1024u, RA, AO1, (unsigned)((st) * 64)); } \
        if (!(ABL & 1)) { H_DMA(ldsb + (sb_), RB, boff[0], (unsigned)(st) * 32u * ldb2); H_DMA(ldsb + (sb_) + 1024u, RB, boff[1], (unsigned)(st) * 32u * ldb2); } } while (0)
#define H_READ(sb_) do { if (!(ABL & 16)) { \
        _Pragma("unroll") for (int n = 0; n < 4; ++n) { \
            const s16x4 lo = __builtin_amdgcn_ds_read_tr16_b64_v4i16((LAS s16x4*)(lds + (sb_) + b_r[n])); \
            const s16x4 hi = __builtin_amdgcn_ds_read_tr16_b64_v4i16((LAS s16x4*)(lds + (sb_) + b_r[n] + 8192)); \
            Bf[n] = (bf16x8){lo[0], lo[1], lo[2], lo[3], hi[0], hi[1], hi[2], hi[3]}; } \
        _Pragma("unroll") for (int m = 0; m < 8; ++m) At[m] = *(const LAS bf16x8*)(lds + (sb_) + a_r + m * 1024); } } while (0)
#define H_MMA() do { if (!(ABL & 16)) { __builtin_amdgcn_s_setprio(1); \
        if (!(ABL & 4)) { _Pragma("unroll") for (int m = 0; m < 8; ++m) _Pragma("unroll") for (int n = 0; n < 4; ++n) \
            acc[m][n] = __builtin_amdgcn_mfma_f32_16x16x32_bf16(Bf[n], At[m], acc[m][n], 0, 0, 0); } \
        else { _Pragma("unroll") for (int m = 0; m < 8; ++m) asm volatile("" :: "v"(At[m])); _Pragma("unroll") for (int n = 0; n < 4; ++n) asm volatile("" :: "v"(Bf[n])); } \
        __builtin_amdgcn_s_setprio(0); } } while (0)
#define H_MMA0() do { if (!(ABL & 16)) { __builtin_amdgcn_s_setprio(1); \
        _Pragma("unroll") for (int m = 0; m < 8; ++m) _Pragma("unroll") for (int n = 0; n < 4; ++n) \
            acc[m][n] = __builtin_amdgcn_mfma_f32_16x16x32_bf16(Bf[n], At[m], (f32x4){0.f, 0.f, 0.f, 0.f}, 0, 0, 0); \
        __builtin_amdgcn_s_setprio(0); } } while (0)
#define H_BAR() do { asm volatile("s_waitcnt lgkmcnt(0)" ::: "memory"); __builtin_amdgcn_s_barrier(); __builtin_amdgcn_sched_barrier(0); } while (0)
    bf16x8 At[8], Bf[4];
    { unsigned s0 = 0, s1 = STEP_B, s2 = 2 * STEP_B; asm volatile("" : "+s"(s0), "+s"(s1), "+s"(s2));
      H_STAGE(s0, ra_c, cur.aoff[0], cur.aoff[1], rb_c, 0); H_STAGE(s1, ra_c, cur.aoff[0], cur.aoff[1], rb_c, 1); H_STAGE(s2, ra_c, cur.aoff[0], cur.aoff[1], rb_c, 2); }
    asm volatile("s_waitcnt vmcnt(8)" ::: "memory");
    H_BAR();
    if (wr == 1) H_BAR();
    unsigned g = 0;
    for (int ti = 0;; ++ti) {
        const bool hasn = P.get(ti + 1, nxt);
        if (hasn) { ra_n = make_rsrc(nxt.A); rb_n = make_rsrc(nxt.B); }
        const unsigned bias_lds = BIAS_OFF + (unsigned)(ti & 1) * 1024u, list_lds = BIAS_OFF + 2048u + (unsigned)(ti & 1) * 1024u;
        if (P.has_bias && wid == 0) { const u32x4 rbias = make_rsrc(P.bias); H_DMA((unsigned)(__UINTPTR_TYPE__)lds + bias_lds, rbias, P.bias_voff(cur), 0u); }
        if (P.has_list && hasn && wid == 1) { const u32x4 rl = make_rsrc(P.listp); H_DMA((unsigned)(__UINTPTR_TYPE__)lds + list_lds, rl, P.list_voff(nxt), 0u); }
        for (int t = 0; t < nt; ++t, ++g) {
            unsigned sc = (g & 3u) * STEP_B, sn = ((g + 3u) & 3u) * STEP_B; asm volatile("" : "+s"(sc), "+s"(sn));
            const bool c3 = t + 3 < nt, i3 = c3 || hasn, i2 = (t + 2 < nt) || hasn;
            if (P.has_list && hasn && t == nt - 3) P.late(nxt, (const LAS int*)(lds + list_lds));
            if (c3) { H_STAGE(sn, ra_c, cur.aoff[0], cur.aoff[1], rb_c, (unsigned)(t + 3)); }
            else if (hasn) { u32x4 ra = ra_n, rb = rb_n;
#pragma unroll
                for (int q = 0; q < 4; ++q) { ra[q] = __builtin_amdgcn_readfirstlane(ra[q]); rb[q] = __builtin_amdgcn_readfirstlane(rb[q]); }
                H_STAGE(sn, ra, nxt.aoff[0], nxt.aoff[1], rb, (unsigned)__builtin_amdgcn_readfirstlane(t + 3 - nt)); }
            H_READ(sc);
            if (i3) asm volatile("s_waitcnt vmcnt(8)" ::: "memory");
            else if (i2) asm volatile("s_waitcnt vmcnt(4)" ::: "memory");
            else asm volatile("s_waitcnt vmcnt(0)" ::: "memory");
            H_BAR();
            if (t == 0) H_MMA0(); else H_MMA();
            H_BAR();
        }
        if (wr == 0) H_BAR();
        if (!(ABL & 8)) P.epi(acc, cur, (const LAS float*)(lds + bias_lds)); else { _Pragma("unroll") for (int m = 0; m < 8; ++m) _Pragma("unroll") for (int n = 0; n < 4; ++n) asm volatile("" :: "v"(acc[m][n])); }
        if (!hasn) break;
        cur = nxt; ra_c = ra_n; rb_c = rb_n;
        if (wr == 1) H_BAR();
    }
#undef H_DMA
#undef H_STAGE
#undef H_READ
#undef H_MMA
#undef H_MMA0
#undef H_BAR
}

struct XOrder {
    int c1, step, cur;
    __device__ __forceinline__ void init(int T, int G, int bid) {
        if ((G & 7) == 0) { const int x = bid & 7; cur = (int)(((long)x * T) >> 3) + (bid >> 3); c1 = (int)(((long)(x + 1) * T) >> 3); step = G >> 3; }
        else { cur = bid; c1 = T; step = G; }
    }
    __device__ __forceinline__ bool next(int& L) { if (cur >= c1) return false; L = cur; cur += step; return true; }
};
__device__ __forceinline__ void dense_tile(int L, int nM, int nN, int& pm, int& pn) { const int per = 8 * nN, g = L / per, w = L - g * per, fm = g * 8, gs = (nM - fm) < 8 ? (nM - fm) : 8; pn = w / gs; pm = fm + w - pn * gs; }

struct Frame { LAS unsigned char* lds; int tid, lane, wid, bid, G; unsigned char* ws; };
__device__ __forceinline__ const void* ldp(const Frame& F, int off) {
    const u32x2 v = *(const volatile LAS u32x2*)(F.lds + PARAM_OFF + off);
    const unsigned lo = __builtin_amdgcn_readfirstlane(v.x), hi = __builtin_amdgcn_readfirstlane(v.y);
    return (const void*)(((unsigned long long)hi << 32) | lo);
}
#define PP(f) ((const float*)ldp(F, (int)__builtin_offsetof(Params, f)))
#define F_mod ((float*)(F.ws + WS_MOD))
#define F_M1 ((bf16_t*)(F.ws + WS_M1))
#define F_M2 ((bf16_t*)(F.ws + WS_M2))
#define F_ROPE ((f32x2*)(F.ws + WS_ROPE))
#define F_TW ((f32x2*)(F.ws + WS_TW))
#define F_WF ((float*)(F.ws + WS_WF))
#define F_TOPW ((float*)(F.ws + WS_TOPW))
#define F_POS ((int*)(F.ws + WS_POS))
#define F_LIST ((int*)(F.ws + WS_LIST))
#define F_H ((bf16_t*)(F.ws + WS_H))
#define F_MIX ((bf16_t*)(F.ws + WS_MIX))
#define F_XS ((float*)(F.ws + WS_XS))
#define F_PROJ ((bf16_t*)(F.ws + WS_PROJ))
#define F_Z ((float*)(F.ws + WS_Z))
#define F_A1 ((float*)(F.ws + WS_A1))
#define F_ACT ((bf16_t*)(F.ws + WS_ACT))
#define F_Y ((bf16_t*)(F.ws + WS_Y))
#define F_cnt ((unsigned*)(F.ws + WS_CTL) + CW_CNT)

__device__ __forceinline__ const float* modp(const Frame& F, int l, int r, int which) { return F_mod + ((size_t)(l * 5 + r)) * 6144 + which * 1024; }
__device__ __forceinline__ int mod_row(int row) { return row < NMAIN ? (row >> 12) : 4; }

__device__ __forceinline__ float row_rstd(const f32x4 (&v)[4]) {
    float s = 0.f;
#pragma unroll
    for (int j = 0; j < 4; ++j) s += (v[j][0] * v[j][0] + v[j][1] * v[j][1]) + (v[j][2] * v[j][2] + v[j][3] * v[j][3]);
    return __builtin_amdgcn_rsqf(wave_sum(s) * (1.f / D) + NORM_EPS);
}
__device__ __forceinline__ void norm_mod_store(const f32x4 (&v)[4], float rstd, const float* gam, const float* sc, const float* sh, bf16_t* dst, int lane, f32x4 (*keep)[4] = nullptr) {
#pragma unroll
    for (int j = 0; j < 4; ++j) {
        const int c = 4 * lane + 256 * j;
        const f32x4 g = *(const f32x4*)(gam + c), s1 = *(const f32x4*)(sc + c), s0 = *(const f32x4*)(sh + c);
        f32x4 h;
#pragma unroll
        for (int i = 0; i < 4; ++i) h[i] = v[j][i] * rstd * g[i] * (1.f + s1[i]) + s0[i];
        u32x2 w; w.x = pk2(h[0], h[1]); w.y = pk2(h[2], h[3]);
        *(u32x2*)(dst + c) = w;
        if (keep) (*keep)[j] = h;
    }
}

__device__ __forceinline__ void phase_prep(Frame& F) {
    LAS float* sil = (LAS float*)F.lds;
    LAS float* red = (LAS float*)(F.lds + 20480);
    LAS float* ct = (LAS float*)(F.lds + 32768);
    for (int idx = F.tid; idx < 5120; idx += 512) { const int r = idx >> 10, k = idx & 1023; const float v = r < 4 ? PP(c)[r * 1024 + k] : PP(c_ctx)[k]; sil[idx] = v / (1.f + __expf(-v)); }
    if (F.tid < 128) ct[F.tid] = cospif((float)F.tid / 64.f);
    __syncthreads();
    constexpr int N_ADA = 192, N_CONST = 8, N_FOLD = 256, N_CVT = 368;
    for (int it = F.bid; it < N_ADA + N_CONST + N_FOLD + N_CVT; it += F.G) {
        if (it < N_ADA) {
            const int l = it / 96, j0 = (it % 96) * 64, col = j0 + F.lane;
            const float* w = PP(ada_w) + ((size_t)l * 1024 + F.wid * 128) * 6144 + col;
            float a[5] = {0.f, 0.f, 0.f, 0.f, 0.f};
            for (int k0 = 0; k0 < 128; k0 += 32) {
                float wv[32];
#pragma unroll
                for (int u = 0; u < 32; ++u) wv[u] = w[(size_t)(k0 + u) * 6144];
#pragma unroll
                for (int u = 0; u < 32; ++u)
#pragma unroll
                    for (int r = 0; r < 5; ++r) a[r] += sil[r * 1024 + F.wid * 128 + k0 + u] * wv[u];
            }
#pragma unroll
            for (int r = 0; r < 5; ++r) red[(F.wid * 5 + r) * 64 + F.lane] = a[r];
            __syncthreads();
            if (F.tid < 320) { const int r = F.tid >> 6, ln = F.tid & 63; float s = 0.f;
#pragma unroll
                for (int w8 = 0; w8 < 8; ++w8) s += red[(w8 * 5 + r) * 64 + ln];
                F_mod[(size_t)(l * 5 + r) * 6144 + j0 + ln] = s + PP(ada_b)[l * 6144 + j0 + ln]; }
            __syncthreads();
        } else if (it < N_ADA + N_CONST) {
            const int gt = (it - N_ADA) * 512 + F.tid;
            for (int e = gt; e < 32768; e += 4096) {
                const int row = e >> 7, kk = e & 127;
                float v1 = 0.f, v2 = 0.f;
                if (row < 128) { const int ro = row >> 6, k1 = row & 63, n1 = kk >> 1, ri = kk & 1; const float ph = (float)((n1 * k1) & 63) / 32.f; const float cs = cospif(ph), sn = sinpif(ph);
                    v1 = (ro == ri) ? cs : (ro == 0 ? sn : -sn); }
                if (row < 64) { const int ro = kk >> 6, n2 = kk & 63; const float ph = (float)((row * n2) & 63) / 32.f; v2 = ro == 0 ? cospif(ph) : sinpif(ph); }
                F_M1[e] = (bf16_t)(pk2(v1, 0.f) & 0xffffu); F_M2[e] = (bf16_t)(pk2(v2, 0.f) & 0xffffu);
            }
            if (gt < 1024) { const int pos = gt >> 4, f = gt & 15; const double ang = (double)pos * pow(10000.0, -(double)f / 16.0); F_ROPE[gt] = (f32x2){(float)cos(ang), (float)sin(ang)}; }
            { const float ph = (float)gt / 2048.f; F_TW[gt] = (f32x2){cospif(ph), sinpif(ph)}; }
        } else if (it >= N_ADA + N_CONST + N_FOLD) {
            int ci = it - (N_ADA + N_CONST + N_FOLD); const float* src; bf16_t* dst; int sld, dld, ncol;
            if (ci < 144) { src = PP(even_w_in); dst = (bf16_t*)(F.ws + WB_EIN); sld = EVEN_IN; dld = EVEN_IN; ncol = EVEN_IN; }
            else if (ci < 208) { ci -= 144; src = PP(even_w_out); dst = (bf16_t*)(F.ws + WB_EOUT); sld = D; dld = D; ncol = D; }
            else if (ci < 304) { ci -= 208; src = PP(odd_w_in); dst = (bf16_t*)(F.ws + WB_OIN); sld = 2048; dld = 2560; ncol = 1536; }
            else { ci -= 304; src = PP(odd_w_out); dst = (bf16_t*)(F.ws + WB_OOUT); sld = D; dld = D; ncol = D; }
            const int q4 = ncol >> 2;
#pragma unroll
            for (int u = 0; u < 8; ++u) { const int gidx = ci * 4096 + u * 512 + F.tid, row = gidx / q4, c4 = (gidx - row * q4) * 4;
                const f32x4 v = *(const f32x4*)(src + (size_t)row * sld + c4); u32x2 w; w.x = pk2(v[0], v[1]); w.y = pk2(v[2], v[3]); *(u32x2*)(dst + (size_t)row * dld + c4) = w; }
        } else {
            const int fi = it - N_ADA - N_CONST, rc = fi >> 2, g = fi & 3, half = F.tid >> 8, j = F.tid & 255, jj = j & 127;
            { const float* wb = PP(odd_w_in) + (size_t)(rc * 16 + half * 8) * 2048 + 1536 + g * 128;
              const int toff = j < 128 ? 0 : -32; const float sg = j < 128 ? 1.f : -1.f;
              float sacc[8] = {0.f, 0.f, 0.f, 0.f, 0.f, 0.f, 0.f, 0.f};
#pragma unroll 4
              for (int cc = 0; cc < 128; ++cc) { const float tv = ct[((cc * jj) + toff) & 127];
#pragma unroll
                  for (int r8 = 0; r8 < 8; ++r8) sacc[r8] += wb[(size_t)r8 * 2048 + cc] * tv; }
#pragma unroll
              for (int r8 = 0; r8 < 8; ++r8) ((bf16_t*)(F.ws + WB_OIN))[(size_t)(rc * 16 + half * 8 + r8) * 2560 + 1536 + g * 256 + j] = (bf16_t)(pk2(sg * sacc[r8], 0.f) & 0xffffu); }
        }
    }
}

__device__ __forceinline__ void phase_norm1_l0(Frame& F) {
    const int gw = F.bid * 8 + F.wid, NGW = F.G * 8;
    for (int row = gw; row < NTOK; row += NGW) {
        const float* src = row < NMAIN ? PP(x) + (size_t)row * D : PP(ctx) + (size_t)(row - NMAIN) * D;
        f32x4 v[4];
#pragma unroll
        for (int j = 0; j < 4; ++j) v[j] = *(const f32x4*)(src + 4 * F.lane + 256 * j);
        const float rstd = row_rstd(v); const int r = mod_row(row);
        norm_mod_store(v, rstd, PP(norm_mix), modp(F, 0, r, 1), modp(F, 0, r, 0), F_H + (size_t)row * D, F.lane);
    }
}

#define EPI_GEOM const int wid = this->wid, lane = this->lane, wr = wid >> 2, wc = wid & 3, fr = lane & 15, fq = lane >> 4; (void)wr; (void)wc; (void)fr; (void)fq
struct PolBase { unsigned char* ws; LAS unsigned char* lds; int wid, lane, nt; unsigned lcolb, woff, ldbB; XOrder xo; int aC, aR0, aCb, aR0b; bool bfm;
    __device__ __forceinline__ void base_init(Frame& F, int nt_, int T) { ws = F.ws; lds = F.lds; wid = F.wid; lane = F.lane; nt = nt_; lcolb = 16u * (unsigned)F.lane; woff = 8u * (unsigned)F.lane;
        xo.init(T, F.G, F.bid); aC = a_piece_col(F.wid, F.lane); aR0 = a_piece_row0(F.wid, F.lane); bfm = true;
        { const int sbb = F.lane * 16, swz = sbb ^ (((sbb >> 9) & 1) << 5); aR0b = F.wid * 32 + (swz >> 6); aCb = (swz & 63) >> 1; } }
    bool has_bias = false; const float* bias = nullptr;
    bool has_list = false; const int* listp = nullptr;
    __device__ __forceinline__ unsigned list_voff(const TD&) const { return 0u; }
    __device__ __forceinline__ void late(TD&, const LAS int*) const {}
    __device__ __forceinline__ unsigned bias_voff(const TD&) const { return 0u; }
    __device__ __forceinline__ bool tileL(int i, int& L) const { L = xo.cur + i * xo.step; return L < xo.c1; }
    __device__ __forceinline__ int prow(int i) const { return bfm ? aR0b + 16 * (i & 1) : aR0 + 64 * i; }
    __device__ __forceinline__ int pcol() const { return bfm ? aCb : aC; }
    __device__ __forceinline__ void dense_aoff(TD& td, int row0, int pitch) const {
#pragma unroll
        for (int i = 0; i < 4; ++i) td.aoff[i] = (unsigned)(((row0 + prow(i)) * pitch + pcol()) * 2); }
};

struct PolInproj0 : PolBase {
    const float* W; Frame* Fp;
    __device__ __forceinline__ bool get(int i, TD& td) const { int L; if (!tileL(i, L)) return false; int pm, pn; dense_tile(L, NTOK / 256, EVEN_IN / 256, pm, pn);
        td.A = (const bf16_t*)(ws + WS_H); dense_aoff(td, pm * 256, D); td.B = (const bf16_t*)(ws + WB_EIN) + pn * 256; td.i0 = pm; td.i1 = pn; return true; }
    __device__ __forceinline__ void epi(f32x4 (&acc)[8][4], const TD& td, const LAS float* bl) const { (void)bl; EPI_GEOM; const int pm = td.i0, pn = td.i1;
        const int colb = pn * 256 + wc * 64; const bool rope = (colb < 640) && (pm < NMAIN / 256);
        const LAS f32x2* ROPE = (const LAS f32x2*)(lds + ROPE_LDS); bf16_t* PROJ = (bf16_t*)(ws + WS_PROJ);
#pragma unroll
        for (int m = 0; m < 8; ++m) { const int row = pm * 256 + wr * 128 + m * 16 + fr;
            if (rope) { const int tt = row & (SEQ - 1), gr = tt >> 6, gc = tt & 63;
#pragma unroll
                for (int n = 0; n < 2; ++n) { const int pos = n == 0 ? gr : gc;
#pragma unroll
                    for (int j = 0; j < 4; ++j) { const f32x2 cs = ROPE[pos * 16 + 4 * fq + j]; const float x1 = acc[m][n][j], x2 = acc[m][n + 2][j];
                        acc[m][n][j] = x1 * cs.x - x2 * cs.y; acc[m][n + 2][j] = x2 * cs.x + x1 * cs.y; } } }
#pragma unroll
            for (int n = 0; n < 4; ++n) { u32x2 w; w.x = pk2(acc[m][n][0], acc[m][n][1]); w.y = pk2(acc[m][n][2], acc[m][n][3]);
                *(u32x2*)(PROJ + (size_t)row * EVEN_IN + colb + n * 16 + 4 * fq) = w; } } }
};
__device__ __forceinline__ void phase_inproj_l0(Frame& F) {
    for (int i = F.tid; i < 1024; i += 512) ((LAS f32x2*)(F.lds + ROPE_LDS))[i] = F_ROPE[i];
    __syncthreads();
    PolInproj0 P; P.base_init(F, D / 64, (NTOK / 256) * (EVEN_IN / 256)); P.ldbB = EVEN_IN;
    gemm_stream_bf(F.lds, P, F.wid, F.lane);
}

struct PolOutproj : PolBase {
    const float *W, *x, *ctx; int layer, nM;
    __device__ __forceinline__ bool get(int i, TD& td) const { int L; if (!tileL(i, L)) return false; int pm, pn; dense_tile(L, nM, 4, pm, pn);
        td.A = (const bf16_t*)(ws + WS_MIX); dense_aoff(td, pm * 256, D); td.B = (const bf16_t*)(ws + (layer == 0 ? WB_EOUT : WB_OOUT)) + pn * 256; td.i0 = pm; td.i1 = pn; return true; }
    __device__ __forceinline__ void epi(f32x4 (&acc)[8][4], const TD& td, const LAS float* bl) const { (void)bl; EPI_GEOM; const int pm = td.i0, pn = td.i1;
        const int colb = pn * 256 + wc * 64; float* XS = (float*)(ws + WS_XS); const float* mod = (const float*)(ws + WS_MOD);
#pragma unroll
        for (int m = 0; m < 8; ++m) { const int row = pm * 256 + wr * 128 + m * 16 + fr; const int r = mod_row(row);
            const float* xin = layer == 0 ? (row < NMAIN ? x + (size_t)row * D : ctx + (size_t)(row - NMAIN) * D) : XS + (size_t)row * D;
            const float* g1 = mod + ((size_t)(layer * 5 + r)) * 6144 + 2 * 1024;
#pragma unroll
            for (int n = 0; n < 4; ++n) { const int c = colb + n * 16 + 4 * fq; const f32x4 xv = *(const f32x4*)(xin + c), gv = *(const f32x4*)(g1 + c);
                f32x4 o;
#pragma unroll
                for (int j = 0; j < 4; ++j) o[j] = xv[j] + gv[j] * acc[m][n][j];
                *(f32x4*)(XS + (size_t)row * D + c) = o; } } }
};
__device__ __forceinline__ void phase_outproj(Frame& F, const int layer) {
    PolOutproj P; P.layer = layer; P.nM = (layer == 0 ? NTOK : NMAIN) / 256; P.base_init(F, D / 64, P.nM * 4);
    P.ldbB = D; P.x = PP(x); P.ctx = PP(ctx);
    gemm_stream_bf(F.lds, P, F.wid, F.lane);
}

template <int Q> struct AttnStT { f32x4 o[4][Q]; float m[Q], l[Q]; };
#define V_ROWB 160
__device__ __forceinline__ void v_stage(LAS unsigned char* vl, const bf16_t* vsrc, int ld, int lane) {
    i32x4 t[4];
    asm volatile("" ::: "memory");
#pragma unroll
    for (int i = 0; i < 4; ++i) t[i] = *(const i32x4*)(vsrc + (size_t)((lane >> 3) + 8 * i) * ld + (lane & 7) * 8);
#pragma unroll
    for (int i = 0; i < 4; ++i) *(LAS i32x4*)(vl + ((lane >> 3) + 8 * i) * V_ROWB + (lane & 7) * 16) = t[i];
    asm volatile("s_waitcnt lgkmcnt(0)" ::: "memory");
}
#define ATTN_STEP(ksrc, kld, vsrc, vld, SCALE, BIAS, SKIP) do { \
    bf16x8 kf[2][2]; \
    _Pragma("unroll") for (int kt = 0; kt < 2; ++kt) _Pragma("unroll") for (int ks = 0; ks < 2; ++ks) \
        kf[kt][ks] = *(const bf16x8*)((ksrc) + (size_t)(kt * 16 + fr) * (kld) + ks * 32 + 8 * fq); \
    v_stage(vl, (vsrc), (vld), lane); \
    bf16x8 vf[4]; \
    _Pragma("unroll") for (int dt = 0; dt < 4; ++dt) { \
        const s16x4 lo = __builtin_amdgcn_ds_read_tr16_b64_v4i16((LAS s16x4*)(vl + (4 * fq + (fr >> 2)) * V_ROWB + (dt * 16 + (fr & 3) * 4) * 2)); \
        const s16x4 hi = __builtin_amdgcn_ds_read_tr16_b64_v4i16((LAS s16x4*)(vl + (16 + 4 * fq + (fr >> 2)) * V_ROWB + (dt * 16 + (fr & 3) * 4) * 2)); \
        vf[dt] = (bf16x8){lo[0], lo[1], lo[2], lo[3], hi[0], hi[1], hi[2], hi[3]}; } \
    _Pragma("unroll") for (int qt = 0; qt < QTL; ++qt) { if (SKIP(qt)) continue;        \
        f32x4 s[2]; \
        _Pragma("unroll") for (int kt = 0; kt < 2; ++kt) { s[kt] = (f32x4){0.f, 0.f, 0.f, 0.f}; \
            _Pragma("unroll") for (int ks = 0; ks < 2; ++ks) s[kt] = __builtin_amdgcn_mfma_f32_16x16x32_bf16(kf[kt][ks], qf[qt][ks], s[kt], 0, 0, 0); } \
        float mx = -INFINITY; \
        _Pragma("unroll") for (int kt = 0; kt < 2; ++kt) _Pragma("unroll") for (int j = 0; j < 4; ++j) { const float tv = s[kt][j] * (SCALE) + BIAS(qt, kt, j); s[kt][j] = tv; mx = fmaxf(mx, tv); } \
        mx = fmaxf(mx, __shfl_xor(mx, 16)); mx = fmaxf(mx, __shfl_xor(mx, 32)); \
        const float mn = fmaxf(st.m[qt], mx), al = fexp2(st.m[qt] - mn); st.m[qt] = mn; \
        float ps = 0.f; \
        _Pragma("unroll") for (int kt = 0; kt < 2; ++kt) _Pragma("unroll") for (int j = 0; j < 4; ++j) { const float pv = fexp2(s[kt][j] - mn); s[kt][j] = pv; ps += pv; } \
        st.l[qt] = st.l[qt] * al + ps; \
        const unsigned w0 = pk2(s[0][0], s[0][1]), w1 = pk2(s[0][2], s[0][3]), w2 = pk2(s[1][0], s[1][1]), w3 = pk2(s[1][2], s[1][3]); \
        const bf16x8 pf = __builtin_bit_cast(bf16x8, ((u32x4){w0, w1, w2, w3})); \
        _Pragma("unroll") for (int dt = 0; dt < 4; ++dt) st.o[dt][qt] = __builtin_amdgcn_mfma_f32_16x16x32_bf16(vf[dt], pf, st.o[dt][qt] * al, 0, 0, 0); } \
    } while (0)

template <int QTL>
__device__ __forceinline__ void attn_store(AttnStT<QTL>& st, bf16_t* dst  , int dld, int fr, int fq) {
#pragma unroll
    for (int qt = 0; qt < QTL; ++qt) {
        float l = st.l[qt]; l += __shfl_xor(l, 16); l += __shfl_xor(l, 32);
        const float inv = 1.f / l;
#pragma unroll
        for (int dt = 0; dt < 4; ++dt) { const f32x4 o = st.o[dt][qt] * inv; u32x2 w; w.x = pk2(o[0], o[1]); w.y = pk2(o[2], o[3]);
            *(u32x2*)(dst + (size_t)(qt * 16 + fr) * dld + dt * 16 + 4 * fq) = w; }
    }
}

__device__ __forceinline__ void phase_attn_l0(Frame& F) {
    constexpr int QTL = 2;
    const int wid = F.wid, lane = F.lane, fr = lane & 15, fq = lane >> 4;
    LAS unsigned char* vl = F.lds + wid * 8192;
    constexpr int NPASS = 4 / QTL, N_WIN = 256 * NPASS, N_CTXA = 16 * NPASS, N_CONV = NTOK / 64;
    const float SC = 0.125f * LOG2E;
    for (int it = F.bid; it < N_WIN + N_CTXA + N_CONV; it += F.G) {
        if (it < N_WIN + N_CTXA) {
            const bool isctx = it >= N_WIN;
            int b, kvh, qb, qh;
            if (!isctx) { const int c = it / NPASS; qh = it - c * NPASS; b = c >> 6; kvh = (c >> 5) & 1; qb = c & 31; } else { const int c2 = it - N_WIN, c = c2 / NPASS; qh = c2 - c * NPASS; b = c >> 2; kvh = (c >> 1) & 1; qb = c & 1; }
            const int g = wid >> 1, h = kvh * 4 + g;
            {
            const int qq0 = (wid & 1) * 64 + qh * (16 * QTL);
            const int qrow0 = (isctx ? NMAIN + b * CTXL : b * SEQ) + qb * 128 + qq0;
            bf16x8 qf[QTL][2];
#pragma unroll
            for (int qt = 0; qt < QTL; ++qt)
#pragma unroll
                for (int ks = 0; ks < 2; ++ks) qf[qt][ks] = *(const bf16x8*)(F_PROJ + (size_t)(qrow0 + qt * 16 + fr) * EVEN_IN + h * 64 + ks * 32 + 8 * fq);
            AttnStT<QTL> st;
            const float sink = PP(even_sink)[h] * LOG2E;
#pragma unroll
            for (int qt = 0; qt < QTL; ++qt) { st.m[qt] = sink; st.l[qt] = (fq == 0) ? 1.f : 0.f;
#pragma unroll
                for (int dt = 0; dt < 4; ++dt) st.o[dt][qt] = (f32x4){0.f, 0.f, 0.f, 0.f}; }
            const int kcol = 512 + kvh * 64, vcol = 640 + kvh * 64;
            for (int ch = isctx ? 3 : 0; ch < 5; ++ch) {
                int krow0;
                if (ch < 3) { const int kb = qb - 1 + ch; if (kb < 0 || kb >= SEQ / 128) continue; krow0 = b * SEQ + kb * 128; } else krow0 = NMAIN + b * CTXL + (ch - 3) * 128;
                for (int s32 = 0; s32 < 4; ++s32) {
                    const bf16_t* kp = F_PROJ + (size_t)(krow0 + s32 * 32) * EVEN_IN + kcol;
                    const bf16_t* vp = F_PROJ + (size_t)(krow0 + s32 * 32) * EVEN_IN + vcol;
                    if (ch == 0) {
#define SKIP_NONE(qt) false
#define SKIP_PREV(qt) ((s32 * 32 + 31) < (qq0 + qt * 16))
#define SKIP_NEXT(qt) ((s32 * 32) > (qq0 + qt * 16 + 15))
#define BIAS_PREV(qt, kt, j) ((s32 * 32 + kt * 16 + 4 * fq + j) >= (qq0 + qt * 16 + fr) ? 0.f : -INFINITY)
                        ATTN_STEP(kp, EVEN_IN, vp, EVEN_IN, SC, BIAS_PREV, SKIP_PREV);
                    } else if (ch == 2) {
#define BIAS_NEXT(qt, kt, j) ((s32 * 32 + kt * 16 + 4 * fq + j) <= (qq0 + qt * 16 + fr) ? 0.f : -INFINITY)
                        ATTN_STEP(kp, EVEN_IN, vp, EVEN_IN, SC, BIAS_NEXT, SKIP_NEXT);
                    } else {
#define BIAS_NONE(qt, kt, j) 0.f
                        ATTN_STEP(kp, EVEN_IN, vp, EVEN_IN, SC, BIAS_NONE, SKIP_NONE);
                    }
                }
            }
            attn_store(st, F_MIX + (size_t)qrow0 * D + h * 64, D, fr, fq);
            }
        } else {
            const int ci = it - N_WIN - N_CTXA, c4 = (F.tid & 127) * 4, r0 = ci * 64 + (F.tid >> 7) * 16;
            const f32x4 w0 = *(const f32x4*)(PP(even_conv_w) + c4), w1 = *(const f32x4*)(PP(even_conv_w) + 512 + c4), w2 = *(const f32x4*)(PP(even_conv_w) + 1024 + c4);
#define LOADZ(dst, row_) do { const u32x2 gc_ = *(const u32x2*)(F_PROJ + (size_t)(row_) * EVEN_IN + 1280 + c4), uu_ = *(const u32x2*)(F_PROJ + (size_t)(row_) * EVEN_IN + 1792 + c4); \
                dst = (f32x4){bflo(gc_.x) * bflo(uu_.x), bfhi(gc_.x) * bfhi(uu_.x), bflo(gc_.y) * bflo(uu_.y), bfhi(gc_.y) * bfhi(uu_.y)}; } while (0)
            const int seqmask = r0 < NMAIN ? (SEQ - 1) : (CTXL - 1);
            u32x2 gcv[18], uuv[18], gbv[16];
#pragma unroll
            for (int i = 0; i < 18; ++i) { const int row = r0 - 1 + i; const bool ok = (i == 0) ? ((r0 & seqmask) != 0) : (i == 17) ? (((r0 + 15) & seqmask) != seqmask) : true;
                const int rr = ok ? row : r0;
                gcv[i] = *(const u32x2*)(F_PROJ + (size_t)rr * EVEN_IN + 1280 + c4); uuv[i] = *(const u32x2*)(F_PROJ + (size_t)rr * EVEN_IN + 1792 + c4);
                if (!ok) { gcv[i] = (u32x2){0u, 0u}; } }
#pragma unroll
            for (int i = 0; i < 16; ++i) gbv[i] = *(const u32x2*)(F_PROJ + (size_t)(r0 + i) * EVEN_IN + 768 + c4);
            __builtin_amdgcn_sched_barrier(0);
#define ZOF(i_) ((f32x4){bflo(gcv[i_].x) * bflo(uuv[i_].x), bfhi(gcv[i_].x) * bfhi(uuv[i_].x), bflo(gcv[i_].y) * bflo(uuv[i_].y), bfhi(gcv[i_].y) * bfhi(uuv[i_].y)})
            f32x4 zp = ZOF(0), zc = ZOF(1);
#pragma unroll
            for (int i = 0; i < 16; ++i) {
                const int row = r0 + i;
                const f32x4 zn = ZOF(i + 2);
                const u32x2 gb = gbv[i];
                const f32x4 y = zp * w0 + zc * w1 + zn * w2;
                u32x2 w; w.x = pk2(bflo(gb.x) * y[0], bfhi(gb.x) * y[1]); w.y = pk2(bflo(gb.y) * y[2], bfhi(gb.y) * y[3]);
                *(u32x2*)(F_MIX + (size_t)row * D + 512 + c4) = w;
                zp = zc; zc = zn;
            }
#undef ZOF
        }
    }
}

constexpr int RW_LD = 1028;
__device__ __forceinline__ void phase_route(Frame& F, const int layer) {
    const int nrows = layer == 0 ? NTOK : NMAIN;
    LAS float* rwT = (LAS float*)F.lds;
    LAS int* cntL = (LAS int*)(F.lds + 32 * RW_LD * 4);
    LAS int* baseL = cntL + 32;
    LAS int* selE = baseL + 32;
    LAS int* selR = selE + 384;
    const float* rw = PP(router_w) + (size_t)layer * D * NEXP;
    { const f32x4* rsrc4 = (const f32x4*)rw + F.tid; LAS float* wp = rwT + ((4 * F.tid) & 31) * RW_LD + (F.tid >> 3);
      for (int it = 0; it < 4; ++it) {
        f32x4 v[4];
#pragma unroll
        for (int u = 0; u < 4; ++u) v[u] = rsrc4[(it * 4 + u) * 512];
#pragma unroll
        for (int u = 0; u < 4; ++u)
#pragma unroll
            for (int j = 0; j < 4; ++j) wp[it * 256 + u * 64 + j * RW_LD] = v[u][j];
        asm volatile("" ::: "memory"); } }
    if (F.tid < 32) cntL[F.tid] = 0;
    __syncthreads();
    const int lane = F.lane, gw = F.bid * 8 + F.wid, NGW = F.G * 8;
    const float* gam = PP(norm_ffn) + layer * D;
    int slot = F.wid;
    const float* Wd = PP(moe_w_dn) + (size_t)layer * NEXP * DFF * D; bf16_t* pd = (bf16_t*)(F.ws + WS_BC2);
    constexpr int CV_TOTAL = NEXP * 4 * 1024;
    const int cv_q = (CV_TOTAL + NGW - 1) / NGW, cv_end = min((gw + 1) * cv_q, CV_TOTAL); int cv_u = gw * cv_q;
#define CV_LOAD(v_, u0_) do { _Pragma("unroll") for (int u = 0; u < 8; ++u) { const int pr = min((u0_) + u, CV_TOTAL - 1), pnl = pr >> 10, k = pr & 1023, e = pnl >> 2, ct = pnl & 3; \
        v_[u] = *(const f32x4*)(Wd + ((size_t)e * DFF + k) * D + ct * 256 + 4 * lane); } } while (0)
#define CV_STORE(v_, u0_, uend_) do { _Pragma("unroll") for (int u = 0; u < 8; ++u) { const int pr = (u0_) + u; if (pr < (uend_)) { u32x2 w; w.x = pk2(v_[u][0], v_[u][1]); w.y = pk2(v_[u][2], v_[u][3]); \
        *(u32x2*)(pd + (size_t)pr * 256 + 4 * lane) = w; } } } while (0)
    f32x4 vn[4];
    if (gw < nrows) {
#pragma unroll
        for (int j = 0; j < 4; ++j) vn[j] = *(const f32x4*)(F_XS + (size_t)gw * D + 4 * lane + 256 * j); }
    for (int row = gw; row < nrows; row += NGW, slot += 8) {
        f32x4 v[4], h[4], cvv[8];
        const int cv_u0 = cv_u; CV_LOAD(cvv, cv_u0); cv_u += 8;
#pragma unroll
        for (int j = 0; j < 4; ++j) v[j] = vn[j];
        if (row + NGW < nrows) {
#pragma unroll
            for (int j = 0; j < 4; ++j) vn[j] = *(const f32x4*)(F_XS + (size_t)(row + NGW) * D + 4 * lane + 256 * j); }
        const float rstd = row_rstd(v); const int r = mod_row(row);
        norm_mod_store(v, rstd, gam, modp(F, layer, r, 4), modp(F, layer, r, 3), F_H + (size_t)row * D, lane, &h);
        float pe[32];
#pragma unroll
        for (int e = 0; e < 32; ++e) { float s = 0.f;
            f32x2 s2 = (f32x2){0.f, 0.f};
#pragma unroll
            for (int j = 0; j < 4; ++j) { const f32x4 w = *(const LAS f32x4*)(rwT + e * RW_LD + 4 * lane + 256 * j);
                s2 = __builtin_elementwise_fma((f32x2){h[j][0], h[j][1]}, (f32x2){w[0], w[1]}, s2); s2 = __builtin_elementwise_fma((f32x2){h[j][2], h[j][3]}, (f32x2){w[2], w[3]}, s2); }
            s = s2.x + s2.y;
            pe[e] = s; if ((e & 3) == 3) __builtin_amdgcn_sched_barrier(0); }
        float q16[16], q8[8], q4[4], q2[2], q1;
        { const bool hi = lane & 32;
#pragma unroll
          for (int i = 0; i < 16; ++i) { const float snd = hi ? pe[i] : pe[16 + i], mine = hi ? pe[16 + i] : pe[i]; q16[i] = mine + __shfl_xor(snd, 32); } }
        { const bool hi = lane & 16;
#pragma unroll
          for (int i = 0; i < 8; ++i) { const float snd = hi ? q16[i] : q16[8 + i], mine = hi ? q16[8 + i] : q16[i]; q8[i] = mine + __shfl_xor(snd, 16); } }
        { const bool hi = lane & 8;
#pragma unroll
          for (int i = 0; i < 4; ++i) { const float snd = hi ? q8[i] : q8[4 + i], mine = hi ? q8[4 + i] : q8[i]; q4[i] = mine + __shfl_xor(snd, 8); } }
        { const bool hi = lane & 4;
#pragma unroll
          for (int i = 0; i < 2; ++i) { const float snd = hi ? q4[i] : q4[2 + i], mine = hi ? q4[2 + i] : q4[i]; q2[i] = mine + __shfl_xor(snd, 4); } }
        { const bool hi = lane & 2; const float snd = hi ? q2[0] : q2[1], mine = hi ? q2[1] : q2[0]; q1 = mine + __shfl_xor(snd, 2); }
        q1 += __shfl_xor(q1, 1);
        const int myE = (lane >> 1) & 31;
        float val = q1 + PP(router_b)[layer * NEXP + myE];
        float tv[4]; int te[4];
        { int rank = 0; const int vb = __builtin_bit_cast(int, val);
#pragma unroll
          for (int e2 = 0; e2 < 32; ++e2) { const float o = __builtin_bit_cast(float, __builtin_amdgcn_readlane(vb, 2 * e2)); rank += (o > val || (o == val && e2 < myE)) ? 1 : 0; }
#pragma unroll
          for (int k = 0; k < 4; ++k) { const unsigned long long mk = __ballot(rank == k); const int src = __builtin_amdgcn_readfirstlane((int)__builtin_ctzll(mk));
              tv[k] = __builtin_bit_cast(float, __builtin_amdgcn_readlane(vb, src)); te[k] = (src >> 1) & 31; } }
        const float e1 = __expf(tv[1] - tv[0]), e2 = __expf(tv[2] - tv[0]), e3 = __expf(tv[3] - tv[0]), inv = 1.f / (1.f + e1 + e2 + e3);
        if (lane == 0) {
            *(f32x4*)(F_TOPW + (size_t)row * 4) = (f32x4){inv, e1 * inv, e2 * inv, e3 * inv};
#pragma unroll
            for (int k = 0; k < 4; ++k) { selE[slot * 4 + k] = te[k]; selR[slot * 4 + k] = atomicAdd((int*)(cntL + te[k]), 1); }
        }
        CV_STORE(cvv, cv_u0, cv_end);
    }
    for (; cv_u < cv_end; cv_u += 8) { f32x4 cvv[8]; CV_LOAD(cvv, cv_u); CV_STORE(cvv, cv_u, cv_end); }
#undef CV_LOAD
#undef CV_STORE
    __syncthreads();
    if (F.tid < 32) { const int c = cntL[F.tid]; baseL[F.tid] = c ? (int)atomicAdd(F_cnt + layer * 32 + F.tid, (unsigned)c) : 0; }
    __syncthreads();
    if (F.tid < 384) { const int s = F.tid >> 2, k = F.tid & 3; const int row = F.bid * 8 + (s & 7) + (s >> 3) * NGW;
        if (row < nrows) { const int e = selE[F.tid], pos = baseL[e] + selR[F.tid]; F_POS[(size_t)row * 4 + k] = e | (pos << 8); F_LIST[(size_t)e * NTOK + pos] = row; } }
    __syncthreads();
}

struct MoeLds { LAS int *mtp, *roff, *mtq, *nz; };
__device__ __forceinline__ MoeLds moe_lds(Frame& F) { MoeLds L; L.mtp = (LAS int*)(F.lds + 2 * STAGE_B); L.roff = L.mtp + 40; L.mtq = L.roff + 40; L.nz = L.mtq + 40; return L; }
__device__ __forceinline__ void moe_prefix(Frame& F, const int layer, const MoeLds& L) {
    if (F.tid < 64) { const int e = F.lane & 31; const int c = (int)__hip_atomic_load(F_cnt + layer * 32 + e, __ATOMIC_RELAXED, __HIP_MEMORY_SCOPE_AGENT);
        const int mt = (c + 255) >> 8; int a = mt, b = c, q = mt > 0 ? mt - 1 : 0, z = mt > 0 ? 1 : 0;
#pragma unroll
        for (int o = 1; o < 32; o <<= 1) { const int ua = __shfl_up(a, o, 32), ub = __shfl_up(b, o, 32), uq = __shfl_up(q, o, 32), uz = __shfl_up(z, o, 32); if (e >= o) { a += ua; b += ub; q += uq; z += uz; } }
        if (F.lane < 32) { L.mtp[e + 1] = a; L.roff[e + 1] = b; L.mtq[e + 1] = q; if (mt > 0) L.nz[z - 1] = e; if (e == 31) L.nz[32] = z; if (e == 0) { L.mtp[0] = 0; L.roff[0] = 0; L.mtq[0] = 0; } } }
    __syncthreads();
}
struct PolMoe : PolBase {
    const float* W; MoeLds L; int layer, nct, round; size_t bc_off; mutable int ehint = 0;
    __device__ __forceinline__ bool find(int i, int& e, int& ct, int& rbase, int& ro, int& cnt) const { int T; if (!tileL(i, T)) return false;
        if (round == 0) { const int q = T / nct; ct = T - q * nct; e = __builtin_amdgcn_readfirstlane(L.nz[q]); rbase = 0; }
        else { LAS int* pf = round == 1 ? L.mtq : L.mtp; e = ehint; while (pf[e + 1] * nct <= T) ++e;
            ehint = e;
            e = __builtin_amdgcn_readfirstlane(e);
            const int mq = __builtin_amdgcn_readfirstlane(pf[e + 1] - pf[e]), w = T - __builtin_amdgcn_readfirstlane(pf[e]) * nct; ct = w / mq; rbase = ((round == 1 ? 1 : 0) + w - ct * mq) * 256; }
        ro = __builtin_amdgcn_readfirstlane(L.roff[e]); cnt = __builtin_amdgcn_readfirstlane(L.roff[e + 1]) - ro; return true; }
    __device__ __forceinline__ bf16_t* panel(int e, int ct) const { return (bf16_t*)(ws + bc_off) + (size_t)(e * nct + ct) * (1024 * 256); }
};
struct PolMoe1 : PolMoe {
    __device__ __forceinline__ unsigned list_voff(const TD& td) const { return 4u * (unsigned)(td.i0 * NTOK + td.i2 + lane * 4); }
    __device__ __forceinline__ void late(TD& td, const LAS int* ll) const { const int cl = td.i4 - 1 - td.i2;
#pragma unroll
        for (int i2 = 0; i2 < 2; ++i2) { int rl = prow(i2); rl = rl < cl ? rl : cl; td.aoff[i2] = (unsigned)((ll[rl] * D + pcol()) * 2); } }
    __device__ __forceinline__ unsigned bias_voff(const TD& td) const { return 4u * (unsigned)((layer * NEXP + td.i0) * (2 * DFF) + (lane >> 5) * DFF + td.i1 * 128 + (lane & 31) * 4); }
    __device__ __forceinline__ bool get(int i, TD& td) const { int e, ct, rbase, ro, cnt; if (!find(i, e, ct, rbase, ro, cnt)) return false;
        const int* list = (const int*)(ws + WS_LIST) + (size_t)e * NTOK; td.A = (const bf16_t*)(ws + WS_H);
        if (!has_list || i == 0) {
#pragma unroll
            for (int i2 = 0; i2 < 4; ++i2) { int rr = rbase + prow(i2); rr = rr < cnt ? rr : cnt - 1; td.aoff[i2] = (unsigned)((list[rr] * D + pcol()) * 2); } }
        if (round == 0) { td.B = W + ((size_t)(layer * NEXP + e) * D + wid * 8) * (2 * DFF) + ct * 128; td.ldb = 2 * DFF; td.bco = panel(e, ct); } else { td.B = panel(e, ct); td.bco = nullptr; }
        td.i0 = e; td.i1 = ct; td.i2 = rbase; td.i3 = ro; td.i4 = cnt; return true; }
    __device__ __forceinline__ void epi(f32x4 (&acc)[8][4], const TD& td, const LAS float* bl) const { (void)bl; EPI_GEOM; const int e = td.i0, ct = td.i1, rbase = td.i2, ro = td.i3, cnt = td.i4;
        bf16_t* ACT = (bf16_t*)(ws + WS_ACT);
#pragma unroll
        for (int n = 0; n < 2; ++n) { const int gc = ct * 128 + wc * 32 + n * 16 + 4 * fq;
            const int gl = wc * 32 + n * 16 + 4 * fq; const f32x4 bg = bl ? *(const LAS f32x4*)(bl + gl) : *(const f32x4*)(bias + (size_t)(layer * NEXP + e) * (2 * DFF) + gc), bu = bl ? *(const LAS f32x4*)(bl + 128 + gl) : *(const f32x4*)(bias + (size_t)(layer * NEXP + e) * (2 * DFF) + DFF + gc);
#pragma unroll
            for (int m = 0; m < 8; ++m) { const int r = rbase + wr * 128 + m * 16 + fr; float a[4];
#pragma unroll
                for (int j = 0; j < 4; ++j) { const float gg = fminf(acc[m][n][j] + bg[j], 7.f), uu = __builtin_amdgcn_fmed3f(acc[m][n + 2][j] + bu[j], -7.f, 7.f);
                    a[j] = (uu + 1.f) * gg * __builtin_amdgcn_rcpf(1.f + fexp2(-1.702f * LOG2E * gg)); }
                if (r < cnt) { u32x2 w; w.x = pk2(a[0], a[1]); w.y = pk2(a[2], a[3]); *(u32x2*)(ACT + (size_t)(ro + r) * DFF + gc) = w; } } } }
};
struct PolMoe2 : PolMoe {
    __device__ __forceinline__ unsigned bias_voff(const TD& td) const { return 4u * (unsigned)((layer * NEXP + td.i0) * D + td.i1 * 256 + lane * 4); }
    __device__ __forceinline__ bool get(int i, TD& td) const { int e, ct, rbase, ro, cnt; if (!find(i, e, ct, rbase, ro, cnt)) return false;
        td.A = (const bf16_t*)(ws + WS_ACT);
#pragma unroll
        for (int i2 = 0; i2 < 4; ++i2) { int rr = rbase + prow(i2); rr = rr < cnt ? rr : cnt - 1; td.aoff[i2] = (unsigned)(((ro + rr) * DFF + pcol()) * 2); }
        td.B = panel(e, ct); td.bco = nullptr;
        td.i0 = e; td.i1 = ct; td.i2 = rbase; td.i3 = ro; td.i4 = cnt; return true; }
    __device__ __forceinline__ void epi(f32x4 (&acc)[8][4], const TD& td, const LAS float* bl) const { (void)bl; EPI_GEOM; const int e = td.i0, ct = td.i1, rbase = td.i2, ro = td.i3, cnt = td.i4;
        bf16_t* Y = (bf16_t*)(ws + WS_Y);
#pragma unroll
        for (int n = 0; n < 4; ++n) { const int c = ct * 256 + wc * 64 + n * 16 + 4 * fq; const f32x4 bv = bl ? *(const LAS f32x4*)(bl + wc * 64 + n * 16 + 4 * fq) : *(const f32x4*)(bias + (size_t)(layer * NEXP + e) * D + c);
#pragma unroll
            for (int m = 0; m < 8; ++m) { const int r = rbase + wr * 128 + m * 16 + fr;
                if (r < cnt) { u32x2 w; w.x = pk2(acc[m][n][0] + bv[0], acc[m][n][1] + bv[1]); w.y = pk2(acc[m][n][2] + bv[2], acc[m][n][3] + bv[3]); *(u32x2*)(Y + (size_t)(ro + r) * D + c) = w; } } } }
};
__device__ __forceinline__ void phase_moe1(Frame& F, const XcdBarrier& bar, const bool use_bar, const int layer) {
    const MoeLds L = moe_lds(F);
    moe_prefix(F, layer, L);
    const int ne = __builtin_amdgcn_readfirstlane(L.nz[32]), tq = __builtin_amdgcn_readfirstlane(L.mtq[32]);
    const float* W = PP(moe_w_gu); const float* bias = PP(moe_b_gu);
    { PolMoe1 P; P.L = L; P.layer = layer; P.nct = 8; P.round = 0; P.bc_off = WS_BC; P.base_init(F, D / 64, ne * 8); P.bfm = false; P.W = W; P.bias = bias;
      { const int l2 = F.lane & 31; P.lcolb = 4u * (unsigned)((F.lane >> 5) * DFF + 4 * l2); P.woff = 2u * (unsigned)(((4 * l2) >> 5) * 64 + (F.lane >> 5) * 32 + ((4 * l2) & 31)); }
      gemm_stream(F.lds, P, F.wid, F.lane); }
    if (use_bar) xcd_barrier(bar);
    { PolMoe1 P; P.L = L; P.layer = layer; P.nct = 8; P.round = 1; P.bc_off = WS_BC; P.base_init(F, D / 64, tq * 8); P.ldbB = 256; P.W = W; P.bias = bias; P.has_bias = true; P.has_list = true; P.listp = (const int*)(F.ws + WS_LIST);
      gemm_stream_bf(F.lds, P, F.wid, F.lane); }
}
__device__ __forceinline__ void phase_moe2(Frame& F, const int layer) {
    const MoeLds L = moe_lds(F);
    moe_prefix(F, layer, L);
    PolMoe2 P; P.L = L; P.layer = layer; P.nct = 4; P.round = 2; P.bc_off = WS_BC2; P.base_init(F, DFF / 64, __builtin_amdgcn_readfirstlane(L.mtp[32]) * 4); P.ldbB = 256; P.W = nullptr; P.bias = PP(moe_b_dn); P.has_bias = true;
    gemm_stream_bf(F.lds, P, F.wid, F.lane);
}

__device__ __forceinline__ void phase_combine(Frame& F, const int layer) {
    const MoeLds ML = moe_lds(F); LAS int* roff = ML.roff;
    moe_prefix(F, layer, ML);
    const int nrows = layer == 0 ? NTOK : NMAIN, lane = F.lane;
    const int gw = F.bid * 8 + F.wid, NGW = F.G * 8;
    i32x4 ps_n = (i32x4){0, 0, 0, 0}; f32x4 tw_n = (f32x4){0.f, 0.f, 0.f, 0.f}, tw_c = tw_n;
    u32x2 y_c[4][4], y_n[4][4]; f32x4 xs_c[4], xs_n[4];
#define CMB_IDX(row_) do { if ((row_) < nrows) { ps_n = *(const i32x4*)(F_POS + (size_t)(row_) * 4); tw_n = *(const f32x4*)(F_TOPW + (size_t)(row_) * 4); } } while (0)
#define CMB_DATA(row_, Y_, XS_) do { if ((row_) < nrows) { \
        _Pragma("unroll") for (int k = 0; k < 4; ++k) { const int e = ps_n[k] & 255, pos = ps_n[k] >> 8; const bf16_t* y = F_Y + (size_t)(roff[e] + pos) * D; \
            _Pragma("unroll") for (int j = 0; j < 4; ++j) Y_[k][j] = *(const u32x2*)(y + 4 * lane + 256 * j); } \
        _Pragma("unroll") for (int j = 0; j < 4; ++j) XS_[j] = *(const f32x4*)(F_XS + (size_t)(row_) * D + 4 * lane + 256 * j); } } while (0)
    CMB_IDX(gw); CMB_DATA(gw, y_c, xs_c); tw_c = tw_n; CMB_IDX(gw + NGW);
    for (int row = gw; row < nrows; row += NGW) {
        CMB_DATA(row + NGW, y_n, xs_n); const f32x4 tw_nn = tw_n; CMB_IDX(row + 2 * NGW);
        const int r = mod_row(row); const float* g2 = modp(F, layer, r, 5);
        f32x4 v[4];
#pragma unroll
        for (int j = 0; j < 4; ++j) v[j] = (f32x4){0.f, 0.f, 0.f, 0.f};
#pragma unroll
        for (int k = 0; k < 4; ++k) { const float w = tw_c[k];
#pragma unroll
            for (int j = 0; j < 4; ++j) { const u32x2 u = y_c[k][j]; v[j][0] += w * bflo(u.x); v[j][1] += w * bfhi(u.x); v[j][2] += w * bflo(u.y); v[j][3] += w * bfhi(u.y); } }
#pragma unroll
        for (int j = 0; j < 4; ++j) { const int c = 4 * lane + 256 * j; const f32x4 gv = *(const f32x4*)(g2 + c); v[j] = xs_c[j] + gv * v[j]; }
        const float rstd = row_rstd(v);
        if (layer == 0) {
#pragma unroll
            for (int j = 0; j < 4; ++j) *(f32x4*)(F_XS + (size_t)row * D + 4 * lane + 256 * j) = v[j];
            norm_mod_store(v, rstd, PP(norm_mix) + D, modp(F, 1, r, 1), modp(F, 1, r, 0), F_H + (size_t)row * D, lane);
        } else {
#pragma unroll
            for (int j = 0; j < 4; ++j) { const int c = 4 * lane + 256 * j; const f32x4 g = *(const f32x4*)(PP(final_norm) + c); *(f32x4*)(((float*)ldp(F, (int)__builtin_offsetof(Params, out))) + (size_t)row * D + c) = v[j] * rstd * g; }
        }
        tw_c = tw_nn;
#pragma unroll
        for (int k = 0; k < 4; ++k)
#pragma unroll
            for (int j = 0; j < 4; ++j) y_c[k][j] = y_n[k][j];
#pragma unroll
        for (int j = 0; j < 4; ++j) xs_c[j] = xs_n[j];
        __builtin_amdgcn_sched_barrier(0);
    }
#undef CMB_IDX
#undef CMB_DATA
}

struct PolInproj1 : PolBase {
    const float* W;
    __device__ __forceinline__ bool get(int i, TD& td) const { int t; if (!tileL(i, t)) return false; constexpr int N_MAIN_T = (NMAIN / 256) * 10; int pm, pn;
        if (t < N_MAIN_T) dense_tile(t, NMAIN / 256, 10, pm, pn); else { const int c = t - N_MAIN_T; pm = NMAIN / 256 + (c & 3); pn = 2 + (c >> 2); }
        td.A = (const bf16_t*)(ws + WS_H); dense_aoff(td, pm * 256, D);
        td.B = (const bf16_t*)(ws + WB_OIN) + pn * 256; td.i0 = pm; td.i1 = pn; return true; }
    __device__ __forceinline__ void epi(f32x4 (&acc)[8][4], const TD& td, const LAS float* bl) const { (void)bl; EPI_GEOM; const int pm = td.i0, pn = td.i1;
        if (pn < 6) { bf16_t* PROJ = (bf16_t*)(ws + WS_PROJ);
#pragma unroll
            for (int m = 0; m < 8; ++m) { const int row = pm * 256 + wr * 128 + m * 16 + fr;
#pragma unroll
                for (int n = 0; n < 4; ++n) { u32x2 w; w.x = pk2(acc[m][n][0], acc[m][n][1]); w.y = pk2(acc[m][n][2], acc[m][n][3]);
                    *(u32x2*)(PROJ + (size_t)row * QKV_LD + pn * 256 + wc * 64 + n * 16 + 4 * fq) = w; } }
        } else { const int g = pn - 6, ri = wc >> 1; bf16_t* Z = (bf16_t*)(ws + WS_Z);
#pragma unroll
            for (int m = 0; m < 8; ++m) { const int row = pm * 256 + wr * 128 + m * 16 + fr, b = row >> 12, n1 = (row >> 6) & 63, n2 = row & 63;
                bf16_t* zb = Z + ((((size_t)(b * 64 + n1) * 2 + ri) * 64 + n2) * 512) + g * 128 + (wc & 1) * 64;
#pragma unroll
                for (int n = 0; n < 4; ++n) { u32x2 w; w.x = pk2(acc[m][n][0], acc[m][n][1]); w.y = pk2(acc[m][n][2], acc[m][n][3]); *(u32x2*)(zb + n * 16 + 4 * fq) = w; } } } }
};
__device__ __forceinline__ void phase_inproj_l1(Frame& F) {
    PolInproj1 P; P.base_init(F, D / 64, (NMAIN / 256) * 10 + (NCTX / 256) * 4); P.ldbB = 2560;
    gemm_stream_bf(F.lds, P, F.wid, F.lane);
}

struct PolFour : PolBase {
    int stage;
    __device__ __forceinline__ bool get(int i, TD& td) const { int L; if (!tileL(i, L)) return false; const int b = L >> 7, ct = L & 127;
        td.A = (const bf16_t*)(ws + (stage == 1 ? WS_M1 : WS_M2)); dense_aoff(td, 0, 128);
        td.B = (const bf16_t*)(ws + (stage == 1 ? WS_Z : WS_A1)) + (size_t)b * 128 * 32768 + ct * 256; td.i0 = b; td.i1 = ct; return true; }
    __device__ __forceinline__ void epi(f32x4 (&acc)[8][4], const TD& td, const LAS float* bl) const { (void)bl; EPI_GEOM; const int b = td.i0, ct = td.i1;
        if (wr != 0) return;
        if (stage == 1) { const f32x2* TW = (const f32x2*)(ws + WS_TW); bf16_t* A1 = (bf16_t*)(ws + WS_A1);
#pragma unroll
            for (int m = 0; m < 4; ++m) { const int k1 = m * 16 + fr;
#pragma unroll
                for (int n = 0; n < 4; ++n) { const int col = ct * 256 + wc * 64 + n * 16 + 4 * fq, n2 = col >> 9, c = col & 511;
                    const f32x2 tw = TW[n2 * k1]; const f32x4 re = acc[m][n], im = acc[m + 4][n];
                    const f32x4 ore = re * tw.x + im * tw.y, oim = im * tw.x - re * tw.y; u32x2 w0, w1;
                    w0.x = pk2(ore[0], ore[1]); w0.y = pk2(ore[2], ore[3]); w1.x = pk2(oim[0], oim[1]); w1.y = pk2(oim[2], oim[3]);
                    *(u32x2*)(A1 + ((((size_t)(b * 2 + 0) * 64 + n2) * 64 + k1) * 512) + c) = w0;
                    *(u32x2*)(A1 + ((((size_t)(b * 2 + 1) * 64 + n2) * 64 + k1) * 512) + c) = w1; } }
        } else { const float scl = 1.f / 724.0773439350247f; bf16_t* MIX = (bf16_t*)(ws + WS_MIX);
#pragma unroll
            for (int m = 0; m < 4; ++m) { const int k2 = m * 16 + fr;
#pragma unroll
                for (int n = 0; n < 4; ++n) { const int col = ct * 256 + wc * 64 + n * 16 + 4 * fq, k1 = col >> 9, c = col & 511;
                    const f32x4 o = acc[m][n] * scl; u32x2 w; w.x = pk2(o[0], o[1]); w.y = pk2(o[2], o[3]);
                    *(u32x2*)(MIX + (size_t)(b * SEQ + k1 + 64 * k2) * D + 512 + c) = w; } } } }
};

__device__ __forceinline__ void phase_attn_l1(Frame& F) {
    constexpr int QTL = 4;
    const int wid = F.wid, lane = F.lane, fr = lane & 15, fq = lane >> 4;
    constexpr int N_NA = NB * 64, N_F1 = NB * 128;
    const float SC = 0.125f * LOG2E;
    for (int it = F.bid; it < N_NA; it += F.G) {
            LAS unsigned char* vl = F.lds + wid * 8192;
            LAS float* rp = (LAS float*)(vl + 5120);
            const int b = it >> 6, r = it & 63, h = wid;
            for (int i = lane; i < 465; i += 64) rp[i] = PP(odd_rpb)[h * 465 + i] * LOG2E;
            for (int qh = 0; qh < 4 / QTL; ++qh) {
            const int qc0 = qh * (16 * QTL), qrow0 = b * SEQ + r * 64 + qc0;
            bf16x8 qf[QTL][2];
#pragma unroll
            for (int qt = 0; qt < QTL; ++qt)
#pragma unroll
                for (int ks = 0; ks < 2; ++ks) qf[qt][ks] = *(const bf16x8*)(F_PROJ + (size_t)(qrow0 + qt * 16 + fr) * QKV_LD + h * 64 + ks * 32 + 8 * fq);
            AttnStT<QTL> st;
#pragma unroll
            for (int qt = 0; qt < QTL; ++qt) { st.m[qt] = -1e30f; st.l[qt] = 0.f;
#pragma unroll
                for (int dt = 0; dt < 4; ++dt) st.o[dt][qt] = (f32x4){0.f, 0.f, 0.f, 0.f}; }
            const int r0 = min(max(r - 4, 0), 56);
            int c0q[QTL];
#pragma unroll
            for (int qt = 0; qt < QTL; ++qt) c0q[qt] = min(max(qc0 + qt * 16 + fr - 8, 0), 48);
            for (int s = 0; s < 16; ++s) {
                const int kr = r0 + (s >> 1), half = s & 1;
                const bf16_t* kp = F_PROJ + (size_t)(b * SEQ + kr * 64 + half * 32) * QKV_LD + 512 + h * 64;
                const bf16_t* vp = kp + 512;
                const LAS float* rpr = rp + (kr - r + 7) * 31 + 15;
#define SKIP_NA(qt) ({ const int qlo_ = qc0 + qt * 16, wlo_ = min(max(qlo_ - 8, 0), 48), whi_ = min(max(qlo_ + 15 - 8, 0), 48) + 15; (half * 32 + 31 < wlo_) || (half * 32 > whi_); })
#define BIAS_NA(qt, kt, j) ({ const int kc = half * 32 + kt * 16 + 4 * fq + j; const int dc = kc - (qc0 + qt * 16 + fr); (kc >= c0q[qt] && kc < c0q[qt] + 16) ? rpr[dc] : -INFINITY; })
                ATTN_STEP(kp, QKV_LD, vp, QKV_LD, SC, BIAS_NA, SKIP_NA);
            }
            for (int s = 0; s < 8; ++s) {
                const bf16_t* kp = F_PROJ + (size_t)(NMAIN + b * CTXL + s * 32) * QKV_LD + 512 + h * 64;
                const bf16_t* vp = kp + 512;
                ATTN_STEP(kp, QKV_LD, vp, QKV_LD, SC, BIAS_NONE, SKIP_NONE);
            }
            attn_store(st, F_MIX + (size_t)qrow0 * D + h * 64, D, fr, fq);
            }
    }
    __syncthreads();
    PolFour P; P.stage = 1; P.base_init(F, 2, N_F1); P.ldbB = 32768;
    gemm_stream_bf(F.lds, P, F.wid, F.lane);
}

__device__ __forceinline__ void phase_fst2(Frame& F) {
    PolFour P; P.stage = 2; P.base_init(F, 2, NB * 128); P.ldbB = 32768;
    gemm_stream_bf(F.lds, P, F.wid, F.lane);
}

__global__ void __launch_bounds__(512, 2) fwd_kernel(Params p) {
    extern __shared__ __attribute__((aligned(16))) unsigned char lds_raw[];
    Frame F;
    F.lds = (LAS unsigned char*)lds_raw;
    F.tid = threadIdx.x; F.lane = F.tid & 63; F.wid = __builtin_amdgcn_readfirstlane(F.tid >> 6); F.bid = blockIdx.x; F.G = gridDim.x;
    unsigned char* ws = p.ws; F.ws = ws;
    volatile LAS unsigned* MISC = (volatile LAS unsigned*)(F.lds + MISC_OFF);
    if (F.tid < 64) MISC[F.tid] = 0u;
    if (F.tid == 64) { LAS unsigned long long* LP = (LAS unsigned long long*)(F.lds + PARAM_OFF);
        LP[0] = (unsigned long long)p.x; LP[1] = (unsigned long long)p.c; LP[2] = (unsigned long long)p.ctx; LP[3] = (unsigned long long)p.c_ctx; LP[4] = (unsigned long long)p.ada_w; LP[5] = (unsigned long long)p.ada_b;
        LP[6] = (unsigned long long)p.norm_mix; LP[7] = (unsigned long long)p.norm_ffn; LP[8] = (unsigned long long)p.even_w_in; LP[9] = (unsigned long long)p.even_w_out; LP[10] = (unsigned long long)p.even_conv_w;
        LP[11] = (unsigned long long)p.even_sink; LP[12] = (unsigned long long)p.odd_w_in; LP[13] = (unsigned long long)p.odd_w_out; LP[14] = (unsigned long long)p.odd_rpb; LP[15] = (unsigned long long)p.router_w;
        LP[16] = (unsigned long long)p.router_b; LP[17] = (unsigned long long)p.moe_w_gu; LP[18] = (unsigned long long)p.moe_b_gu; LP[19] = (unsigned long long)p.moe_w_dn; LP[20] = (unsigned long long)p.moe_b_dn;
        LP[21] = (unsigned long long)p.final_norm; LP[22] = (unsigned long long)p.out; }
    __syncthreads();
    const int lo = p.ph_lo, hi = p.ph_hi;
    XcdBarrier bar; bar.bar = (unsigned*)(ws + WS_CTL) + CW_BAR; bar.x = 0; bar.st = MISC + 8;
    if (hi - lo > 1) bar = xcd_barrier_post((unsigned*)(ws + WS_CTL) + CW_BAR, MISC + 8);
#define RUN_PHASE(ph, call) do { if (PH_ON(ph) && lo <= (ph) && (ph) < hi) { call; if (PH_REP(ph)) { xcd_barrier(bar); call; } } if (lo <= (ph) && (ph) + 1 < hi) xcd_barrier(bar); } while (0)
    RUN_PHASE(PH_PREP, phase_prep(F));
    RUN_PHASE(PH_NORM1_0, phase_norm1_l0(F));
    RUN_PHASE(PH_INPROJ_0, phase_inproj_l0(F));
    RUN_PHASE(PH_ATTN_0, phase_attn_l0(F));
    RUN_PHASE(PH_OUTPROJ_0, phase_outproj(F, 0));
    RUN_PHASE(PH_ROUTE_0, phase_route(F, 0));
    RUN_PHASE(PH_MOE1_0, phase_moe1(F, bar, hi - lo > 1, 0));
    RUN_PHASE(PH_MOE2_0, phase_moe2(F, 0));
    RUN_PHASE(PH_COMB_0, phase_combine(F, 0));
    RUN_PHASE(PH_INPROJ_1, phase_inproj_l1(F));
    RUN_PHASE(PH_ATTN_1, phase_attn_l1(F));
    RUN_PHASE(PH_FST2_1, phase_fst2(F));
    RUN_PHASE(PH_OUTPROJ_1, phase_outproj(F, 1));
    RUN_PHASE(PH_ROUTE_1, phase_route(F, 1));
    RUN_PHASE(PH_MOE1_1, phase_moe1(F, bar, hi - lo > 1, 1));
    RUN_PHASE(PH_MOE2_1, phase_moe2(F, 1));
    RUN_PHASE(PH_FINAL, phase_combine(F, 1));
}

extern "C" void kernel_launch(void* const* d_in, const int* in_sizes, int n_in, void* d_out, int out_size, void* d_ws, size_t ws_size, hipStream_t stream) {
    static int grid = 0;
    if (grid == 0) {
        if (n_in != 22 || ws_size < WS_END) { fprintf(stderr, "kernel_launch: unexpected inputs (n_in %d, ws %zu)\n", n_in, ws_size); grid = -1; return; }
        int dev = 0, cus = 0, per_cu = 0;
        hipGetDevice(&dev);
        hipDeviceGetAttribute(&cus, hipDeviceAttributeMultiprocessorCount, dev);
        hipFuncSetAttribute((const void*)fwd_kernel, hipFuncAttributeMaxDynamicSharedMemorySize, LDS_BYTES);
        hipOccupancyMaxActiveBlocksPerMultiprocessor(&per_cu, (const void*)fwd_kernel, 512, LDS_BYTES);
        if (per_cu < 1) { fprintf(stderr, "kernel_launch: occupancy query says %d blocks/CU\n", per_cu); per_cu = 1; }
        (void)hipGetLastError();
        grid = cus;
    }
    if (grid < 0) return;
    hipMemsetAsync((char*)d_ws + WS_CTL, 0, CTL_BYTES, stream);
    Params p{};
    const float** pp = (const float**)&p;
    for (int i = 0; i < 22; ++i) pp[i] = (const float*)d_in[i];
    p.out = (float*)d_out; p.ws = (unsigned char*)d_ws;
#if N_LAUNCH_MODE == 1
    for (int ph = 0; ph < NPHASE; ++ph) { p.ph_lo = ph; p.ph_hi = ph + 1; hipLaunchKernelGGL(fwd_kernel, dim3(grid), dim3(512), LDS_BYTES, stream, p); }
#else
    p.ph_lo = 0; p.ph_hi = NPHASE;
    void* args[] = {&p};
    hipError_t e = hipLaunchCooperativeKernel((const void*)fwd_kernel, dim3(grid), dim3(512), args, LDS_BYTES, stream);
    if (e != hipSuccess) fprintf(stderr, "kernel_launch: cooperative launch failed: %s (grid %d)\n", hipGetErrorString(e), grid);
#endif
}
```

```cpp
#include <hip/hip_runtime.h>
#include <cstdio>
#include <cstdint>

#ifndef N_LAUNCH_MODE
#define N_LAUNCH_MODE 0
#endif

#ifndef PHASE_MASK
#define PHASE_MASK 0x1FFFF
#endif
#define PH_ON(ph) ((PHASE_MASK >> (ph)) & 1)
#ifndef REPEAT_MASK
#define REPEAT_MASK 0
#endif
#define PH_REP(ph) ((REPEAT_MASK >> (ph)) & 1)
#define LAS __attribute__((address_space(3)))
#define GAS __attribute__((address_space(1)))
typedef unsigned short bf16_t;
typedef short bf16x8 __attribute__((ext_vector_type(8)));
typedef short s16x4 __attribute__((ext_vector_type(4)));
typedef float f32x4 __attribute__((ext_vector_type(4)));
typedef float f32x2 __attribute__((ext_vector_type(2)));
typedef int i32x4 __attribute__((ext_vector_type(4)));
typedef unsigned u32x2 __attribute__((ext_vector_type(2)));
typedef unsigned u32x4 __attribute__((ext_vector_type(4)));

constexpr int D = 1024, NB = 4, SEQ = 4096, CTXL = 256;
constexpr int NMAIN = NB * SEQ, NCTX = NB * CTXL, NTOK = NMAIN + NCTX;
constexpr int EVEN_IN = 2304, NEXP = 32, DFF = 1024;
constexpr int QKV_LD = 1536;
constexpr float NORM_EPS = 1e-6f;
constexpr float LOG2E = 1.4426950408889634f;

constexpr size_t MiB = 1ull << 20;
constexpr size_t WS_CTL = 0, CTL_BYTES = 1 * MiB;
constexpr size_t WS_MOD = 1 * MiB;
constexpr size_t WS_M1 = 2 * MiB;
constexpr size_t WS_M2 = WS_M1 + 65536;
constexpr size_t WS_ROPE = WS_M2 + 65536;
constexpr size_t WS_TW = WS_ROPE + 8192;
constexpr size_t WS_WF = 4 * MiB;
constexpr size_t WS_TOPW = 8 * MiB;
constexpr size_t WS_POS = 9 * MiB;
constexpr size_t WS_LIST = 12 * MiB;
constexpr size_t WS_H = 16 * MiB;
constexpr size_t WS_MIX = 52 * MiB;
constexpr size_t WS_XS = 88 * MiB;
constexpr size_t WS_PROJ = 160 * MiB;
constexpr size_t WS_Z = 240 * MiB;
constexpr size_t WS_A1 = 304 * MiB;
constexpr size_t WS_ACT = 368 * MiB;
constexpr size_t WS_Y = 512 * MiB;
constexpr size_t WS_WB = 656 * MiB;
constexpr size_t WB_EIN = WS_WB, WB_EOUT = WB_EIN + (size_t)D * EVEN_IN * 2, WB_OIN = WB_EOUT + (size_t)D * D * 2, WB_OOUT = WB_OIN + (size_t)D * 2560 * 2;
constexpr size_t WS_BC = 672 * MiB;
constexpr size_t WS_BC2 = WS_BC + 128 * MiB;
constexpr size_t WS_END = 864 * MiB;
constexpr int CW_BAR = 4096;
constexpr int CW_CNT = 8192;

constexpr int LDS_BYTES = 147456;
constexpr int PARAM_OFF = LDS_BYTES - 512;
constexpr int MISC_OFF = LDS_BYTES - 256;
constexpr int A_TILE_B = 32768, B_ROWB = 544, B_TILE_B = 64 * B_ROWB, STAGE_B = A_TILE_B + B_TILE_B;
static_assert(2 * STAGE_B + 1024 + 8192 <= PARAM_OFF, "LDS");

enum { PH_PREP = 0, PH_NORM1_0, PH_INPROJ_0, PH_ATTN_0, PH_OUTPROJ_0, PH_ROUTE_0, PH_MOE1_0, PH_MOE2_0, PH_COMB_0,
       PH_INPROJ_1, PH_ATTN_1, PH_FST2_1, PH_OUTPROJ_1, PH_ROUTE_1, PH_MOE1_1, PH_MOE2_1, PH_FINAL, NPHASE };

struct Params {
    const float *x, *c, *ctx, *c_ctx, *ada_w, *ada_b, *norm_mix, *norm_ffn, *even_w_in, *even_w_out, *even_conv_w, *even_sink,
                *odd_w_in, *odd_w_out, *odd_rpb, *router_w, *router_b, *moe_w_gu, *moe_b_gu, *moe_w_dn, *moe_b_dn, *final_norm;
    float* out; unsigned char* ws; int ph_lo, ph_hi;
};

__device__ __forceinline__ unsigned pk2(float lo, float hi) { unsigned r; asm("v_cvt_pk_bf16_f32 %0, %1, %2" : "=v"(r) : "v"(lo), "v"(hi)); return r; }
__device__ __forceinline__ float bflo(unsigned u) { return __builtin_bit_cast(float, u << 16); }
__device__ __forceinline__ float bfhi(unsigned u) { return __builtin_bit_cast(float, u & 0xffff0000u); }
__device__ __forceinline__ f32x4 ld_bf4(const bf16_t* p) { const u32x2 u = *(const u32x2*)p; return (f32x4){bflo(u.x), bfhi(u.x), bflo(u.y), bfhi(u.y)}; }
__device__ __forceinline__ void st_bf4(bf16_t* p, const f32x4 v) { u32x2 w; w.x = pk2(v[0], v[1]); w.y = pk2(v[2], v[3]); *(u32x2*)p = w; }
__device__ __forceinline__ float wave_sum(float v) {
#pragma unroll
    for (int o = 1; o < 64; o <<= 1) v += __shfl_xor(v, o);
    return v;
}
__device__ __forceinline__ float fexp2(float x) { return __builtin_amdgcn_exp2f(x); }

__device__ __forceinline__ u32x4 widen16(unsigned ax, unsigned ay, unsigned bx, unsigned by) {
    asm volatile("s_nop 1\n\tv_permlane16_swap_b32 %0, %1\n\tv_permlane16_swap_b32 %2, %3" : "+v"(ax), "+v"(bx), "+v"(ay), "+v"(by));
    return (u32x4){ax, ay, bx, by}; }
#define WIDE_COL(np_, fq_) (((np_) + ((fq_) & 1)) * 16 + ((fq_) >> 1) * 8)
__device__ __forceinline__ void fullline(const u32x4 w0, const u32x4 w1, const bool odd, u32x4& d1, u32x4& d2) {
#pragma unroll
    for (int q = 0; q < 4; ++q) { const unsigned snd = odd ? w0[q] : w1[q]; const unsigned rcv = (unsigned)__builtin_amdgcn_update_dpp(0, (int)snd, 0xB1, 0xF, 0xF, true);
        d1[q] = odd ? rcv : w0[q]; d2[q] = odd ? w1[q] : rcv; } }
#define FL_COL(fr_, fq_) ((((fr_) & 1) ? 32 : 0) + WIDE_COL(0, fq_))
#define PK4W(A0, A1) widen16(pk2((A0)[0], (A0)[1]), pk2((A0)[2], (A0)[3]), pk2((A1)[0], (A1)[1]), pk2((A1)[2], (A1)[3]))

#define XB_TMO      128
#define XB_XCNT(j)  (256  + 64 * (j))
#define XB_XSUB(j)  (1280 + 64 * (j))
#define XB_XGEN(j)  (2304 + 64 * (j))
#define XB_TOP      3328
#define XB_TOPGEN   3392
#define XB_SPIN_CAP (1u << 22)
__device__ __forceinline__ unsigned xb_ld(unsigned* p)              { return __hip_atomic_load(p, __ATOMIC_RELAXED, __HIP_MEMORY_SCOPE_AGENT); }
__device__ __forceinline__ unsigned xb_add(unsigned* p, unsigned v) { return __hip_atomic_fetch_add(p, v, __ATOMIC_RELAXED, __HIP_MEMORY_SCOPE_AGENT); }
__device__ __forceinline__ unsigned xb_xcc_id() { return (unsigned)__builtin_amdgcn_s_getreg((3 << 11) | 20) & 0xFu; }
#define XB_SPIN(cond, bar) do { unsigned _sp = 0; while (cond) { __builtin_amdgcn_s_sleep(1); \
    if ((++_sp & 255u) == 0u) { if (xb_ld(&(bar)[XB_TMO])) break; if (_sp > XB_SPIN_CAP) { atomicAdd(&(bar)[XB_TMO], 1u); break; } } } } while (0)
struct XcdBarrier { unsigned* bar; unsigned x; volatile LAS unsigned* st; };
__device__ __forceinline__ XcdBarrier xcd_barrier_post(unsigned* bar, volatile LAS unsigned* st) {
    XcdBarrier b; b.bar = bar; b.x = xb_xcc_id(); b.st = st;
    if (threadIdx.x == 0) (void)xb_add(&bar[XB_XCNT(b.x)], 1u);
    return b;
}
__device__ __forceinline__ void xcd_barrier_complete(unsigned* bar, unsigned x, unsigned& nloc, unsigned& nx) {
    const unsigned G = gridDim.x * gridDim.y * gridDim.z;
    unsigned sum, cnt, mine, sp = 0u;
    for (;;) {
        sum = 0u; cnt = 0u; mine = 0u;
#pragma unroll
        for (unsigned j = 0; j < 16; ++j) { const unsigned c = xb_ld(&bar[XB_XCNT(j)]); sum += c; cnt += (c > 0u) ? 1u : 0u; mine = (j == x) ? c : mine; }
        if (sum == G) break;
        __builtin_amdgcn_s_sleep(1);
        if ((++sp & 255u) == 0u) { if (xb_ld(&bar[XB_TMO])) break; if (sp > XB_SPIN_CAP) { atomicAdd(&bar[XB_TMO], 1u); break; } }
    }
    nloc = mine > 0u ? mine : 1u; nx = cnt > 0u ? cnt : 1u;
}
__device__ __forceinline__ void xcd_barrier(const XcdBarrier& b) {
    asm volatile("s_waitcnt vmcnt(0)" ::: "memory");
    __syncthreads();
    if (threadIdx.x == 0) {
        unsigned* bar = b.bar;
        __builtin_amdgcn_s_waitcnt(0);
        unsigned nloc = b.st[0], nx = b.st[1];
        if (nloc == 0u) { xcd_barrier_complete(bar, b.x, nloc, nx); b.st[0] = nloc; b.st[1] = nx; }
        asm volatile("buffer_inv sc1" ::: "memory");
        const unsigned old = xb_add(&bar[XB_XSUB(b.x)], 1u);
        const unsigned gen = old / nloc;
        if (old + 1u == (gen + 1u) * nloc) {
            __builtin_amdgcn_fence(__ATOMIC_RELEASE, "agent");
            asm volatile("s_waitcnt vmcnt(0)" ::: "memory");
            (void)xb_add(&bar[XB_TOP], 1u);
        }
        XB_SPIN(xb_ld(&bar[XB_TOP]) < (gen + 1u) * nx, bar);
        asm volatile("s_waitcnt vmcnt(0)" ::: "memory");
    }
    __syncthreads();
}

struct TD { const bf16_t* A; const void* B; bf16_t* bco; unsigned ldb; unsigned aoff[4]; int i0, i1, i2, i3, i4; };
__device__ __forceinline__ int a_piece_row0(int wid, int lane) { const int sb = lane * 16, swz = sb ^ (((sb >> 9) & 1) << 5); return (wid >> 1) * 16 + (swz >> 6); }
__device__ __forceinline__ int a_piece_col(int wid, int lane) { const int sb = lane * 16, swz = sb ^ (((sb >> 9) & 1) << 5); return (wid & 1) * 32 + ((swz & 63) >> 1); }
__device__ __forceinline__ u32x4 make_rsrc(const void* p) { const unsigned long long ab = (unsigned long long)p; u32x4 r; r.x = __builtin_amdgcn_readfirstlane((unsigned)ab); r.y = __builtin_amdgcn_readfirstlane((unsigned)(ab >> 32)) & 0xffffu; r.z = 0x7fffffffu; r.w = 0x00020000u; return r; }

template <class Pol>
__device__ __forceinline__ void gemm_stream(LAS unsigned char* lds, Pol& P, const int wid, const int lane) {
    const int wr = wid >> 2, wc = wid & 3, fr = lane & 15, fq = lane >> 4;
    const unsigned b_w = (unsigned)(A_TILE_B + ((wid >> 2) * 32 + 4 * (wid & 3)) * B_ROWB) + P.woff;
    const unsigned a_r = (unsigned)(wr * 16384 + ((fr * 64 + fq * 16) ^ ((fr >> 3) << 5)));
    const unsigned b_r = (unsigned)(A_TILE_B + (4 * fq + (fr >> 2)) * B_ROWB + (wc * 64 + (fr & 3) * 4) * 2);
    const unsigned ldsa = (unsigned)(__UINTPTR_TYPE__)lds + (unsigned)(wid * 1024);
    const unsigned lcolb = P.lcolb;
    TD cur, nxt;
    if (!P.get(0, cur)) return;
    int nt = P.nt; asm volatile("" : "+s"(nt));
    f32x4 sb[8]; f32x4 acc[8][4];
    u32x4 ra_c = make_rsrc(cur.A), ra_n = ra_c;
    __amdgpu_buffer_rsrc_t rb_c = __builtin_amdgcn_make_buffer_rsrc((void*)cur.B, 0, 0x7fffffff, 0x00020000), rb_n = rb_c;
#define G_GLDS_A(buf, RA, AOFF, kt) do { _Pragma("unroll") for (int i = 0; i < 4; ++i) { unsigned keep_; \
        asm volatile("s_mov_b32 %0, m0\n\ts_mov_b32 m0, %3\n\ts_nop 0\n\tbuffer_load_dwordx4 %1, %2, %4 offen lds\n\ts_mov_b32 m0, %0" \
            : "=&s"(keep_) : "v"(AOFF[i]), "s"(RA), "s"(ldsa + (buf) + (unsigned)(i * 8192)), "s"((unsigned)((kt) * 128)) : "memory"); } } while (0)
#define G_ISSUE_BH(RB, LDB4, kt, h) do { \
        _Pragma("unroll") for (int i = 4 * (h); i < 4 * (h) + 4; ++i) sb[i] = __builtin_bit_cast(f32x4, __builtin_amdgcn_raw_buffer_load_b128(RB, (int)lcolb, (int)(((unsigned)(kt) * 64u + i) * (LDB4)), 0)); \
        __builtin_amdgcn_sched_barrier(0); } while (0)
#define G_WRITE_BH(buf, h, BCO, kt) do { \
        _Pragma("unroll") for (int i = 4 * (h); i < 4 * (h) + 4; ++i) { u32x2 w; w.x = pk2(sb[i][0], sb[i][1]); w.y = pk2(sb[i][2], sb[i][3]); \
            *(LAS u32x2*)(lds + (buf) + b_w + (16 * (i >> 2) + (i & 3)) * B_ROWB) = w; \
            if (BCO) *(u32x2*)((char*)(BCO) + (size_t)((kt) * 64 + wid * 8 + i) * 512 + P.woff) = w; } __builtin_amdgcn_sched_barrier(0); } while (0)
#define G_KSTEP(buf, ks) do { bf16x8 Bf[4]; \
        _Pragma("unroll") for (int n = 0; n < 4; ++n) { \
            const s16x4 lo = __builtin_amdgcn_ds_read_tr16_b64_v4i16((LAS s16x4*)(lds + (buf) + b_r + (ks) * 32 * B_ROWB + n * 32)); \
            const s16x4 hi = __builtin_amdgcn_ds_read_tr16_b64_v4i16((LAS s16x4*)(lds + (buf) + b_r + (ks) * 32 * B_ROWB + 16 * B_ROWB + n * 32)); \
            Bf[n] = (bf16x8){lo[0], lo[1], lo[2], lo[3], hi[0], hi[1], hi[2], hi[3]}; } \
        _Pragma("unroll") for (int mh = 0; mh < 2; ++mh) { bf16x8 At[4]; \
            _Pragma("unroll") for (int m = 0; m < 4; ++m) At[m] = *(const LAS bf16x8*)(lds + (buf) + a_r + (mh * 4 + m) * 2048 + (ks) * 1024); \
            _Pragma("unroll") for (int m = 0; m < 4; ++m) _Pragma("unroll") for (int n = 0; n < 4; ++n) \
                acc[mh * 4 + m][n] = __builtin_amdgcn_mfma_f32_16x16x32_bf16(Bf[n], At[m], acc[mh * 4 + m][n], 0, 0, 0); } \
        __builtin_amdgcn_sched_barrier(0); } while (0)
    { unsigned b0 = 0; asm volatile("" : "+s"(b0));
      const unsigned l4 = cur.ldb * 4u;
      G_GLDS_A(b0, ra_c, cur.aoff, 0); G_ISSUE_BH(rb_c, l4, 0, 0); G_ISSUE_BH(rb_c, l4, 0, 1); G_WRITE_BH(b0, 0, cur.bco, 0); G_WRITE_BH(b0, 1, cur.bco, 0);
      G_ISSUE_BH(rb_c, l4, 1, 0); G_ISSUE_BH(rb_c, l4, 1, 1); }
    asm volatile("s_waitcnt vmcnt(8)" ::: "memory");
    asm volatile("s_waitcnt lgkmcnt(0)" ::: "memory");
    __builtin_amdgcn_s_barrier();
    unsigned par = 0;
    for (int ti = 0;; ++ti) {
        const bool hasn = P.get(ti + 1, nxt);
        if (hasn) { ra_n = make_rsrc(nxt.A); rb_n = __builtin_amdgcn_make_buffer_rsrc((void*)nxt.B, 0, 0x7fffffff, 0x00020000); }
#pragma unroll
        for (int m = 0; m < 8; ++m)
#pragma unroll
            for (int n = 0; n < 4; ++n) acc[m][n] = (f32x4){0.f, 0.f, 0.f, 0.f};
        for (int t = 0; t < nt; ++t) {
            unsigned bc = par * STAGE_B, bn = (par ^ 1u) * STAGE_B; asm volatile("" : "+s"(bc), "+s"(bn));
            const bool c1 = t + 1 < nt, w1 = c1 || hasn, c2 = t + 2 < nt, i2 = c2 || hasn;
            if (w1) { const u32x4 ra = c1 ? ra_c : ra_n; unsigned ao[4];
#pragma unroll
                for (int i = 0; i < 4; ++i) ao[i] = c1 ? cur.aoff[i] : nxt.aoff[i];
                G_GLDS_A(bn, ra, ao, c1 ? t + 1 : 0); }
            G_KSTEP(bc, 0);
            const __amdgpu_buffer_rsrc_t rb = c2 ? rb_c : rb_n; const unsigned l4 = (c2 ? cur.ldb : nxt.ldb) * 4u; const int k2 = c2 ? t + 2 : t + 2 - nt;
            bf16_t* const bco = c1 ? cur.bco : nxt.bco; const int k1 = c1 ? t + 1 : 0;
            if (w1) G_WRITE_BH(bn, 0, bco, k1);
            if (i2) G_ISSUE_BH(rb, l4, k2, 0);
            G_KSTEP(bc, 1);
            if (w1) G_WRITE_BH(bn, 1, bco, k1);
            if (i2) { G_ISSUE_BH(rb, l4, k2, 1); asm volatile("s_waitcnt vmcnt(8)" ::: "memory"); }
            else asm volatile("s_waitcnt vmcnt(0)" ::: "memory");
            asm volatile("s_waitcnt lgkmcnt(0)" ::: "memory");
            __builtin_amdgcn_s_barrier();
            par ^= 1u;
        }
        P.epi(acc, cur, (const LAS float*)nullptr);
        if (!hasn) break;
        cur = nxt; ra_c = ra_n; rb_c = rb_n;
    }
#undef G_GLDS_A
#undef G_ISSUE_BH
#undef G_WRITE_BH
#undef G_KSTEP
}

constexpr int STEP_B = 32768;
constexpr unsigned ROPE_LDS = 2 * STAGE_B + 1024;
constexpr unsigned BIAS_OFF = 4 * STEP_B;
template <class Pol, int ABL = 0>
__device__ __forceinline__ void gemm_stream_bf(LAS unsigned char* lds, Pol& P, const int wid, const int lane) {
    const int wr = wid >> 2, wc = wid & 3, fr = lane & 15, fq = lane >> 4;
    const unsigned a_r = (unsigned)(wr * 8192 + ((fr * 64 + fq * 16) ^ ((fr >> 3) << 5)));
    const int x7 = 4 * (fq & 1) + (fr >> 2);
    unsigned b_r[4];
#pragma unroll
    for (int n = 0; n < 4; ++n) b_r[n] = (unsigned)(16384 + (4 * fq + (fr >> 2)) * 512 + (((wc * 4 + n) ^ x7) * 32) + (fr & 3) * 8);
    const unsigned ldsa = (unsigned)(__UINTPTR_TYPE__)lds + (unsigned)(wid * 2048), ldsb = (unsigned)(__UINTPTR_TYPE__)lds + 16384u + (unsigned)(wid * 2048);
    const unsigned ldb2 = P.ldbB * 2u;
    unsigned boff[2];
#pragma unroll
    for (int j = 0; j < 2; ++j) { const int sl = 4 * wid + 2 * j + (lane >> 5), u = lane & 31, c = (u >> 1) ^ (sl & 7), n = c * 16 + (u & 1) * 8;
        const int k = 8 * ((sl >> 2) & 3) + 4 * (sl >> 4) + (sl & 3); boff[j] = (unsigned)k * ldb2 + (unsigned)n * 2u; }
    TD cur, nxt;
    if (!P.get(0, cur)) return;
    int nt = P.nt * 2; asm volatile("" : "+s"(nt));
    f32x4 acc[8][4];
    u32x4 ra_c = make_rsrc(cur.A), ra_n = ra_c, rb_c = make_rsrc(cur.B), rb_n = rb_c;
#define H_DMA(LDSADDR, RS, VOFF, SOFF) do { unsigned keep_; \
        asm volatile("s_mov_b32 %0, m0\n\ts_mov_b32 m0, %3\n\ts_nop 0\n\tbuffer_load_dwordx4 %1, %2, %4 offen lds\n\ts_mov_b32 m0, %0" \
            : "=&s"(keep_) : "v"(VOFF), "s"(RS), "s"(LDSADDR), "s"(SOFF) : "memory"); } while (0)
#define H_STAGE(sb_, RA, AO0, AO1, RB, st) do { \
        if (!(ABL & 2)) { H_DMA(ldsa + (sb_), RA, AO0, (unsigned)((st) * 64)); H_DMA(ldsa + (sb_) + 1024u, RA, AO1, (unsigned)((st) * 64)); } \
        if (!(ABL & 1)) { H_DMA(ldsb + (sb_), RB, boff[0], (unsigned)(st) * 32u * ldb2); H_DMA(ldsb + (sb_) + 1024u, RB, boff[1], (unsigned)(st) * 32u * ldb2); } } while (0)
#define H_READ(sb_) do { if (!(ABL & 16)) { \
        _Pragma("unroll") for (int m = 0; m < 8; ++m) At[m] = *(const LAS bf16x8*)(lds + (sb_) + a_r + m * 1024); \
        __builtin_amdgcn_sched_barrier(0); \
        s16x4 lo_[4], hi_[4]; \
        _Pragma("unroll") for (int n = 0; n < 4; ++n) lo_[n] = __builtin_amdgcn_ds_read_tr16_b64_v4i16((LAS s16x4*)(lds + (sb_) + b_r[n])); \
        __builtin_amdgcn_sched_barrier(0); \
        _Pragma("unroll") for (int n = 0; n < 4; ++n) hi_[n] = __builtin_amdgcn_ds_read_tr16_b64_v4i16((LAS s16x4*)(lds + (sb_) + b_r[n] + 8192)); \
        _Pragma("unroll") for (int n = 0; n < 4; ++n) Bf[n] = (bf16x8){lo_[n][0], lo_[n][1], lo_[n][2], lo_[n][3], hi_[n][0], hi_[n][1], hi_[n][2], hi_[n][3]}; } } while (0)
#define H_MMA() do { if (!(ABL & 16)) { __builtin_amdgcn_s_setprio(1); \
        if (!(ABL & 4)) { _Pragma("unroll") for (int m = 0; m < 8; ++m) _Pragma("unroll") for (int n = 0; n < 4; ++n) \
            acc[m][n] = __builtin_amdgcn_mfma_f32_16x16x32_bf16(Bf[n], At[m], acc[m][n], 0, 0, 0); } \
        else { _Pragma("unroll") for (int m = 0; m < 8; ++m) asm volatile("" :: "v"(At[m])); _Pragma("unroll") for (int n = 0; n < 4; ++n) asm volatile("" :: "v"(Bf[n])); } \
        __builtin_amdgcn_s_setprio(0); } } while (0)
#define H_MMA0() do { if (!(ABL & 16)) { __builtin_amdgcn_s_setprio(1); \
        _Pragma("unroll") for (int m = 0; m < 8; ++m) _Pragma("unroll") for (int n = 0; n < 4; ++n) \
            acc[m][n] = __builtin_amdgcn_mfma_f32_16x16x32_bf16(Bf[n], At[m], (f32x4){0.f, 0.f, 0.f, 0.f}, 0, 0, 0); \
        __builtin_amdgcn_s_setprio(0); } } while (0)
#define H_BAR() do { asm volatile("s_waitcnt lgkmcnt(0)" ::: "memory"); __builtin_amdgcn_s_barrier(); __builtin_amdgcn_sched_barrier(0); } while (0)
    bf16x8 At[8], Bf[4];
    { unsigned s0 = 0, s1 = STEP_B, s2 = 2 * STEP_B; asm volatile("" : "+s"(s0), "+s"(s1), "+s"(s2));
      H_STAGE(s0, ra_c, cur.aoff[0], cur.aoff[1], rb_c, 0); H_STAGE(s1, ra_c, cur.aoff[0], cur.aoff[1], rb_c, 1); H_STAGE(s2, ra_c, cur.aoff[0], cur.aoff[1], rb_c, 2); }
    asm volatile("s_waitcnt vmcnt(8)" ::: "memory");
    H_BAR();
    if (wr == 1) H_BAR();
    unsigned g = 0;
    for (int ti = 0;; ++ti) {
        const bool hasn = P.get(ti + 1, nxt);
        if (hasn) { ra_n = make_rsrc(nxt.A); rb_n = make_rsrc(nxt.B); }
        const unsigned bias_lds = BIAS_OFF + (unsigned)(ti & 1) * 1024u, list_lds = BIAS_OFF + 2048u + (unsigned)(ti & 1) * 1024u;
        if (P.has_bias && wid == 0) { const u32x4 rbias = make_rsrc(P.bias); H_DMA((unsigned)(__UINTPTR_TYPE__)lds + bias_lds, rbias, P.bias_voff(cur), 0u); }
        if (P.has_list && hasn && wid == 1) { const u32x4 rl = make_rsrc(P.listp); H_DMA((unsigned)(__UINTPTR_TYPE__)lds + list_lds, rl, P.list_voff(nxt), 0u); }
        for (int t = 0; t < nt; ++t, ++g) {
            unsigned sc = (g & 3u) * STEP_B, sn = ((g + 3u) & 3u) * STEP_B; asm volatile("" : "+s"(sc), "+s"(sn));
            const bool c3 = t + 3 < nt, i3 = c3 || hasn, i2 = (t + 2 < nt) || hasn;
            if (P.has_list && hasn && t == nt - 3) P.late(nxt, (const LAS int*)(lds + list_lds));
            if (c3) { H_STAGE(sn, ra_c, cur.aoff[0], cur.aoff[1], rb_c, (unsigned)(t + 3)); }
            else if (hasn) { u32x4 ra = ra_n, rb = rb_n;
#pragma unroll
                for (int q = 0; q < 4; ++q) { ra[q] = __builtin_amdgcn_readfirstlane(ra[q]); rb[q] = __builtin_amdgcn_readfirstlane(rb[q]); }
                H_STAGE(sn, ra, nxt.aoff[0], nxt.aoff[1], rb, (unsigned)__builtin_amdgcn_readfirstlane(t + 3 - nt)); }
            H_READ(sc);
            if (i3) asm volatile("s_waitcnt vmcnt(8)" ::: "memory");
            else if (i2) asm volatile("s_waitcnt vmcnt(4)" ::: "memory");
            else asm volatile("s_waitcnt vmcnt(0)" ::: "memory");
            H_BAR();
            if (t == 0) H_MMA0(); else H_MMA();
            H_BAR();
        }
        if (wr == 0) H_BAR();
        if (!(ABL & 8)) P.epi(acc, cur, (const LAS float*)(lds + bias_lds)); else { _Pragma("unroll") for (int m = 0; m < 8; ++m) _Pragma("unroll") for (int n = 0; n < 4; ++n) asm volatile("" :: "v"(acc[m][n])); }
        if (!hasn) break;
        cur = nxt; ra_c = ra_n; rb_c = rb_n;
        if (wr == 1) H_BAR();
    }
#undef H_DMA
#undef H_STAGE
#undef H_READ
#undef H_MMA
#undef H_MMA0
#undef H_BAR
}

struct XOrder {
    int c1, step, cur;
    __device__ __forceinline__ void init(int T, int G, int bid) {
        if ((G & 7) == 0) { const int x = bid & 7; cur = (int)(((long)x * T) >> 3) + (bid >> 3); c1 = (int)(((long)(x + 1) * T) >> 3); step = G >> 3; }
        else { cur = bid; c1 = T; step = G; }
    }
    __device__ __forceinline__ bool next(int& L) { if (cur >= c1) return false; L = cur; cur += step; return true; }
};
__device__ __forceinline__ void dense_tile(int L, int nM, int nN, int& pm, int& pn) { const int per = 8 * nN, g = L / per, w = L - g * per, fm = g * 8, gs = (nM - fm) < 8 ? (nM - fm) : 8; pn = w / gs; pm = fm + w - pn * gs; }

struct Frame { LAS unsigned char* lds; int tid, lane, wid, bid, G; unsigned char* ws; };
__device__ __forceinline__ const void* ldp(const Frame& F, int off) {
    const u32x2 v = *(const volatile LAS u32x2*)(F.lds + PARAM_OFF + off);
    const unsigned lo = __builtin_amdgcn_readfirstlane(v.x), hi = __builtin_amdgcn_readfirstlane(v.y);
    return (const void*)(((unsigned long long)hi << 32) | lo);
}
#define PP(f) ((const float*)ldp(F, (int)__builtin_offsetof(Params, f)))
#define F_mod ((float*)(F.ws + WS_MOD))
#define F_M1 ((bf16_t*)(F.ws + WS_M1))
#define F_M2 ((bf16_t*)(F.ws + WS_M2))
#define F_ROPE ((f32x2*)(F.ws + WS_ROPE))
#define F_TW ((f32x2*)(F.ws + WS_TW))
#define F_WF ((float*)(F.ws + WS_WF))
#define F_TOPW ((float*)(F.ws + WS_TOPW))
#define F_POS ((int*)(F.ws + WS_POS))
#define F_LIST ((int*)(F.ws + WS_LIST))
#define F_H ((bf16_t*)(F.ws + WS_H))
#define F_MIX ((bf16_t*)(F.ws + WS_MIX))
#define F_XS ((bf16_t*)(F.ws + WS_XS))
#define F_PROJ ((bf16_t*)(F.ws + WS_PROJ))
#define F_Z ((float*)(F.ws + WS_Z))
#define F_A1 ((float*)(F.ws + WS_A1))
#define F_ACT ((bf16_t*)(F.ws + WS_ACT))
#define F_Y ((bf16_t*)(F.ws + WS_Y))
#define F_cnt ((unsigned*)(F.ws + WS_CTL) + CW_CNT)

__device__ __forceinline__ const float* modp(const Frame& F, int l, int r, int which) { return F_mod + ((size_t)(l * 5 + r)) * 6144 + which * 1024; }
__device__ __forceinline__ int mod_row(int row) { return row < NMAIN ? (row >> 12) : 4; }

__device__ __forceinline__ float row_rstd(const f32x4 (&v)[4]) {
    float s = 0.f;
#pragma unroll
    for (int j = 0; j < 4; ++j) s += (v[j][0] * v[j][0] + v[j][1] * v[j][1]) + (v[j][2] * v[j][2] + v[j][3] * v[j][3]);
    return __builtin_amdgcn_rsqf(wave_sum(s) * (1.f / D) + NORM_EPS);
}
__device__ __forceinline__ void norm_mod_store(const f32x4 (&v)[4], float rstd, const float* gam, const float* sc, const float* sh, bf16_t* dst, int lane, f32x4 (*keep)[4] = nullptr) {
#pragma unroll
    for (int j = 0; j < 4; ++j) {
        const int c = 4 * lane + 256 * j;
        const f32x4 g = *(const f32x4*)(gam + c), s1 = *(const f32x4*)(sc + c), s0 = *(const f32x4*)(sh + c);
        f32x4 h;
#pragma unroll
        for (int i = 0; i < 4; ++i) h[i] = v[j][i] * rstd * g[i] * (1.f + s1[i]) + s0[i];
        u32x2 w; w.x = pk2(h[0], h[1]); w.y = pk2(h[2], h[3]);
        *(u32x2*)(dst + c) = w;
        if (keep) (*keep)[j] = h;
    }
}

__device__ __forceinline__ void phase_prep(Frame& F) {
    LAS float* sil = (LAS float*)F.lds;
    LAS float* red = (LAS float*)(F.lds + 20480);
    LAS float* ct = (LAS float*)(F.lds + 32768);
    for (int idx = F.tid; idx < 5120; idx += 512) { const int r = idx >> 10, k = idx & 1023; const float v = r < 4 ? PP(c)[r * 1024 + k] : PP(c_ctx)[k]; sil[idx] = v / (1.f + __expf(-v)); }
    if (F.tid < 128) ct[F.tid] = cospif((float)F.tid / 64.f);
    __syncthreads();
    constexpr int N_ADA = 192, N_CONST = 8, N_FOLD = 256, N_CVT = 368;
    for (int it = F.bid; it < N_ADA + N_CONST + N_FOLD + N_CVT; it += F.G) {
        if (it < N_ADA) {
            const int l = it / 96, j0 = (it % 96) * 64, kg = F.lane >> 4, c4 = (F.lane & 15) * 4;
            const float* w = PP(ada_w) + ((size_t)l * 1024 + F.wid * 128 + kg) * 6144 + j0 + c4;
            f32x4 wv[32];
#pragma unroll
            for (int u = 0; u < 32; ++u) wv[u] = *(const f32x4*)(w + (size_t)(4 * u) * 6144);
            f32x4 a4[5];
#pragma unroll
            for (int r = 0; r < 5; ++r) a4[r] = (f32x4){0.f, 0.f, 0.f, 0.f};
#pragma unroll
            for (int u = 0; u < 32; ++u)
#pragma unroll
                for (int r = 0; r < 5; ++r) a4[r] += sil[r * 1024 + F.wid * 128 + 4 * u + kg] * wv[u];
#pragma unroll
            for (int r = 0; r < 5; ++r)
#pragma unroll
                for (int c = 0; c < 4; ++c) { float v = a4[r][c]; v += __shfl_xor(v, 16); v += __shfl_xor(v, 32); a4[r][c] = v; }
            if (kg == 0) {
#pragma unroll
                for (int r = 0; r < 5; ++r) *(LAS f32x4*)(red + (F.wid * 5 + r) * 64 + c4) = a4[r]; }
            __syncthreads();
            if (F.tid < 320) { const int r = F.tid >> 6, ln = F.tid & 63; float s = 0.f;
#pragma unroll
                for (int w8 = 0; w8 < 8; ++w8) s += red[(w8 * 5 + r) * 64 + ln];
                F_mod[(size_t)(l * 5 + r) * 6144 + j0 + ln] = s + PP(ada_b)[l * 6144 + j0 + ln]; }
            __syncthreads();
        } else if (it < N_ADA + N_CONST) {
            const int gt = (it - N_ADA) * 512 + F.tid;
            for (int e = gt; e < 32768; e += 4096) {
                const int row = e >> 7, kk = e & 127;
                float v1 = 0.f, v2 = 0.f;
                if (row < 128) { const int ro = row >> 6, k1 = row & 63, n1 = kk >> 1, ri = kk & 1; const float ph = (float)((n1 * k1) & 63) / 32.f; const float cs = cospif(ph), sn = sinpif(ph);
                    v1 = (ro == ri) ? cs : (ro == 0 ? sn : -sn); }
                if (row < 64) { const int ro = kk >> 6, n2 = kk & 63; const float ph = (float)((row * n2) & 63) / 32.f; v2 = ro == 0 ? cospif(ph) : sinpif(ph); }
                F_M1[e] = (bf16_t)(pk2(v1, 0.f) & 0xffffu); F_M2[e] = (bf16_t)(pk2(v2, 0.f) & 0xffffu);
            }
            if (gt < 1024) { const int pos = gt >> 4, f = gt & 15; const double ang = (double)pos * pow(10000.0, -(double)f / 16.0); F_ROPE[gt] = (f32x2){(float)cos(ang), (float)sin(ang)}; }
            { const float ph = (float)gt / 2048.f; F_TW[gt] = (f32x2){cospif(ph), sinpif(ph)}; }
        } else if (it >= N_ADA + N_CONST + N_FOLD) {
            int ci = it - (N_ADA + N_CONST + N_FOLD); const float* src; bf16_t* dst; int sld, dld, ncol;
            if (ci < 144) { src = PP(even_w_in); dst = (bf16_t*)(F.ws + WB_EIN); sld = EVEN_IN; dld = EVEN_IN; ncol = EVEN_IN; }
            else if (ci < 208) { ci -= 144; src = PP(even_w_out); dst = (bf16_t*)(F.ws + WB_EOUT); sld = D; dld = D; ncol = D; }
            else if (ci < 304) { ci -= 208; src = PP(odd_w_in); dst = (bf16_t*)(F.ws + WB_OIN); sld = 2048; dld = 2560; ncol = 1536; }
            else { ci -= 304; src = PP(odd_w_out); dst = (bf16_t*)(F.ws + WB_OOUT); sld = D; dld = D; ncol = D; }
            const int q4 = ncol >> 2;
#pragma unroll
            for (int u = 0; u < 8; ++u) { const int gidx = ci * 4096 + u * 512 + F.tid, row = gidx / q4, c4 = (gidx - row * q4) * 4;
                const f32x4 v = *(const f32x4*)(src + (size_t)row * sld + c4); u32x2 w; w.x = pk2(v[0], v[1]); w.y = pk2(v[2], v[3]); *(u32x2*)(dst + (size_t)row * dld + c4) = w; }
        } else {
            const int fi = it - N_ADA - N_CONST, rc = fi >> 2, g = fi & 3, half = F.tid >> 8, j = F.tid & 255, jj = j & 127;
            { LAS float* wst = (LAS float*)(F.lds + 36864);
              __syncthreads();
              *(LAS f32x4*)(wst + F.tid * 4) = *(const f32x4*)(PP(odd_w_in) + (size_t)(rc * 16 + (F.tid >> 5)) * 2048 + 1536 + g * 128 + (F.tid & 31) * 4);
              __syncthreads();
              const int toff = j < 128 ? 0 : -32; const float sg = j < 128 ? 1.f : -1.f;
              float sacc[8] = {0.f, 0.f, 0.f, 0.f, 0.f, 0.f, 0.f, 0.f};
#pragma unroll 1
              for (int ch = 0; ch < 2; ++ch) {
                  float tv[64];
#pragma unroll
                  for (int cc = 0; cc < 64; ++cc) tv[cc] = ct[(((ch * 64 + cc) * jj) + toff) & 127];
#pragma unroll
                  for (int r8 = 0; r8 < 8; ++r8) { const LAS float* wr_ = wst + (half * 8 + r8) * 128 + ch * 64; float s0 = 0.f, s1 = 0.f;
#pragma unroll
                      for (int c4 = 0; c4 < 64; c4 += 4) { const f32x4 w4 = *(const LAS f32x4*)(wr_ + c4); s0 += w4[0] * tv[c4]; s1 += w4[1] * tv[c4 + 1]; s0 += w4[2] * tv[c4 + 2]; s1 += w4[3] * tv[c4 + 3]; }
                      sacc[r8] += s0 + s1; } }
#pragma unroll
              for (int r8 = 0; r8 < 8; ++r8) ((bf16_t*)(F.ws + WB_OIN))[(size_t)(rc * 16 + half * 8 + r8) * 2560 + 1536 + g * 256 + j] = (bf16_t)(pk2(sg * sacc[r8], 0.f) & 0xffffu); }
        }
    }
}

__device__ __forceinline__ void phase_norm1_l0(Frame& F) {
    const int gw = F.bid * 8 + F.wid, NGW = F.G * 8;
    f32x4 va[4], vb[4];
#define N1_LOAD(dst_, row_) do { if ((row_) < NTOK) { const float* s_ = (row_) < NMAIN ? PP(x) + (size_t)(row_) * D : PP(ctx) + (size_t)((row_) - NMAIN) * D; \
        _Pragma("unroll") for (int j = 0; j < 4; ++j) dst_[j] = *(const f32x4*)(s_ + 4 * F.lane + 256 * j); } } while (0)
    N1_LOAD(va, gw); N1_LOAD(vb, gw + NGW);
    for (int row = gw; row < NTOK; row += NGW) {
        f32x4 v[4], vc[4];
#pragma unroll
        for (int j = 0; j < 4; ++j) v[j] = va[j];
        N1_LOAD(vc, row + 2 * NGW);
        const float rstd = row_rstd(v); const int r = mod_row(row);
        norm_mod_store(v, rstd, PP(norm_mix), modp(F, 0, r, 1), modp(F, 0, r, 0), F_H + (size_t)row * D, F.lane);
#pragma unroll
        for (int j = 0; j < 4; ++j) { va[j] = vb[j]; vb[j] = vc[j]; }
        __builtin_amdgcn_sched_barrier(0);
    }
#undef N1_LOAD
}

#define EPI_GEOM const int wid = this->wid, lane = this->lane, wr = wid >> 2, wc = wid & 3, fr = lane & 15, fq = lane >> 4; (void)wr; (void)wc; (void)fr; (void)fq
struct PolBase { unsigned char* ws; LAS unsigned char* lds; int wid, lane, nt; unsigned lcolb, woff, ldbB; XOrder xo; int aC, aR0, aCb, aR0b; bool bfm;
    __device__ __forceinline__ void base_init(Frame& F, int nt_, int T) { ws = F.ws; lds = F.lds; wid = F.wid; lane = F.lane; nt = nt_; lcolb = 16u * (unsigned)F.lane; woff = 8u * (unsigned)F.lane;
        xo.init(T, F.G, F.bid); aC = a_piece_col(F.wid, F.lane); aR0 = a_piece_row0(F.wid, F.lane); bfm = true;
        { const int sbb = F.lane * 16, swz = sbb ^ (((sbb >> 9) & 1) << 5); aR0b = F.wid * 32 + (swz >> 6); aCb = (swz & 63) >> 1; } }
    bool has_bias = false; const float* bias = nullptr;
    bool has_list = false; const int* listp = nullptr;
    __device__ __forceinline__ unsigned list_voff(const TD&) const { return 0u; }
    __device__ __forceinline__ void late(TD&, const LAS int*) const {}
    __device__ __forceinline__ unsigned bias_voff(const TD&) const { return 0u; }
    __device__ __forceinline__ bool tileL(int i, int& L) const { L = xo.cur + i * xo.step; return L < xo.c1; }
    __device__ __forceinline__ int prow(int i) const { return bfm ? aR0b + 16 * (i & 1) : aR0 + 64 * i; }
    __device__ __forceinline__ int pcol() const { return bfm ? aCb : aC; }
    __device__ __forceinline__ void dense_aoff(TD& td, int row0, int pitch) const {
#pragma unroll
        for (int i = 0; i < 4; ++i) td.aoff[i] = (unsigned)(((row0 + prow(i)) * pitch + pcol()) * 2); }
};

struct PolInproj0 : PolBase {
    const float* W; Frame* Fp;
    __device__ __forceinline__ bool get(int i, TD& td) const { int L; if (!tileL(i, L)) return false; int pm, pn; dense_tile(L, NTOK / 256, EVEN_IN / 256, pm, pn);
        td.A = (const bf16_t*)(ws + WS_H); dense_aoff(td, pm * 256, D); td.B = (const bf16_t*)(ws + WB_EIN) + pn * 256; td.i0 = pm; td.i1 = pn; return true; }
    __device__ __forceinline__ void epi(f32x4 (&acc)[8][4], const TD& td, const LAS float* bl) const { (void)bl; EPI_GEOM; const int pm = td.i0, pn = td.i1;
        const int colb = pn * 256 + wc * 64; const bool rope = (colb < 640) && (pm < NMAIN / 256);
        const LAS f32x2* ROPE = (const LAS f32x2*)(lds + ROPE_LDS); bf16_t* PROJ = (bf16_t*)(ws + WS_PROJ);
#pragma unroll
        for (int m = 0; m < 8; ++m) { const int row = pm * 256 + wr * 128 + m * 16 + fr;
            if (rope) { const int tt = row & (SEQ - 1), gr = tt >> 6, gc = tt & 63;
#pragma unroll
                for (int n = 0; n < 2; ++n) { const int pos = n == 0 ? gr : gc;
#pragma unroll
                    for (int j = 0; j < 4; ++j) { const f32x2 cs = ROPE[pos * 16 + 4 * fq + j]; const float x1 = acc[m][n][j], x2 = acc[m][n + 2][j];
                        acc[m][n][j] = x1 * cs.x - x2 * cs.y; acc[m][n + 2][j] = x2 * cs.x + x1 * cs.y; } } }
            { u32x4 d1, d2; fullline(PK4W(acc[m][0], acc[m][1]), PK4W(acc[m][2], acc[m][3]), fr & 1, d1, d2); const size_t re = (size_t)(row & ~1) * EVEN_IN + colb + FL_COL(fr, fq);
              *(u32x4*)(PROJ + re) = d1; *(u32x4*)(PROJ + re + EVEN_IN) = d2; } } }
};
__device__ __forceinline__ void phase_inproj_l0(Frame& F) {
    for (int i = F.tid; i < 1024; i += 512) ((LAS f32x2*)(F.lds + ROPE_LDS))[i] = F_ROPE[i];
    __syncthreads();
    PolInproj0 P; P.base_init(F, D / 64, (NTOK / 256) * (EVEN_IN / 256)); P.ldbB = EVEN_IN;
    gemm_stream_bf(F.lds, P, F.wid, F.lane);
}

struct PolOutproj : PolBase {
    const float *W, *x, *ctx; int layer, nM;
    __device__ __forceinline__ bool get(int i, TD& td) const { int L; if (!tileL(i, L)) return false; int pm, pn; dense_tile(L, nM, 4, pm, pn);
        td.A = (const bf16_t*)(ws + WS_MIX); dense_aoff(td, pm * 256, D); td.B = (const bf16_t*)(ws + (layer == 0 ? WB_EOUT : WB_OOUT)) + pn * 256; td.i0 = pm; td.i1 = pn; return true; }
    __device__ __forceinline__ void epi(f32x4 (&acc)[8][4], const TD& td, const LAS float* bl) const { (void)bl; EPI_GEOM; const int pm = td.i0, pn = td.i1;
        const int colb = pn * 256 + wc * 64; bf16_t* XS = (bf16_t*)(ws + WS_XS); const float* mod = (const float*)(ws + WS_MOD);
#pragma unroll
        for (int m = 0; m < 8; ++m) { const int row = pm * 256 + wr * 128 + m * 16 + fr; const int r = mod_row(row);
            const float* xin = row < NMAIN ? x + (size_t)row * D : ctx + (size_t)(row - NMAIN) * D;
            const float* g1 = mod + ((size_t)(layer * 5 + r)) * 6144 + 2 * 1024;
            u32x4 wv[2];
#pragma unroll
            for (int np = 0; np < 4; np += 2) { unsigned pw[2][2];
                u32x4 xw = (u32x4){0u, 0u, 0u, 0u};
                if (layer != 0) { xw = *(const u32x4*)(XS + (size_t)row * D + colb + WIDE_COL(np, fq)); xw = widen16(xw[0], xw[1], xw[2], xw[3]); }
#pragma unroll
                for (int h2 = 0; h2 < 2; ++h2) { const int n = np + h2, c = colb + n * 16 + 4 * fq; const unsigned x0 = h2 ? xw[2] : xw[0], x1 = h2 ? xw[3] : xw[1];
                    const f32x4 xv = layer == 0 ? *(const f32x4*)(xin + c) : (f32x4){bflo(x0), bfhi(x0), bflo(x1), bfhi(x1)}, gv = *(const f32x4*)(g1 + c);
                    f32x4 o;
#pragma unroll
                    for (int j = 0; j < 4; ++j) o[j] = xv[j] + gv[j] * acc[m][n][j];
                    pw[h2][0] = pk2(o[0], o[1]); pw[h2][1] = pk2(o[2], o[3]); }
                wv[np >> 1] = widen16(pw[0][0], pw[0][1], pw[1][0], pw[1][1]); }
            { u32x4 d1, d2; fullline(wv[0], wv[1], fr & 1, d1, d2); const size_t re = (size_t)(row & ~1) * D + colb + FL_COL(fr, fq);
              *(u32x4*)(XS + re) = d1; *(u32x4*)(XS + re + D) = d2; } } }
};
__device__ __forceinline__ void phase_outproj(Frame& F, const int layer) {
    PolOutproj P; P.layer = layer; P.nM = (layer == 0 ? NTOK : NMAIN) / 256; P.base_init(F, D / 64, P.nM * 4);
    P.ldbB = D; P.x = PP(x); P.ctx = PP(ctx);
    gemm_stream_bf(F.lds, P, F.wid, F.lane);
}

template <int Q> struct AttnStT { f32x4 o[4][Q]; float m[Q], l[Q]; };
#define V_ROWB 160
__device__ __forceinline__ void v_stage(LAS unsigned char* vl, const bf16_t* vsrc, int ld, int lane) {
    i32x4 t[4];
    asm volatile("" ::: "memory");
#pragma unroll
    for (int i = 0; i < 4; ++i) t[i] = *(const i32x4*)(vsrc + (size_t)((lane >> 3) + 8 * i) * ld + (lane & 7) * 8);
#pragma unroll
    for (int i = 0; i < 4; ++i) *(LAS i32x4*)(vl + ((lane >> 3) + 8 * i) * V_ROWB + (lane & 7) * 16) = t[i];
    asm volatile("s_waitcnt lgkmcnt(0)" ::: "memory");
}
#define ATTN_STEP(ksrc, kld, vsrc, vld, SCALE, BIAS, SKIP) do { \
    bf16x8 kf[2][2]; \
    _Pragma("unroll") for (int kt = 0; kt < 2; ++kt) _Pragma("unroll") for (int ks = 0; ks < 2; ++ks) \
        kf[kt][ks] = *(const bf16x8*)((ksrc) + (size_t)(kt * 16 + fr) * (kld) + ks * 32 + 8 * fq); \
    v_stage(vl, (vsrc), (vld), lane); \
    bf16x8 vf[4]; \
    _Pragma("unroll") for (int dt = 0; dt < 4; ++dt) { \
        const s16x4 lo = __builtin_amdgcn_ds_read_tr16_b64_v4i16((LAS s16x4*)(vl + (4 * fq + (fr >> 2)) * V_ROWB + (dt * 16 + (fr & 3) * 4) * 2)); \
        const s16x4 hi = __builtin_amdgcn_ds_read_tr16_b64_v4i16((LAS s16x4*)(vl + (16 + 4 * fq + (fr >> 2)) * V_ROWB + (dt * 16 + (fr & 3) * 4) * 2)); \
        vf[dt] = (bf16x8){lo[0], lo[1], lo[2], lo[3], hi[0], hi[1], hi[2], hi[3]}; } \
    _Pragma("unroll") for (int qt = 0; qt < QTL; ++qt) { if (SKIP(qt)) continue;        \
        f32x4 s[2]; \
        _Pragma("unroll") for (int kt = 0; kt < 2; ++kt) { s[kt] = (f32x4){0.f, 0.f, 0.f, 0.f}; \
            _Pragma("unroll") for (int ks = 0; ks < 2; ++ks) s[kt] = __builtin_amdgcn_mfma_f32_16x16x32_bf16(kf[kt][ks], qf[qt][ks], s[kt], 0, 0, 0); } \
        float mx = -INFINITY; \
        _Pragma("unroll") for (int kt = 0; kt < 2; ++kt) _Pragma("unroll") for (int j = 0; j < 4; ++j) { const float tv = s[kt][j] * (SCALE) + BIAS(qt, kt, j); s[kt][j] = tv; mx = fmaxf(mx, tv); } \
        mx = fmaxf(mx, __shfl_xor(mx, 16)); mx = fmaxf(mx, __shfl_xor(mx, 32)); \
        const float mn = fmaxf(st.m[qt], mx), al = fexp2(st.m[qt] - mn); st.m[qt] = mn; \
        float ps = 0.f; \
        _Pragma("unroll") for (int kt = 0; kt < 2; ++kt) _Pragma("unroll") for (int j = 0; j < 4; ++j) { const float pv = fexp2(s[kt][j] - mn); s[kt][j] = pv; ps += pv; } \
        st.l[qt] = st.l[qt] * al + ps; \
        const unsigned w0 = pk2(s[0][0], s[0][1]), w1 = pk2(s[0][2], s[0][3]), w2 = pk2(s[1][0], s[1][1]), w3 = pk2(s[1][2], s[1][3]); \
        const bf16x8 pf = __builtin_bit_cast(bf16x8, ((u32x4){w0, w1, w2, w3})); \
        _Pragma("unroll") for (int dt = 0; dt < 4; ++dt) st.o[dt][qt] = __builtin_amdgcn_mfma_f32_16x16x32_bf16(vf[dt], pf, st.o[dt][qt] * al, 0, 0, 0); } \
    } while (0)

#define ATTN_LOAD(kf_, tv_, ksrc, kld, vsrc, vld) do { \
    _Pragma("unroll") for (int kt = 0; kt < 2; ++kt) _Pragma("unroll") for (int ks = 0; ks < 2; ++ks) \
        kf_[kt][ks] = *(const bf16x8*)((ksrc) + (size_t)(kt * 16 + fr) * (kld) + ks * 32 + 8 * fq); \
    _Pragma("unroll") for (int i = 0; i < 4; ++i) tv_[i] = *(const i32x4*)((vsrc) + (size_t)((lane >> 3) + 8 * i) * (vld) + (lane & 7) * 8); } while (0)
#define ATTN_COMP(kf, tv_, SCALE, BIAS, SKIP) do { \
    _Pragma("unroll") for (int i = 0; i < 4; ++i) *(LAS i32x4*)(vl + ((lane >> 3) + 8 * i) * V_ROWB + (lane & 7) * 16) = tv_[i]; \
    asm volatile("s_waitcnt lgkmcnt(0)" ::: "memory"); \
    bf16x8 vf[4]; \
    _Pragma("unroll") for (int dt = 0; dt < 4; ++dt) { \
        const s16x4 lo = __builtin_amdgcn_ds_read_tr16_b64_v4i16((LAS s16x4*)(vl + (4 * fq + (fr >> 2)) * V_ROWB + (dt * 16 + (fr & 3) * 4) * 2)); \
        const s16x4 hi = __builtin_amdgcn_ds_read_tr16_b64_v4i16((LAS s16x4*)(vl + (16 + 4 * fq + (fr >> 2)) * V_ROWB + (dt * 16 + (fr & 3) * 4) * 2)); \
        vf[dt] = (bf16x8){lo[0], lo[1], lo[2], lo[3], hi[0], hi[1], hi[2], hi[3]}; } \
    _Pragma("unroll") for (int qt = 0; qt < QTL; ++qt) { if (SKIP(qt)) continue;        \
        f32x4 s[2]; \
        _Pragma("unroll") for (int kt = 0; kt < 2; ++kt) { s[kt] = (f32x4){0.f, 0.f, 0.f, 0.f}; \
            _Pragma("unroll") for (int ks = 0; ks < 2; ++ks) s[kt] = __builtin_amdgcn_mfma_f32_16x16x32_bf16(kf[kt][ks], qf[qt][ks], s[kt], 0, 0, 0); } \
        float mx = -INFINITY; \
        _Pragma("unroll") for (int kt = 0; kt < 2; ++kt) _Pragma("unroll") for (int j = 0; j < 4; ++j) { const float tv = s[kt][j] * (SCALE) + BIAS(qt, kt, j); s[kt][j] = tv; mx = fmaxf(mx, tv); } \
        mx = fmaxf(mx, __shfl_xor(mx, 16)); mx = fmaxf(mx, __shfl_xor(mx, 32)); \
        const float mn = fmaxf(st.m[qt], mx), al = fexp2(st.m[qt] - mn); st.m[qt] = mn; \
        float ps = 0.f; \
        _Pragma("unroll") for (int kt = 0; kt < 2; ++kt) _Pragma("unroll") for (int j = 0; j < 4; ++j) { const float pv = fexp2(s[kt][j] - mn); s[kt][j] = pv; ps += pv; } \
        st.l[qt] = st.l[qt] * al + ps; \
        const unsigned w0 = pk2(s[0][0], s[0][1]), w1 = pk2(s[0][2], s[0][3]), w2 = pk2(s[1][0], s[1][1]), w3 = pk2(s[1][2], s[1][3]); \
        const bf16x8 pf = __builtin_bit_cast(bf16x8, ((u32x4){w0, w1, w2, w3})); \
        _Pragma("unroll") for (int dt = 0; dt < 4; ++dt) st.o[dt][qt] = __builtin_amdgcn_mfma_f32_16x16x32_bf16(vf[dt], pf, st.o[dt][qt] * al, 0, 0, 0); } \
    } while (0)


#define KS_ROWB 144
#define ATTN_COMPS(kb_, vb_, SCALE, BIAS, SKIP) do { \
    bf16x8 kf[2][2]; \
    _Pragma("unroll") for (int kt = 0; kt < 2; ++kt) _Pragma("unroll") for (int ks = 0; ks < 2; ++ks) \
        kf[kt][ks] = *(const LAS bf16x8*)((kb_) + (kt * 16 + fr) * KS_ROWB + (ks * 32 + 8 * fq) * 2); \
    bf16x8 vf[4]; \
    _Pragma("unroll") for (int dt = 0; dt < 4; ++dt) { \
        const s16x4 lo = __builtin_amdgcn_ds_read_tr16_b64_v4i16((LAS s16x4*)((vb_) + (4 * fq + (fr >> 2)) * V_ROWB + (dt * 16 + (fr & 3) * 4) * 2)); \
        const s16x4 hi = __builtin_amdgcn_ds_read_tr16_b64_v4i16((LAS s16x4*)((vb_) + (16 + 4 * fq + (fr >> 2)) * V_ROWB + (dt * 16 + (fr & 3) * 4) * 2)); \
        vf[dt] = (bf16x8){lo[0], lo[1], lo[2], lo[3], hi[0], hi[1], hi[2], hi[3]}; } \
    _Pragma("unroll") for (int qt = 0; qt < QTL; ++qt) { if (SKIP(qt)) continue;        \
        f32x4 s[2]; \
        _Pragma("unroll") for (int kt = 0; kt < 2; ++kt) { s[kt] = (f32x4){0.f, 0.f, 0.f, 0.f}; \
            _Pragma("unroll") for (int ks = 0; ks < 2; ++ks) s[kt] = __builtin_amdgcn_mfma_f32_16x16x32_bf16(kf[kt][ks], qf[qt][ks], s[kt], 0, 0, 0); } \
        float mx = -INFINITY; \
        _Pragma("unroll") for (int kt = 0; kt < 2; ++kt) _Pragma("unroll") for (int j = 0; j < 4; ++j) { const float tv = s[kt][j] * (SCALE) + BIAS(qt, kt, j); s[kt][j] = tv; mx = fmaxf(mx, tv); } \
        mx = fmaxf(mx, __shfl_xor(mx, 16)); mx = fmaxf(mx, __shfl_xor(mx, 32)); \
        const float mn = fmaxf(st.m[qt], mx), al = fexp2(st.m[qt] - mn); st.m[qt] = mn; \
        float ps = 0.f; \
        _Pragma("unroll") for (int kt = 0; kt < 2; ++kt) _Pragma("unroll") for (int j = 0; j < 4; ++j) { const float pv = fexp2(s[kt][j] - mn); s[kt][j] = pv; ps += pv; } \
        st.l[qt] = st.l[qt] * al + ps; \
        const unsigned w0 = pk2(s[0][0], s[0][1]), w1 = pk2(s[0][2], s[0][3]), w2 = pk2(s[1][0], s[1][1]), w3 = pk2(s[1][2], s[1][3]); \
        const bf16x8 pf = __builtin_bit_cast(bf16x8, ((u32x4){w0, w1, w2, w3})); \
        _Pragma("unroll") for (int dt = 0; dt < 4; ++dt) st.o[dt][qt] = __builtin_amdgcn_mfma_f32_16x16x32_bf16(vf[dt], pf, st.o[dt][qt] * al, 0, 0, 0); } \
    } while (0)


template <int QTL>
__device__ __forceinline__ void attn_store(AttnStT<QTL>& st, bf16_t* dst  , int dld, int fr, int fq) {
#pragma unroll
    for (int qt = 0; qt < QTL; ++qt) {
        float l = st.l[qt]; l += __shfl_xor(l, 16); l += __shfl_xor(l, 32);
        const float inv = 1.f / l;
        { const f32x4 o0 = st.o[0][qt] * inv, o1 = st.o[1][qt] * inv, o2 = st.o[2][qt] * inv, o3 = st.o[3][qt] * inv;
          u32x4 d1, d2; fullline(PK4W(o0, o1), PK4W(o2, o3), fr & 1, d1, d2); bf16_t* de = dst + (size_t)(qt * 16 + (fr & ~1)) * dld + FL_COL(fr, fq);
          *(u32x4*)de = d1; *(u32x4*)(de + dld) = d2; }
    }
}

__device__ __forceinline__ void phase_attn_l0(Frame& F) {
    constexpr int QTL = 2;
    const int wid = F.wid, lane = F.lane, fr = lane & 15, fq = lane >> 4;
    LAS unsigned char* vl = F.lds + wid * 8192;
    constexpr int NPASS = 4 / QTL, N_WIN = 256 * NPASS, N_CTXA = 16 * NPASS, N_CONV = NTOK / 64;
    const float SC = 0.125f * LOG2E;
    for (int it = F.bid; it < N_WIN + N_CTXA + N_CONV; it += F.G) {
        if (it < N_WIN + N_CTXA) {
            const bool isctx = it >= N_WIN;
            int b, kvh, qb, qh;
            if (!isctx) { const int c = it / NPASS; qh = it - c * NPASS; b = c >> 6; kvh = (c >> 5) & 1; qb = c & 31; } else { const int c2 = it - N_WIN, c = c2 / NPASS; qh = c2 - c * NPASS; b = c >> 2; kvh = (c >> 1) & 1; qb = c & 1; }
            const int g = wid >> 1, h = kvh * 4 + g;
            {
            const int qq0 = (wid & 1) * 64 + qh * (16 * QTL);
            const int qrow0 = (isctx ? NMAIN + b * CTXL : b * SEQ) + qb * 128 + qq0;
            bf16x8 qf[QTL][2];
#pragma unroll
            for (int qt = 0; qt < QTL; ++qt)
#pragma unroll
                for (int ks = 0; ks < 2; ++ks) qf[qt][ks] = *(const bf16x8*)(F_PROJ + (size_t)(qrow0 + qt * 16 + fr) * EVEN_IN + h * 64 + ks * 32 + 8 * fq);
            AttnStT<QTL> st;
            const float sink = PP(even_sink)[h] * LOG2E;
#pragma unroll
            for (int qt = 0; qt < QTL; ++qt) { st.m[qt] = sink; st.l[qt] = (fq == 0) ? 1.f : 0.f;
#pragma unroll
                for (int dt = 0; dt < 4; ++dt) st.o[dt][qt] = (f32x4){0.f, 0.f, 0.f, 0.f}; }
            const int kcol = 512 + kvh * 64, vcol = 640 + kvh * 64;
#define SKIP_NONE(qt) false
#define SKIP_PREV(qt) ((s32 * 32 + 31) < (qq0 + qt * 16))
#define SKIP_NEXT(qt) ((s32 * 32) > (qq0 + qt * 16 + 15))
#define BIAS_PREV(qt, kt, j) ((s32 * 32 + kt * 16 + 4 * fq + j) >= (qq0 + qt * 16 + fr) ? 0.f : -INFINITY)
#define BIAS_NEXT(qt, kt, j) ((s32 * 32 + kt * 16 + 4 * fq + j) <= (qq0 + qt * 16 + fr) ? 0.f : -INFINITY)
#define BIAS_NONE(qt, kt, j) 0.f
#define W_OK(ch_) ((ch_) >= 3 || ((qb - 1 + (ch_)) >= 0 && (qb - 1 + (ch_)) < SEQ / 128))
#define W_KROW(ch_, s_) (((ch_) < 3 ? b * SEQ + (qb - 1 + (ch_)) * 128 : NMAIN + b * CTXL + ((ch_) - 3) * 128) + (s_) * 32)
            int ch = isctx ? 3 : 0; if (!W_OK(ch)) ++ch;
            int s32 = 0;
            const bool isK = wid < 4; const int skey = (wid & 3) * 8 + (lane >> 3), scol = (isK ? kcol : vcol) + (lane & 7) * 8;
            const unsigned sdst = isK ? (unsigned)(skey * KS_ROWB + (lane & 7) * 16) : (unsigned)(2 * 32 * KS_ROWB + skey * V_ROWB + (lane & 7) * 16), sbuf = isK ? 32u * KS_ROWB : 32u * V_ROWB;
            i32x4 sh;
            __syncthreads();
            sh = *(const i32x4*)(F_PROJ + (size_t)(W_KROW(ch, s32) + skey) * EVEN_IN + scol);
            *(LAS i32x4*)(F.lds + sdst) = sh;
            asm volatile("s_waitcnt vmcnt(0) lgkmcnt(0)" ::: "memory");
            __syncthreads();
            asm volatile("" ::: "memory"); __builtin_amdgcn_sched_barrier(0);
            for (unsigned bufi = 0;; bufi ^= 1u) {
                int ch2 = ch, s2 = s32 + 1; if (s2 == 4) { s2 = 0; ++ch2; if (ch2 < 5 && !W_OK(ch2)) ++ch2; }
                const bool more = ch2 < 5;
                if (more) sh = *(const i32x4*)(F_PROJ + (size_t)(W_KROW(ch2, s2) + skey) * EVEN_IN + scol);
                __builtin_amdgcn_sched_barrier(0);
                LAS unsigned char* kbp = F.lds + bufi * (32u * KS_ROWB); LAS unsigned char* vbp = F.lds + 2 * 32 * KS_ROWB + bufi * (32u * V_ROWB);
                if (ch == 0) { ATTN_COMPS(kbp, vbp, SC, BIAS_PREV, SKIP_PREV); }
                else if (ch == 2) { ATTN_COMPS(kbp, vbp, SC, BIAS_NEXT, SKIP_NEXT); }
                else { ATTN_COMPS(kbp, vbp, SC, BIAS_NONE, SKIP_NONE); }
                if (!more) break;
                *(LAS i32x4*)(F.lds + sdst + (bufi ^ 1u) * sbuf) = sh;
                asm volatile("s_waitcnt vmcnt(0) lgkmcnt(0)" ::: "memory");
                __syncthreads();
                asm volatile("" ::: "memory"); __builtin_amdgcn_sched_barrier(0);
                ch = ch2; s32 = s2;
            }
#undef W_OK
#undef W_KROW
            attn_store(st, F_MIX + (size_t)qrow0 * D + h * 64, D, fr, fq);
            }
        } else {
            const int ci = it - N_WIN - N_CTXA, c4 = (F.tid & 127) * 4, r0 = ci * 64 + (F.tid >> 7) * 16;
            const f32x4 w0 = *(const f32x4*)(PP(even_conv_w) + c4), w1 = *(const f32x4*)(PP(even_conv_w) + 512 + c4), w2 = *(const f32x4*)(PP(even_conv_w) + 1024 + c4);
#define LOADZ(dst, row_) do { const u32x2 gc_ = *(const u32x2*)(F_PROJ + (size_t)(row_) * EVEN_IN + 1280 + c4), uu_ = *(const u32x2*)(F_PROJ + (size_t)(row_) * EVEN_IN + 1792 + c4); \
                dst = (f32x4){bflo(gc_.x) * bflo(uu_.x), bfhi(gc_.x) * bfhi(uu_.x), bflo(gc_.y) * bflo(uu_.y), bfhi(gc_.y) * bfhi(uu_.y)}; } while (0)
            const int seqmask = r0 < NMAIN ? (SEQ - 1) : (CTXL - 1);
            u32x2 gcv[18], uuv[18], gbv[16];
#pragma unroll
            for (int i = 0; i < 18; ++i) { const int row = r0 - 1 + i; const bool ok = (i == 0) ? ((r0 & seqmask) != 0) : (i == 17) ? (((r0 + 15) & seqmask) != seqmask) : true;
                const int rr = ok ? row : r0;
                gcv[i] = *(const u32x2*)(F_PROJ + (size_t)rr * EVEN_IN + 1280 + c4); uuv[i] = *(const u32x2*)(F_PROJ + (size_t)rr * EVEN_IN + 1792 + c4);
                if (!ok) { gcv[i] = (u32x2){0u, 0u}; } }
#pragma unroll
            for (int i = 0; i < 16; ++i) gbv[i] = *(const u32x2*)(F_PROJ + (size_t)(r0 + i) * EVEN_IN + 768 + c4);
            __builtin_amdgcn_sched_barrier(0);
#define ZOF(i_) ((f32x4){bflo(gcv[i_].x) * bflo(uuv[i_].x), bfhi(gcv[i_].x) * bfhi(uuv[i_].x), bflo(gcv[i_].y) * bflo(uuv[i_].y), bfhi(gcv[i_].y) * bfhi(uuv[i_].y)})
            f32x4 zp = ZOF(0), zc = ZOF(1);
#pragma unroll
            for (int i = 0; i < 16; ++i) {
                const int row = r0 + i;
                const f32x4 zn = ZOF(i + 2);
                const u32x2 gb = gbv[i];
                const f32x4 y = zp * w0 + zc * w1 + zn * w2;
                u32x2 w; w.x = pk2(bflo(gb.x) * y[0], bfhi(gb.x) * y[1]); w.y = pk2(bflo(gb.y) * y[2], bfhi(gb.y) * y[3]);
                *(u32x2*)(F_MIX + (size_t)row * D + 512 + c4) = w;
                zp = zc; zc = zn;
            }
#undef ZOF
        }
    }
}

constexpr int RW_LD = 1028;
__device__ __forceinline__ void phase_route(Frame& F, const int layer) {
    const int nrows = layer == 0 ? NTOK : NMAIN;
    LAS float* rwT = (LAS float*)F.lds;
    LAS int* cntL = (LAS int*)(F.lds + 32 * RW_LD * 4);
    LAS int* baseL = cntL + 32;
    LAS int* selE = baseL + 32;
    LAS int* selR = selE + 384;
    const float* rw = PP(router_w) + (size_t)layer * D * NEXP;
    { const f32x4* rsrc4 = (const f32x4*)rw + F.tid; LAS float* wp = rwT + ((4 * F.tid) & 31) * RW_LD + (F.tid >> 3);
      for (int it = 0; it < 4; ++it) {
        f32x4 v[4];
#pragma unroll
        for (int u = 0; u < 4; ++u) v[u] = rsrc4[(it * 4 + u) * 512];
#pragma unroll
        for (int u = 0; u < 4; ++u)
#pragma unroll
            for (int j = 0; j < 4; ++j) wp[it * 256 + u * 64 + j * RW_LD] = v[u][j];
        asm volatile("" ::: "memory"); } }
    if (F.tid < 32) cntL[F.tid] = 0;
    __syncthreads();
    const int lane = F.lane, gw = F.bid * 8 + F.wid, NGW = F.G * 8;
    const float* gam = PP(norm_ffn) + layer * D;
    int slot = F.wid;
    const float* Wd = PP(moe_w_dn) + (size_t)layer * NEXP * DFF * D; bf16_t* pd = (bf16_t*)(F.ws + WS_BC2);
    constexpr int CV_TOTAL = NEXP * 4 * 1024;
    const int cv_q = (CV_TOTAL + NGW - 1) / NGW, cv_end = min((gw + 1) * cv_q, CV_TOTAL); int cv_u = gw * cv_q;
#define CV_LOAD(v_, u0_) do { _Pragma("unroll") for (int u = 0; u < 8; ++u) { const int pr = min((u0_) + u, CV_TOTAL - 1), pnl = pr >> 10, k = pr & 1023, e = pnl >> 2, ct = pnl & 3; \
        v_[u] = *(const f32x4*)(Wd + ((size_t)e * DFF + k) * D + ct * 256 + 4 * lane); } } while (0)
#define CV_STORE(v_, u0_, uend_) do { _Pragma("unroll") for (int u = 0; u < 8; ++u) { const int pr = (u0_) + u; if (pr < (uend_)) { u32x2 w; w.x = pk2(v_[u][0], v_[u][1]); w.y = pk2(v_[u][2], v_[u][3]); \
        *(u32x2*)(pd + (size_t)pr * 256 + 4 * lane) = w; } } } while (0)
#define RT_LOADROW(dst_, r_) do { if ((r_) < nrows) { _Pragma("unroll") for (int j = 0; j < 4; ++j) dst_[j] = *(const u32x2*)(F_XS + (size_t)(r_) * D + 4 * lane + 256 * j); } } while (0)
#define RT_CVT(u_) ((f32x4){bflo((u_).x), bfhi((u_).x), bflo((u_).y), bfhi((u_).y)})
#define RT_TAIL(pe, row_, slot_, on_) do { \
        float q16[16], q8[8], q4[4], q2[2], q1; \
        { _Pragma("unroll") for (int i = 0; i < 16; ++i) { float a_ = pe[i], b_ = pe[16 + i];        \
            asm volatile("s_nop 1\n\tv_permlane32_swap_b32 %0, %1" : "+v"(a_), "+v"(b_)); q16[i] = a_ + b_; } } \
        { _Pragma("unroll") for (int i = 0; i < 8; ++i) { float a_ = q16[i], b_ = q16[8 + i];        \
            asm volatile("s_nop 1\n\tv_permlane16_swap_b32 %0, %1" : "+v"(a_), "+v"(b_)); q8[i] = a_ + b_; } } \
        { const bool hi = lane & 8; _Pragma("unroll") for (int i = 0; i < 4; ++i) { const float snd = hi ? q8[i] : q8[4 + i], mine = hi ? q8[4 + i] : q8[i]; q4[i] = mine + __shfl_xor(snd, 8); } } \
        { const bool hi = lane & 4; _Pragma("unroll") for (int i = 0; i < 2; ++i) { const float snd = hi ? q4[i] : q4[2 + i], mine = hi ? q4[2 + i] : q4[i]; q2[i] = mine + __shfl_xor(snd, 4); } } \
        { const bool hi = lane & 2; const float snd = hi ? q2[0] : q2[1], mine = hi ? q2[1] : q2[0]; q1 = mine + __shfl_xor(snd, 2); } \
        q1 += __shfl_xor(q1, 1); \
        const int myE = (lane >> 1) & 31; \
        const float val = q1 + PP(router_b)[layer * NEXP + myE]; \
        float tv[4]; int te[4]; \
        { int rank = 0; const int vb = __builtin_bit_cast(int, val); \
          _Pragma("unroll") for (int e2 = 0; e2 < 32; ++e2) { const float o = __builtin_bit_cast(float, __builtin_amdgcn_readlane(vb, 2 * e2)); rank += (o > val || (o == val && e2 < myE)) ? 1 : 0; } \
          _Pragma("unroll") for (int k = 0; k < 4; ++k) { const unsigned long long mk = __ballot(rank == k); const int src = __builtin_amdgcn_readfirstlane((int)__builtin_ctzll(mk)); \
              tv[k] = __builtin_bit_cast(float, __builtin_amdgcn_readlane(vb, src)); te[k] = (src >> 1) & 31; } } \
        const float e1 = __expf(tv[1] - tv[0]), e2 = __expf(tv[2] - tv[0]), e3 = __expf(tv[3] - tv[0]), inv = 1.f / (1.f + e1 + e2 + e3); \
        if (lane == 0 && (on_)) { \
            *(f32x4*)(F_TOPW + (size_t)(row_) * 4) = (f32x4){inv, e1 * inv, e2 * inv, e3 * inv}; \
            _Pragma("unroll") for (int k = 0; k < 4; ++k) { selE[(slot_) * 4 + k] = te[k]; selR[(slot_) * 4 + k] = atomicAdd((int*)(cntL + te[k]), 1); } \
        } } while (0)
    u32x2 vn0[4], vn1[4];
    RT_LOADROW(vn0, gw); RT_LOADROW(vn1, gw + NGW);
    for (int row = gw; row < nrows; row += 2 * NGW, slot += 16) {
        const bool two = row + NGW < nrows;
        f32x4 v0[4], v1[4], h0[4], h1[4], cvv[8];
        const int cv_u0 = cv_u; CV_LOAD(cvv, cv_u0); cv_u += 8;
#pragma unroll
        for (int j = 0; j < 4; ++j) { v0[j] = RT_CVT(vn0[j]); v1[j] = two ? RT_CVT(vn1[j]) : RT_CVT(vn0[j]); }
        RT_LOADROW(vn0, row + 2 * NGW); RT_LOADROW(vn1, row + 3 * NGW);
        { const float rstd = row_rstd(v0); const int r = mod_row(row);
          norm_mod_store(v0, rstd, gam, modp(F, layer, r, 4), modp(F, layer, r, 3), F_H + (size_t)row * D, lane, &h0); }
        if (two) { const float rstd = row_rstd(v1); const int r = mod_row(row + NGW);
          norm_mod_store(v1, rstd, gam, modp(F, layer, r, 4), modp(F, layer, r, 3), F_H + (size_t)(row + NGW) * D, lane, &h1); }
        else {
#pragma unroll
          for (int j = 0; j < 4; ++j) h1[j] = h0[j]; }
        float pe0[32], pe1[32];
        f32x2 hh[4][4];
#pragma unroll
        for (int j = 0; j < 4; ++j)
#pragma unroll
            for (int c = 0; c < 4; ++c) hh[j][c] = (f32x2){h0[j][c], h1[j][c]};
#pragma unroll
        for (int e = 0; e < 32; ++e) {
            f32x2 s2 = (f32x2){0.f, 0.f};
#pragma unroll
            for (int j = 0; j < 4; ++j) { const f32x4 w = *(const LAS f32x4*)(rwT + e * RW_LD + 4 * lane + 256 * j);
#pragma unroll
                for (int c = 0; c < 4; ++c) s2 = __builtin_elementwise_fma(hh[j][c], (f32x2){w[c], w[c]}, s2); }
            pe0[e] = s2.x; pe1[e] = s2.y; if ((e & 3) == 3) __builtin_amdgcn_sched_barrier(0); }
        __builtin_amdgcn_sched_barrier(0);
        RT_TAIL(pe0, row, slot, true);
        __builtin_amdgcn_sched_barrier(0);
        CV_STORE(cvv, cv_u0, cv_end);
        const int cv_u1 = cv_u; CV_LOAD(cvv, cv_u1); cv_u += 8;
        __builtin_amdgcn_sched_barrier(0);
        RT_TAIL(pe1, row + NGW, slot + 8, two);
        __builtin_amdgcn_sched_barrier(0);
        CV_STORE(cvv, cv_u1, cv_end);
    }
#undef RT_LOADROW
#undef RT_CVT
#undef RT_TAIL
    for (; cv_u < cv_end; cv_u += 8) { f32x4 cvv[8]; CV_LOAD(cvv, cv_u); CV_STORE(cvv, cv_u, cv_end); }
#undef CV_LOAD
#undef CV_STORE
    __syncthreads();
    if (F.tid < 32) { const int c = cntL[F.tid]; baseL[F.tid] = c ? (int)atomicAdd(F_cnt + layer * 32 + F.tid, (unsigned)c) : 0; }
    __syncthreads();
    if (F.tid < 384) { const int s = F.tid >> 2, k = F.tid & 3; const int row = F.bid * 8 + (s & 7) + (s >> 3) * NGW;
        if (row < nrows) { const int e = selE[F.tid], pos = baseL[e] + selR[F.tid]; F_POS[(size_t)row * 4 + k] = e | (pos << 8); F_LIST[(size_t)e * NTOK + pos] = row; } }
    __syncthreads();
}

struct MoeLds { LAS int *mtp, *roff, *mtq, *nz; };
__device__ __forceinline__ MoeLds moe_lds(Frame& F) { MoeLds L; L.mtp = (LAS int*)(F.lds + 2 * STAGE_B); L.roff = L.mtp + 40; L.mtq = L.roff + 40; L.nz = L.mtq + 40; return L; }
__device__ __forceinline__ void moe_prefix(Frame& F, const int layer, const MoeLds& L) {
    if (F.tid < 64) { const int e = F.lane & 31; const int c = (int)__hip_atomic_load(F_cnt + layer * 32 + e, __ATOMIC_RELAXED, __HIP_MEMORY_SCOPE_AGENT);
        const int mt = (c + 255) >> 8; int a = mt, b = c, q = mt > 0 ? mt - 1 : 0, z = mt > 0 ? 1 : 0;
#pragma unroll
        for (int o = 1; o < 32; o <<= 1) { const int ua = __shfl_up(a, o, 32), ub = __shfl_up(b, o, 32), uq = __shfl_up(q, o, 32), uz = __shfl_up(z, o, 32); if (e >= o) { a += ua; b += ub; q += uq; z += uz; } }
        if (F.lane < 32) { L.mtp[e + 1] = a; L.roff[e + 1] = b; L.mtq[e + 1] = q; if (mt > 0) L.nz[z - 1] = e; if (e == 31) L.nz[32] = z; if (e == 0) { L.mtp[0] = 0; L.roff[0] = 0; L.mtq[0] = 0; } } }
    __syncthreads();
}
struct PolMoe : PolBase {
    const float* W; MoeLds L; int layer, nct, round; size_t bc_off; mutable int ehint = 0;
    __device__ __forceinline__ bool find(int i, int& e, int& ct, int& rbase, int& ro, int& cnt) const { int T; if (!tileL(i, T)) return false;
        if (round == 0) { const int q = T / nct; ct = T - q * nct; e = __builtin_amdgcn_readfirstlane(L.nz[q]); rbase = 0; }
        else { LAS int* pf = round == 1 ? L.mtq : L.mtp; e = ehint; while (pf[e + 1] * nct <= T) ++e;
            ehint = e;
            e = __builtin_amdgcn_readfirstlane(e);
            const int mq = __builtin_amdgcn_readfirstlane(pf[e + 1] - pf[e]), w = T - __builtin_amdgcn_readfirstlane(pf[e]) * nct; ct = w / mq; rbase = ((round == 1 ? 1 : 0) + w - ct * mq) * 256; }
        ro = __builtin_amdgcn_readfirstlane(L.roff[e]); cnt = __builtin_amdgcn_readfirstlane(L.roff[e + 1]) - ro; return true; }
    __device__ __forceinline__ bf16_t* panel(int e, int ct) const { return (bf16_t*)(ws + bc_off) + (size_t)(e * nct + ct) * (1024 * 256); }
};
struct PolMoe1 : PolMoe {
    __device__ __forceinline__ unsigned list_voff(const TD& td) const { return 4u * (unsigned)(td.i0 * NTOK + td.i2 + lane * 4); }
    __device__ __forceinline__ void late(TD& td, const LAS int* ll) const { const int cl = td.i4 - 1 - td.i2;
#pragma unroll
        for (int i2 = 0; i2 < 2; ++i2) { int rl = prow(i2); rl = rl < cl ? rl : cl; td.aoff[i2] = (unsigned)((ll[rl] * D + pcol()) * 2); } }
    __device__ __forceinline__ unsigned bias_voff(const TD& td) const { return 4u * (unsigned)((layer * NEXP + td.i0) * (2 * DFF) + (lane >> 5) * DFF + td.i1 * 128 + (lane & 31) * 4); }
    __device__ __forceinline__ bool get(int i, TD& td) const { int e, ct, rbase, ro, cnt; if (!find(i, e, ct, rbase, ro, cnt)) return false;
        const int* list = (const int*)(ws + WS_LIST) + (size_t)e * NTOK; td.A = (const bf16_t*)(ws + WS_H);
        if (!has_list || i == 0) {
#pragma unroll
            for (int i2 = 0; i2 < 4; ++i2) { int rr = rbase + prow(i2); rr = rr < cnt ? rr : cnt - 1; td.aoff[i2] = (unsigned)((list[rr] * D + pcol()) * 2); } }
        if (round == 0) { td.B = W + ((size_t)(layer * NEXP + e) * D + wid * 8) * (2 * DFF) + ct * 128; td.ldb = 2 * DFF; td.bco = panel(e, ct); } else { td.B = panel(e, ct); td.bco = nullptr; }
        td.i0 = e; td.i1 = ct; td.i2 = rbase; td.i3 = ro; td.i4 = cnt; return true; }
    __device__ __forceinline__ void epi(f32x4 (&acc)[8][4], const TD& td, const LAS float* bl) const { (void)bl; EPI_GEOM; const int e = td.i0, ct = td.i1, rbase = td.i2, ro = td.i3, cnt = td.i4;
        bf16_t* ACT = (bf16_t*)(ws + WS_ACT);
        const int gl0 = wc * 32 + 4 * fq, gc0 = ct * 128 + gl0; const size_t bo = (size_t)(layer * NEXP + e) * (2 * DFF);
        const f32x4 bg0 = bl ? *(const LAS f32x4*)(bl + gl0) : *(const f32x4*)(bias + bo + gc0), bu0 = bl ? *(const LAS f32x4*)(bl + 128 + gl0) : *(const f32x4*)(bias + bo + DFF + gc0);
        const f32x4 bg1 = bl ? *(const LAS f32x4*)(bl + gl0 + 16) : *(const f32x4*)(bias + bo + gc0 + 16), bu1 = bl ? *(const LAS f32x4*)(bl + 128 + gl0 + 16) : *(const f32x4*)(bias + bo + DFF + gc0 + 16);
        const int cw = ct * 128 + wc * 32 + WIDE_COL(0, fq);
#pragma unroll
        for (int m = 0; m < 8; ++m) { const int r = rbase + wr * 128 + m * 16 + fr; float a[2][4];
#pragma unroll
            for (int n = 0; n < 2; ++n)
#pragma unroll
                for (int j = 0; j < 4; ++j) { const float gg = fminf(acc[m][n][j] + (n ? bg1[j] : bg0[j]), 7.f), uu = __builtin_amdgcn_fmed3f(acc[m][n + 2][j] + (n ? bu1[j] : bu0[j]), -7.f, 7.f);
                    a[n][j] = (uu + 1.f) * gg * __builtin_amdgcn_rcpf(1.f + fexp2(-1.702f * LOG2E * gg)); }
            const u32x4 w = widen16(pk2(a[0][0], a[0][1]), pk2(a[0][2], a[0][3]), pk2(a[1][0], a[1][1]), pk2(a[1][2], a[1][3]));
            if (r < cnt) *(u32x4*)(ACT + (size_t)(ro + r) * DFF + cw) = w; } }
};
struct PolMoe2 : PolMoe {
    __device__ __forceinline__ unsigned bias_voff(const TD& td) const { return 4u * (unsigned)((layer * NEXP + td.i0) * D + td.i1 * 256 + lane * 4); }
    __device__ __forceinline__ bool get(int i, TD& td) const { int e, ct, rbase, ro, cnt; if (!find(i, e, ct, rbase, ro, cnt)) return false;
        td.A = (const bf16_t*)(ws + WS_ACT);
#pragma unroll
        for (int i2 = 0; i2 < 4; ++i2) { int rr = rbase + prow(i2); rr = rr < cnt ? rr : cnt - 1; td.aoff[i2] = (unsigned)(((ro + rr) * DFF + pcol()) * 2); }
        td.B = panel(e, ct); td.bco = nullptr;
        td.i0 = e; td.i1 = ct; td.i2 = rbase; td.i3 = ro; td.i4 = cnt; return true; }
    __device__ __forceinline__ void epi(f32x4 (&acc)[8][4], const TD& td, const LAS float* bl) const { (void)bl; EPI_GEOM; const int e = td.i0, ct = td.i1, rbase = td.i2, ro = td.i3, cnt = td.i4;
        bf16_t* Y = (bf16_t*)(ws + WS_Y);
        const size_t bo = (size_t)(layer * NEXP + e) * D + ct * 256 + wc * 64;
        f32x4 bv[4];
#pragma unroll
        for (int n = 0; n < 4; ++n) bv[n] = bl ? *(const LAS f32x4*)(bl + wc * 64 + n * 16 + 4 * fq) : *(const f32x4*)(bias + bo + n * 16 + 4 * fq);
        const bool odd = fr & 1;
        const int cw = ct * 256 + wc * 64 + (odd ? 32 : 0) + WIDE_COL(0, fq);
#pragma unroll
        for (int m = 0; m < 8; ++m) { const int r1 = rbase + wr * 128 + m * 16 + (fr & ~1);
            u32x4 w[2];
#pragma unroll
            for (int h2 = 0; h2 < 2; ++h2) { const int np = 2 * h2;
                w[h2] = widen16(pk2(acc[m][np][0] + bv[np][0], acc[m][np][1] + bv[np][1]), pk2(acc[m][np][2] + bv[np][2], acc[m][np][3] + bv[np][3]),
                                pk2(acc[m][np + 1][0] + bv[np + 1][0], acc[m][np + 1][1] + bv[np + 1][1]), pk2(acc[m][np + 1][2] + bv[np + 1][2], acc[m][np + 1][3] + bv[np + 1][3])); }
            u32x4 d1, d2;
#pragma unroll
            for (int q = 0; q < 4; ++q) { const unsigned snd = odd ? w[0][q] : w[1][q];
                const unsigned rcv = (unsigned)__builtin_amdgcn_update_dpp(0, (int)snd, 0xB1, 0xF, 0xF, true);
                d1[q] = odd ? rcv : w[0][q]; d2[q] = odd ? w[1][q] : rcv; }
            if (r1 < cnt) *(u32x4*)(Y + (size_t)(ro + r1) * D + cw) = d1;
            if (r1 + 1 < cnt) *(u32x4*)(Y + (size_t)(ro + r1 + 1) * D + cw) = d2; } }
};
__device__ __forceinline__ void phase_moe1(Frame& F, const XcdBarrier& bar, const bool use_bar, const int layer) {
    const MoeLds L = moe_lds(F);
    moe_prefix(F, layer, L);
    const int ne = __builtin_amdgcn_readfirstlane(L.nz[32]), tq = __builtin_amdgcn_readfirstlane(L.mtq[32]);
    const float* W = PP(moe_w_gu); const float* bias = PP(moe_b_gu);
    { PolMoe1 P; P.L = L; P.layer = layer; P.nct = 8; P.round = 0; P.bc_off = WS_BC; P.base_init(F, D / 64, ne * 8); P.bfm = false; P.W = W; P.bias = bias;
      { const int l2 = F.lane & 31; P.lcolb = 4u * (unsigned)((F.lane >> 5) * DFF + 4 * l2); P.woff = 2u * (unsigned)(((4 * l2) >> 5) * 64 + (F.lane >> 5) * 32 + ((4 * l2) & 31)); }
      gemm_stream(F.lds, P, F.wid, F.lane); }
    if (use_bar) xcd_barrier(bar);
    { PolMoe1 P; P.L = L; P.layer = layer; P.nct = 8; P.round = 1; P.bc_off = WS_BC; P.base_init(F, D / 64, tq * 8); P.ldbB = 256; P.W = W; P.bias = bias; P.has_bias = true; P.has_list = true; P.listp = (const int*)(F.ws + WS_LIST);
      gemm_stream_bf(F.lds, P, F.wid, F.lane); }
}
__device__ __forceinline__ void phase_moe2(Frame& F, const int layer) {
    const MoeLds L = moe_lds(F);
    moe_prefix(F, layer, L);
    PolMoe2 P; P.L = L; P.layer = layer; P.nct = 4; P.round = 2; P.bc_off = WS_BC2; P.base_init(F, DFF / 64, __builtin_amdgcn_readfirstlane(L.mtp[32]) * 4); P.ldbB = 256; P.W = nullptr; P.bias = PP(moe_b_dn); P.has_bias = true;
    gemm_stream_bf(F.lds, P, F.wid, F.lane);
}

__device__ __forceinline__ void phase_combine(Frame& F, const int layer) {
    const MoeLds ML = moe_lds(F); LAS int* roff = ML.roff;
    moe_prefix(F, layer, ML);
    const int nrows = layer == 0 ? NTOK : NMAIN, lane = F.lane;
    const int gw = F.bid * 8 + F.wid, NGW = F.G * 8;
    i32x4 ps_n = (i32x4){0, 0, 0, 0}; f32x4 tw_n = (f32x4){0.f, 0.f, 0.f, 0.f}, tw_c = tw_n, tw_m = tw_n;
    u32x2 y_c[4][4], y_m[4][4], y_n[4][4]; u32x2 xs_c[4], xs_m[4], xs_n[4];
#define CMB_IDX(row_) do { if ((row_) < nrows) { ps_n = *(const i32x4*)(F_POS + (size_t)(row_) * 4); tw_n = *(const f32x4*)(F_TOPW + (size_t)(row_) * 4); } } while (0)
#define CMB_DATA(row_, Y_, XS_) do { if ((row_) < nrows) { \
        _Pragma("unroll") for (int k = 0; k < 4; ++k) { const int e = ps_n[k] & 255, pos = ps_n[k] >> 8; const bf16_t* y = F_Y + (size_t)(roff[e] + pos) * D; \
            _Pragma("unroll") for (int j = 0; j < 4; ++j) Y_[k][j] = *(const u32x2*)(y + 4 * lane + 256 * j); } \
        _Pragma("unroll") for (int j = 0; j < 4; ++j) XS_[j] = *(const u32x2*)(F_XS + (size_t)(row_) * D + 4 * lane + 256 * j); } } while (0)
    CMB_IDX(gw); CMB_DATA(gw, y_c, xs_c); tw_c = tw_n; CMB_IDX(gw + NGW); CMB_DATA(gw + NGW, y_m, xs_m); tw_m = tw_n; CMB_IDX(gw + 2 * NGW);
    for (int row = gw; row < nrows; row += NGW) {
        CMB_DATA(row + 2 * NGW, y_n, xs_n); const f32x4 tw_nn = tw_n; CMB_IDX(row + 3 * NGW);
        const int r = mod_row(row); const float* g2 = modp(F, layer, r, 5);
        f32x4 v[4];
#pragma unroll
        for (int j = 0; j < 4; ++j) v[j] = (f32x4){0.f, 0.f, 0.f, 0.f};
#pragma unroll
        for (int k = 0; k < 4; ++k) { const float w = tw_c[k];
#pragma unroll
            for (int j = 0; j < 4; ++j) { const u32x2 u = y_c[k][j]; v[j][0] += w * bflo(u.x); v[j][1] += w * bfhi(u.x); v[j][2] += w * bflo(u.y); v[j][3] += w * bfhi(u.y); } }
#pragma unroll
        for (int j = 0; j < 4; ++j) { const int c = 4 * lane + 256 * j; const f32x4 gv = *(const f32x4*)(g2 + c); const u32x2 xu = xs_c[j];
            v[j] = (f32x4){bflo(xu.x), bfhi(xu.x), bflo(xu.y), bfhi(xu.y)} + gv * v[j]; }
        const float rstd = row_rstd(v);
        if (layer == 0) {
#pragma unroll
            for (int j = 0; j < 4; ++j) st_bf4(F_XS + (size_t)row * D + 4 * lane + 256 * j, v[j]);
            norm_mod_store(v, rstd, PP(norm_mix) + D, modp(F, 1, r, 1), modp(F, 1, r, 0), F_H + (size_t)row * D, lane);
        } else {
#pragma unroll
            for (int j = 0; j < 4; ++j) { const int c = 4 * lane + 256 * j; const f32x4 g = *(const f32x4*)(PP(final_norm) + c); *(f32x4*)(((float*)ldp(F, (int)__builtin_offsetof(Params, out))) + (size_t)row * D + c) = v[j] * rstd * g; }
        }
        tw_c = tw_m; tw_m = tw_nn;
#pragma unroll
        for (int k = 0; k < 4; ++k)
#pragma unroll
            for (int j = 0; j < 4; ++j) { y_c[k][j] = y_m[k][j]; y_m[k][j] = y_n[k][j]; }
#pragma unroll
        for (int j = 0; j < 4; ++j) { xs_c[j] = xs_m[j]; xs_m[j] = xs_n[j]; }
        __builtin_amdgcn_sched_barrier(0);
    }
#undef CMB_IDX
#undef CMB_DATA
}

struct PolInproj1 : PolBase {
    const float* W;
    __device__ __forceinline__ bool get(int i, TD& td) const { int t; if (!tileL(i, t)) return false; constexpr int N_MAIN_T = (NMAIN / 256) * 10; int pm, pn;
        if (t < N_MAIN_T) dense_tile(t, NMAIN / 256, 10, pm, pn); else { const int c = t - N_MAIN_T; pm = NMAIN / 256 + (c & 3); pn = 2 + (c >> 2); }
        td.A = (const bf16_t*)(ws + WS_H); dense_aoff(td, pm * 256, D);
        td.B = (const bf16_t*)(ws + WB_OIN) + pn * 256; td.i0 = pm; td.i1 = pn; return true; }
    __device__ __forceinline__ void epi(f32x4 (&acc)[8][4], const TD& td, const LAS float* bl) const { (void)bl; EPI_GEOM; const int pm = td.i0, pn = td.i1;
        if (pn < 6) { bf16_t* PROJ = (bf16_t*)(ws + WS_PROJ);
#pragma unroll
            for (int m = 0; m < 8; ++m) { const int row = pm * 256 + wr * 128 + m * 16 + fr;
                { u32x4 d1, d2; fullline(PK4W(acc[m][0], acc[m][1]), PK4W(acc[m][2], acc[m][3]), fr & 1, d1, d2); const size_t re = (size_t)(row & ~1) * QKV_LD + pn * 256 + wc * 64 + FL_COL(fr, fq);
                  *(u32x4*)(PROJ + re) = d1; *(u32x4*)(PROJ + re + QKV_LD) = d2; } }
        } else { const int g = pn - 6, ri = wc >> 1; bf16_t* Z = (bf16_t*)(ws + WS_Z);
#pragma unroll
            for (int m = 0; m < 8; ++m) { const int row = pm * 256 + wr * 128 + m * 16 + fr, b = row >> 12, n1 = (row >> 6) & 63, n2 = row & 63;
                bf16_t* zb = Z + ((((size_t)(b * 64 + n1) * 2 + ri) * 64 + n2) * 512) + g * 128 + (wc & 1) * 64;
                { u32x4 d1, d2; fullline(PK4W(acc[m][0], acc[m][1]), PK4W(acc[m][2], acc[m][3]), fr & 1, d1, d2); bf16_t* ze = zb - (fr & 1) * 512 + FL_COL(fr, fq);
                  *(u32x4*)ze = d1; *(u32x4*)(ze + 512) = d2; } } } }
};
__device__ __forceinline__ void phase_inproj_l1(Frame& F) {
    PolInproj1 P; P.base_init(F, D / 64, (NMAIN / 256) * 10 + (NCTX / 256) * 4); P.ldbB = 2560;
    gemm_stream_bf(F.lds, P, F.wid, F.lane);
}

struct PolFour : PolBase {
    int stage;
    __device__ __forceinline__ bool get(int i, TD& td) const { int L; if (!tileL(i, L)) return false; const int b = L >> 7, ct = L & 127;
        td.A = (const bf16_t*)(ws + (stage == 1 ? WS_M1 : WS_M2)); dense_aoff(td, 0, 128);
        td.B = (const bf16_t*)(ws + (stage == 1 ? WS_Z : WS_A1)) + (size_t)b * 128 * 32768 + ct * 256; td.i0 = b; td.i1 = ct; return true; }
    __device__ __forceinline__ void epi(f32x4 (&acc)[8][4], const TD& td, const LAS float* bl) const { (void)bl; EPI_GEOM; const int b = td.i0, ct = td.i1;
        if (wr != 0) return;
        if (stage == 1) { const f32x2* TW = (const f32x2*)(ws + WS_TW); bf16_t* A1 = (bf16_t*)(ws + WS_A1);
#pragma unroll
            for (int m = 0; m < 4; ++m) { const int k1 = m * 16 + fr;
                { const int colw = ct * 256 + wc * 64, n2 = colw >> 9, c = (colw & 511) + FL_COL(fr, fq);
                  const f32x2 tw = TW[n2 * k1]; f32x4 ore[4], oim[4];
#pragma unroll
                  for (int n = 0; n < 4; ++n) { const f32x4 re = acc[m][n], im = acc[m + 4][n]; ore[n] = re * tw.x + im * tw.y; oim[n] = im * tw.x - re * tw.y; }
                  u32x4 r1_, r2_, i1_, i2_; fullline(PK4W(ore[0], ore[1]), PK4W(ore[2], ore[3]), fr & 1, r1_, r2_); fullline(PK4W(oim[0], oim[1]), PK4W(oim[2], oim[3]), fr & 1, i1_, i2_);
                  bf16_t* pr_ = A1 + ((((size_t)(b * 2 + 0) * 64 + n2) * 64 + (k1 & ~1)) * 512) + c; bf16_t* pi_ = A1 + ((((size_t)(b * 2 + 1) * 64 + n2) * 64 + (k1 & ~1)) * 512) + c;
                  *(u32x4*)pr_ = r1_; *(u32x4*)(pr_ + 512) = r2_; *(u32x4*)pi_ = i1_; *(u32x4*)(pi_ + 512) = i2_; } }
        } else { const float scl = 1.f / 724.0773439350247f; bf16_t* MIX = (bf16_t*)(ws + WS_MIX);
#pragma unroll
            for (int m = 0; m < 4; ++m) { const int k2 = m * 16 + fr;
                { const int colw = ct * 256 + wc * 64, k1 = colw >> 9, c = (colw & 511) + FL_COL(fr, fq);
                  const f32x4 o0 = acc[m][0] * scl, o1 = acc[m][1] * scl, o2 = acc[m][2] * scl, o3 = acc[m][3] * scl;
                  u32x4 d1, d2; fullline(PK4W(o0, o1), PK4W(o2, o3), fr & 1, d1, d2); bf16_t* me = MIX + (size_t)(b * SEQ + k1 + 64 * (k2 & ~1)) * D + 512 + c;
                  *(u32x4*)me = d1; *(u32x4*)(me + (size_t)64 * D) = d2; } } } }
};

__device__ __forceinline__ void phase_attn_l1(Frame& F) {
    constexpr int QTL = 4;
    const int wid = F.wid, lane = F.lane, fr = lane & 15, fq = lane >> 4;
    constexpr int N_NA = NB * 64, N_F1 = NB * 128;
    const float SC = 0.125f * LOG2E;
    for (int it = F.bid; it < N_NA; it += F.G) {
            LAS unsigned char* vl = F.lds + wid * 8192;
            LAS float* rp = (LAS float*)(vl + 5120);
            const int b = it >> 6, r = it & 63, h = wid;
            for (int i = lane; i < 465; i += 64) rp[i] = PP(odd_rpb)[h * 465 + i] * LOG2E;
            for (int qh = 0; qh < 4 / QTL; ++qh) {
            const int qc0 = qh * (16 * QTL), qrow0 = b * SEQ + r * 64 + qc0;
            bf16x8 qf[QTL][2];
#pragma unroll
            for (int qt = 0; qt < QTL; ++qt)
#pragma unroll
                for (int ks = 0; ks < 2; ++ks) qf[qt][ks] = *(const bf16x8*)(F_PROJ + (size_t)(qrow0 + qt * 16 + fr) * QKV_LD + h * 64 + ks * 32 + 8 * fq);
            AttnStT<QTL> st;
#pragma unroll
            for (int qt = 0; qt < QTL; ++qt) { st.m[qt] = -1e30f; st.l[qt] = 0.f;
#pragma unroll
                for (int dt = 0; dt < 4; ++dt) st.o[dt][qt] = (f32x4){0.f, 0.f, 0.f, 0.f}; }
            const int r0 = min(max(r - 4, 0), 56);
            int c0q[QTL];
#pragma unroll
            for (int qt = 0; qt < QTL; ++qt) c0q[qt] = min(max(qc0 + qt * 16 + fr - 8, 0), 48);
            for (int s = 0; s < 16; ++s) {
                const int kr = r0 + (s >> 1), half = s & 1;
                const bf16_t* kp = F_PROJ + (size_t)(b * SEQ + kr * 64 + half * 32) * QKV_LD + 512 + h * 64;
                const bf16_t* vp = kp + 512;
                const LAS float* rpr = rp + (kr - r + 7) * 31 + 15;
#define SKIP_NA(qt) ({ const int qlo_ = qc0 + qt * 16, wlo_ = min(max(qlo_ - 8, 0), 48), whi_ = min(max(qlo_ + 15 - 8, 0), 48) + 15; (half * 32 + 31 < wlo_) || (half * 32 > whi_); })
#define BIAS_NA(qt, kt, j) ({ const int kc = half * 32 + kt * 16 + 4 * fq + j; const int dc = kc - (qc0 + qt * 16 + fr); (kc >= c0q[qt] && kc < c0q[qt] + 16) ? rpr[dc] : -INFINITY; })
                ATTN_STEP(kp, QKV_LD, vp, QKV_LD, SC, BIAS_NA, SKIP_NA);
            }
            for (int s = 0; s < 8; ++s) {
                const bf16_t* kp = F_PROJ + (size_t)(NMAIN + b * CTXL + s * 32) * QKV_LD + 512 + h * 64;
                const bf16_t* vp = kp + 512;
                ATTN_STEP(kp, QKV_LD, vp, QKV_LD, SC, BIAS_NONE, SKIP_NONE);
            }
            attn_store(st, F_MIX + (size_t)qrow0 * D + h * 64, D, fr, fq);
            }
    }
    __syncthreads();
    PolFour P; P.stage = 1; P.base_init(F, 2, N_F1); P.ldbB = 32768;
    gemm_stream_bf(F.lds, P, F.wid, F.lane);
}

__device__ __forceinline__ void phase_fst2(Frame& F) {
    PolFour P; P.stage = 2; P.base_init(F, 2, NB * 128); P.ldbB = 32768;
    gemm_stream_bf(F.lds, P, F.wid, F.lane);
}

__global__ void __launch_bounds__(512, 2) fwd_kernel(Params p) {
    extern __shared__ __attribute__((aligned(16))) unsigned char lds_raw[];
    Frame F;
    F.lds = (LAS unsigned char*)lds_raw;
    F.tid = threadIdx.x; F.lane = F.tid & 63; F.wid = __builtin_amdgcn_readfirstlane(F.tid >> 6); F.bid = blockIdx.x; F.G = gridDim.x;
    unsigned char* ws = p.ws; F.ws = ws;
    volatile LAS unsigned* MISC = (volatile LAS unsigned*)(F.lds + MISC_OFF);
    if (F.tid < 64) MISC[F.tid] = 0u;
    if (F.tid == 64) { LAS unsigned long long* LP = (LAS unsigned long long*)(F.lds + PARAM_OFF);
        LP[0] = (unsigned long long)p.x; LP[1] = (unsigned long long)p.c; LP[2] = (unsigned long long)p.ctx; LP[3] = (unsigned long long)p.c_ctx; LP[4] = (unsigned long long)p.ada_w; LP[5] = (unsigned long long)p.ada_b;
        LP[6] = (unsigned long long)p.norm_mix; LP[7] = (unsigned long long)p.norm_ffn; LP[8] = (unsigned long long)p.even_w_in; LP[9] = (unsigned long long)p.even_w_out; LP[10] = (unsigned long long)p.even_conv_w;
        LP[11] = (unsigned long long)p.even_sink; LP[12] = (unsigned long long)p.odd_w_in; LP[13] = (unsigned long long)p.odd_w_out; LP[14] = (unsigned long long)p.odd_rpb; LP[15] = (unsigned long long)p.router_w;
        LP[16] = (unsigned long long)p.router_b; LP[17] = (unsigned long long)p.moe_w_gu; LP[18] = (unsigned long long)p.moe_b_gu; LP[19] = (unsigned long long)p.moe_w_dn; LP[20] = (unsigned long long)p.moe_b_dn;
        LP[21] = (unsigned long long)p.final_norm; LP[22] = (unsigned long long)p.out; }
    __syncthreads();
    const int lo = p.ph_lo, hi = p.ph_hi;
    XcdBarrier bar; bar.bar = (unsigned*)(ws + WS_CTL) + CW_BAR; bar.x = 0; bar.st = MISC + 8;
    if (hi - lo > 1) bar = xcd_barrier_post((unsigned*)(ws + WS_CTL) + CW_BAR, MISC + 8);
#define RUN_PHASE(ph, call) do { if (PH_ON(ph) && lo <= (ph) && (ph) < hi) { call; if (PH_REP(ph)) { xcd_barrier(bar); call; } } if (lo <= (ph) && (ph) + 1 < hi) xcd_barrier(bar); } while (0)
    RUN_PHASE(PH_PREP, phase_prep(F));
    RUN_PHASE(PH_NORM1_0, phase_norm1_l0(F));
    RUN_PHASE(PH_INPROJ_0, phase_inproj_l0(F));
    RUN_PHASE(PH_ATTN_0, phase_attn_l0(F));
    RUN_PHASE(PH_OUTPROJ_0, phase_outproj(F, 0));
    RUN_PHASE(PH_ROUTE_0, phase_route(F, 0));
    RUN_PHASE(PH_MOE1_0, phase_moe1(F, bar, hi - lo > 1, 0));
    RUN_PHASE(PH_MOE2_0, phase_moe2(F, 0));
    RUN_PHASE(PH_COMB_0, phase_combine(F, 0));
    RUN_PHASE(PH_INPROJ_1, phase_inproj_l1(F));
    RUN_PHASE(PH_ATTN_1, phase_attn_l1(F));
    RUN_PHASE(PH_FST2_1, phase_fst2(F));
    RUN_PHASE(PH_OUTPROJ_1, phase_outproj(F, 1));
    RUN_PHASE(PH_ROUTE_1, phase_route(F, 1));
    RUN_PHASE(PH_MOE1_1, phase_moe1(F, bar, hi - lo > 1, 1));
    RUN_PHASE(PH_MOE2_1, phase_moe2(F, 1));
    RUN_PHASE(PH_FINAL, phase_combine(F, 1));
}

extern "C" void kernel_launch(void* const* d_in, const int* in_sizes, int n_in, void* d_out, int out_size, void* d_ws, size_t ws_size, hipStream_t stream) {
    static int grid = 0;
    if (grid == 0) {
        if (n_in != 22 || ws_size < WS_END) { fprintf(stderr, "kernel_launch: unexpected inputs (n_in %d, ws %zu)\n", n_in, ws_size); grid = -1; return; }
        int dev = 0, cus = 0, per_cu = 0;
        hipGetDevice(&dev);
        hipDeviceGetAttribute(&cus, hipDeviceAttributeMultiprocessorCount, dev);
        hipFuncSetAttribute((const void*)fwd_kernel, hipFuncAttributeMaxDynamicSharedMemorySize, LDS_BYTES);
        hipOccupancyMaxActiveBlocksPerMultiprocessor(&per_cu, (const void*)fwd_kernel, 512, LDS_BYTES);
        if (per_cu < 1) { fprintf(stderr, "kernel_launch: occupancy query says %d blocks/CU\n", per_cu); per_cu = 1; }
        (void)hipGetLastError();
        grid = cus;
    }
    if (grid < 0) return;
    hipMemsetAsync((char*)d_ws + WS_CTL, 0, 64 * 1024, stream);
    Params p{};
    const float** pp = (const float**)&p;
    for (int i = 0; i < 22; ++i) pp[i] = (const float*)d_in[i];
    p.out = (float*)d_out; p.ws = (unsigned char*)d_ws;
#if N_LAUNCH_MODE == 1
    for (int ph = 0; ph < NPHASE; ++ph) { p.ph_lo = ph; p.ph_hi = ph + 1; hipLaunchKernelGGL(fwd_kernel, dim3(grid), dim3(512), LDS_BYTES, stream, p); }
#else
    p.ph_lo = 0; p.ph_hi = NPHASE;
    void* args[] = {&p};
    hipError_t e = hipLaunchCooperativeKernel((const void*)fwd_kernel, dim3(grid), dim3(512), args, LDS_BYTES, stream);
    if (e != hipSuccess) fprintf(stderr, "kernel_launch: cooperative launch failed: %s (grid %d)\n", hipGetErrorString(e), grid);
#endif
}
```
